# Optimizing an MI355X kernel written in HIP

```python
import jax, jax.numpy as jnp
from jax import lax
import numpy as np

D_MODEL = 1024
BATCH = 4
SEQ = 4096
DEPTH = 2

GRID_W = 64
CTX_LEN = 256
ROPE_THETA = 10000.0
EPS = 1e-6
Q_BLOCK = 128
MLA_HEADS = 8
MLA_Q_RANK = 384
MLA_KV_RANK = 256
MLA_NOPE = 64
MLA_ROPE = 32
MLA_V = 64
GQA_HEADS = 8
GQA_KV_HEADS = 2
GQA_GROUP = GQA_HEADS // GQA_KV_HEADS
GQA_HEAD_DIM = 64
GLA_HEADS = 4
GLA_DK = D_MODEL // 2 // GLA_HEADS
GLA_DV = D_MODEL // GLA_HEADS
GLA_GATE_RANK = 16
GLA_GATE_NORM = 16.0
GLA_CHUNK = 32
FFN_DIM = 2816
N_EXPERTS = 8
TOP_K = 2
EXPERT_DIM = 3584

N_EVEN = (DEPTH + 1) // 2
N_ODD = DEPTH // 2

ATTN_WIDTHS = (MLA_Q_RANK, MLA_KV_RANK, MLA_ROPE, GQA_HEADS * GQA_HEAD_DIM,
               GQA_KV_HEADS * GQA_HEAD_DIM, GQA_KV_HEADS * GQA_HEAD_DIM)
ATTN_IN = MLA_Q_RANK + MLA_KV_RANK + MLA_ROPE + (GQA_HEADS + 2 * GQA_KV_HEADS) * GQA_HEAD_DIM
ATTN_MIX = MLA_HEADS * MLA_V + GQA_HEADS * GQA_HEAD_DIM
GLA_WIDTHS = (GLA_HEADS * GLA_DK, GLA_HEADS * GLA_DK, GLA_HEADS * GLA_DV, GLA_HEADS * GLA_DV,
              GLA_GATE_RANK, GLA_GATE_RANK)
GLA_IN = 2 * GLA_HEADS * GLA_DK + 2 * GLA_HEADS * GLA_DV + 2 * GLA_GATE_RANK
GLA_MIX = GLA_HEADS * GLA_DV

kernel_name = 'hybrid_mla_gqa_gla_moe_dit_block'


def rms_norm(x, g):
    x32 = x.astype(jnp.float32)
    y = x32 * lax.rsqrt(jnp.mean(x32 * x32, axis=-1, keepdims=True) + EPS)
    return (y * g).astype(x.dtype)


def modulate(h, shift, scale):
    return h * (1.0 + scale) + shift


def split_cols(z, widths):
    idx, acc = [], 0
    for w in widths[:-1]:
        acc += w
        idx.append(acc)
    return jnp.split(z, idx, axis=-1)


def to_heads(z, h):
    b, t, _ = z.shape
    return z.reshape(b, t, h, -1).transpose(0, 2, 1, 3)


def from_heads(o):
    b, h, t, d = o.shape
    return o.transpose(0, 2, 1, 3).reshape(b, t, h * d)


def rope_1d(x, pos):
    d = x.shape[-1]
    freqs = ROPE_THETA ** (-jnp.arange(0, d, 2, dtype=jnp.float32) / d)
    ang = pos.astype(jnp.float32)[:, None] * freqs[None, :]
    cos, sin = jnp.cos(ang), jnp.sin(ang)
    x32 = x.astype(jnp.float32)
    x1, x2 = x32[..., : d // 2], x32[..., d // 2:]
    return jnp.concatenate([x1 * cos - x2 * sin, x2 * cos + x1 * sin], axis=-1).astype(x.dtype)


def axial_rope(x, rows, cols):
    half = x.shape[-1] // 2
    return jnp.concatenate([rope_1d(x[..., :half], rows), rope_1d(x[..., half:], cols)], axis=-1)


def attend(q, k, v):
    s = jnp.einsum('bhgqd,bhkd->bhgqk', q, k, preferred_element_type=jnp.float32) * (q.shape[-1] ** -0.5)
    p = jax.nn.softmax(s, axis=-1)
    return jnp.einsum('bhgqk,bhkd->bhgqd', p.astype(v.dtype), v)


def blocked_attend(q, k, v):
    b, hk, g, t, d = q.shape
    nb = t // Q_BLOCK
    qb = jnp.moveaxis(q.reshape(b, hk, g, nb, Q_BLOCK, d), 3, 0)
    ob = lax.map(lambda qi: attend(qi, k, v), qb)
    return jnp.moveaxis(ob, 0, 3).reshape(b, hk, g, t, v.shape[-1])


def attn_project(u, w_in, q_a_norm, w_uq, kv_a_norm, w_ukv, qk_norm, rows, cols):
    b, t, _ = u.shape
    q_lat, kv_lat, k_rope, q_b, k_b, v_b = split_cols(u @ w_in, ATTN_WIDTHS)
    q_a = to_heads(rms_norm(q_lat, q_a_norm) @ w_uq, MLA_HEADS)
    kv_a = to_heads(rms_norm(kv_lat, kv_a_norm) @ w_ukv, MLA_HEADS)
    q_nope, q_rope = q_a[..., :MLA_NOPE], q_a[..., MLA_NOPE:]
    k_nope, v_a = kv_a[..., :MLA_NOPE], kv_a[..., MLA_NOPE:]
    k_rope = k_rope[:, None]
    q_b = rms_norm(to_heads(q_b, GQA_HEADS), qk_norm[0])
    k_b = rms_norm(to_heads(k_b, GQA_KV_HEADS), qk_norm[1])
    v_b = to_heads(v_b, GQA_KV_HEADS)
    if rows is not None:
        q_rope = axial_rope(q_rope, rows, cols)
        k_rope = axial_rope(k_rope, rows, cols)
        q_b = axial_rope(q_b, rows, cols)
        k_b = axial_rope(k_b, rows, cols)
    q_a = jnp.concatenate([q_nope, q_rope], axis=-1)[:, :, None]
    k_a = jnp.concatenate([k_nope, jnp.broadcast_to(k_rope, k_nope.shape[:-1] + (MLA_ROPE,))], axis=-1)
    q_b = q_b.reshape(b, GQA_KV_HEADS, GQA_GROUP, t, GQA_HEAD_DIM)
    return (q_a, k_a, v_a), (q_b, k_b, v_b)


def merge_heads(o_a, o_b):
    b, _, _, t, _ = o_a.shape
    o_a = o_a.transpose(0, 3, 1, 2, 4).reshape(b, t, -1)
    o_b = o_b.transpose(0, 3, 1, 2, 4).reshape(b, t, -1)
    return jnp.concatenate([o_a, o_b], axis=-1)


def attn_mixer(u_ctx, u_lat, w_in, q_a_norm, w_uq, kv_a_norm, w_ukv, qk_norm, w_out, rows, cols, ctx_out):
    (qa_c, ka_c, va_c), (qb_c, kb_c, vb_c) = attn_project(u_ctx, w_in, q_a_norm, w_uq, kv_a_norm, w_ukv, qk_norm, None, None)
    (qa_l, ka_l, va_l), (qb_l, kb_l, vb_l) = attn_project(u_lat, w_in, q_a_norm, w_uq, kv_a_norm, w_ukv, qk_norm, rows, cols)
    o_a = blocked_attend(qa_l, jnp.concatenate([ka_c, ka_l], axis=2), jnp.concatenate([va_c, va_l], axis=2))
    o_b = blocked_attend(qb_l, jnp.concatenate([kb_c, kb_l], axis=2), jnp.concatenate([vb_c, vb_l], axis=2))
    y_lat = merge_heads(o_a, o_b) @ w_out
    y_ctx = None
    if ctx_out:
        y_ctx = merge_heads(attend(qa_c, ka_c, va_c), attend(qb_c, kb_c, vb_c)) @ w_out
    return y_ctx, y_lat


def gla_chunked(q, k, v, log_a, s0):
    b, h, t, dk = q.shape
    dv = v.shape[-1]
    n = t // GLA_CHUNK

    def chunks(a):
        return jnp.moveaxis(a.astype(jnp.float32).reshape(b, h, n, GLA_CHUNK, a.shape[-1]), 2, 0)

    qc, kc, vc, ac = chunks(q), chunks(k), chunks(v), chunks(log_a)
    cum = jnp.cumsum(ac, axis=-2)
    cum_last = cum[..., -1:, :]
    q_dec = qc * jnp.exp(cum)
    k_intra = kc * jnp.exp(-cum)
    k_state = kc * jnp.exp(cum_last - cum)
    mask = jnp.tril(jnp.ones((GLA_CHUNK, GLA_CHUNK), jnp.float32))
    scores = jnp.einsum('nbhtk,nbhsk->nbhts', q_dec, k_intra) * mask
    o_intra = jnp.einsum('nbhts,nbhsv->nbhtv', scores, vc)

    def step(state, xs):
        q_n, k_n, v_n, cl_n = xs
        o_n = jnp.einsum('bhtk,bhkv->bhtv', q_n, state)
        state = jnp.exp(cl_n[..., 0, :])[..., None] * state + jnp.einsum('bhtk,bhtv->bhkv', k_n, v_n)
        return state, o_n

    s_final, o_inter = lax.scan(step, s0, (q_dec, k_state, vc, cum_last))
    o = jnp.moveaxis(o_intra + o_inter, 0, 2).reshape(b, h, t, dv)
    return o.astype(v.dtype), s_final


def gla_final_state(k, v, log_a):
    a = log_a.astype(jnp.float32)
    cum = jnp.cumsum(a, axis=-2)
    tail = cum[..., -1:, :] - cum
    return jnp.einsum('bhtk,bhtv->bhkv', k.astype(jnp.float32) * jnp.exp(tail), v.astype(jnp.float32))


def gla_project(u, w_in, w_gate2, b_gate):
    q, k, v, g, r_f, r_b = split_cols(u @ w_in, GLA_WIDTHS)
    q = to_heads(q, GLA_HEADS) * (GLA_DK ** -0.5)
    k = to_heads(k, GLA_HEADS)
    v = to_heads(v, GLA_HEADS)

    def log_decay(r, d):
        z = (r @ w_gate2[d] + b_gate[d]).astype(jnp.float32)
        return to_heads(jax.nn.log_sigmoid(z) / GLA_GATE_NORM, GLA_HEADS)

    return q, k, v, g, log_decay(r_f, 0), log_decay(r_b, 1)


def flip_t(a):
    return a[:, :, ::-1, :]


def gla_mixer(u_ctx, u_lat, w_in, w_gate2, b_gate, o_norm, w_out, ctx_out):
    qc, kc, vc, gc, afc, abc = gla_project(u_ctx, w_in, w_gate2, b_gate)
    ql, kl, vl, gl, afl, abl = gla_project(u_lat, w_in, w_gate2, b_gate)

    def finish(o, g):
        return (from_heads(rms_norm(o, o_norm)) * jax.nn.silu(g)) @ w_out

    y_ctx = None
    if ctx_out:
        zeros = jnp.zeros((qc.shape[0], GLA_HEADS, GLA_DK, GLA_DV), jnp.float32)
        oc_f, s_f = gla_chunked(qc, kc, vc, afc, zeros)
        oc_b, s_b = gla_chunked(flip_t(qc), flip_t(kc), flip_t(vc), flip_t(abc), zeros)
        y_ctx = finish(oc_f + flip_t(oc_b), gc)
    else:
        s_f = gla_final_state(kc, vc, afc)
        s_b = gla_final_state(flip_t(kc), flip_t(vc), flip_t(abc))
    ol_f, _ = gla_chunked(ql, kl, vl, afl, s_f)
    ol_b, _ = gla_chunked(flip_t(ql), flip_t(kl), flip_t(vl), flip_t(abl), s_b)
    y_lat = finish(ol_f + flip_t(ol_b), gl)
    return y_ctx, y_lat


def swiglu(u, w_gate, w_up, w_down):
    return (jax.nn.silu(u @ w_gate) * (u @ w_up)) @ w_down


def moe_swiglu(u, w_router, b_router, w_gate, w_up, w_down):
    logits = (u @ w_router).astype(jnp.float32) + b_router
    probs = jax.nn.softmax(logits, axis=-1)
    top_p, top_i = lax.top_k(probs, TOP_K)
    top_p = top_p / jnp.sum(top_p, axis=-1, keepdims=True)
    combine = jnp.einsum('btk,btke->bte', top_p, jax.nn.one_hot(top_i, N_EXPERTS, dtype=jnp.float32)).astype(u.dtype)
    y = jnp.zeros_like(u)
    for e in range(N_EXPERTS):
        y = y + combine[..., e:e + 1] * swiglu(u, w_gate[e], w_up[e], w_down[e])
    return y


def setup_inputs(seed: int = 0) -> dict:
    key = jax.random.key(seed)
    ks = iter(jax.random.split(key, 32))
    f32 = jnp.float32
    D = D_MODEL

    def normal(shape, scale=1.0):
        return jax.random.normal(next(ks), shape, f32) * scale

    def w(shape, fan_in, scale=1.0):
        return normal(shape, scale * fan_in ** -0.5)

    def gain(shape):
        return 1.0 + normal(shape, 0.05)

    return {
        'x': normal((BATCH, SEQ, D)),
        'c': normal((BATCH, D)),
        'ctx': normal((BATCH, CTX_LEN, D)),
        'c_ctx': normal((D,)),
        'mod_w': w((DEPTH, D, 6 * D), D, 0.5),
        'mod_b': normal((DEPTH, 6 * D), 0.02),
        'norm_g': gain((DEPTH, 4, D)),
        'attn_w_in': w((N_EVEN, D, ATTN_IN), D),
        'attn_q_norm': gain((N_EVEN, MLA_Q_RANK)),
        'attn_w_uq': w((N_EVEN, MLA_Q_RANK, MLA_HEADS * (MLA_NOPE + MLA_ROPE)), MLA_Q_RANK),
        'attn_kv_norm': gain((N_EVEN, MLA_KV_RANK)),
        'attn_w_ukv': w((N_EVEN, MLA_KV_RANK, MLA_HEADS * (MLA_NOPE + MLA_V)), MLA_KV_RANK),
        'attn_qk_norm': gain((N_EVEN, 2, GQA_HEAD_DIM)),
        'attn_w_out': w((N_EVEN, ATTN_MIX, D), ATTN_MIX),
        'gla_w_in': w((N_ODD, D, GLA_IN), D),
        'gla_w_gate2': w((N_ODD, 2, GLA_GATE_RANK, GLA_HEADS * GLA_DK), GLA_GATE_RANK),
        'gla_b_gate': normal((N_ODD, 2, GLA_HEADS * GLA_DK), 0.1),
        'gla_o_norm': gain((N_ODD, GLA_DV)),
        'gla_w_out': w((N_ODD, GLA_MIX, D), GLA_MIX),
        'ffn_w_gate': w((N_EVEN, D, FFN_DIM), D),
        'ffn_w_up': w((N_EVEN, D, FFN_DIM), D),
        'ffn_w_down': w((N_EVEN, FFN_DIM, D), FFN_DIM),
        'moe_w_router': w((N_ODD, D, N_EXPERTS), D),
        'moe_b_router': normal((N_ODD, N_EXPERTS), 0.01),
        'moe_w_gate': w((N_ODD, N_EXPERTS, D, EXPERT_DIM), D),
        'moe_w_up': w((N_ODD, N_EXPERTS, D, EXPERT_DIM), D),
        'moe_w_down': w((N_ODD, N_EXPERTS, EXPERT_DIM, D), EXPERT_DIM),
    }


def reference(x, c, ctx, c_ctx, mod_w, mod_b, norm_g, attn_w_in, attn_q_norm, attn_w_uq, attn_kv_norm,
              attn_w_ukv, attn_qk_norm, attn_w_out, gla_w_in, gla_w_gate2, gla_b_gate, gla_o_norm, gla_w_out,
              ffn_w_gate, ffn_w_up, ffn_w_down, moe_w_router, moe_b_router, moe_w_gate, moe_w_up, moe_w_down):
    t = x.shape[1]
    ROWS = t // GRID_W
    rows = jnp.repeat(jnp.arange(ROWS, dtype=jnp.int32), GRID_W)
    cols = jnp.tile(jnp.arange(GRID_W, dtype=jnp.int32), ROWS)

    def channel_mixer(u, layer):
        i = layer // 2
        if layer % 2 == 0:
            return swiglu(u, ffn_w_gate[i], ffn_w_up[i], ffn_w_down[i])
        return moe_swiglu(u, moe_w_router[i], moe_b_router[i], moe_w_gate[i], moe_w_up[i], moe_w_down[i])

    h_lat, h_ctx = x, ctx
    for layer in range(DEPTH):
        i = layer // 2
        last = layer == DEPTH - 1
        g = norm_g[layer]
        m_lat = [m[:, None, :] for m in jnp.split(jax.nn.silu(c) @ mod_w[layer] + mod_b[layer], 6, axis=-1)]
        m_ctx = jnp.split(jax.nn.silu(c_ctx) @ mod_w[layer] + mod_b[layer], 6, axis=-1)
        u_lat = modulate(rms_norm(h_lat, g[0]), m_lat[0], m_lat[1])
        u_ctx = modulate(rms_norm(h_ctx, g[0]), m_ctx[0], m_ctx[1])
        if layer % 2 == 0:
            y_ctx, y_lat = attn_mixer(u_ctx, u_lat, attn_w_in[i], attn_q_norm[i], attn_w_uq[i], attn_kv_norm[i],
                                      attn_w_ukv[i], attn_qk_norm[i], attn_w_out[i], rows, cols, not last)
        else:
            y_ctx, y_lat = gla_mixer(u_ctx, u_lat, gla_w_in[i], gla_w_gate2[i], gla_b_gate[i], gla_o_norm[i],
                                     gla_w_out[i], not last)
        h_lat = h_lat + m_lat[2] * rms_norm(y_lat, g[1])
        u_lat = modulate(rms_norm(h_lat, g[2]), m_lat[3], m_lat[4])
        h_lat = h_lat + m_lat[5] * rms_norm(channel_mixer(u_lat, layer), g[3])
        if not last:
            h_ctx = h_ctx + m_ctx[2] * rms_norm(y_ctx, g[1])
            u_ctx = modulate(rms_norm(h_ctx, g[2]), m_ctx[3], m_ctx[4])
            h_ctx = h_ctx + m_ctx[5] * rms_norm(channel_mixer(u_ctx, layer), g[3])
    return h_lat
```

```cpp
#include <hip/hip_runtime.h>
#include <cstdio>
#include <cstdint>

#ifndef MK_ONE_LAUNCH
#define MK_ONE_LAUNCH 1
#endif

#define LAS __attribute__((address_space(3)))
#define GAS __attribute__((address_space(1)))
typedef unsigned short bf16_t;
typedef short bf16x8 __attribute__((ext_vector_type(8)));
typedef short s16x4 __attribute__((ext_vector_type(4)));
typedef float f32x4 __attribute__((ext_vector_type(4)));
typedef float f32x16 __attribute__((ext_vector_type(16)));
typedef unsigned u32x4 __attribute__((ext_vector_type(4)));
typedef unsigned u32x2 __attribute__((ext_vector_type(2)));
typedef float f32x2_t __attribute__((ext_vector_type(2)));
typedef __bf16 bf16x2_t __attribute__((ext_vector_type(2)));
#define RLX_AGENT __ATOMIC_RELAXED, __HIP_MEMORY_SCOPE_AGENT

__device__ __forceinline__ unsigned cvtpk(float lo, float hi) { f32x2_t v = {lo, hi}; bf16x2_t b = __builtin_convertvector(v, bf16x2_t); return __builtin_bit_cast(unsigned, b); }
__device__ __forceinline__ bf16_t f2bf(float f) { return (bf16_t)(cvtpk(f, 0.f) & 0xffffu); }
__device__ __forceinline__ float bflo(unsigned w) { return __uint_as_float(w << 16); }
__device__ __forceinline__ float bfhi(unsigned w) { return __uint_as_float(w & 0xffff0000u); }
__device__ __forceinline__ float bf2f(bf16_t b) { return __uint_as_float(((unsigned)b) << 16); }
__device__ __forceinline__ float wave_sum(float v) {
#pragma unroll
    for (int o = 1; o < 64; o <<= 1) v += __shfl_xor(v, o);
    return v;
}
__device__ __forceinline__ float fast_exp(float x) { return __builtin_amdgcn_exp2f(x * 1.4426950408889634f); }
__device__ __forceinline__ float silu_f(float g) { return g * __builtin_amdgcn_rcpf(1.0f + fast_exp(-g)); }

#define XB_TMO      128
#define XB_XCNT(j)  (256  + 64 * (j))
#define XB_XSUB(j)  (1280 + 64 * (j))
#define XB_XGEN(j)  (2304 + 64 * (j))
#define XB_TOP      3328
#define XB_TOPGEN   3392
#define XCD_BAR_WORDS 3456
#define XB_SPIN_CAP (1u << 18)
__device__ __forceinline__ unsigned xb_ld(unsigned* p)              { return __hip_atomic_load(p, __ATOMIC_RELAXED, __HIP_MEMORY_SCOPE_AGENT); }
__device__ __forceinline__ unsigned xb_add(unsigned* p, unsigned v) { return __hip_atomic_fetch_add(p, v, __ATOMIC_RELAXED, __HIP_MEMORY_SCOPE_AGENT); }
__device__ __forceinline__ unsigned xb_xcc_id() { return (unsigned)__builtin_amdgcn_s_getreg((3 << 11) | 20) & 0xFu; }
#define XB_SPIN(cond, bar) do { unsigned _sp = 0; while (cond) { __builtin_amdgcn_s_sleep(1); \
    if ((++_sp & 255u) == 0u) { if (xb_ld(&(bar)[XB_TMO])) break; if (_sp > XB_SPIN_CAP) { atomicAdd(&(bar)[XB_TMO], 1u); break; } } } } while (0)
struct XcdBarrier { unsigned* bar; unsigned x; volatile LAS unsigned* st; };
__device__ __forceinline__ XcdBarrier xcd_barrier_post(unsigned* bar, volatile LAS unsigned* st) {
    XcdBarrier b; b.bar = bar; b.x = xb_xcc_id(); b.st = st;
    if (threadIdx.x == 0) (void)xb_add(&bar[XB_XCNT(b.x)], 1u);
    return b;
}
__device__ __forceinline__ void xcd_barrier_complete(unsigned* bar, unsigned x, unsigned& nloc, unsigned& nx) {
    const unsigned G = gridDim.x * gridDim.y * gridDim.z;
    unsigned sum, cnt, mine, sp = 0u;
    for (;;) {
        sum = 0u; cnt = 0u; mine = 0u;
#pragma unroll
        for (unsigned j = 0; j < 16; ++j) { const unsigned c = xb_ld(&bar[XB_XCNT(j)]); sum += c; cnt += (c > 0u) ? 1u : 0u; mine = (j == x) ? c : mine; }
        if (sum == G) break;
        __builtin_amdgcn_s_sleep(1);
        if ((++sp & 255u) == 0u) { if (xb_ld(&bar[XB_TMO])) break; if (sp > XB_SPIN_CAP) { atomicAdd(&bar[XB_TMO], 1u); break; } }
    }
    nloc = mine > 0u ? mine : 1u; nx = cnt > 0u ? cnt : 1u;
}
__device__ __forceinline__ void xcd_barrier(const XcdBarrier& b) {
    asm volatile("s_waitcnt vmcnt(0)" ::: "memory");
    __syncthreads();
    if (threadIdx.x == 0) {
        unsigned* bar = b.bar;
        __builtin_amdgcn_s_waitcnt(0);
        unsigned nloc = b.st[0], nx = b.st[1];
        if (nloc == 0u) { xcd_barrier_complete(bar, b.x, nloc, nx); b.st[0] = nloc; b.st[1] = nx; }
        const unsigned old = xb_add(&bar[XB_XSUB(b.x)], 1u);
        const unsigned gen = old / nloc;
        if (old + 1u == (gen + 1u) * nloc) {
            __builtin_amdgcn_fence(__ATOMIC_RELEASE, "agent");
            asm volatile("s_waitcnt vmcnt(0)" ::: "memory");
            const unsigned og = xb_add(&bar[XB_TOP], 1u);
            const unsigned tg = og / nx;
            if (og + 1u == (tg + 1u) * nx) xb_add(&bar[XB_TOPGEN], 1u);
            else XB_SPIN(xb_ld(&bar[XB_TOPGEN]) == tg, bar);
            __builtin_amdgcn_fence(__ATOMIC_ACQUIRE, "agent");
            xb_add(&bar[XB_XGEN(b.x)], 1u);
            asm volatile("s_waitcnt vmcnt(0)" ::: "memory");
        } else {
            XB_SPIN(xb_ld(&bar[XB_XGEN(b.x)]) == gen, bar);
            __builtin_amdgcn_fence(__ATOMIC_ACQUIRE, "agent");
            asm volatile("s_waitcnt vmcnt(0)" ::: "memory");
        }
    }
    __syncthreads();
}

constexpr int D = 1024, NB = 4, SEQ = 4096, CTX = 256;
constexpr int RL = NB * SEQ;
constexpr int RC = NB * CTX;
constexpr int R = RL + RC;
constexpr float EPS = 1e-6f;
constexpr float LOG2E = 1.4426950408889634f;
constexpr int N_IN0 = 1536, N_QA = 768, N_KVA = 1024, FFN = 2816, N_GU0 = 2 * FFN, N_IN1 = 3328, EXD = 3584, N_GU1 = 2 * EXD, NEXP = 8;
constexpr int CAPE = 16384;

constexpr size_t MiB = 1u << 20;
constexpr size_t O_CTL = 0;
constexpr size_t CTL_BYTES = 65536;
constexpr int CW_BAR = 0;
constexpr int CW_CNT = 8192;
constexpr size_t O_MODV = 1 * MiB;
constexpr size_t O_TAB16 = O_MODV + 256 * 1024;
constexpr size_t O_TAB32 = O_TAB16 + 8192;
constexpr size_t O_RSTDQ = O_TAB32 + 16384;
constexpr size_t O_RSTDKV = O_RSTDQ + 81920;
constexpr size_t O_SEL = 2 * MiB;
constexpr size_t O_ROWTOK = 3 * MiB;
constexpr size_t O_WGU1 = 4 * MiB;
constexpr size_t O_YE = O_WGU1;
constexpr size_t O_WD1 = 116 * MiB;
constexpr size_t O_WIN1 = 172 * MiB;
constexpr size_t O_WOUT1 = 179 * MiB;
constexpr size_t O_WIN0 = 181 * MiB;
constexpr size_t O_WUQ = 184 * MiB;
constexpr size_t O_WUKV = 185 * MiB;
constexpr size_t O_WOUT0 = 186 * MiB;
constexpr size_t O_WGU0 = 188 * MiB;
constexpr size_t O_WD0 = 199 * MiB;
constexpr size_t O_HC = 205 * MiB;
constexpr size_t O_U = 209 * MiB;
constexpr size_t O_Y = 243 * MiB;
constexpr size_t O_Z0 = 311 * MiB;
constexpr size_t O_QA = 362 * MiB;
constexpr size_t O_KVA = 388 * MiB;
constexpr size_t O_QB = 422 * MiB;
constexpr size_t O_KB = 439 * MiB;
constexpr size_t O_KR = 444 * MiB;
constexpr size_t O_AO = 446 * MiB;
constexpr size_t O_H0 = 311 * MiB;
constexpr size_t O_QK1 = 311 * MiB;
constexpr size_t O_V1 = 345 * MiB;
constexpr size_t O_G1 = 379 * MiB;
constexpr size_t O_RR = 413 * MiB;
constexpr size_t O_QDF = 422 * MiB, O_KIF = 439 * MiB, O_KTF = 456 * MiB, O_QDB = 473 * MiB;
constexpr size_t O_KIB = 243 * MiB, O_KTB = 260 * MiB, O_VT = 277 * MiB;
constexpr size_t O_ECL = 490 * MiB;
constexpr size_t O_OF = O_QK1, O_OB = O_V1;
constexpr size_t O_GA = O_QDF;
constexpr size_t O_HM = 243 * MiB;
constexpr size_t WS_END = 495 * MiB;
static_assert(O_HM + (size_t)34816 * EXD * 2 <= 482 * MiB, "HM");
static_assert(O_RR + (size_t)R * 256 * 2 <= O_QDF, "RR");
static_assert(O_ECL + (size_t)544 * 8 * 1024 <= WS_END, "ECL");

constexpr int RING_BYTES = 131072;
constexpr int LDSCTL_OFF = RING_BYTES;
constexpr int LDS_BYTES = 147456;

struct Args {
    const float* in[27];
    float* out; unsigned char* ws;
    int ph_lo, ph_hi;
};
enum { I_X = 0, I_C, I_CTX, I_CCTX, I_MODW, I_MODB, I_NORMG, I_AWIN, I_AQN, I_AWUQ, I_AKVN, I_AWUKV, I_AQKN, I_AWOUT, I_GWIN, I_GGATE2, I_GBGATE, I_GONORM, I_GWOUT,
       I_FWG, I_FWU, I_FWD, I_MROUTER, I_MBROUTER, I_MWG, I_MWU, I_MWD };

struct Conv { const float* s0; const float* s1; int Nsrc; int K; int Ndst; bf16_t* dst; int mode; const float* kscale; };
__device__ __forceinline__ int ilv64(int p) { return (p >> 5) * 32 + (p & 1) * 16 + ((p & 31) >> 1); }
__device__ __forceinline__ int ilv32(int p) { return (p >> 4) * 16 + (p & 1) * 8 + ((p & 15) >> 1); }
__device__ __forceinline__ const float* conv_col(const Conv& c, int n, float& sc) {
    sc = 1.0f;
    switch (c.mode) {
    case 0: return c.s0 + n;
    case 1: {
        if (n < 640) return c.s0 + n;
        if (n < 1152) { const int hh = (n - 640) >> 6, p = (n - 640) & 63; return c.s0 + 672 + hh * 64 + ilv64(p); }
        if (n < 1280) { const int hh = (n - 1152) >> 6, p = (n - 1152) & 63; return c.s0 + 1184 + hh * 64 + ilv64(p); }
        if (n < 1408) return c.s0 + 1312 + (n - 1280);
        if (n < 1440) return c.s0 + 640 + ilv32(n - 1408);
        return nullptr; }
    case 2: {
        if (n < 512) return c.s0 + (n >> 6) * 96 + (n & 63);
        const int hh = (n - 512) >> 5, p = (n - 512) & 31; return c.s0 + hh * 96 + 64 + ilv32(p); }
    case 3: {
        const int G = n >> 5, j = n & 31; return (j < 16) ? c.s0 + 16 * G + j : c.s1 + 16 * G + (j - 16); }
    case 4: {
        if (n >= 3104) return nullptr;
        if (n < 512) sc = 0.08838834764831845f;
        return c.s0 + n; }
    }
    return nullptr;
}
__device__ __forceinline__ void conv_item(const Conv& c, int item, LAS float* scr, int lane) {
    const int nblk = c.Ndst / 32, kb = item / nblk, nb = item % nblk, k0 = 64 * kb, n0 = 32 * nb;
    float sc; const float* cp = conv_col(c, n0 + (lane & 31), sc);
    const int kh = lane >> 5;
#pragma unroll 16
    for (int i = 0; i < 32; ++i) { const int kk = 2 * i + kh; float v = 0.f;
        if (cp) { v = cp[(size_t)(k0 + kk) * c.Nsrc] * sc; if (c.kscale) v *= c.kscale[k0 + kk]; }
        scr[kk * 33 + (lane & 31)] = v; }
    asm volatile("s_waitcnt lgkmcnt(0)" ::: "memory");
    const int ch = lane & 7;
#pragma unroll
    for (int j = 0; j < 4; ++j) { const int n = (lane >> 3) + 8 * j; const LAS float* s = scr + (8 * ch) * 33 + n;
        u32x4 o; o.x = cvtpk(s[0 * 33], s[1 * 33]); o.y = cvtpk(s[2 * 33], s[3 * 33]); o.z = cvtpk(s[4 * 33], s[5 * 33]); o.w = cvtpk(s[6 * 33], s[7 * 33]);
        *(u32x4*)(c.dst + (size_t)(n0 + n) * c.K + k0 + 8 * ch) = o; }
    asm volatile("s_waitcnt lgkmcnt(0)" ::: "memory");
}

namespace pg8 {
constexpr int BM = 256, BK = 64, HALF = 128, HTB = HALF * BK * 2, STAGE_BYTES = 8 * HTB;
constexpr int NXCD = 8, WGM = 8;
__device__ __forceinline__ int lds_byte(int r, int c) { const int st = (r >> 4) * 2 + (c >> 5), rr = r & 15, cc = c & 31, ob = rr * 64 + cc * 2; return st * 1024 + (ob ^ (((ob >> 9) & 1) << 5)); }
__device__ __forceinline__ void stage_rc(int b, int& Rr, int& C) { const int st = b / 1024, sb = b % 1024, swz = sb ^ (((sb >> 9) & 1) << 5); Rr = (st >> 1) * 16 + swz / 64; C = (st & 1) * 32 + (swz % 64) / 2; }
__device__ __forceinline__ int perm32(int rho) { const int n = rho >> 4, i = rho & 15; return 8 * (i >> 2) + 4 * n + (i & 3); }
struct Unit { int pm, pn; };
struct Order {
    int nM, nN, nwg, G, c;
    __device__ __forceinline__ void init(int nM_, int nN_, int G_, int c_) { nM = nM_; nN = nN_; nwg = nM * nN; G = G_; c = c_; }
    __device__ __forceinline__ bool next(int i, Unit& u) const {
        const long L = (long)i * G + c; if (L >= nwg) return false;
        int wgid = (int)L; { const int q = nwg / NXCD, r = nwg % NXCD, xcd = wgid % NXCD, off = wgid / NXCD; wgid = (xcd < r ? xcd * (q + 1) : r * (q + 1) + (xcd - r) * q) + off; }
        const int nig = WGM * nN, gid = wgid / nig, fm = gid * WGM, gsz = (nM - fm) < WGM ? (nM - fm) : WGM;
        u.pm = fm + ((wgid % nig) % gsz); u.pn = (wgid % nig) / gsz; return true;
    }
};

template <class Prob, class Epi>
__device__ __forceinline__ void gemm_phase(LAS unsigned char* lds, const Prob& P, const Epi& E) {
    const int tid = threadIdx.x, wid = __builtin_amdgcn_readfirstlane(tid >> 6), lane = tid & 63, wr = wid >> 2, wc = wid & 3, fr = lane & 15, fq = lane >> 4;
    const int K = P.K, nt = K / BK, ldb = P.ldb;
    int RA[2], CA[2]; unsigned voffB[2];
#pragma unroll
    for (int i = 0; i < 2; ++i) { int Rr, C; stage_rc(tid * 16 + i * 8192, Rr, C); const int Rb = Epi::PERM ? ((Rr & ~31) + perm32(Rr & 31)) : Rr;
        RA[i] = Rr; CA[i] = C; voffB[i] = (unsigned)(Rb * ldb + C) * 2u; }
    const size_t hstepB = (size_t)HALF * ldb * 2;
    const unsigned ldsw = (unsigned)wid * 1024u;
    const int aoff = lds_byte(wr * 64 + fr, fq * 8), boff = lds_byte(wc * 32 + fr, fq * 8);
    const char* Abase = (const char*)P.Abase;
#define PG8_SA(b, h) (((b) * 2 + (h)) * HTB)
#define PG8_SB(b, h) ((4 + (b) * 2 + (h)) * HTB)
#define PG8_STAGEB(bufoff, gbase) do { _Pragma("unroll") for (int _i = 0; _i < 2; ++_i) \
        __builtin_amdgcn_global_load_lds((const unsigned*)((const char*)(gbase) + voffB[_i]), (LAS unsigned*)(lds + (bufoff) + ldsw + _i * 8192), 16, 0, 0); } while (0)
#define PG8_STAGEA(bufoff, vo, h, kb) do { _Pragma("unroll") for (int _i = 0; _i < 2; ++_i) \
        __builtin_amdgcn_global_load_lds((const unsigned*)(Abase + (size_t)(kb) + (vo)[h][_i]), (LAS unsigned*)(lds + (bufoff) + ldsw + _i * 8192), 16, 0, 0); } while (0)
#define PG8_LDA(dst, b, h) do { _Pragma("unroll") for (int m = 0; m < 4; ++m) _Pragma("unroll") for (int k = 0; k < 2; ++k) dst[m][k] = *(const LAS bf16x8*)(lds + PG8_SA(b, h) + aoff + m * 2048 + k * 1024); } while (0)
#define PG8_LDB(dst, b, h) do { _Pragma("unroll") for (int n = 0; n < 2; ++n) _Pragma("unroll") for (int k = 0; k < 2; ++k) dst[n][k] = *(const LAS bf16x8*)(lds + PG8_SB(b, h) + boff + n * 2048 + k * 1024); } while (0)
#define PG8_MMA(ai, bj, At, Bt) do { __builtin_amdgcn_s_setprio(1); _Pragma("unroll") for (int m = 0; m < 4; ++m) _Pragma("unroll") for (int n = 0; n < 2; ++n) _Pragma("unroll") for (int k = 0; k < 2; ++k) \
        acc[ai][bj][m][n] = __builtin_amdgcn_mfma_f32_16x16x32_bf16(Bt[n][k], At[m][k], acc[ai][bj][m][n], 0, 0, 0); __builtin_amdgcn_s_setprio(0); } while (0)
#define PG8_WAIT_V(n) asm volatile("s_waitcnt vmcnt(" #n ")" ::: "memory")
#define PG8_WAIT_L(n) asm volatile("s_waitcnt lgkmcnt(" #n ")" ::: "memory")
#define PG8_BAR __builtin_amdgcn_s_barrier()
#define PG8_SCHED __builtin_amdgcn_sched_barrier(0)
    Unit cur, nxt; int ui = 0;
    if (!P.next(0, cur)) return;
    f32x4 acc[2][2][4][2];
#pragma unroll
    for (int a = 0; a < 2; ++a)
#pragma unroll
        for (int b = 0; b < 2; ++b)
#pragma unroll
            for (int m = 0; m < 4; ++m)
#pragma unroll
                for (int n = 0; n < 2; ++n) acc[a][b][m][n] = (f32x4){0.f, 0.f, 0.f, 0.f};
    bf16x8 At[4][2], B0[2][2], B1[2][2];
    unsigned cvo[2][2], nvo[2][2];
#pragma unroll
    for (int h = 0; h < 2; ++h)
#pragma unroll
        for (int i = 0; i < 2; ++i) cvo[h][i] = P.a_off(cur, h * HALF + RA[i]) + (unsigned)CA[i] * 2u;
    const char* cB = P.b_ptr(cur);
    const size_t kstep = (size_t)(BK * 2);
    PG8_STAGEB(PG8_SB(0, 0), cB); PG8_STAGEA(PG8_SA(0, 0), cvo, 0, 0); PG8_STAGEB(PG8_SB(0, 1), cB + hstepB); PG8_STAGEA(PG8_SA(0, 1), cvo, 1, 0);
    if (wr == 1) PG8_BAR;
    PG8_WAIT_V(4); PG8_BAR;
    PG8_STAGEB(PG8_SB(1, 0), cB + kstep); PG8_STAGEA(PG8_SA(1, 0), cvo, 0, kstep); PG8_STAGEB(PG8_SB(1, 1), cB + hstepB + kstep);
    PG8_WAIT_V(6); PG8_BAR;
    for (;;) {
        const bool has_next = P.next(ui + 1, nxt);
        const char* nB = cB;
#pragma unroll
        for (int h = 0; h < 2; ++h)
#pragma unroll
            for (int i = 0; i < 2; ++i) nvo[h][i] = cvo[h][i];
        if (has_next) { nB = P.b_ptr(nxt);
#pragma unroll
            for (int h = 0; h < 2; ++h)
#pragma unroll
                for (int i = 0; i < 2; ++i) nvo[h][i] = P.a_off(nxt, h * HALF + RA[i]) + (unsigned)CA[i] * 2u; }
        for (int t = 0; t < nt; t += 2) {
            const bool last = (t == nt - 2);
            const size_t k1 = (size_t)(t + 1) * kstep;
            const size_t k2 = last ? 0 : (size_t)(t + 2) * kstep, k3 = k2 + kstep;
            unsigned vo2[2][2];
#pragma unroll
            for (int h = 0; h < 2; ++h)
#pragma unroll
                for (int i = 0; i < 2; ++i) vo2[h][i] = last ? nvo[h][i] : cvo[h][i];
            const char* b2 = (last ? nB : cB) + k2; const char* b3 = b2 + kstep;
            PG8_LDB(B0, 0, 0); PG8_SCHED; PG8_LDA(At, 0, 0); PG8_STAGEA(PG8_SA(1, 1), cvo, 1, k1);
            PG8_WAIT_L(8); PG8_BAR; PG8_WAIT_L(0); PG8_MMA(0, 0, At, B0); PG8_BAR; PG8_SCHED;
            PG8_LDB(B1, 0, 1); PG8_STAGEB(PG8_SB(0, 0), b2);
            PG8_BAR; PG8_WAIT_L(0); PG8_MMA(0, 1, At, B1); PG8_BAR;
            PG8_LDA(At, 0, 1); PG8_STAGEA(PG8_SA(0, 0), vo2, 0, k2);
            PG8_BAR; PG8_WAIT_L(0); PG8_MMA(1, 0, At, B0); PG8_BAR; PG8_SCHED;
            PG8_STAGEB(PG8_SB(0, 1), b2 + hstepB);
            PG8_WAIT_V(6); PG8_BAR; PG8_MMA(1, 1, At, B1); PG8_BAR;
            PG8_LDB(B0, 1, 0); PG8_SCHED; PG8_LDA(At, 1, 0); PG8_STAGEA(PG8_SA(0, 1), vo2, 1, k2);
            PG8_WAIT_L(8); PG8_BAR; PG8_WAIT_L(0); PG8_MMA(0, 0, At, B0); PG8_BAR; PG8_SCHED;
            PG8_LDB(B1, 1, 1); PG8_STAGEB(PG8_SB(1, 0), b3);
            PG8_BAR; PG8_WAIT_L(0); PG8_MMA(0, 1, At, B1); PG8_BAR;
            PG8_LDA(At, 1, 1); PG8_STAGEA(PG8_SA(1, 0), vo2, 0, k3);
            PG8_BAR; PG8_WAIT_L(0); PG8_MMA(1, 0, At, B0); PG8_BAR; PG8_SCHED;
            PG8_STAGEB(PG8_SB(1, 1), b3 + hstepB);
            PG8_WAIT_V(6); PG8_BAR; PG8_MMA(1, 1, At, B1); PG8_BAR;
        }
        E(acc, P, cur, wr, wc, fr, fq);
        if (!has_next) break;
#pragma unroll
        for (int a = 0; a < 2; ++a)
#pragma unroll
            for (int b = 0; b < 2; ++b)
#pragma unroll
                for (int m = 0; m < 4; ++m)
#pragma unroll
                    for (int n = 0; n < 2; ++n) acc[a][b][m][n] = (f32x4){0.f, 0.f, 0.f, 0.f};
        cur = nxt; cB = nB; ++ui;
#pragma unroll
        for (int h = 0; h < 2; ++h)
#pragma unroll
            for (int i = 0; i < 2; ++i) cvo[h][i] = nvo[h][i];
    }
    PG8_WAIT_V(0);
    if (wr == 0) PG8_BAR;
    PG8_BAR;
#undef PG8_SA
#undef PG8_SB
#undef PG8_STAGEA
#undef PG8_STAGEB
#undef PG8_LDA
#undef PG8_LDB
#undef PG8_MMA
#undef PG8_WAIT_V
#undef PG8_WAIT_L
#undef PG8_BAR
#undef PG8_SCHED
}

struct DenseProb {
    const bf16_t* Abase; const bf16_t* Bt; int K, lda, ldb; Order ord;
    __device__ __forceinline__ bool next(int i, Unit& u) const { return ord.next(i, u); }
    __device__ __forceinline__ unsigned a_off(const Unit& u, int r) const { return (unsigned)((size_t)(u.pm * BM + r) * lda * 2); }
    __device__ __forceinline__ const char* b_ptr(const Unit& u) const { return (const char*)Bt + (size_t)u.pn * BM * ldb * 2; }
    __device__ __forceinline__ int orow0(const Unit& u) const { return u.pm * BM; }
};
struct MoeTiles { unsigned long long tp8; unsigned long long c4a, c4b; int nt; };
__device__ __forceinline__ int moe_tp(const MoeTiles& T, int e) { return (int)((T.tp8 >> (8 * e)) & 0xffull); }
__device__ __forceinline__ int moe_cnt(const MoeTiles& T, int e) { const unsigned long long w = (e < 4) ? T.c4a : T.c4b; return (int)((w >> (16 * (e & 3))) & 0xffffull); }
__device__ __forceinline__ int moe_expert(const MoeTiles& T, int pm) { int e = 0;
#pragma unroll
    for (int j = 1; j < 8; ++j) e += (pm >= (int)((T.tp8 >> (8 * j)) & 0xffull)) ? 1 : 0;
    return e; }
struct MoeGuProb {
    const bf16_t* Abase; const bf16_t* Bt; int K, lda, ldb; Order ord; MoeTiles T; const int* rowtok;
    __device__ __forceinline__ bool next(int i, Unit& u) const { return ord.next(i, u); }
    __device__ __forceinline__ unsigned a_off(const Unit& u, int r) const {
        const int e = moe_expert(T, u.pm); const int idx = (u.pm - moe_tp(T, e)) * BM + r; int tok = 0;
        if (idx < moe_cnt(T, e)) tok = rowtok[e * CAPE + idx];
        return (unsigned)tok * (unsigned)(lda * 2); }
    __device__ __forceinline__ const char* b_ptr(const Unit& u) const { const int e = moe_expert(T, u.pm); return (const char*)Bt + ((size_t)e * N_GU1 + (size_t)u.pn * BM) * ldb * 2; }
    __device__ __forceinline__ int orow0(const Unit& u) const { return u.pm * BM; }
};
struct MoeDnProb {
    const bf16_t* Abase; const bf16_t* Bt; int K, lda, ldb; Order ord; MoeTiles T;
    __device__ __forceinline__ bool next(int i, Unit& u) const { return ord.next(i, u); }
    __device__ __forceinline__ unsigned a_off(const Unit& u, int r) const { return (unsigned)((size_t)(u.pm * BM + r) * lda * 2); }
    __device__ __forceinline__ const char* b_ptr(const Unit& u) const { const int e = moe_expert(T, u.pm); return (const char*)Bt + ((size_t)e * D + (size_t)u.pn * BM) * ldb * 2; }
    __device__ __forceinline__ int orow0(const Unit& u) const { return u.pm * BM; }
};

struct EpiF32 { static constexpr bool PERM = false; float* C; int ldc;
    template <class Prob> __device__ __forceinline__ void operator()(const f32x4 (&acc)[2][2][4][2], const Prob& P, const Unit& u, int wr, int wc, int fr, int fq) const {
        const int row0 = P.orow0(u) + wr * 64 + fr, col0 = u.pn * BM + wc * 32 + 4 * fq;
#pragma unroll
        for (int ai = 0; ai < 2; ++ai)
#pragma unroll
            for (int m = 0; m < 4; ++m) { float* rowp = C + (size_t)(row0 + ai * HALF + m * 16) * ldc + col0;
#pragma unroll
                for (int bj = 0; bj < 2; ++bj)
#pragma unroll
                    for (int n = 0; n < 2; ++n) *(f32x4*)(rowp + bj * HALF + n * 16) = acc[ai][bj][m][n]; }
    }
};
struct EpiBf16 { static constexpr bool PERM = true; bf16_t* O; int ldc; const float* rowscale;
    template <class Prob> __device__ __forceinline__ void operator()(const f32x4 (&acc)[2][2][4][2], const Prob& P, const Unit& u, int wr, int wc, int fr, int fq) const {
        const int row0 = P.orow0(u) + wr * 64 + fr, col0 = u.pn * BM + wc * 32 + 8 * fq;
#pragma unroll
        for (int ai = 0; ai < 2; ++ai)
#pragma unroll
            for (int m = 0; m < 4; ++m) { const int row = row0 + ai * HALF + m * 16; bf16_t* rowp = O + (size_t)row * ldc + col0; const float rs = rowscale ? rowscale[row] : 1.0f;
#pragma unroll
                for (int bj = 0; bj < 2; ++bj) { const f32x4 v0 = acc[ai][bj][m][0] * rs, v1 = acc[ai][bj][m][1] * rs;
                    u32x4 w; w.x = cvtpk(v0[0], v0[1]); w.y = cvtpk(v0[2], v0[3]); w.z = cvtpk(v1[0], v1[1]); w.w = cvtpk(v1[2], v1[3]);
                    *(u32x4*)(rowp + bj * HALF) = w; } }
    }
};
struct EpiIn1 { static constexpr bool PERM = true; bf16_t* QK; bf16_t* V; bf16_t* G; bf16_t* RRp;
    template <class Prob> __device__ __forceinline__ void operator()(const f32x4 (&acc)[2][2][4][2], const Prob& P, const Unit& u, int wr, int wc, int fr, int fq) const {
        const int t = u.pn >> 2; bf16_t* base = (t == 0) ? QK : (t == 1) ? V : (t == 2) ? G : RRp; const int ldc = (t == 3) ? 256 : 1024;
        const int row0 = P.orow0(u) + wr * 64 + fr, col0 = (u.pn & 3) * BM + wc * 32 + 8 * fq;
#pragma unroll
        for (int ai = 0; ai < 2; ++ai)
#pragma unroll
            for (int m = 0; m < 4; ++m) { const int row = row0 + ai * HALF + m * 16; bf16_t* rowp = base + (size_t)row * ldc + col0;
#pragma unroll
                for (int bj = 0; bj < 2; ++bj) { const f32x4 v0 = acc[ai][bj][m][0], v1 = acc[ai][bj][m][1];
                    u32x4 w; w.x = cvtpk(v0[0], v0[1]); w.y = cvtpk(v0[2], v0[3]); w.z = cvtpk(v1[0], v1[1]); w.w = cvtpk(v1[2], v1[3]);
                    *(u32x4*)(rowp + bj * HALF) = w; } }
    }
};
struct EpiQA { static constexpr bool PERM = true; bf16_t* O; const float* rstd; const float* tab16; float qscale;
    template <class Prob> __device__ __forceinline__ void operator()(const f32x4 (&acc)[2][2][4][2], const Prob& P, const Unit& u, int wr, int wc, int fr, int fq) const {
        const int row0 = P.orow0(u) + wr * 64 + fr, col0 = u.pn * BM + wc * 32 + 8 * fq;
        const bool ropet = (u.pn == 2);
#pragma unroll
        for (int ai = 0; ai < 2; ++ai)
#pragma unroll
            for (int m = 0; m < 4; ++m) { const int row = row0 + ai * HALF + m * 16; bf16_t* rowp = O + (size_t)row * N_QA + col0; const float rs = rstd[row] * qscale;
                f32x4 cs0 = {1.f, 1.f, 1.f, 1.f}, sn0 = {0.f, 0.f, 0.f, 0.f};
                if (ropet && row < RL) { const int tt = row & (SEQ - 1); const int pos = (fq >> 1) ? (tt & 63) : (tt >> 6); const int i0 = 4 * (fq & 1);
                    cs0 = *(const f32x4*)(tab16 + pos * 8 + i0); sn0 = *(const f32x4*)(tab16 + 512 + pos * 8 + i0); }
#pragma unroll
                for (int bj = 0; bj < 2; ++bj) { f32x4 v0 = acc[ai][bj][m][0] * rs, v1 = acc[ai][bj][m][1] * rs;
                    if (ropet) {
                        const f32x4 a = v0, b = v1;
                        v0[0] = a[0] * cs0[0] - a[1] * sn0[0]; v0[1] = a[1] * cs0[0] + a[0] * sn0[0];
                        v0[2] = a[2] * cs0[1] - a[3] * sn0[1]; v0[3] = a[3] * cs0[1] + a[2] * sn0[1];
                        v1[0] = b[0] * cs0[2] - b[1] * sn0[2]; v1[1] = b[1] * cs0[2] + b[0] * sn0[2];
                        v1[2] = b[2] * cs0[3] - b[3] * sn0[3]; v1[3] = b[3] * cs0[3] + b[2] * sn0[3]; }
                    u32x4 w; w.x = cvtpk(v0[0], v0[1]); w.y = cvtpk(v0[2], v0[3]); w.z = cvtpk(v1[0], v1[1]); w.w = cvtpk(v1[2], v1[3]);
                    *(u32x4*)(rowp + bj * HALF) = w; } }
    }
};
struct EpiSwiglu { static constexpr bool PERM = false; bf16_t* Hh; int ldh;
    template <class Prob> __device__ __forceinline__ void operator()(const f32x4 (&acc)[2][2][4][2], const Prob& P, const Unit& u, int wr, int wc, int fr, int fq) const {
        const int row0 = P.orow0(u) + wr * 64 + fr, col0 = (u.pn * BM + wc * 32) / 2 + 4 * fq;
#pragma unroll
        for (int ai = 0; ai < 2; ++ai)
#pragma unroll
            for (int m = 0; m < 4; ++m) { bf16_t* rowp = Hh + (size_t)(row0 + ai * HALF + m * 16) * ldh + col0;
#pragma unroll
                for (int bj = 0; bj < 2; ++bj) { const f32x4 g = acc[ai][bj][m][0], up = acc[ai][bj][m][1];
                    u32x2 w; w.x = cvtpk(silu_f(g[0]) * up[0], silu_f(g[1]) * up[1]); w.y = cvtpk(silu_f(g[2]) * up[2], silu_f(g[3]) * up[3]);
                    *(u32x2*)(rowp + bj * (HALF / 2)) = w; } }
    }
};
}

struct Frame {
    LAS unsigned char* lds;
    unsigned char* ws;
    int tid, lane, wave, vcu, G;
};
template <class T> __device__ __forceinline__ T* wsp(const Frame& F, size_t off) { return (T*)(F.ws + off); }

__device__ __forceinline__ void load_row(const float* p, int lane, f32x4 (&v)[4]) {
    const f32x4* r = (const f32x4*)p + lane;
#pragma unroll
    for (int j = 0; j < 4; ++j) v[j] = r[64 * j];
}
__device__ __forceinline__ float row_ssq(const f32x4 (&v)[4]) { float s = 0.f;
#pragma unroll
    for (int j = 0; j < 4; ++j) s += (v[j][0] * v[j][0] + v[j][1] * v[j][1]) + (v[j][2] * v[j][2] + v[j][3] * v[j][3]);
    return wave_sum(s); }
__device__ __forceinline__ void norm_mod_store(const f32x4 (&h)[4], const float* g, const float* sh, const float* sc, bf16_t* urow, int lane, f32x4 (&uo)[4]) {
    const float rstd = __builtin_amdgcn_rsqf(row_ssq(h) * (1.0f / D) + EPS);
#pragma unroll
    for (int j = 0; j < 4; ++j) { const int c = 4 * lane + 256 * j; const f32x4 gg = *(const f32x4*)(g + c), s1 = *(const f32x4*)(sc + c), s0 = *(const f32x4*)(sh + c);
        const f32x4 uu = (h[j] * rstd * gg) * (1.0f + s1) + s0; uo[j] = uu;
        u32x2 w; w.x = cvtpk(uu[0], uu[1]); w.y = cvtpk(uu[2], uu[3]); *(u32x2*)(urow + c) = w; }
}
__device__ __forceinline__ int row_bidx(int row) { return row < RL ? (row >> 12) : 4; }

template <int DQK> struct AttnSrc {
    const bf16_t* Q; int qpitch; const bf16_t* Qr;
    const bf16_t* Kn; int kpitch; const bf16_t* Kr; int krpitch;
    const bf16_t* V; int vpitch;
    bf16_t* O; int opitch;
};
__device__ __forceinline__ s16x4 vtr(const LAS unsigned char* p) { typedef short v4i16_t __attribute__((ext_vector_type(4))); return __builtin_bit_cast(s16x4, __builtin_amdgcn_ds_read_tr16_b64_v4i16((LAS v4i16_t*)p)); }
__device__ __forceinline__ int attn_krow(int kt, int lat0, int ctx0) { return kt < 64 ? lat0 + kt * 64 : ctx0 + (kt - 64) * 64; }
template <int DQK>
__device__ __forceinline__ void attn_unit(const Frame& F, const AttnSrc<DQK>& S, int q0, int lat0, int ctx0, int kt0, int kt1) {
    constexpr int NKS = DQK / 16, KB = DQK * 128, SLOT = KB + 8192;
    constexpr float THR = 8.0f;
    const int lane = F.lane, wid = F.wave, r32 = lane & 31, hi = lane >> 5;
    LAS unsigned char* lds = F.lds;
    bf16x8 qf[NKS];
    { const bf16_t* qrow = S.Q + (size_t)(q0 + wid * 32 + r32) * S.qpitch;
#pragma unroll
      for (int ks = 0; ks < 4; ++ks) qf[ks] = *(const bf16x8*)(qrow + ks * 16 + hi * 8);
      if (DQK == 96) { const bf16_t* qr = S.Qr + (size_t)(q0 + wid * 32 + r32) * S.qpitch;
#pragma unroll
          for (int ks = 4; ks < NKS; ++ks) qf[ks] = *(const bf16x8*)(qr + (ks - 4) * 16 + hi * 8); } }
    auto dma = [&](int kt, int slot) {
        const int krow = attn_krow(kt, lat0, ctx0);
        LAS unsigned char* sb = lds + slot * SLOT;
        __builtin_amdgcn_global_load_lds((const unsigned*)(S.Kn + (size_t)(krow + lane) * S.kpitch + wid * 8), (LAS unsigned*)(sb + wid * 1024), 16, 0, 0);
        if (DQK == 96 && wid < 4)
            __builtin_amdgcn_global_load_lds((const unsigned*)(S.Kr + (size_t)(krow + lane) * S.krpitch + wid * 8), (LAS unsigned*)(sb + (8 + wid) * 1024), 16, 0, 0);
        __builtin_amdgcn_global_load_lds((const unsigned*)(S.V + (size_t)(krow + 16 * (wid & 3) + (lane >> 2)) * S.vpitch + (wid >> 2) * 32 + (lane & 3) * 8), (LAS unsigned*)(sb + KB + wid * 1024), 16, 0, 0);
    };
    f32x16 oT[2]; f32x16 negm;
#pragma unroll
    for (int r = 0; r < 16; ++r) { oT[0][r] = 0.f; oT[1][r] = 0.f; negm[r] = 0.f; }
    float mrun = 0.f, lrun = 0.f; bool first = true;
    dma(kt0, 0);
    asm volatile("s_waitcnt vmcnt(0)" ::: "memory");
    __syncthreads();
    const int vlane = ((lane >> 4) & 1) * 32 + (lane & 3) * 8 + (4 * hi + ((lane & 15) >> 2)) * 64;
    for (int kt = kt0; kt < kt1; ++kt) {
        const int slot = (kt - kt0) & 1;
        if (kt + 1 < kt1) dma(kt + 1, slot ^ 1);
        const LAS unsigned char* kb = lds + slot * SLOT + hi * 1024 + r32 * 16;
        f32x16 p0 = negm, p1 = negm;
#pragma unroll
        for (int ks = 0; ks < NKS; ++ks) {
            const bf16x8 k0 = *(const LAS bf16x8*)(kb + ks * 2048), k1 = *(const LAS bf16x8*)(kb + ks * 2048 + 512);
            p0 = __builtin_amdgcn_mfma_f32_32x32x16_bf16(k0, qf[ks], p0, 0, 0, 0);
            p1 = __builtin_amdgcn_mfma_f32_32x32x16_bf16(k1, qf[ks], p1, 0, 0, 0);
        }
        float tm = fmaxf(p0[0], p1[0]);
#pragma unroll
        for (int r = 1; r < 16; ++r) tm = fmaxf(tm, fmaxf(p0[r], p1[r]));
        { auto rr = __builtin_amdgcn_permlane32_swap(__float_as_uint(tm), __float_as_uint(tm), false, false); tm = fmaxf(__uint_as_float(rr[0]), __uint_as_float(rr[1])); }
        if (first) {
            mrun = tm;
#pragma unroll
            for (int r = 0; r < 16; ++r) { p0[r] -= tm; p1[r] -= tm; negm[r] = -mrun; }
            first = false;
        } else if (__any(tm > THR)) {
            const float dl = fmaxf(tm, 0.f); mrun += dl; const float al = __builtin_amdgcn_exp2f(-dl); lrun *= al;
#pragma unroll
            for (int r = 0; r < 16; ++r) { p0[r] -= dl; p1[r] -= dl; negm[r] = -mrun; oT[0][r] *= al; oT[1][r] *= al; }
        }
        float rs = 0.f;
#pragma unroll
        for (int r = 0; r < 16; ++r) { p0[r] = __builtin_amdgcn_exp2f(p0[r]); p1[r] = __builtin_amdgcn_exp2f(p1[r]); rs += p0[r] + p1[r]; }
        lrun += rs;
        bf16x8 pf[4];
        { u32x4 w;
          w.x = cvtpk(p0[0], p0[1]); w.y = cvtpk(p0[2], p0[3]); w.z = cvtpk(p0[4], p0[5]); w.w = cvtpk(p0[6], p0[7]); pf[0] = __builtin_bit_cast(bf16x8, w);
          w.x = cvtpk(p0[8], p0[9]); w.y = cvtpk(p0[10], p0[11]); w.z = cvtpk(p0[12], p0[13]); w.w = cvtpk(p0[14], p0[15]); pf[1] = __builtin_bit_cast(bf16x8, w);
          w.x = cvtpk(p1[0], p1[1]); w.y = cvtpk(p1[2], p1[3]); w.z = cvtpk(p1[4], p1[5]); w.w = cvtpk(p1[6], p1[7]); pf[2] = __builtin_bit_cast(bf16x8, w);
          w.x = cvtpk(p1[8], p1[9]); w.y = cvtpk(p1[10], p1[11]); w.z = cvtpk(p1[12], p1[13]); w.w = cvtpk(p1[14], p1[15]); pf[3] = __builtin_bit_cast(bf16x8, w); }
        const LAS unsigned char* vb = lds + slot * SLOT + KB + vlane;
#pragma unroll
        for (int d0 = 0; d0 < 2; ++d0)
#pragma unroll
            for (int ks = 0; ks < 4; ++ks) {
                const s16x4 lo = vtr(vb + d0 * 4096 + ks * 1024), hh = vtr(vb + d0 * 4096 + ks * 1024 + 512);
                const bf16x8 vf = (bf16x8){lo[0], lo[1], lo[2], lo[3], hh[0], hh[1], hh[2], hh[3]};
                oT[d0] = __builtin_amdgcn_mfma_f32_32x32x16_bf16(vf, pf[ks], oT[d0], 0, 0, 0);
            }
        asm volatile("s_waitcnt vmcnt(0)" ::: "memory");
        __syncthreads();
    }
    { auto rr = __builtin_amdgcn_permlane32_swap(__float_as_uint(lrun), __float_as_uint(lrun), false, false); lrun = __uint_as_float(rr[0]) + __uint_as_float(rr[1]); }
    const float inv = 1.0f / lrun;
    bf16_t* orow = S.O + (size_t)(q0 + wid * 32 + r32) * S.opitch;
#pragma unroll
    for (int d0 = 0; d0 < 2; ++d0)
#pragma unroll
        for (int g = 0; g < 4; ++g) { u32x2 w; w.x = cvtpk(oT[d0][4 * g] * inv, oT[d0][4 * g + 1] * inv); w.y = cvtpk(oT[d0][4 * g + 2] * inv, oT[d0][4 * g + 3] * inv);
            *(u32x2*)(orow + 32 * d0 + 8 * g + 4 * hi) = w; }
}

__device__ __forceinline__ int sig5(int c) { return (c & ~12) | ((c & 8) >> 1) | ((c & 4) << 1); }

__global__ void __launch_bounds__(512, 2) mk_fwd(Args args) {
    extern __shared__ __attribute__((aligned(16))) unsigned char lds_raw[];
    Frame F;
    F.lds = (LAS unsigned char*)lds_raw; F.ws = args.ws;
    F.tid = threadIdx.x; F.lane = F.tid & 63; F.wave = __builtin_amdgcn_readfirstlane(F.tid >> 6);
    F.G = gridDim.x; { const int bx = blockIdx.x; F.vcu = (F.G % 8 == 0) ? (bx % 8) * (F.G / 8) + bx / 8 : bx; }
    volatile LAS unsigned* MISC = (volatile LAS unsigned*)(F.lds + LDSCTL_OFF);
    if (F.tid < 64) MISC[F.tid] = 0u;
    __syncthreads();
    unsigned* ctl = wsp<unsigned>(F, O_CTL);
#if MK_ONE_LAUNCH
    XcdBarrier bar = xcd_barrier_post(ctl + CW_BAR, MISC + 8);
#define GRID_BAR() xcd_barrier(bar)
#else
#define GRID_BAR() do {} while (0)
#endif
    const int lo = args.ph_lo, hi_ph = args.ph_hi;
#define IN(k) (lo <= (k) && (k) < hi_ph)
#define SEAM(k) do { if (IN(k) && IN((k) + 1)) GRID_BAR(); } while (0)
    const int lane = F.lane, wave = F.wave, tid = F.tid;
    const int gw = F.vcu * 8 + wave, NGW = F.G * 8;

    const float* x_in = args.in[I_X]; const float* ctx_in = args.in[I_CTX];
    float* MODV = wsp<float>(F, O_MODV);
    float* TAB16 = wsp<float>(F, O_TAB16); float* TAB32 = wsp<float>(F, O_TAB32);
    float* HC = wsp<float>(F, O_HC);
    bf16_t* U = wsp<bf16_t>(F, O_U);
    float* Y = wsp<float>(F, O_Y);
    const float* normg = args.in[I_NORMG];
#define MV(layer, bidx, k) (MODV + ((size_t)((layer) * 5 + (bidx)) * 6 + (k)) * D)

    if (IN(0)) {
        {
            LAS float* sc = (LAS float*)F.lds;
            LAS float* red = sc + 5 * 1024;
            for (int i = tid; i < 5 * 1024; i += 512) { const int b = i >> 10, k = i & 1023; const float cv = (b < 4) ? args.in[I_C][b * 1024 + k] : args.in[I_CCTX][k]; sc[i] = cv / (1.0f + __expf(-cv)); }
            __syncthreads();
            for (int unit = F.vcu; unit < 192; unit += F.G) {
                const int layer = unit / 96, cb = unit % 96, col = cb * 64 + lane;
                const float* W = args.in[I_MODW] + (size_t)layer * D * 6144 + col;
                float a0 = 0.f, a1 = 0.f, a2 = 0.f, a3 = 0.f, a4 = 0.f;
#pragma unroll 16
                for (int kk = 0; kk < 128; ++kk) { const int k = wave * 128 + kk; const float w = W[(size_t)k * 6144];
                    a0 += sc[k] * w; a1 += sc[1024 + k] * w; a2 += sc[2048 + k] * w; a3 += sc[3072 + k] * w; a4 += sc[4096 + k] * w; }
                red[(wave * 5 + 0) * 64 + lane] = a0; red[(wave * 5 + 1) * 64 + lane] = a1; red[(wave * 5 + 2) * 64 + lane] = a2; red[(wave * 5 + 3) * 64 + lane] = a3; red[(wave * 5 + 4) * 64 + lane] = a4;
                __syncthreads();
                if (tid < 320) { const int b = tid >> 6, cc = tid & 63; float s = 0.f;
#pragma unroll
                    for (int w = 0; w < 8; ++w) s += red[(w * 5 + b) * 64 + cc];
                    MODV[(size_t)(layer * 5 + b) * 6144 + cb * 64 + cc] = s + args.in[I_MODB][layer * 6144 + cb * 64 + cc]; }
                __syncthreads();
            }
        }
        if (blockIdx.x == 0) {
            for (int i = tid; i < 64 * 8; i += 512) { const int pos = i >> 3, f = i & 7; const float fr = powf(10000.0f, -(float)f / 8.0f), a = (float)pos * fr; TAB16[i] = cosf(a); TAB16[512 + i] = sinf(a); }
            for (int i = tid; i < 64 * 16; i += 512) { const int pos = i >> 4, f = i & 15; const float fr = powf(10000.0f, -(float)f / 16.0f), a = (float)pos * fr; TAB32[i] = cosf(a); TAB32[1024 + i] = sinf(a); }
        }
        {
            LAS float* scr = (LAS float*)(F.lds + wave * 16384);
            auto run = [&](const Conv& c, int& base) { const int n = (c.K / 64) * (c.Ndst / 32); for (int it = gw - base; it < n; it += NGW) { if (it >= 0) conv_item(c, it, scr, lane); }
                base = (base + n) % NGW; };
            int base = 0;
            Conv c;
            c = Conv{args.in[I_AWIN], nullptr, 1440, 1024, N_IN0, wsp<bf16_t>(F, O_WIN0), 1, nullptr}; run(c, base);
            c = Conv{args.in[I_AWUQ], nullptr, 768, 384, N_QA, wsp<bf16_t>(F, O_WUQ), 2, args.in[I_AQN]}; run(c, base);
            c = Conv{args.in[I_AWUKV], nullptr, 1024, 256, N_KVA, wsp<bf16_t>(F, O_WUKV), 0, args.in[I_AKVN]}; run(c, base);
            c = Conv{args.in[I_AWOUT], nullptr, 1024, 1024, 1024, wsp<bf16_t>(F, O_WOUT0), 0, nullptr}; run(c, base);
            c = Conv{args.in[I_FWG], args.in[I_FWU], FFN, 1024, N_GU0, wsp<bf16_t>(F, O_WGU0), 3, nullptr}; run(c, base);
            c = Conv{args.in[I_FWD], nullptr, 1024, FFN, 1024, wsp<bf16_t>(F, O_WD0), 0, nullptr}; run(c, base);
            c = Conv{args.in[I_GWIN], nullptr, 3104, 1024, N_IN1, wsp<bf16_t>(F, O_WIN1), 4, nullptr}; run(c, base);
            c = Conv{args.in[I_GWOUT], nullptr, 1024, 1024, 1024, wsp<bf16_t>(F, O_WOUT1), 0, nullptr}; run(c, base);
            for (int e = 0; e < NEXP; ++e) {
                c = Conv{args.in[I_MWG] + (size_t)e * D * EXD, args.in[I_MWU] + (size_t)e * D * EXD, EXD, 1024, N_GU1, wsp<bf16_t>(F, O_WGU1) + (size_t)e * N_GU1 * 1024, 3, nullptr}; run(c, base);
                c = Conv{args.in[I_MWD] + (size_t)e * EXD * D, nullptr, 1024, EXD, 1024, wsp<bf16_t>(F, O_WD1) + (size_t)e * 1024 * EXD, 0, nullptr}; run(c, base);
            }
        }
    }
    SEAM(0);

    if (IN(1)) {
        for (int row = gw; row < R; row += NGW) {
            const float* hp = row < RL ? x_in + (size_t)row * D : ctx_in + (size_t)(row - RL) * D;
            f32x4 h[4], uo[4]; load_row(hp, lane, h);
            const int b = row_bidx(row);
            norm_mod_store(h, normg + 0 * D, MV(0, b, 0), MV(0, b, 1), U + (size_t)row * D, lane, uo);
        }
    }
    SEAM(1);

    if (IN(2)) {
        pg8::DenseProb P{U, wsp<bf16_t>(F, O_WIN0), 1024, 1024, 1024, {}}; P.ord.init(R / 256, N_IN0 / 256, F.G, (int)blockIdx.x);
        pg8::EpiBf16 E{wsp<bf16_t>(F, O_Z0), N_IN0, nullptr};
        pg8::gemm_phase(F.lds, P, E);
    }
    SEAM(2);

    if (IN(3)) {
        const bf16_t* Z0 = wsp<bf16_t>(F, O_Z0);
        float* RSQ = wsp<float>(F, O_RSTDQ); float* RSKV = wsp<float>(F, O_RSTDKV);
        bf16_t* QB = wsp<bf16_t>(F, O_QB); bf16_t* KBp = wsp<bf16_t>(F, O_KB); bf16_t* KR = wsp<bf16_t>(F, O_KR);
        const float* qkn = args.in[I_AQKN];
        for (int row = gw; row < R; row += NGW) {
            const unsigned* z32 = (const unsigned*)(Z0 + (size_t)row * N_IN0);
            float s = 0.f;
#pragma unroll
            for (int j = 0; j < 3; ++j) { const unsigned w = z32[lane + 64 * j]; const float a = bflo(w), b = bfhi(w); s += a * a + b * b; }
            s = wave_sum(s);
            float s2 = 0.f;
#pragma unroll
            for (int j = 0; j < 2; ++j) { const unsigned w = z32[192 + lane + 64 * j]; const float a = bflo(w), b = bfhi(w); s2 += a * a + b * b; }
            s2 = wave_sum(s2);
            if (lane == 0) { RSQ[row] = __builtin_amdgcn_rsqf(s * (1.0f / 384.0f) + EPS); RSKV[row] = __builtin_amdgcn_rsqf(s2 * (1.0f / 256.0f) + EPS); }
            const bool lat = row < RL; const int tt = row & (SEQ - 1);
#pragma unroll
            for (int which = 0; which < 2; ++which) {
                if (which == 1 && lane >= 16) break;
                const u32x4 w4 = *(const u32x4*)(Z0 + (size_t)row * N_IN0 + (which ? 1152 : 640) + lane * 8);
                float v[8] = {bflo(w4.x), bfhi(w4.x), bflo(w4.y), bfhi(w4.y), bflo(w4.z), bfhi(w4.z), bflo(w4.w), bfhi(w4.w)};
                float ss = 0.f;
#pragma unroll
                for (int j = 0; j < 8; ++j) ss += v[j] * v[j];
                ss += __shfl_xor(ss, 1); ss += __shfl_xor(ss, 2); ss += __shfl_xor(ss, 4);
                const float rstd = __builtin_amdgcn_rsqf(ss * (1.0f / 64.0f) + EPS);
                const int jp = lane & 7, half = jp >> 2, i0 = 4 * (jp & 3);
                const float* gn = qkn + which * 64 + half * 32;
#pragma unroll
                for (int pz = 0; pz < 4; ++pz) { v[2 * pz] *= rstd * gn[i0 + pz]; v[2 * pz + 1] *= rstd * gn[16 + i0 + pz]; }
                if (lat) { const int pos = half ? (tt & 63) : (tt >> 6);
                    const f32x4 cs = *(const f32x4*)(TAB32 + pos * 16 + i0), sn = *(const f32x4*)(TAB32 + 1024 + pos * 16 + i0);
#pragma unroll
                    for (int pz = 0; pz < 4; ++pz) { const float a = v[2 * pz], b = v[2 * pz + 1]; v[2 * pz] = a * cs[pz] - b * sn[pz]; v[2 * pz + 1] = b * cs[pz] + a * sn[pz]; } }
                const float osc = which ? 1.0f : 0.125f * LOG2E;
                u32x4 o; o.x = cvtpk(v[0] * osc, v[1] * osc); o.y = cvtpk(v[2] * osc, v[3] * osc); o.z = cvtpk(v[4] * osc, v[5] * osc); o.w = cvtpk(v[6] * osc, v[7] * osc);
                if (which == 0) *(u32x4*)(QB + (size_t)row * 512 + lane * 8) = o; else *(u32x4*)(KBp + (size_t)row * 128 + lane * 8) = o;
            }
            if (lane < 4) {
                const u32x4 w4 = *(const u32x4*)(Z0 + (size_t)row * N_IN0 + 1408 + lane * 8);
                float v[8] = {bflo(w4.x), bfhi(w4.x), bflo(w4.y), bfhi(w4.y), bflo(w4.z), bfhi(w4.z), bflo(w4.w), bfhi(w4.w)};
                if (lat) { const int half = lane >> 1, i0 = 4 * (lane & 1); const int pos = half ? (tt & 63) : (tt >> 6);
                    const f32x4 cs = *(const f32x4*)(TAB16 + pos * 8 + i0), sn = *(const f32x4*)(TAB16 + 512 + pos * 8 + i0);
#pragma unroll
                    for (int pz = 0; pz < 4; ++pz) { const float a = v[2 * pz], b = v[2 * pz + 1]; v[2 * pz] = a * cs[pz] - b * sn[pz]; v[2 * pz + 1] = b * cs[pz] + a * sn[pz]; } }
                u32x4 o; o.x = cvtpk(v[0], v[1]); o.y = cvtpk(v[2], v[3]); o.z = cvtpk(v[4], v[5]); o.w = cvtpk(v[6], v[7]);
                *(u32x4*)(KR + (size_t)row * 32 + lane * 8) = o;
            }
        }
    }
    SEAM(3);

    if (IN(4)) {
        { pg8::DenseProb P{wsp<bf16_t>(F, O_Z0), wsp<bf16_t>(F, O_WUQ), 384, N_IN0, 384, {}}; P.ord.init(R / 256, N_QA / 256, F.G, (int)blockIdx.x);
          pg8::EpiQA E{wsp<bf16_t>(F, O_QA), wsp<float>(F, O_RSTDQ), TAB16, 0.10206207261596577f * LOG2E};
          pg8::gemm_phase(F.lds, P, E); }
        { pg8::DenseProb P{wsp<bf16_t>(F, O_Z0) + 384, wsp<bf16_t>(F, O_WUKV), 256, N_IN0, 256, {}}; P.ord.init(R / 256, N_KVA / 256, F.G, (int)((blockIdx.x + F.G - (204 % F.G)) % F.G));
          pg8::EpiBf16 E{wsp<bf16_t>(F, O_KVA), N_KVA, wsp<float>(F, O_RSTDKV)};
          pg8::gemm_phase(F.lds, P, E); }
    }
    SEAM(4);

    if (IN(5)) {
        const bf16_t* QA = wsp<bf16_t>(F, O_QA); const bf16_t* KVA = wsp<bf16_t>(F, O_KVA); const bf16_t* QB = wsp<bf16_t>(F, O_QB);
        const bf16_t* KBp = wsp<bf16_t>(F, O_KB); const bf16_t* KR = wsp<bf16_t>(F, O_KR); const bf16_t* Z0 = wsp<bf16_t>(F, O_Z0);
        bf16_t* AO = wsp<bf16_t>(F, O_AO);
        for (int i = 0; i < 5; ++i) {
            int typ, b, hh, q0, kt0, kt1;
            if (i < 4) { const int m = (i & 1) * 256 + F.vcu; if (F.vcu >= 256) break; typ = i >> 1; b = m >> 7; hh = (m >> 4) & 7; q0 = b * SEQ + (m & 15) * 256; kt0 = 0; kt1 = 68; }
            else { if (F.vcu >= 64) break; typ = F.vcu >> 5; b = (F.vcu >> 3) & 3; hh = F.vcu & 7; q0 = RL + b * CTX; kt0 = 64; kt1 = 68; }
            const int lat0 = b * SEQ, ctx0 = RL + b * CTX;
            if (typ == 0) { AttnSrc<96> S{QA + hh * 64, N_QA, QA + 512 + hh * 32, KVA + hh * 128, N_KVA, KR, 32, KVA + hh * 128 + 64, N_KVA, AO + hh * 64, D};
                attn_unit<96>(F, S, q0, lat0, ctx0, kt0, kt1); }
            else { const int kvh = hh >> 2; AttnSrc<64> S{QB + hh * 64, 512, nullptr, KBp + kvh * 64, 128, nullptr, 0, Z0 + 1280 + kvh * 64, N_IN0, AO + 512 + hh * 64, D};
                attn_unit<64>(F, S, q0, lat0, ctx0, kt0, kt1); }
        }
    }
    SEAM(5);

    if (IN(6)) {
        pg8::DenseProb P{wsp<bf16_t>(F, O_AO), wsp<bf16_t>(F, O_WOUT0), 1024, 1024, 1024, {}}; P.ord.init(R / 256, 4, F.G, (int)blockIdx.x);
        pg8::EpiF32 E{Y, D};
        pg8::gemm_phase(F.lds, P, E);
    }
    SEAM(6);

    if (IN(7)) {
        for (int row = gw; row < R; row += NGW) {
            const float* hp = row < RL ? x_in + (size_t)row * D : ctx_in + (size_t)(row - RL) * D;
            float* ho = row < RL ? args.out + (size_t)row * D : HC + (size_t)(row - RL) * D;
            const int b = row_bidx(row);
            f32x4 y[4], h[4], uo[4]; load_row(Y + (size_t)row * D, lane, y); load_row(hp, lane, h);
            const float rstd = __builtin_amdgcn_rsqf(row_ssq(y) * (1.0f / D) + EPS);
#pragma unroll
            for (int j = 0; j < 4; ++j) { const int c = 4 * lane + 256 * j; const f32x4 g = *(const f32x4*)(normg + 1 * D + c), mg = *(const f32x4*)(MV(0, b, 2) + c);
                h[j] = h[j] + mg * (y[j] * rstd * g); *(f32x4*)(ho + c) = h[j]; }
            norm_mod_store(h, normg + 2 * D, MV(0, b, 3), MV(0, b, 4), U + (size_t)row * D, lane, uo);
        }
    }
    SEAM(7);

    if (IN(8)) {
        pg8::DenseProb P{U, wsp<bf16_t>(F, O_WGU0), 1024, 1024, 1024, {}}; P.ord.init(R / 256, N_GU0 / 256, F.G, (int)blockIdx.x);
        pg8::EpiSwiglu E{wsp<bf16_t>(F, O_H0), FFN};
        pg8::gemm_phase(F.lds, P, E);
    }
    SEAM(8);
    if (IN(9)) {
        pg8::DenseProb P{wsp<bf16_t>(F, O_H0), wsp<bf16_t>(F, O_WD0), FFN, FFN, FFN, {}}; P.ord.init(R / 256, 4, F.G, (int)blockIdx.x);
        pg8::EpiF32 E{Y, D};
        pg8::gemm_phase(F.lds, P, E);
    }
    SEAM(9);

    if (IN(10)) {
        for (int row = gw; row < R; row += NGW) {
            float* hp = row < RL ? args.out + (size_t)row * D : HC + (size_t)(row - RL) * D;
            const int b = row_bidx(row);
            f32x4 y[4], h[4], uo[4]; load_row(Y + (size_t)row * D, lane, y); load_row(hp, lane, h);
            const float rstd = __builtin_amdgcn_rsqf(row_ssq(y) * (1.0f / D) + EPS);
#pragma unroll
            for (int j = 0; j < 4; ++j) { const int c = 4 * lane + 256 * j; const f32x4 g = *(const f32x4*)(normg + 3 * D + c), mg = *(const f32x4*)(MV(0, b, 5) + c);
                h[j] = h[j] + mg * (y[j] * rstd * g); *(f32x4*)(hp + c) = h[j]; }
            norm_mod_store(h, normg + 4 * D, MV(1, b, 0), MV(1, b, 1), U + (size_t)row * D, lane, uo);
        }
    }
    SEAM(10);

    if (IN(11)) {
        pg8::DenseProb P{U, wsp<bf16_t>(F, O_WIN1), 1024, 1024, 1024, {}}; P.ord.init(R / 256, N_IN1 / 256, F.G, (int)blockIdx.x);
        pg8::EpiIn1 E{wsp<bf16_t>(F, O_QK1), wsp<bf16_t>(F, O_V1), wsp<bf16_t>(F, O_G1), wsp<bf16_t>(F, O_RR)};
        pg8::gemm_phase(F.lds, P, E);
    }
    SEAM(11);

    if (IN(12)) {
        const bf16_t* QK1 = wsp<bf16_t>(F, O_QK1); const bf16_t* V1 = wsp<bf16_t>(F, O_V1); const bf16_t* RRp = wsp<bf16_t>(F, O_RR);
        bf16_t* QDd[2] = {wsp<bf16_t>(F, O_QDF), wsp<bf16_t>(F, O_QDB)}; bf16_t* KId[2] = {wsp<bf16_t>(F, O_KIF), wsp<bf16_t>(F, O_KIB)}; bf16_t* KTd[2] = {wsp<bf16_t>(F, O_KTF), wsp<bf16_t>(F, O_KTB)};
        bf16_t* VT = wsp<bf16_t>(F, O_VT); float* ECL = wsp<float>(F, O_ECL);
        LAS float* tot = (LAS float*)F.lds;
        const int dk = tid & 127, tq = tid >> 7;
        for (int item = F.vcu; item < 544 * 4; item += F.G) {
            const int rc = item >> 2, hh = item & 3, row0 = rc * 32;
            float w2[2][16], bg[2];
#pragma unroll
            for (int d = 0; d < 2; ++d) { bg[d] = args.in[I_GBGATE][d * 512 + hh * 128 + dk];
#pragma unroll
                for (int j = 0; j < 16; ++j) w2[d][j] = args.in[I_GGATE2][(size_t)(d * 16 + j) * 512 + hh * 128 + dk]; }
            float a[2][8];
#pragma unroll
            for (int i = 0; i < 8; ++i) { const int row = row0 + 8 * tq + i;
                const u32x4* rp = (const u32x4*)(RRp + (size_t)row * 256);
#pragma unroll
                for (int d = 0; d < 2; ++d) { const u32x4 r0 = rp[2 * d], r1 = rp[2 * d + 1];
                    const float rv[16] = {bflo(r0.x), bfhi(r0.x), bflo(r0.y), bfhi(r0.y), bflo(r0.z), bfhi(r0.z), bflo(r0.w), bfhi(r0.w), bflo(r1.x), bfhi(r1.x), bflo(r1.y), bfhi(r1.y), bflo(r1.z), bfhi(r1.z), bflo(r1.w), bfhi(r1.w)};
                    float z = bg[d];
#pragma unroll
                    for (int j = 0; j < 16; ++j) z += rv[j] * w2[d][j];
                    a[d][i] = (fminf(z, 0.f) - __logf(1.0f + __expf(-fabsf(z)))) * (1.0f / 16.0f); } }
            float cf[8], sb[8];
            { float s = 0.f;
#pragma unroll
              for (int i = 0; i < 8; ++i) { s += a[0][i]; cf[i] = s; }
              s = 0.f;
#pragma unroll
              for (int i = 7; i >= 0; --i) { s += a[1][i]; sb[i] = s; } }
            tot[(0 * 4 + tq) * 128 + dk] = cf[7]; tot[(1 * 4 + tq) * 128 + dk] = sb[0];
            __syncthreads();
            float offF = 0.f, offB = 0.f, clF = 0.f, clB = 0.f;
#pragma unroll
            for (int g = 0; g < 4; ++g) { const float tf = tot[(0 * 4 + g) * 128 + dk], tb = tot[(1 * 4 + g) * 128 + dk]; clF += tf; clB += tb; if (g < tq) offF += tf; if (g > tq) offB += tb; }
            __syncthreads();
            const int pc = hh * 128 + (dk & ~31) + sig5(dk & 31);
            unsigned ktw[2][4];
#pragma unroll
            for (int i = 0; i < 8; ++i) { const int row = row0 + 8 * tq + i;
                const float q = bf2f(QK1[(size_t)row * D + hh * 128 + dk]), k = bf2f(QK1[(size_t)row * D + 512 + hh * 128 + dk]);
                const float cF = offF + cf[i], cB = offB + sb[i];
                const float kiF = k * __expf(-cF), kiB = k * __expf(-cB);
                QDd[0][(size_t)row * 512 + pc] = f2bf(q * __expf(cF)); KId[0][(size_t)row * 512 + pc] = f2bf(kiF);
                QDd[1][(size_t)row * 512 + pc] = f2bf(q * __expf(cB)); KId[1][(size_t)row * 512 + pc] = f2bf(kiB);
                const unsigned bF = f2bf(kiF), bB = f2bf(kiB);
                if (i & 1) { ktw[0][i >> 1] |= bF << 16; ktw[1][i >> 1] |= bB << 16; } else { ktw[0][i >> 1] = bF; ktw[1][i >> 1] = bB; } }
#pragma unroll
            for (int d = 0; d < 2; ++d) { bf16_t* kt = KTd[d] + ((size_t)(rc * 4 + hh) * 128 + dk) * 32 + 16 * (tq >> 1) + 4 * (tq & 1);
                u32x2 w0; w0.x = ktw[d][0]; w0.y = ktw[d][1]; *(u32x2*)kt = w0; u32x2 w1; w1.x = ktw[d][2]; w1.y = ktw[d][3]; *(u32x2*)(kt + 8) = w1; }
            if (tq == 0) { ECL[((size_t)(rc * 2 + 0) * 4 + hh) * 256 + dk] = __expf(clF); ECL[((size_t)(rc * 2 + 1) * 4 + hh) * 256 + dk] = __expf(clB); }
            { const int dv = tid & 255, th = tid >> 8; unsigned vw[8];
#pragma unroll
              for (int i = 0; i < 16; ++i) { const unsigned bv = V1[(size_t)(row0 + 16 * th + i) * D + hh * 256 + dv];
                  const int cc = sig5(i);
                  if (cc & 1) vw[cc >> 1] |= bv << 16; else vw[cc >> 1] = bv; }
              bf16_t* vp = VT + ((size_t)rc * 1024 + hh * 256 + dv) * 32 + 16 * th;
              u32x4 o0; o0.x = vw[0]; o0.y = vw[1]; o0.z = vw[2]; o0.w = vw[3]; *(u32x4*)vp = o0;
              u32x4 o1; o1.x = vw[4]; o1.y = vw[5]; o1.z = vw[6]; o1.w = vw[7]; *(u32x4*)(vp + 8) = o1; }
        }
    }
    SEAM(12);

    if (IN(13)) {
        const bf16_t* VT = wsp<bf16_t>(F, O_VT); const float* ECL = wsp<float>(F, O_ECL);
        constexpr int SLOT = 8192 * 3 + 2048 + 1024;
        const int r32 = lane & 31, hi = lane >> 5;
        for (int unit = F.vcu; unit < 256; unit += F.G) {
            const int chain = unit >> 3, dvb = unit & 7, b = chain >> 3, hh = (chain >> 1) & 3, dir = chain & 1;
            const bf16_t* QDp = wsp<bf16_t>(F, dir ? O_QDB : O_QDF); const bf16_t* KIp = wsp<bf16_t>(F, dir ? O_KIB : O_KIF); const bf16_t* KTp = wsp<bf16_t>(F, dir ? O_KTB : O_KTF);
            bf16_t* Odp = wsp<bf16_t>(F, dir ? O_OB : O_OF);
            auto rcof = [&](int step) { return step < 8 ? 512 + b * 8 + (dir ? 7 - step : step) : b * 128 + (dir ? 127 - (step - 8) : (step - 8)); };
            auto dma = [&](int step, int slot) {
                const int rc = rcof(step); LAS unsigned char* sb = F.lds + slot * SLOT;
                const int ch = lane >> 5, rw = lane & 31;
                __builtin_amdgcn_global_load_lds((const unsigned*)(KIp + (size_t)(rc * 32 + rw) * 512 + hh * 128 + (2 * wave + ch) * 8), (LAS unsigned*)(sb + wave * 1024), 16, 0, 0);
                __builtin_amdgcn_global_load_lds((const unsigned*)(QDp + (size_t)(rc * 32 + rw) * 512 + hh * 128 + (2 * wave + ch) * 8), (LAS unsigned*)(sb + 8192 + wave * 1024), 16, 0, 0);
                __builtin_amdgcn_global_load_lds((const unsigned*)(KTp + ((size_t)(rc * 4 + hh) * 128 + 32 * (wave >> 1) + rw) * 32 + (2 * (wave & 1) + ch) * 8), (LAS unsigned*)(sb + 16384 + wave * 1024), 16, 0, 0);
                if (wave < 2) __builtin_amdgcn_global_load_lds((const unsigned*)(VT + ((size_t)rc * 1024 + hh * 256 + dvb * 32 + rw) * 32 + (2 * wave + ch) * 8), (LAS unsigned*)(sb + 24576 + wave * 1024), 16, 0, 0);
                if (wave == 2) __builtin_amdgcn_global_load_lds((const unsigned*)(ECL + ((size_t)(rc * 2 + dir) * 4 + hh) * 256 + lane * 4), (LAS unsigned*)(sb + 26624), 16, 0, 0);
            };
            f32x16 S4[4];
#pragma unroll
            for (int k = 0; k < 4; ++k)
#pragma unroll
                for (int r = 0; r < 16; ++r) S4[k][r] = 0.f;
            dma(0, 0);
            asm volatile("s_waitcnt vmcnt(0)" ::: "memory");
            __syncthreads();
            for (int step = 0; step < 136; ++step) {
                const int slot = step & 1;
                if (step + 1 < 136) dma(step + 1, slot ^ 1);
                if (wave == 0) {
                    const LAS unsigned char* sb = F.lds + slot * SLOT;
                    const int fo = hi * 512 + r32 * 16;
                    bf16x8 qdF[8];
#pragma unroll
                    for (int k = 0; k < 8; ++k) qdF[k] = *(const LAS bf16x8*)(sb + 8192 + k * 1024 + fo);
                    const bf16x8 vF0 = *(const LAS bf16x8*)(sb + 24576 + fo), vF1 = *(const LAS bf16x8*)(sb + 24576 + 1024 + fo);
                    f32x16 o;
#pragma unroll
                    for (int r = 0; r < 16; ++r) o[r] = 0.f;
                    if (step >= 8) {
                        f32x16 sc;
#pragma unroll
                        for (int r = 0; r < 16; ++r) sc[r] = 0.f;
#pragma unroll
                        for (int k = 0; k < 8; ++k) { const bf16x8 kiF = *(const LAS bf16x8*)(sb + k * 1024 + fo); sc = __builtin_amdgcn_mfma_f32_32x32x16_bf16(kiF, qdF[k], sc, 0, 0, 0); }
#pragma unroll
                        for (int r = 0; r < 16; ++r) { const int s = (r & 3) + 8 * (r >> 2) + 4 * hi; const bool keep = dir ? (s >= r32) : (s <= r32); sc[r] = keep ? sc[r] : 0.f; }
                        u32x4 w; bf16x8 pf0, pf1;
                        w.x = cvtpk(sc[0], sc[1]); w.y = cvtpk(sc[2], sc[3]); w.z = cvtpk(sc[4], sc[5]); w.w = cvtpk(sc[6], sc[7]); pf0 = __builtin_bit_cast(bf16x8, w);
                        w.x = cvtpk(sc[8], sc[9]); w.y = cvtpk(sc[10], sc[11]); w.z = cvtpk(sc[12], sc[13]); w.w = cvtpk(sc[14], sc[15]); pf1 = __builtin_bit_cast(bf16x8, w);
                        o = __builtin_amdgcn_mfma_f32_32x32x16_bf16(pf0, vF0, o, 0, 0, 0);
                        o = __builtin_amdgcn_mfma_f32_32x32x16_bf16(pf1, vF1, o, 0, 0, 0);
#pragma unroll
                        for (int blk = 0; blk < 4; ++blk)
#pragma unroll
                            for (int s2 = 0; s2 < 2; ++s2) { u32x4 ws4; ws4.x = cvtpk(S4[blk][8 * s2], S4[blk][8 * s2 + 1]); ws4.y = cvtpk(S4[blk][8 * s2 + 2], S4[blk][8 * s2 + 3]);
                                ws4.z = cvtpk(S4[blk][8 * s2 + 4], S4[blk][8 * s2 + 5]); ws4.w = cvtpk(S4[blk][8 * s2 + 6], S4[blk][8 * s2 + 7]);
                                o = __builtin_amdgcn_mfma_f32_32x32x16_bf16(qdF[2 * blk + s2], __builtin_bit_cast(bf16x8, ws4), o, 0, 0, 0); }
                        const int rc = rcof(step);
                        bf16_t* op = Odp + (size_t)(rc * 32) * D + hh * 256 + dvb * 32 + r32;
#pragma unroll
                        for (int r = 0; r < 16; ++r) { const int t = (r & 3) + 8 * (r >> 2) + 4 * hi; op[(size_t)t * D] = f2bf(o[r]); }
                    }
#pragma unroll
                    for (int blk = 0; blk < 4; ++blk) {
                        const bf16x8 kt0 = *(const LAS bf16x8*)(sb + 16384 + blk * 2048 + fo), kt1 = *(const LAS bf16x8*)(sb + 16384 + blk * 2048 + 1024 + fo);
                        S4[blk] = __builtin_amdgcn_mfma_f32_32x32x16_bf16(kt0, vF0, S4[blk], 0, 0, 0);
                        S4[blk] = __builtin_amdgcn_mfma_f32_32x32x16_bf16(kt1, vF1, S4[blk], 0, 0, 0);
#pragma unroll
                        for (int g = 0; g < 4; ++g) { const f32x4 e4 = *(const LAS f32x4*)(sb + 26624 + (32 * blk + 8 * g + 4 * hi) * 4);
                            S4[blk][4 * g] *= e4[0]; S4[blk][4 * g + 1] *= e4[1]; S4[blk][4 * g + 2] *= e4[2]; S4[blk][4 * g + 3] *= e4[3]; }
                    }
                }
                asm volatile("s_waitcnt vmcnt(0)" ::: "memory");
                __syncthreads();
            }
        }
    }
    SEAM(13);

    if (IN(14)) {
        const bf16_t* OFp = wsp<bf16_t>(F, O_OF); const bf16_t* OBp = wsp<bf16_t>(F, O_OB); const bf16_t* G1 = wsp<bf16_t>(F, O_G1); bf16_t* GA = wsp<bf16_t>(F, O_GA);
        const float* on = args.in[I_GONORM];
        for (int row = gw; row < RL; row += NGW) {
            const u32x4* pf = (const u32x4*)(OFp + (size_t)row * D + lane * 16); const u32x4* pb = (const u32x4*)(OBp + (size_t)row * D + lane * 16); const u32x4* pg = (const u32x4*)(G1 + (size_t)row * D + lane * 16);
            float v[16], gv[16];
#pragma unroll
            for (int q = 0; q < 2; ++q) { const u32x4 a = pf[q], bq = pb[q], gq = pg[q]; const unsigned aw[4] = {a.x, a.y, a.z, a.w}, bw[4] = {bq.x, bq.y, bq.z, bq.w}, gw4[4] = {gq.x, gq.y, gq.z, gq.w};
#pragma unroll
                for (int j = 0; j < 4; ++j) { v[8 * q + 2 * j] = bflo(aw[j]) + bflo(bw[j]); v[8 * q + 2 * j + 1] = bfhi(aw[j]) + bfhi(bw[j]); gv[8 * q + 2 * j] = bflo(gw4[j]); gv[8 * q + 2 * j + 1] = bfhi(gw4[j]); } }
            float ss = 0.f;
#pragma unroll
            for (int j = 0; j < 16; ++j) ss += v[j] * v[j];
            ss += __shfl_xor(ss, 1); ss += __shfl_xor(ss, 2); ss += __shfl_xor(ss, 4); ss += __shfl_xor(ss, 8);
            const float rstd = __builtin_amdgcn_rsqf(ss * (1.0f / 256.0f) + EPS);
            const int c0 = (lane & 15) * 16;
            unsigned ow[8];
#pragma unroll
            for (int j = 0; j < 8; ++j) { const float a = v[2 * j] * rstd * on[c0 + 2 * j] * silu_f(gv[2 * j]), bq = v[2 * j + 1] * rstd * on[c0 + 2 * j + 1] * silu_f(gv[2 * j + 1]); ow[j] = cvtpk(a, bq); }
            u32x4* po = (u32x4*)(GA + (size_t)row * D + lane * 16);
            u32x4 o0; o0.x = ow[0]; o0.y = ow[1]; o0.z = ow[2]; o0.w = ow[3]; po[0] = o0; u32x4 o1; o1.x = ow[4]; o1.y = ow[5]; o1.z = ow[6]; o1.w = ow[7]; po[1] = o1;
        }
    }
    SEAM(14);

    if (IN(15)) {
        pg8::DenseProb P{wsp<bf16_t>(F, O_GA), wsp<bf16_t>(F, O_WOUT1), 1024, 1024, 1024, {}}; P.ord.init(RL / 256, 4, F.G, (int)blockIdx.x);
        pg8::EpiF32 E{Y, D};
        pg8::gemm_phase(F.lds, P, E);
    }
    SEAM(15);

    if (IN(16)) {
        int* SEL = wsp<int>(F, O_SEL); int* ROWTOK = wsp<int>(F, O_ROWTOK);
        LAS float* wr_l = (LAS float*)F.lds;
        LAS int* se = (LAS int*)(F.lds + 32768);
        LAS float* sw = (LAS float*)(F.lds + 32768 + 512);
        LAS int* sbase = (LAS int*)(F.lds + 32768 + 1024);
        for (int i = tid; i < 8192; i += 512) wr_l[i] = args.in[I_MROUTER][i];
        __syncthreads();
        for (int tile = F.vcu; tile < RL / 64; tile += F.G) {
            for (int rr = 0; rr < 8; ++rr) {
                const int lr = wave * 8 + rr, row = tile * 64 + lr; const int b = row >> 12;
                float* hp = args.out + (size_t)row * D;
                f32x4 y[4], h[4], uo[4]; load_row(Y + (size_t)row * D, lane, y); load_row(hp, lane, h);
                const float rstd = __builtin_amdgcn_rsqf(row_ssq(y) * (1.0f / D) + EPS);
#pragma unroll
                for (int j = 0; j < 4; ++j) { const int c = 4 * lane + 256 * j; const f32x4 g = *(const f32x4*)(normg + 5 * D + c), mg = *(const f32x4*)(MV(1, b, 2) + c);
                    h[j] = h[j] + mg * (y[j] * rstd * g); *(f32x4*)(hp + c) = h[j]; }
                norm_mod_store(h, normg + 6 * D, MV(1, b, 3), MV(1, b, 4), U + (size_t)row * D, lane, uo);
                float lg[8];
#pragma unroll
                for (int e = 0; e < 8; ++e) lg[e] = 0.f;
#pragma unroll
                for (int j = 0; j < 4; ++j)
#pragma unroll
                    for (int q = 0; q < 4; ++q) { const int k = 4 * lane + 256 * j + q; const LAS f32x4* wp = (const LAS f32x4*)(wr_l + k * 8); const f32x4 w0 = wp[0], w1 = wp[1]; const float uv = uo[j][q];
                        lg[0] += uv * w0[0]; lg[1] += uv * w0[1]; lg[2] += uv * w0[2]; lg[3] += uv * w0[3]; lg[4] += uv * w1[0]; lg[5] += uv * w1[1]; lg[6] += uv * w1[2]; lg[7] += uv * w1[3]; }
#pragma unroll
                for (int e = 0; e < 8; ++e) lg[e] = wave_sum(lg[e]) + args.in[I_MBROUTER][e];
                int e0 = 0; float l0 = lg[0];
#pragma unroll
                for (int e = 1; e < 8; ++e) if (lg[e] > l0) { l0 = lg[e]; e0 = e; }
                int e1 = -1; float l1 = -3.0e38f;
#pragma unroll
                for (int e = 0; e < 8; ++e) if (e != e0 && lg[e] > l1) { l1 = lg[e]; e1 = e; }
                const float p1 = __expf(l1 - l0), w0n = 1.0f / (1.0f + p1), w1n = p1 / (1.0f + p1);
                if (lane == 0) { se[lr * 2] = e0; se[lr * 2 + 1] = e1; sw[lr * 2] = w0n; sw[lr * 2 + 1] = w1n; }
            }
            __syncthreads();
            if (tid < 8) { int c = 0; for (int r2 = 0; r2 < 64; ++r2) c += (se[2 * r2] == tid) + (se[2 * r2 + 1] == tid);
                sbase[tid] = (int)__hip_atomic_fetch_add(ctl + CW_CNT + 64 * tid, (unsigned)c, RLX_AGENT); }
            __syncthreads();
            if (tid < 64) { const int e0 = se[2 * tid], e1 = se[2 * tid + 1]; int r0 = 0, r1 = 0;
                for (int r2 = 0; r2 < tid; ++r2) { const int a0 = se[2 * r2], a1 = se[2 * r2 + 1]; r0 += (a0 == e0) + (a1 == e0); r1 += (a0 == e1) + (a1 == e1); }
                const int p0 = sbase[e0] + r0, p1 = sbase[e1] + r1, tok = tile * 64 + tid;
                ROWTOK[e0 * CAPE + p0] = tok; ROWTOK[e1 * CAPE + p1] = tok;
                int* sp = SEL + (size_t)tok * 8; sp[0] = e0; sp[1] = p0; sp[2] = e1; sp[3] = p1; sp[4] = __float_as_int(sw[2 * tid]); sp[5] = __float_as_int(sw[2 * tid + 1]); }
            __syncthreads();
        }
    }
    SEAM(16);

    pg8::MoeTiles MT;
    if (IN(17) || IN(18) || IN(19)) {
        int acc = 0; MT.tp8 = 0ull; MT.c4a = 0ull; MT.c4b = 0ull;
#pragma unroll
        for (int e = 0; e < 8; ++e) { const int c = (int)__builtin_amdgcn_readfirstlane((int)__hip_atomic_load(ctl + CW_CNT + 64 * e, RLX_AGENT));
            if (e < 4) MT.c4a |= (unsigned long long)(unsigned)c << (16 * e); else MT.c4b |= (unsigned long long)(unsigned)c << (16 * (e - 4));
            MT.tp8 |= (unsigned long long)(unsigned)acc << (8 * e); acc += (c + 255) >> 8; }
        MT.nt = acc;
    }
    if (IN(17)) {
        pg8::MoeGuProb P{U, wsp<bf16_t>(F, O_WGU1), 1024, 1024, 1024, {}, MT, wsp<int>(F, O_ROWTOK)}; P.ord.init(MT.nt, N_GU1 / 256, F.G, (int)blockIdx.x);
        pg8::EpiSwiglu E{wsp<bf16_t>(F, O_HM), EXD};
        pg8::gemm_phase(F.lds, P, E);
    }
    SEAM(17);
    if (IN(18)) {
        pg8::MoeDnProb P{wsp<bf16_t>(F, O_HM), wsp<bf16_t>(F, O_WD1), EXD, EXD, EXD, {}, MT}; P.ord.init(MT.nt, 4, F.G, (int)blockIdx.x);
        pg8::EpiBf16 E{wsp<bf16_t>(F, O_YE), D, nullptr};
        pg8::gemm_phase(F.lds, P, E);
    }
    SEAM(18);
    if (IN(19)) {
        const int* SEL = wsp<int>(F, O_SEL); const bf16_t* YE = wsp<bf16_t>(F, O_YE);
        for (int row = gw; row < RL; row += NGW) {
            const int b = row >> 12; const int* sp = SEL + (size_t)row * 8;
            const int e0 = sp[0], p0 = sp[1], e1 = sp[2], p1 = sp[3]; const float w0 = __int_as_float(sp[4]), w1 = __int_as_float(sp[5]);
            const int t0 = pg8::moe_tp(MT, e0), t1 = pg8::moe_tp(MT, e1);
            const bf16_t* y0 = YE + ((size_t)t0 * 256 + p0) * D; const bf16_t* y1 = YE + ((size_t)t1 * 256 + p1) * D;
            float* hp = args.out + (size_t)row * D;
            f32x4 y[4], h[4]; load_row(hp, lane, h);
#pragma unroll
            for (int j = 0; j < 4; ++j) { const int c = 4 * lane + 256 * j; const u32x2 a = *(const u32x2*)(y0 + c), bq = *(const u32x2*)(y1 + c);
                y[j][0] = w0 * bflo(a.x) + w1 * bflo(bq.x); y[j][1] = w0 * bfhi(a.x) + w1 * bfhi(bq.x); y[j][2] = w0 * bflo(a.y) + w1 * bflo(bq.y); y[j][3] = w0 * bfhi(a.y) + w1 * bfhi(bq.y); }
            const float rstd = __builtin_amdgcn_rsqf(row_ssq(y) * (1.0f / D) + EPS);
#pragma unroll
            for (int j = 0; j < 4; ++j) { const int c = 4 * lane + 256 * j; const f32x4 g = *(const f32x4*)(normg + 7 * D + c), mg = *(const f32x4*)(MV(1, b, 5) + c);
                *(f32x4*)(hp + c) = h[j] + mg * (y[j] * rstd * g); }
        }
    }
#undef IN
#undef SEAM
#undef MV
}

constexpr int N_PHASES = 20;
extern "C" void kernel_launch(void* const* d_in, const int* in_sizes, int n_in, void* d_out, int out_size, void* d_ws, size_t ws_size, hipStream_t stream) {
    static int grid = 0;
    if (grid == 0) {
        if (n_in != 27 || out_size != RL * D || ws_size < WS_END) { fprintf(stderr, "kernel_launch: unexpected shapes n_in %d out %d ws %zu (need %zu)\n", n_in, out_size, ws_size, (size_t)WS_END); grid = -1; return; }
        int dev = 0, cus = 0, per_cu = 0;
        if (hipGetDevice(&dev) != hipSuccess || hipDeviceGetAttribute(&cus, hipDeviceAttributeMultiprocessorCount, dev) != hipSuccess) { grid = -1; return; }
        if (hipFuncSetAttribute((const void*)mk_fwd, hipFuncAttributeMaxDynamicSharedMemorySize, LDS_BYTES) != hipSuccess) { fprintf(stderr, "kernel_launch: hipFuncSetAttribute failed\n"); grid = -1; return; }
        if (hipOccupancyMaxActiveBlocksPerMultiprocessor(&per_cu, (const void*)mk_fwd, 512, LDS_BYTES) != hipSuccess || per_cu < 1) { fprintf(stderr, "kernel_launch: occupancy query says %d\n", per_cu); }
        (void)hipGetLastError();
        grid = cus;
        if (grid > 256) grid = 256;
    }
    if (grid < 0) return;
    (void)hipMemsetAsync((char*)d_ws + O_CTL, 0, CTL_BYTES, stream);
    Args a{};
    for (int i = 0; i < 27; ++i) a.in[i] = (const float*)d_in[i];
    a.out = (float*)d_out; a.ws = (unsigned char*)d_ws;
#if MK_ONE_LAUNCH
    a.ph_lo = 0; a.ph_hi = N_PHASES;
    hipLaunchKernelGGL(mk_fwd, dim3(grid), dim3(512), LDS_BYTES, stream, a);
#else
    for (int p = 0; p < N_PHASES; ++p) { a.ph_lo = p; a.ph_hi = p + 1; hipLaunchKernelGGL(mk_fwd, dim3(grid), dim3(512), LDS_BYTES, stream, a); }
#endif
}
```

```cpp
#include <hip/hip_runtime.h>
#include <cstdio>
#include <cstdint>

#ifndef MK_ONE_LAUNCH
#define MK_ONE_LAUNCH 1
#endif
#ifndef MK_REP
#define MK_REP -1
#endif

#define LAS __attribute__((address_space(3)))
#define GAS __attribute__((address_space(1)))
typedef unsigned short bf16_t;
typedef short bf16x8 __attribute__((ext_vector_type(8)));
typedef short s16x4 __attribute__((ext_vector_type(4)));
typedef float f32x4 __attribute__((ext_vector_type(4)));
typedef float f32x16 __attribute__((ext_vector_type(16)));
typedef unsigned u32x4 __attribute__((ext_vector_type(4)));
typedef unsigned u32x2 __attribute__((ext_vector_type(2)));
typedef float f32x2_t __attribute__((ext_vector_type(2)));
typedef __bf16 bf16x2_t __attribute__((ext_vector_type(2)));
#define RLX_AGENT __ATOMIC_RELAXED, __HIP_MEMORY_SCOPE_AGENT

__device__ __forceinline__ unsigned cvtpk(float lo, float hi) { f32x2_t v = {lo, hi}; bf16x2_t b = __builtin_convertvector(v, bf16x2_t); return __builtin_bit_cast(unsigned, b); }
__device__ __forceinline__ bf16_t f2bf(float f) { return (bf16_t)(cvtpk(f, 0.f) & 0xffffu); }
__device__ __forceinline__ float bflo(unsigned w) { return __uint_as_float(w << 16); }
__device__ __forceinline__ float bfhi(unsigned w) { return __uint_as_float(w & 0xffff0000u); }
__device__ __forceinline__ float bf2f(bf16_t b) { return __uint_as_float(((unsigned)b) << 16); }
__device__ __forceinline__ float wave_sum(float v) {
#pragma unroll
    for (int o = 1; o < 64; o <<= 1) v += __shfl_xor(v, o);
    return v;
}
__device__ __forceinline__ float fast_exp(float x) { return __builtin_amdgcn_exp2f(x * 1.4426950408889634f); }
__device__ __forceinline__ float silu_f(float g) { return g * __builtin_amdgcn_rcpf(1.0f + fast_exp(-g)); }

#define XB_TMO      128
#define XB_XCNT(j)  (256  + 64 * (j))
#define XB_XSUB(j)  (1280 + 64 * (j))
#define XB_XGEN(j)  (2304 + 64 * (j))
#define XB_TOP      3328
#define XB_TOPGEN   3392
#define XCD_BAR_WORDS 3456
#define XB_SPIN_CAP (1u << 18)
__device__ __forceinline__ unsigned xb_ld(unsigned* p)              { return __hip_atomic_load(p, __ATOMIC_RELAXED, __HIP_MEMORY_SCOPE_AGENT); }
__device__ __forceinline__ unsigned xb_add(unsigned* p, unsigned v) { return __hip_atomic_fetch_add(p, v, __ATOMIC_RELAXED, __HIP_MEMORY_SCOPE_AGENT); }
__device__ __forceinline__ unsigned xb_xcc_id() { return (unsigned)__builtin_amdgcn_s_getreg((3 << 11) | 20) & 0xFu; }
#define XB_SPIN(cond, bar) do { unsigned _sp = 0; while (cond) { __builtin_amdgcn_s_sleep(1); \
    if ((++_sp & 255u) == 0u) { if (xb_ld(&(bar)[XB_TMO])) break; if (_sp > XB_SPIN_CAP) { atomicAdd(&(bar)[XB_TMO], 1u); break; } } } } while (0)
struct XcdBarrier { unsigned* bar; unsigned x; volatile LAS unsigned* st; };
__device__ __forceinline__ XcdBarrier xcd_barrier_post(unsigned* bar, volatile LAS unsigned* st) {
    XcdBarrier b; b.bar = bar; b.x = xb_xcc_id(); b.st = st;
    if (threadIdx.x == 0) (void)xb_add(&bar[XB_XCNT(b.x)], 1u);
    return b;
}
__device__ __forceinline__ void xcd_barrier_complete(unsigned* bar, unsigned x, unsigned& nloc, unsigned& nx) {
    const unsigned G = gridDim.x * gridDim.y * gridDim.z;
    unsigned sum, cnt, mine, sp = 0u;
    for (;;) {
        sum = 0u; cnt = 0u; mine = 0u;
#pragma unroll
        for (unsigned j = 0; j < 16; ++j) { const unsigned c = xb_ld(&bar[XB_XCNT(j)]); sum += c; cnt += (c > 0u) ? 1u : 0u; mine = (j == x) ? c : mine; }
        if (sum == G) break;
        __builtin_amdgcn_s_sleep(1);
        if ((++sp & 255u) == 0u) { if (xb_ld(&bar[XB_TMO])) break; if (sp > XB_SPIN_CAP) { atomicAdd(&bar[XB_TMO], 1u); break; } }
    }
    nloc = mine > 0u ? mine : 1u; nx = cnt > 0u ? cnt : 1u;
}
__device__ __forceinline__ void xcd_barrier(const XcdBarrier& b) {
    asm volatile("s_waitcnt vmcnt(0)" ::: "memory");
    __syncthreads();
    if (threadIdx.x == 0) {
        unsigned* bar = b.bar;
        __builtin_amdgcn_s_waitcnt(0);
        unsigned nloc = b.st[0], nx = b.st[1];
        if (nloc == 0u) { xcd_barrier_complete(bar, b.x, nloc, nx); b.st[0] = nloc; b.st[1] = nx; }
        const unsigned old = xb_add(&bar[XB_XSUB(b.x)], 1u);
        const unsigned gen = old / nloc;
        if (old + 1u == (gen + 1u) * nloc) {
            __builtin_amdgcn_fence(__ATOMIC_RELEASE, "agent");
            asm volatile("s_waitcnt vmcnt(0)" ::: "memory");
            const unsigned og = xb_add(&bar[XB_TOP], 1u);
            const unsigned tg = og / nx;
            if (og + 1u == (tg + 1u) * nx) xb_add(&bar[XB_TOPGEN], 1u);
            else XB_SPIN(xb_ld(&bar[XB_TOPGEN]) == tg, bar);
            __builtin_amdgcn_fence(__ATOMIC_ACQUIRE, "agent");
            xb_add(&bar[XB_XGEN(b.x)], 1u);
            asm volatile("s_waitcnt vmcnt(0)" ::: "memory");
        } else {
            XB_SPIN(xb_ld(&bar[XB_XGEN(b.x)]) == gen, bar);
            __builtin_amdgcn_fence(__ATOMIC_ACQUIRE, "agent");
            asm volatile("s_waitcnt vmcnt(0)" ::: "memory");
        }
    }
    __syncthreads();
}

constexpr int D = 1024, NB = 4, SEQ = 4096, CTX = 256;
constexpr int RL = NB * SEQ;
constexpr int RC = NB * CTX;
constexpr int R = RL + RC;
constexpr float EPS = 1e-6f;
constexpr float LOG2E = 1.4426950408889634f;
constexpr int N_IN0 = 1536, N_QA = 768, N_KVA = 1024, FFN = 2816, N_GU0 = 2 * FFN, N_IN1 = 3328, EXD = 3584, N_GU1 = 2 * EXD, NEXP = 8;
constexpr int CAPE = 16384;

constexpr size_t MiB = 1u << 20;
constexpr size_t O_CTL = 0;
constexpr size_t CTL_BYTES = 65536;
constexpr int CW_BAR = 0;
constexpr int CW_CNT = 8192;
constexpr size_t O_MODV = 1 * MiB;
constexpr size_t O_TAB16 = O_MODV + 256 * 1024;
constexpr size_t O_TAB32 = O_TAB16 + 8192;
constexpr size_t O_RSTDQ = O_TAB32 + 16384;
constexpr size_t O_RSTDKV = O_RSTDQ + 81920;
constexpr size_t O_SEL = 2 * MiB;
constexpr size_t O_ROWTOK = 3 * MiB;
constexpr size_t O_WGU1 = 4 * MiB;
constexpr size_t O_YE = O_WGU1;
constexpr size_t O_WD1 = 116 * MiB;
constexpr size_t O_WIN1 = 172 * MiB;
constexpr size_t O_WOUT1 = 179 * MiB;
constexpr size_t O_WIN0 = 181 * MiB;
constexpr size_t O_WUQ = 184 * MiB;
constexpr size_t O_WUKV = 185 * MiB;
constexpr size_t O_WOUT0 = 186 * MiB;
constexpr size_t O_WGU0 = 188 * MiB;
constexpr size_t O_WD0 = 199 * MiB;
constexpr size_t O_HC = 205 * MiB;
constexpr size_t O_U = 209 * MiB;
constexpr size_t O_Y = 243 * MiB;
constexpr size_t O_Z0 = 311 * MiB;
constexpr size_t O_QA = 362 * MiB;
constexpr size_t O_KVA = 388 * MiB;
constexpr size_t O_QB = 422 * MiB;
constexpr size_t O_KB = 439 * MiB;
constexpr size_t O_KR = 444 * MiB;
constexpr size_t O_AO = 446 * MiB;
constexpr size_t O_H0 = 311 * MiB;
constexpr size_t O_QK1 = 311 * MiB;
constexpr size_t O_V1 = 345 * MiB;
constexpr size_t O_G1 = 379 * MiB;
constexpr size_t O_RR = 413 * MiB;
constexpr size_t O_QDF = 422 * MiB, O_KIF = 439 * MiB, O_KTF = 456 * MiB, O_QDB = 473 * MiB;
constexpr size_t O_KIB = 243 * MiB, O_KTB = 260 * MiB, O_VT = 277 * MiB;
constexpr size_t O_ECL = 490 * MiB;
constexpr size_t O_OF = O_QK1, O_OB = O_V1;
constexpr size_t O_GA = O_QDF;
constexpr size_t O_HM = 243 * MiB;
constexpr size_t WS_END = 495 * MiB;
static_assert(O_HM + (size_t)34816 * EXD * 2 <= 482 * MiB, "HM");
static_assert(O_RR + (size_t)R * 256 * 2 <= O_QDF, "RR");
static_assert(O_ECL + (size_t)544 * 8 * 1024 <= WS_END, "ECL");

constexpr int RING_BYTES = 131072;
constexpr int LDS_BYTES = 147456;
constexpr int LDSCTL_OFF = LDS_BYTES - 256;

struct Args {
    const float* in[27];
    float* out; unsigned char* ws;
    int ph_lo, ph_hi;
};
enum { I_X = 0, I_C, I_CTX, I_CCTX, I_MODW, I_MODB, I_NORMG, I_AWIN, I_AQN, I_AWUQ, I_AKVN, I_AWUKV, I_AQKN, I_AWOUT, I_GWIN, I_GGATE2, I_GBGATE, I_GONORM, I_GWOUT,
       I_FWG, I_FWU, I_FWD, I_MROUTER, I_MBROUTER, I_MWG, I_MWU, I_MWD };

struct Conv { const float* s0; const float* s1; int Nsrc; int K; int Ndst; bf16_t* dst; int mode; const float* kscale; };
__device__ __forceinline__ int ilv64(int p) { return (p >> 5) * 32 + (p & 1) * 16 + ((p & 31) >> 1); }
__device__ __forceinline__ int ilv32(int p) { return (p >> 4) * 16 + (p & 1) * 8 + ((p & 15) >> 1); }
__device__ __forceinline__ const float* conv_col(const Conv& c, int n, float& sc) {
    sc = 1.0f;
    switch (c.mode) {
    case 0: return c.s0 + n;
    case 1: {
        if (n < 640) return c.s0 + n;
        if (n < 1152) { const int hh = (n - 640) >> 6, p = (n - 640) & 63; return c.s0 + 672 + hh * 64 + ilv64(p); }
        if (n < 1280) { const int hh = (n - 1152) >> 6, p = (n - 1152) & 63; return c.s0 + 1184 + hh * 64 + ilv64(p); }
        if (n < 1408) return c.s0 + 1312 + (n - 1280);
        if (n < 1440) return c.s0 + 640 + ilv32(n - 1408);
        return nullptr; }
    case 2: {
        if (n < 512) return c.s0 + (n >> 6) * 96 + (n & 63);
        const int hh = (n - 512) >> 5, p = (n - 512) & 31; return c.s0 + hh * 96 + 64 + ilv32(p); }
    case 3: {
        const int G = n >> 5, j = n & 31; return (j < 16) ? c.s0 + 16 * G + j : c.s1 + 16 * G + (j - 16); }
    case 4: {
        if (n >= 3104) return nullptr;
        if (n < 512) sc = 0.08838834764831845f;
        return c.s0 + n; }
    }
    return nullptr;
}
__device__ __forceinline__ void conv_item(const Conv& c, int item, LAS float* scr, int lane) {
    const int nblk = c.Ndst / 32, kb = item / nblk, nb = item % nblk, k0 = 64 * kb, n0 = 32 * nb;
    float sc; const float* cp = conv_col(c, n0 + (lane & 31), sc);
    const int kh = lane >> 5;
#pragma unroll 16
    for (int i = 0; i < 32; ++i) { const int kk = 2 * i + kh; float v = 0.f;
        if (cp) { v = cp[(size_t)(k0 + kk) * c.Nsrc] * sc; if (c.kscale) v *= c.kscale[k0 + kk]; }
        scr[kk * 33 + (lane & 31)] = v; }
    asm volatile("s_waitcnt lgkmcnt(0)" ::: "memory");
    const int ch = lane & 7;
#pragma unroll
    for (int j = 0; j < 4; ++j) { const int n = (lane >> 3) + 8 * j; const LAS float* s = scr + (8 * ch) * 33 + n;
        u32x4 o; o.x = cvtpk(s[0 * 33], s[1 * 33]); o.y = cvtpk(s[2 * 33], s[3 * 33]); o.z = cvtpk(s[4 * 33], s[5 * 33]); o.w = cvtpk(s[6 * 33], s[7 * 33]);
        *(u32x4*)(c.dst + (size_t)(n0 + n) * c.K + k0 + 8 * ch) = o; }
    asm volatile("s_waitcnt lgkmcnt(0)" ::: "memory");
}

struct Conv64 { const float* s0; const float* s1; int Nsrc; int K; int Ndst; bf16_t* dst; int mode; int nvalid; int nscaled; float rscale; };
__device__ __forceinline__ void conv64_item(const Conv64& c, int item, LAS float* scr, int lane) {
    const int nblk = c.Ndst / 64, kb = item / nblk, nb = item % nblk, k0 = 64 * kb, n0 = 64 * nb;
    const int c4 = lane & 15, kr = lane >> 4;
    const float* src; int nd; bool valid = true; float sc = 1.0f;
    if (c.mode == 3) { const int cc = 4 * (c4 & 7); src = ((c4 < 8) ? c.s0 : c.s1) + 32 * nb + cc; nd = 32 * (cc >> 4) + ((c4 < 8) ? 0 : 16) + (cc & 15); }
    else { nd = 4 * c4; src = c.s0 + n0 + nd; valid = (n0 + nd) < c.nvalid; if (n0 + nd < c.nscaled) sc = c.rscale; }
    src += (size_t)(k0 + kr) * c.Nsrc;
    f32x4 v[16];
#pragma unroll
    for (int i = 0; i < 16; ++i) v[i] = valid ? *(const f32x4*)(src + (size_t)(4 * i) * c.Nsrc) : (f32x4){0.f, 0.f, 0.f, 0.f};
#pragma unroll
    for (int i = 0; i < 16; ++i) { LAS float* p = scr + (4 * i + kr) * 65 + nd; p[0] = v[i][0] * sc; p[1] = v[i][1] * sc; p[2] = v[i][2] * sc; p[3] = v[i][3] * sc; }
    asm volatile("s_waitcnt lgkmcnt(0)" ::: "memory");
    const int ch = lane & 7;
#pragma unroll
    for (int it = 0; it < 8; ++it) { const int r = it * 8 + (lane >> 3); const LAS float* sp = scr + (8 * ch) * 65 + r;
        u32x4 o; o.x = cvtpk(sp[0 * 65], sp[1 * 65]); o.y = cvtpk(sp[2 * 65], sp[3 * 65]); o.z = cvtpk(sp[4 * 65], sp[5 * 65]); o.w = cvtpk(sp[6 * 65], sp[7 * 65]);
        *(u32x4*)(c.dst + (size_t)(n0 + r) * c.K + k0 + 8 * ch) = o; }
    asm volatile("s_waitcnt lgkmcnt(0)" ::: "memory");
}

namespace pg8 {
constexpr int BM = 256, BK = 64, HALF = 128, HTB = HALF * BK * 2, STAGE_BYTES = 8 * HTB;
constexpr int NXCD = 8, WGM = 8;
__device__ __forceinline__ int lds_byte(int r, int c) { const int st = (r >> 4) * 2 + (c >> 5), rr = r & 15, cc = c & 31, ob = rr * 64 + cc * 2; return st * 1024 + (ob ^ (((ob >> 9) & 1) << 5)); }
__device__ __forceinline__ void stage_rc(int b, int& Rr, int& C) { const int st = b / 1024, sb = b % 1024, swz = sb ^ (((sb >> 9) & 1) << 5); Rr = (st >> 1) * 16 + swz / 64; C = (st & 1) * 32 + (swz % 64) / 2; }
__device__ __forceinline__ int perm32(int rho) { const int n = rho >> 4, i = rho & 15; return 8 * (i >> 2) + 4 * n + (i & 3); }
struct Unit { int pm, pn; };
struct Order {
    int nM, nN, nwg, G, c;
    __device__ __forceinline__ void init(int nM_, int nN_, int G_, int c_) { nM = nM_; nN = nN_; nwg = nM * nN; G = G_; c = c_; }
    __device__ __forceinline__ bool next(int i, Unit& u) const {
        const long L = (long)i * G + c; if (L >= nwg) return false;
        int wgid = (int)L; { const int q = nwg / NXCD, r = nwg % NXCD, xcd = wgid % NXCD, off = wgid / NXCD; wgid = (xcd < r ? xcd * (q + 1) : r * (q + 1) + (xcd - r) * q) + off; }
        const int nig = WGM * nN, gid = wgid / nig, fm = gid * WGM, gsz = (nM - fm) < WGM ? (nM - fm) : WGM;
        u.pm = fm + ((wgid % nig) % gsz); u.pn = (wgid % nig) / gsz; return true;
    }
};

template <class Prob, class Epi>
__device__ __forceinline__ void gemm_phase(LAS unsigned char* lds, const Prob& P, const Epi& E) {
    const int tid = threadIdx.x, wid = __builtin_amdgcn_readfirstlane(tid >> 6), lane = tid & 63, wr = wid >> 2, wc = wid & 3, fr = lane & 15, fq = lane >> 4;
    const int K = P.K, nt = K / BK, ldb = P.ldb;
    int RA[2], CA[2]; unsigned voffB[2];
#pragma unroll
    for (int i = 0; i < 2; ++i) { int Rr, C; stage_rc(tid * 16 + i * 8192, Rr, C); const int Rb = Epi::PERM ? ((Rr & ~31) + perm32(Rr & 31)) : Rr;
        RA[i] = Rr; CA[i] = C; voffB[i] = (unsigned)(Rb * ldb + C) * 2u; }
    const size_t hstepB = (size_t)HALF * ldb * 2;
    const unsigned ldsw = (unsigned)wid * 1024u;
    const int aoff = lds_byte(wr * 64 + fr, fq * 8), boff = lds_byte(wc * 32 + fr, fq * 8);
    const char* Abase = (const char*)P.Abase;
#define PG8_SA(b, h) (((b) * 2 + (h)) * HTB)
#define PG8_SB(b, h) ((4 + (b) * 2 + (h)) * HTB)
#define PG8_STAGEB(bufoff, gbase) do { _Pragma("unroll") for (int _i = 0; _i < 2; ++_i) \
        __builtin_amdgcn_global_load_lds((const unsigned*)((const char*)(gbase) + voffB[_i]), (LAS unsigned*)(lds + (bufoff) + ldsw + _i * 8192), 16, 0, 0); } while (0)
#define PG8_STAGEA(bufoff, vo, h, kb) do { _Pragma("unroll") for (int _i = 0; _i < 2; ++_i) \
        __builtin_amdgcn_global_load_lds((const unsigned*)(Abase + (size_t)(kb) + (vo)[h][_i]), (LAS unsigned*)(lds + (bufoff) + ldsw + _i * 8192), 16, 0, 0); } while (0)
#define PG8_LDA(dst, b, h) do { _Pragma("unroll") for (int m = 0; m < 4; ++m) _Pragma("unroll") for (int k = 0; k < 2; ++k) dst[m][k] = *(const LAS bf16x8*)(lds + PG8_SA(b, h) + aoff + m * 2048 + k * 1024); } while (0)
#define PG8_LDB(dst, b, h) do { _Pragma("unroll") for (int n = 0; n < 2; ++n) _Pragma("unroll") for (int k = 0; k < 2; ++k) dst[n][k] = *(const LAS bf16x8*)(lds + PG8_SB(b, h) + boff + n * 2048 + k * 1024); } while (0)
#define PG8_MMA(ai, bj, At, Bt) do { __builtin_amdgcn_s_setprio(1); _Pragma("unroll") for (int m = 0; m < 4; ++m) _Pragma("unroll") for (int n = 0; n < 2; ++n) _Pragma("unroll") for (int k = 0; k < 2; ++k) \
        acc[ai][bj][m][n] = __builtin_amdgcn_mfma_f32_16x16x32_bf16(Bt[n][k], At[m][k], acc[ai][bj][m][n], 0, 0, 0); __builtin_amdgcn_s_setprio(0); } while (0)
#define PG8_WAIT_V(n) asm volatile("s_waitcnt vmcnt(" #n ")" ::: "memory")
#define PG8_WAIT_L(n) asm volatile("s_waitcnt lgkmcnt(" #n ")" ::: "memory")
#define PG8_BAR __builtin_amdgcn_s_barrier()
#define PG8_SCHED __builtin_amdgcn_sched_barrier(0)
    Unit cur, nxt; int ui = 0;
    if (!P.next(0, cur)) return;
    f32x4 acc[2][2][4][2];
#pragma unroll
    for (int a = 0; a < 2; ++a)
#pragma unroll
        for (int b = 0; b < 2; ++b)
#pragma unroll
            for (int m = 0; m < 4; ++m)
#pragma unroll
                for (int n = 0; n < 2; ++n) acc[a][b][m][n] = (f32x4){0.f, 0.f, 0.f, 0.f};
    bf16x8 At[4][2], B0[2][2], B1[2][2];
    unsigned cvo[2][2], nvo[2][2];
#pragma unroll
    for (int h = 0; h < 2; ++h)
#pragma unroll
        for (int i = 0; i < 2; ++i) cvo[h][i] = P.a_off(cur, h * HALF + RA[i]) + (unsigned)CA[i] * 2u;
    const char* cB = P.b_ptr(cur);
    const size_t kstep = (size_t)(BK * 2);
    PG8_STAGEB(PG8_SB(0, 0), cB); PG8_STAGEA(PG8_SA(0, 0), cvo, 0, 0); PG8_STAGEB(PG8_SB(0, 1), cB + hstepB); PG8_STAGEA(PG8_SA(0, 1), cvo, 1, 0);
    if (wr == 1) PG8_BAR;
    PG8_WAIT_V(4); PG8_BAR;
    PG8_STAGEB(PG8_SB(1, 0), cB + kstep); PG8_STAGEA(PG8_SA(1, 0), cvo, 0, kstep); PG8_STAGEB(PG8_SB(1, 1), cB + hstepB + kstep);
    PG8_WAIT_V(6); PG8_BAR;
    for (;;) {
        const bool has_next = P.next(ui + 1, nxt);
        const char* nB = cB;
#pragma unroll
        for (int h = 0; h < 2; ++h)
#pragma unroll
            for (int i = 0; i < 2; ++i) nvo[h][i] = cvo[h][i];
        if (has_next) { nB = P.b_ptr(nxt);
#pragma unroll
            for (int h = 0; h < 2; ++h)
#pragma unroll
                for (int i = 0; i < 2; ++i) nvo[h][i] = P.a_off(nxt, h * HALF + RA[i]) + (unsigned)CA[i] * 2u; }
        for (int t = 0; t < nt; t += 2) {
            const bool last = (t == nt - 2);
            const size_t k1 = (size_t)(t + 1) * kstep;
            const size_t k2 = last ? 0 : (size_t)(t + 2) * kstep, k3 = k2 + kstep;
            unsigned vo2[2][2];
#pragma unroll
            for (int h = 0; h < 2; ++h)
#pragma unroll
                for (int i = 0; i < 2; ++i) vo2[h][i] = last ? nvo[h][i] : cvo[h][i];
            const char* b2 = (last ? nB : cB) + k2; const char* b3 = b2 + kstep;
            PG8_LDB(B0, 0, 0); PG8_SCHED; PG8_LDA(At, 0, 0); PG8_STAGEA(PG8_SA(1, 1), cvo, 1, k1);
            PG8_WAIT_L(8); PG8_BAR; PG8_WAIT_L(0); PG8_MMA(0, 0, At, B0); PG8_BAR; PG8_SCHED;
            PG8_LDB(B1, 0, 1); PG8_STAGEB(PG8_SB(0, 0), b2);
            PG8_BAR; PG8_WAIT_L(0); PG8_MMA(0, 1, At, B1); PG8_BAR;
            PG8_LDA(At, 0, 1); PG8_STAGEA(PG8_SA(0, 0), vo2, 0, k2);
            PG8_BAR; PG8_WAIT_L(0); PG8_MMA(1, 0, At, B0); PG8_BAR; PG8_SCHED;
            PG8_STAGEB(PG8_SB(0, 1), b2 + hstepB);
            PG8_WAIT_V(6); PG8_BAR; PG8_MMA(1, 1, At, B1); PG8_BAR;
            PG8_LDB(B0, 1, 0); PG8_SCHED; PG8_LDA(At, 1, 0); PG8_STAGEA(PG8_SA(0, 1), vo2, 1, k2);
            PG8_WAIT_L(8); PG8_BAR; PG8_WAIT_L(0); PG8_MMA(0, 0, At, B0); PG8_BAR; PG8_SCHED;
            PG8_LDB(B1, 1, 1); PG8_STAGEB(PG8_SB(1, 0), b3);
            PG8_BAR; PG8_WAIT_L(0); PG8_MMA(0, 1, At, B1); PG8_BAR;
            PG8_LDA(At, 1, 1); PG8_STAGEA(PG8_SA(1, 0), vo2, 0, k3);
            PG8_BAR; PG8_WAIT_L(0); PG8_MMA(1, 0, At, B0); PG8_BAR; PG8_SCHED;
            PG8_STAGEB(PG8_SB(1, 1), b3 + hstepB);
            PG8_WAIT_V(6); PG8_BAR; PG8_MMA(1, 1, At, B1); PG8_BAR;
        }
        E(acc, P, cur, wr, wc, fr, fq);
        if (!has_next) break;
#pragma unroll
        for (int a = 0; a < 2; ++a)
#pragma unroll
            for (int b = 0; b < 2; ++b)
#pragma unroll
                for (int m = 0; m < 4; ++m)
#pragma unroll
                    for (int n = 0; n < 2; ++n) acc[a][b][m][n] = (f32x4){0.f, 0.f, 0.f, 0.f};
        cur = nxt; cB = nB; ++ui;
#pragma unroll
        for (int h = 0; h < 2; ++h)
#pragma unroll
            for (int i = 0; i < 2; ++i) cvo[h][i] = nvo[h][i];
    }
    PG8_WAIT_V(0);
    if (wr == 0) PG8_BAR;
    PG8_BAR;
#undef PG8_SA
#undef PG8_SB
#undef PG8_STAGEA
#undef PG8_STAGEB
#undef PG8_LDA
#undef PG8_LDB
#undef PG8_MMA
#undef PG8_WAIT_V
#undef PG8_WAIT_L
#undef PG8_BAR
#undef PG8_SCHED
}

struct DenseProb {
    const bf16_t* Abase; const bf16_t* Bt; int K, lda, ldb; Order ord;
    __device__ __forceinline__ bool next(int i, Unit& u) const { return ord.next(i, u); }
    __device__ __forceinline__ unsigned a_off(const Unit& u, int r) const { return (unsigned)((size_t)(u.pm * BM + r) * lda * 2); }
    __device__ __forceinline__ const char* b_ptr(const Unit& u) const { return (const char*)Bt + (size_t)u.pn * BM * ldb * 2; }
    __device__ __forceinline__ int orow0(const Unit& u) const { return u.pm * BM; }
};
struct MoeTiles { unsigned long long tp8; unsigned long long c4a, c4b; int nt; };
__device__ __forceinline__ int moe_tp(const MoeTiles& T, int e) { return (int)((T.tp8 >> (8 * e)) & 0xffull); }
__device__ __forceinline__ int moe_cnt(const MoeTiles& T, int e) { const unsigned long long w = (e < 4) ? T.c4a : T.c4b; return (int)((w >> (16 * (e & 3))) & 0xffffull); }
__device__ __forceinline__ int moe_expert(const MoeTiles& T, int pm) { int e = 0;
#pragma unroll
    for (int j = 1; j < 8; ++j) e += (pm >= (int)((T.tp8 >> (8 * j)) & 0xffull)) ? 1 : 0;
    return e; }
struct MoeGuProb {
    const bf16_t* Abase; const bf16_t* Bt; int K, lda, ldb; Order ord; MoeTiles T; const int* rowtok;
    __device__ __forceinline__ bool next(int i, Unit& u) const { return ord.next(i, u); }
    __device__ __forceinline__ unsigned a_off(const Unit& u, int r) const {
        const int e = moe_expert(T, u.pm); const int idx = (u.pm - moe_tp(T, e)) * BM + r; int tok = 0;
        if (idx < moe_cnt(T, e)) tok = rowtok[e * CAPE + idx];
        return (unsigned)tok * (unsigned)(lda * 2); }
    __device__ __forceinline__ const char* b_ptr(const Unit& u) const { const int e = moe_expert(T, u.pm); return (const char*)Bt + ((size_t)e * N_GU1 + (size_t)u.pn * BM) * ldb * 2; }
    __device__ __forceinline__ int orow0(const Unit& u) const { return u.pm * BM; }
};
struct MoeDnProb {
    const bf16_t* Abase; const bf16_t* Bt; int K, lda, ldb; Order ord; MoeTiles T;
    __device__ __forceinline__ bool next(int i, Unit& u) const { return ord.next(i, u); }
    __device__ __forceinline__ unsigned a_off(const Unit& u, int r) const { return (unsigned)((size_t)(u.pm * BM + r) * lda * 2); }
    __device__ __forceinline__ const char* b_ptr(const Unit& u) const { const int e = moe_expert(T, u.pm); return (const char*)Bt + ((size_t)e * D + (size_t)u.pn * BM) * ldb * 2; }
    __device__ __forceinline__ int orow0(const Unit& u) const { return u.pm * BM; }
};

struct EpiF32 { static constexpr bool PERM = false; float* C; int ldc;
    template <class Prob> __device__ __forceinline__ void operator()(const f32x4 (&acc)[2][2][4][2], const Prob& P, const Unit& u, int wr, int wc, int fr, int fq) const {
        const int row0 = P.orow0(u) + wr * 64 + fr, col0 = u.pn * BM + wc * 32 + 4 * fq;
#pragma unroll
        for (int ai = 0; ai < 2; ++ai)
#pragma unroll
            for (int m = 0; m < 4; ++m) { float* rowp = C + (size_t)(row0 + ai * HALF + m * 16) * ldc + col0;
#pragma unroll
                for (int bj = 0; bj < 2; ++bj)
#pragma unroll
                    for (int n = 0; n < 2; ++n) *(f32x4*)(rowp + bj * HALF + n * 16) = acc[ai][bj][m][n]; }
    }
};
struct EpiBf16 { static constexpr bool PERM = true; bf16_t* O; int ldc; const float* rowscale;
    template <class Prob> __device__ __forceinline__ void operator()(const f32x4 (&acc)[2][2][4][2], const Prob& P, const Unit& u, int wr, int wc, int fr, int fq) const {
        const int row0 = P.orow0(u) + wr * 64 + fr, col0 = u.pn * BM + wc * 32 + 8 * fq;
#pragma unroll
        for (int ai = 0; ai < 2; ++ai)
#pragma unroll
            for (int m = 0; m < 4; ++m) { const int row = row0 + ai * HALF + m * 16; bf16_t* rowp = O + (size_t)row * ldc + col0; const float rs = rowscale ? rowscale[row] : 1.0f;
#pragma unroll
                for (int bj = 0; bj < 2; ++bj) { const f32x4 v0 = acc[ai][bj][m][0] * rs, v1 = acc[ai][bj][m][1] * rs;
                    u32x4 w; w.x = cvtpk(v0[0], v0[1]); w.y = cvtpk(v0[2], v0[3]); w.z = cvtpk(v1[0], v1[1]); w.w = cvtpk(v1[2], v1[3]);
                    *(u32x4*)(rowp + bj * HALF) = w; } }
    }
};
struct EpiIn1 { static constexpr bool PERM = true; bf16_t* QK; bf16_t* V; bf16_t* G; bf16_t* RRp;
    template <class Prob> __device__ __forceinline__ void operator()(const f32x4 (&acc)[2][2][4][2], const Prob& P, const Unit& u, int wr, int wc, int fr, int fq) const {
        const int t = u.pn >> 2; bf16_t* base = (t == 0) ? QK : (t == 1) ? V : (t == 2) ? G : RRp; const int ldc = (t == 3) ? 256 : 1024;
        const int row0 = P.orow0(u) + wr * 64 + fr, col0 = (u.pn & 3) * BM + wc * 32 + 8 * fq;
#pragma unroll
        for (int ai = 0; ai < 2; ++ai)
#pragma unroll
            for (int m = 0; m < 4; ++m) { const int row = row0 + ai * HALF + m * 16; bf16_t* rowp = base + (size_t)row * ldc + col0;
#pragma unroll
                for (int bj = 0; bj < 2; ++bj) { const f32x4 v0 = acc[ai][bj][m][0], v1 = acc[ai][bj][m][1];
                    u32x4 w; w.x = cvtpk(v0[0], v0[1]); w.y = cvtpk(v0[2], v0[3]); w.z = cvtpk(v1[0], v1[1]); w.w = cvtpk(v1[2], v1[3]);
                    *(u32x4*)(rowp + bj * HALF) = w; } }
    }
};
struct EpiQA { static constexpr bool PERM = true; bf16_t* O; const float* rstd; const float* tab16; float qscale;
    template <class Prob> __device__ __forceinline__ void operator()(const f32x4 (&acc)[2][2][4][2], const Prob& P, const Unit& u, int wr, int wc, int fr, int fq) const {
        const int row0 = P.orow0(u) + wr * 64 + fr, col0 = u.pn * BM + wc * 32 + 8 * fq;
        const bool ropet = (u.pn == 2);
#pragma unroll
        for (int ai = 0; ai < 2; ++ai)
#pragma unroll
            for (int m = 0; m < 4; ++m) { const int row = row0 + ai * HALF + m * 16; bf16_t* rowp = O + (size_t)row * N_QA + col0; const float rs = rstd[row] * qscale;
                f32x4 cs0 = {1.f, 1.f, 1.f, 1.f}, sn0 = {0.f, 0.f, 0.f, 0.f};
                if (ropet && row < RL) { const int tt = row & (SEQ - 1); const int pos = (fq >> 1) ? (tt & 63) : (tt >> 6); const int i0 = 4 * (fq & 1);
                    cs0 = *(const f32x4*)(tab16 + pos * 8 + i0); sn0 = *(const f32x4*)(tab16 + 512 + pos * 8 + i0); }
#pragma unroll
                for (int bj = 0; bj < 2; ++bj) { f32x4 v0 = acc[ai][bj][m][0] * rs, v1 = acc[ai][bj][m][1] * rs;
                    if (ropet) {
                        const f32x4 a = v0, b = v1;
                        v0[0] = a[0] * cs0[0] - a[1] * sn0[0]; v0[1] = a[1] * cs0[0] + a[0] * sn0[0];
                        v0[2] = a[2] * cs0[1] - a[3] * sn0[1]; v0[3] = a[3] * cs0[1] + a[2] * sn0[1];
                        v1[0] = b[0] * cs0[2] - b[1] * sn0[2]; v1[1] = b[1] * cs0[2] + b[0] * sn0[2];
                        v1[2] = b[2] * cs0[3] - b[3] * sn0[3]; v1[3] = b[3] * cs0[3] + b[2] * sn0[3]; }
                    u32x4 w; w.x = cvtpk(v0[0], v0[1]); w.y = cvtpk(v0[2], v0[3]); w.z = cvtpk(v1[0], v1[1]); w.w = cvtpk(v1[2], v1[3]);
                    *(u32x4*)(rowp + bj * HALF) = w; } }
    }
};
struct EpiSwiglu { static constexpr bool PERM = false; bf16_t* Hh; int ldh;
    template <class Prob> __device__ __forceinline__ void operator()(const f32x4 (&acc)[2][2][4][2], const Prob& P, const Unit& u, int wr, int wc, int fr, int fq) const {
        const int row0 = P.orow0(u) + wr * 64 + fr, col0 = (u.pn * BM + wc * 32) / 2 + 4 * fq;
#pragma unroll
        for (int ai = 0; ai < 2; ++ai)
#pragma unroll
            for (int m = 0; m < 4; ++m) { bf16_t* rowp = Hh + (size_t)(row0 + ai * HALF + m * 16) * ldh + col0;
#pragma unroll
                for (int bj = 0; bj < 2; ++bj) { const f32x4 g = acc[ai][bj][m][0], up = acc[ai][bj][m][1];
                    u32x2 w; w.x = cvtpk(silu_f(g[0]) * up[0], silu_f(g[1]) * up[1]); w.y = cvtpk(silu_f(g[2]) * up[2], silu_f(g[3]) * up[3]);
                    *(u32x2*)(rowp + bj * (HALF / 2)) = w; } }
    }
};
}

struct Frame {
    LAS unsigned char* lds;
    unsigned char* ws;
    int tid, lane, wave, vcu, G;
};
template <class T> __device__ __forceinline__ T* wsp(const Frame& F, size_t off) { return (T*)(F.ws + off); }

__device__ __forceinline__ void load_row(const float* p, int lane, f32x4 (&v)[4]) {
    const f32x4* r = (const f32x4*)p + lane;
#pragma unroll
    for (int j = 0; j < 4; ++j) v[j] = r[64 * j];
}
__device__ __forceinline__ float row_ssq(const f32x4 (&v)[4]) { float s = 0.f;
#pragma unroll
    for (int j = 0; j < 4; ++j) s += (v[j][0] * v[j][0] + v[j][1] * v[j][1]) + (v[j][2] * v[j][2] + v[j][3] * v[j][3]);
    return wave_sum(s); }
__device__ __forceinline__ void norm_mod_store(const f32x4 (&h)[4], const float* g, const float* sh, const float* sc, bf16_t* urow, int lane, f32x4 (&uo)[4]) {
    const float rstd = __builtin_amdgcn_rsqf(row_ssq(h) * (1.0f / D) + EPS);
#pragma unroll
    for (int j = 0; j < 4; ++j) { const int c = 4 * lane + 256 * j; const f32x4 gg = *(const f32x4*)(g + c), s1 = *(const f32x4*)(sc + c), s0 = *(const f32x4*)(sh + c);
        const f32x4 uu = (h[j] * rstd * gg) * (1.0f + s1) + s0; uo[j] = uu;
        u32x2 w; w.x = cvtpk(uu[0], uu[1]); w.y = cvtpk(uu[2], uu[3]); *(u32x2*)(urow + c) = w; }
}
__device__ __forceinline__ int row_bidx(int row) { return row < RL ? (row >> 12) : 4; }

template <int DQK> struct AttnSrc {
    const bf16_t* Q; int qpitch; const bf16_t* Qr;
    const bf16_t* Kn; int kpitch; const bf16_t* Kr; int krpitch;
    const bf16_t* V; int vpitch;
    bf16_t* O; int opitch;
};
__device__ __forceinline__ s16x4 vtr(const LAS unsigned char* p) { typedef short v4i16_t __attribute__((ext_vector_type(4))); return __builtin_bit_cast(s16x4, __builtin_amdgcn_ds_read_tr16_b64_v4i16((LAS v4i16_t*)p)); }
__device__ __forceinline__ int attn_krow(int kt, int lat0, int ctx0) { return kt < 64 ? lat0 + kt * 64 : ctx0 + (kt - 64) * 64; }
template <int DQK>
__device__ __forceinline__ void attn_unit(const Frame& F, const AttnSrc<DQK>& S, int q0, int lat0, int ctx0, int kt0, int kt1) {
    constexpr int NKS = DQK / 16, KB = DQK * 128, SLOT = KB + 8192;
    constexpr float THR = 8.0f;
    const int lane = F.lane, wid = F.wave, r32 = lane & 31, hi = lane >> 5;
    LAS unsigned char* lds = F.lds;
    bf16x8 qf[NKS];
    { const bf16_t* qrow = S.Q + (size_t)(q0 + wid * 32 + r32) * S.qpitch;
#pragma unroll
      for (int ks = 0; ks < 4; ++ks) qf[ks] = *(const bf16x8*)(qrow + ks * 16 + hi * 8);
      if (DQK == 96) { const bf16_t* qr = S.Qr + (size_t)(q0 + wid * 32 + r32) * S.qpitch;
#pragma unroll
          for (int ks = 4; ks < NKS; ++ks) qf[ks] = *(const bf16x8*)(qr + (ks - 4) * 16 + hi * 8); } }
    auto dma = [&](int kt, int slot) {
        const int krow = attn_krow(kt, lat0, ctx0);
        LAS unsigned char* sb = lds + slot * SLOT;
        __builtin_amdgcn_global_load_lds((const unsigned*)(S.Kn + (size_t)(krow + lane) * S.kpitch + wid * 8), (LAS unsigned*)(sb + wid * 1024), 16, 0, 0);
        if (DQK == 96 && wid < 4)
            __builtin_amdgcn_global_load_lds((const unsigned*)(S.Kr + (size_t)(krow + lane) * S.krpitch + wid * 8), (LAS unsigned*)(sb + (8 + wid) * 1024), 16, 0, 0);
        __builtin_amdgcn_global_load_lds((const unsigned*)(S.V + (size_t)(krow + 16 * (wid & 3) + (lane >> 2)) * S.vpitch + (wid >> 2) * 32 + (lane & 3) * 8), (LAS unsigned*)(sb + KB + wid * 1024), 16, 0, 0);
    };
    f32x16 oT[2]; f32x16 negm;
#pragma unroll
    for (int r = 0; r < 16; ++r) { oT[0][r] = 0.f; oT[1][r] = 0.f; negm[r] = 0.f; }
    float mrun = 0.f, lrun = 0.f; bool first = true;
    dma(kt0, 0);
    asm volatile("s_waitcnt vmcnt(0)" ::: "memory");
    __syncthreads();
    const int vlane = ((lane >> 4) & 1) * 32 + (lane & 3) * 8 + (4 * hi + ((lane & 15) >> 2)) * 64;
    for (int kt = kt0; kt < kt1; ++kt) {
        const int slot = (kt - kt0) & 1;
        if (kt + 1 < kt1) dma(kt + 1, slot ^ 1);
        const LAS unsigned char* kb = lds + slot * SLOT + hi * 1024 + r32 * 16;
        f32x16 p0 = negm, p1 = negm;
#pragma unroll
        for (int ks = 0; ks < NKS; ++ks) {
            const bf16x8 k0 = *(const LAS bf16x8*)(kb + ks * 2048), k1 = *(const LAS bf16x8*)(kb + ks * 2048 + 512);
            p0 = __builtin_amdgcn_mfma_f32_32x32x16_bf16(k0, qf[ks], p0, 0, 0, 0);
            p1 = __builtin_amdgcn_mfma_f32_32x32x16_bf16(k1, qf[ks], p1, 0, 0, 0);
        }
        float tm = fmaxf(p0[0], p1[0]);
#pragma unroll
        for (int r = 1; r < 16; ++r) tm = fmaxf(tm, fmaxf(p0[r], p1[r]));
        { auto rr = __builtin_amdgcn_permlane32_swap(__float_as_uint(tm), __float_as_uint(tm), false, false); tm = fmaxf(__uint_as_float(rr[0]), __uint_as_float(rr[1])); }
        if (first) {
            mrun = tm;
#pragma unroll
            for (int r = 0; r < 16; ++r) { p0[r] -= tm; p1[r] -= tm; negm[r] = -mrun; }
            first = false;
        } else if (__any(tm > THR)) {
            const float dl = fmaxf(tm, 0.f); mrun += dl; const float al = __builtin_amdgcn_exp2f(-dl); lrun *= al;
#pragma unroll
            for (int r = 0; r < 16; ++r) { p0[r] -= dl; p1[r] -= dl; negm[r] = -mrun; oT[0][r] *= al; oT[1][r] *= al; }
        }
        float rs = 0.f;
#pragma unroll
        for (int r = 0; r < 16; ++r) { p0[r] = __builtin_amdgcn_exp2f(p0[r]); p1[r] = __builtin_amdgcn_exp2f(p1[r]); rs += p0[r] + p1[r]; }
        lrun += rs;
        bf16x8 pf[4];
        { u32x4 w;
          w.x = cvtpk(p0[0], p0[1]); w.y = cvtpk(p0[2], p0[3]); w.z = cvtpk(p0[4], p0[5]); w.w = cvtpk(p0[6], p0[7]); pf[0] = __builtin_bit_cast(bf16x8, w);
          w.x = cvtpk(p0[8], p0[9]); w.y = cvtpk(p0[10], p0[11]); w.z = cvtpk(p0[12], p0[13]); w.w = cvtpk(p0[14], p0[15]); pf[1] = __builtin_bit_cast(bf16x8, w);
          w.x = cvtpk(p1[0], p1[1]); w.y = cvtpk(p1[2], p1[3]); w.z = cvtpk(p1[4], p1[5]); w.w = cvtpk(p1[6], p1[7]); pf[2] = __builtin_bit_cast(bf16x8, w);
          w.x = cvtpk(p1[8], p1[9]); w.y = cvtpk(p1[10], p1[11]); w.z = cvtpk(p1[12], p1[13]); w.w = cvtpk(p1[14], p1[15]); pf[3] = __builtin_bit_cast(bf16x8, w); }
        const LAS unsigned char* vb = lds + slot * SLOT + KB + vlane;
#pragma unroll
        for (int d0 = 0; d0 < 2; ++d0)
#pragma unroll
            for (int ks = 0; ks < 4; ++ks) {
                const s16x4 lo = vtr(vb + d0 * 4096 + ks * 1024), hh = vtr(vb + d0 * 4096 + ks * 1024 + 512);
                const bf16x8 vf = (bf16x8){lo[0], lo[1], lo[2], lo[3], hh[0], hh[1], hh[2], hh[3]};
                oT[d0] = __builtin_amdgcn_mfma_f32_32x32x16_bf16(vf, pf[ks], oT[d0], 0, 0, 0);
            }
        asm volatile("s_waitcnt vmcnt(0)" ::: "memory");
        __syncthreads();
    }
    { auto rr = __builtin_amdgcn_permlane32_swap(__float_as_uint(lrun), __float_as_uint(lrun), false, false); lrun = __uint_as_float(rr[0]) + __uint_as_float(rr[1]); }
    const float inv = 1.0f / lrun;
    bf16_t* orow = S.O + (size_t)(q0 + wid * 32 + r32) * S.opitch;
#pragma unroll
    for (int d0 = 0; d0 < 2; ++d0)
#pragma unroll
        for (int g = 0; g < 4; ++g) { u32x2 w; w.x = cvtpk(oT[d0][4 * g] * inv, oT[d0][4 * g + 1] * inv); w.y = cvtpk(oT[d0][4 * g + 2] * inv, oT[d0][4 * g + 3] * inv);
            *(u32x2*)(orow + 32 * d0 + 8 * g + 4 * hi) = w; }
}

__device__ __forceinline__ int sig5(int c) { return (c & ~12) | ((c & 8) >> 1) | ((c & 4) << 1); }

__global__ void __launch_bounds__(512, 2) mk_fwd(Args args) {
    extern __shared__ __attribute__((aligned(16))) unsigned char lds_raw[];
    Frame F;
    F.lds = (LAS unsigned char*)lds_raw; F.ws = args.ws;
    F.tid = threadIdx.x; F.lane = F.tid & 63; F.wave = __builtin_amdgcn_readfirstlane(F.tid >> 6);
    F.G = gridDim.x; { const int bx = blockIdx.x; F.vcu = (F.G % 8 == 0) ? (bx % 8) * (F.G / 8) + bx / 8 : bx; }
    volatile LAS unsigned* MISC = (volatile LAS unsigned*)(F.lds + LDSCTL_OFF);
    if (F.tid < 64) MISC[F.tid] = 0u;
    __syncthreads();
    unsigned* ctl = wsp<unsigned>(F, O_CTL);
#if MK_ONE_LAUNCH
    XcdBarrier bar = xcd_barrier_post(ctl + CW_BAR, MISC + 8);
#define GRID_BAR() xcd_barrier(bar)
#else
#define GRID_BAR() do {} while (0)
#endif
    const int lo = args.ph_lo, hi_ph = args.ph_hi;
#define IN(k) (lo <= (k) && (k) < hi_ph)
#define SEAM(k) do { if (IN(k) && IN((k) + 1)) GRID_BAR(); } while (0)
    const int lane = F.lane, wave = F.wave, tid = F.tid;
    const int gw = F.vcu * 8 + wave, NGW = F.G * 8;

    const float* x_in = args.in[I_X]; const float* ctx_in = args.in[I_CTX];
    float* MODV = wsp<float>(F, O_MODV);
    float* TAB16 = wsp<float>(F, O_TAB16); float* TAB32 = wsp<float>(F, O_TAB32);
    float* HC = wsp<float>(F, O_HC);
    bf16_t* U = wsp<bf16_t>(F, O_U);
    float* Y = wsp<float>(F, O_Y);
    const float* normg = args.in[I_NORMG];
#define MV(layer, bidx, k) (MODV + ((size_t)((layer) * 5 + (bidx)) * 6 + (k)) * D)

    if (IN(0)) for (int rep_ = 0; rep_ < ((0) == MK_REP ? 2 : 1); ++rep_) {
        if (rep_) __syncthreads();
        {
            LAS float* sc = (LAS float*)F.lds;
            LAS float* red = sc + 5 * 1024;
            for (int i = tid; i < 5 * 1024; i += 512) { const int b = i >> 10, k = i & 1023; const float cv = (b < 4) ? args.in[I_C][b * 1024 + k] : args.in[I_CCTX][k]; sc[i] = cv / (1.0f + __expf(-cv)); }
            __syncthreads();
            for (int unit = F.vcu; unit < 192; unit += F.G) {
                const int layer = unit / 96, cb = unit % 96, col = cb * 64 + lane;
                const float* W = args.in[I_MODW] + (size_t)layer * D * 6144 + col;
                float a0 = 0.f, a1 = 0.f, a2 = 0.f, a3 = 0.f, a4 = 0.f;
#pragma unroll 16
                for (int kk = 0; kk < 128; ++kk) { const int k = wave * 128 + kk; const float w = W[(size_t)k * 6144];
                    a0 += sc[k] * w; a1 += sc[1024 + k] * w; a2 += sc[2048 + k] * w; a3 += sc[3072 + k] * w; a4 += sc[4096 + k] * w; }
                red[(wave * 5 + 0) * 64 + lane] = a0; red[(wave * 5 + 1) * 64 + lane] = a1; red[(wave * 5 + 2) * 64 + lane] = a2; red[(wave * 5 + 3) * 64 + lane] = a3; red[(wave * 5 + 4) * 64 + lane] = a4;
                __syncthreads();
                if (tid < 320) { const int b = tid >> 6, cc = tid & 63; float s = 0.f;
#pragma unroll
                    for (int w = 0; w < 8; ++w) s += red[(w * 5 + b) * 64 + cc];
                    MODV[(size_t)(layer * 5 + b) * 6144 + cb * 64 + cc] = s + args.in[I_MODB][layer * 6144 + cb * 64 + cc]; }
                __syncthreads();
            }
        }
        if (blockIdx.x == 0) {
            for (int i = tid; i < 64 * 8; i += 512) { const int pos = i >> 3, f = i & 7; const float fr = powf(10000.0f, -(float)f / 8.0f), a = (float)pos * fr; TAB16[i] = cosf(a); TAB16[512 + i] = sinf(a); }
            for (int i = tid; i < 64 * 16; i += 512) { const int pos = i >> 4, f = i & 15; const float fr = powf(10000.0f, -(float)f / 16.0f), a = (float)pos * fr; TAB32[i] = cosf(a); TAB32[1024 + i] = sinf(a); }
        }
        {
            LAS float* scr = (LAS float*)(F.lds + wave * 16640);
            int base = 0;
            auto run = [&](const Conv& c) { const int n = (c.K / 64) * (c.Ndst / 32); for (int it = gw - base; it < n; it += NGW) { if (it >= 0) conv_item(c, it, scr, lane); }
                base = (base + n) % NGW; };
            auto run64 = [&](const Conv64& c) { const int n = (c.K / 64) * (c.Ndst / 64); for (int it = gw - base; it < n; it += NGW) { if (it >= 0) conv64_item(c, it, scr, lane); }
                base = (base + n) % NGW; };
            for (int e = 0; e < NEXP; ++e) {
                run64(Conv64{args.in[I_MWG] + (size_t)e * D * EXD, args.in[I_MWU] + (size_t)e * D * EXD, EXD, 1024, N_GU1, wsp<bf16_t>(F, O_WGU1) + (size_t)e * N_GU1 * 1024, 3, 0, 0, 1.0f});
                run64(Conv64{args.in[I_MWD] + (size_t)e * EXD * D, nullptr, 1024, EXD, 1024, wsp<bf16_t>(F, O_WD1) + (size_t)e * 1024 * EXD, 0, 1024, 0, 1.0f});
            }
            run64(Conv64{args.in[I_FWG], args.in[I_FWU], FFN, 1024, N_GU0, wsp<bf16_t>(F, O_WGU0), 3, 0, 0, 1.0f});
            run64(Conv64{args.in[I_FWD], nullptr, 1024, FFN, 1024, wsp<bf16_t>(F, O_WD0), 0, 1024, 0, 1.0f});
            run64(Conv64{args.in[I_GWIN], nullptr, 3104, 1024, N_IN1, wsp<bf16_t>(F, O_WIN1), 0, 3104, 512, 0.08838834764831845f});
            run64(Conv64{args.in[I_GWOUT], nullptr, 1024, 1024, 1024, wsp<bf16_t>(F, O_WOUT1), 0, 1024, 0, 1.0f});
            run64(Conv64{args.in[I_AWOUT], nullptr, 1024, 1024, 1024, wsp<bf16_t>(F, O_WOUT0), 0, 1024, 0, 1.0f});
            run(Conv{args.in[I_AWIN], nullptr, 1440, 1024, N_IN0, wsp<bf16_t>(F, O_WIN0), 1, nullptr});
            run(Conv{args.in[I_AWUQ], nullptr, 768, 384, N_QA, wsp<bf16_t>(F, O_WUQ), 2, args.in[I_AQN]});
            run(Conv{args.in[I_AWUKV], nullptr, 1024, 256, N_KVA, wsp<bf16_t>(F, O_WUKV), 0, args.in[I_AKVN]});
        }
    }
    SEAM(0);

    if (IN(1)) for (int rep_ = 0; rep_ < ((1) == MK_REP ? 2 : 1); ++rep_) {
        for (int row = gw; row < R; row += NGW) {
            const float* hp = row < RL ? x_in + (size_t)row * D : ctx_in + (size_t)(row - RL) * D;
            f32x4 h[4], uo[4]; load_row(hp, lane, h);
            const int b = row_bidx(row);
            norm_mod_store(h, normg + 0 * D, MV(0, b, 0), MV(0, b, 1), U + (size_t)row * D, lane, uo);
        }
    }
    SEAM(1);

    if (IN(2)) for (int rep_ = 0; rep_ < ((2) == MK_REP ? 2 : 1); ++rep_) {
        pg8::DenseProb P{U, wsp<bf16_t>(F, O_WIN0), 1024, 1024, 1024, {}}; P.ord.init(R / 256, N_IN0 / 256, F.G, (int)blockIdx.x);
        pg8::EpiBf16 E{wsp<bf16_t>(F, O_Z0), N_IN0, nullptr};
        pg8::gemm_phase(F.lds, P, E);
    }
    SEAM(2);

    if (IN(3)) for (int rep_ = 0; rep_ < ((3) == MK_REP ? 2 : 1); ++rep_) {
        const bf16_t* Z0 = wsp<bf16_t>(F, O_Z0);
        float* RSQ = wsp<float>(F, O_RSTDQ); float* RSKV = wsp<float>(F, O_RSTDKV);
        bf16_t* QB = wsp<bf16_t>(F, O_QB); bf16_t* KBp = wsp<bf16_t>(F, O_KB); bf16_t* KR = wsp<bf16_t>(F, O_KR);
        const float* qkn = args.in[I_AQKN];
        for (int row = gw; row < R; row += NGW) {
            const unsigned* z32 = (const unsigned*)(Z0 + (size_t)row * N_IN0);
            float s = 0.f;
#pragma unroll
            for (int j = 0; j < 3; ++j) { const unsigned w = z32[lane + 64 * j]; const float a = bflo(w), b = bfhi(w); s += a * a + b * b; }
            s = wave_sum(s);
            float s2 = 0.f;
#pragma unroll
            for (int j = 0; j < 2; ++j) { const unsigned w = z32[192 + lane + 64 * j]; const float a = bflo(w), b = bfhi(w); s2 += a * a + b * b; }
            s2 = wave_sum(s2);
            if (lane == 0) { RSQ[row] = __builtin_amdgcn_rsqf(s * (1.0f / 384.0f) + EPS); RSKV[row] = __builtin_amdgcn_rsqf(s2 * (1.0f / 256.0f) + EPS); }
            const bool lat = row < RL; const int tt = row & (SEQ - 1);
#pragma unroll
            for (int which = 0; which < 2; ++which) {
                if (which == 1 && lane >= 16) break;
                const u32x4 w4 = *(const u32x4*)(Z0 + (size_t)row * N_IN0 + (which ? 1152 : 640) + lane * 8);
                float v[8] = {bflo(w4.x), bfhi(w4.x), bflo(w4.y), bfhi(w4.y), bflo(w4.z), bfhi(w4.z), bflo(w4.w), bfhi(w4.w)};
                float ss = 0.f;
#pragma unroll
                for (int j = 0; j < 8; ++j) ss += v[j] * v[j];
                ss += __shfl_xor(ss, 1); ss += __shfl_xor(ss, 2); ss += __shfl_xor(ss, 4);
                const float rstd = __builtin_amdgcn_rsqf(ss * (1.0f / 64.0f) + EPS);
                const int jp = lane & 7, half = jp >> 2, i0 = 4 * (jp & 3);
                const float* gn = qkn + which * 64 + half * 32;
#pragma unroll
                for (int pz = 0; pz < 4; ++pz) { v[2 * pz] *= rstd * gn[i0 + pz]; v[2 * pz + 1] *= rstd * gn[16 + i0 + pz]; }
                if (lat) { const int pos = half ? (tt & 63) : (tt >> 6);
                    const f32x4 cs = *(const f32x4*)(TAB32 + pos * 16 + i0), sn = *(const f32x4*)(TAB32 + 1024 + pos * 16 + i0);
#pragma unroll
                    for (int pz = 0; pz < 4; ++pz) { const float a = v[2 * pz], b = v[2 * pz + 1]; v[2 * pz] = a * cs[pz] - b * sn[pz]; v[2 * pz + 1] = b * cs[pz] + a * sn[pz]; } }
                const float osc = which ? 1.0f : 0.125f * LOG2E;
                u32x4 o; o.x = cvtpk(v[0] * osc, v[1] * osc); o.y = cvtpk(v[2] * osc, v[3] * osc); o.z = cvtpk(v[4] * osc, v[5] * osc); o.w = cvtpk(v[6] * osc, v[7] * osc);
                if (which == 0) *(u32x4*)(QB + (size_t)row * 512 + lane * 8) = o; else *(u32x4*)(KBp + (size_t)row * 128 + lane * 8) = o;
            }
            if (lane < 4) {
                const u32x4 w4 = *(const u32x4*)(Z0 + (size_t)row * N_IN0 + 1408 + lane * 8);
                float v[8] = {bflo(w4.x), bfhi(w4.x), bflo(w4.y), bfhi(w4.y), bflo(w4.z), bfhi(w4.z), bflo(w4.w), bfhi(w4.w)};
                if (lat) { const int half = lane >> 1, i0 = 4 * (lane & 1); const int pos = half ? (tt & 63) : (tt >> 6);
                    const f32x4 cs = *(const f32x4*)(TAB16 + pos * 8 + i0), sn = *(const f32x4*)(TAB16 + 512 + pos * 8 + i0);
#pragma unroll
                    for (int pz = 0; pz < 4; ++pz) { const float a = v[2 * pz], b = v[2 * pz + 1]; v[2 * pz] = a * cs[pz] - b * sn[pz]; v[2 * pz + 1] = b * cs[pz] + a * sn[pz]; } }
                u32x4 o; o.x = cvtpk(v[0], v[1]); o.y = cvtpk(v[2], v[3]); o.z = cvtpk(v[4], v[5]); o.w = cvtpk(v[6], v[7]);
                *(u32x4*)(KR + (size_t)row * 32 + lane * 8) = o;
            }
        }
    }
    SEAM(3);

    if (IN(4)) for (int rep_ = 0; rep_ < ((4) == MK_REP ? 2 : 1); ++rep_) {
        { pg8::DenseProb P{wsp<bf16_t>(F, O_Z0), wsp<bf16_t>(F, O_WUQ), 384, N_IN0, 384, {}}; P.ord.init(R / 256, N_QA / 256, F.G, (int)blockIdx.x);
          pg8::EpiQA E{wsp<bf16_t>(F, O_QA), wsp<float>(F, O_RSTDQ), TAB16, 0.10206207261596577f * LOG2E};
          pg8::gemm_phase(F.lds, P, E); }
        { pg8::DenseProb P{wsp<bf16_t>(F, O_Z0) + 384, wsp<bf16_t>(F, O_WUKV), 256, N_IN0, 256, {}}; P.ord.init(R / 256, N_KVA / 256, F.G, (int)((blockIdx.x + F.G - (204 % F.G)) % F.G));
          pg8::EpiBf16 E{wsp<bf16_t>(F, O_KVA), N_KVA, wsp<float>(F, O_RSTDKV)};
          pg8::gemm_phase(F.lds, P, E); }
    }
    SEAM(4);

    if (IN(5)) for (int rep_ = 0; rep_ < ((5) == MK_REP ? 2 : 1); ++rep_) {
        const bf16_t* QA = wsp<bf16_t>(F, O_QA); const bf16_t* KVA = wsp<bf16_t>(F, O_KVA); const bf16_t* QB = wsp<bf16_t>(F, O_QB);
        const bf16_t* KBp = wsp<bf16_t>(F, O_KB); const bf16_t* KR = wsp<bf16_t>(F, O_KR); const bf16_t* Z0 = wsp<bf16_t>(F, O_Z0);
        bf16_t* AO = wsp<bf16_t>(F, O_AO);
        for (int i = 0; i < 5; ++i) {
            int typ, b, hh, q0, kt0, kt1;
            if (i < 4) { const int m = (i & 1) * 256 + F.vcu; if (F.vcu >= 256) break; typ = i >> 1; b = m >> 7; hh = (m >> 4) & 7; q0 = b * SEQ + (m & 15) * 256; kt0 = 0; kt1 = 68; }
            else { if (F.vcu >= 64) break; typ = F.vcu >> 5; b = (F.vcu >> 3) & 3; hh = F.vcu & 7; q0 = RL + b * CTX; kt0 = 64; kt1 = 68; }
            const int lat0 = b * SEQ, ctx0 = RL + b * CTX;
            if (typ == 0) { AttnSrc<96> S{QA + hh * 64, N_QA, QA + 512 + hh * 32, KVA + hh * 128, N_KVA, KR, 32, KVA + hh * 128 + 64, N_KVA, AO + hh * 64, D};
                attn_unit<96>(F, S, q0, lat0, ctx0, kt0, kt1); }
            else { const int kvh = hh >> 2; AttnSrc<64> S{QB + hh * 64, 512, nullptr, KBp + kvh * 64, 128, nullptr, 0, Z0 + 1280 + kvh * 64, N_IN0, AO + 512 + hh * 64, D};
                attn_unit<64>(F, S, q0, lat0, ctx0, kt0, kt1); }
        }
    }
    SEAM(5);

    if (IN(6)) for (int rep_ = 0; rep_ < ((6) == MK_REP ? 2 : 1); ++rep_) {
        pg8::DenseProb P{wsp<bf16_t>(F, O_AO), wsp<bf16_t>(F, O_WOUT0), 1024, 1024, 1024, {}}; P.ord.init(R / 256, 4, F.G, (int)blockIdx.x);
        pg8::EpiF32 E{Y, D};
        pg8::gemm_phase(F.lds, P, E);
    }
    SEAM(6);

    if (IN(7)) for (int rep_ = 0; rep_ < ((7) == MK_REP ? 2 : 1); ++rep_) {
        for (int row = gw; row < R; row += NGW) {
            const float* hp = row < RL ? x_in + (size_t)row * D : ctx_in + (size_t)(row - RL) * D;
            float* ho = row < RL ? args.out + (size_t)row * D : HC + (size_t)(row - RL) * D;
            const int b = row_bidx(row);
            f32x4 y[4], h[4], uo[4]; load_row(Y + (size_t)row * D, lane, y); load_row(hp, lane, h);
            const float rstd = __builtin_amdgcn_rsqf(row_ssq(y) * (1.0f / D) + EPS);
#pragma unroll
            for (int j = 0; j < 4; ++j) { const int c = 4 * lane + 256 * j; const f32x4 g = *(const f32x4*)(normg + 1 * D + c), mg = *(const f32x4*)(MV(0, b, 2) + c);
                h[j] = h[j] + mg * (y[j] * rstd * g); *(f32x4*)(ho + c) = h[j]; }
            norm_mod_store(h, normg + 2 * D, MV(0, b, 3), MV(0, b, 4), U + (size_t)row * D, lane, uo);
        }
    }
    SEAM(7);

    if (IN(8)) for (int rep_ = 0; rep_ < ((8) == MK_REP ? 2 : 1); ++rep_) {
        pg8::DenseProb P{U, wsp<bf16_t>(F, O_WGU0), 1024, 1024, 1024, {}}; P.ord.init(R / 256, N_GU0 / 256, F.G, (int)blockIdx.x);
        pg8::EpiSwiglu E{wsp<bf16_t>(F, O_H0), FFN};
        pg8::gemm_phase(F.lds, P, E);
    }
    SEAM(8);
    if (IN(9)) for (int rep_ = 0; rep_ < ((9) == MK_REP ? 2 : 1); ++rep_) {
        pg8::DenseProb P{wsp<bf16_t>(F, O_H0), wsp<bf16_t>(F, O_WD0), FFN, FFN, FFN, {}}; P.ord.init(R / 256, 4, F.G, (int)blockIdx.x);
        pg8::EpiF32 E{Y, D};
        pg8::gemm_phase(F.lds, P, E);
    }
    SEAM(9);

    if (IN(10)) for (int rep_ = 0; rep_ < ((10) == MK_REP ? 2 : 1); ++rep_) {
        for (int row = gw; row < R; row += NGW) {
            float* hp = row < RL ? args.out + (size_t)row * D : HC + (size_t)(row - RL) * D;
            const int b = row_bidx(row);
            f32x4 y[4], h[4], uo[4]; load_row(Y + (size_t)row * D, lane, y); load_row(hp, lane, h);
            const float rstd = __builtin_amdgcn_rsqf(row_ssq(y) * (1.0f / D) + EPS);
#pragma unroll
            for (int j = 0; j < 4; ++j) { const int c = 4 * lane + 256 * j; const f32x4 g = *(const f32x4*)(normg + 3 * D + c), mg = *(const f32x4*)(MV(0, b, 5) + c);
                h[j] = h[j] + mg * (y[j] * rstd * g); *(f32x4*)(hp + c) = h[j]; }
            norm_mod_store(h, normg + 4 * D, MV(1, b, 0), MV(1, b, 1), U + (size_t)row * D, lane, uo);
        }
    }
    SEAM(10);

    if (IN(11)) for (int rep_ = 0; rep_ < ((11) == MK_REP ? 2 : 1); ++rep_) {
        pg8::DenseProb P{U, wsp<bf16_t>(F, O_WIN1), 1024, 1024, 1024, {}}; P.ord.init(R / 256, N_IN1 / 256, F.G, (int)blockIdx.x);
        pg8::EpiIn1 E{wsp<bf16_t>(F, O_QK1), wsp<bf16_t>(F, O_V1), wsp<bf16_t>(F, O_G1), wsp<bf16_t>(F, O_RR)};
        pg8::gemm_phase(F.lds, P, E);
    }
    SEAM(11);

    if (IN(12)) for (int rep_ = 0; rep_ < ((12) == MK_REP ? 2 : 1); ++rep_) {
        const bf16_t* QK1 = wsp<bf16_t>(F, O_QK1); const bf16_t* V1 = wsp<bf16_t>(F, O_V1); const bf16_t* RRp = wsp<bf16_t>(F, O_RR);
        bf16_t* QDd[2] = {wsp<bf16_t>(F, O_QDF), wsp<bf16_t>(F, O_QDB)}; bf16_t* KId[2] = {wsp<bf16_t>(F, O_KIF), wsp<bf16_t>(F, O_KIB)}; bf16_t* KTd[2] = {wsp<bf16_t>(F, O_KTF), wsp<bf16_t>(F, O_KTB)};
        bf16_t* VT = wsp<bf16_t>(F, O_VT); float* ECL = wsp<float>(F, O_ECL);
        LAS float* tot = (LAS float*)F.lds;
        const int dk = tid & 127, tq = tid >> 7;
        for (int item = F.vcu; item < 544 * 4; item += F.G) {
            const int rc = item >> 2, hh = item & 3, row0 = rc * 32;
            float w2[2][16], bg[2];
#pragma unroll
            for (int d = 0; d < 2; ++d) { bg[d] = args.in[I_GBGATE][d * 512 + hh * 128 + dk];
#pragma unroll
                for (int j = 0; j < 16; ++j) w2[d][j] = args.in[I_GGATE2][(size_t)(d * 16 + j) * 512 + hh * 128 + dk]; }
            float a[2][8];
#pragma unroll
            for (int i = 0; i < 8; ++i) { const int row = row0 + 8 * tq + i;
                const u32x4* rp = (const u32x4*)(RRp + (size_t)row * 256);
#pragma unroll
                for (int d = 0; d < 2; ++d) { const u32x4 r0 = rp[2 * d], r1 = rp[2 * d + 1];
                    const float rv[16] = {bflo(r0.x), bfhi(r0.x), bflo(r0.y), bfhi(r0.y), bflo(r0.z), bfhi(r0.z), bflo(r0.w), bfhi(r0.w), bflo(r1.x), bfhi(r1.x), bflo(r1.y), bfhi(r1.y), bflo(r1.z), bfhi(r1.z), bflo(r1.w), bfhi(r1.w)};
                    float z = bg[d];
#pragma unroll
                    for (int j = 0; j < 16; ++j) z += rv[j] * w2[d][j];
                    a[d][i] = (fminf(z, 0.f) - __logf(1.0f + __expf(-fabsf(z)))) * (1.0f / 16.0f); } }
            float cf[8], sb[8];
            { float s = 0.f;
#pragma unroll
              for (int i = 0; i < 8; ++i) { s += a[0][i]; cf[i] = s; }
              s = 0.f;
#pragma unroll
              for (int i = 7; i >= 0; --i) { s += a[1][i]; sb[i] = s; } }
            tot[(0 * 4 + tq) * 128 + dk] = cf[7]; tot[(1 * 4 + tq) * 128 + dk] = sb[0];
            __syncthreads();
            float offF = 0.f, offB = 0.f, clF = 0.f, clB = 0.f;
#pragma unroll
            for (int g = 0; g < 4; ++g) { const float tf = tot[(0 * 4 + g) * 128 + dk], tb = tot[(1 * 4 + g) * 128 + dk]; clF += tf; clB += tb; if (g < tq) offF += tf; if (g > tq) offB += tb; }
            __syncthreads();
            const int pc = hh * 128 + (dk & ~31) + sig5(dk & 31);
            unsigned ktw[2][4];
#pragma unroll
            for (int i = 0; i < 8; ++i) { const int row = row0 + 8 * tq + i;
                const float q = bf2f(QK1[(size_t)row * D + hh * 128 + dk]), k = bf2f(QK1[(size_t)row * D + 512 + hh * 128 + dk]);
                const float cF = offF + cf[i], cB = offB + sb[i];
                const float kiF = k * __expf(-cF), kiB = k * __expf(-cB);
                QDd[0][(size_t)row * 512 + pc] = f2bf(q * __expf(cF)); KId[0][(size_t)row * 512 + pc] = f2bf(kiF);
                QDd[1][(size_t)row * 512 + pc] = f2bf(q * __expf(cB)); KId[1][(size_t)row * 512 + pc] = f2bf(kiB);
                const unsigned bF = f2bf(kiF), bB = f2bf(kiB);
                if (i & 1) { ktw[0][i >> 1] |= bF << 16; ktw[1][i >> 1] |= bB << 16; } else { ktw[0][i >> 1] = bF; ktw[1][i >> 1] = bB; } }
#pragma unroll
            for (int d = 0; d < 2; ++d) { bf16_t* kt = KTd[d] + ((size_t)(rc * 4 + hh) * 128 + dk) * 32 + 16 * (tq >> 1) + 4 * (tq & 1);
                u32x2 w0; w0.x = ktw[d][0]; w0.y = ktw[d][1]; *(u32x2*)kt = w0; u32x2 w1; w1.x = ktw[d][2]; w1.y = ktw[d][3]; *(u32x2*)(kt + 8) = w1; }
            if (tq == 0) { ECL[((size_t)(rc * 2 + 0) * 4 + hh) * 256 + dk] = __expf(clF); ECL[((size_t)(rc * 2 + 1) * 4 + hh) * 256 + dk] = __expf(clB); }
            { const int dv = tid & 255, th = tid >> 8; unsigned vw[8];
#pragma unroll
              for (int i = 0; i < 16; ++i) { const unsigned bv = V1[(size_t)(row0 + 16 * th + i) * D + hh * 256 + dv];
                  const int cc = sig5(i);
                  if (cc & 1) vw[cc >> 1] |= bv << 16; else vw[cc >> 1] = bv; }
              bf16_t* vp = VT + ((size_t)rc * 1024 + hh * 256 + dv) * 32 + 16 * th;
              u32x4 o0; o0.x = vw[0]; o0.y = vw[1]; o0.z = vw[2]; o0.w = vw[3]; *(u32x4*)vp = o0;
              u32x4 o1; o1.x = vw[4]; o1.y = vw[5]; o1.z = vw[6]; o1.w = vw[7]; *(u32x4*)(vp + 8) = o1; }
        }
    }
    SEAM(12);

    if (IN(13)) for (int rep_ = 0; rep_ < ((13) == MK_REP ? 2 : 1); ++rep_) {
        const bf16_t* VT = wsp<bf16_t>(F, O_VT); const float* ECL = wsp<float>(F, O_ECL);
        constexpr int SLOT = 8192 * 3 + 2048 + 1024;
        const int r32 = lane & 31, hi = lane >> 5;
        for (int unit = F.vcu; unit < 256; unit += F.G) {
            const int chain = unit >> 3, dvb = unit & 7, b = chain >> 3, hh = (chain >> 1) & 3, dir = chain & 1;
            const bf16_t* QDp = wsp<bf16_t>(F, dir ? O_QDB : O_QDF); const bf16_t* KIp = wsp<bf16_t>(F, dir ? O_KIB : O_KIF); const bf16_t* KTp = wsp<bf16_t>(F, dir ? O_KTB : O_KTF);
            bf16_t* Odp = wsp<bf16_t>(F, dir ? O_OB : O_OF);
            auto rcof = [&](int step) { return step < 8 ? 512 + b * 8 + (dir ? 7 - step : step) : b * 128 + (dir ? 127 - (step - 8) : (step - 8)); };
            auto dma = [&](int step, int slot) {
                const int rc = rcof(step); LAS unsigned char* sb = F.lds + slot * SLOT;
                const int ch = lane >> 5, rw = lane & 31;
                __builtin_amdgcn_global_load_lds((const unsigned*)(KIp + (size_t)(rc * 32 + rw) * 512 + hh * 128 + (2 * wave + ch) * 8), (LAS unsigned*)(sb + wave * 1024), 16, 0, 0);
                __builtin_amdgcn_global_load_lds((const unsigned*)(QDp + (size_t)(rc * 32 + rw) * 512 + hh * 128 + (2 * wave + ch) * 8), (LAS unsigned*)(sb + 8192 + wave * 1024), 16, 0, 0);
                __builtin_amdgcn_global_load_lds((const unsigned*)(KTp + ((size_t)(rc * 4 + hh) * 128 + 32 * (wave >> 1) + rw) * 32 + (2 * (wave & 1) + ch) * 8), (LAS unsigned*)(sb + 16384 + wave * 1024), 16, 0, 0);
                if (wave < 2) __builtin_amdgcn_global_load_lds((const unsigned*)(VT + ((size_t)rc * 1024 + hh * 256 + dvb * 32 + rw) * 32 + (2 * wave + ch) * 8), (LAS unsigned*)(sb + 24576 + wave * 1024), 16, 0, 0);
                if (wave == 2) __builtin_amdgcn_global_load_lds((const unsigned*)(ECL + ((size_t)(rc * 2 + dir) * 4 + hh) * 256 + lane * 4), (LAS unsigned*)(sb + 26624), 16, 0, 0);
            };
            f32x16 S4[4];
#pragma unroll
            for (int k = 0; k < 4; ++k)
#pragma unroll
                for (int r = 0; r < 16; ++r) S4[k][r] = 0.f;
            dma(0, 0);
            asm volatile("s_waitcnt vmcnt(0)" ::: "memory");
            __syncthreads();
            for (int step = 0; step < 136; ++step) {
                const int slot = step & 1;
                if (step + 1 < 136) dma(step + 1, slot ^ 1);
                if (wave == 0) {
                    const LAS unsigned char* sb = F.lds + slot * SLOT;
                    const int fo = hi * 512 + r32 * 16;
                    bf16x8 qdF[8];
#pragma unroll
                    for (int k = 0; k < 8; ++k) qdF[k] = *(const LAS bf16x8*)(sb + 8192 + k * 1024 + fo);
                    const bf16x8 vF0 = *(const LAS bf16x8*)(sb + 24576 + fo), vF1 = *(const LAS bf16x8*)(sb + 24576 + 1024 + fo);
                    f32x16 o;
#pragma unroll
                    for (int r = 0; r < 16; ++r) o[r] = 0.f;
                    if (step >= 8) {
                        f32x16 sc;
#pragma unroll
                        for (int r = 0; r < 16; ++r) sc[r] = 0.f;
#pragma unroll
                        for (int k = 0; k < 8; ++k) { const bf16x8 kiF = *(const LAS bf16x8*)(sb + k * 1024 + fo); sc = __builtin_amdgcn_mfma_f32_32x32x16_bf16(kiF, qdF[k], sc, 0, 0, 0); }
#pragma unroll
                        for (int r = 0; r < 16; ++r) { const int s = (r & 3) + 8 * (r >> 2) + 4 * hi; const bool keep = dir ? (s >= r32) : (s <= r32); sc[r] = keep ? sc[r] : 0.f; }
                        u32x4 w; bf16x8 pf0, pf1;
                        w.x = cvtpk(sc[0], sc[1]); w.y = cvtpk(sc[2], sc[3]); w.z = cvtpk(sc[4], sc[5]); w.w = cvtpk(sc[6], sc[7]); pf0 = __builtin_bit_cast(bf16x8, w);
                        w.x = cvtpk(sc[8], sc[9]); w.y = cvtpk(sc[10], sc[11]); w.z = cvtpk(sc[12], sc[13]); w.w = cvtpk(sc[14], sc[15]); pf1 = __builtin_bit_cast(bf16x8, w);
                        o = __builtin_amdgcn_mfma_f32_32x32x16_bf16(pf0, vF0, o, 0, 0, 0);
                        o = __builtin_amdgcn_mfma_f32_32x32x16_bf16(pf1, vF1, o, 0, 0, 0);
#pragma unroll
                        for (int blk = 0; blk < 4; ++blk)
#pragma unroll
                            for (int s2 = 0; s2 < 2; ++s2) { u32x4 ws4; ws4.x = cvtpk(S4[blk][8 * s2], S4[blk][8 * s2 + 1]); ws4.y = cvtpk(S4[blk][8 * s2 + 2], S4[blk][8 * s2 + 3]);
                                ws4.z = cvtpk(S4[blk][8 * s2 + 4], S4[blk][8 * s2 + 5]); ws4.w = cvtpk(S4[blk][8 * s2 + 6], S4[blk][8 * s2 + 7]);
                                o = __builtin_amdgcn_mfma_f32_32x32x16_bf16(qdF[2 * blk + s2], __builtin_bit_cast(bf16x8, ws4), o, 0, 0, 0); }
                        const int rc = rcof(step);
                        bf16_t* op = Odp + (size_t)(rc * 32) * D + hh * 256 + dvb * 32 + r32;
#pragma unroll
                        for (int r = 0; r < 16; ++r) { const int t = (r & 3) + 8 * (r >> 2) + 4 * hi; op[(size_t)t * D] = f2bf(o[r]); }
                    }
#pragma unroll
                    for (int blk = 0; blk < 4; ++blk) {
                        const bf16x8 kt0 = *(const LAS bf16x8*)(sb + 16384 + blk * 2048 + fo), kt1 = *(const LAS bf16x8*)(sb + 16384 + blk * 2048 + 1024 + fo);
                        S4[blk] = __builtin_amdgcn_mfma_f32_32x32x16_bf16(kt0, vF0, S4[blk], 0, 0, 0);
                        S4[blk] = __builtin_amdgcn_mfma_f32_32x32x16_bf16(kt1, vF1, S4[blk], 0, 0, 0);
#pragma unroll
                        for (int g = 0; g < 4; ++g) { const f32x4 e4 = *(const LAS f32x4*)(sb + 26624 + (32 * blk + 8 * g + 4 * hi) * 4);
                            S4[blk][4 * g] *= e4[0]; S4[blk][4 * g + 1] *= e4[1]; S4[blk][4 * g + 2] *= e4[2]; S4[blk][4 * g + 3] *= e4[3]; }
                    }
                }
                asm volatile("s_waitcnt vmcnt(0)" ::: "memory");
                __syncthreads();
            }
        }
    }
    SEAM(13);

    if (IN(14)) for (int rep_ = 0; rep_ < ((14) == MK_REP ? 2 : 1); ++rep_) {
        const bf16_t* OFp = wsp<bf16_t>(F, O_OF); const bf16_t* OBp = wsp<bf16_t>(F, O_OB); const bf16_t* G1 = wsp<bf16_t>(F, O_G1); bf16_t* GA = wsp<bf16_t>(F, O_GA);
        const float* on = args.in[I_GONORM];
        for (int row = gw; row < RL; row += NGW) {
            const u32x4* pf = (const u32x4*)(OFp + (size_t)row * D + lane * 16); const u32x4* pb = (const u32x4*)(OBp + (size_t)row * D + lane * 16); const u32x4* pg = (const u32x4*)(G1 + (size_t)row * D + lane * 16);
            float v[16], gv[16];
#pragma unroll
            for (int q = 0; q < 2; ++q) { const u32x4 a = pf[q], bq = pb[q], gq = pg[q]; const unsigned aw[4] = {a.x, a.y, a.z, a.w}, bw[4] = {bq.x, bq.y, bq.z, bq.w}, gw4[4] = {gq.x, gq.y, gq.z, gq.w};
#pragma unroll
                for (int j = 0; j < 4; ++j) { v[8 * q + 2 * j] = bflo(aw[j]) + bflo(bw[j]); v[8 * q + 2 * j + 1] = bfhi(aw[j]) + bfhi(bw[j]); gv[8 * q + 2 * j] = bflo(gw4[j]); gv[8 * q + 2 * j + 1] = bfhi(gw4[j]); } }
            float ss = 0.f;
#pragma unroll
            for (int j = 0; j < 16; ++j) ss += v[j] * v[j];
            ss += __shfl_xor(ss, 1); ss += __shfl_xor(ss, 2); ss += __shfl_xor(ss, 4); ss += __shfl_xor(ss, 8);
            const float rstd = __builtin_amdgcn_rsqf(ss * (1.0f / 256.0f) + EPS);
            const int c0 = (lane & 15) * 16;
            unsigned ow[8];
#pragma unroll
            for (int j = 0; j < 8; ++j) { const float a = v[2 * j] * rstd * on[c0 + 2 * j] * silu_f(gv[2 * j]), bq = v[2 * j + 1] * rstd * on[c0 + 2 * j + 1] * silu_f(gv[2 * j + 1]); ow[j] = cvtpk(a, bq); }
            u32x4* po = (u32x4*)(GA + (size_t)row * D + lane * 16);
            u32x4 o0; o0.x = ow[0]; o0.y = ow[1]; o0.z = ow[2]; o0.w = ow[3]; po[0] = o0; u32x4 o1; o1.x = ow[4]; o1.y = ow[5]; o1.z = ow[6]; o1.w = ow[7]; po[1] = o1;
        }
    }
    SEAM(14);

    if (IN(15)) for (int rep_ = 0; rep_ < ((15) == MK_REP ? 2 : 1); ++rep_) {
        pg8::DenseProb P{wsp<bf16_t>(F, O_GA), wsp<bf16_t>(F, O_WOUT1), 1024, 1024, 1024, {}}; P.ord.init(RL / 256, 4, F.G, (int)blockIdx.x);
        pg8::EpiF32 E{Y, D};
        pg8::gemm_phase(F.lds, P, E);
    }
    SEAM(15);

    if (IN(16)) for (int rep_ = 0; rep_ < ((16) == MK_REP ? 2 : 1); ++rep_) {
        int* SEL = wsp<int>(F, O_SEL); int* ROWTOK = wsp<int>(F, O_ROWTOK);
        LAS float* wr_l = (LAS float*)F.lds;
        LAS int* se = (LAS int*)(F.lds + 32768);
        LAS float* sw = (LAS float*)(F.lds + 32768 + 512);
        LAS int* sbase = (LAS int*)(F.lds + 32768 + 1024);
        for (int i = tid; i < 8192; i += 512) wr_l[i] = args.in[I_MROUTER][i];
        __syncthreads();
        for (int tile = F.vcu; tile < RL / 64; tile += F.G) {
            for (int rr = 0; rr < 8; ++rr) {
                const int lr = wave * 8 + rr, row = tile * 64 + lr; const int b = row >> 12;
                float* hp = args.out + (size_t)row * D;
                f32x4 y[4], h[4], uo[4]; load_row(Y + (size_t)row * D, lane, y); load_row(hp, lane, h);
                const float rstd = __builtin_amdgcn_rsqf(row_ssq(y) * (1.0f / D) + EPS);
#pragma unroll
                for (int j = 0; j < 4; ++j) { const int c = 4 * lane + 256 * j; const f32x4 g = *(const f32x4*)(normg + 5 * D + c), mg = *(const f32x4*)(MV(1, b, 2) + c);
                    h[j] = h[j] + mg * (y[j] * rstd * g); *(f32x4*)(hp + c) = h[j]; }
                norm_mod_store(h, normg + 6 * D, MV(1, b, 3), MV(1, b, 4), U + (size_t)row * D, lane, uo);
                float lg[8];
#pragma unroll
                for (int e = 0; e < 8; ++e) lg[e] = 0.f;
#pragma unroll
                for (int j = 0; j < 4; ++j)
#pragma unroll
                    for (int q = 0; q < 4; ++q) { const int k = 4 * lane + 256 * j + q; const LAS f32x4* wp = (const LAS f32x4*)(wr_l + k * 8); const f32x4 w0 = wp[0], w1 = wp[1]; const float uv = uo[j][q];
                        lg[0] += uv * w0[0]; lg[1] += uv * w0[1]; lg[2] += uv * w0[2]; lg[3] += uv * w0[3]; lg[4] += uv * w1[0]; lg[5] += uv * w1[1]; lg[6] += uv * w1[2]; lg[7] += uv * w1[3]; }
#pragma unroll
                for (int e = 0; e < 8; ++e) lg[e] = wave_sum(lg[e]) + args.in[I_MBROUTER][e];
                int e0 = 0; float l0 = lg[0];
#pragma unroll
                for (int e = 1; e < 8; ++e) if (lg[e] > l0) { l0 = lg[e]; e0 = e; }
                int e1 = -1; float l1 = -3.0e38f;
#pragma unroll
                for (int e = 0; e < 8; ++e) if (e != e0 && lg[e] > l1) { l1 = lg[e]; e1 = e; }
                const float p1 = __expf(l1 - l0), w0n = 1.0f / (1.0f + p1), w1n = p1 / (1.0f + p1);
                if (lane == 0) { se[lr * 2] = e0; se[lr * 2 + 1] = e1; sw[lr * 2] = w0n; sw[lr * 2 + 1] = w1n; }
            }
            __syncthreads();
            if (tid < 8) { int c = 0; for (int r2 = 0; r2 < 64; ++r2) c += (se[2 * r2] == tid) + (se[2 * r2 + 1] == tid);
                sbase[tid] = (int)__hip_atomic_fetch_add(ctl + CW_CNT + 64 * tid, (unsigned)c, RLX_AGENT); }
            __syncthreads();
            if (tid < 64) { const int e0 = se[2 * tid], e1 = se[2 * tid + 1]; int r0 = 0, r1 = 0;
                for (int r2 = 0; r2 < tid; ++r2) { const int a0 = se[2 * r2], a1 = se[2 * r2 + 1]; r0 += (a0 == e0) + (a1 == e0); r1 += (a0 == e1) + (a1 == e1); }
                const int p0 = sbase[e0] + r0, p1 = sbase[e1] + r1, tok = tile * 64 + tid;
                ROWTOK[e0 * CAPE + p0] = tok; ROWTOK[e1 * CAPE + p1] = tok;
                int* sp = SEL + (size_t)tok * 8; sp[0] = e0; sp[1] = p0; sp[2] = e1; sp[3] = p1; sp[4] = __float_as_int(sw[2 * tid]); sp[5] = __float_as_int(sw[2 * tid + 1]); }
            __syncthreads();
        }
    }
    SEAM(16);

    pg8::MoeTiles MT;
    if (IN(17) || IN(18) || IN(19)) {
        int acc = 0; MT.tp8 = 0ull; MT.c4a = 0ull; MT.c4b = 0ull;
#pragma unroll
        for (int e = 0; e < 8; ++e) { const int c = (int)__builtin_amdgcn_readfirstlane((int)__hip_atomic_load(ctl + CW_CNT + 64 * e, RLX_AGENT));
            if (e < 4) MT.c4a |= (unsigned long long)(unsigned)c << (16 * e); else MT.c4b |= (unsigned long long)(unsigned)c << (16 * (e - 4));
            MT.tp8 |= (unsigned long long)(unsigned)acc << (8 * e); acc += (c + 255) >> 8; }
        MT.nt = acc;
    }
    if (IN(17)) for (int rep_ = 0; rep_ < ((17) == MK_REP ? 2 : 1); ++rep_) {
        pg8::MoeGuProb P{U, wsp<bf16_t>(F, O_WGU1), 1024, 1024, 1024, {}, MT, wsp<int>(F, O_ROWTOK)}; P.ord.init(MT.nt, N_GU1 / 256, F.G, (int)blockIdx.x);
        pg8::EpiSwiglu E{wsp<bf16_t>(F, O_HM), EXD};
        pg8::gemm_phase(F.lds, P, E);
    }
    SEAM(17);
    if (IN(18)) for (int rep_ = 0; rep_ < ((18) == MK_REP ? 2 : 1); ++rep_) {
        pg8::MoeDnProb P{wsp<bf16_t>(F, O_HM), wsp<bf16_t>(F, O_WD1), EXD, EXD, EXD, {}, MT}; P.ord.init(MT.nt, 4, F.G, (int)blockIdx.x);
        pg8::EpiBf16 E{wsp<bf16_t>(F, O_YE), D, nullptr};
        pg8::gemm_phase(F.lds, P, E);
    }
    SEAM(18);
    if (IN(19)) for (int rep_ = 0; rep_ < ((19) == MK_REP ? 2 : 1); ++rep_) {
        const int* SEL = wsp<int>(F, O_SEL); const bf16_t* YE = wsp<bf16_t>(F, O_YE);
        for (int row = gw; row < RL; row += NGW) {
            const int b = row >> 12; const int* sp = SEL + (size_t)row * 8;
            const int e0 = sp[0], p0 = sp[1], e1 = sp[2], p1 = sp[3]; const float w0 = __int_as_float(sp[4]), w1 = __int_as_float(sp[5]);
            const int t0 = pg8::moe_tp(MT, e0), t1 = pg8::moe_tp(MT, e1);
            const bf16_t* y0 = YE + ((size_t)t0 * 256 + p0) * D; const bf16_t* y1 = YE + ((size_t)t1 * 256 + p1) * D;
            float* hp = args.out + (size_t)row * D;
            f32x4 y[4], h[4]; load_row(hp, lane, h);
#pragma unroll
            for (int j = 0; j < 4; ++j) { const int c = 4 * lane + 256 * j; const u32x2 a = *(const u32x2*)(y0 + c), bq = *(const u32x2*)(y1 + c);
                y[j][0] = w0 * bflo(a.x) + w1 * bflo(bq.x); y[j][1] = w0 * bfhi(a.x) + w1 * bfhi(bq.x); y[j][2] = w0 * bflo(a.y) + w1 * bflo(bq.y); y[j][3] = w0 * bfhi(a.y) + w1 * bfhi(bq.y); }
            const float rstd = __builtin_amdgcn_rsqf(row_ssq(y) * (1.0f / D) + EPS);
#pragma unroll
            for (int j = 0; j < 4; ++j) { const int c = 4 * lane + 256 * j; const f32x4 g = *(const f32x4*)(normg + 7 * D + c), mg = *(const f32x4*)(MV(1, b, 5) + c);
                *(f32x4*)(hp + c) = h[j] + mg * (y[j] * rstd * g); }
        }
    }
#undef IN
#undef SEAM
#undef MV
}

constexpr int N_PHASES = 20;
extern "C" void kernel_launch(void* const* d_in, const int* in_sizes, int n_in, void* d_out, int out_size, void* d_ws, size_t ws_size, hipStream_t stream) {
    static int grid = 0;
    if (grid == 0) {
        if (n_in != 27 || out_size != RL * D || ws_size < WS_END) { fprintf(stderr, "kernel_launch: unexpected shapes n_in %d out %d ws %zu (need %zu)\n", n_in, out_size, ws_size, (size_t)WS_END); grid = -1; return; }
        int dev = 0, cus = 0, per_cu = 0;
        if (hipGetDevice(&dev) != hipSuccess || hipDeviceGetAttribute(&cus, hipDeviceAttributeMultiprocessorCount, dev) != hipSuccess) { grid = -1; return; }
        if (hipFuncSetAttribute((const void*)mk_fwd, hipFuncAttributeMaxDynamicSharedMemorySize, LDS_BYTES) != hipSuccess) { fprintf(stderr, "kernel_launch: hipFuncSetAttribute failed\n"); grid = -1; return; }
        if (hipOccupancyMaxActiveBlocksPerMultiprocessor(&per_cu, (const void*)mk_fwd, 512, LDS_BYTES) != hipSuccess || per_cu < 1) { fprintf(stderr, "kernel_launch: occupancy query says %d\n", per_cu); }
        (void)hipGetLastError();
        grid = cus;
        if (grid > 256) grid = 256;
    }
    if (grid < 0) return;
    (void)hipMemsetAsync((char*)d_ws + O_CTL, 0, CTL_BYTES, stream);
    Args a{};
    for (int i = 0; i < 27; ++i) a.in[i] = (const float*)d_in[i];
    a.out = (float*)d_out; a.ws = (unsigned char*)d_ws;
#if MK_ONE_LAUNCH
    a.ph_lo = 0; a.ph_hi = N_PHASES;
    hipLaunchKernelGGL(mk_fwd, dim3(grid), dim3(512), LDS_BYTES, stream, a);
#else
    for (int p = 0; p < N_PHASES; ++p) { a.ph_lo = p; a.ph_hi = p + 1; hipLaunchKernelGGL(mk_fwd, dim3(grid), dim3(512), LDS_BYTES, stream, a); }
#endif
}
```

```cpp
#include <hip/hip_runtime.h>
#include <cstdio>
#include <cstdint>

#ifndef MK_ONE_LAUNCH
#define MK_ONE_LAUNCH 1
#endif
#ifndef MK_REP
#define MK_REP -1
#endif

#define LAS __attribute__((address_space(3)))
#define GAS __attribute__((address_space(1)))
typedef unsigned short bf16_t;
typedef short bf16x8 __attribute__((ext_vector_type(8)));
typedef short s16x4 __attribute__((ext_vector_type(4)));
typedef float f32x4 __attribute__((ext_vector_type(4)));
typedef float f32x16 __attribute__((ext_vector_type(16)));
typedef unsigned u32x4 __attribute__((ext_vector_type(4)));
typedef unsigned u32x2 __attribute__((ext_vector_type(2)));
typedef float f32x2_t __attribute__((ext_vector_type(2)));
typedef __bf16 bf16x2_t __attribute__((ext_vector_type(2)));
#define RLX_AGENT __ATOMIC_RELAXED, __HIP_MEMORY_SCOPE_AGENT

__device__ __forceinline__ unsigned cvtpk(float lo, float hi) { f32x2_t v = {lo, hi}; bf16x2_t b = __builtin_convertvector(v, bf16x2_t); return __builtin_bit_cast(unsigned, b); }
__device__ __forceinline__ bf16_t f2bf(float f) { return (bf16_t)(cvtpk(f, 0.f) & 0xffffu); }
__device__ __forceinline__ float bflo(unsigned w) { return __uint_as_float(w << 16); }
__device__ __forceinline__ float bfhi(unsigned w) { return __uint_as_float(w & 0xffff0000u); }
__device__ __forceinline__ float bf2f(bf16_t b) { return __uint_as_float(((unsigned)b) << 16); }
__device__ __forceinline__ float wave_sum(float v) {
#pragma unroll
    for (int o = 1; o < 64; o <<= 1) v += __shfl_xor(v, o);
    return v;
}
__device__ __forceinline__ float fast_exp(float x) { return __builtin_amdgcn_exp2f(x * 1.4426950408889634f); }
__device__ __forceinline__ float clamp8(float x) { return __builtin_amdgcn_fmed3f(x, -448.0f, 448.0f); }
__device__ __forceinline__ unsigned pack_fp8x4(float a, float b, float c, float d) { int w = __builtin_amdgcn_cvt_pk_fp8_f32(clamp8(a), clamp8(b), 0, false); w = __builtin_amdgcn_cvt_pk_fp8_f32(clamp8(c), clamp8(d), w, true); return (unsigned)w; }
__device__ __forceinline__ float silu_f(float g) { return g * __builtin_amdgcn_rcpf(1.0f + fast_exp(-g)); }

#define XB_TMO      128
#define XB_XCNT(j)  (256  + 64 * (j))
#define XB_XSUB(j)  (1280 + 64 * (j))
#define XB_XGEN(j)  (2304 + 64 * (j))
#define XB_TOP      3328
#define XB_TOPGEN   3392
#define XCD_BAR_WORDS 3456
#define XB_SPIN_CAP (1u << 18)
__device__ __forceinline__ unsigned xb_ld(unsigned* p)              { return __hip_atomic_load(p, __ATOMIC_RELAXED, __HIP_MEMORY_SCOPE_AGENT); }
__device__ __forceinline__ unsigned xb_add(unsigned* p, unsigned v) { return __hip_atomic_fetch_add(p, v, __ATOMIC_RELAXED, __HIP_MEMORY_SCOPE_AGENT); }
__device__ __forceinline__ unsigned xb_xcc_id() { return (unsigned)__builtin_amdgcn_s_getreg((3 << 11) | 20) & 0xFu; }
#define XB_SPIN(cond, bar) do { unsigned _sp = 0; while (cond) { __builtin_amdgcn_s_sleep(1); \
    if ((++_sp & 255u) == 0u) { if (xb_ld(&(bar)[XB_TMO])) break; if (_sp > XB_SPIN_CAP) { atomicAdd(&(bar)[XB_TMO], 1u); break; } } } } while (0)
struct XcdBarrier { unsigned* bar; unsigned x; volatile LAS unsigned* st; };
__device__ __forceinline__ XcdBarrier xcd_barrier_post(unsigned* bar, volatile LAS unsigned* st) {
    XcdBarrier b; b.bar = bar; b.x = xb_xcc_id(); b.st = st;
    if (threadIdx.x == 0) (void)xb_add(&bar[XB_XCNT(b.x)], 1u);
    return b;
}
__device__ __forceinline__ void xcd_barrier_complete(unsigned* bar, unsigned x, unsigned& nloc, unsigned& nx) {
    const unsigned G = gridDim.x * gridDim.y * gridDim.z;
    unsigned sum, cnt, mine, sp = 0u;
    for (;;) {
        sum = 0u; cnt = 0u; mine = 0u;
#pragma unroll
        for (unsigned j = 0; j < 16; ++j) { const unsigned c = xb_ld(&bar[XB_XCNT(j)]); sum += c; cnt += (c > 0u) ? 1u : 0u; mine = (j == x) ? c : mine; }
        if (sum == G) break;
        __builtin_amdgcn_s_sleep(1);
        if ((++sp & 255u) == 0u) { if (xb_ld(&bar[XB_TMO])) break; if (sp > XB_SPIN_CAP) { atomicAdd(&bar[XB_TMO], 1u); break; } }
    }
    nloc = mine > 0u ? mine : 1u; nx = cnt > 0u ? cnt : 1u;
}
__device__ __forceinline__ void xcd_barrier(const XcdBarrier& b) {
    asm volatile("s_waitcnt vmcnt(0)" ::: "memory");
    __syncthreads();
    if (threadIdx.x == 0) {
        unsigned* bar = b.bar;
        __builtin_amdgcn_s_waitcnt(0);
        unsigned nloc = b.st[0], nx = b.st[1];
        if (nloc == 0u) { xcd_barrier_complete(bar, b.x, nloc, nx); b.st[0] = nloc; b.st[1] = nx; }
        const unsigned old = xb_add(&bar[XB_XSUB(b.x)], 1u);
        const unsigned gen = old / nloc;
        if (old + 1u == (gen + 1u) * nloc) {
            __builtin_amdgcn_fence(__ATOMIC_RELEASE, "agent");
            asm volatile("s_waitcnt vmcnt(0)" ::: "memory");
            const unsigned og = xb_add(&bar[XB_TOP], 1u);
            const unsigned tg = og / nx;
            if (og + 1u == (tg + 1u) * nx) xb_add(&bar[XB_TOPGEN], 1u);
            else XB_SPIN(xb_ld(&bar[XB_TOPGEN]) == tg, bar);
            __builtin_amdgcn_fence(__ATOMIC_ACQUIRE, "agent");
            xb_add(&bar[XB_XGEN(b.x)], 1u);
            asm volatile("s_waitcnt vmcnt(0)" ::: "memory");
        } else {
            XB_SPIN(xb_ld(&bar[XB_XGEN(b.x)]) == gen, bar);
            __builtin_amdgcn_fence(__ATOMIC_ACQUIRE, "agent");
            asm volatile("s_waitcnt vmcnt(0)" ::: "memory");
        }
    }
    __syncthreads();
}

constexpr int D = 1024, NB = 4, SEQ = 4096, CTX = 256;
constexpr int RL = NB * SEQ;
constexpr int RC = NB * CTX;
constexpr int R = RL + RC;
constexpr float EPS = 1e-6f;
constexpr float LOG2E = 1.4426950408889634f;
constexpr int N_IN0 = 1536, N_QA = 768, N_KVA = 1024, FFN = 2816, N_GU0 = 2 * FFN, N_IN1 = 3328, EXD = 3584, N_GU1 = 2 * EXD, NEXP = 8;
constexpr int CAPE = 16384;

constexpr size_t MiB = 1u << 20;
constexpr size_t O_CTL = 0;
constexpr size_t CTL_BYTES = 65536;
constexpr int CW_BAR = 0;
constexpr int CW_CNT = 8192;
constexpr size_t O_MODV = 1 * MiB;
constexpr size_t O_TAB16 = O_MODV + 256 * 1024;
constexpr size_t O_TAB32 = O_TAB16 + 8192;
constexpr size_t O_RSTDQ = O_TAB32 + 16384;
constexpr size_t O_RSTDKV = O_RSTDQ + 81920;
constexpr size_t O_SEL = 2 * MiB;
constexpr size_t O_ROWTOK = 3 * MiB;
constexpr size_t O_WGU1 = 4 * MiB;
constexpr size_t O_YE = O_WGU1;
constexpr size_t O_WD1 = 116 * MiB;
constexpr size_t O_WIN1 = 172 * MiB;
constexpr size_t O_WOUT1 = 179 * MiB;
constexpr size_t O_WIN0 = 181 * MiB;
constexpr size_t O_WUQ = 184 * MiB;
constexpr size_t O_WUKV = 185 * MiB;
constexpr size_t O_WOUT0 = 186 * MiB;
constexpr size_t O_WGU0 = 188 * MiB;
constexpr size_t O_WD0 = 199 * MiB;
constexpr size_t O_HC = 205 * MiB;
constexpr size_t O_U = 209 * MiB;
constexpr size_t O_Y = 243 * MiB;
constexpr size_t O_Z0 = 311 * MiB;
constexpr size_t O_QA = 362 * MiB;
constexpr size_t O_KVA = 388 * MiB;
constexpr size_t O_QB = 422 * MiB;
constexpr size_t O_KB = 439 * MiB;
constexpr size_t O_KR = 444 * MiB;
constexpr size_t O_AO = 446 * MiB;
constexpr size_t O_H0 = 311 * MiB;
constexpr size_t O_QK1 = 311 * MiB;
constexpr size_t O_V1 = 345 * MiB;
constexpr size_t O_G1 = 379 * MiB;
constexpr size_t O_RR = 413 * MiB;
constexpr size_t O_QDF = 422 * MiB, O_KIF = 439 * MiB, O_KTF = 456 * MiB, O_QDB = 473 * MiB;
constexpr size_t O_KIB = 243 * MiB, O_KTB = 260 * MiB, O_VT = 277 * MiB;
constexpr size_t O_ECL = 490 * MiB;
constexpr size_t O_OF = O_QK1, O_OB = O_V1;
constexpr size_t O_GA = O_QDF;
constexpr size_t O_HM = 243 * MiB;
constexpr size_t WS_END = 495 * MiB;
static_assert(O_HM + (size_t)34816 * EXD * 2 <= 482 * MiB, "HM");
static_assert(O_RR + (size_t)R * 256 * 2 <= O_QDF, "RR");
static_assert(O_ECL + (size_t)544 * 8 * 1024 <= WS_END, "ECL");

constexpr int RING_BYTES = 131072;
constexpr int LDS_BYTES = 147456;
constexpr int LDSCTL_OFF = LDS_BYTES - 256;

struct Args {
    const float* in[27];
    float* out; unsigned char* ws;
    int ph_lo, ph_hi;
};
enum { I_X = 0, I_C, I_CTX, I_CCTX, I_MODW, I_MODB, I_NORMG, I_AWIN, I_AQN, I_AWUQ, I_AKVN, I_AWUKV, I_AQKN, I_AWOUT, I_GWIN, I_GGATE2, I_GBGATE, I_GONORM, I_GWOUT,
       I_FWG, I_FWU, I_FWD, I_MROUTER, I_MBROUTER, I_MWG, I_MWU, I_MWD };

struct Conv { const float* s0; const float* s1; int Nsrc; int K; int Ndst; bf16_t* dst; int mode; const float* kscale; };
__device__ __forceinline__ int ilv64(int p) { return (p >> 5) * 32 + (p & 1) * 16 + ((p & 31) >> 1); }
__device__ __forceinline__ int ilv32(int p) { return (p >> 4) * 16 + (p & 1) * 8 + ((p & 15) >> 1); }
__device__ __forceinline__ const float* conv_col(const Conv& c, int n, float& sc) {
    sc = 1.0f;
    switch (c.mode) {
    case 0: return c.s0 + n;
    case 1: {
        if (n < 640) return c.s0 + n;
        if (n < 1152) { const int hh = (n - 640) >> 6, p = (n - 640) & 63; return c.s0 + 672 + hh * 64 + ilv64(p); }
        if (n < 1280) { const int hh = (n - 1152) >> 6, p = (n - 1152) & 63; return c.s0 + 1184 + hh * 64 + ilv64(p); }
        if (n < 1408) return c.s0 + 1312 + (n - 1280);
        if (n < 1440) return c.s0 + 640 + ilv32(n - 1408);
        return nullptr; }
    case 2: {
        if (n < 512) return c.s0 + (n >> 6) * 96 + (n & 63);
        const int hh = (n - 512) >> 5, p = (n - 512) & 31; return c.s0 + hh * 96 + 64 + ilv32(p); }
    case 3: {
        const int G = n >> 5, j = n & 31; return (j < 16) ? c.s0 + 16 * G + j : c.s1 + 16 * G + (j - 16); }
    case 4: {
        if (n >= 3104) return nullptr;
        if (n < 512) sc = 0.08838834764831845f;
        return c.s0 + n; }
    }
    return nullptr;
}
__device__ __forceinline__ void conv_item(const Conv& c, int item, LAS float* scr, int lane) {
    const int nblk = c.Ndst / 32, kb = item / nblk, nb = item % nblk, k0 = 64 * kb, n0 = 32 * nb;
    float sc; const float* cp = conv_col(c, n0 + (lane & 31), sc);
    const int kh = lane >> 5;
#pragma unroll 16
    for (int i = 0; i < 32; ++i) { const int kk = 2 * i + kh; float v = 0.f;
        if (cp) { v = cp[(size_t)(k0 + kk) * c.Nsrc] * sc; if (c.kscale) v *= c.kscale[k0 + kk]; }
        scr[kk * 33 + (lane & 31)] = v; }
    asm volatile("s_waitcnt lgkmcnt(0)" ::: "memory");
    const int ch = lane & 7;
#pragma unroll
    for (int j = 0; j < 4; ++j) { const int n = (lane >> 3) + 8 * j; const LAS float* s = scr + (8 * ch) * 33 + n;
        u32x4 o; o.x = cvtpk(s[0 * 33], s[1 * 33]); o.y = cvtpk(s[2 * 33], s[3 * 33]); o.z = cvtpk(s[4 * 33], s[5 * 33]); o.w = cvtpk(s[6 * 33], s[7 * 33]);
        *(u32x4*)(c.dst + (size_t)(n0 + n) * c.K + k0 + 8 * ch) = o; }
    asm volatile("s_waitcnt lgkmcnt(0)" ::: "memory");
}

struct Conv64 { const float* s0; const float* s1; int Nsrc; int K; int Ndst; bf16_t* dst; int mode; int nvalid; int nscaled; float rscale; int f8; };
__device__ __forceinline__ void conv64_item(const Conv64& c, int item, LAS float* scr, int lane) {
    const int nblk = c.Ndst / 64, kb = item / nblk, nb = item % nblk, k0 = 64 * kb, n0 = 64 * nb;
    const int c4 = lane & 15, kr = lane >> 4;
    const float* src; int nd; bool valid = true; float sc = 1.0f;
    if (c.mode == 3) { const int cc = 4 * (c4 & 7); src = ((c4 < 8) ? c.s0 : c.s1) + 32 * nb + cc; nd = 32 * (cc >> 4) + ((c4 < 8) ? 0 : 16) + (cc & 15); if (c.f8) sc = c.rscale; }
    else { nd = 4 * c4; src = c.s0 + n0 + nd; valid = (n0 + nd) < c.nvalid; if (n0 + nd < c.nscaled) sc = c.rscale; }
    src += (size_t)(k0 + kr) * c.Nsrc;
    f32x4 v[16];
#pragma unroll
    for (int i = 0; i < 16; ++i) v[i] = valid ? *(const f32x4*)(src + (size_t)(4 * i) * c.Nsrc) : (f32x4){0.f, 0.f, 0.f, 0.f};
#pragma unroll
    for (int i = 0; i < 16; ++i) { LAS float* p = scr + (4 * i + kr) * 65 + nd; p[0] = v[i][0] * sc; p[1] = v[i][1] * sc; p[2] = v[i][2] * sc; p[3] = v[i][3] * sc; }
    asm volatile("s_waitcnt lgkmcnt(0)" ::: "memory");
    if (c.f8) {
        const int ch = lane & 3; unsigned char* d8 = (unsigned char*)c.dst;
#pragma unroll
        for (int it = 0; it < 4; ++it) { const int r = it * 16 + (lane >> 2); const LAS float* sp = scr + (16 * ch) * 65 + r; u32x4 o;
            o.x = pack_fp8x4(sp[0 * 65], sp[1 * 65], sp[2 * 65], sp[3 * 65]); o.y = pack_fp8x4(sp[4 * 65], sp[5 * 65], sp[6 * 65], sp[7 * 65]);
            o.z = pack_fp8x4(sp[8 * 65], sp[9 * 65], sp[10 * 65], sp[11 * 65]); o.w = pack_fp8x4(sp[12 * 65], sp[13 * 65], sp[14 * 65], sp[15 * 65]);
            *(u32x4*)(d8 + (size_t)(n0 + r) * c.K + k0 + 16 * ch) = o; }
    } else {
    const int ch = lane & 7;
#pragma unroll
    for (int it = 0; it < 8; ++it) { const int r = it * 8 + (lane >> 3); const LAS float* sp = scr + (8 * ch) * 65 + r;
        u32x4 o; o.x = cvtpk(sp[0 * 65], sp[1 * 65]); o.y = cvtpk(sp[2 * 65], sp[3 * 65]); o.z = cvtpk(sp[4 * 65], sp[5 * 65]); o.w = cvtpk(sp[6 * 65], sp[7 * 65]);
        *(u32x4*)(c.dst + (size_t)(n0 + r) * c.K + k0 + 8 * ch) = o; }
    }
    asm volatile("s_waitcnt lgkmcnt(0)" ::: "memory");
}

namespace pg8 {
constexpr int BM = 256, BK = 64, HALF = 128, HTB = HALF * BK * 2, STAGE_BYTES = 8 * HTB;
constexpr int NXCD = 8, WGM = 8;
__device__ __forceinline__ int lds_byte(int r, int c) { const int st = (r >> 4) * 2 + (c >> 5), rr = r & 15, cc = c & 31, ob = rr * 64 + cc * 2; return st * 1024 + (ob ^ (((ob >> 9) & 1) << 5)); }
__device__ __forceinline__ void stage_rc(int b, int& Rr, int& C) { const int st = b / 1024, sb = b % 1024, swz = sb ^ (((sb >> 9) & 1) << 5); Rr = (st >> 1) * 16 + swz / 64; C = (st & 1) * 32 + (swz % 64) / 2; }
__device__ __forceinline__ int perm32(int rho) { const int n = rho >> 4, i = rho & 15; return 8 * (i >> 2) + 4 * n + (i & 3); }
struct Unit { int pm, pn; };
typedef int v8i_t __attribute__((ext_vector_type(8)));
typedef int v4i_t __attribute__((ext_vector_type(4)));
__device__ __forceinline__ v8i_t cat8(bf16x8 a, bf16x8 b) { const v4i_t x = __builtin_bit_cast(v4i_t, a), y = __builtin_bit_cast(v4i_t, b); return __builtin_shufflevector(x, y, 0, 1, 2, 3, 4, 5, 6, 7); }
struct Order {
    int nM, nN, nwg, G, c;
    __device__ __forceinline__ void init(int nM_, int nN_, int G_, int c_) { nM = nM_; nN = nN_; nwg = nM * nN; G = G_; c = c_; }
    __device__ __forceinline__ bool next(int i, Unit& u) const {
        const long L = (long)i * G + c; if (L >= nwg) return false;
        int wgid = (int)L; { const int q = nwg / NXCD, r = nwg % NXCD, xcd = wgid % NXCD, off = wgid / NXCD; wgid = (xcd < r ? xcd * (q + 1) : r * (q + 1) + (xcd - r) * q) + off; }
        const int nig = WGM * nN, gid = wgid / nig, fm = gid * WGM, gsz = (nM - fm) < WGM ? (nM - fm) : WGM;
        u.pm = fm + ((wgid % nig) % gsz); u.pn = (wgid % nig) / gsz; return true;
    }
};

template <class Prob, class Epi>
__device__ __forceinline__ void gemm_phase(LAS unsigned char* lds, const Prob& P, const Epi& E) {
    const int tid = threadIdx.x, wid = __builtin_amdgcn_readfirstlane(tid >> 6), lane = tid & 63, wr = wid >> 2, wc = wid & 3, fr = lane & 15, fq = lane >> 4;
    const int K = P.K, nt = K / BK, ldb = P.ldb;
    int RA[2], CA[2]; unsigned voffB[2];
#pragma unroll
    for (int i = 0; i < 2; ++i) { int Rr, C; stage_rc(tid * 16 + i * 8192, Rr, C); const int Rb = Epi::PERM ? ((Rr & ~31) + perm32(Rr & 31)) : Rr;
        RA[i] = Rr; CA[i] = C; voffB[i] = (unsigned)(Rb * ldb + C) * 2u; }
    const size_t hstepB = (size_t)HALF * ldb * 2;
    const unsigned ldsw = (unsigned)wid * 1024u;
    const int aoff = lds_byte(wr * 64 + fr, fq * 8), boff = lds_byte(wc * 32 + fr, fq * 8);
    const char* Abase = (const char*)P.Abase;
    const int scl_a = P.sa * 0x01010101, scl_b = P.sb * 0x01010101;
#define PG8_SA(b, h) (((b) * 2 + (h)) * HTB)
#define PG8_SB(b, h) ((4 + (b) * 2 + (h)) * HTB)
#define PG8_STAGEB(bufoff, gbase) do { _Pragma("unroll") for (int _i = 0; _i < 2; ++_i) \
        __builtin_amdgcn_global_load_lds((const unsigned*)((const char*)(gbase) + voffB[_i]), (LAS unsigned*)(lds + (bufoff) + ldsw + _i * 8192), 16, 0, 0); } while (0)
#define PG8_STAGEA(bufoff, vo, h, kb) do { _Pragma("unroll") for (int _i = 0; _i < 2; ++_i) \
        __builtin_amdgcn_global_load_lds((const unsigned*)(Abase + (size_t)(kb) + (vo)[h][_i]), (LAS unsigned*)(lds + (bufoff) + ldsw + _i * 8192), 16, 0, 0); } while (0)
#define PG8_LDA(dst, b, h) do { _Pragma("unroll") for (int m = 0; m < 4; ++m) { if constexpr (Prob::FP8) dst##8[m] = cat8(*(const LAS bf16x8*)(lds + PG8_SA(b, h) + aoff + m * 2048), *(const LAS bf16x8*)(lds + PG8_SA(b, h) + aoff + m * 2048 + 1024)); \
        else { _Pragma("unroll") for (int k = 0; k < 2; ++k) dst[m][k] = *(const LAS bf16x8*)(lds + PG8_SA(b, h) + aoff + m * 2048 + k * 1024); } } } while (0)
#define PG8_LDB(dst, b, h) do { _Pragma("unroll") for (int n = 0; n < 2; ++n) { if constexpr (Prob::FP8) dst##8[n] = cat8(*(const LAS bf16x8*)(lds + PG8_SB(b, h) + boff + n * 2048), *(const LAS bf16x8*)(lds + PG8_SB(b, h) + boff + n * 2048 + 1024)); \
        else { _Pragma("unroll") for (int k = 0; k < 2; ++k) dst[n][k] = *(const LAS bf16x8*)(lds + PG8_SB(b, h) + boff + n * 2048 + k * 1024); } } } while (0)
#define PG8_MMA(ai, bj, At, Bt) do { __builtin_amdgcn_s_setprio(1); _Pragma("unroll") for (int m = 0; m < 4; ++m) _Pragma("unroll") for (int n = 0; n < 2; ++n) { \
        if constexpr (Prob::FP8) asm volatile("v_mfma_scale_f32_16x16x128_f8f6f4 %0, %1, %2, %0, %3, %4 op_sel_hi:[0,0,0]" : "+v"(acc[ai][bj][m][n]) : "v"(Bt##8[n]), "v"(At##8[m]), "v"(scl_b), "v"(scl_a)); \
        else { _Pragma("unroll") for (int k = 0; k < 2; ++k) acc[ai][bj][m][n] = __builtin_amdgcn_mfma_f32_16x16x32_bf16(Bt[n][k], At[m][k], acc[ai][bj][m][n], 0, 0, 0); } } \
        __builtin_amdgcn_s_setprio(0); } while (0)
#define PG8_WAIT_V(n) asm volatile("s_waitcnt vmcnt(" #n ")" ::: "memory")
#define PG8_WAIT_L(n) asm volatile("s_waitcnt lgkmcnt(" #n ")" ::: "memory")
#define PG8_BAR __builtin_amdgcn_s_barrier()
#define PG8_SCHED __builtin_amdgcn_sched_barrier(0)
    Unit cur, nxt; int ui = 0;
    if (!P.next(0, cur)) return;
    f32x4 acc[2][2][4][2];
#pragma unroll
    for (int a = 0; a < 2; ++a)
#pragma unroll
        for (int b = 0; b < 2; ++b)
#pragma unroll
            for (int m = 0; m < 4; ++m)
#pragma unroll
                for (int n = 0; n < 2; ++n) acc[a][b][m][n] = (f32x4){0.f, 0.f, 0.f, 0.f};
    bf16x8 At[4][2], B0[2][2], B1[2][2]; v8i_t At8[4], B08[2], B18[2];
    unsigned cvo[2][2], nvo[2][2];
#pragma unroll
    for (int h = 0; h < 2; ++h)
#pragma unroll
        for (int i = 0; i < 2; ++i) cvo[h][i] = P.a_off(cur, h * HALF + RA[i]) + (unsigned)CA[i] * 2u;
    const char* cB = P.b_ptr(cur);
    const size_t kstep = (size_t)(BK * 2);
    PG8_STAGEB(PG8_SB(0, 0), cB); PG8_STAGEA(PG8_SA(0, 0), cvo, 0, 0); PG8_STAGEB(PG8_SB(0, 1), cB + hstepB); PG8_STAGEA(PG8_SA(0, 1), cvo, 1, 0);
    if (wr == 1) PG8_BAR;
    PG8_WAIT_V(4); PG8_BAR;
    PG8_STAGEB(PG8_SB(1, 0), cB + kstep); PG8_STAGEA(PG8_SA(1, 0), cvo, 0, kstep); PG8_STAGEB(PG8_SB(1, 1), cB + hstepB + kstep);
    PG8_WAIT_V(6); PG8_BAR;
    for (;;) {
        const bool has_next = P.next(ui + 1, nxt);
        const char* nB = cB;
#pragma unroll
        for (int h = 0; h < 2; ++h)
#pragma unroll
            for (int i = 0; i < 2; ++i) nvo[h][i] = cvo[h][i];
        if (has_next) { nB = P.b_ptr(nxt);
#pragma unroll
            for (int h = 0; h < 2; ++h)
#pragma unroll
                for (int i = 0; i < 2; ++i) nvo[h][i] = P.a_off(nxt, h * HALF + RA[i]) + (unsigned)CA[i] * 2u; }
        for (int t = 0; t < nt; t += 2) {
            const bool last = (t == nt - 2);
            const size_t k1 = (size_t)(t + 1) * kstep;
            const size_t k2 = last ? 0 : (size_t)(t + 2) * kstep, k3 = k2 + kstep;
            unsigned vo2[2][2];
#pragma unroll
            for (int h = 0; h < 2; ++h)
#pragma unroll
                for (int i = 0; i < 2; ++i) vo2[h][i] = last ? nvo[h][i] : cvo[h][i];
            const char* b2 = (last ? nB : cB) + k2; const char* b3 = b2 + kstep;
            PG8_LDB(B0, 0, 0); PG8_SCHED; PG8_LDA(At, 0, 0); PG8_STAGEA(PG8_SA(1, 1), cvo, 1, k1);
            PG8_WAIT_L(8); PG8_BAR; PG8_WAIT_L(0); PG8_MMA(0, 0, At, B0); PG8_BAR; PG8_SCHED;
            PG8_LDB(B1, 0, 1); PG8_STAGEB(PG8_SB(0, 0), b2);
            PG8_BAR; PG8_WAIT_L(0); PG8_MMA(0, 1, At, B1); PG8_BAR;
            PG8_LDA(At, 0, 1); PG8_STAGEA(PG8_SA(0, 0), vo2, 0, k2);
            PG8_BAR; PG8_WAIT_L(0); PG8_MMA(1, 0, At, B0); PG8_BAR; PG8_SCHED;
            PG8_STAGEB(PG8_SB(0, 1), b2 + hstepB);
            PG8_WAIT_V(6); PG8_BAR; PG8_MMA(1, 1, At, B1); PG8_BAR;
            PG8_LDB(B0, 1, 0); PG8_SCHED; PG8_LDA(At, 1, 0); PG8_STAGEA(PG8_SA(0, 1), vo2, 1, k2);
            PG8_WAIT_L(8); PG8_BAR; PG8_WAIT_L(0); PG8_MMA(0, 0, At, B0); PG8_BAR; PG8_SCHED;
            PG8_LDB(B1, 1, 1); PG8_STAGEB(PG8_SB(1, 0), b3);
            PG8_BAR; PG8_WAIT_L(0); PG8_MMA(0, 1, At, B1); PG8_BAR;
            PG8_LDA(At, 1, 1); PG8_STAGEA(PG8_SA(1, 0), vo2, 0, k3);
            PG8_BAR; PG8_WAIT_L(0); PG8_MMA(1, 0, At, B0); PG8_BAR; PG8_SCHED;
            PG8_STAGEB(PG8_SB(1, 1), b3 + hstepB);
            PG8_WAIT_V(6); PG8_BAR; PG8_MMA(1, 1, At, B1); PG8_BAR;
        }
        if constexpr (Prob::FP8) asm volatile("s_nop 15\n\ts_nop 15" ::: "memory");
        E(acc, P, cur, wr, wc, fr, fq);
        if (!has_next) break;
#pragma unroll
        for (int a = 0; a < 2; ++a)
#pragma unroll
            for (int b = 0; b < 2; ++b)
#pragma unroll
                for (int m = 0; m < 4; ++m)
#pragma unroll
                    for (int n = 0; n < 2; ++n) acc[a][b][m][n] = (f32x4){0.f, 0.f, 0.f, 0.f};
        cur = nxt; cB = nB; ++ui;
#pragma unroll
        for (int h = 0; h < 2; ++h)
#pragma unroll
            for (int i = 0; i < 2; ++i) cvo[h][i] = nvo[h][i];
    }
    PG8_WAIT_V(0);
    if (wr == 0) PG8_BAR;
    PG8_BAR;
#undef PG8_SA
#undef PG8_SB
#undef PG8_STAGEA
#undef PG8_STAGEB
#undef PG8_LDA
#undef PG8_LDB
#undef PG8_MMA
#undef PG8_WAIT_V
#undef PG8_WAIT_L
#undef PG8_BAR
#undef PG8_SCHED
}

struct DenseProb {
    static constexpr bool FP8 = false; static constexpr int sa = 127, sb = 127;
    const bf16_t* Abase; const bf16_t* Bt; int K, lda, ldb; Order ord;
    __device__ __forceinline__ bool next(int i, Unit& u) const { return ord.next(i, u); }
    __device__ __forceinline__ unsigned a_off(const Unit& u, int r) const { return (unsigned)((size_t)(u.pm * BM + r) * lda * 2); }
    __device__ __forceinline__ const char* b_ptr(const Unit& u) const { return (const char*)Bt + (size_t)u.pn * BM * ldb * 2; }
    __device__ __forceinline__ int orow0(const Unit& u) const { return u.pm * BM; }
};
struct MoeTiles { unsigned long long tp8; unsigned long long c4a, c4b; int nt; };
__device__ __forceinline__ int moe_tp(const MoeTiles& T, int e) { return (int)((T.tp8 >> (8 * e)) & 0xffull); }
__device__ __forceinline__ int moe_cnt(const MoeTiles& T, int e) { const unsigned long long w = (e < 4) ? T.c4a : T.c4b; return (int)((w >> (16 * (e & 3))) & 0xffffull); }
__device__ __forceinline__ int moe_expert(const MoeTiles& T, int pm) { int e = 0;
#pragma unroll
    for (int j = 1; j < 8; ++j) e += (pm >= (int)((T.tp8 >> (8 * j)) & 0xffull)) ? 1 : 0;
    return e; }
struct MoeGuProb {
    static constexpr bool FP8 = true; static constexpr int sa = 125, sb = 121;
    const unsigned char* Abase; const unsigned char* Bt; int K, ldb; Order ord; MoeTiles T; const int* rowtok;
    __device__ __forceinline__ bool next(int i, Unit& u) const { return ord.next(i, u); }
    __device__ __forceinline__ unsigned a_off(const Unit& u, int r) const {
        const int e = moe_expert(T, u.pm); const int idx = (u.pm - moe_tp(T, e)) * BM + r; int tok = 0;
        if (idx < moe_cnt(T, e)) tok = rowtok[e * CAPE + idx];
        return (unsigned)tok * (unsigned)D; }
    __device__ __forceinline__ const char* b_ptr(const Unit& u) const { const int e = moe_expert(T, u.pm); return (const char*)Bt + ((size_t)e * N_GU1 + (size_t)u.pn * BM) * D; }
    __device__ __forceinline__ int orow0(const Unit& u) const { return u.pm * BM; }
};
struct MoeDnProb {
    static constexpr bool FP8 = true; static constexpr int sa = 124, sb = 121;
    const unsigned char* Abase; const unsigned char* Bt; int K, ldb; Order ord; MoeTiles T;
    __device__ __forceinline__ bool next(int i, Unit& u) const { return ord.next(i, u); }
    __device__ __forceinline__ unsigned a_off(const Unit& u, int r) const { return (unsigned)((size_t)(u.pm * BM + r) * EXD); }
    __device__ __forceinline__ const char* b_ptr(const Unit& u) const { const int e = moe_expert(T, u.pm); return (const char*)Bt + ((size_t)e * D + (size_t)u.pn * BM) * EXD; }
    __device__ __forceinline__ int orow0(const Unit& u) const { return u.pm * BM; }
};

struct EpiF32 { static constexpr bool PERM = false; float* C; int ldc;
    template <class Prob> __device__ __forceinline__ void operator()(const f32x4 (&acc)[2][2][4][2], const Prob& P, const Unit& u, int wr, int wc, int fr, int fq) const {
        const int row0 = P.orow0(u) + wr * 64 + fr, col0 = u.pn * BM + wc * 32 + 4 * fq;
#pragma unroll
        for (int ai = 0; ai < 2; ++ai)
#pragma unroll
            for (int m = 0; m < 4; ++m) { float* rowp = C + (size_t)(row0 + ai * HALF + m * 16) * ldc + col0;
#pragma unroll
                for (int bj = 0; bj < 2; ++bj)
#pragma unroll
                    for (int n = 0; n < 2; ++n) *(f32x4*)(rowp + bj * HALF + n * 16) = acc[ai][bj][m][n]; }
    }
};
struct EpiBf16 { static constexpr bool PERM = true; bf16_t* O; int ldc; const float* rowscale;
    template <class Prob> __device__ __forceinline__ void operator()(const f32x4 (&acc)[2][2][4][2], const Prob& P, const Unit& u, int wr, int wc, int fr, int fq) const {
        const int row0 = P.orow0(u) + wr * 64 + fr, col0 = u.pn * BM + wc * 32 + 8 * fq;
#pragma unroll
        for (int ai = 0; ai < 2; ++ai)
#pragma unroll
            for (int m = 0; m < 4; ++m) { const int row = row0 + ai * HALF + m * 16; bf16_t* rowp = O + (size_t)row * ldc + col0; const float rs = rowscale ? rowscale[row] : 1.0f;
#pragma unroll
                for (int bj = 0; bj < 2; ++bj) { const f32x4 v0 = acc[ai][bj][m][0] * rs, v1 = acc[ai][bj][m][1] * rs;
                    u32x4 w; w.x = cvtpk(v0[0], v0[1]); w.y = cvtpk(v0[2], v0[3]); w.z = cvtpk(v1[0], v1[1]); w.w = cvtpk(v1[2], v1[3]);
                    *(u32x4*)(rowp + bj * HALF) = w; } }
    }
};
struct EpiIn1 { static constexpr bool PERM = true; bf16_t* QK; bf16_t* V; bf16_t* G; bf16_t* RRp;
    template <class Prob> __device__ __forceinline__ void operator()(const f32x4 (&acc)[2][2][4][2], const Prob& P, const Unit& u, int wr, int wc, int fr, int fq) const {
        const int t = u.pn >> 2; bf16_t* base = (t == 0) ? QK : (t == 1) ? V : (t == 2) ? G : RRp; const int ldc = (t == 3) ? 256 : 1024;
        const int row0 = P.orow0(u) + wr * 64 + fr, col0 = (u.pn & 3) * BM + wc * 32 + 8 * fq;
#pragma unroll
        for (int ai = 0; ai < 2; ++ai)
#pragma unroll
            for (int m = 0; m < 4; ++m) { const int row = row0 + ai * HALF + m * 16; bf16_t* rowp = base + (size_t)row * ldc + col0;
#pragma unroll
                for (int bj = 0; bj < 2; ++bj) { const f32x4 v0 = acc[ai][bj][m][0], v1 = acc[ai][bj][m][1];
                    u32x4 w; w.x = cvtpk(v0[0], v0[1]); w.y = cvtpk(v0[2], v0[3]); w.z = cvtpk(v1[0], v1[1]); w.w = cvtpk(v1[2], v1[3]);
                    *(u32x4*)(rowp + bj * HALF) = w; } }
    }
};
struct EpiQA { static constexpr bool PERM = true; bf16_t* O; const float* rstd; const float* tab16; float qscale;
    template <class Prob> __device__ __forceinline__ void operator()(const f32x4 (&acc)[2][2][4][2], const Prob& P, const Unit& u, int wr, int wc, int fr, int fq) const {
        const int row0 = P.orow0(u) + wr * 64 + fr, col0 = u.pn * BM + wc * 32 + 8 * fq;
        const bool ropet = (u.pn == 2);
#pragma unroll
        for (int ai = 0; ai < 2; ++ai)
#pragma unroll
            for (int m = 0; m < 4; ++m) { const int row = row0 + ai * HALF + m * 16; bf16_t* rowp = O + (size_t)row * N_QA + col0; const float rs = rstd[row] * qscale;
                f32x4 cs0 = {1.f, 1.f, 1.f, 1.f}, sn0 = {0.f, 0.f, 0.f, 0.f};
                if (ropet && row < RL) { const int tt = row & (SEQ - 1); const int pos = (fq >> 1) ? (tt & 63) : (tt >> 6); const int i0 = 4 * (fq & 1);
                    cs0 = *(const f32x4*)(tab16 + pos * 8 + i0); sn0 = *(const f32x4*)(tab16 + 512 + pos * 8 + i0); }
#pragma unroll
                for (int bj = 0; bj < 2; ++bj) { f32x4 v0 = acc[ai][bj][m][0] * rs, v1 = acc[ai][bj][m][1] * rs;
                    if (ropet) {
                        const f32x4 a = v0, b = v1;
                        v0[0] = a[0] * cs0[0] - a[1] * sn0[0]; v0[1] = a[1] * cs0[0] + a[0] * sn0[0];
                        v0[2] = a[2] * cs0[1] - a[3] * sn0[1]; v0[3] = a[3] * cs0[1] + a[2] * sn0[1];
                        v1[0] = b[0] * cs0[2] - b[1] * sn0[2]; v1[1] = b[1] * cs0[2] + b[0] * sn0[2];
                        v1[2] = b[2] * cs0[3] - b[3] * sn0[3]; v1[3] = b[3] * cs0[3] + b[2] * sn0[3]; }
                    u32x4 w; w.x = cvtpk(v0[0], v0[1]); w.y = cvtpk(v0[2], v0[3]); w.z = cvtpk(v1[0], v1[1]); w.w = cvtpk(v1[2], v1[3]);
                    *(u32x4*)(rowp + bj * HALF) = w; } }
    }
};
struct EpiSwiglu { static constexpr bool PERM = false; bf16_t* Hh; int ldh;
    template <class Prob> __device__ __forceinline__ void operator()(const f32x4 (&acc)[2][2][4][2], const Prob& P, const Unit& u, int wr, int wc, int fr, int fq) const {
        const int row0 = P.orow0(u) + wr * 64 + fr, col0 = (u.pn * BM + wc * 32) / 2 + 4 * fq;
#pragma unroll
        for (int ai = 0; ai < 2; ++ai)
#pragma unroll
            for (int m = 0; m < 4; ++m) { bf16_t* rowp = Hh + (size_t)(row0 + ai * HALF + m * 16) * ldh + col0;
#pragma unroll
                for (int bj = 0; bj < 2; ++bj) { const f32x4 g = acc[ai][bj][m][0], up = acc[ai][bj][m][1];
                    u32x2 w; w.x = cvtpk(silu_f(g[0]) * up[0], silu_f(g[1]) * up[1]); w.y = cvtpk(silu_f(g[2]) * up[2], silu_f(g[3]) * up[3]);
                    *(u32x2*)(rowp + bj * (HALF / 2)) = w; } }
    }
};
struct EpiSwiglu8 { static constexpr bool PERM = false; unsigned char* Hh; int ldh;
    template <class Prob> __device__ __forceinline__ void operator()(const f32x4 (&acc)[2][2][4][2], const Prob& P, const Unit& u, int wr, int wc, int fr, int fq) const {
        const int row0 = P.orow0(u) + wr * 64 + fr, col0 = (u.pn * BM + wc * 32) / 2 + 4 * fq;
#pragma unroll
        for (int ai = 0; ai < 2; ++ai)
#pragma unroll
            for (int m = 0; m < 4; ++m) { unsigned char* rowp = Hh + (size_t)(row0 + ai * HALF + m * 16) * ldh + col0;
#pragma unroll
                for (int bj = 0; bj < 2; ++bj) { const f32x4 g = acc[ai][bj][m][0], up = acc[ai][bj][m][1];
                    *(unsigned*)(rowp + bj * (HALF / 2)) = pack_fp8x4(8.0f * silu_f(g[0]) * up[0], 8.0f * silu_f(g[1]) * up[1], 8.0f * silu_f(g[2]) * up[2], 8.0f * silu_f(g[3]) * up[3]); } }
    }
};
}

struct Frame {
    LAS unsigned char* lds;
    unsigned char* ws;
    int tid, lane, wave, vcu, G;
};
template <class T> __device__ __forceinline__ T* wsp(const Frame& F, size_t off) { return (T*)(F.ws + off); }

__device__ __forceinline__ void load_row(const float* p, int lane, f32x4 (&v)[4]) {
    const f32x4* r = (const f32x4*)p + lane;
#pragma unroll
    for (int j = 0; j < 4; ++j) v[j] = r[64 * j];
}
__device__ __forceinline__ float row_ssq(const f32x4 (&v)[4]) { float s = 0.f;
#pragma unroll
    for (int j = 0; j < 4; ++j) s += (v[j][0] * v[j][0] + v[j][1] * v[j][1]) + (v[j][2] * v[j][2] + v[j][3] * v[j][3]);
    return wave_sum(s); }
__device__ __forceinline__ void norm_mod_store(const f32x4 (&h)[4], const float* g, const float* sh, const float* sc, bf16_t* urow, int lane, f32x4 (&uo)[4], unsigned char* u8row = nullptr) {
    const float rstd = __builtin_amdgcn_rsqf(row_ssq(h) * (1.0f / D) + EPS);
#pragma unroll
    for (int j = 0; j < 4; ++j) { const int c = 4 * lane + 256 * j; const f32x4 gg = *(const f32x4*)(g + c), s1 = *(const f32x4*)(sc + c), s0 = *(const f32x4*)(sh + c);
        const f32x4 uu = (h[j] * rstd * gg) * (1.0f + s1) + s0; uo[j] = uu;
        if (u8row) *(unsigned*)(u8row + c) = pack_fp8x4(4.0f * uu[0], 4.0f * uu[1], 4.0f * uu[2], 4.0f * uu[3]);
        else { u32x2 w; w.x = cvtpk(uu[0], uu[1]); w.y = cvtpk(uu[2], uu[3]); *(u32x2*)(urow + c) = w; } }
}
__device__ __forceinline__ int row_bidx(int row) { return row < RL ? (row >> 12) : 4; }

__device__ __forceinline__ void glds16(const void* gsrc, unsigned lds_dst) { unsigned keep;
    asm volatile("s_mov_b32 %0, m0\n\ts_mov_b32 m0, %2\n\ts_nop 0\n\tglobal_load_lds_dwordx4 %1, off\n\ts_mov_b32 m0, %0" : "=&s"(keep) : "v"(gsrc), "s"(lds_dst) : "memory"); }
__device__ __forceinline__ float max3f(float a, float b, float c) { float r; asm("v_max3_f32 %0, %1, %2, %3" : "=v"(r) : "v"(a), "v"(b), "v"(c)); return r; }
#define WAIT_BAR(N) asm volatile("s_waitcnt vmcnt(" #N ") lgkmcnt(0)\n\ts_barrier" ::: "memory")
template <int DQK> struct AttnSrc {
    const bf16_t* Q; int qpitch; const bf16_t* Qr;
    const bf16_t* Kn; int kpitch; const bf16_t* Kr; int krpitch;
    const bf16_t* V; int vpitch;
    bf16_t* O; int opitch;
};
__device__ __forceinline__ s16x4 vtr(const LAS unsigned char* p) { typedef short v4i16_t __attribute__((ext_vector_type(4))); return __builtin_bit_cast(s16x4, __builtin_amdgcn_ds_read_tr16_b64_v4i16((LAS v4i16_t*)p)); }
__device__ __forceinline__ int attn_krow(int kt, int lat0, int ctx0) { return kt < 64 ? lat0 + kt * 64 : ctx0 + (kt - 64) * 64; }
template <int DQK>
__device__ __forceinline__ void attn_unit(const Frame& F, const AttnSrc<DQK>& S, int q0, int lat0, int ctx0, int kt0, int kt1) {
    constexpr int NKS = DQK / 16, KB = DQK * 128, SLOT = KB + 8192;
    constexpr float THR = 8.0f;
    const int lane = F.lane, wid = F.wave, r32 = lane & 31, hi = lane >> 5;
    LAS unsigned char* lds = F.lds;
    constexpr bool QLDS = false;
    bf16x8 qf[QLDS ? 1 : NKS];
    LAS unsigned char* qfl = lds + 4 * SLOT + wid * (NKS * 1024) + lane * 16;
    { const bf16_t* qrow = S.Q + (size_t)(q0 + wid * 32 + r32) * S.qpitch;
#pragma unroll
      for (int ks = 0; ks < 4; ++ks) { const bf16x8 v = *(const bf16x8*)(qrow + ks * 16 + hi * 8); if (QLDS) *(LAS bf16x8*)(qfl + ks * 1024) = v; else qf[ks] = v; }
      if (DQK == 96) { const bf16_t* qr = S.Qr + (size_t)(q0 + wid * 32 + r32) * S.qpitch;
#pragma unroll
          for (int ks = 4; ks < NKS; ++ks) { const bf16x8 v = *(const bf16x8*)(qr + (ks - 4) * 16 + hi * 8); if (QLDS) *(LAS bf16x8*)(qfl + ks * 1024) = v; else qf[ks] = v; } } }
    const unsigned lds0 = (unsigned)(size_t)lds;
    auto dma = [&](int kt, int slot) {
        const int krow = attn_krow(kt, lat0, ctx0);
        const unsigned sb = lds0 + slot * SLOT;
        glds16(S.Kn + (size_t)(krow + lane) * S.kpitch + wid * 8, (unsigned)__builtin_amdgcn_readfirstlane(sb + wid * 1024));
        if (DQK == 96 && wid < 4) glds16(S.Kr + (size_t)(krow + lane) * S.krpitch + wid * 8, (unsigned)__builtin_amdgcn_readfirstlane(sb + (8 + wid) * 1024));
        glds16(S.V + (size_t)(krow + 16 * (wid & 3) + (lane >> 2)) * S.vpitch + (wid >> 2) * 32 + (lane & 3) * 8, (unsigned)__builtin_amdgcn_readfirstlane(sb + KB + wid * 1024));
    };
    auto wait_bar = [&](bool inflight) {
        if (!inflight) { WAIT_BAR(0); } else if (DQK == 96 && wid < 4) { WAIT_BAR(3); } else { WAIT_BAR(2); }
    };
    f32x16 oT[2]; f32x16 negm;
#pragma unroll
    for (int r = 0; r < 16; ++r) { oT[0][r] = 0.f; oT[1][r] = 0.f; negm[r] = 0.f; }
    float mrun = 0.f, lrun = 0.f;
    const int vlane = ((lane >> 4) & 1) * 32 + (lane & 3) * 8 + (4 * hi + ((lane & 15) >> 2)) * 64;
    auto qk = [&](int slot, f32x16& p0, f32x16& p1) {
        const LAS unsigned char* kb = lds + slot * SLOT + hi * 1024 + r32 * 16;
        p0 = negm; p1 = negm;
#pragma unroll
        for (int ks = 0; ks < NKS; ++ks) {
            const bf16x8 k0 = *(const LAS bf16x8*)(kb + ks * 2048), k1 = *(const LAS bf16x8*)(kb + ks * 2048 + 512);
            p0 = __builtin_amdgcn_mfma_f32_32x32x16_bf16(k0, qf[ks], p0, 0, 0, 0);
            p1 = __builtin_amdgcn_mfma_f32_32x32x16_bf16(k1, qf[ks], p1, 0, 0, 0);
            if (ks & 1) asm volatile("" ::: "memory");
        }
    };
    auto tilemax = [&](f32x16& p0, f32x16& p1) -> float {
        asm volatile("s_nop 15\n\ts_nop 7" : "+v"(p0), "+v"(p1));
        float a = max3f(p0[0], p0[1], p1[0]), b = max3f(p0[2], p0[3], p1[1]); a = max3f(a, p1[2], p1[3]);
#pragma unroll
        for (int r = 4; r < 16; r += 4) { a = max3f(a, p0[r], p0[r + 1]); b = max3f(b, p0[r + 2], p0[r + 3]); a = max3f(a, p1[r], p1[r + 1]); b = max3f(b, p1[r + 2], p1[r + 3]); }
        float tm = fmaxf(a, b);
        auto rr = __builtin_amdgcn_permlane32_swap(__float_as_uint(tm), __float_as_uint(tm), false, false); return fmaxf(__uint_as_float(rr[0]), __uint_as_float(rr[1]));
    };
    auto smpv = [&](f32x16& p0, f32x16& p1, int slot) -> bool {
        const float tm = tilemax(p0, p1);
        bool moved = false;
        if (__any(tm > THR)) {
            const float dl = fmaxf(tm, 0.f); mrun += dl; const float al = __builtin_amdgcn_exp2f(-dl); lrun *= al;
#pragma unroll
            for (int r = 0; r < 16; ++r) { p0[r] -= dl; p1[r] -= dl; negm[r] = -mrun; oT[0][r] *= al; oT[1][r] *= al; }
            moved = true;
        }
        float rs = 0.f;
#pragma unroll
        for (int r = 0; r < 16; ++r) { p0[r] = __builtin_amdgcn_exp2f(p0[r]); p1[r] = __builtin_amdgcn_exp2f(p1[r]); rs += p0[r] + p1[r]; }
        lrun += rs;
        bf16x8 pf[4];
        { u32x4 w;
          w.x = cvtpk(p0[0], p0[1]); w.y = cvtpk(p0[2], p0[3]); w.z = cvtpk(p0[4], p0[5]); w.w = cvtpk(p0[6], p0[7]); pf[0] = __builtin_bit_cast(bf16x8, w);
          w.x = cvtpk(p0[8], p0[9]); w.y = cvtpk(p0[10], p0[11]); w.z = cvtpk(p0[12], p0[13]); w.w = cvtpk(p0[14], p0[15]); pf[1] = __builtin_bit_cast(bf16x8, w);
          w.x = cvtpk(p1[0], p1[1]); w.y = cvtpk(p1[2], p1[3]); w.z = cvtpk(p1[4], p1[5]); w.w = cvtpk(p1[6], p1[7]); pf[2] = __builtin_bit_cast(bf16x8, w);
          w.x = cvtpk(p1[8], p1[9]); w.y = cvtpk(p1[10], p1[11]); w.z = cvtpk(p1[12], p1[13]); w.w = cvtpk(p1[14], p1[15]); pf[3] = __builtin_bit_cast(bf16x8, w); }
        const LAS unsigned char* vb = lds + slot * SLOT + KB + vlane;
#pragma unroll
        for (int d0 = 0; d0 < 2; ++d0)
#pragma unroll
            for (int ks = 0; ks < 4; ++ks) {
                const s16x4 lo = vtr(vb + d0 * 4096 + ks * 1024), hh = vtr(vb + d0 * 4096 + ks * 1024 + 512);
                const bf16x8 vf = (bf16x8){lo[0], lo[1], lo[2], lo[3], hh[0], hh[1], hh[2], hh[3]};
                oT[d0] = __builtin_amdgcn_mfma_f32_32x32x16_bf16(vf, pf[ks], oT[d0], 0, 0, 0);
                if (ks & 1) asm volatile("" ::: "memory");
            }
        return moved;
    };
    dma(kt0, 0); dma(kt0 + 1, 1); dma(kt0 + 2, 2);
    wait_bar(true);
    f32x16 pA0, pA1, pB0, pB1;
    qk(0, pA0, pA1);
    { mrun = tilemax(pA0, pA1);
#pragma unroll
      for (int r = 0; r < 16; ++r) negm[r] = -mrun;
      qk(0, pA0, pA1); }
    int sc = 0;
    for (int kt = kt0; kt < kt1; kt += 2) {
        { const int s1 = (sc + 1) & 3, s3 = (sc + 3) & 3;
          if (kt + 3 < kt1) dma(kt + 3, s3);
          qk(s1, pB0, pB1);
          if (smpv(pA0, pA1, sc)) qk(s1, pB0, pB1);
          wait_bar(kt + 3 < kt1);
          sc = s1; }
        { const int s1 = (sc + 1) & 3, s3 = (sc + 3) & 3;
          if (kt + 4 < kt1) dma(kt + 4, s3);
          if (kt + 2 < kt1) qk(s1, pA0, pA1);
          if (smpv(pB0, pB1, sc) && kt + 2 < kt1) qk(s1, pA0, pA1);
          wait_bar(kt + 4 < kt1);
          sc = s1; }
    }
    { auto rr = __builtin_amdgcn_permlane32_swap(__float_as_uint(lrun), __float_as_uint(lrun), false, false); lrun = __uint_as_float(rr[0]) + __uint_as_float(rr[1]); }
    const float inv = 1.0f / lrun;
    bf16_t* orow = S.O + (size_t)(q0 + wid * 32 + r32) * S.opitch;
#pragma unroll
    for (int d0 = 0; d0 < 2; ++d0)
#pragma unroll
        for (int g = 0; g < 4; ++g) { u32x2 w; w.x = cvtpk(oT[d0][4 * g] * inv, oT[d0][4 * g + 1] * inv); w.y = cvtpk(oT[d0][4 * g + 2] * inv, oT[d0][4 * g + 3] * inv);
            *(u32x2*)(orow + 32 * d0 + 8 * g + 4 * hi) = w; }
}

__device__ __forceinline__ int sig5(int c) { return (c & ~12) | ((c & 8) >> 1) | ((c & 4) << 1); }

__global__ void __launch_bounds__(512, 2) mk_fwd(Args args) {
    extern __shared__ __attribute__((aligned(16))) unsigned char lds_raw[];
    Frame F;
    F.lds = (LAS unsigned char*)lds_raw; F.ws = args.ws;
    F.tid = threadIdx.x; F.lane = F.tid & 63; F.wave = __builtin_amdgcn_readfirstlane(F.tid >> 6);
    F.G = gridDim.x; { const int bx = blockIdx.x; F.vcu = (F.G % 8 == 0) ? (bx % 8) * (F.G / 8) + bx / 8 : bx; }
    volatile LAS unsigned* MISC = (volatile LAS unsigned*)(F.lds + LDSCTL_OFF);
    if (F.tid < 64) MISC[F.tid] = 0u;
    __syncthreads();
    unsigned* ctl = wsp<unsigned>(F, O_CTL);
#if MK_ONE_LAUNCH
    XcdBarrier bar = xcd_barrier_post(ctl + CW_BAR, MISC + 8);
#define GRID_BAR() xcd_barrier(bar)
#else
#define GRID_BAR() do {} while (0)
#endif
    const int lo = args.ph_lo, hi_ph = args.ph_hi;
#define IN(k) (lo <= (k) && (k) < hi_ph)
#define SEAM(k) do { if (IN(k) && IN((k) + 1)) GRID_BAR(); } while (0)
    const int lane = F.lane, wave = F.wave, tid = F.tid;
    const int gw = F.vcu * 8 + wave, NGW = F.G * 8;

    const float* x_in = args.in[I_X]; const float* ctx_in = args.in[I_CTX];
    float* MODV = wsp<float>(F, O_MODV);
    float* TAB16 = wsp<float>(F, O_TAB16); float* TAB32 = wsp<float>(F, O_TAB32);
    float* HC = wsp<float>(F, O_HC);
    bf16_t* U = wsp<bf16_t>(F, O_U);
    float* Y = wsp<float>(F, O_Y);
    const float* normg = args.in[I_NORMG];
#define MV(layer, bidx, k) (MODV + ((size_t)((layer) * 5 + (bidx)) * 6 + (k)) * D)

    if (IN(0)) {
        {
            LAS float* sc = (LAS float*)F.lds;
            LAS float* red = sc + 5 * 1024;
            for (int i = tid; i < 5 * 1024; i += 512) { const int b = i >> 10, k = i & 1023; const float cv = (b < 4) ? args.in[I_C][b * 1024 + k] : args.in[I_CCTX][k]; sc[i] = cv / (1.0f + __expf(-cv)); }
            __syncthreads();
            for (int unit = F.vcu; unit < 192; unit += F.G) {
                const int layer = unit / 96, cb = unit % 96, col = cb * 64 + lane;
                const float* W = args.in[I_MODW] + (size_t)layer * D * 6144 + col;
                float a0 = 0.f, a1 = 0.f, a2 = 0.f, a3 = 0.f, a4 = 0.f;
#pragma unroll 16
                for (int kk = 0; kk < 128; ++kk) { const int k = wave * 128 + kk; const float w = W[(size_t)k * 6144];
                    a0 += sc[k] * w; a1 += sc[1024 + k] * w; a2 += sc[2048 + k] * w; a3 += sc[3072 + k] * w; a4 += sc[4096 + k] * w; }
                red[(wave * 5 + 0) * 64 + lane] = a0; red[(wave * 5 + 1) * 64 + lane] = a1; red[(wave * 5 + 2) * 64 + lane] = a2; red[(wave * 5 + 3) * 64 + lane] = a3; red[(wave * 5 + 4) * 64 + lane] = a4;
                __syncthreads();
                if (tid < 320) { const int b = tid >> 6, cc = tid & 63; float s = 0.f;
#pragma unroll
                    for (int w = 0; w < 8; ++w) s += red[(w * 5 + b) * 64 + cc];
                    MODV[(size_t)(layer * 5 + b) * 6144 + cb * 64 + cc] = s + args.in[I_MODB][layer * 6144 + cb * 64 + cc]; }
                __syncthreads();
            }
        }
        if (blockIdx.x == 0) {
            for (int i = tid; i < 64 * 8; i += 512) { const int pos = i >> 3, f = i & 7; const float fr = powf(10000.0f, -(float)f / 8.0f), a = (float)pos * fr; TAB16[i] = cosf(a); TAB16[512 + i] = sinf(a); }
            for (int i = tid; i < 64 * 16; i += 512) { const int pos = i >> 4, f = i & 15; const float fr = powf(10000.0f, -(float)f / 16.0f), a = (float)pos * fr; TAB32[i] = cosf(a); TAB32[1024 + i] = sinf(a); }
        }
        {
            LAS float* scr = (LAS float*)(F.lds + wave * 16640);
            int base = 0;
            auto run = [&](const Conv& c) { const int n = (c.K / 64) * (c.Ndst / 32); for (int it = gw - base; it < n; it += NGW) { if (it >= 0) conv_item(c, it, scr, lane); }
                base = (base + n) % NGW; };
            auto run64 = [&](const Conv64& c) { const int n = (c.K / 64) * (c.Ndst / 64); for (int it = gw - base; it < n; it += NGW) { if (it >= 0) conv64_item(c, it, scr, lane); }
                base = (base + n) % NGW; };
            for (int e = 0; e < NEXP; ++e) {
                run64(Conv64{args.in[I_MWG] + (size_t)e * D * EXD, args.in[I_MWU] + (size_t)e * D * EXD, EXD, 1024, N_GU1, wsp<bf16_t>(F, O_WGU1) + (size_t)e * N_GU1 * 1024 / 2, 3, 0, 0, 64.0f, 1});
                run64(Conv64{args.in[I_MWD] + (size_t)e * EXD * D, nullptr, 1024, EXD, 1024, wsp<bf16_t>(F, O_WD1) + (size_t)e * 1024 * EXD / 2, 0, 1024, 1024, 64.0f, 1});
            }
            run64(Conv64{args.in[I_FWG], args.in[I_FWU], FFN, 1024, N_GU0, wsp<bf16_t>(F, O_WGU0), 3, 0, 0, 1.0f, 0});
            run64(Conv64{args.in[I_FWD], nullptr, 1024, FFN, 1024, wsp<bf16_t>(F, O_WD0), 0, 1024, 0, 1.0f, 0});
            run64(Conv64{args.in[I_GWIN], nullptr, 3104, 1024, N_IN1, wsp<bf16_t>(F, O_WIN1), 0, 3104, 512, 0.08838834764831845f, 0});
            run64(Conv64{args.in[I_GWOUT], nullptr, 1024, 1024, 1024, wsp<bf16_t>(F, O_WOUT1), 0, 1024, 0, 1.0f, 0});
            run64(Conv64{args.in[I_AWOUT], nullptr, 1024, 1024, 1024, wsp<bf16_t>(F, O_WOUT0), 0, 1024, 0, 1.0f, 0});
            run(Conv{args.in[I_AWIN], nullptr, 1440, 1024, N_IN0, wsp<bf16_t>(F, O_WIN0), 1, nullptr});
            run(Conv{args.in[I_AWUQ], nullptr, 768, 384, N_QA, wsp<bf16_t>(F, O_WUQ), 2, args.in[I_AQN]});
            run(Conv{args.in[I_AWUKV], nullptr, 1024, 256, N_KVA, wsp<bf16_t>(F, O_WUKV), 0, args.in[I_AKVN]});
        }
    }
    SEAM(0);

    if (IN(1)) {
        for (int row = gw; row < R; row += NGW) {
            const float* hp = row < RL ? x_in + (size_t)row * D : ctx_in + (size_t)(row - RL) * D;
            f32x4 h[4], uo[4]; load_row(hp, lane, h);
            const int b = row_bidx(row);
            norm_mod_store(h, normg + 0 * D, MV(0, b, 0), MV(0, b, 1), U + (size_t)row * D, lane, uo);
        }
    }
    SEAM(1);

    if (IN(2)) {
        pg8::DenseProb P{U, wsp<bf16_t>(F, O_WIN0), 1024, 1024, 1024, {}}; P.ord.init(R / 256, N_IN0 / 256, F.G, (int)blockIdx.x);
        pg8::EpiBf16 E{wsp<bf16_t>(F, O_Z0), N_IN0, nullptr};
        pg8::gemm_phase(F.lds, P, E);
    }
    SEAM(2);

    if (IN(3)) {
        const bf16_t* Z0 = wsp<bf16_t>(F, O_Z0);
        float* RSQ = wsp<float>(F, O_RSTDQ); float* RSKV = wsp<float>(F, O_RSTDKV);
        bf16_t* QB = wsp<bf16_t>(F, O_QB); bf16_t* KBp = wsp<bf16_t>(F, O_KB); bf16_t* KR = wsp<bf16_t>(F, O_KR);
        const float* qkn = args.in[I_AQKN];
        for (int row = gw; row < R; row += NGW) {
            const unsigned* z32 = (const unsigned*)(Z0 + (size_t)row * N_IN0);
            float s = 0.f;
#pragma unroll
            for (int j = 0; j < 3; ++j) { const unsigned w = z32[lane + 64 * j]; const float a = bflo(w), b = bfhi(w); s += a * a + b * b; }
            s = wave_sum(s);
            float s2 = 0.f;
#pragma unroll
            for (int j = 0; j < 2; ++j) { const unsigned w = z32[192 + lane + 64 * j]; const float a = bflo(w), b = bfhi(w); s2 += a * a + b * b; }
            s2 = wave_sum(s2);
            if (lane == 0) { RSQ[row] = __builtin_amdgcn_rsqf(s * (1.0f / 384.0f) + EPS); RSKV[row] = __builtin_amdgcn_rsqf(s2 * (1.0f / 256.0f) + EPS); }
            const bool lat = row < RL; const int tt = row & (SEQ - 1);
#pragma unroll
            for (int which = 0; which < 2; ++which) {
                if (which == 1 && lane >= 16) break;
                const u32x4 w4 = *(const u32x4*)(Z0 + (size_t)row * N_IN0 + (which ? 1152 : 640) + lane * 8);
                float v[8] = {bflo(w4.x), bfhi(w4.x), bflo(w4.y), bfhi(w4.y), bflo(w4.z), bfhi(w4.z), bflo(w4.w), bfhi(w4.w)};
                float ss = 0.f;
#pragma unroll
                for (int j = 0; j < 8; ++j) ss += v[j] * v[j];
                ss += __shfl_xor(ss, 1); ss += __shfl_xor(ss, 2); ss += __shfl_xor(ss, 4);
                const float rstd = __builtin_amdgcn_rsqf(ss * (1.0f / 64.0f) + EPS);
                const int jp = lane & 7, half = jp >> 2, i0 = 4 * (jp & 3);
                const float* gn = qkn + which * 64 + half * 32;
#pragma unroll
                for (int pz = 0; pz < 4; ++pz) { v[2 * pz] *= rstd * gn[i0 + pz]; v[2 * pz + 1] *= rstd * gn[16 + i0 + pz]; }
                if (lat) { const int pos = half ? (tt & 63) : (tt >> 6);
                    const f32x4 cs = *(const f32x4*)(TAB32 + pos * 16 + i0), sn = *(const f32x4*)(TAB32 + 1024 + pos * 16 + i0);
#pragma unroll
                    for (int pz = 0; pz < 4; ++pz) { const float a = v[2 * pz], b = v[2 * pz + 1]; v[2 * pz] = a * cs[pz] - b * sn[pz]; v[2 * pz + 1] = b * cs[pz] + a * sn[pz]; } }
                const float osc = which ? 1.0f : 0.125f * LOG2E;
                u32x4 o; o.x = cvtpk(v[0] * osc, v[1] * osc); o.y = cvtpk(v[2] * osc, v[3] * osc); o.z = cvtpk(v[4] * osc, v[5] * osc); o.w = cvtpk(v[6] * osc, v[7] * osc);
                if (which == 0) *(u32x4*)(QB + (size_t)row * 512 + lane * 8) = o; else *(u32x4*)(KBp + (size_t)row * 128 + lane * 8) = o;
            }
            if (lane < 4) {
                const u32x4 w4 = *(const u32x4*)(Z0 + (size_t)row * N_IN0 + 1408 + lane * 8);
                float v[8] = {bflo(w4.x), bfhi(w4.x), bflo(w4.y), bfhi(w4.y), bflo(w4.z), bfhi(w4.z), bflo(w4.w), bfhi(w4.w)};
                if (lat) { const int half = lane >> 1, i0 = 4 * (lane & 1); const int pos = half ? (tt & 63) : (tt >> 6);
                    const f32x4 cs = *(const f32x4*)(TAB16 + pos * 8 + i0), sn = *(const f32x4*)(TAB16 + 512 + pos * 8 + i0);
#pragma unroll
                    for (int pz = 0; pz < 4; ++pz) { const float a = v[2 * pz], b = v[2 * pz + 1]; v[2 * pz] = a * cs[pz] - b * sn[pz]; v[2 * pz + 1] = b * cs[pz] + a * sn[pz]; } }
                u32x4 o; o.x = cvtpk(v[0], v[1]); o.y = cvtpk(v[2], v[3]); o.z = cvtpk(v[4], v[5]); o.w = cvtpk(v[6], v[7]);
                *(u32x4*)(KR + (size_t)row * 32 + lane * 8) = o;
            }
        }
    }
    SEAM(3);

    if (IN(4)) {
        { pg8::DenseProb P{wsp<bf16_t>(F, O_Z0), wsp<bf16_t>(F, O_WUQ), 384, N_IN0, 384, {}}; P.ord.init(R / 256, N_QA / 256, F.G, (int)blockIdx.x);
          pg8::EpiQA E{wsp<bf16_t>(F, O_QA), wsp<float>(F, O_RSTDQ), TAB16, 0.10206207261596577f * LOG2E};
          pg8::gemm_phase(F.lds, P, E); }
        { pg8::DenseProb P{wsp<bf16_t>(F, O_Z0) + 384, wsp<bf16_t>(F, O_WUKV), 256, N_IN0, 256, {}}; P.ord.init(R / 256, N_KVA / 256, F.G, (int)((blockIdx.x + F.G - (204 % F.G)) % F.G));
          pg8::EpiBf16 E{wsp<bf16_t>(F, O_KVA), N_KVA, wsp<float>(F, O_RSTDKV)};
          pg8::gemm_phase(F.lds, P, E); }
    }
    SEAM(4);

    if (IN(5)) {
        const bf16_t* QA = wsp<bf16_t>(F, O_QA); const bf16_t* KVA = wsp<bf16_t>(F, O_KVA); const bf16_t* QB = wsp<bf16_t>(F, O_QB);
        const bf16_t* KBp = wsp<bf16_t>(F, O_KB); const bf16_t* KR = wsp<bf16_t>(F, O_KR); const bf16_t* Z0 = wsp<bf16_t>(F, O_Z0);
        bf16_t* AO = wsp<bf16_t>(F, O_AO);
        for (int i = 0; i < 3; ++i) {
            int b, hh, q0, kt0, kt1;
            if (i < 2) { const int m = i * 256 + F.vcu; b = m >> 7; hh = (m >> 4) & 7; q0 = b * SEQ + (m & 15) * 256; kt0 = 0; kt1 = 68; }
            else { if (F.vcu >= 32) break; b = (F.vcu >> 3) & 3; hh = F.vcu & 7; q0 = RL + b * CTX; kt0 = 64; kt1 = 68; }
            const int lat0 = b * SEQ, ctx0 = RL + b * CTX;
            AttnSrc<96> S{QA + hh * 64, N_QA, QA + 512 + hh * 32, KVA + hh * 128, N_KVA, KR, 32, KVA + hh * 128 + 64, N_KVA, AO + hh * 64, D};
            attn_unit<96>(F, S, q0, lat0, ctx0, kt0, kt1);
        }
        for (int i = 0; i < 3; ++i) {
            int b, hh, q0, kt0, kt1;
            if (i < 2) { const int m = i * 256 + F.vcu; b = m >> 7; hh = (m >> 4) & 7; q0 = b * SEQ + (m & 15) * 256; kt0 = 0; kt1 = 68; }
            else { if (F.vcu < 32 || F.vcu >= 64) break; b = (F.vcu >> 3) & 3; hh = F.vcu & 7; q0 = RL + b * CTX; kt0 = 64; kt1 = 68; }
            const int lat0 = b * SEQ, ctx0 = RL + b * CTX; const int kvh = hh >> 2;
            AttnSrc<64> S{QB + hh * 64, 512, nullptr, KBp + kvh * 64, 128, nullptr, 0, Z0 + 1280 + kvh * 64, N_IN0, AO + 512 + hh * 64, D};
            attn_unit<64>(F, S, q0, lat0, ctx0, kt0, kt1);
        }
    }
    SEAM(5);

    if (IN(6)) {
        pg8::DenseProb P{wsp<bf16_t>(F, O_AO), wsp<bf16_t>(F, O_WOUT0), 1024, 1024, 1024, {}}; P.ord.init(R / 256, 4, F.G, (int)blockIdx.x);
        pg8::EpiF32 E{Y, D};
        pg8::gemm_phase(F.lds, P, E);
    }
    SEAM(6);

    if (IN(7)) {
        for (int row = gw; row < R; row += NGW) {
            const float* hp = row < RL ? x_in + (size_t)row * D : ctx_in + (size_t)(row - RL) * D;
            float* ho = row < RL ? args.out + (size_t)row * D : HC + (size_t)(row - RL) * D;
            const int b = row_bidx(row);
            f32x4 y[4], h[4], uo[4]; load_row(Y + (size_t)row * D, lane, y); load_row(hp, lane, h);
            const float rstd = __builtin_amdgcn_rsqf(row_ssq(y) * (1.0f / D) + EPS);
#pragma unroll
            for (int j = 0; j < 4; ++j) { const int c = 4 * lane + 256 * j; const f32x4 g = *(const f32x4*)(normg + 1 * D + c), mg = *(const f32x4*)(MV(0, b, 2) + c);
                h[j] = h[j] + mg * (y[j] * rstd * g); *(f32x4*)(ho + c) = h[j]; }
            norm_mod_store(h, normg + 2 * D, MV(0, b, 3), MV(0, b, 4), U + (size_t)row * D, lane, uo);
        }
    }
    SEAM(7);

    if (IN(8)) {
        pg8::DenseProb P{U, wsp<bf16_t>(F, O_WGU0), 1024, 1024, 1024, {}}; P.ord.init(R / 256, N_GU0 / 256, F.G, (int)blockIdx.x);
        pg8::EpiSwiglu E{wsp<bf16_t>(F, O_H0), FFN};
        pg8::gemm_phase(F.lds, P, E);
    }
    SEAM(8);
    if (IN(9)) {
        pg8::DenseProb P{wsp<bf16_t>(F, O_H0), wsp<bf16_t>(F, O_WD0), FFN, FFN, FFN, {}}; P.ord.init(R / 256, 4, F.G, (int)blockIdx.x);
        pg8::EpiF32 E{Y, D};
        pg8::gemm_phase(F.lds, P, E);
    }
    SEAM(9);

    if (IN(10)) {
        for (int row = gw; row < R; row += NGW) {
            float* hp = row < RL ? args.out + (size_t)row * D : HC + (size_t)(row - RL) * D;
            const int b = row_bidx(row);
            f32x4 y[4], h[4], uo[4]; load_row(Y + (size_t)row * D, lane, y); load_row(hp, lane, h);
            const float rstd = __builtin_amdgcn_rsqf(row_ssq(y) * (1.0f / D) + EPS);
#pragma unroll
            for (int j = 0; j < 4; ++j) { const int c = 4 * lane + 256 * j; const f32x4 g = *(const f32x4*)(normg + 3 * D + c), mg = *(const f32x4*)(MV(0, b, 5) + c);
                h[j] = h[j] + mg * (y[j] * rstd * g); *(f32x4*)(hp + c) = h[j]; }
            norm_mod_store(h, normg + 4 * D, MV(1, b, 0), MV(1, b, 1), U + (size_t)row * D, lane, uo);
        }
    }
    SEAM(10);

    if (IN(11)) {
        pg8::DenseProb P{U, wsp<bf16_t>(F, O_WIN1), 1024, 1024, 1024, {}}; P.ord.init(R / 256, N_IN1 / 256, F.G, (int)blockIdx.x);
        pg8::EpiIn1 E{wsp<bf16_t>(F, O_QK1), wsp<bf16_t>(F, O_V1), wsp<bf16_t>(F, O_G1), wsp<bf16_t>(F, O_RR)};
        pg8::gemm_phase(F.lds, P, E);
    }
    SEAM(11);

    if (IN(12)) {
        const bf16_t* QK1 = wsp<bf16_t>(F, O_QK1); const bf16_t* V1 = wsp<bf16_t>(F, O_V1); const bf16_t* RRp = wsp<bf16_t>(F, O_RR);
        bf16_t* QDd[2] = {wsp<bf16_t>(F, O_QDF), wsp<bf16_t>(F, O_QDB)}; bf16_t* KId[2] = {wsp<bf16_t>(F, O_KIF), wsp<bf16_t>(F, O_KIB)}; bf16_t* KTd[2] = {wsp<bf16_t>(F, O_KTF), wsp<bf16_t>(F, O_KTB)};
        bf16_t* VT = wsp<bf16_t>(F, O_VT); float* ECL = wsp<float>(F, O_ECL);
        LAS float* tot = (LAS float*)F.lds;
        const int dk = tid & 127, tq = tid >> 7;
        for (int item = F.vcu; item < 544 * 4; item += F.G) {
            const int rc = item >> 2, hh = item & 3, row0 = rc * 32;
            float w2[2][16], bg[2];
#pragma unroll
            for (int d = 0; d < 2; ++d) { bg[d] = args.in[I_GBGATE][d * 512 + hh * 128 + dk];
#pragma unroll
                for (int j = 0; j < 16; ++j) w2[d][j] = args.in[I_GGATE2][(size_t)(d * 16 + j) * 512 + hh * 128 + dk]; }
            float a[2][8];
#pragma unroll
            for (int i = 0; i < 8; ++i) { const int row = row0 + 8 * tq + i;
                const u32x4* rp = (const u32x4*)(RRp + (size_t)row * 256);
#pragma unroll
                for (int d = 0; d < 2; ++d) { const u32x4 r0 = rp[2 * d], r1 = rp[2 * d + 1];
                    const float rv[16] = {bflo(r0.x), bfhi(r0.x), bflo(r0.y), bfhi(r0.y), bflo(r0.z), bfhi(r0.z), bflo(r0.w), bfhi(r0.w), bflo(r1.x), bfhi(r1.x), bflo(r1.y), bfhi(r1.y), bflo(r1.z), bfhi(r1.z), bflo(r1.w), bfhi(r1.w)};
                    float z = bg[d];
#pragma unroll
                    for (int j = 0; j < 16; ++j) z += rv[j] * w2[d][j];
                    a[d][i] = (fminf(z, 0.f) - __logf(1.0f + __expf(-fabsf(z)))) * (1.0f / 16.0f); } }
            float cf[8], sb[8];
            { float s = 0.f;
#pragma unroll
              for (int i = 0; i < 8; ++i) { s += a[0][i]; cf[i] = s; }
              s = 0.f;
#pragma unroll
              for (int i = 7; i >= 0; --i) { s += a[1][i]; sb[i] = s; } }
            tot[(0 * 4 + tq) * 128 + dk] = cf[7]; tot[(1 * 4 + tq) * 128 + dk] = sb[0];
            __syncthreads();
            float offF = 0.f, offB = 0.f, clF = 0.f, clB = 0.f;
#pragma unroll
            for (int g = 0; g < 4; ++g) { const float tf = tot[(0 * 4 + g) * 128 + dk], tb = tot[(1 * 4 + g) * 128 + dk]; clF += tf; clB += tb; if (g < tq) offF += tf; if (g > tq) offB += tb; }
            __syncthreads();
            const int pc = hh * 128 + (dk & ~31) + sig5(dk & 31);
            unsigned ktw[2][4];
#pragma unroll
            for (int i = 0; i < 8; ++i) { const int row = row0 + 8 * tq + i;
                const float q = bf2f(QK1[(size_t)row * D + hh * 128 + dk]), k = bf2f(QK1[(size_t)row * D + 512 + hh * 128 + dk]);
                const float cF = offF + cf[i], cB = offB + sb[i];
                const float kiF = k * __expf(-cF), kiB = k * __expf(-cB);
                QDd[0][(size_t)row * 512 + pc] = f2bf(q * __expf(cF)); KId[0][(size_t)row * 512 + pc] = f2bf(kiF);
                QDd[1][(size_t)row * 512 + pc] = f2bf(q * __expf(cB)); KId[1][(size_t)row * 512 + pc] = f2bf(kiB);
                const unsigned bF = f2bf(kiF), bB = f2bf(kiB);
                if (i & 1) { ktw[0][i >> 1] |= bF << 16; ktw[1][i >> 1] |= bB << 16; } else { ktw[0][i >> 1] = bF; ktw[1][i >> 1] = bB; } }
#pragma unroll
            for (int d = 0; d < 2; ++d) { bf16_t* kt = KTd[d] + ((size_t)(rc * 4 + hh) * 128 + dk) * 32 + 16 * (tq >> 1) + 4 * (tq & 1);
                u32x2 w0; w0.x = ktw[d][0]; w0.y = ktw[d][1]; *(u32x2*)kt = w0; u32x2 w1; w1.x = ktw[d][2]; w1.y = ktw[d][3]; *(u32x2*)(kt + 8) = w1; }
            if (tq == 0) { ECL[((size_t)(rc * 2 + 0) * 4 + hh) * 256 + dk] = __expf(clF); ECL[((size_t)(rc * 2 + 1) * 4 + hh) * 256 + dk] = __expf(clB); }
            { const int dv = tid & 255, th = tid >> 8; unsigned vw[8];
#pragma unroll
              for (int i = 0; i < 16; ++i) { const unsigned bv = V1[(size_t)(row0 + 16 * th + i) * D + hh * 256 + dv];
                  const int cc = sig5(i);
                  if (cc & 1) vw[cc >> 1] |= bv << 16; else vw[cc >> 1] = bv; }
              bf16_t* vp = VT + ((size_t)rc * 1024 + hh * 256 + dv) * 32 + 16 * th;
              u32x4 o0; o0.x = vw[0]; o0.y = vw[1]; o0.z = vw[2]; o0.w = vw[3]; *(u32x4*)vp = o0;
              u32x4 o1; o1.x = vw[4]; o1.y = vw[5]; o1.z = vw[6]; o1.w = vw[7]; *(u32x4*)(vp + 8) = o1; }
        }
    }
    SEAM(12);

    if (IN(13)) {
        const bf16_t* VT = wsp<bf16_t>(F, O_VT); const float* ECL = wsp<float>(F, O_ECL);
        constexpr int SLOT = 8192 * 3 + 2048 + 1024;
        const int r32 = lane & 31, hi = lane >> 5;
        for (int unit = F.vcu; unit < 256; unit += F.G) {
            const int chain = unit >> 3, dvb = unit & 7, b = chain >> 3, hh = (chain >> 1) & 3, dir = chain & 1;
            const bf16_t* QDp = wsp<bf16_t>(F, dir ? O_QDB : O_QDF); const bf16_t* KIp = wsp<bf16_t>(F, dir ? O_KIB : O_KIF); const bf16_t* KTp = wsp<bf16_t>(F, dir ? O_KTB : O_KTF);
            bf16_t* Odp = wsp<bf16_t>(F, dir ? O_OB : O_OF);
            auto rcof = [&](int step) { return step < 8 ? 512 + b * 8 + (dir ? 7 - step : step) : b * 128 + (dir ? 127 - (step - 8) : (step - 8)); };
            const unsigned lds0 = (unsigned)(size_t)F.lds;
            auto dma = [&](int step, int slot) {
                const int rc = rcof(step); const unsigned sb = lds0 + slot * SLOT;
                const int ch = lane >> 5, rw = lane & 31;
                glds16(KIp + (size_t)(rc * 32 + rw) * 512 + hh * 128 + (2 * wave + ch) * 8, (unsigned)__builtin_amdgcn_readfirstlane(sb + wave * 1024));
                glds16(QDp + (size_t)(rc * 32 + rw) * 512 + hh * 128 + (2 * wave + ch) * 8, (unsigned)__builtin_amdgcn_readfirstlane(sb + 8192 + wave * 1024));
                glds16(KTp + ((size_t)(rc * 4 + hh) * 128 + 32 * (wave >> 1) + rw) * 32 + (2 * (wave & 1) + ch) * 8, (unsigned)__builtin_amdgcn_readfirstlane(sb + 16384 + wave * 1024));
                if (wave < 2) glds16(VT + ((size_t)rc * 1024 + hh * 256 + dvb * 32 + rw) * 32 + (2 * wave + ch) * 8, (unsigned)__builtin_amdgcn_readfirstlane(sb + 24576 + wave * 1024));
                if (wave == 2) glds16(ECL + ((size_t)(rc * 2 + dir) * 4 + hh) * 256 + lane * 4, (unsigned)__builtin_amdgcn_readfirstlane(sb + 26624));
            };
            auto wait_bar = [&](bool inflight) { if (!inflight) { WAIT_BAR(0); } else if (wave < 3) { WAIT_BAR(4); } else { WAIT_BAR(3); } };
            f32x16 S4[4];
#pragma unroll
            for (int k = 0; k < 4; ++k)
#pragma unroll
                for (int r = 0; r < 16; ++r) S4[k][r] = 0.f;
            dma(0, 0); dma(1, 1);
            wait_bar(true);
            int slot = 0;
            for (int step = 0; step < 136; ++step) {
                if (step + 2 < 136) dma(step + 2, slot == 0 ? 2 : slot - 1);
                if (wave == 0) {
                    const LAS unsigned char* sb = F.lds + slot * SLOT;
                    const int fo = hi * 512 + r32 * 16;
                    bf16x8 qdF[8];
#pragma unroll
                    for (int k = 0; k < 8; ++k) qdF[k] = *(const LAS bf16x8*)(sb + 8192 + k * 1024 + fo);
                    const bf16x8 vF0 = *(const LAS bf16x8*)(sb + 24576 + fo), vF1 = *(const LAS bf16x8*)(sb + 24576 + 1024 + fo);
                    f32x16 o;
#pragma unroll
                    for (int r = 0; r < 16; ++r) o[r] = 0.f;
                    if (step >= 8) {
                        f32x16 sc;
#pragma unroll
                        for (int r = 0; r < 16; ++r) sc[r] = 0.f;
#pragma unroll
                        for (int k = 0; k < 8; ++k) { const bf16x8 kiF = *(const LAS bf16x8*)(sb + k * 1024 + fo); sc = __builtin_amdgcn_mfma_f32_32x32x16_bf16(kiF, qdF[k], sc, 0, 0, 0); }
#pragma unroll
                        for (int r = 0; r < 16; ++r) { const int s = (r & 3) + 8 * (r >> 2) + 4 * hi; const bool keep = dir ? (s >= r32) : (s <= r32); sc[r] = keep ? sc[r] : 0.f; }
                        u32x4 w; bf16x8 pf0, pf1;
                        w.x = cvtpk(sc[0], sc[1]); w.y = cvtpk(sc[2], sc[3]); w.z = cvtpk(sc[4], sc[5]); w.w = cvtpk(sc[6], sc[7]); pf0 = __builtin_bit_cast(bf16x8, w);
                        w.x = cvtpk(sc[8], sc[9]); w.y = cvtpk(sc[10], sc[11]); w.z = cvtpk(sc[12], sc[13]); w.w = cvtpk(sc[14], sc[15]); pf1 = __builtin_bit_cast(bf16x8, w);
                        o = __builtin_amdgcn_mfma_f32_32x32x16_bf16(pf0, vF0, o, 0, 0, 0);
                        o = __builtin_amdgcn_mfma_f32_32x32x16_bf16(pf1, vF1, o, 0, 0, 0);
#pragma unroll
                        for (int blk = 0; blk < 4; ++blk)
#pragma unroll
                            for (int s2 = 0; s2 < 2; ++s2) { u32x4 ws4; ws4.x = cvtpk(S4[blk][8 * s2], S4[blk][8 * s2 + 1]); ws4.y = cvtpk(S4[blk][8 * s2 + 2], S4[blk][8 * s2 + 3]);
                                ws4.z = cvtpk(S4[blk][8 * s2 + 4], S4[blk][8 * s2 + 5]); ws4.w = cvtpk(S4[blk][8 * s2 + 6], S4[blk][8 * s2 + 7]);
                                o = __builtin_amdgcn_mfma_f32_32x32x16_bf16(qdF[2 * blk + s2], __builtin_bit_cast(bf16x8, ws4), o, 0, 0, 0); }
                        const int rc = rcof(step);
                        bf16_t* op = Odp + (size_t)(rc * 32) * D + hh * 256 + dvb * 32 + r32;
#pragma unroll
                        for (int r = 0; r < 16; ++r) { const int t = (r & 3) + 8 * (r >> 2) + 4 * hi; op[(size_t)t * D] = f2bf(o[r]); }
                    }
#pragma unroll
                    for (int blk = 0; blk < 4; ++blk) {
                        const bf16x8 kt0 = *(const LAS bf16x8*)(sb + 16384 + blk * 2048 + fo), kt1 = *(const LAS bf16x8*)(sb + 16384 + blk * 2048 + 1024 + fo);
                        S4[blk] = __builtin_amdgcn_mfma_f32_32x32x16_bf16(kt0, vF0, S4[blk], 0, 0, 0);
                        S4[blk] = __builtin_amdgcn_mfma_f32_32x32x16_bf16(kt1, vF1, S4[blk], 0, 0, 0);
#pragma unroll
                        for (int g = 0; g < 4; ++g) { const f32x4 e4 = *(const LAS f32x4*)(sb + 26624 + (32 * blk + 8 * g + 4 * hi) * 4);
                            S4[blk][4 * g] *= e4[0]; S4[blk][4 * g + 1] *= e4[1]; S4[blk][4 * g + 2] *= e4[2]; S4[blk][4 * g + 3] *= e4[3]; }
                    }
                }
                wait_bar(step + 2 < 136);
                slot = (slot == 2) ? 0 : slot + 1;
            }
        }
    }
    SEAM(13);

    if (IN(14)) {
        const bf16_t* OFp = wsp<bf16_t>(F, O_OF); const bf16_t* OBp = wsp<bf16_t>(F, O_OB); const bf16_t* G1 = wsp<bf16_t>(F, O_G1); bf16_t* GA = wsp<bf16_t>(F, O_GA);
        const float* on = args.in[I_GONORM];
        for (int row = gw; row < RL; row += NGW) {
            const u32x4* pf = (const u32x4*)(OFp + (size_t)row * D + lane * 16); const u32x4* pb = (const u32x4*)(OBp + (size_t)row * D + lane * 16); const u32x4* pg = (const u32x4*)(G1 + (size_t)row * D + lane * 16);
            float v[16], gv[16];
#pragma unroll
            for (int q = 0; q < 2; ++q) { const u32x4 a = pf[q], bq = pb[q], gq = pg[q]; const unsigned aw[4] = {a.x, a.y, a.z, a.w}, bw[4] = {bq.x, bq.y, bq.z, bq.w}, gw4[4] = {gq.x, gq.y, gq.z, gq.w};
#pragma unroll
                for (int j = 0; j < 4; ++j) { v[8 * q + 2 * j] = bflo(aw[j]) + bflo(bw[j]); v[8 * q + 2 * j + 1] = bfhi(aw[j]) + bfhi(bw[j]); gv[8 * q + 2 * j] = bflo(gw4[j]); gv[8 * q + 2 * j + 1] = bfhi(gw4[j]); } }
            float ss = 0.f;
#pragma unroll
            for (int j = 0; j < 16; ++j) ss += v[j] * v[j];
            ss += __shfl_xor(ss, 1); ss += __shfl_xor(ss, 2); ss += __shfl_xor(ss, 4); ss += __shfl_xor(ss, 8);
            const float rstd = __builtin_amdgcn_rsqf(ss * (1.0f / 256.0f) + EPS);
            const int c0 = (lane & 15) * 16;
            unsigned ow[8];
#pragma unroll
            for (int j = 0; j < 8; ++j) { const float a = v[2 * j] * rstd * on[c0 + 2 * j] * silu_f(gv[2 * j]), bq = v[2 * j + 1] * rstd * on[c0 + 2 * j + 1] * silu_f(gv[2 * j + 1]); ow[j] = cvtpk(a, bq); }
            u32x4* po = (u32x4*)(GA + (size_t)row * D + lane * 16);
            u32x4 o0; o0.x = ow[0]; o0.y = ow[1]; o0.z = ow[2]; o0.w = ow[3]; po[0] = o0; u32x4 o1; o1.x = ow[4]; o1.y = ow[5]; o1.z = ow[6]; o1.w = ow[7]; po[1] = o1;
        }
    }
    SEAM(14);

    if (IN(15)) {
        pg8::DenseProb P{wsp<bf16_t>(F, O_GA), wsp<bf16_t>(F, O_WOUT1), 1024, 1024, 1024, {}}; P.ord.init(RL / 256, 4, F.G, (int)blockIdx.x);
        pg8::EpiF32 E{Y, D};
        pg8::gemm_phase(F.lds, P, E);
    }
    SEAM(15);

    if (IN(16)) {
        int* SEL = wsp<int>(F, O_SEL); int* ROWTOK = wsp<int>(F, O_ROWTOK);
        LAS float* wr_l = (LAS float*)F.lds;
        LAS int* se = (LAS int*)(F.lds + 32768);
        LAS float* sw = (LAS float*)(F.lds + 32768 + 512);
        LAS int* sbase = (LAS int*)(F.lds + 32768 + 1024);
        for (int i = tid; i < 8192; i += 512) wr_l[i] = args.in[I_MROUTER][i];
        __syncthreads();
        for (int tile = F.vcu; tile < RL / 64; tile += F.G) {
            for (int rr = 0; rr < 8; ++rr) {
                const int lr = wave * 8 + rr, row = tile * 64 + lr; const int b = row >> 12;
                float* hp = args.out + (size_t)row * D;
                f32x4 y[4], h[4], uo[4]; load_row(Y + (size_t)row * D, lane, y); load_row(hp, lane, h);
                const float rstd = __builtin_amdgcn_rsqf(row_ssq(y) * (1.0f / D) + EPS);
#pragma unroll
                for (int j = 0; j < 4; ++j) { const int c = 4 * lane + 256 * j; const f32x4 g = *(const f32x4*)(normg + 5 * D + c), mg = *(const f32x4*)(MV(1, b, 2) + c);
                    h[j] = h[j] + mg * (y[j] * rstd * g); *(f32x4*)(hp + c) = h[j]; }
                norm_mod_store(h, normg + 6 * D, MV(1, b, 3), MV(1, b, 4), nullptr, lane, uo, wsp<unsigned char>(F, O_U) + (size_t)row * D);
                float lg[8];
#pragma unroll
                for (int e = 0; e < 8; ++e) lg[e] = 0.f;
#pragma unroll
                for (int j = 0; j < 4; ++j)
#pragma unroll
                    for (int q = 0; q < 4; ++q) { const int k = 4 * lane + 256 * j + q; const LAS f32x4* wp = (const LAS f32x4*)(wr_l + k * 8); const f32x4 w0 = wp[0], w1 = wp[1]; const float uv = uo[j][q];
                        lg[0] += uv * w0[0]; lg[1] += uv * w0[1]; lg[2] += uv * w0[2]; lg[3] += uv * w0[3]; lg[4] += uv * w1[0]; lg[5] += uv * w1[1]; lg[6] += uv * w1[2]; lg[7] += uv * w1[3]; }
#pragma unroll
                for (int e = 0; e < 8; ++e) lg[e] = wave_sum(lg[e]) + args.in[I_MBROUTER][e];
                int e0 = 0; float l0 = lg[0];
#pragma unroll
                for (int e = 1; e < 8; ++e) if (lg[e] > l0) { l0 = lg[e]; e0 = e; }
                int e1 = -1; float l1 = -3.0e38f;
#pragma unroll
                for (int e = 0; e < 8; ++e) if (e != e0 && lg[e] > l1) { l1 = lg[e]; e1 = e; }
                const float p1 = __expf(l1 - l0), w0n = 1.0f / (1.0f + p1), w1n = p1 / (1.0f + p1);
                if (lane == 0) { se[lr * 2] = e0; se[lr * 2 + 1] = e1; sw[lr * 2] = w0n; sw[lr * 2 + 1] = w1n; }
            }
            __syncthreads();
            if (tid < 8) { int c = 0; for (int r2 = 0; r2 < 64; ++r2) c += (se[2 * r2] == tid) + (se[2 * r2 + 1] == tid);
                sbase[tid] = (int)__hip_atomic_fetch_add(ctl + CW_CNT + 64 * tid, (unsigned)c, RLX_AGENT); }
            __syncthreads();
            if (tid < 64) { const int e0 = se[2 * tid], e1 = se[2 * tid + 1]; int r0 = 0, r1 = 0;
                for (int r2 = 0; r2 < tid; ++r2) { const int a0 = se[2 * r2], a1 = se[2 * r2 + 1]; r0 += (a0 == e0) + (a1 == e0); r1 += (a0 == e1) + (a1 == e1); }
                const int p0 = sbase[e0] + r0, p1 = sbase[e1] + r1, tok = tile * 64 + tid;
                ROWTOK[e0 * CAPE + p0] = tok; ROWTOK[e1 * CAPE + p1] = tok;
                int* sp = SEL + (size_t)tok * 8; sp[0] = e0; sp[1] = p0; sp[2] = e1; sp[3] = p1; sp[4] = __float_as_int(sw[2 * tid]); sp[5] = __float_as_int(sw[2 * tid + 1]); }
            __syncthreads();
        }
    }
    SEAM(16);

    pg8::MoeTiles MT;
    if (IN(17) || IN(18) || IN(19)) {
        int acc = 0; MT.tp8 = 0ull; MT.c4a = 0ull; MT.c4b = 0ull;
#pragma unroll
        for (int e = 0; e < 8; ++e) { const int c = (int)__builtin_amdgcn_readfirstlane((int)__hip_atomic_load(ctl + CW_CNT + 64 * e, RLX_AGENT));
            if (e < 4) MT.c4a |= (unsigned long long)(unsigned)c << (16 * e); else MT.c4b |= (unsigned long long)(unsigned)c << (16 * (e - 4));
            MT.tp8 |= (unsigned long long)(unsigned)acc << (8 * e); acc += (c + 255) >> 8; }
        MT.nt = acc;
    }
    if (IN(17)) {
        pg8::MoeGuProb P{wsp<unsigned char>(F, O_U), wsp<unsigned char>(F, O_WGU1), 512, 512, {}, MT, wsp<int>(F, O_ROWTOK)}; P.ord.init(MT.nt, N_GU1 / 256, F.G, (int)blockIdx.x);
        pg8::EpiSwiglu8 E{wsp<unsigned char>(F, O_HM), EXD};
        pg8::gemm_phase(F.lds, P, E);
    }
    SEAM(17);
    if (IN(18)) {
        pg8::MoeDnProb P{wsp<unsigned char>(F, O_HM), wsp<unsigned char>(F, O_WD1), EXD / 2, EXD / 2, {}, MT}; P.ord.init(MT.nt, 4, F.G, (int)blockIdx.x);
        pg8::EpiBf16 E{wsp<bf16_t>(F, O_YE), D, nullptr};
        pg8::gemm_phase(F.lds, P, E);
    }
    SEAM(18);
    if (IN(19)) {
        const int* SEL = wsp<int>(F, O_SEL); const bf16_t* YE = wsp<bf16_t>(F, O_YE);
        for (int row = gw; row < RL; row += NGW) {
            const int b = row >> 12; const int* sp = SEL + (size_t)row * 8;
            const int e0 = sp[0], p0 = sp[1], e1 = sp[2], p1 = sp[3]; const float w0 = __int_as_float(sp[4]), w1 = __int_as_float(sp[5]);
            const int t0 = pg8::moe_tp(MT, e0), t1 = pg8::moe_tp(MT, e1);
            const bf16_t* y0 = YE + ((size_t)t0 * 256 + p0) * D; const bf16_t* y1 = YE + ((size_t)t1 * 256 + p1) * D;
            float* hp = args.out + (size_t)row * D;
            f32x4 y[4], h[4]; load_row(hp, lane, h);
#pragma unroll
            for (int j = 0; j < 4; ++j) { const int c = 4 * lane + 256 * j; const u32x2 a = *(const u32x2*)(y0 + c), bq = *(const u32x2*)(y1 + c);
                y[j][0] = w0 * bflo(a.x) + w1 * bflo(bq.x); y[j][1] = w0 * bfhi(a.x) + w1 * bfhi(bq.x); y[j][2] = w0 * bflo(a.y) + w1 * bflo(bq.y); y[j][3] = w0 * bfhi(a.y) + w1 * bfhi(bq.y); }
            const float rstd = __builtin_amdgcn_rsqf(row_ssq(y) * (1.0f / D) + EPS);
#pragma unroll
            for (int j = 0; j < 4; ++j) { const int c = 4 * lane + 256 * j; const f32x4 g = *(const f32x4*)(normg + 7 * D + c), mg = *(const f32x4*)(MV(1, b, 5) + c);
                *(f32x4*)(hp + c) = h[j] + mg * (y[j] * rstd * g); }
        }
    }
#undef IN
#undef SEAM
#undef MV
}

constexpr int N_PHASES = 20;
extern "C" void kernel_launch(void* const* d_in, const int* in_sizes, int n_in, void* d_out, int out_size, void* d_ws, size_t ws_size, hipStream_t stream) {
    static int grid = 0;
    if (grid == 0) {
        if (n_in != 27 || out_size != RL * D || ws_size < WS_END) { fprintf(stderr, "kernel_launch: unexpected shapes n_in %d out %d ws %zu (need %zu)\n", n_in, out_size, ws_size, (size_t)WS_END); grid = -1; return; }
        int dev = 0, cus = 0, per_cu = 0;
        if (hipGetDevice(&dev) != hipSuccess || hipDeviceGetAttribute(&cus, hipDeviceAttributeMultiprocessorCount, dev) != hipSuccess) { grid = -1; return; }
        if (hipFuncSetAttribute((const void*)mk_fwd, hipFuncAttributeMaxDynamicSharedMemorySize, LDS_BYTES) != hipSuccess) { fprintf(stderr, "kernel_launch: hipFuncSetAttribute failed\n"); grid = -1; return; }
        if (hipOccupancyMaxActiveBlocksPerMultiprocessor(&per_cu, (const void*)mk_fwd, 512, LDS_BYTES) != hipSuccess || per_cu < 1) { fprintf(stderr, "kernel_launch: occupancy query says %d\n", per_cu); }
        (void)hipGetLastError();
        grid = cus;
        if (grid > 256) grid = 256;
    }
    if (grid < 0) return;
    (void)hipMemsetAsync((char*)d_ws + O_CTL, 0, CTL_BYTES, stream);
    Args a{};
    for (int i = 0; i < 27; ++i) a.in[i] = (const float*)d_in[i];
    a.out = (float*)d_out; a.ws = (unsigned char*)d_ws;
#if MK_ONE_LAUNCH
    a.ph_lo = 0; a.ph_hi = N_PHASES;
    hipLaunchKernelGGL(mk_fwd, dim3(grid), dim3(512), LDS_BYTES, stream, a);
#else
    for (int p = 0; p < N_PHASES; ++p) { a.ph_lo = p; a.ph_hi = p + 1; for (int rep = 0; rep < (p == MK_REP ? 2 : 1); ++rep) hipLaunchKernelGGL(mk_fwd, dim3(grid), dim3(512), LDS_BYTES, stream, a); }
#endif
}
```

```cpp
#include <hip/hip_runtime.h>
#include <cstdio>
#include <cstdint>

#ifndef MK_ONE_LAUNCH
#define MK_ONE_LAUNCH 1
#endif
#ifndef MK_EPI2
#define MK_EPI2 0
#endif
#ifndef MK_REP
#define MK_REP -1
#endif

#define LAS __attribute__((address_space(3)))
#define GAS __attribute__((address_space(1)))
typedef unsigned short bf16_t;
typedef short bf16x8 __attribute__((ext_vector_type(8)));
typedef short s16x4 __attribute__((ext_vector_type(4)));
typedef float f32x4 __attribute__((ext_vector_type(4)));
typedef float f32x16 __attribute__((ext_vector_type(16)));
typedef unsigned u32x4 __attribute__((ext_vector_type(4)));
typedef unsigned u32x2 __attribute__((ext_vector_type(2)));
typedef float f32x2_t __attribute__((ext_vector_type(2)));
typedef __bf16 bf16x2_t __attribute__((ext_vector_type(2)));
#define RLX_AGENT __ATOMIC_RELAXED, __HIP_MEMORY_SCOPE_AGENT

__device__ __forceinline__ unsigned cvtpk(float lo, float hi) { f32x2_t v = {lo, hi}; bf16x2_t b = __builtin_convertvector(v, bf16x2_t); return __builtin_bit_cast(unsigned, b); }
__device__ __forceinline__ bf16_t f2bf(float f) { return (bf16_t)(cvtpk(f, 0.f) & 0xffffu); }
__device__ __forceinline__ float bflo(unsigned w) { return __uint_as_float(w << 16); }
__device__ __forceinline__ float bfhi(unsigned w) { return __uint_as_float(w & 0xffff0000u); }
__device__ __forceinline__ float bf2f(bf16_t b) { return __uint_as_float(((unsigned)b) << 16); }
__device__ __forceinline__ float wave_sum(float v) {
#pragma unroll
    for (int o = 1; o < 64; o <<= 1) v += __shfl_xor(v, o);
    return v;
}
__device__ __forceinline__ float fast_exp(float x) { return __builtin_amdgcn_exp2f(x * 1.4426950408889634f); }
__device__ __forceinline__ float clamp8(float x) { return __builtin_amdgcn_fmed3f(x, -448.0f, 448.0f); }
__device__ __forceinline__ unsigned pack_fp8x4(float a, float b, float c, float d) { int w = __builtin_amdgcn_cvt_pk_fp8_f32(clamp8(a), clamp8(b), 0, false); w = __builtin_amdgcn_cvt_pk_fp8_f32(clamp8(c), clamp8(d), w, true); return (unsigned)w; }
__device__ __forceinline__ float silu_f(float g) { return g * __builtin_amdgcn_rcpf(1.0f + fast_exp(-g)); }

#define XB_TMO      128
#define XB_XCNT(j)  (256  + 64 * (j))
#define XB_XSUB(j)  (1280 + 64 * (j))
#define XB_XGEN(j)  (2304 + 64 * (j))
#define XB_TOP      3328
#define XB_TOPGEN   3392
#define XCD_BAR_WORDS 3456
#define XB_SPIN_CAP (1u << 18)
__device__ __forceinline__ unsigned xb_ld(unsigned* p)              { return __hip_atomic_load(p, __ATOMIC_RELAXED, __HIP_MEMORY_SCOPE_AGENT); }
__device__ __forceinline__ unsigned xb_add(unsigned* p, unsigned v) { return __hip_atomic_fetch_add(p, v, __ATOMIC_RELAXED, __HIP_MEMORY_SCOPE_AGENT); }
__device__ __forceinline__ unsigned xb_xcc_id() { return (unsigned)__builtin_amdgcn_s_getreg((3 << 11) | 20) & 0xFu; }
#define XB_SPIN(cond, bar) do { unsigned _sp = 0; while (cond) { __builtin_amdgcn_s_sleep(1); \
    if ((++_sp & 255u) == 0u) { if (xb_ld(&(bar)[XB_TMO])) break; if (_sp > XB_SPIN_CAP) { atomicAdd(&(bar)[XB_TMO], 1u); break; } } } } while (0)
struct XcdBarrier { unsigned* bar; unsigned x; volatile LAS unsigned* st; };
__device__ __forceinline__ XcdBarrier xcd_barrier_post(unsigned* bar, volatile LAS unsigned* st) {
    XcdBarrier b; b.bar = bar; b.x = xb_xcc_id(); b.st = st;
    if (threadIdx.x == 0) (void)xb_add(&bar[XB_XCNT(b.x)], 1u);
    return b;
}
__device__ __forceinline__ void xcd_barrier_complete(unsigned* bar, unsigned x, unsigned& nloc, unsigned& nx) {
    const unsigned G = gridDim.x * gridDim.y * gridDim.z;
    unsigned sum, cnt, mine, sp = 0u;
    for (;;) {
        sum = 0u; cnt = 0u; mine = 0u;
#pragma unroll
        for (unsigned j = 0; j < 16; ++j) { const unsigned c = xb_ld(&bar[XB_XCNT(j)]); sum += c; cnt += (c > 0u) ? 1u : 0u; mine = (j == x) ? c : mine; }
        if (sum == G) break;
        __builtin_amdgcn_s_sleep(1);
        if ((++sp & 255u) == 0u) { if (xb_ld(&bar[XB_TMO])) break; if (sp > XB_SPIN_CAP) { atomicAdd(&bar[XB_TMO], 1u); break; } }
    }
    nloc = mine > 0u ? mine : 1u; nx = cnt > 0u ? cnt : 1u;
}
__device__ __forceinline__ void xcd_barrier(const XcdBarrier& b) {
    asm volatile("s_waitcnt vmcnt(0)" ::: "memory");
    __syncthreads();
    if (threadIdx.x == 0) {
        unsigned* bar = b.bar;
        __builtin_amdgcn_s_waitcnt(0);
        unsigned nloc = b.st[0], nx = b.st[1];
        if (nloc == 0u) { xcd_barrier_complete(bar, b.x, nloc, nx); b.st[0] = nloc; b.st[1] = nx; }
        const unsigned old = xb_add(&bar[XB_XSUB(b.x)], 1u);
        const unsigned gen = old / nloc;
        if (old + 1u == (gen + 1u) * nloc) {
            __builtin_amdgcn_fence(__ATOMIC_RELEASE, "agent");
            asm volatile("s_waitcnt vmcnt(0)" ::: "memory");
            const unsigned og = xb_add(&bar[XB_TOP], 1u);
            const unsigned tg = og / nx;
            if (og + 1u == (tg + 1u) * nx) xb_add(&bar[XB_TOPGEN], 1u);
            else XB_SPIN(xb_ld(&bar[XB_TOPGEN]) == tg, bar);
            __builtin_amdgcn_fence(__ATOMIC_ACQUIRE, "agent");
            xb_add(&bar[XB_XGEN(b.x)], 1u);
            asm volatile("s_waitcnt vmcnt(0)" ::: "memory");
        } else {
            XB_SPIN(xb_ld(&bar[XB_XGEN(b.x)]) == gen, bar);
            __builtin_amdgcn_fence(__ATOMIC_ACQUIRE, "agent");
            asm volatile("s_waitcnt vmcnt(0)" ::: "memory");
        }
    }
    __syncthreads();
}

constexpr int D = 1024, NB = 4, SEQ = 4096, CTX = 256;
constexpr int RL = NB * SEQ;
constexpr int RC = NB * CTX;
constexpr int R = RL + RC;
constexpr float EPS = 1e-6f;
constexpr float LOG2E = 1.4426950408889634f;
constexpr int N_IN0 = 1536, N_QA = 768, N_KVA = 1024, FFN = 2816, N_GU0 = 2 * FFN, N_IN1 = 3328, EXD = 3584, N_GU1 = 2 * EXD, NEXP = 8;
constexpr int CAPE = 16384;

constexpr size_t MiB = 1u << 20;
constexpr size_t O_CTL = 0;
constexpr size_t CTL_BYTES = 65536;
constexpr int CW_BAR = 0;
constexpr int CW_CNT = 8192;
constexpr size_t O_MODV = 1 * MiB;
constexpr size_t O_TAB16 = O_MODV + 256 * 1024;
constexpr size_t O_TAB32 = O_TAB16 + 8192;
constexpr size_t O_RSTDQ = O_TAB32 + 16384;
constexpr size_t O_RSTDKV = O_RSTDQ + 81920;
constexpr size_t O_SEL = 2 * MiB;
constexpr size_t O_ROWTOK = 3 * MiB;
constexpr size_t O_WGU1 = 4 * MiB;
constexpr size_t O_YE = O_WGU1;
constexpr size_t O_WD1 = 116 * MiB;
constexpr size_t O_WIN1 = 172 * MiB;
constexpr size_t O_WOUT1 = 179 * MiB;
constexpr size_t O_WIN0 = 181 * MiB;
constexpr size_t O_WUQ = 184 * MiB;
constexpr size_t O_WUKV = 185 * MiB;
constexpr size_t O_WOUT0 = 186 * MiB;
constexpr size_t O_WGU0 = 188 * MiB;
constexpr size_t O_WD0 = 199 * MiB;
constexpr size_t O_HC = 205 * MiB;
constexpr size_t O_U = 209 * MiB;
constexpr size_t O_Y = 243 * MiB;
constexpr size_t O_Z0 = 311 * MiB;
constexpr size_t O_QA = 362 * MiB;
constexpr size_t O_KVA = 388 * MiB;
constexpr size_t O_QB = 422 * MiB;
constexpr size_t O_KB = 439 * MiB;
constexpr size_t O_KR = 444 * MiB;
constexpr size_t O_AO = 446 * MiB;
constexpr size_t O_H0 = 311 * MiB;
constexpr size_t O_QK1 = 311 * MiB;
constexpr size_t O_V1 = 345 * MiB;
constexpr size_t O_G1 = 379 * MiB;
constexpr size_t O_RR = 413 * MiB;
constexpr size_t O_QDF = 422 * MiB, O_KIF = 439 * MiB, O_KTF = 456 * MiB, O_QDB = 473 * MiB;
constexpr size_t O_KIB = 243 * MiB, O_KTB = 260 * MiB, O_VT = 277 * MiB;
constexpr size_t O_ECL = 490 * MiB;
constexpr size_t O_OF = O_QK1, O_OB = O_V1;
constexpr size_t O_GA = O_QDF;
constexpr size_t O_HM = 243 * MiB;
constexpr size_t WS_END = 495 * MiB;
static_assert(O_HM + (size_t)34816 * EXD * 2 <= 482 * MiB, "HM");
static_assert(O_RR + (size_t)R * 256 * 2 <= O_QDF, "RR");
static_assert(O_ECL + (size_t)544 * 8 * 1024 <= WS_END, "ECL");

constexpr int RING_BYTES = 131072;
constexpr int LDS_BYTES = 163840;
constexpr int LDSCTL_OFF = LDS_BYTES - 256;

struct Args {
    const float* in[27];
    float* out; unsigned char* ws;
    int ph_lo, ph_hi;
};
enum { I_X = 0, I_C, I_CTX, I_CCTX, I_MODW, I_MODB, I_NORMG, I_AWIN, I_AQN, I_AWUQ, I_AKVN, I_AWUKV, I_AQKN, I_AWOUT, I_GWIN, I_GGATE2, I_GBGATE, I_GONORM, I_GWOUT,
       I_FWG, I_FWU, I_FWD, I_MROUTER, I_MBROUTER, I_MWG, I_MWU, I_MWD };

struct Conv { const float* s0; const float* s1; int Nsrc; int K; int Ndst; bf16_t* dst; int mode; const float* kscale; };
__device__ __forceinline__ int ilv64(int p) { return (p >> 5) * 32 + (p & 1) * 16 + ((p & 31) >> 1); }
__device__ __forceinline__ int ilv32(int p) { return (p >> 4) * 16 + (p & 1) * 8 + ((p & 15) >> 1); }
__device__ __forceinline__ const float* conv_col(const Conv& c, int n, float& sc) {
    sc = 1.0f;
    switch (c.mode) {
    case 0: return c.s0 + n;
    case 1: {
        if (n < 640) return c.s0 + n;
        if (n < 1152) { const int hh = (n - 640) >> 6, p = (n - 640) & 63; return c.s0 + 672 + hh * 64 + ilv64(p); }
        if (n < 1280) { const int hh = (n - 1152) >> 6, p = (n - 1152) & 63; return c.s0 + 1184 + hh * 64 + ilv64(p); }
        if (n < 1408) return c.s0 + 1312 + (n - 1280);
        if (n < 1440) return c.s0 + 640 + ilv32(n - 1408);
        return nullptr; }
    case 2: {
        if (n < 512) return c.s0 + (n >> 6) * 96 + (n & 63);
        const int hh = (n - 512) >> 5, p = (n - 512) & 31; return c.s0 + hh * 96 + 64 + ilv32(p); }
    case 3: {
        const int G = n >> 5, j = n & 31; return (j < 16) ? c.s0 + 16 * G + j : c.s1 + 16 * G + (j - 16); }
    case 4: {
        if (n >= 3104) return nullptr;
        if (n < 512) sc = 0.08838834764831845f;
        return c.s0 + n; }
    }
    return nullptr;
}
__device__ __forceinline__ void conv_item(const Conv& c, int item, LAS float* scr, int lane) {
    const int nblk = c.Ndst / 32, kb = item / nblk, nb = item % nblk, k0 = 64 * kb, n0 = 32 * nb;
    float sc; const float* cp = conv_col(c, n0 + (lane & 31), sc);
    const int kh = lane >> 5;
#pragma unroll 16
    for (int i = 0; i < 32; ++i) { const int kk = 2 * i + kh; float v = 0.f;
        if (cp) { v = cp[(size_t)(k0 + kk) * c.Nsrc] * sc; if (c.kscale) v *= c.kscale[k0 + kk]; }
        scr[kk * 33 + (lane & 31)] = v; }
    asm volatile("s_waitcnt lgkmcnt(0)" ::: "memory");
    const int ch = lane & 7;
#pragma unroll
    for (int j = 0; j < 4; ++j) { const int n = (lane >> 3) + 8 * j; const LAS float* s = scr + (8 * ch) * 33 + n;
        u32x4 o; o.x = cvtpk(s[0 * 33], s[1 * 33]); o.y = cvtpk(s[2 * 33], s[3 * 33]); o.z = cvtpk(s[4 * 33], s[5 * 33]); o.w = cvtpk(s[6 * 33], s[7 * 33]);
        *(u32x4*)(c.dst + (size_t)(n0 + n) * c.K + k0 + 8 * ch) = o; }
    asm volatile("s_waitcnt lgkmcnt(0)" ::: "memory");
}

struct Conv64 { const float* s0; const float* s1; int Nsrc; int K; int Ndst; bf16_t* dst; int mode; int nvalid; int nscaled; float rscale; int f8; };
struct Conv64Geo { int k0, n0, nd; bool valid; float sc; const float* src; };
__device__ __forceinline__ Conv64Geo conv64_geo(const Conv64& c, int item, int lane) {
    Conv64Geo g; const int nblk = c.Ndst / 64, kb = item / nblk, nb = item % nblk; g.k0 = 64 * kb; g.n0 = 64 * nb;
    const int c4 = lane & 15, kr = lane >> 4; g.valid = true; g.sc = 1.0f;
    if (c.mode == 3) { const int cc = 4 * (c4 & 7); g.src = c.s0 + ((c4 < 8) ? (long)0 : (long)(c.s1 - c.s0)) + 32 * nb + cc; g.nd = 32 * (cc >> 4) + ((c4 < 8) ? 0 : 16) + (cc & 15); if (c.f8) g.sc = c.rscale; }
    else { g.nd = 4 * c4; g.src = c.s0 + g.n0 + g.nd; g.valid = (g.n0 + g.nd) < c.nvalid; if (g.n0 + g.nd < c.nscaled) g.sc = c.rscale; }
    g.src += (size_t)(g.k0 + kr) * c.Nsrc;
    return g;
}
__device__ __forceinline__ void conv64_load(const Conv64& c, int item, int lane, f32x4 (&v)[16]) {
    const Conv64Geo g = conv64_geo(c, item, lane);
#pragma unroll
    for (int i = 0; i < 16; ++i) v[i] = g.valid ? *(const f32x4*)(g.src + (size_t)(4 * i) * c.Nsrc) : (f32x4){0.f, 0.f, 0.f, 0.f};
}
__device__ __forceinline__ void conv64_store(const Conv64& c, int item, LAS float* scr, int lane, const f32x4 (&v)[16]) {
    const Conv64Geo g = conv64_geo(c, item, lane); const int kr = lane >> 4, nd = g.nd, k0 = g.k0, n0 = g.n0; const float sc = g.sc;
#pragma unroll
    for (int i = 0; i < 16; ++i) { LAS float* p = scr + (4 * i + kr) * 65 + nd; p[0] = v[i][0] * sc; p[1] = v[i][1] * sc; p[2] = v[i][2] * sc; p[3] = v[i][3] * sc; }
    asm volatile("s_waitcnt lgkmcnt(0)" ::: "memory");
    if (c.f8) {
        const int ch = lane & 3; unsigned char* d8 = (unsigned char*)c.dst;
#pragma unroll
        for (int it = 0; it < 4; ++it) { const int r = it * 16 + (lane >> 2); const LAS float* sp = scr + (16 * ch) * 65 + r; u32x4 o;
            o.x = pack_fp8x4(sp[0 * 65], sp[1 * 65], sp[2 * 65], sp[3 * 65]); o.y = pack_fp8x4(sp[4 * 65], sp[5 * 65], sp[6 * 65], sp[7 * 65]);
            o.z = pack_fp8x4(sp[8 * 65], sp[9 * 65], sp[10 * 65], sp[11 * 65]); o.w = pack_fp8x4(sp[12 * 65], sp[13 * 65], sp[14 * 65], sp[15 * 65]);
            *(u32x4*)(d8 + (size_t)(n0 + r) * c.K + k0 + 16 * ch) = o; }
    } else {
    const int ch = lane & 7;
#pragma unroll
    for (int it = 0; it < 8; ++it) { const int r = it * 8 + (lane >> 3); const LAS float* sp = scr + (8 * ch) * 65 + r;
        u32x4 o; o.x = cvtpk(sp[0 * 65], sp[1 * 65]); o.y = cvtpk(sp[2 * 65], sp[3 * 65]); o.z = cvtpk(sp[4 * 65], sp[5 * 65]); o.w = cvtpk(sp[6 * 65], sp[7 * 65]);
        *(u32x4*)(c.dst + (size_t)(n0 + r) * c.K + k0 + 8 * ch) = o; }
    }
    asm volatile("s_waitcnt lgkmcnt(0)" ::: "memory");
}

__device__ __forceinline__ void conv64_run(const Conv64& c, LAS float* scr, int lane, int gwi, int ngw, int& base) {
    const int n = (c.K / 64) * (c.Ndst / 64); int it = gwi - base; if (it < 0) it += ngw;
    if (it < n) { f32x4 va[16], vb[16]; conv64_load(c, it, lane, va);
        for (;;) { const int i2 = it + ngw; if (i2 < n) conv64_load(c, i2, lane, vb); conv64_store(c, it, scr, lane, va); if (i2 >= n) break;
                   const int i3 = i2 + ngw; if (i3 < n) conv64_load(c, i3, lane, va); conv64_store(c, i2, scr, lane, vb); if (i3 >= n) break; it = i3; } }
    base = (base + n) % ngw;
}

namespace pg8 {
constexpr int BM = 256, BK = 64, HALF = 128, HTB = HALF * BK * 2, STAGE_BYTES = 8 * HTB;
constexpr int NXCD = 8, WGM = 8;
__device__ __forceinline__ int lds_byte(int r, int c) { const int st = (r >> 4) * 2 + (c >> 5), rr = r & 15, cc = c & 31, ob = rr * 64 + cc * 2; return st * 1024 + (ob ^ (((ob >> 9) & 1) << 5)); }
__device__ __forceinline__ void stage_rc(int b, int& Rr, int& C) { const int st = b / 1024, sb = b % 1024, swz = sb ^ (((sb >> 9) & 1) << 5); Rr = (st >> 1) * 16 + swz / 64; C = (st & 1) * 32 + (swz % 64) / 2; }
__device__ __forceinline__ int perm32(int rho) { const int n = rho >> 4, i = rho & 15; return 8 * (i >> 2) + 4 * n + (i & 3); }
struct Unit { int pm, pn; };
typedef int v8i_t __attribute__((ext_vector_type(8)));
typedef int v4i_t __attribute__((ext_vector_type(4)));
__device__ __forceinline__ v8i_t cat8(bf16x8 a, bf16x8 b) { const v4i_t x = __builtin_bit_cast(v4i_t, a), y = __builtin_bit_cast(v4i_t, b); return __builtin_shufflevector(x, y, 0, 1, 2, 3, 4, 5, 6, 7); }
struct Order {
    int nM, nN, nwg, G, c;
    __device__ __forceinline__ void init(int nM_, int nN_, int G_, int c_) { nM = nM_; nN = nN_; nwg = nM * nN; G = G_; c = c_; }
    __device__ __forceinline__ bool next(int i, Unit& u) const {
        const long L = (long)i * G + c; if (L >= nwg) return false;
        int wgid = (int)L; { const int q = nwg / NXCD, r = nwg % NXCD, xcd = wgid % NXCD, off = wgid / NXCD; wgid = (xcd < r ? xcd * (q + 1) : r * (q + 1) + (xcd - r) * q) + off; }
        const int nig = WGM * nN, gid = wgid / nig, fm = gid * WGM, gsz = (nM - fm) < WGM ? (nM - fm) : WGM;
        u.pm = fm + ((wgid % nig) % gsz); u.pn = (wgid % nig) / gsz; return true;
    }
};

template <class Prob, class Epi>
__device__ __forceinline__ void gemm_phase(LAS unsigned char* lds, const Prob& P, const Epi& E) {
    const int tid = threadIdx.x, wid = __builtin_amdgcn_readfirstlane(tid >> 6), lane = tid & 63, wr = wid >> 2, wc = wid & 3, fr = lane & 15, fq = lane >> 4;
    const int K = P.K, nt = K / BK, ldb = P.ldb;
    int RA[2], CA[2]; unsigned voffB[2];
#pragma unroll
    for (int i = 0; i < 2; ++i) { int Rr, C; stage_rc(tid * 16 + i * 8192, Rr, C); const int Rb = Epi::PERM ? ((Rr & ~31) + perm32(Rr & 31)) : Rr;
        RA[i] = Rr; CA[i] = C; voffB[i] = (unsigned)(Rb * ldb + C) * 2u; }
    const size_t hstepB = (size_t)HALF * ldb * 2;
    const unsigned ldsw = (unsigned)wid * 1024u;
    const int aoff = lds_byte(wr * 64 + fr, fq * 8), boff = lds_byte(wc * 32 + fr, fq * 8);
    const char* Abase = (const char*)P.Abase;
    const int scl_a = P.sa * 0x01010101, scl_b = P.sb * 0x01010101;
#define PG8_SA(b, h) (((b) * 2 + (h)) * HTB)
#define PG8_SB(b, h) ((4 + (b) * 2 + (h)) * HTB)
#define PG8_STAGEB(bufoff, gbase) do { _Pragma("unroll") for (int _i = 0; _i < 2; ++_i) \
        __builtin_amdgcn_global_load_lds((const unsigned*)((const char*)(gbase) + voffB[_i]), (LAS unsigned*)(lds + (bufoff) + ldsw + _i * 8192), 16, 0, 0); } while (0)
#define PG8_STAGEA(bufoff, vo, h, kb) do { _Pragma("unroll") for (int _i = 0; _i < 2; ++_i) \
        __builtin_amdgcn_global_load_lds((const unsigned*)(Abase + (size_t)(kb) + (vo)[h][_i]), (LAS unsigned*)(lds + (bufoff) + ldsw + _i * 8192), 16, 0, 0); } while (0)
#define PG8_LDA(dst, b, h) do { _Pragma("unroll") for (int m = 0; m < 4; ++m) { if constexpr (Prob::FP8) dst##8[m] = cat8(*(const LAS bf16x8*)(lds + PG8_SA(b, h) + aoff + m * 2048), *(const LAS bf16x8*)(lds + PG8_SA(b, h) + aoff + m * 2048 + 1024)); \
        else { _Pragma("unroll") for (int k = 0; k < 2; ++k) dst[m][k] = *(const LAS bf16x8*)(lds + PG8_SA(b, h) + aoff + m * 2048 + k * 1024); } } } while (0)
#define PG8_LDB(dst, b, h) do { _Pragma("unroll") for (int n = 0; n < 2; ++n) { if constexpr (Prob::FP8) dst##8[n] = cat8(*(const LAS bf16x8*)(lds + PG8_SB(b, h) + boff + n * 2048), *(const LAS bf16x8*)(lds + PG8_SB(b, h) + boff + n * 2048 + 1024)); \
        else { _Pragma("unroll") for (int k = 0; k < 2; ++k) dst[n][k] = *(const LAS bf16x8*)(lds + PG8_SB(b, h) + boff + n * 2048 + k * 1024); } } } while (0)
#define PG8_MMA(ai, bj, At, Bt) do { __builtin_amdgcn_s_setprio(1); _Pragma("unroll") for (int m = 0; m < 4; ++m) _Pragma("unroll") for (int n = 0; n < 2; ++n) { \
        if constexpr (Prob::FP8) asm volatile("v_mfma_scale_f32_16x16x128_f8f6f4 %0, %1, %2, %0, %3, %4 op_sel_hi:[0,0,0]" : "+v"(acc[ai][bj][m][n]) : "v"(Bt##8[n]), "v"(At##8[m]), "v"(scl_b), "v"(scl_a)); \
        else { _Pragma("unroll") for (int k = 0; k < 2; ++k) acc[ai][bj][m][n] = __builtin_amdgcn_mfma_f32_16x16x32_bf16(Bt[n][k], At[m][k], acc[ai][bj][m][n], 0, 0, 0); } } \
        __builtin_amdgcn_s_setprio(0); } while (0)
#define PG8_WAIT_V(n) asm volatile("s_waitcnt vmcnt(" #n ")" ::: "memory")
#define PG8_WAIT_L(n) asm volatile("s_waitcnt lgkmcnt(" #n ")" ::: "memory")
#define PG8_BAR __builtin_amdgcn_s_barrier()
#define PG8_SCHED __builtin_amdgcn_sched_barrier(0)
    Unit cur, nxt; int ui = 0;
    if (!P.next(0, cur)) return;
    f32x4 acc[2][2][4][2];
#pragma unroll
    for (int a = 0; a < 2; ++a)
#pragma unroll
        for (int b = 0; b < 2; ++b)
#pragma unroll
            for (int m = 0; m < 4; ++m)
#pragma unroll
                for (int n = 0; n < 2; ++n) acc[a][b][m][n] = (f32x4){0.f, 0.f, 0.f, 0.f};
    bf16x8 At[4][2], B0[2][2], B1[2][2]; v8i_t At8[4], B08[2], B18[2];
    unsigned cvo[2][2], nvo[2][2];
#pragma unroll
    for (int h = 0; h < 2; ++h)
#pragma unroll
        for (int i = 0; i < 2; ++i) cvo[h][i] = P.a_off(cur, h * HALF + RA[i]) + (unsigned)CA[i] * 2u;
    const char* cB = P.b_ptr(cur);
    const size_t kstep = (size_t)(BK * 2);
    PG8_STAGEB(PG8_SB(0, 0), cB); PG8_STAGEB(PG8_SB(0, 1), cB + hstepB); PG8_STAGEA(PG8_SA(0, 0), cvo, 0, 0); PG8_STAGEA(PG8_SA(0, 1), cvo, 1, 0);
    if (wr == 1) PG8_BAR;
    PG8_WAIT_V(2); PG8_BAR;
    PG8_STAGEB(PG8_SB(1, 0), cB + kstep); PG8_STAGEA(PG8_SA(1, 0), cvo, 0, kstep); PG8_STAGEB(PG8_SB(1, 1), cB + hstepB + kstep);
    PG8_WAIT_V(6); PG8_BAR;
    for (;;) {
        const bool has_next = P.next(ui + 1, nxt);
        const char* nB = cB;
#pragma unroll
        for (int h = 0; h < 2; ++h)
#pragma unroll
            for (int i = 0; i < 2; ++i) nvo[h][i] = cvo[h][i];
        if (has_next) { nB = P.b_ptr(nxt);
#pragma unroll
            for (int h = 0; h < 2; ++h)
#pragma unroll
                for (int i = 0; i < 2; ++i) nvo[h][i] = P.a_off(nxt, h * HALF + RA[i]) + (unsigned)CA[i] * 2u; }
        for (int t = 0; t < nt; t += 2) {
            const bool last = (t == nt - 2);
            const size_t k1 = (size_t)(t + 1) * kstep;
            const size_t k2 = last ? 0 : (size_t)(t + 2) * kstep, k3 = k2 + kstep;
            unsigned vo2[2][2];
#pragma unroll
            for (int h = 0; h < 2; ++h)
#pragma unroll
                for (int i = 0; i < 2; ++i) vo2[h][i] = last ? nvo[h][i] : cvo[h][i];
            const char* b2 = (last ? nB : cB) + k2; const char* b3 = b2 + kstep;
            PG8_LDB(B0, 0, 0); PG8_LDB(B1, 0, 1); PG8_SCHED; PG8_LDA(At, 0, 0); PG8_STAGEA(PG8_SA(1, 1), cvo, 1, k1);
            PG8_WAIT_V(8); PG8_WAIT_L(0); PG8_BAR; PG8_MMA(0, 0, At, B0); PG8_MMA(0, 1, At, B1); PG8_BAR; PG8_SCHED;
            PG8_LDA(At, 0, 1); PG8_STAGEB(PG8_SB(0, 0), b2); PG8_STAGEB(PG8_SB(0, 1), b2 + hstepB); PG8_STAGEA(PG8_SA(0, 0), vo2, 0, k2);
            PG8_WAIT_V(8); PG8_WAIT_L(0); PG8_BAR; PG8_MMA(1, 0, At, B0); PG8_MMA(1, 1, At, B1); PG8_BAR; PG8_SCHED;
            PG8_LDB(B0, 1, 0); PG8_LDB(B1, 1, 1); PG8_SCHED; PG8_LDA(At, 1, 0); PG8_STAGEA(PG8_SA(0, 1), vo2, 1, k2);
            PG8_WAIT_V(8); PG8_WAIT_L(0); PG8_BAR; PG8_MMA(0, 0, At, B0); PG8_MMA(0, 1, At, B1); PG8_BAR; PG8_SCHED;
            PG8_LDA(At, 1, 1); PG8_STAGEB(PG8_SB(1, 0), b3); PG8_STAGEB(PG8_SB(1, 1), b3 + hstepB); PG8_STAGEA(PG8_SA(1, 0), vo2, 0, k3);
            PG8_WAIT_V(8); PG8_WAIT_L(0); PG8_BAR; PG8_MMA(1, 0, At, B0); PG8_MMA(1, 1, At, B1); PG8_BAR; PG8_SCHED;
        }
        if (wr == 0) PG8_BAR;
        if constexpr (Prob::FP8) asm volatile("s_nop 15\n\ts_nop 15" ::: "memory");
        if constexpr (Epi::STAGED) E.staged(acc, P, cur, wr, wc, fr, fq, lds + STAGE_BYTES, tid);
        else { E(acc, P, cur, wr, wc, fr, fq); if (MK_EPI2) { asm volatile("" ::: "memory"); E(acc, P, cur, wr, wc, fr, fq); } }
        if (!has_next) break;
#pragma unroll
        for (int a = 0; a < 2; ++a)
#pragma unroll
            for (int b = 0; b < 2; ++b)
#pragma unroll
                for (int m = 0; m < 4; ++m)
#pragma unroll
                    for (int n = 0; n < 2; ++n) acc[a][b][m][n] = (f32x4){0.f, 0.f, 0.f, 0.f};
        cur = nxt; cB = nB; ++ui;
#pragma unroll
        for (int h = 0; h < 2; ++h)
#pragma unroll
            for (int i = 0; i < 2; ++i) cvo[h][i] = nvo[h][i];
        if (wr == 1) PG8_BAR;
    }
    PG8_WAIT_V(0);
    PG8_BAR;
#undef PG8_SA
#undef PG8_SB
#undef PG8_STAGEA
#undef PG8_STAGEB
#undef PG8_LDA
#undef PG8_LDB
#undef PG8_MMA
#undef PG8_WAIT_V
#undef PG8_WAIT_L
#undef PG8_BAR
#undef PG8_SCHED
}

struct DenseProb {
    static constexpr bool FP8 = false; static constexpr int sa = 127, sb = 127;
    const bf16_t* Abase; const bf16_t* Bt; int K, lda, ldb; Order ord;
    __device__ __forceinline__ bool next(int i, Unit& u) const { return ord.next(i, u); }
    __device__ __forceinline__ unsigned a_off(const Unit& u, int r) const { return (unsigned)((size_t)(u.pm * BM + r) * lda * 2); }
    __device__ __forceinline__ const char* b_ptr(const Unit& u) const { return (const char*)Bt + (size_t)u.pn * BM * ldb * 2; }
    __device__ __forceinline__ int orow0(const Unit& u) const { return u.pm * BM; }
};
struct MoeTiles { unsigned long long tp8; unsigned long long c4a, c4b; int nt; };
__device__ __forceinline__ int moe_tp(const MoeTiles& T, int e) { return (int)((T.tp8 >> (8 * e)) & 0xffull); }
__device__ __forceinline__ int moe_cnt(const MoeTiles& T, int e) { const unsigned long long w = (e < 4) ? T.c4a : T.c4b; return (int)((w >> (16 * (e & 3))) & 0xffffull); }
__device__ __forceinline__ int moe_expert(const MoeTiles& T, int pm) { int e = 0;
#pragma unroll
    for (int j = 1; j < 8; ++j) e += (pm >= (int)((T.tp8 >> (8 * j)) & 0xffull)) ? 1 : 0;
    return e; }
struct MoeGuProb {
    static constexpr bool FP8 = true; static constexpr int sa = 125, sb = 121;
    const unsigned char* Abase; const unsigned char* Bt; int K, ldb; Order ord; MoeTiles T; const int* rowtok;
    __device__ __forceinline__ bool next(int i, Unit& u) const { return ord.next(i, u); }
    __device__ __forceinline__ unsigned a_off(const Unit& u, int r) const {
        const int e = moe_expert(T, u.pm); const int idx = (u.pm - moe_tp(T, e)) * BM + r; const int cm1 = moe_cnt(T, e) - 1;
        const int tok = rowtok[e * CAPE + (idx < cm1 ? idx : cm1)];
        return (unsigned)tok * (unsigned)D; }
    __device__ __forceinline__ const char* b_ptr(const Unit& u) const { const int e = moe_expert(T, u.pm); return (const char*)Bt + ((size_t)e * N_GU1 + (size_t)u.pn * BM) * D; }
    __device__ __forceinline__ int orow0(const Unit& u) const { return u.pm * BM; }
};
struct MoeDnProb {
    static constexpr bool FP8 = true; static constexpr int sa = 124, sb = 121;
    const unsigned char* Abase; const unsigned char* Bt; int K, ldb; Order ord; MoeTiles T;
    __device__ __forceinline__ bool next(int i, Unit& u) const { return ord.next(i, u); }
    __device__ __forceinline__ unsigned a_off(const Unit& u, int r) const { return (unsigned)((size_t)(u.pm * BM + r) * EXD); }
    __device__ __forceinline__ const char* b_ptr(const Unit& u) const { const int e = moe_expert(T, u.pm); return (const char*)Bt + ((size_t)e * D + (size_t)u.pn * BM) * EXD; }
    __device__ __forceinline__ int orow0(const Unit& u) const { return u.pm * BM; }
};

struct EpiF32 { static constexpr bool PERM = false; static constexpr bool STAGED = false; float* C; int ldc;
    template <class Prob> __device__ __forceinline__ void operator()(const f32x4 (&acc)[2][2][4][2], const Prob& P, const Unit& u, int wr, int wc, int fr, int fq) const {
        const int row0 = P.orow0(u) + wr * 64 + fr, col0 = u.pn * BM + wc * 32 + 4 * fq;
#pragma unroll
        for (int ai = 0; ai < 2; ++ai)
#pragma unroll
            for (int m = 0; m < 4; ++m) { float* rowp = C + (size_t)(row0 + ai * HALF + m * 16) * ldc + col0;
#pragma unroll
                for (int bj = 0; bj < 2; ++bj)
#pragma unroll
                    for (int n = 0; n < 2; ++n) *(f32x4*)(rowp + bj * HALF + n * 16) = acc[ai][bj][m][n]; }
    }
};
struct EpiBf16 { static constexpr bool PERM = true; static constexpr bool STAGED = false; bf16_t* O; int ldc; const float* rowscale;
    template <class Prob> __device__ __forceinline__ void operator()(const f32x4 (&acc)[2][2][4][2], const Prob& P, const Unit& u, int wr, int wc, int fr, int fq) const {
        const int row0 = P.orow0(u) + wr * 64 + fr, col0 = u.pn * BM + wc * 32 + 8 * fq;
#pragma unroll
        for (int ai = 0; ai < 2; ++ai)
#pragma unroll
            for (int m = 0; m < 4; ++m) { const int row = row0 + ai * HALF + m * 16; bf16_t* rowp = O + (size_t)row * ldc + col0; const float rs = rowscale ? rowscale[row] : 1.0f;
#pragma unroll
                for (int bj = 0; bj < 2; ++bj) { const f32x4 v0 = acc[ai][bj][m][0] * rs, v1 = acc[ai][bj][m][1] * rs;
                    u32x4 w; w.x = cvtpk(v0[0], v0[1]); w.y = cvtpk(v0[2], v0[3]); w.z = cvtpk(v1[0], v1[1]); w.w = cvtpk(v1[2], v1[3]);
                    *(u32x4*)(rowp + bj * HALF) = w; } }
    }
};
struct EpiIn1 { static constexpr bool PERM = true; static constexpr bool STAGED = false; bf16_t* QK; bf16_t* V; bf16_t* G; bf16_t* RRp;
    template <class Prob> __device__ __forceinline__ void operator()(const f32x4 (&acc)[2][2][4][2], const Prob& P, const Unit& u, int wr, int wc, int fr, int fq) const {
        const int t = u.pn >> 2; bf16_t* base = (t == 0) ? QK : (t == 1) ? V : (t == 2) ? G : RRp; const int ldc = (t == 3) ? 256 : 1024;
        const int row0 = P.orow0(u) + wr * 64 + fr, col0 = (u.pn & 3) * BM + wc * 32 + 8 * fq;
#pragma unroll
        for (int ai = 0; ai < 2; ++ai)
#pragma unroll
            for (int m = 0; m < 4; ++m) { const int row = row0 + ai * HALF + m * 16; bf16_t* rowp = base + (size_t)row * ldc + col0;
#pragma unroll
                for (int bj = 0; bj < 2; ++bj) { const f32x4 v0 = acc[ai][bj][m][0], v1 = acc[ai][bj][m][1];
                    u32x4 w; w.x = cvtpk(v0[0], v0[1]); w.y = cvtpk(v0[2], v0[3]); w.z = cvtpk(v1[0], v1[1]); w.w = cvtpk(v1[2], v1[3]);
                    *(u32x4*)(rowp + bj * HALF) = w; } }
    }
};
struct EpiQA { static constexpr bool PERM = true; static constexpr bool STAGED = false; bf16_t* O; const float* rstd; const float* tab16; float qscale;
    template <class Prob> __device__ __forceinline__ void operator()(const f32x4 (&acc)[2][2][4][2], const Prob& P, const Unit& u, int wr, int wc, int fr, int fq) const {
        const int row0 = P.orow0(u) + wr * 64 + fr, col0 = u.pn * BM + wc * 32 + 8 * fq;
        const bool ropet = (u.pn == 2);
#pragma unroll
        for (int ai = 0; ai < 2; ++ai)
#pragma unroll
            for (int m = 0; m < 4; ++m) { const int row = row0 + ai * HALF + m * 16; bf16_t* rowp = O + (size_t)row * N_QA + col0; const float rs = rstd[row] * qscale;
                f32x4 cs0 = {1.f, 1.f, 1.f, 1.f}, sn0 = {0.f, 0.f, 0.f, 0.f};
                if (ropet && row < RL) { const int tt = row & (SEQ - 1); const int pos = (fq >> 1) ? (tt & 63) : (tt >> 6); const int i0 = 4 * (fq & 1);
                    cs0 = *(const f32x4*)(tab16 + pos * 8 + i0); sn0 = *(const f32x4*)(tab16 + 512 + pos * 8 + i0); }
#pragma unroll
                for (int bj = 0; bj < 2; ++bj) { f32x4 v0 = acc[ai][bj][m][0] * rs, v1 = acc[ai][bj][m][1] * rs;
                    if (ropet) {
                        const f32x4 a = v0, b = v1;
                        v0[0] = a[0] * cs0[0] - a[1] * sn0[0]; v0[1] = a[1] * cs0[0] + a[0] * sn0[0];
                        v0[2] = a[2] * cs0[1] - a[3] * sn0[1]; v0[3] = a[3] * cs0[1] + a[2] * sn0[1];
                        v1[0] = b[0] * cs0[2] - b[1] * sn0[2]; v1[1] = b[1] * cs0[2] + b[0] * sn0[2];
                        v1[2] = b[2] * cs0[3] - b[3] * sn0[3]; v1[3] = b[3] * cs0[3] + b[2] * sn0[3]; }
                    u32x4 w; w.x = cvtpk(v0[0], v0[1]); w.y = cvtpk(v0[2], v0[3]); w.z = cvtpk(v1[0], v1[1]); w.w = cvtpk(v1[2], v1[3]);
                    *(u32x4*)(rowp + bj * HALF) = w; } }
    }
};
struct EpiSwiglu { static constexpr bool PERM = false; static constexpr bool STAGED = false; bf16_t* Hh; int ldh;
    template <class Prob> __device__ __forceinline__ void operator()(const f32x4 (&acc)[2][2][4][2], const Prob& P, const Unit& u, int wr, int wc, int fr, int fq) const {
        const int row0 = P.orow0(u) + wr * 64 + fr, col0 = (u.pn * BM + wc * 32) / 2 + 4 * fq;
#pragma unroll
        for (int ai = 0; ai < 2; ++ai)
#pragma unroll
            for (int m = 0; m < 4; ++m) { bf16_t* rowp = Hh + (size_t)(row0 + ai * HALF + m * 16) * ldh + col0;
#pragma unroll
                for (int bj = 0; bj < 2; ++bj) { const f32x4 g = acc[ai][bj][m][0], up = acc[ai][bj][m][1];
                    u32x2 w; w.x = cvtpk(silu_f(g[0]) * up[0], silu_f(g[1]) * up[1]); w.y = cvtpk(silu_f(g[2]) * up[2], silu_f(g[3]) * up[3]);
                    *(u32x2*)(rowp + bj * (HALF / 2)) = w; } }
    }
};
struct EpiSwiglu8 { static constexpr bool PERM = false; static constexpr bool STAGED = true; unsigned char* Hh; int ldh;
    template <class Prob> __device__ __forceinline__ void staged(const f32x4 (&acc)[2][2][4][2], const Prob& P, const Unit& u, int wr, int wc, int fr, int fq, LAS unsigned char* stg, int tid) const {
        LAS unsigned char* sg = stg + wr * 8192;
        const int t = tid & 255;
        unsigned char* gbase = Hh + (size_t)(P.orow0(u) + wr * 64) * ldh + (size_t)u.pn * 128;
#pragma unroll
        for (int ai = 0; ai < 2; ++ai) {
#pragma unroll
            for (int m = 0; m < 4; ++m) { const int row = m * 16 + fr;
#pragma unroll
                for (int bj = 0; bj < 2; ++bj) { const f32x4 g = acc[ai][bj][m][0], up = acc[ai][bj][m][1]; const int p = bj * 4 + wc;
                    *(LAS unsigned*)(sg + row * 128 + ((p ^ (row & 7)) << 4) + 4 * fq) = pack_fp8x4(8.0f * silu_f(g[0]) * up[0], 8.0f * silu_f(g[1]) * up[1], 8.0f * silu_f(g[2]) * up[2], 8.0f * silu_f(g[3]) * up[3]); } }
            asm volatile("s_waitcnt lgkmcnt(0)" ::: "memory"); __builtin_amdgcn_s_barrier(); asm volatile("" ::: "memory");
#pragma unroll
            for (int j = 0; j < 2; ++j) { const int row = (t >> 3) + 32 * j, p = t & 7;
                const u32x4 v = *(const LAS u32x4*)(sg + row * 128 + ((p ^ (row & 7)) << 4));
                *(u32x4*)(gbase + (size_t)(ai * HALF + row) * ldh + p * 16) = v; }
            if (ai == 0) { asm volatile("s_waitcnt lgkmcnt(0)" ::: "memory"); __builtin_amdgcn_s_barrier(); asm volatile("" ::: "memory"); }
        }
    }
};
}

struct Frame {
    LAS unsigned char* lds;
    unsigned char* ws;
    int tid, lane, wave, vcu, G;
};
template <class T> __device__ __forceinline__ T* wsp(const Frame& F, size_t off) { return (T*)(F.ws + off); }

__device__ __forceinline__ void load_row(const float* p, int lane, f32x4 (&v)[4]) {
    const f32x4* r = (const f32x4*)p + lane;
#pragma unroll
    for (int j = 0; j < 4; ++j) v[j] = r[64 * j];
}
__device__ __forceinline__ float row_ssq(const f32x4 (&v)[4]) { float s = 0.f;
#pragma unroll
    for (int j = 0; j < 4; ++j) s += (v[j][0] * v[j][0] + v[j][1] * v[j][1]) + (v[j][2] * v[j][2] + v[j][3] * v[j][3]);
    return wave_sum(s); }
__device__ __forceinline__ void norm_mod_store(const f32x4 (&h)[4], const float* g, const float* sh, const float* sc, bf16_t* urow, int lane, f32x4 (&uo)[4], unsigned char* u8row = nullptr) {
    const float rstd = __builtin_amdgcn_rsqf(row_ssq(h) * (1.0f / D) + EPS);
#pragma unroll
    for (int j = 0; j < 4; ++j) { const int c = 4 * lane + 256 * j; const f32x4 gg = *(const f32x4*)(g + c), s1 = *(const f32x4*)(sc + c), s0 = *(const f32x4*)(sh + c);
        const f32x4 uu = (h[j] * rstd * gg) * (1.0f + s1) + s0; uo[j] = uu;
        if (u8row) *(unsigned*)(u8row + c) = pack_fp8x4(4.0f * uu[0], 4.0f * uu[1], 4.0f * uu[2], 4.0f * uu[3]);
        else { u32x2 w; w.x = cvtpk(uu[0], uu[1]); w.y = cvtpk(uu[2], uu[3]); *(u32x2*)(urow + c) = w; } }
}
__device__ __forceinline__ int row_bidx(int row) { return row < RL ? (row >> 12) : 4; }

__device__ __forceinline__ void glds16(const void* gsrc, unsigned lds_dst) { unsigned keep;
    asm volatile("s_mov_b32 %0, m0\n\ts_mov_b32 m0, %2\n\ts_nop 0\n\tglobal_load_lds_dwordx4 %1, off\n\ts_mov_b32 m0, %0" : "=&s"(keep) : "v"(gsrc), "s"(lds_dst) : "memory"); }
__device__ __forceinline__ float max3f(float a, float b, float c) { float r; asm("v_max3_f32 %0, %1, %2, %3" : "=v"(r) : "v"(a), "v"(b), "v"(c)); return r; }
#define WAIT_BAR(N) asm volatile("s_waitcnt vmcnt(" #N ") lgkmcnt(0)\n\ts_barrier" ::: "memory")
template <int DQK> struct AttnSrc {
    const bf16_t* Q; int qpitch; const bf16_t* Qr;
    const bf16_t* Kn; int kpitch; const bf16_t* Kr; int krpitch;
    const bf16_t* V; int vpitch;
    bf16_t* O; int opitch;
};
__device__ __forceinline__ s16x4 vtr(const LAS unsigned char* p) { typedef short v4i16_t __attribute__((ext_vector_type(4))); return __builtin_bit_cast(s16x4, __builtin_amdgcn_ds_read_tr16_b64_v4i16((LAS v4i16_t*)p)); }
__device__ __forceinline__ int attn_krow(int kt, int lat0, int ctx0) { return kt < 64 ? lat0 + kt * 64 : ctx0 + (kt - 64) * 64; }
template <int DQK>
__device__ __forceinline__ void attn_unit(const Frame& F, const AttnSrc<DQK>& S, int q0, int lat0, int ctx0, int kt0, int kt1) {
    constexpr int NKS = DQK / 16, KB = DQK * 128, SLOT = KB + 8192;
    constexpr float THR = 8.0f;
    const int lane = F.lane, wid = F.wave, r32 = lane & 31, hi = lane >> 5;
    LAS unsigned char* lds = F.lds;
    constexpr bool QLDS = false;
    bf16x8 qf[QLDS ? 1 : NKS];
    LAS unsigned char* qfl = lds + 4 * SLOT + wid * (NKS * 1024) + lane * 16;
    { const bf16_t* qrow = S.Q + (size_t)(q0 + wid * 32 + r32) * S.qpitch;
#pragma unroll
      for (int ks = 0; ks < 4; ++ks) { const bf16x8 v = *(const bf16x8*)(qrow + ks * 16 + hi * 8); if (QLDS) *(LAS bf16x8*)(qfl + ks * 1024) = v; else qf[ks] = v; }
      if (DQK == 96) { const bf16_t* qr = S.Qr + (size_t)(q0 + wid * 32 + r32) * S.qpitch;
#pragma unroll
          for (int ks = 4; ks < NKS; ++ks) { const bf16x8 v = *(const bf16x8*)(qr + (ks - 4) * 16 + hi * 8); if (QLDS) *(LAS bf16x8*)(qfl + ks * 1024) = v; else qf[ks] = v; } } }
    const unsigned lds0 = (unsigned)(size_t)lds;
    auto dma = [&](int kt, int slot) {
        const int krow = attn_krow(kt, lat0, ctx0);
        const unsigned sb = lds0 + slot * SLOT;
        glds16(S.Kn + (size_t)(krow + lane) * S.kpitch + wid * 8, (unsigned)__builtin_amdgcn_readfirstlane(sb + wid * 1024));
        if (DQK == 96 && wid < 4) glds16(S.Kr + (size_t)(krow + lane) * S.krpitch + wid * 8, (unsigned)__builtin_amdgcn_readfirstlane(sb + (8 + wid) * 1024));
        glds16(S.V + (size_t)(krow + 16 * (wid & 3) + (lane >> 2)) * S.vpitch + (wid >> 2) * 32 + (lane & 3) * 8, (unsigned)__builtin_amdgcn_readfirstlane(sb + KB + wid * 1024));
    };
    auto wait_bar = [&](bool inflight) {
        if (!inflight) { WAIT_BAR(0); } else if (DQK == 96 && wid < 4) { WAIT_BAR(3); } else { WAIT_BAR(2); }
    };
    f32x16 oT[2]; f32x16 negm;
#pragma unroll
    for (int r = 0; r < 16; ++r) { oT[0][r] = 0.f; oT[1][r] = 0.f; negm[r] = 0.f; }
    float mrun = 0.f, lrun = 0.f;
    const int vlane = ((lane >> 4) & 1) * 32 + (lane & 3) * 8 + (4 * hi + ((lane & 15) >> 2)) * 64;
    auto qk = [&](int slot, f32x16& p0, f32x16& p1) {
        const LAS unsigned char* kb = lds + slot * SLOT + hi * 1024 + r32 * 16;
        p0 = negm; p1 = negm;
#pragma unroll
        for (int ks = 0; ks < NKS; ++ks) {
            const bf16x8 k0 = *(const LAS bf16x8*)(kb + ks * 2048), k1 = *(const LAS bf16x8*)(kb + ks * 2048 + 512);
            p0 = __builtin_amdgcn_mfma_f32_32x32x16_bf16(k0, qf[ks], p0, 0, 0, 0);
            p1 = __builtin_amdgcn_mfma_f32_32x32x16_bf16(k1, qf[ks], p1, 0, 0, 0);
            if (ks & 1) asm volatile("" ::: "memory");
        }
    };
    auto tilemax = [&](f32x16& p0, f32x16& p1) -> float {
        asm volatile("s_nop 15\n\ts_nop 7" : "+v"(p0), "+v"(p1));
        float a = max3f(p0[0], p0[1], p1[0]), b = max3f(p0[2], p0[3], p1[1]); a = max3f(a, p1[2], p1[3]);
#pragma unroll
        for (int r = 4; r < 16; r += 4) { a = max3f(a, p0[r], p0[r + 1]); b = max3f(b, p0[r + 2], p0[r + 3]); a = max3f(a, p1[r], p1[r + 1]); b = max3f(b, p1[r + 2], p1[r + 3]); }
        float tm = fmaxf(a, b);
        auto rr = __builtin_amdgcn_permlane32_swap(__float_as_uint(tm), __float_as_uint(tm), false, false); return fmaxf(__uint_as_float(rr[0]), __uint_as_float(rr[1]));
    };
    auto smpv = [&](f32x16& p0, f32x16& p1, int slot) -> bool {
        const float tm = tilemax(p0, p1);
        bool moved = false;
        if (__any(tm > THR)) {
            const float dl = fmaxf(tm, 0.f); mrun += dl; const float al = __builtin_amdgcn_exp2f(-dl); lrun *= al;
#pragma unroll
            for (int r = 0; r < 16; ++r) { p0[r] -= dl; p1[r] -= dl; negm[r] = -mrun; oT[0][r] *= al; oT[1][r] *= al; }
            moved = true;
        }
        float rs = 0.f;
#pragma unroll
        for (int r = 0; r < 16; ++r) { p0[r] = __builtin_amdgcn_exp2f(p0[r]); p1[r] = __builtin_amdgcn_exp2f(p1[r]); rs += p0[r] + p1[r]; }
        lrun += rs;
        bf16x8 pf[4];
        { u32x4 w;
          w.x = cvtpk(p0[0], p0[1]); w.y = cvtpk(p0[2], p0[3]); w.z = cvtpk(p0[4], p0[5]); w.w = cvtpk(p0[6], p0[7]); pf[0] = __builtin_bit_cast(bf16x8, w);
          w.x = cvtpk(p0[8], p0[9]); w.y = cvtpk(p0[10], p0[11]); w.z = cvtpk(p0[12], p0[13]); w.w = cvtpk(p0[14], p0[15]); pf[1] = __builtin_bit_cast(bf16x8, w);
          w.x = cvtpk(p1[0], p1[1]); w.y = cvtpk(p1[2], p1[3]); w.z = cvtpk(p1[4], p1[5]); w.w = cvtpk(p1[6], p1[7]); pf[2] = __builtin_bit_cast(bf16x8, w);
          w.x = cvtpk(p1[8], p1[9]); w.y = cvtpk(p1[10], p1[11]); w.z = cvtpk(p1[12], p1[13]); w.w = cvtpk(p1[14], p1[15]); pf[3] = __builtin_bit_cast(bf16x8, w); }
        const LAS unsigned char* vb = lds + slot * SLOT + KB + vlane;
#pragma unroll
        for (int d0 = 0; d0 < 2; ++d0)
#pragma unroll
            for (int ks = 0; ks < 4; ++ks) {
                const s16x4 lo = vtr(vb + d0 * 4096 + ks * 1024), hh = vtr(vb + d0 * 4096 + ks * 1024 + 512);
                const bf16x8 vf = (bf16x8){lo[0], lo[1], lo[2], lo[3], hh[0], hh[1], hh[2], hh[3]};
                oT[d0] = __builtin_amdgcn_mfma_f32_32x32x16_bf16(vf, pf[ks], oT[d0], 0, 0, 0);
                if (ks & 1) asm volatile("" ::: "memory");
            }
        return moved;
    };
    dma(kt0, 0); dma(kt0 + 1, 1); dma(kt0 + 2, 2);
    wait_bar(true);
    f32x16 pA0, pA1, pB0, pB1;
    qk(0, pA0, pA1);
    { mrun = tilemax(pA0, pA1);
#pragma unroll
      for (int r = 0; r < 16; ++r) negm[r] = -mrun;
      qk(0, pA0, pA1); }
    int sc = 0;
    for (int kt = kt0; kt < kt1; kt += 2) {
        { const int s1 = (sc + 1) & 3, s3 = (sc + 3) & 3;
          if (kt + 3 < kt1) dma(kt + 3, s3);
          qk(s1, pB0, pB1);
          if (smpv(pA0, pA1, sc)) qk(s1, pB0, pB1);
          wait_bar(kt + 3 < kt1);
          sc = s1; }
        { const int s1 = (sc + 1) & 3, s3 = (sc + 3) & 3;
          if (kt + 4 < kt1) dma(kt + 4, s3);
          if (kt + 2 < kt1) qk(s1, pA0, pA1);
          if (smpv(pB0, pB1, sc) && kt + 2 < kt1) qk(s1, pA0, pA1);
          wait_bar(kt + 4 < kt1);
          sc = s1; }
    }
    { auto rr = __builtin_amdgcn_permlane32_swap(__float_as_uint(lrun), __float_as_uint(lrun), false, false); lrun = __uint_as_float(rr[0]) + __uint_as_float(rr[1]); }
    const float inv = 1.0f / lrun;
    bf16_t* orow = S.O + (size_t)(q0 + wid * 32 + r32) * S.opitch;
#pragma unroll
    for (int d0 = 0; d0 < 2; ++d0)
#pragma unroll
        for (int g = 0; g < 4; ++g) { u32x2 w; w.x = cvtpk(oT[d0][4 * g] * inv, oT[d0][4 * g + 1] * inv); w.y = cvtpk(oT[d0][4 * g + 2] * inv, oT[d0][4 * g + 3] * inv);
            *(u32x2*)(orow + 32 * d0 + 8 * g + 4 * hi) = w; }
}

__device__ __forceinline__ int sig5(int c) { return (c & ~12) | ((c & 8) >> 1) | ((c & 4) << 1); }

__global__ void __launch_bounds__(512, 2) mk_fwd(Args args) {
    extern __shared__ __attribute__((aligned(16))) unsigned char lds_raw[];
    Frame F;
    F.lds = (LAS unsigned char*)lds_raw; F.ws = args.ws;
    F.tid = threadIdx.x; F.lane = F.tid & 63; F.wave = __builtin_amdgcn_readfirstlane(F.tid >> 6);
    F.G = gridDim.x; { const int bx = blockIdx.x; F.vcu = (F.G % 8 == 0) ? (bx % 8) * (F.G / 8) + bx / 8 : bx; }
    volatile LAS unsigned* MISC = (volatile LAS unsigned*)(F.lds + LDSCTL_OFF);
    if (F.tid < 64) MISC[F.tid] = 0u;
    __syncthreads();
    unsigned* ctl = wsp<unsigned>(F, O_CTL);
#if MK_ONE_LAUNCH
    XcdBarrier bar = xcd_barrier_post(ctl + CW_BAR, MISC + 8);
#define GRID_BAR() xcd_barrier(bar)
#else
#define GRID_BAR() do {} while (0)
#endif
    const int lo = args.ph_lo, hi_ph = args.ph_hi;
#define IN(k) (lo <= (k) && (k) < hi_ph)
#define SEAM(k) do { if (IN(k) && IN((k) + 1)) GRID_BAR(); } while (0)
    const int lane = F.lane, wave = F.wave, tid = F.tid;
    const int gw = F.vcu * 8 + wave, NGW = F.G * 8;

    const float* x_in = args.in[I_X]; const float* ctx_in = args.in[I_CTX];
    float* MODV = wsp<float>(F, O_MODV);
    float* TAB16 = wsp<float>(F, O_TAB16); float* TAB32 = wsp<float>(F, O_TAB32);
    float* HC = wsp<float>(F, O_HC);
    bf16_t* U = wsp<bf16_t>(F, O_U);
    float* Y = wsp<float>(F, O_Y);
    const float* normg = args.in[I_NORMG];
#define MV(layer, bidx, k) (MODV + ((size_t)((layer) * 5 + (bidx)) * 6 + (k)) * D)

    if (IN(0)) {
        {
            LAS float* sc = (LAS float*)F.lds;
            LAS float* red = sc + 5 * 1024;
            for (int i = tid; i < 5 * 1024; i += 512) { const int b = i >> 10, k = i & 1023; const float cv = (b < 4) ? args.in[I_C][b * 1024 + k] : args.in[I_CCTX][k]; sc[i] = cv / (1.0f + __expf(-cv)); }
            __syncthreads();
            for (int unit = F.vcu; unit < 192; unit += F.G) {
                const int layer = unit / 96, cb = unit % 96, col = cb * 64 + lane;
                const float* W = args.in[I_MODW] + (size_t)layer * D * 6144 + col;
                float a0 = 0.f, a1 = 0.f, a2 = 0.f, a3 = 0.f, a4 = 0.f;
#pragma unroll 16
                for (int kk = 0; kk < 128; ++kk) { const int k = wave * 128 + kk; const float w = W[(size_t)k * 6144];
                    a0 += sc[k] * w; a1 += sc[1024 + k] * w; a2 += sc[2048 + k] * w; a3 += sc[3072 + k] * w; a4 += sc[4096 + k] * w; }
                red[(wave * 5 + 0) * 64 + lane] = a0; red[(wave * 5 + 1) * 64 + lane] = a1; red[(wave * 5 + 2) * 64 + lane] = a2; red[(wave * 5 + 3) * 64 + lane] = a3; red[(wave * 5 + 4) * 64 + lane] = a4;
                __syncthreads();
                if (tid < 320) { const int b = tid >> 6, cc = tid & 63; float s = 0.f;
#pragma unroll
                    for (int w = 0; w < 8; ++w) s += red[(w * 5 + b) * 64 + cc];
                    MODV[(size_t)(layer * 5 + b) * 6144 + cb * 64 + cc] = s + args.in[I_MODB][layer * 6144 + cb * 64 + cc]; }
                __syncthreads();
            }
        }
        if (blockIdx.x == 0) {
            for (int i = tid; i < 64 * 8; i += 512) { const int pos = i >> 3, f = i & 7; const float fr = powf(10000.0f, -(float)f / 8.0f), a = (float)pos * fr; TAB16[i] = cosf(a); TAB16[512 + i] = sinf(a); }
            for (int i = tid; i < 64 * 16; i += 512) { const int pos = i >> 4, f = i & 15; const float fr = powf(10000.0f, -(float)f / 16.0f), a = (float)pos * fr; TAB32[i] = cosf(a); TAB32[1024 + i] = sinf(a); }
        }
        {
            LAS float* scr = (LAS float*)(F.lds + wave * 16640);
            int base = 0;
            auto run = [&](const Conv& c) { const int n = (c.K / 64) * (c.Ndst / 32); for (int it = gw - base; it < n; it += NGW) { if (it >= 0) conv_item(c, it, scr, lane); }
                base = (base + n) % NGW; };
            auto run64 = [&](const Conv64& c) { conv64_run(c, scr, lane, gw, NGW, base); };
            run64(Conv64{args.in[I_FWG], args.in[I_FWU], FFN, 1024, N_GU0, wsp<bf16_t>(F, O_WGU0), 3, 0, 0, 1.0f, 0});
            run64(Conv64{args.in[I_FWD], nullptr, 1024, FFN, 1024, wsp<bf16_t>(F, O_WD0), 0, 1024, 0, 1.0f, 0});
            run64(Conv64{args.in[I_GWIN], nullptr, 3104, 1024, N_IN1, wsp<bf16_t>(F, O_WIN1), 0, 3104, 512, 0.08838834764831845f, 0});
            run64(Conv64{args.in[I_GWOUT], nullptr, 1024, 1024, 1024, wsp<bf16_t>(F, O_WOUT1), 0, 1024, 0, 1.0f, 0});
            run64(Conv64{args.in[I_AWOUT], nullptr, 1024, 1024, 1024, wsp<bf16_t>(F, O_WOUT0), 0, 1024, 0, 1.0f, 0});
            run(Conv{args.in[I_AWIN], nullptr, 1440, 1024, N_IN0, wsp<bf16_t>(F, O_WIN0), 1, nullptr});
            run(Conv{args.in[I_AWUQ], nullptr, 768, 384, N_QA, wsp<bf16_t>(F, O_WUQ), 2, args.in[I_AQN]});
            run(Conv{args.in[I_AWUKV], nullptr, 1024, 256, N_KVA, wsp<bf16_t>(F, O_WUKV), 0, args.in[I_AKVN]});
        }
    }
    SEAM(0);

    if (IN(1)) {
        for (int row = gw; row < R; row += NGW) {
            const float* hp = row < RL ? x_in + (size_t)row * D : ctx_in + (size_t)(row - RL) * D;
            f32x4 h[4], uo[4]; load_row(hp, lane, h);
            const int b = row_bidx(row);
            norm_mod_store(h, normg + 0 * D, MV(0, b, 0), MV(0, b, 1), U + (size_t)row * D, lane, uo);
        }
    }
    SEAM(1);

    if (IN(2)) {
        pg8::DenseProb P{U, wsp<bf16_t>(F, O_WIN0), 1024, 1024, 1024, {}}; P.ord.init(R / 256, N_IN0 / 256, F.G, (int)blockIdx.x);
        pg8::EpiBf16 E{wsp<bf16_t>(F, O_Z0), N_IN0, nullptr};
        pg8::gemm_phase(F.lds, P, E);
    }
    SEAM(2);

    if (IN(3)) {
        const bf16_t* Z0 = wsp<bf16_t>(F, O_Z0);
        float* RSQ = wsp<float>(F, O_RSTDQ); float* RSKV = wsp<float>(F, O_RSTDKV);
        bf16_t* QB = wsp<bf16_t>(F, O_QB); bf16_t* KBp = wsp<bf16_t>(F, O_KB); bf16_t* KR = wsp<bf16_t>(F, O_KR);
        const float* qkn = args.in[I_AQKN];
        for (int row = gw; row < R; row += NGW) {
            const unsigned* z32 = (const unsigned*)(Z0 + (size_t)row * N_IN0);
            float s = 0.f;
#pragma unroll
            for (int j = 0; j < 3; ++j) { const unsigned w = z32[lane + 64 * j]; const float a = bflo(w), b = bfhi(w); s += a * a + b * b; }
            s = wave_sum(s);
            float s2 = 0.f;
#pragma unroll
            for (int j = 0; j < 2; ++j) { const unsigned w = z32[192 + lane + 64 * j]; const float a = bflo(w), b = bfhi(w); s2 += a * a + b * b; }
            s2 = wave_sum(s2);
            if (lane == 0) { RSQ[row] = __builtin_amdgcn_rsqf(s * (1.0f / 384.0f) + EPS); RSKV[row] = __builtin_amdgcn_rsqf(s2 * (1.0f / 256.0f) + EPS); }
            const bool lat = row < RL; const int tt = row & (SEQ - 1);
#pragma unroll
            for (int which = 0; which < 2; ++which) {
                if (which == 1 && lane >= 16) break;
                const u32x4 w4 = *(const u32x4*)(Z0 + (size_t)row * N_IN0 + (which ? 1152 : 640) + lane * 8);
                float v[8] = {bflo(w4.x), bfhi(w4.x), bflo(w4.y), bfhi(w4.y), bflo(w4.z), bfhi(w4.z), bflo(w4.w), bfhi(w4.w)};
                float ss = 0.f;
#pragma unroll
                for (int j = 0; j < 8; ++j) ss += v[j] * v[j];
                ss += __shfl_xor(ss, 1); ss += __shfl_xor(ss, 2); ss += __shfl_xor(ss, 4);
                const float rstd = __builtin_amdgcn_rsqf(ss * (1.0f / 64.0f) + EPS);
                const int jp = lane & 7, half = jp >> 2, i0 = 4 * (jp & 3);
                const float* gn = qkn + which * 64 + half * 32;
#pragma unroll
                for (int pz = 0; pz < 4; ++pz) { v[2 * pz] *= rstd * gn[i0 + pz]; v[2 * pz + 1] *= rstd * gn[16 + i0 + pz]; }
                if (lat) { const int pos = half ? (tt & 63) : (tt >> 6);
                    const f32x4 cs = *(const f32x4*)(TAB32 + pos * 16 + i0), sn = *(const f32x4*)(TAB32 + 1024 + pos * 16 + i0);
#pragma unroll
                    for (int pz = 0; pz < 4; ++pz) { const float a = v[2 * pz], b = v[2 * pz + 1]; v[2 * pz] = a * cs[pz] - b * sn[pz]; v[2 * pz + 1] = b * cs[pz] + a * sn[pz]; } }
                const float osc = which ? 1.0f : 0.125f * LOG2E;
                u32x4 o; o.x = cvtpk(v[0] * osc, v[1] * osc); o.y = cvtpk(v[2] * osc, v[3] * osc); o.z = cvtpk(v[4] * osc, v[5] * osc); o.w = cvtpk(v[6] * osc, v[7] * osc);
                if (which == 0) *(u32x4*)(QB + (size_t)row * 512 + lane * 8) = o; else *(u32x4*)(KBp + (size_t)row * 128 + lane * 8) = o;
            }
            if (lane < 4) {
                const u32x4 w4 = *(const u32x4*)(Z0 + (size_t)row * N_IN0 + 1408 + lane * 8);
                float v[8] = {bflo(w4.x), bfhi(w4.x), bflo(w4.y), bfhi(w4.y), bflo(w4.z), bfhi(w4.z), bflo(w4.w), bfhi(w4.w)};
                if (lat) { const int half = lane >> 1, i0 = 4 * (lane & 1); const int pos = half ? (tt & 63) : (tt >> 6);
                    const f32x4 cs = *(const f32x4*)(TAB16 + pos * 8 + i0), sn = *(const f32x4*)(TAB16 + 512 + pos * 8 + i0);
#pragma unroll
                    for (int pz = 0; pz < 4; ++pz) { const float a = v[2 * pz], b = v[2 * pz + 1]; v[2 * pz] = a * cs[pz] - b * sn[pz]; v[2 * pz + 1] = b * cs[pz] + a * sn[pz]; } }
                u32x4 o; o.x = cvtpk(v[0], v[1]); o.y = cvtpk(v[2], v[3]); o.z = cvtpk(v[4], v[5]); o.w = cvtpk(v[6], v[7]);
                *(u32x4*)(KR + (size_t)row * 32 + lane * 8) = o;
            }
        }
    }
    SEAM(3);

    if (IN(4)) {
        { pg8::DenseProb P{wsp<bf16_t>(F, O_Z0), wsp<bf16_t>(F, O_WUQ), 384, N_IN0, 384, {}}; P.ord.init(R / 256, N_QA / 256, F.G, (int)blockIdx.x);
          pg8::EpiQA E{wsp<bf16_t>(F, O_QA), wsp<float>(F, O_RSTDQ), TAB16, 0.10206207261596577f * LOG2E};
          pg8::gemm_phase(F.lds, P, E); }
        { pg8::DenseProb P{wsp<bf16_t>(F, O_Z0) + 384, wsp<bf16_t>(F, O_WUKV), 256, N_IN0, 256, {}}; P.ord.init(R / 256, N_KVA / 256, F.G, (int)((blockIdx.x + F.G - (204 % F.G)) % F.G));
          pg8::EpiBf16 E{wsp<bf16_t>(F, O_KVA), N_KVA, wsp<float>(F, O_RSTDKV)};
          pg8::gemm_phase(F.lds, P, E); }
    }
    SEAM(4);

    if (IN(5)) {
        const bf16_t* QA = wsp<bf16_t>(F, O_QA); const bf16_t* KVA = wsp<bf16_t>(F, O_KVA); const bf16_t* QB = wsp<bf16_t>(F, O_QB);
        const bf16_t* KBp = wsp<bf16_t>(F, O_KB); const bf16_t* KR = wsp<bf16_t>(F, O_KR); const bf16_t* Z0 = wsp<bf16_t>(F, O_Z0);
        bf16_t* AO = wsp<bf16_t>(F, O_AO);
        for (int i = 0; i < 3; ++i) {
            int b, hh, q0, kt0, kt1;
            if (i < 2) { const int m = i * 256 + F.vcu; b = m >> 7; hh = (m >> 4) & 7; q0 = b * SEQ + (m & 15) * 256; kt0 = 0; kt1 = 68; }
            else { if (F.vcu >= 32) break; b = (F.vcu >> 3) & 3; hh = F.vcu & 7; q0 = RL + b * CTX; kt0 = 64; kt1 = 68; }
            const int lat0 = b * SEQ, ctx0 = RL + b * CTX;
            AttnSrc<96> S{QA + hh * 64, N_QA, QA + 512 + hh * 32, KVA + hh * 128, N_KVA, KR, 32, KVA + hh * 128 + 64, N_KVA, AO + hh * 64, D};
            attn_unit<96>(F, S, q0, lat0, ctx0, kt0, kt1);
        }
        for (int i = 0; i < 3; ++i) {
            int b, hh, q0, kt0, kt1;
            if (i < 2) { const int m = i * 256 + F.vcu; b = m >> 7; hh = (m >> 4) & 7; q0 = b * SEQ + (m & 15) * 256; kt0 = 0; kt1 = 68; }
            else { if (F.vcu < 32 || F.vcu >= 64) break; b = (F.vcu >> 3) & 3; hh = F.vcu & 7; q0 = RL + b * CTX; kt0 = 64; kt1 = 68; }
            const int lat0 = b * SEQ, ctx0 = RL + b * CTX; const int kvh = hh >> 2;
            AttnSrc<64> S{QB + hh * 64, 512, nullptr, KBp + kvh * 64, 128, nullptr, 0, Z0 + 1280 + kvh * 64, N_IN0, AO + 512 + hh * 64, D};
            attn_unit<64>(F, S, q0, lat0, ctx0, kt0, kt1);
        }
    }
    SEAM(5);

    if (IN(6)) {
        pg8::DenseProb P{wsp<bf16_t>(F, O_AO), wsp<bf16_t>(F, O_WOUT0), 1024, 1024, 1024, {}}; P.ord.init(R / 256, 4, F.G, (int)blockIdx.x);
        pg8::EpiF32 E{Y, D};
        pg8::gemm_phase(F.lds, P, E);
    }
    SEAM(6);

    if (IN(7)) {
        for (int row = gw; row < R; row += NGW) {
            const float* hp = row < RL ? x_in + (size_t)row * D : ctx_in + (size_t)(row - RL) * D;
            float* ho = row < RL ? args.out + (size_t)row * D : HC + (size_t)(row - RL) * D;
            const int b = row_bidx(row);
            f32x4 y[4], h[4], uo[4]; load_row(Y + (size_t)row * D, lane, y); load_row(hp, lane, h);
            const float rstd = __builtin_amdgcn_rsqf(row_ssq(y) * (1.0f / D) + EPS);
#pragma unroll
            for (int j = 0; j < 4; ++j) { const int c = 4 * lane + 256 * j; const f32x4 g = *(const f32x4*)(normg + 1 * D + c), mg = *(const f32x4*)(MV(0, b, 2) + c);
                h[j] = h[j] + mg * (y[j] * rstd * g); *(f32x4*)(ho + c) = h[j]; }
            norm_mod_store(h, normg + 2 * D, MV(0, b, 3), MV(0, b, 4), U + (size_t)row * D, lane, uo);
        }
    }
    SEAM(7);

    if (IN(8)) {
        pg8::DenseProb P{U, wsp<bf16_t>(F, O_WGU0), 1024, 1024, 1024, {}}; P.ord.init(R / 256, N_GU0 / 256, F.G, (int)blockIdx.x);
        pg8::EpiSwiglu E{wsp<bf16_t>(F, O_H0), FFN};
        pg8::gemm_phase(F.lds, P, E);
    }
    SEAM(8);
    if (IN(9)) {
        pg8::DenseProb P{wsp<bf16_t>(F, O_H0), wsp<bf16_t>(F, O_WD0), FFN, FFN, FFN, {}}; P.ord.init(R / 256, 4, F.G, (int)blockIdx.x);
        pg8::EpiF32 E{Y, D};
        pg8::gemm_phase(F.lds, P, E);
    }
    SEAM(9);

    if (IN(10)) {
        for (int row = gw; row < R; row += NGW) {
            float* hp = row < RL ? args.out + (size_t)row * D : HC + (size_t)(row - RL) * D;
            const int b = row_bidx(row);
            f32x4 y[4], h[4], uo[4]; load_row(Y + (size_t)row * D, lane, y); load_row(hp, lane, h);
            const float rstd = __builtin_amdgcn_rsqf(row_ssq(y) * (1.0f / D) + EPS);
#pragma unroll
            for (int j = 0; j < 4; ++j) { const int c = 4 * lane + 256 * j; const f32x4 g = *(const f32x4*)(normg + 3 * D + c), mg = *(const f32x4*)(MV(0, b, 5) + c);
                h[j] = h[j] + mg * (y[j] * rstd * g); *(f32x4*)(hp + c) = h[j]; }
            norm_mod_store(h, normg + 4 * D, MV(1, b, 0), MV(1, b, 1), U + (size_t)row * D, lane, uo);
        }
    }
    SEAM(10);

    if (IN(11)) {
        pg8::DenseProb P{U, wsp<bf16_t>(F, O_WIN1), 1024, 1024, 1024, {}}; P.ord.init(R / 256, N_IN1 / 256, F.G, (int)blockIdx.x);
        pg8::EpiIn1 E{wsp<bf16_t>(F, O_QK1), wsp<bf16_t>(F, O_V1), wsp<bf16_t>(F, O_G1), wsp<bf16_t>(F, O_RR)};
        pg8::gemm_phase(F.lds, P, E);
    }
    SEAM(11);

    if (IN(12)) {
        const bf16_t* QK1 = wsp<bf16_t>(F, O_QK1); const bf16_t* V1 = wsp<bf16_t>(F, O_V1); const bf16_t* RRp = wsp<bf16_t>(F, O_RR);
        bf16_t* QDd[2] = {wsp<bf16_t>(F, O_QDF), wsp<bf16_t>(F, O_QDB)}; bf16_t* KId[2] = {wsp<bf16_t>(F, O_KIF), wsp<bf16_t>(F, O_KIB)}; bf16_t* KTd[2] = {wsp<bf16_t>(F, O_KTF), wsp<bf16_t>(F, O_KTB)};
        bf16_t* VT = wsp<bf16_t>(F, O_VT); float* ECL = wsp<float>(F, O_ECL);
        LAS float* tot = (LAS float*)F.lds;
        const int dk = tid & 127, tq = tid >> 7;
        for (int item = F.vcu; item < 544 * 4; item += F.G) {
            const int rc = item >> 2, hh = item & 3, row0 = rc * 32;
            float w2[2][16], bg[2];
#pragma unroll
            for (int d = 0; d < 2; ++d) { bg[d] = args.in[I_GBGATE][d * 512 + hh * 128 + dk];
#pragma unroll
                for (int j = 0; j < 16; ++j) w2[d][j] = args.in[I_GGATE2][(size_t)(d * 16 + j) * 512 + hh * 128 + dk]; }
            float a[2][8];
#pragma unroll
            for (int i = 0; i < 8; ++i) { const int row = row0 + 8 * tq + i;
                const u32x4* rp = (const u32x4*)(RRp + (size_t)row * 256);
#pragma unroll
                for (int d = 0; d < 2; ++d) { const u32x4 r0 = rp[2 * d], r1 = rp[2 * d + 1];
                    const float rv[16] = {bflo(r0.x), bfhi(r0.x), bflo(r0.y), bfhi(r0.y), bflo(r0.z), bfhi(r0.z), bflo(r0.w), bfhi(r0.w), bflo(r1.x), bfhi(r1.x), bflo(r1.y), bfhi(r1.y), bflo(r1.z), bfhi(r1.z), bflo(r1.w), bfhi(r1.w)};
                    float z = bg[d];
#pragma unroll
                    for (int j = 0; j < 16; ++j) z += rv[j] * w2[d][j];
                    a[d][i] = (fminf(z, 0.f) - __logf(1.0f + __expf(-fabsf(z)))) * (1.0f / 16.0f); } }
            float cf[8], sb[8];
            { float s = 0.f;
#pragma unroll
              for (int i = 0; i < 8; ++i) { s += a[0][i]; cf[i] = s; }
              s = 0.f;
#pragma unroll
              for (int i = 7; i >= 0; --i) { s += a[1][i]; sb[i] = s; } }
            tot[(0 * 4 + tq) * 128 + dk] = cf[7]; tot[(1 * 4 + tq) * 128 + dk] = sb[0];
            __syncthreads();
            float offF = 0.f, offB = 0.f, clF = 0.f, clB = 0.f;
#pragma unroll
            for (int g = 0; g < 4; ++g) { const float tf = tot[(0 * 4 + g) * 128 + dk], tb = tot[(1 * 4 + g) * 128 + dk]; clF += tf; clB += tb; if (g < tq) offF += tf; if (g > tq) offB += tb; }
            __syncthreads();
            const int pc = hh * 128 + (dk & ~31) + sig5(dk & 31);
            unsigned ktw[2][4];
#pragma unroll
            for (int i = 0; i < 8; ++i) { const int row = row0 + 8 * tq + i;
                const float q = bf2f(QK1[(size_t)row * D + hh * 128 + dk]), k = bf2f(QK1[(size_t)row * D + 512 + hh * 128 + dk]);
                const float cF = offF + cf[i], cB = offB + sb[i];
                const float kiF = k * __expf(-cF), kiB = k * __expf(-cB);
                QDd[0][(size_t)row * 512 + pc] = f2bf(q * __expf(cF)); KId[0][(size_t)row * 512 + pc] = f2bf(kiF);
                QDd[1][(size_t)row * 512 + pc] = f2bf(q * __expf(cB)); KId[1][(size_t)row * 512 + pc] = f2bf(kiB);
                const unsigned bF = f2bf(kiF), bB = f2bf(kiB);
                if (i & 1) { ktw[0][i >> 1] |= bF << 16; ktw[1][i >> 1] |= bB << 16; } else { ktw[0][i >> 1] = bF; ktw[1][i >> 1] = bB; } }
#pragma unroll
            for (int d = 0; d < 2; ++d) { bf16_t* kt = KTd[d] + ((size_t)(rc * 4 + hh) * 128 + dk) * 32 + 16 * (tq >> 1) + 4 * (tq & 1);
                u32x2 w0; w0.x = ktw[d][0]; w0.y = ktw[d][1]; *(u32x2*)kt = w0; u32x2 w1; w1.x = ktw[d][2]; w1.y = ktw[d][3]; *(u32x2*)(kt + 8) = w1; }
            if (tq == 0) { ECL[((size_t)(rc * 2 + 0) * 4 + hh) * 256 + dk] = __expf(clF); ECL[((size_t)(rc * 2 + 1) * 4 + hh) * 256 + dk] = __expf(clB); }
            { const int dv = tid & 255, th = tid >> 8; unsigned vw[8];
#pragma unroll
              for (int i = 0; i < 16; ++i) { const unsigned bv = V1[(size_t)(row0 + 16 * th + i) * D + hh * 256 + dv];
                  const int cc = sig5(i);
                  if (cc & 1) vw[cc >> 1] |= bv << 16; else vw[cc >> 1] = bv; }
              bf16_t* vp = VT + ((size_t)rc * 1024 + hh * 256 + dv) * 32 + 16 * th;
              u32x4 o0; o0.x = vw[0]; o0.y = vw[1]; o0.z = vw[2]; o0.w = vw[3]; *(u32x4*)vp = o0;
              u32x4 o1; o1.x = vw[4]; o1.y = vw[5]; o1.z = vw[6]; o1.w = vw[7]; *(u32x4*)(vp + 8) = o1; }
        }
    }
    SEAM(12);

    if (IN(13)) {
        const int xl = blockIdx.x & 7, jj = blockIdx.x >> 3;
        const bool scan_role = (jj & 1) == 0;
        const int nscan = ((F.G >> 3) + 1) / 2 * 8, nconv = F.G - nscan;
        if ((F.G & 7) == 0 && nconv > 0 && !scan_role) {
            LAS float* scr = (LAS float*)(F.lds + wave * 16640);
            const int cidx = xl * (F.G >> 4) + (jj >> 1); int base = 0; const int gwi = cidx * 8 + wave, ngw = nconv * 8;
            for (int e = 0; e < NEXP; ++e) {
                conv64_run(Conv64{args.in[I_MWG] + (size_t)e * D * EXD, args.in[I_MWU] + (size_t)e * D * EXD, EXD, 1024, N_GU1, wsp<bf16_t>(F, O_WGU1) + (size_t)e * N_GU1 * 1024 / 2, 3, 0, 0, 64.0f, 1}, scr, lane, gwi, ngw, base);
                conv64_run(Conv64{args.in[I_MWD] + (size_t)e * EXD * D, nullptr, 1024, EXD, 1024, wsp<bf16_t>(F, O_WD1) + (size_t)e * 1024 * EXD / 2, 0, 1024, 1024, 64.0f, 1}, scr, lane, gwi, ngw, base);
            }
        } else {
        const bool split = (F.G & 7) == 0 && nconv > 0;
        const int sidx = split ? xl * ((F.G >> 4) + ((F.G >> 3) & 1)) + (jj >> 1) : F.vcu, nsw = split ? nscan : F.G;
        const bf16_t* VT = wsp<bf16_t>(F, O_VT); const float* ECL = wsp<float>(F, O_ECL);
        constexpr int SLOT = 8192 * 3 + 2 * 2048 + 1024;
        const int r32 = lane & 31, hi = lane >> 5;
        for (int unit = sidx; unit < 128; unit += nsw) {
            const int chain = unit >> 2, dvp = unit & 3, b = chain >> 3, hh = (chain >> 1) & 3, dir = chain & 1;
            const int dvb = dvp * 2 + (wave & 1);
            const bf16_t* QDp = wsp<bf16_t>(F, dir ? O_QDB : O_QDF); const bf16_t* KIp = wsp<bf16_t>(F, dir ? O_KIB : O_KIF); const bf16_t* KTp = wsp<bf16_t>(F, dir ? O_KTB : O_KTF);
            bf16_t* Odp = wsp<bf16_t>(F, dir ? O_OB : O_OF);
            auto rcof = [&](int step) { return step < 8 ? 512 + b * 8 + (dir ? 7 - step : step) : b * 128 + (dir ? 127 - (step - 8) : (step - 8)); };
            const unsigned lds0 = (unsigned)(size_t)F.lds;
            auto dma = [&](int step, int slot) {
                const int rc = rcof(step); const unsigned sb = lds0 + slot * SLOT;
                const int ch = lane >> 5, rw = lane & 31;
                glds16(KIp + (size_t)(rc * 32 + rw) * 512 + hh * 128 + (2 * wave + ch) * 8, (unsigned)__builtin_amdgcn_readfirstlane(sb + wave * 1024));
                glds16(QDp + (size_t)(rc * 32 + rw) * 512 + hh * 128 + (2 * wave + ch) * 8, (unsigned)__builtin_amdgcn_readfirstlane(sb + 8192 + wave * 1024));
                glds16(KTp + ((size_t)(rc * 4 + hh) * 128 + 32 * (wave >> 1) + rw) * 32 + (2 * (wave & 1) + ch) * 8, (unsigned)__builtin_amdgcn_readfirstlane(sb + 16384 + wave * 1024));
                if (wave < 4) glds16(VT + ((size_t)rc * 1024 + hh * 256 + (dvp * 2 + (wave >> 1)) * 32 + rw) * 32 + (2 * (wave & 1) + ch) * 8, (unsigned)__builtin_amdgcn_readfirstlane(sb + 24576 + wave * 1024));
                if (wave == 4) glds16(ECL + ((size_t)(rc * 2 + dir) * 4 + hh) * 256 + lane * 4, (unsigned)__builtin_amdgcn_readfirstlane(sb + 28672));
            };
            auto wait_bar = [&](bool inflight) { if (!inflight) { WAIT_BAR(0); } else if (wave < 5) { WAIT_BAR(4); } else { WAIT_BAR(3); } };
            f32x16 S4[4];
#pragma unroll
            for (int k = 0; k < 4; ++k)
#pragma unroll
                for (int r = 0; r < 16; ++r) S4[k][r] = 0.f;
            dma(0, 0); dma(1, 1);
            wait_bar(true);
            int slot = 0;
            for (int step = 0; step < 136; ++step) {
                if (step + 2 < 136) dma(step + 2, slot == 0 ? 2 : slot - 1);
                if (wave < 2) {
                    const LAS unsigned char* sb = F.lds + slot * SLOT;
                    const int fo = hi * 512 + r32 * 16;
                    const LAS unsigned char* vbase = sb + 24576 + wave * 2048;
                    bf16x8 qdF[8];
#pragma unroll
                    for (int k = 0; k < 8; ++k) qdF[k] = *(const LAS bf16x8*)(sb + 8192 + k * 1024 + fo);
                    const bf16x8 vF0 = *(const LAS bf16x8*)(vbase + fo), vF1 = *(const LAS bf16x8*)(vbase + 1024 + fo);
                    f32x16 o;
#pragma unroll
                    for (int r = 0; r < 16; ++r) o[r] = 0.f;
                    if (step >= 8) {
                        f32x16 sc;
#pragma unroll
                        for (int r = 0; r < 16; ++r) sc[r] = 0.f;
#pragma unroll
                        for (int k = 0; k < 8; ++k) { const bf16x8 kiF = *(const LAS bf16x8*)(sb + k * 1024 + fo); sc = __builtin_amdgcn_mfma_f32_32x32x16_bf16(kiF, qdF[k], sc, 0, 0, 0); }
#pragma unroll
                        for (int r = 0; r < 16; ++r) { const int s = (r & 3) + 8 * (r >> 2) + 4 * hi; const bool keep = dir ? (s >= r32) : (s <= r32); sc[r] = keep ? sc[r] : 0.f; }
                        u32x4 w; bf16x8 pf0, pf1;
                        w.x = cvtpk(sc[0], sc[1]); w.y = cvtpk(sc[2], sc[3]); w.z = cvtpk(sc[4], sc[5]); w.w = cvtpk(sc[6], sc[7]); pf0 = __builtin_bit_cast(bf16x8, w);
                        w.x = cvtpk(sc[8], sc[9]); w.y = cvtpk(sc[10], sc[11]); w.z = cvtpk(sc[12], sc[13]); w.w = cvtpk(sc[14], sc[15]); pf1 = __builtin_bit_cast(bf16x8, w);
                        o = __builtin_amdgcn_mfma_f32_32x32x16_bf16(pf0, vF0, o, 0, 0, 0);
                        o = __builtin_amdgcn_mfma_f32_32x32x16_bf16(pf1, vF1, o, 0, 0, 0);
#pragma unroll
                        for (int blk = 0; blk < 4; ++blk)
#pragma unroll
                            for (int s2 = 0; s2 < 2; ++s2) { u32x4 ws4; ws4.x = cvtpk(S4[blk][8 * s2], S4[blk][8 * s2 + 1]); ws4.y = cvtpk(S4[blk][8 * s2 + 2], S4[blk][8 * s2 + 3]);
                                ws4.z = cvtpk(S4[blk][8 * s2 + 4], S4[blk][8 * s2 + 5]); ws4.w = cvtpk(S4[blk][8 * s2 + 6], S4[blk][8 * s2 + 7]);
                                o = __builtin_amdgcn_mfma_f32_32x32x16_bf16(qdF[2 * blk + s2], __builtin_bit_cast(bf16x8, ws4), o, 0, 0, 0); }
                        const int rc = rcof(step);
                        bf16_t* op = Odp + (size_t)(rc * 32) * D + hh * 256 + dvb * 32 + r32;
#pragma unroll
                        for (int r = 0; r < 16; ++r) { const int t = (r & 3) + 8 * (r >> 2) + 4 * hi; op[(size_t)t * D] = f2bf(o[r]); }
                    }
#pragma unroll
                    for (int blk = 0; blk < 4; ++blk) {
                        const bf16x8 kt0 = *(const LAS bf16x8*)(sb + 16384 + blk * 2048 + fo), kt1 = *(const LAS bf16x8*)(sb + 16384 + blk * 2048 + 1024 + fo);
                        S4[blk] = __builtin_amdgcn_mfma_f32_32x32x16_bf16(kt0, vF0, S4[blk], 0, 0, 0);
                        S4[blk] = __builtin_amdgcn_mfma_f32_32x32x16_bf16(kt1, vF1, S4[blk], 0, 0, 0);
#pragma unroll
                        for (int g = 0; g < 4; ++g) { const f32x4 e4 = *(const LAS f32x4*)(sb + 28672 + (32 * blk + 8 * g + 4 * hi) * 4);
                            S4[blk][4 * g] *= e4[0]; S4[blk][4 * g + 1] *= e4[1]; S4[blk][4 * g + 2] *= e4[2]; S4[blk][4 * g + 3] *= e4[3]; }
                    }
                }
                wait_bar(step + 2 < 136);
                slot = (slot == 2) ? 0 : slot + 1;
            }
        }
        if (!split) {
            LAS float* scr = (LAS float*)(F.lds + wave * 16640); int base = 0;
            for (int e = 0; e < NEXP; ++e) {
                conv64_run(Conv64{args.in[I_MWG] + (size_t)e * D * EXD, args.in[I_MWU] + (size_t)e * D * EXD, EXD, 1024, N_GU1, wsp<bf16_t>(F, O_WGU1) + (size_t)e * N_GU1 * 1024 / 2, 3, 0, 0, 64.0f, 1}, scr, lane, gw, NGW, base);
                conv64_run(Conv64{args.in[I_MWD] + (size_t)e * EXD * D, nullptr, 1024, EXD, 1024, wsp<bf16_t>(F, O_WD1) + (size_t)e * 1024 * EXD / 2, 0, 1024, 1024, 64.0f, 1}, scr, lane, gw, NGW, base);
            }
        }
        }
    }
    SEAM(13);

    if (IN(14)) {
        const bf16_t* OFp = wsp<bf16_t>(F, O_OF); const bf16_t* OBp = wsp<bf16_t>(F, O_OB); const bf16_t* G1 = wsp<bf16_t>(F, O_G1); bf16_t* GA = wsp<bf16_t>(F, O_GA);
        const float* on = args.in[I_GONORM];
        for (int row = gw; row < RL; row += NGW) {
            const u32x4* pf = (const u32x4*)(OFp + (size_t)row * D + lane * 16); const u32x4* pb = (const u32x4*)(OBp + (size_t)row * D + lane * 16); const u32x4* pg = (const u32x4*)(G1 + (size_t)row * D + lane * 16);
            float v[16], gv[16];
#pragma unroll
            for (int q = 0; q < 2; ++q) { const u32x4 a = pf[q], bq = pb[q], gq = pg[q]; const unsigned aw[4] = {a.x, a.y, a.z, a.w}, bw[4] = {bq.x, bq.y, bq.z, bq.w}, gw4[4] = {gq.x, gq.y, gq.z, gq.w};
#pragma unroll
                for (int j = 0; j < 4; ++j) { v[8 * q + 2 * j] = bflo(aw[j]) + bflo(bw[j]); v[8 * q + 2 * j + 1] = bfhi(aw[j]) + bfhi(bw[j]); gv[8 * q + 2 * j] = bflo(gw4[j]); gv[8 * q + 2 * j + 1] = bfhi(gw4[j]); } }
            float ss = 0.f;
#pragma unroll
            for (int j = 0; j < 16; ++j) ss += v[j] * v[j];
            ss += __shfl_xor(ss, 1); ss += __shfl_xor(ss, 2); ss += __shfl_xor(ss, 4); ss += __shfl_xor(ss, 8);
            const float rstd = __builtin_amdgcn_rsqf(ss * (1.0f / 256.0f) + EPS);
            const int c0 = (lane & 15) * 16;
            unsigned ow[8];
#pragma unroll
            for (int j = 0; j < 8; ++j) { const float a = v[2 * j] * rstd * on[c0 + 2 * j] * silu_f(gv[2 * j]), bq = v[2 * j + 1] * rstd * on[c0 + 2 * j + 1] * silu_f(gv[2 * j + 1]); ow[j] = cvtpk(a, bq); }
            u32x4* po = (u32x4*)(GA + (size_t)row * D + lane * 16);
            u32x4 o0; o0.x = ow[0]; o0.y = ow[1]; o0.z = ow[2]; o0.w = ow[3]; po[0] = o0; u32x4 o1; o1.x = ow[4]; o1.y = ow[5]; o1.z = ow[6]; o1.w = ow[7]; po[1] = o1;
        }
    }
    SEAM(14);

    if (IN(15)) {
        pg8::DenseProb P{wsp<bf16_t>(F, O_GA), wsp<bf16_t>(F, O_WOUT1), 1024, 1024, 1024, {}}; P.ord.init(RL / 256, 4, F.G, (int)blockIdx.x);
        pg8::EpiF32 E{Y, D};
        pg8::gemm_phase(F.lds, P, E);
    }
    SEAM(15);

    if (IN(16)) {
        int* SEL = wsp<int>(F, O_SEL); int* ROWTOK = wsp<int>(F, O_ROWTOK);
        LAS float* wr_l = (LAS float*)F.lds;
        LAS int* se = (LAS int*)(F.lds + 32768);
        LAS float* sw = (LAS float*)(F.lds + 32768 + 512);
        LAS int* sbase = (LAS int*)(F.lds + 32768 + 1024);
        for (int i = tid; i < 8192; i += 512) wr_l[i] = args.in[I_MROUTER][i];
        __syncthreads();
        for (int tile = F.vcu; tile < RL / 64; tile += F.G) {
            for (int rr = 0; rr < 8; ++rr) {
                const int lr = wave * 8 + rr, row = tile * 64 + lr; const int b = row >> 12;
                float* hp = args.out + (size_t)row * D;
                f32x4 y[4], h[4], uo[4]; load_row(Y + (size_t)row * D, lane, y); load_row(hp, lane, h);
                const float rstd = __builtin_amdgcn_rsqf(row_ssq(y) * (1.0f / D) + EPS);
#pragma unroll
                for (int j = 0; j < 4; ++j) { const int c = 4 * lane + 256 * j; const f32x4 g = *(const f32x4*)(normg + 5 * D + c), mg = *(const f32x4*)(MV(1, b, 2) + c);
                    h[j] = h[j] + mg * (y[j] * rstd * g); *(f32x4*)(hp + c) = h[j]; }
                norm_mod_store(h, normg + 6 * D, MV(1, b, 3), MV(1, b, 4), nullptr, lane, uo, wsp<unsigned char>(F, O_U) + (size_t)row * D);
                float lg[8];
#pragma unroll
                for (int e = 0; e < 8; ++e) lg[e] = 0.f;
#pragma unroll
                for (int j = 0; j < 4; ++j)
#pragma unroll
                    for (int q = 0; q < 4; ++q) { const int k = 4 * lane + 256 * j + q; const LAS f32x4* wp = (const LAS f32x4*)(wr_l + k * 8); const f32x4 w0 = wp[0], w1 = wp[1]; const float uv = uo[j][q];
                        lg[0] += uv * w0[0]; lg[1] += uv * w0[1]; lg[2] += uv * w0[2]; lg[3] += uv * w0[3]; lg[4] += uv * w1[0]; lg[5] += uv * w1[1]; lg[6] += uv * w1[2]; lg[7] += uv * w1[3]; }
#pragma unroll
                for (int e = 0; e < 8; ++e) lg[e] = wave_sum(lg[e]) + args.in[I_MBROUTER][e];
                int e0 = 0; float l0 = lg[0];
#pragma unroll
                for (int e = 1; e < 8; ++e) if (lg[e] > l0) { l0 = lg[e]; e0 = e; }
                int e1 = -1; float l1 = -3.0e38f;
#pragma unroll
                for (int e = 0; e < 8; ++e) if (e != e0 && lg[e] > l1) { l1 = lg[e]; e1 = e; }
                const float p1 = __expf(l1 - l0), w0n = 1.0f / (1.0f + p1), w1n = p1 / (1.0f + p1);
                if (lane == 0) { se[lr * 2] = e0; se[lr * 2 + 1] = e1; sw[lr * 2] = w0n; sw[lr * 2 + 1] = w1n; }
            }
            __syncthreads();
            if (tid < 8) { int c = 0; for (int r2 = 0; r2 < 64; ++r2) c += (se[2 * r2] == tid) + (se[2 * r2 + 1] == tid);
                sbase[tid] = (int)__hip_atomic_fetch_add(ctl + CW_CNT + 64 * tid, (unsigned)c, RLX_AGENT); }
            __syncthreads();
            if (tid < 64) { const int e0 = se[2 * tid], e1 = se[2 * tid + 1]; int r0 = 0, r1 = 0;
                for (int r2 = 0; r2 < tid; ++r2) { const int a0 = se[2 * r2], a1 = se[2 * r2 + 1]; r0 += (a0 == e0) + (a1 == e0); r1 += (a0 == e1) + (a1 == e1); }
                const int p0 = sbase[e0] + r0, p1 = sbase[e1] + r1, tok = tile * 64 + tid;
                ROWTOK[e0 * CAPE + p0] = tok; ROWTOK[e1 * CAPE + p1] = tok;
                int* sp = SEL + (size_t)tok * 8; sp[0] = e0; sp[1] = p0; sp[2] = e1; sp[3] = p1; sp[4] = __float_as_int(sw[2 * tid]); sp[5] = __float_as_int(sw[2 * tid + 1]); }
            __syncthreads();
        }
    }
    SEAM(16);

    pg8::MoeTiles MT;
    if (IN(17) || IN(18) || IN(19)) {
        int acc = 0; MT.tp8 = 0ull; MT.c4a = 0ull; MT.c4b = 0ull;
#pragma unroll
        for (int e = 0; e < 8; ++e) { const int c = (int)__builtin_amdgcn_readfirstlane((int)__hip_atomic_load(ctl + CW_CNT + 64 * e, RLX_AGENT));
            if (e < 4) MT.c4a |= (unsigned long long)(unsigned)c << (16 * e); else MT.c4b |= (unsigned long long)(unsigned)c << (16 * (e - 4));
            MT.tp8 |= (unsigned long long)(unsigned)acc << (8 * e); acc += (c + 255) >> 8; }
        MT.nt = acc;
    }
    if (IN(17)) {
        pg8::MoeGuProb P{wsp<unsigned char>(F, O_U), wsp<unsigned char>(F, O_WGU1), 512, 512, {}, MT, wsp<int>(F, O_ROWTOK)}; P.ord.init(MT.nt, N_GU1 / 256, F.G, (int)blockIdx.x);
        pg8::EpiSwiglu8 E{wsp<unsigned char>(F, O_HM), EXD};
        pg8::gemm_phase(F.lds, P, E);
    }
    SEAM(17);
    if (IN(18)) {
        pg8::MoeDnProb P{wsp<unsigned char>(F, O_HM), wsp<unsigned char>(F, O_WD1), EXD / 2, EXD / 2, {}, MT}; P.ord.init(MT.nt, 4, F.G, (int)blockIdx.x);
        pg8::EpiBf16 E{wsp<bf16_t>(F, O_YE), D, nullptr};
        pg8::gemm_phase(F.lds, P, E);
    }
    SEAM(18);
    if (IN(19)) {
        const int* SEL = wsp<int>(F, O_SEL); const bf16_t* YE = wsp<bf16_t>(F, O_YE);
        for (int row = gw; row < RL; row += NGW) {
            const int b = row >> 12; const int* sp = SEL + (size_t)row * 8;
            const int e0 = sp[0], p0 = sp[1], e1 = sp[2], p1 = sp[3]; const float w0 = __int_as_float(sp[4]), w1 = __int_as_float(sp[5]);
            const int t0 = pg8::moe_tp(MT, e0), t1 = pg8::moe_tp(MT, e1);
            const bf16_t* y0 = YE + ((size_t)t0 * 256 + p0) * D; const bf16_t* y1 = YE + ((size_t)t1 * 256 + p1) * D;
            float* hp = args.out + (size_t)row * D;
            f32x4 y[4], h[4]; load_row(hp, lane, h);
#pragma unroll
            for (int j = 0; j < 4; ++j) { const int c = 4 * lane + 256 * j; const u32x2 a = *(const u32x2*)(y0 + c), bq = *(const u32x2*)(y1 + c);
                y[j][0] = w0 * bflo(a.x) + w1 * bflo(bq.x); y[j][1] = w0 * bfhi(a.x) + w1 * bfhi(bq.x); y[j][2] = w0 * bflo(a.y) + w1 * bflo(bq.y); y[j][3] = w0 * bfhi(a.y) + w1 * bfhi(bq.y); }
            const float rstd = __builtin_amdgcn_rsqf(row_ssq(y) * (1.0f / D) + EPS);
#pragma unroll
            for (int j = 0; j < 4; ++j) { const int c = 4 * lane + 256 * j; const f32x4 g = *(const f32x4*)(normg + 7 * D + c), mg = *(const f32x4*)(MV(1, b, 5) + c);
                *(f32x4*)(hp + c) = h[j] + mg * (y[j] * rstd * g); }
        }
    }
#undef IN
#undef SEAM
#undef MV
}

constexpr int N_PHASES = 20;
extern "C" void kernel_launch(void* const* d_in, const int* in_sizes, int n_in, void* d_out, int out_size, void* d_ws, size_t ws_size, hipStream_t stream) {
    static int grid = 0;
    if (grid == 0) {
        if (n_in != 27 || out_size != RL * D || ws_size < WS_END) { fprintf(stderr, "kernel_launch: unexpected shapes n_in %d out %d ws %zu (need %zu)\n", n_in, out_size, ws_size, (size_t)WS_END); grid = -1; return; }
        int dev = 0, cus = 0, per_cu = 0;
        if (hipGetDevice(&dev) != hipSuccess || hipDeviceGetAttribute(&cus, hipDeviceAttributeMultiprocessorCount, dev) != hipSuccess) { grid = -1; return; }
        if (hipFuncSetAttribute((const void*)mk_fwd, hipFuncAttributeMaxDynamicSharedMemorySize, LDS_BYTES) != hipSuccess) { fprintf(stderr, "kernel_launch: hipFuncSetAttribute failed\n"); grid = -1; return; }
        if (hipOccupancyMaxActiveBlocksPerMultiprocessor(&per_cu, (const void*)mk_fwd, 512, LDS_BYTES) != hipSuccess || per_cu < 1) { fprintf(stderr, "kernel_launch: occupancy query says %d\n", per_cu); }
        (void)hipGetLastError();
        grid = cus;
        if (grid > 256) grid = 256;
    }
    if (grid < 0) return;
    (void)hipMemsetAsync((char*)d_ws + O_CTL, 0, CTL_BYTES, stream);
    Args a{};
    for (int i = 0; i < 27; ++i) a.in[i] = (const float*)d_in[i];
    a.out = (float*)d_out; a.ws = (unsigned char*)d_ws;
#if MK_ONE_LAUNCH
    a.ph_lo = 0; a.ph_hi = N_PHASES;
    hipLaunchKernelGGL(mk_fwd, dim3(grid), dim3(512), LDS_BYTES, stream, a);
#else
    for (int p = 0; p < N_PHASES; ++p) { a.ph_lo = p; a.ph_hi = p + 1; for (int rep = 0; rep < (p == MK_REP ? 2 : 1); ++rep) hipLaunchKernelGGL(mk_fwd, dim3(grid), dim3(512), LDS_BYTES, stream, a); }
#endif
}
```

```cpp
#include <hip/hip_runtime.h>
#include <cstdio>
#include <cstdint>

#ifndef MK_ONE_LAUNCH
#define MK_ONE_LAUNCH 1
#endif
#ifndef MK_EPI2
#define MK_EPI2 0
#endif
#ifndef MK_REP
#define MK_REP -1
#endif

#define LAS __attribute__((address_space(3)))
#define GAS __attribute__((address_space(1)))
typedef unsigned short bf16_t;
typedef short bf16x8 __attribute__((ext_vector_type(8)));
typedef short s16x4 __attribute__((ext_vector_type(4)));
typedef float f32x4 __attribute__((ext_vector_type(4)));
typedef float f32x16 __attribute__((ext_vector_type(16)));
typedef unsigned u32x4 __attribute__((ext_vector_type(4)));
typedef unsigned u32x2 __attribute__((ext_vector_type(2)));
typedef float f32x2_t __attribute__((ext_vector_type(2)));
typedef __bf16 bf16x2_t __attribute__((ext_vector_type(2)));
#define RLX_AGENT __ATOMIC_RELAXED, __HIP_MEMORY_SCOPE_AGENT

__device__ __forceinline__ unsigned cvtpk(float lo, float hi) { f32x2_t v = {lo, hi}; bf16x2_t b = __builtin_convertvector(v, bf16x2_t); return __builtin_bit_cast(unsigned, b); }
__device__ __forceinline__ bf16_t f2bf(float f) { return (bf16_t)(cvtpk(f, 0.f) & 0xffffu); }
__device__ __forceinline__ float bflo(unsigned w) { return __uint_as_float(w << 16); }
__device__ __forceinline__ float bfhi(unsigned w) { return __uint_as_float(w & 0xffff0000u); }
__device__ __forceinline__ float bf2f(bf16_t b) { return __uint_as_float(((unsigned)b) << 16); }
__device__ __forceinline__ float wave_sum(float v) {
#pragma unroll
    for (int o = 1; o < 64; o <<= 1) v += __shfl_xor(v, o);
    return v;
}
__device__ __forceinline__ float fast_exp(float x) { return __builtin_amdgcn_exp2f(x * 1.4426950408889634f); }
__device__ __forceinline__ float clamp8(float x) { return __builtin_amdgcn_fmed3f(x, -448.0f, 448.0f); }
__device__ __forceinline__ unsigned pack_fp8x4(float a, float b, float c, float d) { int w = __builtin_amdgcn_cvt_pk_fp8_f32(clamp8(a), clamp8(b), 0, false); w = __builtin_amdgcn_cvt_pk_fp8_f32(clamp8(c), clamp8(d), w, true); return (unsigned)w; }
__device__ __forceinline__ float silu_f(float g) { return g * __builtin_amdgcn_rcpf(1.0f + fast_exp(-g)); }

#define XB_TMO      128
#define XB_XCNT(j)  (256  + 64 * (j))
#define XB_XSUB(j)  (1280 + 64 * (j))
#define XB_XGEN(j)  (2304 + 64 * (j))
#define XB_TOP      3328
#define XB_TOPGEN   3392
#define XCD_BAR_WORDS 3456
#define XB_SPIN_CAP (1u << 18)
__device__ __forceinline__ unsigned xb_ld(unsigned* p)              { return __hip_atomic_load(p, __ATOMIC_RELAXED, __HIP_MEMORY_SCOPE_AGENT); }
__device__ __forceinline__ unsigned xb_add(unsigned* p, unsigned v) { return __hip_atomic_fetch_add(p, v, __ATOMIC_RELAXED, __HIP_MEMORY_SCOPE_AGENT); }
__device__ __forceinline__ unsigned xb_xcc_id() { return (unsigned)__builtin_amdgcn_s_getreg((3 << 11) | 20) & 0xFu; }
#define XB_SPIN(cond, bar) do { unsigned _sp = 0; while (cond) { __builtin_amdgcn_s_sleep(1); \
    if ((++_sp & 255u) == 0u) { if (xb_ld(&(bar)[XB_TMO])) break; if (_sp > XB_SPIN_CAP) { atomicAdd(&(bar)[XB_TMO], 1u); break; } } } } while (0)
struct XcdBarrier { unsigned* bar; unsigned x; volatile LAS unsigned* st; };
__device__ __forceinline__ XcdBarrier xcd_barrier_post(unsigned* bar, volatile LAS unsigned* st) {
    XcdBarrier b; b.bar = bar; b.x = xb_xcc_id(); b.st = st;
    if (threadIdx.x == 0) (void)xb_add(&bar[XB_XCNT(b.x)], 1u);
    return b;
}
__device__ __forceinline__ void xcd_barrier_complete(unsigned* bar, unsigned x, unsigned& nloc, unsigned& nx) {
    const unsigned G = gridDim.x * gridDim.y * gridDim.z;
    unsigned sum, cnt, mine, sp = 0u;
    for (;;) {
        sum = 0u; cnt = 0u; mine = 0u;
#pragma unroll
        for (unsigned j = 0; j < 16; ++j) { const unsigned c = xb_ld(&bar[XB_XCNT(j)]); sum += c; cnt += (c > 0u) ? 1u : 0u; mine = (j == x) ? c : mine; }
        if (sum == G) break;
        __builtin_amdgcn_s_sleep(1);
        if ((++sp & 255u) == 0u) { if (xb_ld(&bar[XB_TMO])) break; if (sp > XB_SPIN_CAP) { atomicAdd(&bar[XB_TMO], 1u); break; } }
    }
    nloc = mine > 0u ? mine : 1u; nx = cnt > 0u ? cnt : 1u;
}
__device__ __forceinline__ void xcd_barrier(const XcdBarrier& b) {
    asm volatile("s_waitcnt vmcnt(0)" ::: "memory");
    __syncthreads();
    if (threadIdx.x == 0) {
        unsigned* bar = b.bar;
        __builtin_amdgcn_s_waitcnt(0);
        unsigned nloc = b.st[0], nx = b.st[1];
        if (nloc == 0u) { xcd_barrier_complete(bar, b.x, nloc, nx); b.st[0] = nloc; b.st[1] = nx; }
        const unsigned old = xb_add(&bar[XB_XSUB(b.x)], 1u);
        const unsigned gen = old / nloc;
        if (old + 1u == (gen + 1u) * nloc) {
            __builtin_amdgcn_fence(__ATOMIC_RELEASE, "agent");
            asm volatile("s_waitcnt vmcnt(0)" ::: "memory");
            const unsigned og = xb_add(&bar[XB_TOP], 1u);
            const unsigned tg = og / nx;
            if (og + 1u == (tg + 1u) * nx) xb_add(&bar[XB_TOPGEN], 1u);
            else XB_SPIN(xb_ld(&bar[XB_TOPGEN]) == tg, bar);
            __builtin_amdgcn_fence(__ATOMIC_ACQUIRE, "agent");
            xb_add(&bar[XB_XGEN(b.x)], 1u);
            asm volatile("s_waitcnt vmcnt(0)" ::: "memory");
        } else {
            XB_SPIN(xb_ld(&bar[XB_XGEN(b.x)]) == gen, bar);
            __builtin_amdgcn_fence(__ATOMIC_ACQUIRE, "agent");
            asm volatile("s_waitcnt vmcnt(0)" ::: "memory");
        }
    }
    __syncthreads();
}

constexpr int D = 1024, NB = 4, SEQ = 4096, CTX = 256;
constexpr int RL = NB * SEQ;
constexpr int RC = NB * CTX;
constexpr int R = RL + RC;
constexpr float EPS = 1e-6f;
constexpr float LOG2E = 1.4426950408889634f;
constexpr int N_IN0 = 1536, N_QA = 768, N_KVA = 1024, FFN = 2816, N_GU0 = 2 * FFN, N_IN1 = 3328, EXD = 3584, N_GU1 = 2 * EXD, NEXP = 8;
constexpr int CAPE = 16384;

constexpr size_t MiB = 1u << 20;
constexpr size_t O_CTL = 0;
constexpr size_t CTL_BYTES = 65536;
constexpr int CW_BAR = 0;
constexpr int CW_CNT = 8192;
constexpr size_t O_MODV = 1 * MiB;
constexpr size_t O_TAB16 = O_MODV + 256 * 1024;
constexpr size_t O_TAB32 = O_TAB16 + 8192;
constexpr size_t O_RSTDQ = O_TAB32 + 16384;
constexpr size_t O_RSTDKV = O_RSTDQ + 81920;
constexpr size_t O_SEL = 2 * MiB;
constexpr size_t O_ROWTOK = 3 * MiB;
constexpr size_t O_WGU1 = 4 * MiB;
constexpr size_t O_YE = O_WGU1;
constexpr size_t O_WD1 = 116 * MiB;
constexpr size_t O_WIN1 = 172 * MiB;
constexpr size_t O_WOUT1 = 179 * MiB;
constexpr size_t O_WIN0 = 181 * MiB;
constexpr size_t O_WUQ = 184 * MiB;
constexpr size_t O_WUKV = 185 * MiB;
constexpr size_t O_WOUT0 = 186 * MiB;
constexpr size_t O_WGU0 = 188 * MiB;
constexpr size_t O_WD0 = 199 * MiB;
constexpr size_t O_HC = 205 * MiB;
constexpr size_t O_U = 209 * MiB;
constexpr size_t O_Y = 243 * MiB;
constexpr size_t O_Z0 = 311 * MiB;
constexpr size_t O_QA = 362 * MiB;
constexpr size_t O_KVA = 388 * MiB;
constexpr size_t O_QB = 422 * MiB;
constexpr size_t O_KB = 439 * MiB;
constexpr size_t O_KR = 444 * MiB;
constexpr size_t O_AO = 446 * MiB;
constexpr size_t O_H0 = 311 * MiB;
constexpr size_t O_QK1 = 311 * MiB;
constexpr size_t O_V1 = 345 * MiB;
constexpr size_t O_G1 = 379 * MiB;
constexpr size_t O_RR = 413 * MiB;
constexpr size_t O_QDF = 422 * MiB, O_KIF = 439 * MiB, O_KTF = 456 * MiB, O_QDB = 473 * MiB;
constexpr size_t O_KIB = 243 * MiB, O_KTB = 260 * MiB, O_VT = 277 * MiB;
constexpr size_t O_ECL = 490 * MiB;
constexpr size_t O_OF = O_QK1, O_OB = O_V1;
constexpr size_t O_GA = O_QDF;
constexpr size_t O_HM = 243 * MiB;
constexpr size_t WS_END = 495 * MiB;
static_assert(O_HM + (size_t)34816 * EXD * 2 <= 482 * MiB, "HM");
static_assert(O_RR + (size_t)R * 256 * 2 <= O_QDF, "RR");
static_assert(O_ECL + (size_t)544 * 8 * 1024 <= WS_END, "ECL");

constexpr int RING_BYTES = 131072;
constexpr int LDS_BYTES = 163840;
constexpr int LDSCTL_OFF = LDS_BYTES - 256;

struct Args {
    const float* in[27];
    float* out; unsigned char* ws;
    int ph_lo, ph_hi;
};
enum { I_X = 0, I_C, I_CTX, I_CCTX, I_MODW, I_MODB, I_NORMG, I_AWIN, I_AQN, I_AWUQ, I_AKVN, I_AWUKV, I_AQKN, I_AWOUT, I_GWIN, I_GGATE2, I_GBGATE, I_GONORM, I_GWOUT,
       I_FWG, I_FWU, I_FWD, I_MROUTER, I_MBROUTER, I_MWG, I_MWU, I_MWD };

struct Conv { const float* s0; const float* s1; int Nsrc; int K; int Ndst; bf16_t* dst; int mode; const float* kscale; };
__device__ __forceinline__ int ilv64(int p) { return (p >> 5) * 32 + (p & 1) * 16 + ((p & 31) >> 1); }
__device__ __forceinline__ int ilv32(int p) { return (p >> 4) * 16 + (p & 1) * 8 + ((p & 15) >> 1); }
__device__ __forceinline__ const float* conv_col(const Conv& c, int n, float& sc) {
    sc = 1.0f;
    switch (c.mode) {
    case 0: return c.s0 + n;
    case 1: {
        if (n < 640) return c.s0 + n;
        if (n < 1152) { const int hh = (n - 640) >> 6, p = (n - 640) & 63; return c.s0 + 672 + hh * 64 + ilv64(p); }
        if (n < 1280) { const int hh = (n - 1152) >> 6, p = (n - 1152) & 63; return c.s0 + 1184 + hh * 64 + ilv64(p); }
        if (n < 1408) return c.s0 + 1312 + (n - 1280);
        if (n < 1440) return c.s0 + 640 + ilv32(n - 1408);
        return nullptr; }
    case 2: {
        if (n < 512) return c.s0 + (n >> 6) * 96 + (n & 63);
        const int hh = (n - 512) >> 5, p = (n - 512) & 31; return c.s0 + hh * 96 + 64 + ilv32(p); }
    case 3: {
        const int G = n >> 5, j = n & 31; return (j < 16) ? c.s0 + 16 * G + j : c.s1 + 16 * G + (j - 16); }
    case 4: {
        if (n >= 3104) return nullptr;
        if (n < 512) sc = 0.08838834764831845f;
        return c.s0 + n; }
    }
    return nullptr;
}
__device__ __forceinline__ void conv_item(const Conv& c, int item, LAS float* scr, int lane) {
    const int nblk = c.Ndst / 32, kb = item / nblk, nb = item % nblk, k0 = 64 * kb, n0 = 32 * nb;
    float sc; const float* cp = conv_col(c, n0 + (lane & 31), sc);
    const int kh = lane >> 5;
#pragma unroll 16
    for (int i = 0; i < 32; ++i) { const int kk = 2 * i + kh; float v = 0.f;
        if (cp) { v = cp[(size_t)(k0 + kk) * c.Nsrc] * sc; if (c.kscale) v *= c.kscale[k0 + kk]; }
        scr[kk * 33 + (lane & 31)] = v; }
    asm volatile("s_waitcnt lgkmcnt(0)" ::: "memory");
    const int ch = lane & 7;
#pragma unroll
    for (int j = 0; j < 4; ++j) { const int n = (lane >> 3) + 8 * j; const LAS float* s = scr + (8 * ch) * 33 + n;
        u32x4 o; o.x = cvtpk(s[0 * 33], s[1 * 33]); o.y = cvtpk(s[2 * 33], s[3 * 33]); o.z = cvtpk(s[4 * 33], s[5 * 33]); o.w = cvtpk(s[6 * 33], s[7 * 33]);
        *(u32x4*)(c.dst + (size_t)(n0 + n) * c.K + k0 + 8 * ch) = o; }
    asm volatile("s_waitcnt lgkmcnt(0)" ::: "memory");
}

struct Conv64 { const float* s0; const float* s1; int Nsrc; int K; int Ndst; bf16_t* dst; int mode; int nvalid; int nscaled; float rscale; int f8; };
struct Conv64Geo { int k0, n0, nd; bool valid; float sc; const float* src; };
__device__ __forceinline__ Conv64Geo conv64_geo(const Conv64& c, int item, int lane) {
    Conv64Geo g; const int nblk = c.Ndst / 64, kb = item / nblk, nb = item % nblk; g.k0 = 64 * kb; g.n0 = 64 * nb;
    const int c4 = lane & 15, kr = lane >> 4; g.valid = true; g.sc = 1.0f;
    if (c.mode == 3) { const int cc = 4 * (c4 & 7); g.src = c.s0 + ((c4 < 8) ? (long)0 : (long)(c.s1 - c.s0)) + 32 * nb + cc; g.nd = 32 * (cc >> 4) + ((c4 < 8) ? 0 : 16) + (cc & 15); if (c.f8) g.sc = c.rscale; }
    else { g.nd = 4 * c4; g.src = c.s0 + g.n0 + g.nd; g.valid = (g.n0 + g.nd) < c.nvalid; if (g.n0 + g.nd < c.nscaled) g.sc = c.rscale; }
    g.src += (size_t)(g.k0 + kr) * c.Nsrc;
    return g;
}
__device__ __forceinline__ void conv64_load(const Conv64& c, int item, int lane, f32x4 (&v)[16]) {
    const Conv64Geo g = conv64_geo(c, item, lane);
#pragma unroll
    for (int i = 0; i < 16; ++i) v[i] = g.valid ? *(const f32x4*)(g.src + (size_t)(4 * i) * c.Nsrc) : (f32x4){0.f, 0.f, 0.f, 0.f};
}
__device__ __forceinline__ void conv64_store(const Conv64& c, int item, LAS float* scr, int lane, const f32x4 (&v)[16]) {
    const Conv64Geo g = conv64_geo(c, item, lane); const int kr = lane >> 4, nd = g.nd, k0 = g.k0, n0 = g.n0; const float sc = g.sc;
#pragma unroll
    for (int i = 0; i < 16; ++i) { LAS float* p = scr + (4 * i + kr) * 65 + nd; p[0] = v[i][0] * sc; p[1] = v[i][1] * sc; p[2] = v[i][2] * sc; p[3] = v[i][3] * sc; }
    asm volatile("s_waitcnt lgkmcnt(0)" ::: "memory");
    if (c.f8) {
        const int ch = lane & 3; unsigned char* d8 = (unsigned char*)c.dst;
#pragma unroll
        for (int it = 0; it < 4; ++it) { const int r = it * 16 + (lane >> 2); const LAS float* sp = scr + (16 * ch) * 65 + r; u32x4 o;
            o.x = pack_fp8x4(sp[0 * 65], sp[1 * 65], sp[2 * 65], sp[3 * 65]); o.y = pack_fp8x4(sp[4 * 65], sp[5 * 65], sp[6 * 65], sp[7 * 65]);
            o.z = pack_fp8x4(sp[8 * 65], sp[9 * 65], sp[10 * 65], sp[11 * 65]); o.w = pack_fp8x4(sp[12 * 65], sp[13 * 65], sp[14 * 65], sp[15 * 65]);
            *(u32x4*)(d8 + (size_t)(n0 + r) * c.K + k0 + 16 * ch) = o; }
    } else {
    const int ch = lane & 7;
#pragma unroll
    for (int it = 0; it < 8; ++it) { const int r = it * 8 + (lane >> 3); const LAS float* sp = scr + (8 * ch) * 65 + r;
        u32x4 o; o.x = cvtpk(sp[0 * 65], sp[1 * 65]); o.y = cvtpk(sp[2 * 65], sp[3 * 65]); o.z = cvtpk(sp[4 * 65], sp[5 * 65]); o.w = cvtpk(sp[6 * 65], sp[7 * 65]);
        *(u32x4*)(c.dst + (size_t)(n0 + r) * c.K + k0 + 8 * ch) = o; }
    }
    asm volatile("s_waitcnt lgkmcnt(0)" ::: "memory");
}

__device__ __forceinline__ void conv64_run(const Conv64& c, LAS float* scr, int lane, int gwi, int ngw, int& base) {
    const int n = (c.K / 64) * (c.Ndst / 64); int it = gwi - base; if (it < 0) it += ngw;
    if (it < n) { f32x4 va[16], vb[16]; conv64_load(c, it, lane, va);
        for (;;) { const int i2 = it + ngw; if (i2 < n) conv64_load(c, i2, lane, vb); conv64_store(c, it, scr, lane, va); if (i2 >= n) break;
                   const int i3 = i2 + ngw; if (i3 < n) conv64_load(c, i3, lane, va); conv64_store(c, i2, scr, lane, vb); if (i3 >= n) break; it = i3; } }
    base = (base + n) % ngw;
}

namespace pg8 {
constexpr int BM = 256, BK = 64, HALF = 128, HTB = HALF * BK * 2, STAGE_BYTES = 8 * HTB;
constexpr int NXCD = 8, WGM = 8;
__device__ __forceinline__ int lds_byte(int r, int c) { const int st = (r >> 4) * 2 + (c >> 5), rr = r & 15, cc = c & 31, ob = rr * 64 + cc * 2; return st * 1024 + (ob ^ (((ob >> 9) & 1) << 5)); }
__device__ __forceinline__ void stage_rc(int b, int& Rr, int& C) { const int st = b / 1024, sb = b % 1024, swz = sb ^ (((sb >> 9) & 1) << 5); Rr = (st >> 1) * 16 + swz / 64; C = (st & 1) * 32 + (swz % 64) / 2; }
__device__ __forceinline__ int perm32(int rho) { const int n = rho >> 4, i = rho & 15; return 8 * (i >> 2) + 4 * n + (i & 3); }
struct Unit { int pm, pn; };
typedef int v8i_t __attribute__((ext_vector_type(8)));
typedef int v4i_t __attribute__((ext_vector_type(4)));
__device__ __forceinline__ v8i_t cat8(bf16x8 a, bf16x8 b) { const v4i_t x = __builtin_bit_cast(v4i_t, a), y = __builtin_bit_cast(v4i_t, b); return __builtin_shufflevector(x, y, 0, 1, 2, 3, 4, 5, 6, 7); }
struct Order {
    int nM, nN, nwg, G, c;
    __device__ __forceinline__ void init(int nM_, int nN_, int G_, int c_) { nM = nM_; nN = nN_; nwg = nM * nN; G = G_; c = c_; }
    __device__ __forceinline__ bool next(int i, Unit& u) const {
        const long L = (long)i * G + c; if (L >= nwg) return false;
        int wgid = (int)L; { const int q = nwg / NXCD, r = nwg % NXCD, xcd = wgid % NXCD, off = wgid / NXCD; wgid = (xcd < r ? xcd * (q + 1) : r * (q + 1) + (xcd - r) * q) + off; }
        const int nig = WGM * nN, gid = wgid / nig, fm = gid * WGM, gsz = (nM - fm) < WGM ? (nM - fm) : WGM;
        u.pm = fm + ((wgid % nig) % gsz); u.pn = (wgid % nig) / gsz; return true;
    }
};

template <class Prob, class Epi>
__device__ __forceinline__ void gemm_phase(LAS unsigned char* lds, const Prob& P, const Epi& E) {
    const int tid = threadIdx.x, wid = __builtin_amdgcn_readfirstlane(tid >> 6), lane = tid & 63, wr = wid >> 2, wc = wid & 3, fr = lane & 15, fq = lane >> 4;
    const int K = P.K, nt = K / BK, ldb = P.ldb;
    int RA[2], CA[2]; unsigned voffB[2];
#pragma unroll
    for (int i = 0; i < 2; ++i) { int Rr, C; stage_rc(tid * 16 + i * 8192, Rr, C); const int Rb = Epi::PERM ? ((Rr & ~31) + perm32(Rr & 31)) : Rr;
        RA[i] = Rr; CA[i] = C; voffB[i] = (unsigned)(Rb * ldb + C) * 2u; }
    const size_t hstepB = (size_t)HALF * ldb * 2;
    const unsigned ldsw = (unsigned)wid * 1024u;
    const int aoff = lds_byte(wr * 64 + fr, fq * 8), boff = lds_byte(wc * 32 + fr, fq * 8);
    const char* Abase = (const char*)P.Abase;
    const int scl_a = P.sa * 0x01010101, scl_b = P.sb * 0x01010101;
#define PG8_SA(b, h) (((b) * 2 + (h)) * HTB)
#define PG8_SB(b, h) ((4 + (b) * 2 + (h)) * HTB)
#define PG8_STAGEB(bufoff, gbase) do { _Pragma("unroll") for (int _i = 0; _i < 2; ++_i) \
        __builtin_amdgcn_global_load_lds((const unsigned*)((const char*)(gbase) + voffB[_i]), (LAS unsigned*)(lds + (bufoff) + ldsw + _i * 8192), 16, 0, 0); } while (0)
#define PG8_STAGEA(bufoff, vo, h, kb) do { _Pragma("unroll") for (int _i = 0; _i < 2; ++_i) \
        __builtin_amdgcn_global_load_lds((const unsigned*)(Abase + (size_t)(kb) + (vo)[h][_i]), (LAS unsigned*)(lds + (bufoff) + ldsw + _i * 8192), 16, 0, 0); } while (0)
#define PG8_LDA(dst, b, h) do { _Pragma("unroll") for (int m = 0; m < 4; ++m) { if constexpr (Prob::FP8) dst##8[m] = cat8(*(const LAS bf16x8*)(lds + PG8_SA(b, h) + aoff + m * 2048), *(const LAS bf16x8*)(lds + PG8_SA(b, h) + aoff + m * 2048 + 1024)); \
        else { _Pragma("unroll") for (int k = 0; k < 2; ++k) dst[m][k] = *(const LAS bf16x8*)(lds + PG8_SA(b, h) + aoff + m * 2048 + k * 1024); } } } while (0)
#define PG8_LDB(dst, b, h) do { _Pragma("unroll") for (int n = 0; n < 2; ++n) { if constexpr (Prob::FP8) dst##8[n] = cat8(*(const LAS bf16x8*)(lds + PG8_SB(b, h) + boff + n * 2048), *(const LAS bf16x8*)(lds + PG8_SB(b, h) + boff + n * 2048 + 1024)); \
        else { _Pragma("unroll") for (int k = 0; k < 2; ++k) dst[n][k] = *(const LAS bf16x8*)(lds + PG8_SB(b, h) + boff + n * 2048 + k * 1024); } } } while (0)
#define PG8_MMA(ai, bj, At, Bt) do { __builtin_amdgcn_s_setprio(1); _Pragma("unroll") for (int m = 0; m < 4; ++m) _Pragma("unroll") for (int n = 0; n < 2; ++n) { \
        if constexpr (Prob::FP8) asm volatile("v_mfma_scale_f32_16x16x128_f8f6f4 %0, %1, %2, %0, %3, %4 op_sel_hi:[0,0,0]" : "+v"(acc[ai][bj][m][n]) : "v"(Bt##8[n]), "v"(At##8[m]), "v"(scl_b), "v"(scl_a)); \
        else { _Pragma("unroll") for (int k = 0; k < 2; ++k) acc[ai][bj][m][n] = __builtin_amdgcn_mfma_f32_16x16x32_bf16(Bt[n][k], At[m][k], acc[ai][bj][m][n], 0, 0, 0); } } \
        __builtin_amdgcn_s_setprio(0); } while (0)
#define PG8_WAIT_V(n) asm volatile("s_waitcnt vmcnt(" #n ")" ::: "memory")
#define PG8_WAIT_L(n) asm volatile("s_waitcnt lgkmcnt(" #n ")" ::: "memory")
#define PG8_BAR __builtin_amdgcn_s_barrier()
#define PG8_SCHED __builtin_amdgcn_sched_barrier(0)
    Unit cur, nxt; int ui = 0;
    if (!P.next(0, cur)) return;
    f32x4 acc[2][2][4][2];
#pragma unroll
    for (int a = 0; a < 2; ++a)
#pragma unroll
        for (int b = 0; b < 2; ++b)
#pragma unroll
            for (int m = 0; m < 4; ++m)
#pragma unroll
                for (int n = 0; n < 2; ++n) acc[a][b][m][n] = (f32x4){0.f, 0.f, 0.f, 0.f};
    bf16x8 At[4][2], B0[2][2], B1[2][2]; v8i_t At8[4], B08[2], B18[2];
    unsigned cvo[2][2], nvo[2][2];
#pragma unroll
    for (int h = 0; h < 2; ++h)
#pragma unroll
        for (int i = 0; i < 2; ++i) cvo[h][i] = P.a_off(cur, h * HALF + RA[i]) + (unsigned)CA[i] * 2u;
    const char* cB = P.b_ptr(cur);
    const size_t kstep = (size_t)(BK * 2);
    PG8_STAGEB(PG8_SB(0, 0), cB); PG8_STAGEB(PG8_SB(0, 1), cB + hstepB); PG8_STAGEA(PG8_SA(0, 0), cvo, 0, 0); PG8_STAGEA(PG8_SA(0, 1), cvo, 1, 0);
    if (wr == 1) PG8_BAR;
    PG8_WAIT_V(2); PG8_BAR;
    PG8_STAGEB(PG8_SB(1, 0), cB + kstep); PG8_STAGEA(PG8_SA(1, 0), cvo, 0, kstep); PG8_STAGEB(PG8_SB(1, 1), cB + hstepB + kstep);
    PG8_WAIT_V(6); PG8_BAR;
    for (;;) {
        const bool has_next = P.next(ui + 1, nxt);
        const char* nB = cB;
#pragma unroll
        for (int h = 0; h < 2; ++h)
#pragma unroll
            for (int i = 0; i < 2; ++i) nvo[h][i] = cvo[h][i];
        if (has_next) { nB = P.b_ptr(nxt);
#pragma unroll
            for (int h = 0; h < 2; ++h)
#pragma unroll
                for (int i = 0; i < 2; ++i) nvo[h][i] = P.a_off(nxt, h * HALF + RA[i]) + (unsigned)CA[i] * 2u; }
        for (int t = 0; t < nt; t += 2) {
            const bool last = (t == nt - 2);
            const size_t k1 = (size_t)(t + 1) * kstep;
            const size_t k2 = last ? 0 : (size_t)(t + 2) * kstep, k3 = k2 + kstep;
            unsigned vo2[2][2];
#pragma unroll
            for (int h = 0; h < 2; ++h)
#pragma unroll
                for (int i = 0; i < 2; ++i) vo2[h][i] = last ? nvo[h][i] : cvo[h][i];
            const char* b2 = (last ? nB : cB) + k2; const char* b3 = b2 + kstep;
            PG8_LDB(B0, 0, 0); PG8_LDB(B1, 0, 1); PG8_SCHED; PG8_LDA(At, 0, 0); PG8_STAGEA(PG8_SA(1, 1), cvo, 1, k1);
            PG8_WAIT_V(8); PG8_WAIT_L(0); PG8_BAR; PG8_MMA(0, 0, At, B0); PG8_MMA(0, 1, At, B1); PG8_BAR; PG8_SCHED;
            PG8_LDA(At, 0, 1); PG8_STAGEB(PG8_SB(0, 0), b2); PG8_STAGEB(PG8_SB(0, 1), b2 + hstepB); PG8_STAGEA(PG8_SA(0, 0), vo2, 0, k2);
            PG8_WAIT_V(8); PG8_WAIT_L(0); PG8_BAR; PG8_MMA(1, 0, At, B0); PG8_MMA(1, 1, At, B1); PG8_BAR; PG8_SCHED;
            PG8_LDB(B0, 1, 0); PG8_LDB(B1, 1, 1); PG8_SCHED; PG8_LDA(At, 1, 0); PG8_STAGEA(PG8_SA(0, 1), vo2, 1, k2);
            PG8_WAIT_V(8); PG8_WAIT_L(0); PG8_BAR; PG8_MMA(0, 0, At, B0); PG8_MMA(0, 1, At, B1); PG8_BAR; PG8_SCHED;
            PG8_LDA(At, 1, 1); PG8_STAGEB(PG8_SB(1, 0), b3); PG8_STAGEB(PG8_SB(1, 1), b3 + hstepB); PG8_STAGEA(PG8_SA(1, 0), vo2, 0, k3);
            PG8_WAIT_V(8); PG8_WAIT_L(0); PG8_BAR; PG8_MMA(1, 0, At, B0); PG8_MMA(1, 1, At, B1); PG8_BAR; PG8_SCHED;
        }
        if (wr == 0) PG8_BAR;
        if constexpr (Prob::FP8) asm volatile("s_nop 15\n\ts_nop 15" ::: "memory");
        if constexpr (Epi::STAGED) E.staged(acc, P, cur, wr, wc, fr, fq, lds + STAGE_BYTES, tid);
        else { E(acc, P, cur, wr, wc, fr, fq); if (MK_EPI2) { asm volatile("" ::: "memory"); E(acc, P, cur, wr, wc, fr, fq); } }
        if (!has_next) break;
#pragma unroll
        for (int a = 0; a < 2; ++a)
#pragma unroll
            for (int b = 0; b < 2; ++b)
#pragma unroll
                for (int m = 0; m < 4; ++m)
#pragma unroll
                    for (int n = 0; n < 2; ++n) acc[a][b][m][n] = (f32x4){0.f, 0.f, 0.f, 0.f};
        cur = nxt; cB = nB; ++ui;
#pragma unroll
        for (int h = 0; h < 2; ++h)
#pragma unroll
            for (int i = 0; i < 2; ++i) cvo[h][i] = nvo[h][i];
        if (wr == 1) PG8_BAR;
    }
    PG8_WAIT_V(0);
    PG8_BAR;
#undef PG8_SA
#undef PG8_SB
#undef PG8_STAGEA
#undef PG8_STAGEB
#undef PG8_LDA
#undef PG8_LDB
#undef PG8_MMA
#undef PG8_WAIT_V
#undef PG8_WAIT_L
#undef PG8_BAR
#undef PG8_SCHED
}

struct DenseProb {
    static constexpr bool FP8 = false; static constexpr int sa = 127, sb = 127;
    const bf16_t* Abase; const bf16_t* Bt; int K, lda, ldb; Order ord;
    __device__ __forceinline__ bool next(int i, Unit& u) const { return ord.next(i, u); }
    __device__ __forceinline__ unsigned a_off(const Unit& u, int r) const { return (unsigned)((size_t)(u.pm * BM + r) * lda * 2); }
    __device__ __forceinline__ const char* b_ptr(const Unit& u) const { return (const char*)Bt + (size_t)u.pn * BM * ldb * 2; }
    __device__ __forceinline__ int orow0(const Unit& u) const { return u.pm * BM; }
};
struct MoeTiles { unsigned long long tp8; unsigned long long c4a, c4b; int nt; };
__device__ __forceinline__ int moe_tp(const MoeTiles& T, int e) { return (int)((T.tp8 >> (8 * e)) & 0xffull); }
__device__ __forceinline__ int moe_cnt(const MoeTiles& T, int e) { const unsigned long long w = (e < 4) ? T.c4a : T.c4b; return (int)((w >> (16 * (e & 3))) & 0xffffull); }
__device__ __forceinline__ int moe_expert(const MoeTiles& T, int pm) { int e = 0;
#pragma unroll
    for (int j = 1; j < 8; ++j) e += (pm >= (int)((T.tp8 >> (8 * j)) & 0xffull)) ? 1 : 0;
    return e; }
struct MoeGuProb {
    static constexpr bool FP8 = true; static constexpr int sa = 125, sb = 121;
    const unsigned char* Abase; const unsigned char* Bt; int K, ldb; Order ord; MoeTiles T; const int* rowtok;
    __device__ __forceinline__ bool next(int i, Unit& u) const { return ord.next(i, u); }
    __device__ __forceinline__ unsigned a_off(const Unit& u, int r) const {
        const int e = moe_expert(T, u.pm); const int idx = (u.pm - moe_tp(T, e)) * BM + r; const int cm1 = moe_cnt(T, e) - 1;
        const int tok = rowtok[e * CAPE + (idx < cm1 ? idx : cm1)];
        return (unsigned)tok * (unsigned)D; }
    __device__ __forceinline__ const char* b_ptr(const Unit& u) const { const int e = moe_expert(T, u.pm); return (const char*)Bt + ((size_t)e * N_GU1 + (size_t)u.pn * BM) * D; }
    __device__ __forceinline__ int orow0(const Unit& u) const { return u.pm * BM; }
};
struct MoeDnProb {
    static constexpr bool FP8 = true; static constexpr int sa = 124, sb = 121;
    const unsigned char* Abase; const unsigned char* Bt; int K, ldb; Order ord; MoeTiles T;
    __device__ __forceinline__ bool next(int i, Unit& u) const { return ord.next(i, u); }
    __device__ __forceinline__ unsigned a_off(const Unit& u, int r) const { return (unsigned)((size_t)(u.pm * BM + r) * EXD); }
    __device__ __forceinline__ const char* b_ptr(const Unit& u) const { const int e = moe_expert(T, u.pm); return (const char*)Bt + ((size_t)e * D + (size_t)u.pn * BM) * EXD; }
    __device__ __forceinline__ int orow0(const Unit& u) const { return u.pm * BM; }
};

struct EpiF32 { static constexpr bool PERM = false; static constexpr bool STAGED = false; float* C; int ldc;
    template <class Prob> __device__ __forceinline__ void operator()(const f32x4 (&acc)[2][2][4][2], const Prob& P, const Unit& u, int wr, int wc, int fr, int fq) const {
        const int row0 = P.orow0(u) + wr * 64 + fr, col0 = u.pn * BM + wc * 32 + 4 * fq;
#pragma unroll
        for (int ai = 0; ai < 2; ++ai)
#pragma unroll
            for (int m = 0; m < 4; ++m) { float* rowp = C + (size_t)(row0 + ai * HALF + m * 16) * ldc + col0;
#pragma unroll
                for (int bj = 0; bj < 2; ++bj)
#pragma unroll
                    for (int n = 0; n < 2; ++n) *(f32x4*)(rowp + bj * HALF + n * 16) = acc[ai][bj][m][n]; }
    }
};
struct EpiBf16 { static constexpr bool PERM = true; static constexpr bool STAGED = false; bf16_t* O; int ldc; const float* rowscale;
    template <class Prob> __device__ __forceinline__ void operator()(const f32x4 (&acc)[2][2][4][2], const Prob& P, const Unit& u, int wr, int wc, int fr, int fq) const {
        const int row0 = P.orow0(u) + wr * 64 + fr, col0 = u.pn * BM + wc * 32 + 8 * fq;
#pragma unroll
        for (int ai = 0; ai < 2; ++ai)
#pragma unroll
            for (int m = 0; m < 4; ++m) { const int row = row0 + ai * HALF + m * 16; bf16_t* rowp = O + (size_t)row * ldc + col0; const float rs = rowscale ? rowscale[row] : 1.0f;
#pragma unroll
                for (int bj = 0; bj < 2; ++bj) { const f32x4 v0 = acc[ai][bj][m][0] * rs, v1 = acc[ai][bj][m][1] * rs;
                    u32x4 w; w.x = cvtpk(v0[0], v0[1]); w.y = cvtpk(v0[2], v0[3]); w.z = cvtpk(v1[0], v1[1]); w.w = cvtpk(v1[2], v1[3]);
                    *(u32x4*)(rowp + bj * HALF) = w; } }
    }
};
struct EpiIn1 { static constexpr bool PERM = true; static constexpr bool STAGED = false; bf16_t* QK; bf16_t* V; bf16_t* G; bf16_t* RRp;
    template <class Prob> __device__ __forceinline__ void operator()(const f32x4 (&acc)[2][2][4][2], const Prob& P, const Unit& u, int wr, int wc, int fr, int fq) const {
        const int t = u.pn >> 2; bf16_t* base = (t == 0) ? QK : (t == 1) ? V : (t == 2) ? G : RRp; const int ldc = (t == 3) ? 256 : 1024;
        const int row0 = P.orow0(u) + wr * 64 + fr, col0 = (u.pn & 3) * BM + wc * 32 + 8 * fq;
#pragma unroll
        for (int ai = 0; ai < 2; ++ai)
#pragma unroll
            for (int m = 0; m < 4; ++m) { const int row = row0 + ai * HALF + m * 16; bf16_t* rowp = base + (size_t)row * ldc + col0;
#pragma unroll
                for (int bj = 0; bj < 2; ++bj) { const f32x4 v0 = acc[ai][bj][m][0], v1 = acc[ai][bj][m][1];
                    u32x4 w; w.x = cvtpk(v0[0], v0[1]); w.y = cvtpk(v0[2], v0[3]); w.z = cvtpk(v1[0], v1[1]); w.w = cvtpk(v1[2], v1[3]);
                    *(u32x4*)(rowp + bj * HALF) = w; } }
    }
};
struct EpiQA { static constexpr bool PERM = true; static constexpr bool STAGED = false; bf16_t* O; const float* rstd; const float* tab16; float qscale;
    template <class Prob> __device__ __forceinline__ void operator()(const f32x4 (&acc)[2][2][4][2], const Prob& P, const Unit& u, int wr, int wc, int fr, int fq) const {
        const int row0 = P.orow0(u) + wr * 64 + fr, col0 = u.pn * BM + wc * 32 + 8 * fq;
        const bool ropet = (u.pn == 2);
#pragma unroll
        for (int ai = 0; ai < 2; ++ai)
#pragma unroll
            for (int m = 0; m < 4; ++m) { const int row = row0 + ai * HALF + m * 16; bf16_t* rowp = O + (size_t)row * N_QA + col0; const float rs = rstd[row] * qscale;
                f32x4 cs0 = {1.f, 1.f, 1.f, 1.f}, sn0 = {0.f, 0.f, 0.f, 0.f};
                if (ropet && row < RL) { const int tt = row & (SEQ - 1); const int pos = (fq >> 1) ? (tt & 63) : (tt >> 6); const int i0 = 4 * (fq & 1);
                    cs0 = *(const f32x4*)(tab16 + pos * 8 + i0); sn0 = *(const f32x4*)(tab16 + 512 + pos * 8 + i0); }
#pragma unroll
                for (int bj = 0; bj < 2; ++bj) { f32x4 v0 = acc[ai][bj][m][0] * rs, v1 = acc[ai][bj][m][1] * rs;
                    if (ropet) {
                        const f32x4 a = v0, b = v1;
                        v0[0] = a[0] * cs0[0] - a[1] * sn0[0]; v0[1] = a[1] * cs0[0] + a[0] * sn0[0];
                        v0[2] = a[2] * cs0[1] - a[3] * sn0[1]; v0[3] = a[3] * cs0[1] + a[2] * sn0[1];
                        v1[0] = b[0] * cs0[2] - b[1] * sn0[2]; v1[1] = b[1] * cs0[2] + b[0] * sn0[2];
                        v1[2] = b[2] * cs0[3] - b[3] * sn0[3]; v1[3] = b[3] * cs0[3] + b[2] * sn0[3]; }
                    u32x4 w; w.x = cvtpk(v0[0], v0[1]); w.y = cvtpk(v0[2], v0[3]); w.z = cvtpk(v1[0], v1[1]); w.w = cvtpk(v1[2], v1[3]);
                    *(u32x4*)(rowp + bj * HALF) = w; } }
    }
};
struct EpiSwiglu { static constexpr bool PERM = false; static constexpr bool STAGED = false; bf16_t* Hh; int ldh;
    template <class Prob> __device__ __forceinline__ void operator()(const f32x4 (&acc)[2][2][4][2], const Prob& P, const Unit& u, int wr, int wc, int fr, int fq) const {
        const int row0 = P.orow0(u) + wr * 64 + fr, col0 = (u.pn * BM + wc * 32) / 2 + 4 * fq;
#pragma unroll
        for (int ai = 0; ai < 2; ++ai)
#pragma unroll
            for (int m = 0; m < 4; ++m) { bf16_t* rowp = Hh + (size_t)(row0 + ai * HALF + m * 16) * ldh + col0;
#pragma unroll
                for (int bj = 0; bj < 2; ++bj) { const f32x4 g = acc[ai][bj][m][0], up = acc[ai][bj][m][1];
                    u32x2 w; w.x = cvtpk(silu_f(g[0]) * up[0], silu_f(g[1]) * up[1]); w.y = cvtpk(silu_f(g[2]) * up[2], silu_f(g[3]) * up[3]);
                    *(u32x2*)(rowp + bj * (HALF / 2)) = w; } }
    }
};
struct EpiSwiglu8 { static constexpr bool PERM = false; static constexpr bool STAGED = true; unsigned char* Hh; int ldh;
    template <class Prob> __device__ __forceinline__ void staged(const f32x4 (&acc)[2][2][4][2], const Prob& P, const Unit& u, int wr, int wc, int fr, int fq, LAS unsigned char* stg, int tid) const {
        LAS unsigned char* sg = stg + wr * 8192;
        const int t = tid & 255;
        unsigned char* gbase = Hh + (size_t)(P.orow0(u) + wr * 64) * ldh + (size_t)u.pn * 128;
#pragma unroll
        for (int ai = 0; ai < 2; ++ai) {
#pragma unroll
            for (int m = 0; m < 4; ++m) { const int row = m * 16 + fr;
#pragma unroll
                for (int bj = 0; bj < 2; ++bj) { const f32x4 g = acc[ai][bj][m][0], up = acc[ai][bj][m][1]; const int p = bj * 4 + wc;
                    *(LAS unsigned*)(sg + row * 128 + ((p ^ (row & 7)) << 4) + 4 * fq) = pack_fp8x4(8.0f * silu_f(g[0]) * up[0], 8.0f * silu_f(g[1]) * up[1], 8.0f * silu_f(g[2]) * up[2], 8.0f * silu_f(g[3]) * up[3]); } }
            asm volatile("s_waitcnt lgkmcnt(0)" ::: "memory"); __builtin_amdgcn_s_barrier(); asm volatile("" ::: "memory");
#pragma unroll
            for (int j = 0; j < 2; ++j) { const int row = (t >> 3) + 32 * j, p = t & 7;
                const u32x4 v = *(const LAS u32x4*)(sg + row * 128 + ((p ^ (row & 7)) << 4));
                *(u32x4*)(gbase + (size_t)(ai * HALF + row) * ldh + p * 16) = v; }
            if (ai == 0) { asm volatile("s_waitcnt lgkmcnt(0)" ::: "memory"); __builtin_amdgcn_s_barrier(); asm volatile("" ::: "memory"); }
        }
    }
};
}

struct Frame {
    LAS unsigned char* lds;
    unsigned char* ws;
    int tid, lane, wave, vcu, G;
};
template <class T> __device__ __forceinline__ T* wsp(const Frame& F, size_t off) { return (T*)(F.ws + off); }

__device__ __forceinline__ void load_row(const float* p, int lane, f32x4 (&v)[4]) {
    const f32x4* r = (const f32x4*)p + lane;
#pragma unroll
    for (int j = 0; j < 4; ++j) v[j] = r[64 * j];
}
__device__ __forceinline__ void load_row_bf16(const bf16_t* p, int lane, f32x4 (&v)[4]) {
#pragma unroll
    for (int j = 0; j < 4; ++j) { const u32x2 w = *(const u32x2*)(p + 4 * lane + 256 * j); v[j][0] = bflo(w.x); v[j][1] = bfhi(w.x); v[j][2] = bflo(w.y); v[j][3] = bfhi(w.y); }
}
__device__ __forceinline__ float row_ssq(const f32x4 (&v)[4]) { float s = 0.f;
#pragma unroll
    for (int j = 0; j < 4; ++j) s += (v[j][0] * v[j][0] + v[j][1] * v[j][1]) + (v[j][2] * v[j][2] + v[j][3] * v[j][3]);
    return wave_sum(s); }
__device__ __forceinline__ void norm_mod_store(const f32x4 (&h)[4], const float* g, const float* sh, const float* sc, bf16_t* urow, int lane, f32x4 (&uo)[4], unsigned char* u8row = nullptr) {
    const float rstd = __builtin_amdgcn_rsqf(row_ssq(h) * (1.0f / D) + EPS);
#pragma unroll
    for (int j = 0; j < 4; ++j) { const int c = 4 * lane + 256 * j; const f32x4 gg = *(const f32x4*)(g + c), s1 = *(const f32x4*)(sc + c), s0 = *(const f32x4*)(sh + c);
        const f32x4 uu = (h[j] * rstd * gg) * (1.0f + s1) + s0; uo[j] = uu;
        if (u8row) *(unsigned*)(u8row + c) = pack_fp8x4(4.0f * uu[0], 4.0f * uu[1], 4.0f * uu[2], 4.0f * uu[3]);
        else { u32x2 w; w.x = cvtpk(uu[0], uu[1]); w.y = cvtpk(uu[2], uu[3]); *(u32x2*)(urow + c) = w; } }
}
__device__ __forceinline__ int row_bidx(int row) { return row < RL ? (row >> 12) : 4; }

__device__ __forceinline__ void glds16(const void* gsrc, unsigned lds_dst) { unsigned keep;
    asm volatile("s_mov_b32 %0, m0\n\ts_mov_b32 m0, %2\n\ts_nop 0\n\tglobal_load_lds_dwordx4 %1, off\n\ts_mov_b32 m0, %0" : "=&s"(keep) : "v"(gsrc), "s"(lds_dst) : "memory"); }
__device__ __forceinline__ float max3f(float a, float b, float c) { float r; asm("v_max3_f32 %0, %1, %2, %3" : "=v"(r) : "v"(a), "v"(b), "v"(c)); return r; }
#define WAIT_BAR(N) asm volatile("s_waitcnt vmcnt(" #N ") lgkmcnt(0)\n\ts_barrier" ::: "memory")
template <int DQK> struct AttnSrc {
    const bf16_t* Q; int qpitch; const bf16_t* Qr;
    const bf16_t* Kn; int kpitch; const bf16_t* Kr; int krpitch;
    const bf16_t* V; int vpitch;
    bf16_t* O; int opitch;
};
__device__ __forceinline__ s16x4 vtr(const LAS unsigned char* p) { typedef short v4i16_t __attribute__((ext_vector_type(4))); return __builtin_bit_cast(s16x4, __builtin_amdgcn_ds_read_tr16_b64_v4i16((LAS v4i16_t*)p)); }
__device__ __forceinline__ int attn_krow(int kt, int lat0, int ctx0) { return kt < 64 ? lat0 + kt * 64 : ctx0 + (kt - 64) * 64; }
template <int DQK>
__device__ __forceinline__ void attn_unit(const Frame& F, const AttnSrc<DQK>& S, int q0, int lat0, int ctx0, int kt0, int kt1) {
    constexpr int NKS = DQK / 16, KB = DQK * 128, SLOT = KB + 8192;
    constexpr float THR = 8.0f;
    const int lane = F.lane, wid = F.wave, r32 = lane & 31, hi = lane >> 5;
    LAS unsigned char* lds = F.lds;
    constexpr bool QLDS = false;
    bf16x8 qf[QLDS ? 1 : NKS];
    LAS unsigned char* qfl = lds + 4 * SLOT + wid * (NKS * 1024) + lane * 16;
    { const bf16_t* qrow = S.Q + (size_t)(q0 + wid * 32 + r32) * S.qpitch;
#pragma unroll
      for (int ks = 0; ks < 4; ++ks) { const bf16x8 v = *(const bf16x8*)(qrow + ks * 16 + hi * 8); if (QLDS) *(LAS bf16x8*)(qfl + ks * 1024) = v; else qf[ks] = v; }
      if (DQK == 96) { const bf16_t* qr = S.Qr + (size_t)(q0 + wid * 32 + r32) * S.qpitch;
#pragma unroll
          for (int ks = 4; ks < NKS; ++ks) { const bf16x8 v = *(const bf16x8*)(qr + (ks - 4) * 16 + hi * 8); if (QLDS) *(LAS bf16x8*)(qfl + ks * 1024) = v; else qf[ks] = v; } } }
    const unsigned lds0 = (unsigned)(size_t)lds;
    auto dma = [&](int kt, int slot) {
        const int krow = attn_krow(kt, lat0, ctx0);
        const unsigned sb = lds0 + slot * SLOT;
        glds16(S.Kn + (size_t)(krow + lane) * S.kpitch + wid * 8, (unsigned)__builtin_amdgcn_readfirstlane(sb + wid * 1024));
        if (DQK == 96 && wid < 4) glds16(S.Kr + (size_t)(krow + lane) * S.krpitch + wid * 8, (unsigned)__builtin_amdgcn_readfirstlane(sb + (8 + wid) * 1024));
        glds16(S.V + (size_t)(krow + 16 * (wid & 3) + (lane >> 2)) * S.vpitch + (wid >> 2) * 32 + (lane & 3) * 8, (unsigned)__builtin_amdgcn_readfirstlane(sb + KB + wid * 1024));
    };
    auto wait_bar = [&](bool inflight) {
        if (!inflight) { WAIT_BAR(0); } else if (DQK == 96 && wid < 4) { WAIT_BAR(3); } else { WAIT_BAR(2); }
    };
    f32x16 oT[2]; f32x16 negm;
#pragma unroll
    for (int r = 0; r < 16; ++r) { oT[0][r] = 0.f; oT[1][r] = 0.f; negm[r] = 0.f; }
    float mrun = 0.f, lrun = 0.f;
    const int vlane = ((lane >> 4) & 1) * 32 + (lane & 3) * 8 + (4 * hi + ((lane & 15) >> 2)) * 64;
    auto qk = [&](int slot, f32x16& p0, f32x16& p1) {
        const LAS unsigned char* kb = lds + slot * SLOT + hi * 1024 + r32 * 16;
        p0 = negm; p1 = negm;
#pragma unroll
        for (int ks = 0; ks < NKS; ++ks) {
            const bf16x8 k0 = *(const LAS bf16x8*)(kb + ks * 2048), k1 = *(const LAS bf16x8*)(kb + ks * 2048 + 512);
            p0 = __builtin_amdgcn_mfma_f32_32x32x16_bf16(k0, qf[ks], p0, 0, 0, 0);
            p1 = __builtin_amdgcn_mfma_f32_32x32x16_bf16(k1, qf[ks], p1, 0, 0, 0);
            if (ks & 1) asm volatile("" ::: "memory");
        }
    };
    auto tilemax = [&](f32x16& p0, f32x16& p1) -> float {
        asm volatile("s_nop 15\n\ts_nop 7" : "+v"(p0), "+v"(p1));
        float a = max3f(p0[0], p0[1], p1[0]), b = max3f(p0[2], p0[3], p1[1]); a = max3f(a, p1[2], p1[3]);
#pragma unroll
        for (int r = 4; r < 16; r += 4) { a = max3f(a, p0[r], p0[r + 1]); b = max3f(b, p0[r + 2], p0[r + 3]); a = max3f(a, p1[r], p1[r + 1]); b = max3f(b, p1[r + 2], p1[r + 3]); }
        float tm = fmaxf(a, b);
        auto rr = __builtin_amdgcn_permlane32_swap(__float_as_uint(tm), __float_as_uint(tm), false, false); return fmaxf(__uint_as_float(rr[0]), __uint_as_float(rr[1]));
    };
    auto smpv = [&](f32x16& p0, f32x16& p1, int slot) -> bool {
        const float tm = tilemax(p0, p1);
        bool moved = false;
        if (__any(tm > THR)) {
            const float dl = fmaxf(tm, 0.f); mrun += dl; const float al = __builtin_amdgcn_exp2f(-dl); lrun *= al;
#pragma unroll
            for (int r = 0; r < 16; ++r) { p0[r] -= dl; p1[r] -= dl; negm[r] = -mrun; oT[0][r] *= al; oT[1][r] *= al; }
            moved = true;
        }
        float rs = 0.f;
#pragma unroll
        for (int r = 0; r < 16; ++r) { p0[r] = __builtin_amdgcn_exp2f(p0[r]); p1[r] = __builtin_amdgcn_exp2f(p1[r]); rs += p0[r] + p1[r]; }
        lrun += rs;
        bf16x8 pf[4];
        { u32x4 w;
          w.x = cvtpk(p0[0], p0[1]); w.y = cvtpk(p0[2], p0[3]); w.z = cvtpk(p0[4], p0[5]); w.w = cvtpk(p0[6], p0[7]); pf[0] = __builtin_bit_cast(bf16x8, w);
          w.x = cvtpk(p0[8], p0[9]); w.y = cvtpk(p0[10], p0[11]); w.z = cvtpk(p0[12], p0[13]); w.w = cvtpk(p0[14], p0[15]); pf[1] = __builtin_bit_cast(bf16x8, w);
          w.x = cvtpk(p1[0], p1[1]); w.y = cvtpk(p1[2], p1[3]); w.z = cvtpk(p1[4], p1[5]); w.w = cvtpk(p1[6], p1[7]); pf[2] = __builtin_bit_cast(bf16x8, w);
          w.x = cvtpk(p1[8], p1[9]); w.y = cvtpk(p1[10], p1[11]); w.z = cvtpk(p1[12], p1[13]); w.w = cvtpk(p1[14], p1[15]); pf[3] = __builtin_bit_cast(bf16x8, w); }
        const LAS unsigned char* vb = lds + slot * SLOT + KB + vlane;
#pragma unroll
        for (int d0 = 0; d0 < 2; ++d0)
#pragma unroll
            for (int ks = 0; ks < 4; ++ks) {
                const s16x4 lo = vtr(vb + d0 * 4096 + ks * 1024), hh = vtr(vb + d0 * 4096 + ks * 1024 + 512);
                const bf16x8 vf = (bf16x8){lo[0], lo[1], lo[2], lo[3], hh[0], hh[1], hh[2], hh[3]};
                oT[d0] = __builtin_amdgcn_mfma_f32_32x32x16_bf16(vf, pf[ks], oT[d0], 0, 0, 0);
                if (ks & 1) asm volatile("" ::: "memory");
            }
        return moved;
    };
    dma(kt0, 0); dma(kt0 + 1, 1); dma(kt0 + 2, 2);
    wait_bar(true);
    f32x16 pA0, pA1, pB0, pB1;
    qk(0, pA0, pA1);
    { mrun = tilemax(pA0, pA1);
#pragma unroll
      for (int r = 0; r < 16; ++r) negm[r] = -mrun;
      qk(0, pA0, pA1); }
    int sc = 0;
    for (int kt = kt0; kt < kt1; kt += 2) {
        { const int s1 = (sc + 1) & 3, s3 = (sc + 3) & 3;
          if (kt + 3 < kt1) dma(kt + 3, s3);
          qk(s1, pB0, pB1);
          if (smpv(pA0, pA1, sc)) qk(s1, pB0, pB1);
          wait_bar(kt + 3 < kt1);
          sc = s1; }
        { const int s1 = (sc + 1) & 3, s3 = (sc + 3) & 3;
          if (kt + 4 < kt1) dma(kt + 4, s3);
          if (kt + 2 < kt1) qk(s1, pA0, pA1);
          if (smpv(pB0, pB1, sc) && kt + 2 < kt1) qk(s1, pA0, pA1);
          wait_bar(kt + 4 < kt1);
          sc = s1; }
    }
    { auto rr = __builtin_amdgcn_permlane32_swap(__float_as_uint(lrun), __float_as_uint(lrun), false, false); lrun = __uint_as_float(rr[0]) + __uint_as_float(rr[1]); }
    const float inv = 1.0f / lrun;
    bf16_t* orow = S.O + (size_t)(q0 + wid * 32 + r32) * S.opitch;
#pragma unroll
    for (int d0 = 0; d0 < 2; ++d0)
#pragma unroll
        for (int g = 0; g < 4; ++g) { u32x2 w; w.x = cvtpk(oT[d0][4 * g] * inv, oT[d0][4 * g + 1] * inv); w.y = cvtpk(oT[d0][4 * g + 2] * inv, oT[d0][4 * g + 3] * inv);
            *(u32x2*)(orow + 32 * d0 + 8 * g + 4 * hi) = w; }
}

__device__ __forceinline__ int sig5(int c) { return (c & ~12) | ((c & 8) >> 1) | ((c & 4) << 1); }

__global__ void __launch_bounds__(512, 2) mk_fwd(Args args) {
    extern __shared__ __attribute__((aligned(16))) unsigned char lds_raw[];
    Frame F;
    F.lds = (LAS unsigned char*)lds_raw; F.ws = args.ws;
    F.tid = threadIdx.x; F.lane = F.tid & 63; F.wave = __builtin_amdgcn_readfirstlane(F.tid >> 6);
    F.G = gridDim.x; { const int bx = blockIdx.x; F.vcu = (F.G % 8 == 0) ? (bx % 8) * (F.G / 8) + bx / 8 : bx; }
    volatile LAS unsigned* MISC = (volatile LAS unsigned*)(F.lds + LDSCTL_OFF);
    if (F.tid < 64) MISC[F.tid] = 0u;
    __syncthreads();
    unsigned* ctl = wsp<unsigned>(F, O_CTL);
#if MK_ONE_LAUNCH
    XcdBarrier bar = xcd_barrier_post(ctl + CW_BAR, MISC + 8);
#define GRID_BAR() xcd_barrier(bar)
#else
#define GRID_BAR() do {} while (0)
#endif
    const int lo = args.ph_lo, hi_ph = args.ph_hi;
#define IN(k) (lo <= (k) && (k) < hi_ph)
#define SEAM(k) do { if (IN(k) && IN((k) + 1)) GRID_BAR(); } while (0)
    const int lane = F.lane, wave = F.wave, tid = F.tid;
    const int gw = F.vcu * 8 + wave, NGW = F.G * 8;

    const float* x_in = args.in[I_X]; const float* ctx_in = args.in[I_CTX];
    float* MODV = wsp<float>(F, O_MODV);
    float* TAB16 = wsp<float>(F, O_TAB16); float* TAB32 = wsp<float>(F, O_TAB32);
    float* HC = wsp<float>(F, O_HC);
    bf16_t* U = wsp<bf16_t>(F, O_U);
    float* Y = wsp<float>(F, O_Y);
    const float* normg = args.in[I_NORMG];
#define MV(layer, bidx, k) (MODV + ((size_t)((layer) * 5 + (bidx)) * 6 + (k)) * D)

    if (IN(0)) {
        {
            LAS float* sc = (LAS float*)F.lds;
            LAS float* red = sc + 5 * 1024;
            for (int i = tid; i < 5 * 1024; i += 512) { const int b = i >> 10, k = i & 1023; const float cv = (b < 4) ? args.in[I_C][b * 1024 + k] : args.in[I_CCTX][k]; sc[i] = cv / (1.0f + __expf(-cv)); }
            __syncthreads();
            for (int unit = F.vcu; unit < 192; unit += F.G) {
                const int layer = unit / 96, cb = unit % 96, col = cb * 64 + lane;
                const float* W = args.in[I_MODW] + (size_t)layer * D * 6144 + col;
                float a0 = 0.f, a1 = 0.f, a2 = 0.f, a3 = 0.f, a4 = 0.f;
#pragma unroll 16
                for (int kk = 0; kk < 128; ++kk) { const int k = wave * 128 + kk; const float w = W[(size_t)k * 6144];
                    a0 += sc[k] * w; a1 += sc[1024 + k] * w; a2 += sc[2048 + k] * w; a3 += sc[3072 + k] * w; a4 += sc[4096 + k] * w; }
                red[(wave * 5 + 0) * 64 + lane] = a0; red[(wave * 5 + 1) * 64 + lane] = a1; red[(wave * 5 + 2) * 64 + lane] = a2; red[(wave * 5 + 3) * 64 + lane] = a3; red[(wave * 5 + 4) * 64 + lane] = a4;
                __syncthreads();
                if (tid < 320) { const int b = tid >> 6, cc = tid & 63; float s = 0.f;
#pragma unroll
                    for (int w = 0; w < 8; ++w) s += red[(w * 5 + b) * 64 + cc];
                    MODV[(size_t)(layer * 5 + b) * 6144 + cb * 64 + cc] = s + args.in[I_MODB][layer * 6144 + cb * 64 + cc]; }
                __syncthreads();
            }
        }
        if (blockIdx.x == 0) {
            for (int i = tid; i < 64 * 8; i += 512) { const int pos = i >> 3, f = i & 7; const float fr = powf(10000.0f, -(float)f / 8.0f), a = (float)pos * fr; TAB16[i] = cosf(a); TAB16[512 + i] = sinf(a); }
            for (int i = tid; i < 64 * 16; i += 512) { const int pos = i >> 4, f = i & 15; const float fr = powf(10000.0f, -(float)f / 16.0f), a = (float)pos * fr; TAB32[i] = cosf(a); TAB32[1024 + i] = sinf(a); }
        }
        {
            LAS float* scr = (LAS float*)(F.lds + wave * 16640);
            int base = 0;
            auto run = [&](const Conv& c) { const int n = (c.K / 64) * (c.Ndst / 32); for (int it = gw - base; it < n; it += NGW) { if (it >= 0) conv_item(c, it, scr, lane); }
                base = (base + n) % NGW; };
            auto run64 = [&](const Conv64& c) { conv64_run(c, scr, lane, gw, NGW, base); };
            run64(Conv64{args.in[I_FWG], args.in[I_FWU], FFN, 1024, N_GU0, wsp<bf16_t>(F, O_WGU0), 3, 0, 0, 1.0f, 0});
            run64(Conv64{args.in[I_FWD], nullptr, 1024, FFN, 1024, wsp<bf16_t>(F, O_WD0), 0, 1024, 0, 1.0f, 0});
            run64(Conv64{args.in[I_GWIN], nullptr, 3104, 1024, N_IN1, wsp<bf16_t>(F, O_WIN1), 0, 3104, 512, 0.08838834764831845f, 0});
            run64(Conv64{args.in[I_GWOUT], nullptr, 1024, 1024, 1024, wsp<bf16_t>(F, O_WOUT1), 0, 1024, 0, 1.0f, 0});
            run64(Conv64{args.in[I_AWOUT], nullptr, 1024, 1024, 1024, wsp<bf16_t>(F, O_WOUT0), 0, 1024, 0, 1.0f, 0});
            run(Conv{args.in[I_AWIN], nullptr, 1440, 1024, N_IN0, wsp<bf16_t>(F, O_WIN0), 1, nullptr});
            run(Conv{args.in[I_AWUQ], nullptr, 768, 384, N_QA, wsp<bf16_t>(F, O_WUQ), 2, args.in[I_AQN]});
            run(Conv{args.in[I_AWUKV], nullptr, 1024, 256, N_KVA, wsp<bf16_t>(F, O_WUKV), 0, args.in[I_AKVN]});
        }
    }
    SEAM(0);

    if (IN(1)) {
        for (int row = gw; row < R; row += NGW) {
            const float* hp = row < RL ? x_in + (size_t)row * D : ctx_in + (size_t)(row - RL) * D;
            f32x4 h[4], uo[4]; load_row(hp, lane, h);
            const int b = row_bidx(row);
            norm_mod_store(h, normg + 0 * D, MV(0, b, 0), MV(0, b, 1), U + (size_t)row * D, lane, uo);
        }
    }
    SEAM(1);

    if (IN(2)) {
        pg8::DenseProb P{U, wsp<bf16_t>(F, O_WIN0), 1024, 1024, 1024, {}}; P.ord.init(R / 256, N_IN0 / 256, F.G, (int)blockIdx.x);
        pg8::EpiBf16 E{wsp<bf16_t>(F, O_Z0), N_IN0, nullptr};
        pg8::gemm_phase(F.lds, P, E);
    }
    SEAM(2);

    if (IN(3)) {
        const bf16_t* Z0 = wsp<bf16_t>(F, O_Z0);
        float* RSQ = wsp<float>(F, O_RSTDQ); float* RSKV = wsp<float>(F, O_RSTDKV);
        bf16_t* QB = wsp<bf16_t>(F, O_QB); bf16_t* KBp = wsp<bf16_t>(F, O_KB); bf16_t* KR = wsp<bf16_t>(F, O_KR);
        const float* qkn = args.in[I_AQKN];
        for (int row = gw; row < R; row += NGW) {
            const unsigned* z32 = (const unsigned*)(Z0 + (size_t)row * N_IN0);
            float s = 0.f;
#pragma unroll
            for (int j = 0; j < 3; ++j) { const unsigned w = z32[lane + 64 * j]; const float a = bflo(w), b = bfhi(w); s += a * a + b * b; }
            s = wave_sum(s);
            float s2 = 0.f;
#pragma unroll
            for (int j = 0; j < 2; ++j) { const unsigned w = z32[192 + lane + 64 * j]; const float a = bflo(w), b = bfhi(w); s2 += a * a + b * b; }
            s2 = wave_sum(s2);
            if (lane == 0) { RSQ[row] = __builtin_amdgcn_rsqf(s * (1.0f / 384.0f) + EPS); RSKV[row] = __builtin_amdgcn_rsqf(s2 * (1.0f / 256.0f) + EPS); }
            const bool lat = row < RL; const int tt = row & (SEQ - 1);
#pragma unroll
            for (int which = 0; which < 2; ++which) {
                if (which == 1 && lane >= 16) break;
                const u32x4 w4 = *(const u32x4*)(Z0 + (size_t)row * N_IN0 + (which ? 1152 : 640) + lane * 8);
                float v[8] = {bflo(w4.x), bfhi(w4.x), bflo(w4.y), bfhi(w4.y), bflo(w4.z), bfhi(w4.z), bflo(w4.w), bfhi(w4.w)};
                float ss = 0.f;
#pragma unroll
                for (int j = 0; j < 8; ++j) ss += v[j] * v[j];
                ss += __shfl_xor(ss, 1); ss += __shfl_xor(ss, 2); ss += __shfl_xor(ss, 4);
                const float rstd = __builtin_amdgcn_rsqf(ss * (1.0f / 64.0f) + EPS);
                const int jp = lane & 7, half = jp >> 2, i0 = 4 * (jp & 3);
                const float* gn = qkn + which * 64 + half * 32;
#pragma unroll
                for (int pz = 0; pz < 4; ++pz) { v[2 * pz] *= rstd * gn[i0 + pz]; v[2 * pz + 1] *= rstd * gn[16 + i0 + pz]; }
                if (lat) { const int pos = half ? (tt & 63) : (tt >> 6);
                    const f32x4 cs = *(const f32x4*)(TAB32 + pos * 16 + i0), sn = *(const f32x4*)(TAB32 + 1024 + pos * 16 + i0);
#pragma unroll
                    for (int pz = 0; pz < 4; ++pz) { const float a = v[2 * pz], b = v[2 * pz + 1]; v[2 * pz] = a * cs[pz] - b * sn[pz]; v[2 * pz + 1] = b * cs[pz] + a * sn[pz]; } }
                const float osc = which ? 1.0f : 0.125f * LOG2E;
                u32x4 o; o.x = cvtpk(v[0] * osc, v[1] * osc); o.y = cvtpk(v[2] * osc, v[3] * osc); o.z = cvtpk(v[4] * osc, v[5] * osc); o.w = cvtpk(v[6] * osc, v[7] * osc);
                if (which == 0) *(u32x4*)(QB + (size_t)row * 512 + lane * 8) = o; else *(u32x4*)(KBp + (size_t)row * 128 + lane * 8) = o;
            }
            if (lane < 4) {
                const u32x4 w4 = *(const u32x4*)(Z0 + (size_t)row * N_IN0 + 1408 + lane * 8);
                float v[8] = {bflo(w4.x), bfhi(w4.x), bflo(w4.y), bfhi(w4.y), bflo(w4.z), bfhi(w4.z), bflo(w4.w), bfhi(w4.w)};
                if (lat) { const int half = lane >> 1, i0 = 4 * (lane & 1); const int pos = half ? (tt & 63) : (tt >> 6);
                    const f32x4 cs = *(const f32x4*)(TAB16 + pos * 8 + i0), sn = *(const f32x4*)(TAB16 + 512 + pos * 8 + i0);
#pragma unroll
                    for (int pz = 0; pz < 4; ++pz) { const float a = v[2 * pz], b = v[2 * pz + 1]; v[2 * pz] = a * cs[pz] - b * sn[pz]; v[2 * pz + 1] = b * cs[pz] + a * sn[pz]; } }
                u32x4 o; o.x = cvtpk(v[0], v[1]); o.y = cvtpk(v[2], v[3]); o.z = cvtpk(v[4], v[5]); o.w = cvtpk(v[6], v[7]);
                *(u32x4*)(KR + (size_t)row * 32 + lane * 8) = o;
            }
        }
    }
    SEAM(3);

    if (IN(4)) {
        { pg8::DenseProb P{wsp<bf16_t>(F, O_Z0), wsp<bf16_t>(F, O_WUQ), 384, N_IN0, 384, {}}; P.ord.init(R / 256, N_QA / 256, F.G, (int)blockIdx.x);
          pg8::EpiQA E{wsp<bf16_t>(F, O_QA), wsp<float>(F, O_RSTDQ), TAB16, 0.10206207261596577f * LOG2E};
          pg8::gemm_phase(F.lds, P, E); }
        { pg8::DenseProb P{wsp<bf16_t>(F, O_Z0) + 384, wsp<bf16_t>(F, O_WUKV), 256, N_IN0, 256, {}}; P.ord.init(R / 256, N_KVA / 256, F.G, (int)((blockIdx.x + F.G - (204 % F.G)) % F.G));
          pg8::EpiBf16 E{wsp<bf16_t>(F, O_KVA), N_KVA, wsp<float>(F, O_RSTDKV)};
          pg8::gemm_phase(F.lds, P, E); }
    }
    SEAM(4);

    if (IN(5)) {
        const bf16_t* QA = wsp<bf16_t>(F, O_QA); const bf16_t* KVA = wsp<bf16_t>(F, O_KVA); const bf16_t* QB = wsp<bf16_t>(F, O_QB);
        const bf16_t* KBp = wsp<bf16_t>(F, O_KB); const bf16_t* KR = wsp<bf16_t>(F, O_KR); const bf16_t* Z0 = wsp<bf16_t>(F, O_Z0);
        bf16_t* AO = wsp<bf16_t>(F, O_AO);
        for (int i = 0; i < 3; ++i) {
            int b, hh, q0, kt0, kt1;
            if (i < 2) { const int m = i * 256 + F.vcu; b = m >> 7; hh = (m >> 4) & 7; q0 = b * SEQ + (m & 15) * 256; kt0 = 0; kt1 = 68; }
            else { if (F.vcu >= 32) break; b = (F.vcu >> 3) & 3; hh = F.vcu & 7; q0 = RL + b * CTX; kt0 = 64; kt1 = 68; }
            const int lat0 = b * SEQ, ctx0 = RL + b * CTX;
            AttnSrc<96> S{QA + hh * 64, N_QA, QA + 512 + hh * 32, KVA + hh * 128, N_KVA, KR, 32, KVA + hh * 128 + 64, N_KVA, AO + hh * 64, D};
            attn_unit<96>(F, S, q0, lat0, ctx0, kt0, kt1);
        }
        for (int i = 0; i < 3; ++i) {
            int b, hh, q0, kt0, kt1;
            if (i < 2) { const int m = i * 256 + F.vcu; b = m >> 7; hh = (m >> 4) & 7; q0 = b * SEQ + (m & 15) * 256; kt0 = 0; kt1 = 68; }
            else { if (F.vcu < 32 || F.vcu >= 64) break; b = (F.vcu >> 3) & 3; hh = F.vcu & 7; q0 = RL + b * CTX; kt0 = 64; kt1 = 68; }
            const int lat0 = b * SEQ, ctx0 = RL + b * CTX; const int kvh = hh >> 2;
            AttnSrc<64> S{QB + hh * 64, 512, nullptr, KBp + kvh * 64, 128, nullptr, 0, Z0 + 1280 + kvh * 64, N_IN0, AO + 512 + hh * 64, D};
            attn_unit<64>(F, S, q0, lat0, ctx0, kt0, kt1);
        }
    }
    SEAM(5);

    if (IN(6)) {
        pg8::DenseProb P{wsp<bf16_t>(F, O_AO), wsp<bf16_t>(F, O_WOUT0), 1024, 1024, 1024, {}}; P.ord.init(R / 256, 4, F.G, (int)blockIdx.x);
        pg8::EpiBf16 E{(bf16_t*)Y, D, nullptr};
        pg8::gemm_phase(F.lds, P, E);
    }
    SEAM(6);

    if (IN(7)) {
        for (int row = gw; row < R; row += NGW) {
            const float* hp = row < RL ? x_in + (size_t)row * D : ctx_in + (size_t)(row - RL) * D;
            float* ho = row < RL ? args.out + (size_t)row * D : HC + (size_t)(row - RL) * D;
            const int b = row_bidx(row);
            f32x4 y[4], h[4], uo[4]; load_row_bf16((const bf16_t*)Y + (size_t)row * D, lane, y); load_row(hp, lane, h);
            const float rstd = __builtin_amdgcn_rsqf(row_ssq(y) * (1.0f / D) + EPS);
#pragma unroll
            for (int j = 0; j < 4; ++j) { const int c = 4 * lane + 256 * j; const f32x4 g = *(const f32x4*)(normg + 1 * D + c), mg = *(const f32x4*)(MV(0, b, 2) + c);
                h[j] = h[j] + mg * (y[j] * rstd * g); *(f32x4*)(ho + c) = h[j]; }
            norm_mod_store(h, normg + 2 * D, MV(0, b, 3), MV(0, b, 4), U + (size_t)row * D, lane, uo);
        }
    }
    SEAM(7);

    if (IN(8)) {
        pg8::DenseProb P{U, wsp<bf16_t>(F, O_WGU0), 1024, 1024, 1024, {}}; P.ord.init(R / 256, N_GU0 / 256, F.G, (int)blockIdx.x);
        pg8::EpiSwiglu E{wsp<bf16_t>(F, O_H0), FFN};
        pg8::gemm_phase(F.lds, P, E);
    }
    SEAM(8);
    if (IN(9)) {
        pg8::DenseProb P{wsp<bf16_t>(F, O_H0), wsp<bf16_t>(F, O_WD0), FFN, FFN, FFN, {}}; P.ord.init(R / 256, 4, F.G, (int)blockIdx.x);
        pg8::EpiBf16 E{(bf16_t*)Y, D, nullptr};
        pg8::gemm_phase(F.lds, P, E);
    }
    SEAM(9);

    if (IN(10)) {
        for (int row = gw; row < R; row += NGW) {
            float* hp = row < RL ? args.out + (size_t)row * D : HC + (size_t)(row - RL) * D;
            const int b = row_bidx(row);
            f32x4 y[4], h[4], uo[4]; load_row_bf16((const bf16_t*)Y + (size_t)row * D, lane, y); load_row(hp, lane, h);
            const float rstd = __builtin_amdgcn_rsqf(row_ssq(y) * (1.0f / D) + EPS);
#pragma unroll
            for (int j = 0; j < 4; ++j) { const int c = 4 * lane + 256 * j; const f32x4 g = *(const f32x4*)(normg + 3 * D + c), mg = *(const f32x4*)(MV(0, b, 5) + c);
                h[j] = h[j] + mg * (y[j] * rstd * g); *(f32x4*)(hp + c) = h[j]; }
            norm_mod_store(h, normg + 4 * D, MV(1, b, 0), MV(1, b, 1), U + (size_t)row * D, lane, uo);
        }
    }
    SEAM(10);

    if (IN(11)) {
        pg8::DenseProb P{U, wsp<bf16_t>(F, O_WIN1), 1024, 1024, 1024, {}}; P.ord.init(R / 256, N_IN1 / 256, F.G, (int)blockIdx.x);
        pg8::EpiIn1 E{wsp<bf16_t>(F, O_QK1), wsp<bf16_t>(F, O_V1), wsp<bf16_t>(F, O_G1), wsp<bf16_t>(F, O_RR)};
        pg8::gemm_phase(F.lds, P, E);
    }
    SEAM(11);

    if (IN(12)) {
        const bf16_t* QK1 = wsp<bf16_t>(F, O_QK1); const bf16_t* V1 = wsp<bf16_t>(F, O_V1); const bf16_t* RRp = wsp<bf16_t>(F, O_RR);
        bf16_t* QDd[2] = {wsp<bf16_t>(F, O_QDF), wsp<bf16_t>(F, O_QDB)}; bf16_t* KId[2] = {wsp<bf16_t>(F, O_KIF), wsp<bf16_t>(F, O_KIB)}; bf16_t* KTd[2] = {wsp<bf16_t>(F, O_KTF), wsp<bf16_t>(F, O_KTB)};
        bf16_t* VT = wsp<bf16_t>(F, O_VT); float* ECL = wsp<float>(F, O_ECL);
        LAS float* tot = (LAS float*)F.lds;
        const int dkp = tid & 63, dk0 = 2 * dkp, tq = tid >> 6;
        int hh_loaded = -1; float w2[2][16][2], bg[2][2];
        for (int item = F.vcu; item < 544 * 4; item += F.G) {
            const int rc = item >> 2, hh = item & 3, row0 = rc * 32;
            if (hh != hh_loaded) {
                hh_loaded = hh;
#pragma unroll
                for (int d = 0; d < 2; ++d) { const f32x2_t bv = *(const f32x2_t*)(args.in[I_GBGATE] + d * 512 + hh * 128 + dk0); bg[d][0] = bv[0]; bg[d][1] = bv[1];
#pragma unroll
                    for (int j = 0; j < 16; ++j) { const f32x2_t wv = *(const f32x2_t*)(args.in[I_GGATE2] + (size_t)(d * 16 + j) * 512 + hh * 128 + dk0); w2[d][j][0] = wv[0]; w2[d][j][1] = wv[1]; } }
            }
            float a[2][4][2];
#pragma unroll
            for (int i = 0; i < 4; ++i) { const int row = row0 + 4 * tq + i;
                const u32x4* rp = (const u32x4*)(RRp + (size_t)row * 256);
#pragma unroll
                for (int d = 0; d < 2; ++d) { const u32x4 r0 = rp[2 * d], r1 = rp[2 * d + 1];
                    const float rv[16] = {bflo(r0.x), bfhi(r0.x), bflo(r0.y), bfhi(r0.y), bflo(r0.z), bfhi(r0.z), bflo(r0.w), bfhi(r0.w), bflo(r1.x), bfhi(r1.x), bflo(r1.y), bfhi(r1.y), bflo(r1.z), bfhi(r1.z), bflo(r1.w), bfhi(r1.w)};
#pragma unroll
                    for (int c = 0; c < 2; ++c) { float z = bg[d][c];
#pragma unroll
                        for (int j = 0; j < 16; ++j) z += rv[j] * w2[d][j][c];
                        a[d][i][c] = (fminf(z, 0.f) - __logf(1.0f + __expf(-fabsf(z)))) * (1.0f / 16.0f); } } }
            float cf[4][2], sb[4][2];
#pragma unroll
            for (int c = 0; c < 2; ++c) { float sfw = 0.f;
#pragma unroll
                for (int i = 0; i < 4; ++i) { sfw += a[0][i][c]; cf[i][c] = sfw; }
                float sbw = 0.f;
#pragma unroll
                for (int i = 3; i >= 0; --i) { sbw += a[1][i][c]; sb[i][c] = sbw; } }
            *(LAS f32x2_t*)(tot + (0 * 8 + tq) * 128 + dk0) = (f32x2_t){cf[3][0], cf[3][1]};
            *(LAS f32x2_t*)(tot + (1 * 8 + tq) * 128 + dk0) = (f32x2_t){sb[0][0], sb[0][1]};
            __syncthreads();
            float offF[2] = {0.f, 0.f}, offB[2] = {0.f, 0.f}, clF[2] = {0.f, 0.f}, clB[2] = {0.f, 0.f};
#pragma unroll
            for (int g = 0; g < 8; ++g) { const f32x2_t tf = *(const LAS f32x2_t*)(tot + (0 * 8 + g) * 128 + dk0), tb = *(const LAS f32x2_t*)(tot + (1 * 8 + g) * 128 + dk0);
#pragma unroll
                for (int c = 0; c < 2; ++c) { clF[c] += tf[c]; clB[c] += tb[c]; if (g < tq) offF[c] += tf[c]; if (g > tq) offB[c] += tb[c]; } }
            __syncthreads();
            const int pc = hh * 128 + (dk0 & ~31) + sig5(dk0 & 31);
#pragma unroll
            for (int i = 0; i < 4; ++i) { const int row = row0 + 4 * tq + i;
                const unsigned qw = *(const unsigned*)(QK1 + (size_t)row * D + hh * 128 + dk0), kw = *(const unsigned*)(QK1 + (size_t)row * D + 512 + hh * 128 + dk0);
                const float q[2] = {bflo(qw), bfhi(qw)}, k[2] = {bflo(kw), bfhi(kw)};
                float qdv[2][2], kiv[2][2];
#pragma unroll
                for (int c = 0; c < 2; ++c) { const float cF = offF[c] + cf[i][c], cB = offB[c] + sb[i][c];
                    qdv[0][c] = q[c] * __expf(cF); kiv[0][c] = k[c] * __expf(-cF); qdv[1][c] = q[c] * __expf(cB); kiv[1][c] = k[c] * __expf(-cB); }
#pragma unroll
                for (int d = 0; d < 2; ++d) {
                    *(unsigned*)(QDd[d] + (size_t)row * 512 + pc) = cvtpk(qdv[d][0], qdv[d][1]);
                    const unsigned kp = cvtpk(kiv[d][0], kiv[d][1]);
                    *(unsigned*)(KId[d] + (size_t)row * 512 + pc) = kp;
                } }
            if (tq == 0) { *(f32x2_t*)(ECL + ((size_t)(rc * 2 + 0) * 4 + hh) * 256 + dk0) = (f32x2_t){__expf(clF[0]), __expf(clF[1])};
                           *(f32x2_t*)(ECL + ((size_t)(rc * 2 + 1) * 4 + hh) * 256 + dk0) = (f32x2_t){__expf(clB[0]), __expf(clB[1])}; }
            { const int dv = tid & 255, th = tid >> 8; unsigned vw[8];
#pragma unroll
              for (int i = 0; i < 16; ++i) { const unsigned bv = V1[(size_t)(row0 + 16 * th + i) * D + hh * 256 + dv];
                  const int cc = sig5(i);
                  if (cc & 1) vw[cc >> 1] |= bv << 16; else vw[cc >> 1] = bv; }
              bf16_t* vp = VT + ((size_t)rc * 1024 + hh * 256 + dv) * 32 + 16 * th;
              u32x4 o0; o0.x = vw[0]; o0.y = vw[1]; o0.z = vw[2]; o0.w = vw[3]; *(u32x4*)vp = o0;
              u32x4 o1; o1.x = vw[4]; o1.y = vw[5]; o1.z = vw[6]; o1.w = vw[7]; *(u32x4*)(vp + 8) = o1; }
        }
    }
    SEAM(12);

    if (IN(13)) {
        const int xl = blockIdx.x & 7, jj = blockIdx.x >> 3;
        const bool scan_role = (jj & 1) == 0;
        const int nscan = ((F.G >> 3) + 1) / 2 * 8, nconv = F.G - nscan;
        if ((F.G & 7) == 0 && nconv > 0 && !scan_role) {
            LAS float* scr = (LAS float*)(F.lds + wave * 16640);
            const int cidx = xl * (F.G >> 4) + (jj >> 1); int base = 0; const int gwi = cidx * 8 + wave, ngw = nconv * 8;
            for (int e = 0; e < NEXP; ++e) {
                conv64_run(Conv64{args.in[I_MWG] + (size_t)e * D * EXD, args.in[I_MWU] + (size_t)e * D * EXD, EXD, 1024, N_GU1, wsp<bf16_t>(F, O_WGU1) + (size_t)e * N_GU1 * 1024 / 2, 3, 0, 0, 64.0f, 1}, scr, lane, gwi, ngw, base);
                conv64_run(Conv64{args.in[I_MWD] + (size_t)e * EXD * D, nullptr, 1024, EXD, 1024, wsp<bf16_t>(F, O_WD1) + (size_t)e * 1024 * EXD / 2, 0, 1024, 1024, 64.0f, 1}, scr, lane, gwi, ngw, base);
            }
        } else {
        const bool split = (F.G & 7) == 0 && nconv > 0;
        const int sidx = split ? xl * ((F.G >> 4) + ((F.G >> 3) & 1)) + (jj >> 1) : F.vcu, nsw = split ? nscan : F.G;
        const bf16_t* VT = wsp<bf16_t>(F, O_VT); const float* ECL = wsp<float>(F, O_ECL);
        constexpr int SLOT = 8192 * 2 + 2 * 2048 + 1024;
        const int r32 = lane & 31, hi = lane >> 5;
        for (int unit = sidx; unit < 128; unit += nsw) {
            const int chain = unit >> 2, dvp = unit & 3, b = chain >> 3, hh = (chain >> 1) & 3, dir = chain & 1;
            const int dvb = dvp * 2 + (wave & 1);
            const bf16_t* QDp = wsp<bf16_t>(F, dir ? O_QDB : O_QDF); const bf16_t* KIp = wsp<bf16_t>(F, dir ? O_KIB : O_KIF);
            bf16_t* Odp = wsp<bf16_t>(F, dir ? O_OB : O_OF);
            auto rcof = [&](int step) { return step < 8 ? 512 + b * 8 + (dir ? 7 - step : step) : b * 128 + (dir ? 127 - (step - 8) : (step - 8)); };
            const unsigned lds0 = (unsigned)(size_t)F.lds;
            auto dma = [&](int step, int slot) {
                if (wave < 2) return;
                const int rc = rcof(step); const unsigned sb = lds0 + slot * SLOT;
#pragma unroll
                for (int i = 0; i < 4; ++i) { const int j = (wave - 2) + 6 * i; if (j >= 21) break;
                    if (j < 16) { const int p = j & 7; const int r = 4 * p + (lane >> 4), c = (lane & 15) ^ (r & 15);
                        glds16((j < 8 ? KIp : QDp) + (size_t)(rc * 32 + r) * 512 + hh * 128 + c * 8, (unsigned)__builtin_amdgcn_readfirstlane(sb + j * 1024)); }
                    else if (j < 20) { const int p = j - 16; const int r = 16 * (p & 1) + (lane >> 2), c = (lane & 3) ^ ((r >> 2) & 3);
                        glds16(VT + ((size_t)rc * 1024 + hh * 256 + (dvp * 2 + (p >> 1)) * 32 + r) * 32 + c * 8, (unsigned)__builtin_amdgcn_readfirstlane(sb + 16384 + p * 1024)); }
                    else glds16(ECL + ((size_t)(rc * 2 + dir) * 4 + hh) * 256 + lane * 4, (unsigned)__builtin_amdgcn_readfirstlane(sb + 20480)); }
            };
            auto wait_bar = [&](int ngrp) { if (wave < 2) { asm volatile("s_waitcnt lgkmcnt(0)\n\ts_barrier" ::: "memory"); }
                else if (ngrp == 0) { WAIT_BAR(0); } else if (ngrp == 1) { if (wave < 5) { WAIT_BAR(4); } else { WAIT_BAR(3); } } else { if (wave < 5) { WAIT_BAR(8); } else { WAIT_BAR(6); } } };
            f32x16 S4[4];
#pragma unroll
            for (int k = 0; k < 4; ++k)
#pragma unroll
                for (int r = 0; r < 16; ++r) S4[k][r] = 0.f;
            dma(0, 0); dma(1, 1); dma(2, 2);
            wait_bar(2);
            int slot = 0;
            for (int step = 0; step < 136; ++step) {
                if (step + 3 < 136) dma(step + 3, (slot + 3) & 3);
                if (wave < 2) {
                    const LAS unsigned char* sb = F.lds + slot * SLOT;
                    const int x15 = r32 & 15, x3 = (r32 >> 2) & 3;
                    const int trq = (lane & 15) >> 2, trp = lane & 3, trpp = ((trp & 1) << 1) | (trp >> 1), trg = (lane >> 4) & 1;
                    const LAS unsigned char* vbase = sb + 16384 + wave * 2048;
                    bf16x8 qdF[8], kiF[8];
#pragma unroll
                    for (int k = 0; k < 8; ++k) { qdF[k] = *(const LAS bf16x8*)(sb + 8192 + r32 * 256 + (((2 * k + hi) ^ x15) << 4)); kiF[k] = *(const LAS bf16x8*)(sb + r32 * 256 + (((2 * k + hi) ^ x15) << 4)); }
                    const bf16x8 vF0 = *(const LAS bf16x8*)(vbase + r32 * 64 + ((hi ^ x3) << 4)), vF1 = *(const LAS bf16x8*)(vbase + r32 * 64 + (((2 + hi) ^ x3) << 4));
                    __builtin_amdgcn_sched_barrier(0);
                    f32x16 o;
#pragma unroll
                    for (int r = 0; r < 16; ++r) o[r] = 0.f;
                    if (step >= 8) {
                        f32x16 sc;
#pragma unroll
                        for (int r = 0; r < 16; ++r) sc[r] = 0.f;
#pragma unroll
                        for (int k = 0; k < 8; ++k) sc = __builtin_amdgcn_mfma_f32_32x32x16_bf16(kiF[k], qdF[k], sc, 0, 0, 0);
#pragma unroll
                        for (int r = 0; r < 16; ++r) { const int s = (r & 3) + 8 * (r >> 2) + 4 * hi; const bool keep = dir ? (s >= r32) : (s <= r32); sc[r] = keep ? sc[r] : 0.f; }
                        u32x4 w; bf16x8 pf0, pf1;
                        w.x = cvtpk(sc[0], sc[1]); w.y = cvtpk(sc[2], sc[3]); w.z = cvtpk(sc[4], sc[5]); w.w = cvtpk(sc[6], sc[7]); pf0 = __builtin_bit_cast(bf16x8, w);
                        w.x = cvtpk(sc[8], sc[9]); w.y = cvtpk(sc[10], sc[11]); w.z = cvtpk(sc[12], sc[13]); w.w = cvtpk(sc[14], sc[15]); pf1 = __builtin_bit_cast(bf16x8, w);
                        o = __builtin_amdgcn_mfma_f32_32x32x16_bf16(vF0, pf0, o, 0, 0, 0);
                        o = __builtin_amdgcn_mfma_f32_32x32x16_bf16(vF1, pf1, o, 0, 0, 0);
#pragma unroll
                        for (int blk = 0; blk < 4; ++blk)
#pragma unroll
                            for (int s2 = 0; s2 < 2; ++s2) { u32x4 ws4; ws4.x = cvtpk(S4[blk][8 * s2], S4[blk][8 * s2 + 1]); ws4.y = cvtpk(S4[blk][8 * s2 + 2], S4[blk][8 * s2 + 3]);
                                ws4.z = cvtpk(S4[blk][8 * s2 + 4], S4[blk][8 * s2 + 5]); ws4.w = cvtpk(S4[blk][8 * s2 + 6], S4[blk][8 * s2 + 7]);
                                o = __builtin_amdgcn_mfma_f32_32x32x16_bf16(__builtin_bit_cast(bf16x8, ws4), qdF[2 * blk + s2], o, 0, 0, 0); }
                        const int rc = rcof(step);
                        bf16_t* op = Odp + (size_t)(rc * 32 + r32) * D + hh * 256 + dvb * 32 + 4 * hi;
#pragma unroll
                        for (int g = 0; g < 4; ++g) { u32x2 w2; w2.x = cvtpk(o[4 * g], o[4 * g + 1]); w2.y = cvtpk(o[4 * g + 2], o[4 * g + 3]); *(u32x2*)(op + 8 * g) = w2; }
                    }
#pragma unroll
                    for (int blk = 0; blk < 4; ++blk) {
                        bf16x8 kt0, kt1;
                        { const int chunk = 4 * blk + 2 * trg + (trpp >> 1); const int wb = (trpp & 1) * 8;
                          const int tl = 4 * hi + trq, th = tl + 8;
                          const LAS unsigned char* pl = sb + tl * 256 + ((chunk ^ tl) << 4) + wb; const LAS unsigned char* ph = sb + th * 256 + ((chunk ^ th) << 4) + wb;
                          const s16x4 a0 = vtr(pl), a1 = vtr(ph), b0 = vtr(pl + 4096), b1 = vtr(ph + 4096);
                          kt0 = (bf16x8){a0[0], a0[1], a0[2], a0[3], a1[0], a1[1], a1[2], a1[3]}; kt1 = (bf16x8){b0[0], b0[1], b0[2], b0[3], b1[0], b1[1], b1[2], b1[3]}; }
                        S4[blk] = __builtin_amdgcn_mfma_f32_32x32x16_bf16(kt0, vF0, S4[blk], 0, 0, 0);
                        S4[blk] = __builtin_amdgcn_mfma_f32_32x32x16_bf16(kt1, vF1, S4[blk], 0, 0, 0);
#pragma unroll
                        for (int g = 0; g < 4; ++g) { const f32x4 e4 = *(const LAS f32x4*)(sb + 20480 + (32 * blk + 8 * g + 4 * hi) * 4);
                            S4[blk][4 * g] *= e4[0]; S4[blk][4 * g + 1] *= e4[1]; S4[blk][4 * g + 2] *= e4[2]; S4[blk][4 * g + 3] *= e4[3]; }
                    }
                }
                wait_bar(step + 3 < 136 ? 2 : (step + 2 < 136 ? 1 : 0));
                slot = (slot + 1) & 3;
            }
        }
        if (!split) {
            LAS float* scr = (LAS float*)(F.lds + wave * 16640); int base = 0;
            for (int e = 0; e < NEXP; ++e) {
                conv64_run(Conv64{args.in[I_MWG] + (size_t)e * D * EXD, args.in[I_MWU] + (size_t)e * D * EXD, EXD, 1024, N_GU1, wsp<bf16_t>(F, O_WGU1) + (size_t)e * N_GU1 * 1024 / 2, 3, 0, 0, 64.0f, 1}, scr, lane, gw, NGW, base);
                conv64_run(Conv64{args.in[I_MWD] + (size_t)e * EXD * D, nullptr, 1024, EXD, 1024, wsp<bf16_t>(F, O_WD1) + (size_t)e * 1024 * EXD / 2, 0, 1024, 1024, 64.0f, 1}, scr, lane, gw, NGW, base);
            }
        }
        }
    }
    SEAM(13);

    if (IN(14)) {
        const bf16_t* OFp = wsp<bf16_t>(F, O_OF); const bf16_t* OBp = wsp<bf16_t>(F, O_OB); const bf16_t* G1 = wsp<bf16_t>(F, O_G1); bf16_t* GA = wsp<bf16_t>(F, O_GA);
        const float* on = args.in[I_GONORM];
        for (int row = gw; row < RL; row += NGW) {
            const u32x4* pf = (const u32x4*)(OFp + (size_t)row * D + lane * 16); const u32x4* pb = (const u32x4*)(OBp + (size_t)row * D + lane * 16); const u32x4* pg = (const u32x4*)(G1 + (size_t)row * D + lane * 16);
            float v[16], gv[16];
#pragma unroll
            for (int q = 0; q < 2; ++q) { const u32x4 a = pf[q], bq = pb[q], gq = pg[q]; const unsigned aw[4] = {a.x, a.y, a.z, a.w}, bw[4] = {bq.x, bq.y, bq.z, bq.w}, gw4[4] = {gq.x, gq.y, gq.z, gq.w};
#pragma unroll
                for (int j = 0; j < 4; ++j) { v[8 * q + 2 * j] = bflo(aw[j]) + bflo(bw[j]); v[8 * q + 2 * j + 1] = bfhi(aw[j]) + bfhi(bw[j]); gv[8 * q + 2 * j] = bflo(gw4[j]); gv[8 * q + 2 * j + 1] = bfhi(gw4[j]); } }
            float ss = 0.f;
#pragma unroll
            for (int j = 0; j < 16; ++j) ss += v[j] * v[j];
            ss += __shfl_xor(ss, 1); ss += __shfl_xor(ss, 2); ss += __shfl_xor(ss, 4); ss += __shfl_xor(ss, 8);
            const float rstd = __builtin_amdgcn_rsqf(ss * (1.0f / 256.0f) + EPS);
            const int c0 = (lane & 15) * 16;
            unsigned ow[8];
#pragma unroll
            for (int j = 0; j < 8; ++j) { const float a = v[2 * j] * rstd * on[c0 + 2 * j] * silu_f(gv[2 * j]), bq = v[2 * j + 1] * rstd * on[c0 + 2 * j + 1] * silu_f(gv[2 * j + 1]); ow[j] = cvtpk(a, bq); }
            u32x4* po = (u32x4*)(GA + (size_t)row * D + lane * 16);
            u32x4 o0; o0.x = ow[0]; o0.y = ow[1]; o0.z = ow[2]; o0.w = ow[3]; po[0] = o0; u32x4 o1; o1.x = ow[4]; o1.y = ow[5]; o1.z = ow[6]; o1.w = ow[7]; po[1] = o1;
        }
    }
    SEAM(14);

    if (IN(15)) {
        pg8::DenseProb P{wsp<bf16_t>(F, O_GA), wsp<bf16_t>(F, O_WOUT1), 1024, 1024, 1024, {}}; P.ord.init(RL / 256, 4, F.G, (int)blockIdx.x);
        pg8::EpiBf16 E{(bf16_t*)Y, D, nullptr};
        pg8::gemm_phase(F.lds, P, E);
    }
    SEAM(15);

    if (IN(16)) {
        int* SEL = wsp<int>(F, O_SEL); int* ROWTOK = wsp<int>(F, O_ROWTOK);
        LAS float* wr_l = (LAS float*)F.lds;
        LAS int* se = (LAS int*)(F.lds + 32768);
        LAS float* sw = (LAS float*)(F.lds + 32768 + 512);
        LAS int* sbase = (LAS int*)(F.lds + 32768 + 1024);
        for (int i = tid; i < 8192; i += 512) wr_l[i] = args.in[I_MROUTER][i];
        __syncthreads();
        for (int tile = F.vcu; tile < RL / 64; tile += F.G) {
            for (int rr = 0; rr < 8; ++rr) {
                const int lr = wave * 8 + rr, row = tile * 64 + lr; const int b = row >> 12;
                float* hp = args.out + (size_t)row * D;
                f32x4 y[4], h[4], uo[4]; load_row_bf16((const bf16_t*)Y + (size_t)row * D, lane, y); load_row(hp, lane, h);
                const float rstd = __builtin_amdgcn_rsqf(row_ssq(y) * (1.0f / D) + EPS);
#pragma unroll
                for (int j = 0; j < 4; ++j) { const int c = 4 * lane + 256 * j; const f32x4 g = *(const f32x4*)(normg + 5 * D + c), mg = *(const f32x4*)(MV(1, b, 2) + c);
                    h[j] = h[j] + mg * (y[j] * rstd * g); *(f32x4*)(hp + c) = h[j]; }
                norm_mod_store(h, normg + 6 * D, MV(1, b, 3), MV(1, b, 4), nullptr, lane, uo, wsp<unsigned char>(F, O_U) + (size_t)row * D);
                float lg[8];
#pragma unroll
                for (int e = 0; e < 8; ++e) lg[e] = 0.f;
#pragma unroll
                for (int j = 0; j < 4; ++j)
#pragma unroll
                    for (int q = 0; q < 4; ++q) { const int k = 4 * lane + 256 * j + q; const LAS f32x4* wp = (const LAS f32x4*)(wr_l + k * 8); const f32x4 w0 = wp[0], w1 = wp[1]; const float uv = uo[j][q];
                        lg[0] += uv * w0[0]; lg[1] += uv * w0[1]; lg[2] += uv * w0[2]; lg[3] += uv * w0[3]; lg[4] += uv * w1[0]; lg[5] += uv * w1[1]; lg[6] += uv * w1[2]; lg[7] += uv * w1[3]; }
#pragma unroll
                for (int e = 0; e < 8; ++e) lg[e] = wave_sum(lg[e]) + args.in[I_MBROUTER][e];
                int e0 = 0; float l0 = lg[0];
#pragma unroll
                for (int e = 1; e < 8; ++e) if (lg[e] > l0) { l0 = lg[e]; e0 = e; }
                int e1 = -1; float l1 = -3.0e38f;
#pragma unroll
                for (int e = 0; e < 8; ++e) if (e != e0 && lg[e] > l1) { l1 = lg[e]; e1 = e; }
                const float p1 = __expf(l1 - l0), w0n = 1.0f / (1.0f + p1), w1n = p1 / (1.0f + p1);
                if (lane == 0) { se[lr * 2] = e0; se[lr * 2 + 1] = e1; sw[lr * 2] = w0n; sw[lr * 2 + 1] = w1n; }
            }
            __syncthreads();
            if (tid < 8) { int c = 0; for (int r2 = 0; r2 < 64; ++r2) c += (se[2 * r2] == tid) + (se[2 * r2 + 1] == tid);
                sbase[tid] = (int)__hip_atomic_fetch_add(ctl + CW_CNT + 64 * tid, (unsigned)c, RLX_AGENT); }
            __syncthreads();
            if (tid < 64) { const int e0 = se[2 * tid], e1 = se[2 * tid + 1]; int r0 = 0, r1 = 0;
                for (int r2 = 0; r2 < tid; ++r2) { const int a0 = se[2 * r2], a1 = se[2 * r2 + 1]; r0 += (a0 == e0) + (a1 == e0); r1 += (a0 == e1) + (a1 == e1); }
                const int p0 = sbase[e0] + r0, p1 = sbase[e1] + r1, tok = tile * 64 + tid;
                ROWTOK[e0 * CAPE + p0] = tok; ROWTOK[e1 * CAPE + p1] = tok;
                int* sp = SEL + (size_t)tok * 8; sp[0] = e0; sp[1] = p0; sp[2] = e1; sp[3] = p1; sp[4] = __float_as_int(sw[2 * tid]); sp[5] = __float_as_int(sw[2 * tid + 1]); }
            __syncthreads();
        }
    }
    SEAM(16);

    pg8::MoeTiles MT;
    if (IN(17) || IN(18) || IN(19)) {
        int acc = 0; MT.tp8 = 0ull; MT.c4a = 0ull; MT.c4b = 0ull;
#pragma unroll
        for (int e = 0; e < 8; ++e) { const int c = (int)__builtin_amdgcn_readfirstlane((int)__hip_atomic_load(ctl + CW_CNT + 64 * e, RLX_AGENT));
            if (e < 4) MT.c4a |= (unsigned long long)(unsigned)c << (16 * e); else MT.c4b |= (unsigned long long)(unsigned)c << (16 * (e - 4));
            MT.tp8 |= (unsigned long long)(unsigned)acc << (8 * e); acc += (c + 255) >> 8; }
        MT.nt = acc;
    }
    if (IN(17)) {
        pg8::MoeGuProb P{wsp<unsigned char>(F, O_U), wsp<unsigned char>(F, O_WGU1), 512, 512, {}, MT, wsp<int>(F, O_ROWTOK)}; P.ord.init(MT.nt, N_GU1 / 256, F.G, (int)blockIdx.x);
        pg8::EpiSwiglu8 E{wsp<unsigned char>(F, O_HM), EXD};
        pg8::gemm_phase(F.lds, P, E);
    }
    SEAM(17);
    if (IN(18)) {
        pg8::MoeDnProb P{wsp<unsigned char>(F, O_HM), wsp<unsigned char>(F, O_WD1), EXD / 2, EXD / 2, {}, MT}; P.ord.init(MT.nt, 4, F.G, (int)blockIdx.x);
        pg8::EpiBf16 E{wsp<bf16_t>(F, O_YE), D, nullptr};
        pg8::gemm_phase(F.lds, P, E);
    }
    SEAM(18);
    if (IN(19)) {
        const int* SEL = wsp<int>(F, O_SEL); const bf16_t* YE = wsp<bf16_t>(F, O_YE);
        for (int row = gw; row < RL; row += NGW) {
            const int b = row >> 12; const int* sp = SEL + (size_t)row * 8;
            const int e0 = sp[0], p0 = sp[1], e1 = sp[2], p1 = sp[3]; const float w0 = __int_as_float(sp[4]), w1 = __int_as_float(sp[5]);
            const int t0 = pg8::moe_tp(MT, e0), t1 = pg8::moe_tp(MT, e1);
            const bf16_t* y0 = YE + ((size_t)t0 * 256 + p0) * D; const bf16_t* y1 = YE + ((size_t)t1 * 256 + p1) * D;
            float* hp = args.out + (size_t)row * D;
            f32x4 y[4], h[4]; load_row(hp, lane, h);
#pragma unroll
            for (int j = 0; j < 4; ++j) { const int c = 4 * lane + 256 * j; const u32x2 a = *(const u32x2*)(y0 + c), bq = *(const u32x2*)(y1 + c);
                y[j][0] = w0 * bflo(a.x) + w1 * bflo(bq.x); y[j][1] = w0 * bfhi(a.x) + w1 * bfhi(bq.x); y[j][2] = w0 * bflo(a.y) + w1 * bflo(bq.y); y[j][3] = w0 * bfhi(a.y) + w1 * bfhi(bq.y); }
            const float rstd = __builtin_amdgcn_rsqf(row_ssq(y) * (1.0f / D) + EPS);
#pragma unroll
            for (int j = 0; j < 4; ++j) { const int c = 4 * lane + 256 * j; const f32x4 g = *(const f32x4*)(normg + 7 * D + c), mg = *(const f32x4*)(MV(1, b, 5) + c);
                *(f32x4*)(hp + c) = h[j] + mg * (y[j] * rstd * g); }
        }
    }
#undef IN
#undef SEAM
#undef MV
}

constexpr int N_PHASES = 20;
extern "C" void kernel_launch(void* const* d_in, const int* in_sizes, int n_in, void* d_out, int out_size, void* d_ws, size_t ws_size, hipStream_t stream) {
    static int grid = 0;
    if (grid == 0) {
        if (n_in != 27 || out_size != RL * D || ws_size < WS_END) { fprintf(stderr, "kernel_launch: unexpected shapes n_in %d out %d ws %zu (need %zu)\n", n_in, out_size, ws_size, (size_t)WS_END); grid = -1; return; }
        int dev = 0, cus = 0, per_cu = 0;
        if (hipGetDevice(&dev) != hipSuccess || hipDeviceGetAttribute(&cus, hipDeviceAttributeMultiprocessorCount, dev) != hipSuccess) { grid = -1; return; }
        if (hipFuncSetAttribute((const void*)mk_fwd, hipFuncAttributeMaxDynamicSharedMemorySize, LDS_BYTES) != hipSuccess) { fprintf(stderr, "kernel_launch: hipFuncSetAttribute failed\n"); grid = -1; return; }
        if (hipOccupancyMaxActiveBlocksPerMultiprocessor(&per_cu, (const void*)mk_fwd, 512, LDS_BYTES) != hipSuccess || per_cu < 1) { fprintf(stderr, "kernel_launch: occupancy query says %d\n", per_cu); }
        (void)hipGetLastError();
        grid = cus;
        if (grid > 256) grid = 256;
    }
    if (grid < 0) return;
    (void)hipMemsetAsync((char*)d_ws + O_CTL, 0, CTL_BYTES, stream);
    Args a{};
    for (int i = 0; i < 27; ++i) a.in[i] = (const float*)d_in[i];
    a.out = (float*)d_out; a.ws = (unsigned char*)d_ws;
#if MK_ONE_LAUNCH
    a.ph_lo = 0; a.ph_hi = N_PHASES;
    hipLaunchKernelGGL(mk_fwd, dim3(grid), dim3(512), LDS_BYTES, stream, a);
#else
    for (int p = 0; p < N_PHASES; ++p) { a.ph_lo = p; a.ph_hi = p + 1; for (int rep = 0; rep < (p == MK_REP ? 2 : 1); ++rep) hipLaunchKernelGGL(mk_fwd, dim3(grid), dim3(512), LDS_BYTES, stream, a); }
#endif
}
```

```cpp
#include <hip/hip_runtime.h>
#include <cstdio>
#include <cstdint>

#ifndef MK_ONE_LAUNCH
#define MK_ONE_LAUNCH 1
#endif
#ifndef MK_EPI2
#define MK_EPI2 0
#endif
#ifndef MK_REP
#define MK_REP -1
#endif

#define LAS __attribute__((address_space(3)))
#define GAS __attribute__((address_space(1)))
typedef unsigned short bf16_t;
typedef short bf16x8 __attribute__((ext_vector_type(8)));
typedef short s16x4 __attribute__((ext_vector_type(4)));
typedef float f32x4 __attribute__((ext_vector_type(4)));
typedef float f32x16 __attribute__((ext_vector_type(16)));
typedef unsigned u32x4 __attribute__((ext_vector_type(4)));
typedef unsigned u32x2 __attribute__((ext_vector_type(2)));
typedef float f32x2_t __attribute__((ext_vector_type(2)));
typedef __bf16 bf16x2_t __attribute__((ext_vector_type(2)));
#define RLX_AGENT __ATOMIC_RELAXED, __HIP_MEMORY_SCOPE_AGENT

__device__ __forceinline__ unsigned cvtpk(float lo, float hi) { f32x2_t v = {lo, hi}; bf16x2_t b = __builtin_convertvector(v, bf16x2_t); return __builtin_bit_cast(unsigned, b); }
__device__ __forceinline__ bf16_t f2bf(float f) { return (bf16_t)(cvtpk(f, 0.f) & 0xffffu); }
__device__ __forceinline__ float bflo(unsigned w) { return __uint_as_float(w << 16); }
__device__ __forceinline__ float bfhi(unsigned w) { return __uint_as_float(w & 0xffff0000u); }
__device__ __forceinline__ float bf2f(bf16_t b) { return __uint_as_float(((unsigned)b) << 16); }
__device__ __forceinline__ float wave_sum(float v) {
#pragma unroll
    for (int o = 1; o < 64; o <<= 1) v += __shfl_xor(v, o);
    return v;
}
__device__ __forceinline__ float fast_exp(float x) { return __builtin_amdgcn_exp2f(x * 1.4426950408889634f); }
__device__ __forceinline__ float clamp8(float x) { return __builtin_amdgcn_fmed3f(x, -448.0f, 448.0f); }
__device__ __forceinline__ unsigned pack_fp8x4(float a, float b, float c, float d) { int w = __builtin_amdgcn_cvt_pk_fp8_f32(clamp8(a), clamp8(b), 0, false); w = __builtin_amdgcn_cvt_pk_fp8_f32(clamp8(c), clamp8(d), w, true); return (unsigned)w; }
__device__ __forceinline__ float silu_f(float g) { return g * __builtin_amdgcn_rcpf(1.0f + fast_exp(-g)); }

#define XB_TMO      128
#define XB_XCNT(j)  (256  + 64 * (j))
#define XB_XSUB(j)  (1280 + 64 * (j))
#define XB_XGEN(j)  (2304 + 64 * (j))
#define XB_TOP      3328
#define XB_TOPGEN   3392
#define XCD_BAR_WORDS 3456
#define XB_SPIN_CAP (1u << 18)
__device__ __forceinline__ unsigned xb_ld(unsigned* p)              { return __hip_atomic_load(p, __ATOMIC_RELAXED, __HIP_MEMORY_SCOPE_AGENT); }
__device__ __forceinline__ unsigned xb_add(unsigned* p, unsigned v) { return __hip_atomic_fetch_add(p, v, __ATOMIC_RELAXED, __HIP_MEMORY_SCOPE_AGENT); }
__device__ __forceinline__ unsigned xb_xcc_id() { return (unsigned)__builtin_amdgcn_s_getreg((3 << 11) | 20) & 0xFu; }
#define XB_SPIN(cond, bar) do { unsigned _sp = 0; while (cond) { __builtin_amdgcn_s_sleep(1); \
    if ((++_sp & 255u) == 0u) { if (xb_ld(&(bar)[XB_TMO])) break; if (_sp > XB_SPIN_CAP) { atomicAdd(&(bar)[XB_TMO], 1u); break; } } } } while (0)
struct XcdBarrier { unsigned* bar; unsigned x; volatile LAS unsigned* st; };
__device__ __forceinline__ XcdBarrier xcd_barrier_post(unsigned* bar, volatile LAS unsigned* st) {
    XcdBarrier b; b.bar = bar; b.x = xb_xcc_id(); b.st = st;
    if (threadIdx.x == 0) (void)xb_add(&bar[XB_XCNT(b.x)], 1u);
    return b;
}
__device__ __forceinline__ void xcd_barrier_complete(unsigned* bar, unsigned x, unsigned& nloc, unsigned& nx) {
    const unsigned G = gridDim.x * gridDim.y * gridDim.z;
    unsigned sum, cnt, mine, sp = 0u;
    for (;;) {
        sum = 0u; cnt = 0u; mine = 0u;
#pragma unroll
        for (unsigned j = 0; j < 16; ++j) { const unsigned c = xb_ld(&bar[XB_XCNT(j)]); sum += c; cnt += (c > 0u) ? 1u : 0u; mine = (j == x) ? c : mine; }
        if (sum == G) break;
        __builtin_amdgcn_s_sleep(1);
        if ((++sp & 255u) == 0u) { if (xb_ld(&bar[XB_TMO])) break; if (sp > XB_SPIN_CAP) { atomicAdd(&bar[XB_TMO], 1u); break; } }
    }
    nloc = mine > 0u ? mine : 1u; nx = cnt > 0u ? cnt : 1u;
}
__device__ __forceinline__ void xcd_barrier(const XcdBarrier& b) {
    asm volatile("s_waitcnt vmcnt(0)" ::: "memory");
    __syncthreads();
    if (threadIdx.x == 0) {
        unsigned* bar = b.bar;
        __builtin_amdgcn_s_waitcnt(0);
        unsigned nloc = b.st[0], nx = b.st[1];
        if (nloc == 0u) { xcd_barrier_complete(bar, b.x, nloc, nx); b.st[0] = nloc; b.st[1] = nx; }
        const unsigned old = xb_add(&bar[XB_XSUB(b.x)], 1u);
        const unsigned gen = old / nloc;
        if (old + 1u == (gen + 1u) * nloc) {
            __builtin_amdgcn_fence(__ATOMIC_RELEASE, "agent");
            asm volatile("s_waitcnt vmcnt(0)" ::: "memory");
            const unsigned og = xb_add(&bar[XB_TOP], 1u);
            const unsigned tg = og / nx;
            if (og + 1u == (tg + 1u) * nx) xb_add(&bar[XB_TOPGEN], 1u);
            else XB_SPIN(xb_ld(&bar[XB_TOPGEN]) == tg, bar);
            __builtin_amdgcn_fence(__ATOMIC_ACQUIRE, "agent");
            xb_add(&bar[XB_XGEN(b.x)], 1u);
            asm volatile("s_waitcnt vmcnt(0)" ::: "memory");
        } else {
            XB_SPIN(xb_ld(&bar[XB_XGEN(b.x)]) == gen, bar);
            __builtin_amdgcn_fence(__ATOMIC_ACQUIRE, "agent");
            asm volatile("s_waitcnt vmcnt(0)" ::: "memory");
        }
    }
    __syncthreads();
}

constexpr int D = 1024, NB = 4, SEQ = 4096, CTX = 256;
constexpr int RL = NB * SEQ;
constexpr int RC = NB * CTX;
constexpr int R = RL + RC;
constexpr float EPS = 1e-6f;
constexpr float LOG2E = 1.4426950408889634f;
constexpr int N_IN0 = 1536, N_QA = 768, N_KVA = 1024, FFN = 2816, N_GU0 = 2 * FFN, N_IN1 = 3328, EXD = 3584, N_GU1 = 2 * EXD, NEXP = 8;
constexpr int CAPE = 16384;

constexpr size_t MiB = 1u << 20;
constexpr size_t O_CTL = 0;
constexpr size_t CTL_BYTES = 65536;
constexpr int CW_BAR = 0;
constexpr int CW_CNT = 8192;
constexpr size_t O_MODV = 1 * MiB;
constexpr size_t O_TAB16 = O_MODV + 256 * 1024;
constexpr size_t O_TAB32 = O_TAB16 + 8192;
constexpr size_t O_RSTDQ = O_TAB32 + 16384;
constexpr size_t O_RSTDKV = O_RSTDQ + 81920;
constexpr size_t O_SEL = 2 * MiB;
constexpr size_t O_ROWTOK = 3 * MiB;
constexpr size_t O_WGU1 = 4 * MiB;
constexpr size_t O_YE = O_WGU1;
constexpr size_t O_WD1 = 116 * MiB;
constexpr size_t O_WIN1 = 172 * MiB;
constexpr size_t O_WOUT1 = 179 * MiB;
constexpr size_t O_WIN0 = 181 * MiB;
constexpr size_t O_WUQ = 184 * MiB;
constexpr size_t O_WUKV = 185 * MiB;
constexpr size_t O_WOUT0 = 186 * MiB;
constexpr size_t O_WGU0 = 188 * MiB;
constexpr size_t O_WD0 = 199 * MiB;
constexpr size_t O_HC = 205 * MiB;
constexpr size_t O_U = 209 * MiB;
constexpr size_t O_Y = 243 * MiB;
constexpr size_t O_Z0 = 311 * MiB;
constexpr size_t O_QA = 362 * MiB;
constexpr size_t O_KVA = 388 * MiB;
constexpr size_t O_QB = 422 * MiB;
constexpr size_t O_KB = 439 * MiB;
constexpr size_t O_KR = 444 * MiB;
constexpr size_t O_AO = 446 * MiB;
constexpr size_t O_H0 = 311 * MiB;
constexpr size_t O_QK1 = 311 * MiB;
constexpr size_t O_V1 = 345 * MiB;
constexpr size_t O_G1 = 379 * MiB;
constexpr size_t O_RR = 413 * MiB;
constexpr size_t O_QDF = 422 * MiB, O_KIF = 439 * MiB, O_KTF = 456 * MiB, O_QDB = 473 * MiB;
constexpr size_t O_KIB = 243 * MiB, O_KTB = 260 * MiB, O_VT = 277 * MiB;
constexpr size_t O_ECL = 490 * MiB;
constexpr size_t O_OF = O_QK1, O_OB = O_V1;
constexpr size_t O_GA = O_QDF;
constexpr size_t O_HM = 243 * MiB;
constexpr size_t WS_END = 495 * MiB;
static_assert(O_HM + (size_t)34816 * EXD * 2 <= 482 * MiB, "HM");
static_assert(O_RR + (size_t)R * 256 * 2 <= O_QDF, "RR");
static_assert(O_ECL + (size_t)544 * 8 * 1024 <= WS_END, "ECL");

constexpr int RING_BYTES = 131072;
constexpr int LDS_BYTES = 163840;
constexpr int LDSCTL_OFF = LDS_BYTES - 256;

struct Args {
    const float* in[27];
    float* out; unsigned char* ws;
    int ph_lo, ph_hi;
};
enum { I_X = 0, I_C, I_CTX, I_CCTX, I_MODW, I_MODB, I_NORMG, I_AWIN, I_AQN, I_AWUQ, I_AKVN, I_AWUKV, I_AQKN, I_AWOUT, I_GWIN, I_GGATE2, I_GBGATE, I_GONORM, I_GWOUT,
       I_FWG, I_FWU, I_FWD, I_MROUTER, I_MBROUTER, I_MWG, I_MWU, I_MWD };

struct Conv { const float* s0; const float* s1; int Nsrc; int K; int Ndst; bf16_t* dst; int mode; const float* kscale; };
__device__ __forceinline__ int ilv64(int p) { return (p >> 5) * 32 + (p & 1) * 16 + ((p & 31) >> 1); }
__device__ __forceinline__ int ilv32(int p) { return (p >> 4) * 16 + (p & 1) * 8 + ((p & 15) >> 1); }
__device__ __forceinline__ const float* conv_col(const Conv& c, int n, float& sc) {
    sc = 1.0f;
    switch (c.mode) {
    case 0: return c.s0 + n;
    case 1: {
        if (n < 640) return c.s0 + n;
        if (n < 1152) { const int hh = (n - 640) >> 6, p = (n - 640) & 63; return c.s0 + 672 + hh * 64 + ilv64(p); }
        if (n < 1280) { const int hh = (n - 1152) >> 6, p = (n - 1152) & 63; return c.s0 + 1184 + hh * 64 + ilv64(p); }
        if (n < 1408) return c.s0 + 1312 + (n - 1280);
        if (n < 1440) return c.s0 + 640 + ilv32(n - 1408);
        return nullptr; }
    case 2: {
        if (n < 512) return c.s0 + (n >> 6) * 96 + (n & 63);
        const int hh = (n - 512) >> 5, p = (n - 512) & 31; return c.s0 + hh * 96 + 64 + ilv32(p); }
    case 3: {
        const int G = n >> 5, j = n & 31; return (j < 16) ? c.s0 + 16 * G + j : c.s1 + 16 * G + (j - 16); }
    case 4: {
        if (n >= 3104) return nullptr;
        if (n < 512) sc = 0.08838834764831845f;
        return c.s0 + n; }
    }
    return nullptr;
}
__device__ __forceinline__ void conv_item(const Conv& c, int item, LAS float* scr, int lane) {
    const int nblk = c.Ndst / 32, kb = item / nblk, nb = item % nblk, k0 = 64 * kb, n0 = 32 * nb;
    float sc; const float* cp = conv_col(c, n0 + (lane & 31), sc);
    const int kh = lane >> 5;
#pragma unroll 16
    for (int i = 0; i < 32; ++i) { const int kk = 2 * i + kh; float v = 0.f;
        if (cp) { v = cp[(size_t)(k0 + kk) * c.Nsrc] * sc; if (c.kscale) v *= c.kscale[k0 + kk]; }
        scr[kk * 33 + (lane & 31)] = v; }
    asm volatile("s_waitcnt lgkmcnt(0)" ::: "memory");
    const int ch = lane & 7;
#pragma unroll
    for (int j = 0; j < 4; ++j) { const int n = (lane >> 3) + 8 * j; const LAS float* s = scr + (8 * ch) * 33 + n;
        u32x4 o; o.x = cvtpk(s[0 * 33], s[1 * 33]); o.y = cvtpk(s[2 * 33], s[3 * 33]); o.z = cvtpk(s[4 * 33], s[5 * 33]); o.w = cvtpk(s[6 * 33], s[7 * 33]);
        *(u32x4*)(c.dst + (size_t)(n0 + n) * c.K + k0 + 8 * ch) = o; }
    asm volatile("s_waitcnt lgkmcnt(0)" ::: "memory");
}

struct Conv64 { const float* s0; const float* s1; int Nsrc; int K; int Ndst; bf16_t* dst; int mode; int nvalid; int nscaled; float rscale; int f8; };
struct Conv64Geo { int k0, n0, nd; bool valid; float sc; const float* src; };
__device__ __forceinline__ Conv64Geo conv64_geo(const Conv64& c, int item, int lane) {
    Conv64Geo g; const int nblk = c.Ndst / 64, kb = item / nblk, nb = item % nblk; g.k0 = 64 * kb; g.n0 = 64 * nb;
    const int c4 = lane & 15, kr = lane >> 4; g.valid = true; g.sc = 1.0f;
    if (c.mode == 3) { const int cc = 4 * (c4 & 7); g.src = c.s0 + ((c4 < 8) ? (long)0 : (long)(c.s1 - c.s0)) + 32 * nb + cc; g.nd = 32 * (cc >> 4) + ((c4 < 8) ? 0 : 16) + (cc & 15); if (c.f8) g.sc = c.rscale; }
    else { g.nd = 4 * c4; g.src = c.s0 + g.n0 + g.nd; g.valid = (g.n0 + g.nd) < c.nvalid; if (g.n0 + g.nd < c.nscaled) g.sc = c.rscale; }
    g.src += (size_t)(g.k0 + kr) * c.Nsrc;
    return g;
}
__device__ __forceinline__ void conv64_load(const Conv64& c, int item, int lane, f32x4 (&v)[16]) {
    const Conv64Geo g = conv64_geo(c, item, lane);
#pragma unroll
    for (int i = 0; i < 16; ++i) v[i] = g.valid ? *(const f32x4*)(g.src + (size_t)(4 * i) * c.Nsrc) : (f32x4){0.f, 0.f, 0.f, 0.f};
}
__device__ __forceinline__ void conv64_store(const Conv64& c, int item, LAS float* scr, int lane, const f32x4 (&v)[16]) {
    const Conv64Geo g = conv64_geo(c, item, lane); const int kr = lane >> 4, nd = g.nd, k0 = g.k0, n0 = g.n0; const float sc = g.sc;
#pragma unroll
    for (int i = 0; i < 16; ++i) { LAS float* p = scr + (4 * i + kr) * 65 + nd; p[0] = v[i][0] * sc; p[1] = v[i][1] * sc; p[2] = v[i][2] * sc; p[3] = v[i][3] * sc; }
    asm volatile("s_waitcnt lgkmcnt(0)" ::: "memory");
    if (c.f8) {
        const int ch = lane & 3; unsigned char* d8 = (unsigned char*)c.dst;
#pragma unroll
        for (int it = 0; it < 4; ++it) { const int r = it * 16 + (lane >> 2); const LAS float* sp = scr + (16 * ch) * 65 + r; u32x4 o;
            o.x = pack_fp8x4(sp[0 * 65], sp[1 * 65], sp[2 * 65], sp[3 * 65]); o.y = pack_fp8x4(sp[4 * 65], sp[5 * 65], sp[6 * 65], sp[7 * 65]);
            o.z = pack_fp8x4(sp[8 * 65], sp[9 * 65], sp[10 * 65], sp[11 * 65]); o.w = pack_fp8x4(sp[12 * 65], sp[13 * 65], sp[14 * 65], sp[15 * 65]);
            *(u32x4*)(d8 + (size_t)(n0 + r) * c.K + k0 + 16 * ch) = o; }
    } else {
    const int ch = lane & 7;
#pragma unroll
    for (int it = 0; it < 8; ++it) { const int r = it * 8 + (lane >> 3); const LAS float* sp = scr + (8 * ch) * 65 + r;
        u32x4 o; o.x = cvtpk(sp[0 * 65], sp[1 * 65]); o.y = cvtpk(sp[2 * 65], sp[3 * 65]); o.z = cvtpk(sp[4 * 65], sp[5 * 65]); o.w = cvtpk(sp[6 * 65], sp[7 * 65]);
        *(u32x4*)(c.dst + (size_t)(n0 + r) * c.K + k0 + 8 * ch) = o; }
    }
    asm volatile("s_waitcnt lgkmcnt(0)" ::: "memory");
}

__device__ __forceinline__ void conv64_run(const Conv64& c, LAS float* scr, int lane, int gwi, int ngw, int& base) {
    const int n = (c.K / 64) * (c.Ndst / 64); int it = gwi - base; if (it < 0) it += ngw;
    if (it < n) { f32x4 va[16], vb[16]; conv64_load(c, it, lane, va);
        for (;;) { const int i2 = it + ngw; if (i2 < n) conv64_load(c, i2, lane, vb); conv64_store(c, it, scr, lane, va); if (i2 >= n) break;
                   const int i3 = i2 + ngw; if (i3 < n) conv64_load(c, i3, lane, va); conv64_store(c, i2, scr, lane, vb); if (i3 >= n) break; it = i3; } }
    base = (base + n) % ngw;
}

namespace pg8 {
constexpr int BM = 256, BK = 64, HALF = 128, HTB = HALF * BK * 2, STAGE_BYTES = 8 * HTB;
constexpr int NXCD = 8, WGM = 8;
__device__ __forceinline__ int lds_byte(int r, int c) { const int st = (r >> 4) * 2 + (c >> 5), rr = r & 15, cc = c & 31, ob = rr * 64 + cc * 2; return st * 1024 + (ob ^ (((ob >> 9) & 1) << 5)); }
__device__ __forceinline__ void stage_rc(int b, int& Rr, int& C) { const int st = b / 1024, sb = b % 1024, swz = sb ^ (((sb >> 9) & 1) << 5); Rr = (st >> 1) * 16 + swz / 64; C = (st & 1) * 32 + (swz % 64) / 2; }
__device__ __forceinline__ int perm32(int rho) { const int n = rho >> 4, i = rho & 15; return 8 * (i >> 2) + 4 * n + (i & 3); }
struct Unit { int pm, pn; };
typedef int v8i_t __attribute__((ext_vector_type(8)));
typedef int v4i_t __attribute__((ext_vector_type(4)));
__device__ __forceinline__ v8i_t cat8(bf16x8 a, bf16x8 b) { const v4i_t x = __builtin_bit_cast(v4i_t, a), y = __builtin_bit_cast(v4i_t, b); return __builtin_shufflevector(x, y, 0, 1, 2, 3, 4, 5, 6, 7); }
struct Order {
    int nM, nN, nwg, G, c;
    __device__ __forceinline__ void init(int nM_, int nN_, int G_, int c_) { nM = nM_; nN = nN_; nwg = nM * nN; G = G_; c = c_; }
    __device__ __forceinline__ bool next(int i, Unit& u) const {
        const long L = (long)i * G + c; if (L >= nwg) return false;
        int wgid = (int)L; { const int q = nwg / NXCD, r = nwg % NXCD, xcd = wgid % NXCD, off = wgid / NXCD; wgid = (xcd < r ? xcd * (q + 1) : r * (q + 1) + (xcd - r) * q) + off; }
        const int nig = WGM * nN, gid = wgid / nig, fm = gid * WGM, gsz = (nM - fm) < WGM ? (nM - fm) : WGM;
        u.pm = fm + ((wgid % nig) % gsz); u.pn = (wgid % nig) / gsz; return true;
    }
};

template <class Prob, class Epi>
__device__ __forceinline__ void gemm_phase(LAS unsigned char* lds, const Prob& P, const Epi& E) {
    const int tid = threadIdx.x, wid = __builtin_amdgcn_readfirstlane(tid >> 6), lane = tid & 63, wr = wid >> 2, wc = wid & 3, fr = lane & 15, fq = lane >> 4;
    const int K = P.K, nt = K / BK, ldb = P.ldb;
    int RA[2], CA[2]; unsigned voffB[2];
#pragma unroll
    for (int i = 0; i < 2; ++i) { int Rr, C; stage_rc(tid * 16 + i * 8192, Rr, C); const int Rb = Epi::PERM ? ((Rr & ~31) + perm32(Rr & 31)) : Rr;
        RA[i] = Rr; CA[i] = C; voffB[i] = (unsigned)(Rb * ldb + C) * 2u; }
    const size_t hstepB = (size_t)HALF * ldb * 2;
    const unsigned ldsw = (unsigned)wid * 1024u;
    const int aoff = lds_byte(wr * 64 + fr, fq * 8), boff = lds_byte(wc * 32 + fr, fq * 8);
    const char* Abase = (const char*)P.Abase;
    const int scl_a = P.sa * 0x01010101, scl_b = P.sb * 0x01010101;
#define PG8_SA(b, h) (((b) * 2 + (h)) * HTB)
#define PG8_SB(b, h) ((4 + (b) * 2 + (h)) * HTB)
#define PG8_STAGEB(bufoff, gbase) do { _Pragma("unroll") for (int _i = 0; _i < 2; ++_i) \
        __builtin_amdgcn_global_load_lds((const unsigned*)((const char*)(gbase) + voffB[_i]), (LAS unsigned*)(lds + (bufoff) + ldsw + _i * 8192), 16, 0, 0); } while (0)
#define PG8_STAGEA(bufoff, vo, h, kb) do { _Pragma("unroll") for (int _i = 0; _i < 2; ++_i) \
        __builtin_amdgcn_global_load_lds((const unsigned*)(Abase + (size_t)(kb) + (vo)[h][_i]), (LAS unsigned*)(lds + (bufoff) + ldsw + _i * 8192), 16, 0, 0); } while (0)
#define PG8_LDA(dst, b, h) do { _Pragma("unroll") for (int m = 0; m < 4; ++m) { if constexpr (Prob::FP8) dst##8[m] = cat8(*(const LAS bf16x8*)(lds + PG8_SA(b, h) + aoff + m * 2048), *(const LAS bf16x8*)(lds + PG8_SA(b, h) + aoff + m * 2048 + 1024)); \
        else { _Pragma("unroll") for (int k = 0; k < 2; ++k) dst[m][k] = *(const LAS bf16x8*)(lds + PG8_SA(b, h) + aoff + m * 2048 + k * 1024); } } } while (0)
#define PG8_LDB(dst, b, h) do { _Pragma("unroll") for (int n = 0; n < 2; ++n) { if constexpr (Prob::FP8) dst##8[n] = cat8(*(const LAS bf16x8*)(lds + PG8_SB(b, h) + boff + n * 2048), *(const LAS bf16x8*)(lds + PG8_SB(b, h) + boff + n * 2048 + 1024)); \
        else { _Pragma("unroll") for (int k = 0; k < 2; ++k) dst[n][k] = *(const LAS bf16x8*)(lds + PG8_SB(b, h) + boff + n * 2048 + k * 1024); } } } while (0)
#define PG8_MMA(ai, bj, At, Bt) do { __builtin_amdgcn_s_setprio(1); _Pragma("unroll") for (int m = 0; m < 4; ++m) _Pragma("unroll") for (int n = 0; n < 2; ++n) { \
        if constexpr (Prob::FP8) asm volatile("v_mfma_scale_f32_16x16x128_f8f6f4 %0, %1, %2, %0, %3, %4 op_sel_hi:[0,0,0]" : "+v"(acc[ai][bj][m][n]) : "v"(Bt##8[n]), "v"(At##8[m]), "v"(scl_b), "v"(scl_a)); \
        else { _Pragma("unroll") for (int k = 0; k < 2; ++k) acc[ai][bj][m][n] = __builtin_amdgcn_mfma_f32_16x16x32_bf16(Bt[n][k], At[m][k], acc[ai][bj][m][n], 0, 0, 0); } } \
        __builtin_amdgcn_s_setprio(0); } while (0)
#define PG8_WAIT_V(n) asm volatile("s_waitcnt vmcnt(" #n ")" ::: "memory")
#define PG8_WAIT_L(n) asm volatile("s_waitcnt lgkmcnt(" #n ")" ::: "memory")
#define PG8_BAR __builtin_amdgcn_s_barrier()
#define PG8_SCHED __builtin_amdgcn_sched_barrier(0)
    Unit cur, nxt; int ui = 0;
    if (!P.next(0, cur)) return;
    f32x4 acc[2][2][4][2];
#pragma unroll
    for (int a = 0; a < 2; ++a)
#pragma unroll
        for (int b = 0; b < 2; ++b)
#pragma unroll
            for (int m = 0; m < 4; ++m)
#pragma unroll
                for (int n = 0; n < 2; ++n) acc[a][b][m][n] = (f32x4){0.f, 0.f, 0.f, 0.f};
    bf16x8 At[4][2], B0[2][2], B1[2][2]; v8i_t At8[4], B08[2], B18[2];
    unsigned cvo[2][2], nvo[2][2];
#pragma unroll
    for (int h = 0; h < 2; ++h)
#pragma unroll
        for (int i = 0; i < 2; ++i) cvo[h][i] = P.a_off(cur, h * HALF + RA[i]) + (unsigned)CA[i] * 2u;
    const char* cB = P.b_ptr(cur);
    const size_t kstep = (size_t)(BK * 2);
    PG8_STAGEB(PG8_SB(0, 0), cB); PG8_STAGEB(PG8_SB(0, 1), cB + hstepB); PG8_STAGEA(PG8_SA(0, 0), cvo, 0, 0); PG8_STAGEA(PG8_SA(0, 1), cvo, 1, 0);
    if (wr == 1) PG8_BAR;
    PG8_WAIT_V(2); PG8_BAR;
    PG8_STAGEB(PG8_SB(1, 0), cB + kstep); PG8_STAGEA(PG8_SA(1, 0), cvo, 0, kstep); PG8_STAGEB(PG8_SB(1, 1), cB + hstepB + kstep);
    PG8_WAIT_V(6); PG8_BAR;
    for (;;) {
        const bool has_next = P.next(ui + 1, nxt);
        const char* nB = cB;
#pragma unroll
        for (int h = 0; h < 2; ++h)
#pragma unroll
            for (int i = 0; i < 2; ++i) nvo[h][i] = cvo[h][i];
        if (has_next) { nB = P.b_ptr(nxt);
#pragma unroll
            for (int h = 0; h < 2; ++h)
#pragma unroll
                for (int i = 0; i < 2; ++i) nvo[h][i] = P.a_off(nxt, h * HALF + RA[i]) + (unsigned)CA[i] * 2u; }
        for (int t = 0; t < nt; t += 2) {
            const bool last = (t == nt - 2);
            const size_t k1 = (size_t)(t + 1) * kstep;
            const size_t k2 = last ? 0 : (size_t)(t + 2) * kstep, k3 = k2 + kstep;
            unsigned vo2[2][2];
#pragma unroll
            for (int h = 0; h < 2; ++h)
#pragma unroll
                for (int i = 0; i < 2; ++i) vo2[h][i] = last ? nvo[h][i] : cvo[h][i];
            const char* b2 = (last ? nB : cB) + k2; const char* b3 = b2 + kstep;
            PG8_LDB(B0, 0, 0); PG8_LDB(B1, 0, 1); PG8_SCHED; PG8_LDA(At, 0, 0); PG8_STAGEA(PG8_SA(1, 1), cvo, 1, k1);
            PG8_WAIT_V(8); PG8_WAIT_L(0); PG8_BAR; PG8_MMA(0, 0, At, B0); PG8_MMA(0, 1, At, B1); PG8_BAR; PG8_SCHED;
            PG8_LDA(At, 0, 1); PG8_STAGEB(PG8_SB(0, 0), b2); PG8_STAGEB(PG8_SB(0, 1), b2 + hstepB); PG8_STAGEA(PG8_SA(0, 0), vo2, 0, k2);
            PG8_WAIT_V(8); PG8_WAIT_L(0); PG8_BAR; PG8_MMA(1, 0, At, B0); PG8_MMA(1, 1, At, B1); PG8_BAR; PG8_SCHED;
            PG8_LDB(B0, 1, 0); PG8_LDB(B1, 1, 1); PG8_SCHED; PG8_LDA(At, 1, 0); PG8_STAGEA(PG8_SA(0, 1), vo2, 1, k2);
            PG8_WAIT_V(8); PG8_WAIT_L(0); PG8_BAR; PG8_MMA(0, 0, At, B0); PG8_MMA(0, 1, At, B1); PG8_BAR; PG8_SCHED;
            PG8_LDA(At, 1, 1); PG8_STAGEB(PG8_SB(1, 0), b3); PG8_STAGEB(PG8_SB(1, 1), b3 + hstepB); PG8_STAGEA(PG8_SA(1, 0), vo2, 0, k3);
            PG8_WAIT_V(8); PG8_WAIT_L(0); PG8_BAR; PG8_MMA(1, 0, At, B0); PG8_MMA(1, 1, At, B1); PG8_BAR; PG8_SCHED;
        }
        if (wr == 0) PG8_BAR;
        if constexpr (Prob::FP8) asm volatile("s_nop 15\n\ts_nop 15" ::: "memory");
        if constexpr (Epi::STAGED) E.staged(acc, P, cur, wr, wc, fr, fq, lds + STAGE_BYTES, tid);
        else { E(acc, P, cur, wr, wc, fr, fq); if (MK_EPI2) { asm volatile("" ::: "memory"); E(acc, P, cur, wr, wc, fr, fq); } }
        if (!has_next) break;
#pragma unroll
        for (int a = 0; a < 2; ++a)
#pragma unroll
            for (int b = 0; b < 2; ++b)
#pragma unroll
                for (int m = 0; m < 4; ++m)
#pragma unroll
                    for (int n = 0; n < 2; ++n) acc[a][b][m][n] = (f32x4){0.f, 0.f, 0.f, 0.f};
        cur = nxt; cB = nB; ++ui;
#pragma unroll
        for (int h = 0; h < 2; ++h)
#pragma unroll
            for (int i = 0; i < 2; ++i) cvo[h][i] = nvo[h][i];
        if (wr == 1) PG8_BAR;
    }
    PG8_WAIT_V(0);
    PG8_BAR;
#undef PG8_SA
#undef PG8_SB
#undef PG8_STAGEA
#undef PG8_STAGEB
#undef PG8_LDA
#undef PG8_LDB
#undef PG8_MMA
#undef PG8_WAIT_V
#undef PG8_WAIT_L
#undef PG8_BAR
#undef PG8_SCHED
}

struct DenseProb {
    static constexpr bool FP8 = false; static constexpr int sa = 127, sb = 127;
    const bf16_t* Abase; const bf16_t* Bt; int K, lda, ldb; Order ord;
    __device__ __forceinline__ bool next(int i, Unit& u) const { return ord.next(i, u); }
    __device__ __forceinline__ unsigned a_off(const Unit& u, int r) const { return (unsigned)((size_t)(u.pm * BM + r) * lda * 2); }
    __device__ __forceinline__ const char* b_ptr(const Unit& u) const { return (const char*)Bt + (size_t)u.pn * BM * ldb * 2; }
    __device__ __forceinline__ int orow0(const Unit& u) const { return u.pm * BM; }
};
struct MoeTiles { unsigned long long tp8; unsigned long long c4a, c4b; int nt; };
__device__ __forceinline__ int moe_tp(const MoeTiles& T, int e) { return (int)((T.tp8 >> (8 * e)) & 0xffull); }
__device__ __forceinline__ int moe_cnt(const MoeTiles& T, int e) { const unsigned long long w = (e < 4) ? T.c4a : T.c4b; return (int)((w >> (16 * (e & 3))) & 0xffffull); }
__device__ __forceinline__ int moe_expert(const MoeTiles& T, int pm) { int e = 0;
#pragma unroll
    for (int j = 1; j < 8; ++j) e += (pm >= (int)((T.tp8 >> (8 * j)) & 0xffull)) ? 1 : 0;
    return e; }
struct MoeGuProb {
    static constexpr bool FP8 = true; static constexpr int sa = 125, sb = 121;
    const unsigned char* Abase; const unsigned char* Bt; int K, ldb; Order ord; MoeTiles T; const int* rowtok;
    __device__ __forceinline__ bool next(int i, Unit& u) const { return ord.next(i, u); }
    __device__ __forceinline__ unsigned a_off(const Unit& u, int r) const {
        const int e = moe_expert(T, u.pm); const int idx = (u.pm - moe_tp(T, e)) * BM + r; const int cm1 = moe_cnt(T, e) - 1;
        const int tok = rowtok[e * CAPE + (idx < cm1 ? idx : cm1)];
        return (unsigned)tok * (unsigned)D; }
    __device__ __forceinline__ const char* b_ptr(const Unit& u) const { const int e = moe_expert(T, u.pm); return (const char*)Bt + ((size_t)e * N_GU1 + (size_t)u.pn * BM) * D; }
    __device__ __forceinline__ int orow0(const Unit& u) const { return u.pm * BM; }
};
struct MoeDnProb {
    static constexpr bool FP8 = true; static constexpr int sa = 124, sb = 121;
    const unsigned char* Abase; const unsigned char* Bt; int K, ldb; Order ord; MoeTiles T;
    __device__ __forceinline__ bool next(int i, Unit& u) const { return ord.next(i, u); }
    __device__ __forceinline__ unsigned a_off(const Unit& u, int r) const { return (unsigned)((size_t)(u.pm * BM + r) * EXD); }
    __device__ __forceinline__ const char* b_ptr(const Unit& u) const { const int e = moe_expert(T, u.pm); return (const char*)Bt + ((size_t)e * D + (size_t)u.pn * BM) * EXD; }
    __device__ __forceinline__ int orow0(const Unit& u) const { return u.pm * BM; }
};

struct EpiF32 { static constexpr bool PERM = false; static constexpr bool STAGED = false; float* C; int ldc;
    template <class Prob> __device__ __forceinline__ void operator()(const f32x4 (&acc)[2][2][4][2], const Prob& P, const Unit& u, int wr, int wc, int fr, int fq) const {
        const int row0 = P.orow0(u) + wr * 64 + fr, col0 = u.pn * BM + wc * 32 + 4 * fq;
#pragma unroll
        for (int ai = 0; ai < 2; ++ai)
#pragma unroll
            for (int m = 0; m < 4; ++m) { float* rowp = C + (size_t)(row0 + ai * HALF + m * 16) * ldc + col0;
#pragma unroll
                for (int bj = 0; bj < 2; ++bj)
#pragma unroll
                    for (int n = 0; n < 2; ++n) *(f32x4*)(rowp + bj * HALF + n * 16) = acc[ai][bj][m][n]; }
    }
};
struct EpiBf16 { static constexpr bool PERM = true; static constexpr bool STAGED = false; bf16_t* O; int ldc; const float* rowscale;
    template <class Prob> __device__ __forceinline__ void operator()(const f32x4 (&acc)[2][2][4][2], const Prob& P, const Unit& u, int wr, int wc, int fr, int fq) const {
        const int row0 = P.orow0(u) + wr * 64 + fr, col0 = u.pn * BM + wc * 32 + 8 * fq;
#pragma unroll
        for (int ai = 0; ai < 2; ++ai)
#pragma unroll
            for (int m = 0; m < 4; ++m) { const int row = row0 + ai * HALF + m * 16; bf16_t* rowp = O + (size_t)row * ldc + col0; const float rs = rowscale ? rowscale[row] : 1.0f;
#pragma unroll
                for (int bj = 0; bj < 2; ++bj) { const f32x4 v0 = acc[ai][bj][m][0] * rs, v1 = acc[ai][bj][m][1] * rs;
                    u32x4 w; w.x = cvtpk(v0[0], v0[1]); w.y = cvtpk(v0[2], v0[3]); w.z = cvtpk(v1[0], v1[1]); w.w = cvtpk(v1[2], v1[3]);
                    *(u32x4*)(rowp + bj * HALF) = w; } }
    }
};
struct EpiIn1 { static constexpr bool PERM = true; static constexpr bool STAGED = false; bf16_t* QK; bf16_t* V; bf16_t* G; bf16_t* RRp;
    template <class Prob> __device__ __forceinline__ void operator()(const f32x4 (&acc)[2][2][4][2], const Prob& P, const Unit& u, int wr, int wc, int fr, int fq) const {
        const int t = u.pn >> 2; bf16_t* base = (t == 0) ? QK : (t == 1) ? V : (t == 2) ? G : RRp; const int ldc = (t == 3) ? 256 : 1024;
        const int row0 = P.orow0(u) + wr * 64 + fr, col0 = (u.pn & 3) * BM + wc * 32 + 8 * fq;
#pragma unroll
        for (int ai = 0; ai < 2; ++ai)
#pragma unroll
            for (int m = 0; m < 4; ++m) { const int row = row0 + ai * HALF + m * 16; bf16_t* rowp = base + (size_t)row * ldc + col0;
#pragma unroll
                for (int bj = 0; bj < 2; ++bj) { const f32x4 v0 = acc[ai][bj][m][0], v1 = acc[ai][bj][m][1];
                    u32x4 w; w.x = cvtpk(v0[0], v0[1]); w.y = cvtpk(v0[2], v0[3]); w.z = cvtpk(v1[0], v1[1]); w.w = cvtpk(v1[2], v1[3]);
                    *(u32x4*)(rowp + bj * HALF) = w; } }
    }
};
struct EpiQA { static constexpr bool PERM = true; static constexpr bool STAGED = false; bf16_t* O; const float* rstd; const float* tab16; float qscale;
    template <class Prob> __device__ __forceinline__ void operator()(const f32x4 (&acc)[2][2][4][2], const Prob& P, const Unit& u, int wr, int wc, int fr, int fq) const {
        const int row0 = P.orow0(u) + wr * 64 + fr, col0 = u.pn * BM + wc * 32 + 8 * fq;
        const bool ropet = (u.pn == 2);
#pragma unroll
        for (int ai = 0; ai < 2; ++ai)
#pragma unroll
            for (int m = 0; m < 4; ++m) { const int row = row0 + ai * HALF + m * 16; bf16_t* rowp = O + (size_t)row * N_QA + col0; const float rs = rstd[row] * qscale;
                f32x4 cs0 = {1.f, 1.f, 1.f, 1.f}, sn0 = {0.f, 0.f, 0.f, 0.f};
                if (ropet && row < RL) { const int tt = row & (SEQ - 1); const int pos = (fq >> 1) ? (tt & 63) : (tt >> 6); const int i0 = 4 * (fq & 1);
                    cs0 = *(const f32x4*)(tab16 + pos * 8 + i0); sn0 = *(const f32x4*)(tab16 + 512 + pos * 8 + i0); }
#pragma unroll
                for (int bj = 0; bj < 2; ++bj) { f32x4 v0 = acc[ai][bj][m][0] * rs, v1 = acc[ai][bj][m][1] * rs;
                    if (ropet) {
                        const f32x4 a = v0, b = v1;
                        v0[0] = a[0] * cs0[0] - a[1] * sn0[0]; v0[1] = a[1] * cs0[0] + a[0] * sn0[0];
                        v0[2] = a[2] * cs0[1] - a[3] * sn0[1]; v0[3] = a[3] * cs0[1] + a[2] * sn0[1];
                        v1[0] = b[0] * cs0[2] - b[1] * sn0[2]; v1[1] = b[1] * cs0[2] + b[0] * sn0[2];
                        v1[2] = b[2] * cs0[3] - b[3] * sn0[3]; v1[3] = b[3] * cs0[3] + b[2] * sn0[3]; }
                    u32x4 w; w.x = cvtpk(v0[0], v0[1]); w.y = cvtpk(v0[2], v0[3]); w.z = cvtpk(v1[0], v1[1]); w.w = cvtpk(v1[2], v1[3]);
                    *(u32x4*)(rowp + bj * HALF) = w; } }
    }
};
struct EpiSwiglu { static constexpr bool PERM = false; static constexpr bool STAGED = false; bf16_t* Hh; int ldh;
    template <class Prob> __device__ __forceinline__ void operator()(const f32x4 (&acc)[2][2][4][2], const Prob& P, const Unit& u, int wr, int wc, int fr, int fq) const {
        const int row0 = P.orow0(u) + wr * 64 + fr, col0 = (u.pn * BM + wc * 32) / 2 + 4 * fq;
#pragma unroll
        for (int ai = 0; ai < 2; ++ai)
#pragma unroll
            for (int m = 0; m < 4; ++m) { bf16_t* rowp = Hh + (size_t)(row0 + ai * HALF + m * 16) * ldh + col0;
#pragma unroll
                for (int bj = 0; bj < 2; ++bj) { const f32x4 g = acc[ai][bj][m][0], up = acc[ai][bj][m][1];
                    u32x2 w; w.x = cvtpk(silu_f(g[0]) * up[0], silu_f(g[1]) * up[1]); w.y = cvtpk(silu_f(g[2]) * up[2], silu_f(g[3]) * up[3]);
                    *(u32x2*)(rowp + bj * (HALF / 2)) = w; } }
    }
};
struct EpiSwiglu8 { static constexpr bool PERM = false; static constexpr bool STAGED = true; unsigned char* Hh; int ldh;
    template <class Prob> __device__ __forceinline__ void staged(const f32x4 (&acc)[2][2][4][2], const Prob& P, const Unit& u, int wr, int wc, int fr, int fq, LAS unsigned char* stg, int tid) const {
        LAS unsigned char* sg = stg + wr * 8192;
        const int t = tid & 255;
        unsigned char* gbase = Hh + (size_t)(P.orow0(u) + wr * 64) * ldh + (size_t)u.pn * 128;
#pragma unroll
        for (int ai = 0; ai < 2; ++ai) {
#pragma unroll
            for (int m = 0; m < 4; ++m) { const int row = m * 16 + fr;
#pragma unroll
                for (int bj = 0; bj < 2; ++bj) { const f32x4 g = acc[ai][bj][m][0], up = acc[ai][bj][m][1]; const int p = bj * 4 + wc;
                    *(LAS unsigned*)(sg + row * 128 + ((p ^ (row & 7)) << 4) + 4 * fq) = pack_fp8x4(8.0f * silu_f(g[0]) * up[0], 8.0f * silu_f(g[1]) * up[1], 8.0f * silu_f(g[2]) * up[2], 8.0f * silu_f(g[3]) * up[3]); } }
            asm volatile("s_waitcnt lgkmcnt(0)" ::: "memory"); __builtin_amdgcn_s_barrier(); asm volatile("" ::: "memory");
#pragma unroll
            for (int j = 0; j < 2; ++j) { const int row = (t >> 3) + 32 * j, p = t & 7;
                const u32x4 v = *(const LAS u32x4*)(sg + row * 128 + ((p ^ (row & 7)) << 4));
                *(u32x4*)(gbase + (size_t)(ai * HALF + row) * ldh + p * 16) = v; }
            if (ai == 0) { asm volatile("s_waitcnt lgkmcnt(0)" ::: "memory"); __builtin_amdgcn_s_barrier(); asm volatile("" ::: "memory"); }
        }
    }
};
}

struct Frame {
    LAS unsigned char* lds;
    unsigned char* ws;
    int tid, lane, wave, vcu, G;
};
template <class T> __device__ __forceinline__ T* wsp(const Frame& F, size_t off) { return (T*)(F.ws + off); }

__device__ __forceinline__ void load_row(const float* p, int lane, f32x4 (&v)[4]) {
    const f32x4* r = (const f32x4*)p + lane;
#pragma unroll
    for (int j = 0; j < 4; ++j) v[j] = r[64 * j];
}
__device__ __forceinline__ void load_row_bf16(const bf16_t* p, int lane, f32x4 (&v)[4]) {
#pragma unroll
    for (int j = 0; j < 4; ++j) { const u32x2 w = *(const u32x2*)(p + 4 * lane + 256 * j); v[j][0] = bflo(w.x); v[j][1] = bfhi(w.x); v[j][2] = bflo(w.y); v[j][3] = bfhi(w.y); }
}
__device__ __forceinline__ float row_ssq(const f32x4 (&v)[4]) { float s = 0.f;
#pragma unroll
    for (int j = 0; j < 4; ++j) s += (v[j][0] * v[j][0] + v[j][1] * v[j][1]) + (v[j][2] * v[j][2] + v[j][3] * v[j][3]);
    return wave_sum(s); }
__device__ __forceinline__ void norm_mod_store(const f32x4 (&h)[4], const float* g, const float* sh, const float* sc, bf16_t* urow, int lane, f32x4 (&uo)[4], unsigned char* u8row = nullptr) {
    const float rstd = __builtin_amdgcn_rsqf(row_ssq(h) * (1.0f / D) + EPS);
#pragma unroll
    for (int j = 0; j < 4; ++j) { const int c = 4 * lane + 256 * j; const f32x4 gg = *(const f32x4*)(g + c), s1 = *(const f32x4*)(sc + c), s0 = *(const f32x4*)(sh + c);
        const f32x4 uu = (h[j] * rstd * gg) * (1.0f + s1) + s0; uo[j] = uu;
        if (u8row) *(unsigned*)(u8row + c) = pack_fp8x4(4.0f * uu[0], 4.0f * uu[1], 4.0f * uu[2], 4.0f * uu[3]);
        else { u32x2 w; w.x = cvtpk(uu[0], uu[1]); w.y = cvtpk(uu[2], uu[3]); *(u32x2*)(urow + c) = w; } }
}
__device__ __forceinline__ int row_bidx(int row) { return row < RL ? (row >> 12) : 4; }

__device__ __forceinline__ void glds16(const void* gsrc, unsigned lds_dst) { unsigned keep;
    asm volatile("s_mov_b32 %0, m0\n\ts_mov_b32 m0, %2\n\ts_nop 0\n\tglobal_load_lds_dwordx4 %1, off\n\ts_mov_b32 m0, %0" : "=&s"(keep) : "v"(gsrc), "s"(lds_dst) : "memory"); }
__device__ __forceinline__ float max3f(float a, float b, float c) { float r; asm("v_max3_f32 %0, %1, %2, %3" : "=v"(r) : "v"(a), "v"(b), "v"(c)); return r; }
#define WAIT_BAR(N) asm volatile("s_waitcnt vmcnt(" #N ") lgkmcnt(0)\n\ts_barrier" ::: "memory")
template <int DQK> struct AttnSrc {
    const bf16_t* Q; int qpitch; const bf16_t* Qr;
    const bf16_t* Kn; int kpitch; const bf16_t* Kr; int krpitch;
    const bf16_t* V; int vpitch;
    bf16_t* O; int opitch;
};
__device__ __forceinline__ s16x4 vtr(const LAS unsigned char* p) { typedef short v4i16_t __attribute__((ext_vector_type(4))); return __builtin_bit_cast(s16x4, __builtin_amdgcn_ds_read_tr16_b64_v4i16((LAS v4i16_t*)p)); }
__device__ __forceinline__ int attn_krow(int kt, int lat0, int ctx0) { return kt < 64 ? lat0 + kt * 64 : ctx0 + (kt - 64) * 64; }
template <int DQK>
__device__ __forceinline__ void attn_unit(const Frame& F, const AttnSrc<DQK>& S, int q0, int lat0, int ctx0, int kt0, int kt1) {
    constexpr int NKS = DQK / 16, KB = DQK * 128, SLOT = KB + 8192;
    constexpr float THR = 8.0f;
    const int lane = F.lane, wid = F.wave, r32 = lane & 31, hi = lane >> 5;
    LAS unsigned char* lds = F.lds;
    constexpr bool QLDS = false;
    bf16x8 qf[QLDS ? 1 : NKS];
    LAS unsigned char* qfl = lds + 4 * SLOT + wid * (NKS * 1024) + lane * 16;
    { const bf16_t* qrow = S.Q + (size_t)(q0 + wid * 32 + r32) * S.qpitch;
#pragma unroll
      for (int ks = 0; ks < 4; ++ks) { const bf16x8 v = *(const bf16x8*)(qrow + ks * 16 + hi * 8); if (QLDS) *(LAS bf16x8*)(qfl + ks * 1024) = v; else qf[ks] = v; }
      if (DQK == 96) { const bf16_t* qr = S.Qr + (size_t)(q0 + wid * 32 + r32) * S.qpitch;
#pragma unroll
          for (int ks = 4; ks < NKS; ++ks) { const bf16x8 v = *(const bf16x8*)(qr + (ks - 4) * 16 + hi * 8); if (QLDS) *(LAS bf16x8*)(qfl + ks * 1024) = v; else qf[ks] = v; } } }
    const unsigned lds0 = (unsigned)(size_t)lds;
    auto dma = [&](int kt, int slot) {
        const int krow = attn_krow(kt, lat0, ctx0);
        const unsigned sb = lds0 + slot * SLOT;
        glds16(S.Kn + (size_t)(krow + lane) * S.kpitch + wid * 8, (unsigned)__builtin_amdgcn_readfirstlane(sb + wid * 1024));
        if (DQK == 96 && wid < 4) glds16(S.Kr + (size_t)(krow + lane) * S.krpitch + wid * 8, (unsigned)__builtin_amdgcn_readfirstlane(sb + (8 + wid) * 1024));
        glds16(S.V + (size_t)(krow + 16 * (wid & 3) + (lane >> 2)) * S.vpitch + (wid >> 2) * 32 + (lane & 3) * 8, (unsigned)__builtin_amdgcn_readfirstlane(sb + KB + wid * 1024));
    };
    auto wait_bar = [&](bool inflight) {
        if (!inflight) { WAIT_BAR(0); } else if (DQK == 96 && wid < 4) { WAIT_BAR(3); } else { WAIT_BAR(2); }
    };
    f32x16 oT[2]; f32x16 negm;
#pragma unroll
    for (int r = 0; r < 16; ++r) { oT[0][r] = 0.f; oT[1][r] = 0.f; negm[r] = 0.f; }
    float mrun = 0.f, lrun = 0.f;
    const int vlane = ((lane >> 4) & 1) * 32 + (lane & 3) * 8 + (4 * hi + ((lane & 15) >> 2)) * 64;
    auto qk = [&](int slot, f32x16& p0, f32x16& p1) {
        const LAS unsigned char* kb = lds + slot * SLOT + hi * 1024 + r32 * 16;
        p0 = negm; p1 = negm;
        bf16x8 ka = *(const LAS bf16x8*)(kb), kc = *(const LAS bf16x8*)(kb + 512);
#pragma unroll
        for (int ks = 0; ks < NKS; ++ks) {
            bf16x8 na = ka, nc = kc;
            if (ks + 1 < NKS) { na = *(const LAS bf16x8*)(kb + (ks + 1) * 2048); nc = *(const LAS bf16x8*)(kb + (ks + 1) * 2048 + 512); }
            const bf16x8 qv = QLDS ? *(const LAS bf16x8*)(qfl + ks * 1024) : qf[QLDS ? 0 : ks];
            p0 = __builtin_amdgcn_mfma_f32_32x32x16_bf16(ka, qv, p0, 0, 0, 0);
            p1 = __builtin_amdgcn_mfma_f32_32x32x16_bf16(kc, qv, p1, 0, 0, 0);
            ka = na; kc = nc;
        }
    };
    auto tilemax = [&](f32x16& p0, f32x16& p1) -> float {
        asm volatile("s_nop 15\n\ts_nop 7" : "+v"(p0), "+v"(p1));
        float a = max3f(p0[0], p0[1], p1[0]), b = max3f(p0[2], p0[3], p1[1]); a = max3f(a, p1[2], p1[3]);
#pragma unroll
        for (int r = 4; r < 16; r += 4) { a = max3f(a, p0[r], p0[r + 1]); b = max3f(b, p0[r + 2], p0[r + 3]); a = max3f(a, p1[r], p1[r + 1]); b = max3f(b, p1[r + 2], p1[r + 3]); }
        float tm = fmaxf(a, b);
        auto rr = __builtin_amdgcn_permlane32_swap(__float_as_uint(tm), __float_as_uint(tm), false, false); return fmaxf(__uint_as_float(rr[0]), __uint_as_float(rr[1]));
    };
    auto smpv = [&](f32x16& p0, f32x16& p1, int slot) -> bool {
        const float tm = tilemax(p0, p1);
        bool moved = false;
        if (__any(tm > THR)) {
            const float dl = fmaxf(tm, 0.f); mrun += dl; const float al = __builtin_amdgcn_exp2f(-dl); lrun *= al;
#pragma unroll
            for (int r = 0; r < 16; ++r) { p0[r] -= dl; p1[r] -= dl; negm[r] = -mrun; oT[0][r] *= al; oT[1][r] *= al; }
            moved = true;
        }
        float rs = 0.f;
#pragma unroll
        for (int r = 0; r < 16; ++r) { p0[r] = __builtin_amdgcn_exp2f(p0[r]); p1[r] = __builtin_amdgcn_exp2f(p1[r]); rs += p0[r] + p1[r]; }
        lrun += rs;
        bf16x8 pf[4];
        { u32x4 w;
          w.x = cvtpk(p0[0], p0[1]); w.y = cvtpk(p0[2], p0[3]); w.z = cvtpk(p0[4], p0[5]); w.w = cvtpk(p0[6], p0[7]); pf[0] = __builtin_bit_cast(bf16x8, w);
          w.x = cvtpk(p0[8], p0[9]); w.y = cvtpk(p0[10], p0[11]); w.z = cvtpk(p0[12], p0[13]); w.w = cvtpk(p0[14], p0[15]); pf[1] = __builtin_bit_cast(bf16x8, w);
          w.x = cvtpk(p1[0], p1[1]); w.y = cvtpk(p1[2], p1[3]); w.z = cvtpk(p1[4], p1[5]); w.w = cvtpk(p1[6], p1[7]); pf[2] = __builtin_bit_cast(bf16x8, w);
          w.x = cvtpk(p1[8], p1[9]); w.y = cvtpk(p1[10], p1[11]); w.z = cvtpk(p1[12], p1[13]); w.w = cvtpk(p1[14], p1[15]); pf[3] = __builtin_bit_cast(bf16x8, w); }
        const LAS unsigned char* vb = lds + slot * SLOT + KB + vlane;
        s16x4 lo = vtr(vb), hh = vtr(vb + 512);
#pragma unroll
        for (int i = 0; i < 8; ++i) {
            const int d0 = i >> 2, ks = i & 3;
            s16x4 nlo = lo, nhh = hh;
            if (i + 1 < 8) { const int o2 = ((i + 1) >> 2) * 4096 + ((i + 1) & 3) * 1024; nlo = vtr(vb + o2); nhh = vtr(vb + o2 + 512); }
            const bf16x8 vf = (bf16x8){lo[0], lo[1], lo[2], lo[3], hh[0], hh[1], hh[2], hh[3]};
            oT[d0] = __builtin_amdgcn_mfma_f32_32x32x16_bf16(vf, pf[ks], oT[d0], 0, 0, 0);
            lo = nlo; hh = nhh;
        }
        return moved;
    };
    dma(kt0, 0); dma(kt0 + 1, 1); dma(kt0 + 2, 2);
    wait_bar(true);
    f32x16 pA0, pA1, pB0, pB1;
    qk(0, pA0, pA1);
    { mrun = tilemax(pA0, pA1);
#pragma unroll
      for (int r = 0; r < 16; ++r) negm[r] = -mrun;
      qk(0, pA0, pA1); }
    int sc = 0;
    for (int kt = kt0; kt < kt1; kt += 2) {
        { const int s1 = (sc + 1) & 3, s3 = (sc + 3) & 3;
          if (kt + 3 < kt1) dma(kt + 3, s3);
          qk(s1, pB0, pB1);
          if (smpv(pA0, pA1, sc)) qk(s1, pB0, pB1);
          wait_bar(kt + 3 < kt1);
          sc = s1; }
        { const int s1 = (sc + 1) & 3, s3 = (sc + 3) & 3;
          if (kt + 4 < kt1) dma(kt + 4, s3);
          if (kt + 2 < kt1) qk(s1, pA0, pA1);
          if (smpv(pB0, pB1, sc) && kt + 2 < kt1) qk(s1, pA0, pA1);
          wait_bar(kt + 4 < kt1);
          sc = s1; }
    }
    { auto rr = __builtin_amdgcn_permlane32_swap(__float_as_uint(lrun), __float_as_uint(lrun), false, false); lrun = __uint_as_float(rr[0]) + __uint_as_float(rr[1]); }
    const float inv = 1.0f / lrun;
    bf16_t* orow = S.O + (size_t)(q0 + wid * 32 + r32) * S.opitch;
#pragma unroll
    for (int d0 = 0; d0 < 2; ++d0)
#pragma unroll
        for (int g = 0; g < 4; ++g) { u32x2 w; w.x = cvtpk(oT[d0][4 * g] * inv, oT[d0][4 * g + 1] * inv); w.y = cvtpk(oT[d0][4 * g + 2] * inv, oT[d0][4 * g + 3] * inv);
            *(u32x2*)(orow + 32 * d0 + 8 * g + 4 * hi) = w; }
}

__device__ __forceinline__ int sig5(int c) { return (c & ~12) | ((c & 8) >> 1) | ((c & 4) << 1); }

__global__ void __launch_bounds__(512, 2) mk_fwd(Args args) {
    extern __shared__ __attribute__((aligned(16))) unsigned char lds_raw[];
    Frame F;
    F.lds = (LAS unsigned char*)lds_raw; F.ws = args.ws;
    F.tid = threadIdx.x; F.lane = F.tid & 63; F.wave = __builtin_amdgcn_readfirstlane(F.tid >> 6);
    F.G = gridDim.x; { const int bx = blockIdx.x; F.vcu = (F.G % 8 == 0) ? (bx % 8) * (F.G / 8) + bx / 8 : bx; }
    volatile LAS unsigned* MISC = (volatile LAS unsigned*)(F.lds + LDSCTL_OFF);
    if (F.tid < 64) MISC[F.tid] = 0u;
    __syncthreads();
    unsigned* ctl = wsp<unsigned>(F, O_CTL);
#if MK_ONE_LAUNCH
    XcdBarrier bar = xcd_barrier_post(ctl + CW_BAR, MISC + 8);
#define GRID_BAR() xcd_barrier(bar)
#else
#define GRID_BAR() do {} while (0)
#endif
    const int lo = args.ph_lo, hi_ph = args.ph_hi;
#define IN(k) (lo <= (k) && (k) < hi_ph)
#define SEAM(k) do { if (IN(k) && IN((k) + 1)) GRID_BAR(); } while (0)
    const int lane = F.lane, wave = F.wave, tid = F.tid;
    const int gw = F.vcu * 8 + wave, NGW = F.G * 8;

    const float* x_in = args.in[I_X]; const float* ctx_in = args.in[I_CTX];
    float* MODV = wsp<float>(F, O_MODV);
    float* TAB16 = wsp<float>(F, O_TAB16); float* TAB32 = wsp<float>(F, O_TAB32);
    float* HC = wsp<float>(F, O_HC);
    bf16_t* U = wsp<bf16_t>(F, O_U);
    float* Y = wsp<float>(F, O_Y);
    const float* normg = args.in[I_NORMG];
#define MV(layer, bidx, k) (MODV + ((size_t)((layer) * 5 + (bidx)) * 6 + (k)) * D)

    if (IN(0)) {
        {
            LAS float* sc = (LAS float*)F.lds;
            LAS float* red = sc + 5 * 1024;
            for (int i = tid; i < 5 * 1024; i += 512) { const int b = i >> 10, k = i & 1023; const float cv = (b < 4) ? args.in[I_C][b * 1024 + k] : args.in[I_CCTX][k]; sc[i] = cv / (1.0f + __expf(-cv)); }
            __syncthreads();
            for (int unit = F.vcu; unit < 192; unit += F.G) {
                const int layer = unit / 96, cb = unit % 96, col = cb * 64 + lane;
                const float* W = args.in[I_MODW] + (size_t)layer * D * 6144 + col;
                float a0 = 0.f, a1 = 0.f, a2 = 0.f, a3 = 0.f, a4 = 0.f;
#pragma unroll 16
                for (int kk = 0; kk < 128; ++kk) { const int k = wave * 128 + kk; const float w = W[(size_t)k * 6144];
                    a0 += sc[k] * w; a1 += sc[1024 + k] * w; a2 += sc[2048 + k] * w; a3 += sc[3072 + k] * w; a4 += sc[4096 + k] * w; }
                red[(wave * 5 + 0) * 64 + lane] = a0; red[(wave * 5 + 1) * 64 + lane] = a1; red[(wave * 5 + 2) * 64 + lane] = a2; red[(wave * 5 + 3) * 64 + lane] = a3; red[(wave * 5 + 4) * 64 + lane] = a4;
                __syncthreads();
                if (tid < 320) { const int b = tid >> 6, cc = tid & 63; float s = 0.f;
#pragma unroll
                    for (int w = 0; w < 8; ++w) s += red[(w * 5 + b) * 64 + cc];
                    MODV[(size_t)(layer * 5 + b) * 6144 + cb * 64 + cc] = s + args.in[I_MODB][layer * 6144 + cb * 64 + cc]; }
                __syncthreads();
            }
        }
        if (blockIdx.x == 0) {
            for (int i = tid; i < 64 * 8; i += 512) { const int pos = i >> 3, f = i & 7; const float fr = powf(10000.0f, -(float)f / 8.0f), a = (float)pos * fr; TAB16[i] = cosf(a); TAB16[512 + i] = sinf(a); }
            for (int i = tid; i < 64 * 16; i += 512) { const int pos = i >> 4, f = i & 15; const float fr = powf(10000.0f, -(float)f / 16.0f), a = (float)pos * fr; TAB32[i] = cosf(a); TAB32[1024 + i] = sinf(a); }
        }
        {
            LAS float* scr = (LAS float*)(F.lds + wave * 16640);
            int base = 0;
            auto run = [&](const Conv& c) { const int n = (c.K / 64) * (c.Ndst / 32); for (int it = gw - base; it < n; it += NGW) { if (it >= 0) conv_item(c, it, scr, lane); }
                base = (base + n) % NGW; };
            auto run64 = [&](const Conv64& c) { conv64_run(c, scr, lane, gw, NGW, base); };
            run64(Conv64{args.in[I_FWG], args.in[I_FWU], FFN, 1024, N_GU0, wsp<bf16_t>(F, O_WGU0), 3, 0, 0, 1.0f, 0});
            run64(Conv64{args.in[I_FWD], nullptr, 1024, FFN, 1024, wsp<bf16_t>(F, O_WD0), 0, 1024, 0, 1.0f, 0});
            run64(Conv64{args.in[I_GWIN], nullptr, 3104, 1024, N_IN1, wsp<bf16_t>(F, O_WIN1), 0, 3104, 512, 0.08838834764831845f, 0});
            run64(Conv64{args.in[I_GWOUT], nullptr, 1024, 1024, 1024, wsp<bf16_t>(F, O_WOUT1), 0, 1024, 0, 1.0f, 0});
            run64(Conv64{args.in[I_AWOUT], nullptr, 1024, 1024, 1024, wsp<bf16_t>(F, O_WOUT0), 0, 1024, 0, 1.0f, 0});
            run(Conv{args.in[I_AWIN], nullptr, 1440, 1024, N_IN0, wsp<bf16_t>(F, O_WIN0), 1, nullptr});
            run(Conv{args.in[I_AWUQ], nullptr, 768, 384, N_QA, wsp<bf16_t>(F, O_WUQ), 2, args.in[I_AQN]});
            run(Conv{args.in[I_AWUKV], nullptr, 1024, 256, N_KVA, wsp<bf16_t>(F, O_WUKV), 0, args.in[I_AKVN]});
        }
    }
    SEAM(0);

    if (IN(1)) {
        for (int row = gw; row < R; row += NGW) {
            const float* hp = row < RL ? x_in + (size_t)row * D : ctx_in + (size_t)(row - RL) * D;
            f32x4 h[4], uo[4]; load_row(hp, lane, h);
            const int b = row_bidx(row);
            norm_mod_store(h, normg + 0 * D, MV(0, b, 0), MV(0, b, 1), U + (size_t)row * D, lane, uo);
        }
    }
    SEAM(1);

    if (IN(2)) {
        pg8::DenseProb P{U, wsp<bf16_t>(F, O_WIN0), 1024, 1024, 1024, {}}; P.ord.init(R / 256, N_IN0 / 256, F.G, (int)blockIdx.x);
        pg8::EpiBf16 E{wsp<bf16_t>(F, O_Z0), N_IN0, nullptr};
        pg8::gemm_phase(F.lds, P, E);
    }
    SEAM(2);

    if (IN(3)) {
        const bf16_t* Z0 = wsp<bf16_t>(F, O_Z0);
        float* RSQ = wsp<float>(F, O_RSTDQ); float* RSKV = wsp<float>(F, O_RSTDKV);
        bf16_t* QB = wsp<bf16_t>(F, O_QB); bf16_t* KBp = wsp<bf16_t>(F, O_KB); bf16_t* KR = wsp<bf16_t>(F, O_KR);
        const float* qkn = args.in[I_AQKN];
        for (int row = gw; row < R; row += NGW) {
            const unsigned* z32 = (const unsigned*)(Z0 + (size_t)row * N_IN0);
            float s = 0.f;
#pragma unroll
            for (int j = 0; j < 3; ++j) { const unsigned w = z32[lane + 64 * j]; const float a = bflo(w), b = bfhi(w); s += a * a + b * b; }
            s = wave_sum(s);
            float s2 = 0.f;
#pragma unroll
            for (int j = 0; j < 2; ++j) { const unsigned w = z32[192 + lane + 64 * j]; const float a = bflo(w), b = bfhi(w); s2 += a * a + b * b; }
            s2 = wave_sum(s2);
            if (lane == 0) { RSQ[row] = __builtin_amdgcn_rsqf(s * (1.0f / 384.0f) + EPS); RSKV[row] = __builtin_amdgcn_rsqf(s2 * (1.0f / 256.0f) + EPS); }
            const bool lat = row < RL; const int tt = row & (SEQ - 1);
#pragma unroll
            for (int which = 0; which < 2; ++which) {
                if (which == 1 && lane >= 16) break;
                const u32x4 w4 = *(const u32x4*)(Z0 + (size_t)row * N_IN0 + (which ? 1152 : 640) + lane * 8);
                float v[8] = {bflo(w4.x), bfhi(w4.x), bflo(w4.y), bfhi(w4.y), bflo(w4.z), bfhi(w4.z), bflo(w4.w), bfhi(w4.w)};
                float ss = 0.f;
#pragma unroll
                for (int j = 0; j < 8; ++j) ss += v[j] * v[j];
                ss += __shfl_xor(ss, 1); ss += __shfl_xor(ss, 2); ss += __shfl_xor(ss, 4);
                const float rstd = __builtin_amdgcn_rsqf(ss * (1.0f / 64.0f) + EPS);
                const int jp = lane & 7, half = jp >> 2, i0 = 4 * (jp & 3);
                const float* gn = qkn + which * 64 + half * 32;
#pragma unroll
                for (int pz = 0; pz < 4; ++pz) { v[2 * pz] *= rstd * gn[i0 + pz]; v[2 * pz + 1] *= rstd * gn[16 + i0 + pz]; }
                if (lat) { const int pos = half ? (tt & 63) : (tt >> 6);
                    const f32x4 cs = *(const f32x4*)(TAB32 + pos * 16 + i0), sn = *(const f32x4*)(TAB32 + 1024 + pos * 16 + i0);
#pragma unroll
                    for (int pz = 0; pz < 4; ++pz) { const float a = v[2 * pz], b = v[2 * pz + 1]; v[2 * pz] = a * cs[pz] - b * sn[pz]; v[2 * pz + 1] = b * cs[pz] + a * sn[pz]; } }
                const float osc = which ? 1.0f : 0.125f * LOG2E;
                u32x4 o; o.x = cvtpk(v[0] * osc, v[1] * osc); o.y = cvtpk(v[2] * osc, v[3] * osc); o.z = cvtpk(v[4] * osc, v[5] * osc); o.w = cvtpk(v[6] * osc, v[7] * osc);
                if (which == 0) *(u32x4*)(QB + (size_t)row * 512 + lane * 8) = o; else *(u32x4*)(KBp + (size_t)row * 128 + lane * 8) = o;
            }
            if (lane < 4) {
                const u32x4 w4 = *(const u32x4*)(Z0 + (size_t)row * N_IN0 + 1408 + lane * 8);
                float v[8] = {bflo(w4.x), bfhi(w4.x), bflo(w4.y), bfhi(w4.y), bflo(w4.z), bfhi(w4.z), bflo(w4.w), bfhi(w4.w)};
                if (lat) { const int half = lane >> 1, i0 = 4 * (lane & 1); const int pos = half ? (tt & 63) : (tt >> 6);
                    const f32x4 cs = *(const f32x4*)(TAB16 + pos * 8 + i0), sn = *(const f32x4*)(TAB16 + 512 + pos * 8 + i0);
#pragma unroll
                    for (int pz = 0; pz < 4; ++pz) { const float a = v[2 * pz], b = v[2 * pz + 1]; v[2 * pz] = a * cs[pz] - b * sn[pz]; v[2 * pz + 1] = b * cs[pz] + a * sn[pz]; } }
                u32x4 o; o.x = cvtpk(v[0], v[1]); o.y = cvtpk(v[2], v[3]); o.z = cvtpk(v[4], v[5]); o.w = cvtpk(v[6], v[7]);
                *(u32x4*)(KR + (size_t)row * 32 + lane * 8) = o;
            }
        }
    }
    SEAM(3);

    if (IN(4)) {
        { pg8::DenseProb P{wsp<bf16_t>(F, O_Z0), wsp<bf16_t>(F, O_WUQ), 384, N_IN0, 384, {}}; P.ord.init(R / 256, N_QA / 256, F.G, (int)blockIdx.x);
          pg8::EpiQA E{wsp<bf16_t>(F, O_QA), wsp<float>(F, O_RSTDQ), TAB16, 0.10206207261596577f * LOG2E};
          pg8::gemm_phase(F.lds, P, E); }
        { pg8::DenseProb P{wsp<bf16_t>(F, O_Z0) + 384, wsp<bf16_t>(F, O_WUKV), 256, N_IN0, 256, {}}; P.ord.init(R / 256, N_KVA / 256, F.G, (int)((blockIdx.x + F.G - (204 % F.G)) % F.G));
          pg8::EpiBf16 E{wsp<bf16_t>(F, O_KVA), N_KVA, wsp<float>(F, O_RSTDKV)};
          pg8::gemm_phase(F.lds, P, E); }
    }
    SEAM(4);

    if (IN(5)) {
        const bf16_t* QA = wsp<bf16_t>(F, O_QA); const bf16_t* KVA = wsp<bf16_t>(F, O_KVA); const bf16_t* QB = wsp<bf16_t>(F, O_QB);
        const bf16_t* KBp = wsp<bf16_t>(F, O_KB); const bf16_t* KR = wsp<bf16_t>(F, O_KR); const bf16_t* Z0 = wsp<bf16_t>(F, O_Z0);
        bf16_t* AO = wsp<bf16_t>(F, O_AO);
        for (int i = 0; i < 3; ++i) {
            int b, hh, q0, kt0, kt1;
            if (i < 2) { const int m = i * 256 + F.vcu; b = m >> 7; hh = (m >> 4) & 7; q0 = b * SEQ + (m & 15) * 256; kt0 = 0; kt1 = 68; }
            else { if (F.vcu >= 32) break; b = (F.vcu >> 3) & 3; hh = F.vcu & 7; q0 = RL + b * CTX; kt0 = 64; kt1 = 68; }
            const int lat0 = b * SEQ, ctx0 = RL + b * CTX;
            AttnSrc<96> S{QA + hh * 64, N_QA, QA + 512 + hh * 32, KVA + hh * 128, N_KVA, KR, 32, KVA + hh * 128 + 64, N_KVA, AO + hh * 64, D};
            attn_unit<96>(F, S, q0, lat0, ctx0, kt0, kt1);
        }
        for (int i = 0; i < 3; ++i) {
            int b, hh, q0, kt0, kt1;
            if (i < 2) { const int m = i * 256 + F.vcu; b = m >> 7; hh = (m >> 4) & 7; q0 = b * SEQ + (m & 15) * 256; kt0 = 0; kt1 = 68; }
            else { if (F.vcu < 32 || F.vcu >= 64) break; b = (F.vcu >> 3) & 3; hh = F.vcu & 7; q0 = RL + b * CTX; kt0 = 64; kt1 = 68; }
            const int lat0 = b * SEQ, ctx0 = RL + b * CTX; const int kvh = hh >> 2;
            AttnSrc<64> S{QB + hh * 64, 512, nullptr, KBp + kvh * 64, 128, nullptr, 0, Z0 + 1280 + kvh * 64, N_IN0, AO + 512 + hh * 64, D};
            attn_unit<64>(F, S, q0, lat0, ctx0, kt0, kt1);
        }
    }
    SEAM(5);

    if (IN(6)) {
        pg8::DenseProb P{wsp<bf16_t>(F, O_AO), wsp<bf16_t>(F, O_WOUT0), 1024, 1024, 1024, {}}; P.ord.init(RL / 256, 4, F.G, (int)blockIdx.x);
        pg8::EpiBf16 E{(bf16_t*)Y, D, nullptr};
        pg8::gemm_phase(F.lds, P, E);
    }
    SEAM(6);


    auto post0 = [&](int row) {
            const float* hp = row < RL ? x_in + (size_t)row * D : ctx_in + (size_t)(row - RL) * D;
            float* ho = row < RL ? args.out + (size_t)row * D : HC + (size_t)(row - RL) * D;
            const int b = row_bidx(row);
            f32x4 y[4], h[4], uo[4]; load_row_bf16((const bf16_t*)Y + (size_t)row * D, lane, y); load_row(hp, lane, h);
            const float rstd = __builtin_amdgcn_rsqf(row_ssq(y) * (1.0f / D) + EPS);
#pragma unroll
            for (int j = 0; j < 4; ++j) { const int c = 4 * lane + 256 * j; const f32x4 g = *(const f32x4*)(normg + 1 * D + c), mg = *(const f32x4*)(MV(0, b, 2) + c);
                h[j] = h[j] + mg * (y[j] * rstd * g); *(f32x4*)(ho + c) = h[j]; }
            norm_mod_store(h, normg + 2 * D, MV(0, b, 3), MV(0, b, 4), U + (size_t)row * D, lane, uo);
    };
    if (IN(7)) {
        const bool split = F.G > 32;
        if (!split || blockIdx.x < 16) {
            pg8::DenseProb P{wsp<bf16_t>(F, O_AO) + (size_t)RL * D, wsp<bf16_t>(F, O_WOUT0), 1024, 1024, 1024, {}}; P.ord.init(RC / 256, 4, split ? 16 : F.G, (int)blockIdx.x);
            pg8::EpiBf16 E{(bf16_t*)Y + (size_t)RL * D, D, nullptr};
            pg8::gemm_phase(F.lds, P, E);
        }
        if (!split) { for (int row = gw; row < RL; row += NGW) post0(row); }
        else if (blockIdx.x >= 16) { for (int row = ((int)blockIdx.x - 16) * 8 + wave; row < RL; row += (F.G - 16) * 8) post0(row); }
    }
    SEAM(7);
    if (IN(8)) { for (int row = RL + gw; row < R; row += NGW) post0(row); }
    SEAM(8);


    if (IN(9)) {
        pg8::DenseProb P{U, wsp<bf16_t>(F, O_WGU0), 1024, 1024, 1024, {}}; P.ord.init(R / 256, N_GU0 / 256, F.G, (int)blockIdx.x);
        pg8::EpiSwiglu E{wsp<bf16_t>(F, O_H0), FFN};
        pg8::gemm_phase(F.lds, P, E);
    }
    SEAM(9);
    if (IN(10)) {
        pg8::DenseProb P{wsp<bf16_t>(F, O_H0), wsp<bf16_t>(F, O_WD0), FFN, FFN, FFN, {}}; P.ord.init(RL / 256, 4, F.G, (int)blockIdx.x);
        pg8::EpiBf16 E{(bf16_t*)Y, D, nullptr};
        pg8::gemm_phase(F.lds, P, E);
    }
    SEAM(10);


    auto post1 = [&](int row) {
            float* hp = row < RL ? args.out + (size_t)row * D : HC + (size_t)(row - RL) * D;
            const int b = row_bidx(row);
            f32x4 y[4], h[4], uo[4]; load_row_bf16((const bf16_t*)Y + (size_t)row * D, lane, y); load_row(hp, lane, h);
            const float rstd = __builtin_amdgcn_rsqf(row_ssq(y) * (1.0f / D) + EPS);
#pragma unroll
            for (int j = 0; j < 4; ++j) { const int c = 4 * lane + 256 * j; const f32x4 g = *(const f32x4*)(normg + 3 * D + c), mg = *(const f32x4*)(MV(0, b, 5) + c);
                h[j] = h[j] + mg * (y[j] * rstd * g); *(f32x4*)(hp + c) = h[j]; }
            norm_mod_store(h, normg + 4 * D, MV(1, b, 0), MV(1, b, 1), U + (size_t)row * D, lane, uo);
    };
    if (IN(11)) {
        const bool split = F.G > 32;
        if (!split || blockIdx.x < 16) {
            pg8::DenseProb P{wsp<bf16_t>(F, O_H0) + (size_t)RL * FFN, wsp<bf16_t>(F, O_WD0), FFN, FFN, FFN, {}}; P.ord.init(RC / 256, 4, split ? 16 : F.G, (int)blockIdx.x);
            pg8::EpiBf16 E{(bf16_t*)Y + (size_t)RL * D, D, nullptr};
            pg8::gemm_phase(F.lds, P, E);
        }
        if (!split) { for (int row = gw; row < RL; row += NGW) post1(row); }
        else if (blockIdx.x >= 16) { for (int row = ((int)blockIdx.x - 16) * 8 + wave; row < RL; row += (F.G - 16) * 8) post1(row); }
    }
    SEAM(11);
    if (IN(12)) { for (int row = RL + gw; row < R; row += NGW) post1(row); }
    SEAM(12);


    if (IN(13)) {
        pg8::DenseProb P{U, wsp<bf16_t>(F, O_WIN1), 1024, 1024, 1024, {}}; P.ord.init(R / 256, N_IN1 / 256, F.G, (int)blockIdx.x);
        pg8::EpiIn1 E{wsp<bf16_t>(F, O_QK1), wsp<bf16_t>(F, O_V1), wsp<bf16_t>(F, O_G1), wsp<bf16_t>(F, O_RR)};
        pg8::gemm_phase(F.lds, P, E);
    }
    SEAM(13);

    if (IN(14)) {
        const bf16_t* QK1 = wsp<bf16_t>(F, O_QK1); const bf16_t* V1 = wsp<bf16_t>(F, O_V1); const bf16_t* RRp = wsp<bf16_t>(F, O_RR);
        bf16_t* QDd[2] = {wsp<bf16_t>(F, O_QDF), wsp<bf16_t>(F, O_QDB)}; bf16_t* KId[2] = {wsp<bf16_t>(F, O_KIF), wsp<bf16_t>(F, O_KIB)}; bf16_t* KTd[2] = {wsp<bf16_t>(F, O_KTF), wsp<bf16_t>(F, O_KTB)};
        bf16_t* VT = wsp<bf16_t>(F, O_VT); float* ECL = wsp<float>(F, O_ECL);
        LAS float* tot = (LAS float*)F.lds;
        const int dkp = tid & 63, dk0 = 2 * dkp, tq = tid >> 6;
        int hh_loaded = -1; float w2[2][16][2], bg[2][2];
        for (int item = F.vcu; item < 544 * 4; item += F.G) {
            const int rc = item >> 2, hh = item & 3, row0 = rc * 32;
            if (hh != hh_loaded) {
                hh_loaded = hh;
#pragma unroll
                for (int d = 0; d < 2; ++d) { const f32x2_t bv = *(const f32x2_t*)(args.in[I_GBGATE] + d * 512 + hh * 128 + dk0); bg[d][0] = bv[0]; bg[d][1] = bv[1];
#pragma unroll
                    for (int j = 0; j < 16; ++j) { const f32x2_t wv = *(const f32x2_t*)(args.in[I_GGATE2] + (size_t)(d * 16 + j) * 512 + hh * 128 + dk0); w2[d][j][0] = wv[0]; w2[d][j][1] = wv[1]; } }
            }
            float a[2][4][2];
#pragma unroll
            for (int i = 0; i < 4; ++i) { const int row = row0 + 4 * tq + i;
                const u32x4* rp = (const u32x4*)(RRp + (size_t)row * 256);
#pragma unroll
                for (int d = 0; d < 2; ++d) { const u32x4 r0 = rp[2 * d], r1 = rp[2 * d + 1];
                    const float rv[16] = {bflo(r0.x), bfhi(r0.x), bflo(r0.y), bfhi(r0.y), bflo(r0.z), bfhi(r0.z), bflo(r0.w), bfhi(r0.w), bflo(r1.x), bfhi(r1.x), bflo(r1.y), bfhi(r1.y), bflo(r1.z), bfhi(r1.z), bflo(r1.w), bfhi(r1.w)};
#pragma unroll
                    for (int c = 0; c < 2; ++c) { float z = bg[d][c];
#pragma unroll
                        for (int j = 0; j < 16; ++j) z += rv[j] * w2[d][j][c];
                        a[d][i][c] = (fminf(z, 0.f) - __logf(1.0f + __expf(-fabsf(z)))) * (1.0f / 16.0f); } } }
            float cf[4][2], sb[4][2];
#pragma unroll
            for (int c = 0; c < 2; ++c) { float sfw = 0.f;
#pragma unroll
                for (int i = 0; i < 4; ++i) { sfw += a[0][i][c]; cf[i][c] = sfw; }
                float sbw = 0.f;
#pragma unroll
                for (int i = 3; i >= 0; --i) { sbw += a[1][i][c]; sb[i][c] = sbw; } }
            *(LAS f32x2_t*)(tot + (0 * 8 + tq) * 128 + dk0) = (f32x2_t){cf[3][0], cf[3][1]};
            *(LAS f32x2_t*)(tot + (1 * 8 + tq) * 128 + dk0) = (f32x2_t){sb[0][0], sb[0][1]};
            __syncthreads();
            float offF[2] = {0.f, 0.f}, offB[2] = {0.f, 0.f}, clF[2] = {0.f, 0.f}, clB[2] = {0.f, 0.f};
#pragma unroll
            for (int g = 0; g < 8; ++g) { const f32x2_t tf = *(const LAS f32x2_t*)(tot + (0 * 8 + g) * 128 + dk0), tb = *(const LAS f32x2_t*)(tot + (1 * 8 + g) * 128 + dk0);
#pragma unroll
                for (int c = 0; c < 2; ++c) { clF[c] += tf[c]; clB[c] += tb[c]; if (g < tq) offF[c] += tf[c]; if (g > tq) offB[c] += tb[c]; } }
            __syncthreads();
            const int pc = hh * 128 + (dk0 & ~31) + sig5(dk0 & 31);
#pragma unroll
            for (int i = 0; i < 4; ++i) { const int row = row0 + 4 * tq + i;
                const unsigned qw = *(const unsigned*)(QK1 + (size_t)row * D + hh * 128 + dk0), kw = *(const unsigned*)(QK1 + (size_t)row * D + 512 + hh * 128 + dk0);
                const float q[2] = {bflo(qw), bfhi(qw)}, k[2] = {bflo(kw), bfhi(kw)};
                float qdv[2][2], kiv[2][2];
#pragma unroll
                for (int c = 0; c < 2; ++c) { const float cF = offF[c] + cf[i][c], cB = offB[c] + sb[i][c];
                    qdv[0][c] = q[c] * __expf(cF); kiv[0][c] = k[c] * __expf(-cF); qdv[1][c] = q[c] * __expf(cB); kiv[1][c] = k[c] * __expf(-cB); }
#pragma unroll
                for (int d = 0; d < 2; ++d) {
                    *(unsigned*)(QDd[d] + (size_t)row * 512 + pc) = cvtpk(qdv[d][0], qdv[d][1]);
                    const unsigned kp = cvtpk(kiv[d][0], kiv[d][1]);
                    *(unsigned*)(KId[d] + (size_t)row * 512 + pc) = kp;
                } }
            if (tq == 0) { *(f32x2_t*)(ECL + ((size_t)(rc * 2 + 0) * 4 + hh) * 256 + dk0) = (f32x2_t){__expf(clF[0]), __expf(clF[1])};
                           *(f32x2_t*)(ECL + ((size_t)(rc * 2 + 1) * 4 + hh) * 256 + dk0) = (f32x2_t){__expf(clB[0]), __expf(clB[1])}; }
            { const int dv = tid & 255, th = tid >> 8; unsigned vw[8];
#pragma unroll
              for (int i = 0; i < 16; ++i) { const unsigned bv = V1[(size_t)(row0 + 16 * th + i) * D + hh * 256 + dv];
                  const int cc = sig5(i);
                  if (cc & 1) vw[cc >> 1] |= bv << 16; else vw[cc >> 1] = bv; }
              bf16_t* vp = VT + ((size_t)rc * 1024 + hh * 256 + dv) * 32 + 16 * th;
              u32x4 o0; o0.x = vw[0]; o0.y = vw[1]; o0.z = vw[2]; o0.w = vw[3]; *(u32x4*)vp = o0;
              u32x4 o1; o1.x = vw[4]; o1.y = vw[5]; o1.z = vw[6]; o1.w = vw[7]; *(u32x4*)(vp + 8) = o1; }
        }
    }
    SEAM(14);

    if (IN(15)) {
        const int xl = blockIdx.x & 7, jj = blockIdx.x >> 3;
        const bool scan_role = (jj & 1) == 0;
        const int nscan = ((F.G >> 3) + 1) / 2 * 8, nconv = F.G - nscan;
        if ((F.G & 7) == 0 && nconv > 0 && !scan_role) {
            LAS float* scr = (LAS float*)(F.lds + wave * 16640);
            const int cidx = xl * (F.G >> 4) + (jj >> 1); int base = 0; const int gwi = cidx * 8 + wave, ngw = nconv * 8;
            for (int e = 0; e < NEXP; ++e) {
                conv64_run(Conv64{args.in[I_MWG] + (size_t)e * D * EXD, args.in[I_MWU] + (size_t)e * D * EXD, EXD, 1024, N_GU1, wsp<bf16_t>(F, O_WGU1) + (size_t)e * N_GU1 * 1024 / 2, 3, 0, 0, 64.0f, 1}, scr, lane, gwi, ngw, base);
                conv64_run(Conv64{args.in[I_MWD] + (size_t)e * EXD * D, nullptr, 1024, EXD, 1024, wsp<bf16_t>(F, O_WD1) + (size_t)e * 1024 * EXD / 2, 0, 1024, 1024, 64.0f, 1}, scr, lane, gwi, ngw, base);
            }
        } else {
        const bool split = (F.G & 7) == 0 && nconv > 0;
        const int sidx = split ? xl * ((F.G >> 4) + ((F.G >> 3) & 1)) + (jj >> 1) : F.vcu, nsw = split ? nscan : F.G;
        const bf16_t* VT = wsp<bf16_t>(F, O_VT); const float* ECL = wsp<float>(F, O_ECL);
        constexpr int SLOT = 8192 * 2 + 2 * 2048 + 1024;
        const int r32 = lane & 31, hi = lane >> 5;
        for (int unit = sidx; unit < 128; unit += nsw) {
            const int chain = unit >> 2, dvp = unit & 3, b = chain >> 3, hh = (chain >> 1) & 3, dir = chain & 1;
            const int dvb = dvp * 2 + (wave & 1);
            const bf16_t* QDp = wsp<bf16_t>(F, dir ? O_QDB : O_QDF); const bf16_t* KIp = wsp<bf16_t>(F, dir ? O_KIB : O_KIF);
            bf16_t* Odp = wsp<bf16_t>(F, dir ? O_OB : O_OF);
            auto rcof = [&](int step) { return step < 8 ? 512 + b * 8 + (dir ? 7 - step : step) : b * 128 + (dir ? 127 - (step - 8) : (step - 8)); };
            const unsigned lds0 = (unsigned)(size_t)F.lds;
            auto dma = [&](int step, int slot) {
                if (wave < 2) return;
                const int rc = rcof(step); const unsigned sb = lds0 + slot * SLOT;
#pragma unroll
                for (int i = 0; i < 4; ++i) { const int j = (wave - 2) + 6 * i; if (j >= 21) break;
                    if (j < 16) { const int p = j & 7; const int r = 4 * p + (lane >> 4), c = (lane & 15) ^ (r & 15);
                        glds16((j < 8 ? KIp : QDp) + (size_t)(rc * 32 + r) * 512 + hh * 128 + c * 8, (unsigned)__builtin_amdgcn_readfirstlane(sb + j * 1024)); }
                    else if (j < 20) { const int p = j - 16; const int r = 16 * (p & 1) + (lane >> 2), c = (lane & 3) ^ ((r >> 2) & 3);
                        glds16(VT + ((size_t)rc * 1024 + hh * 256 + (dvp * 2 + (p >> 1)) * 32 + r) * 32 + c * 8, (unsigned)__builtin_amdgcn_readfirstlane(sb + 16384 + p * 1024)); }
                    else glds16(ECL + ((size_t)(rc * 2 + dir) * 4 + hh) * 256 + lane * 4, (unsigned)__builtin_amdgcn_readfirstlane(sb + 20480)); }
            };
            auto wait_bar = [&](int ngrp) { if (wave < 2) { asm volatile("s_waitcnt lgkmcnt(0)\n\ts_barrier" ::: "memory"); }
                else if (ngrp == 0) { WAIT_BAR(0); } else if (ngrp == 1) { if (wave < 5) { WAIT_BAR(4); } else { WAIT_BAR(3); } } else { if (wave < 5) { WAIT_BAR(8); } else { WAIT_BAR(6); } } };
            f32x16 S4[4];
#pragma unroll
            for (int k = 0; k < 4; ++k)
#pragma unroll
                for (int r = 0; r < 16; ++r) S4[k][r] = 0.f;
            dma(0, 0); dma(1, 1); dma(2, 2);
            wait_bar(2);
            int slot = 0;
            for (int step = 0; step < 136; ++step) {
                if (step + 3 < 136) dma(step + 3, (slot + 3) & 3);
                if (wave < 2) {
                    const LAS unsigned char* sb = F.lds + slot * SLOT;
                    const int x15 = r32 & 15, x3 = (r32 >> 2) & 3;
                    const int trq = (lane & 15) >> 2, trp = lane & 3, trpp = ((trp & 1) << 1) | (trp >> 1), trg = (lane >> 4) & 1;
                    const LAS unsigned char* vbase = sb + 16384 + wave * 2048;
                    bf16x8 qdF[8], kiF[8];
#pragma unroll
                    for (int k = 0; k < 8; ++k) { qdF[k] = *(const LAS bf16x8*)(sb + 8192 + r32 * 256 + (((2 * k + hi) ^ x15) << 4)); kiF[k] = *(const LAS bf16x8*)(sb + r32 * 256 + (((2 * k + hi) ^ x15) << 4)); }
                    const bf16x8 vF0 = *(const LAS bf16x8*)(vbase + r32 * 64 + ((hi ^ x3) << 4)), vF1 = *(const LAS bf16x8*)(vbase + r32 * 64 + (((2 + hi) ^ x3) << 4));
                    __builtin_amdgcn_sched_barrier(0);
                    f32x16 o;
#pragma unroll
                    for (int r = 0; r < 16; ++r) o[r] = 0.f;
                    if (step >= 8) {
                        f32x16 sc;
#pragma unroll
                        for (int r = 0; r < 16; ++r) sc[r] = 0.f;
#pragma unroll
                        for (int k = 0; k < 8; ++k) sc = __builtin_amdgcn_mfma_f32_32x32x16_bf16(kiF[k], qdF[k], sc, 0, 0, 0);
#pragma unroll
                        for (int r = 0; r < 16; ++r) { const int s = (r & 3) + 8 * (r >> 2) + 4 * hi; const bool keep = dir ? (s >= r32) : (s <= r32); sc[r] = keep ? sc[r] : 0.f; }
                        u32x4 w; bf16x8 pf0, pf1;
                        w.x = cvtpk(sc[0], sc[1]); w.y = cvtpk(sc[2], sc[3]); w.z = cvtpk(sc[4], sc[5]); w.w = cvtpk(sc[6], sc[7]); pf0 = __builtin_bit_cast(bf16x8, w);
                        w.x = cvtpk(sc[8], sc[9]); w.y = cvtpk(sc[10], sc[11]); w.z = cvtpk(sc[12], sc[13]); w.w = cvtpk(sc[14], sc[15]); pf1 = __builtin_bit_cast(bf16x8, w);
                        o = __builtin_amdgcn_mfma_f32_32x32x16_bf16(vF0, pf0, o, 0, 0, 0);
                        o = __builtin_amdgcn_mfma_f32_32x32x16_bf16(vF1, pf1, o, 0, 0, 0);
#pragma unroll
                        for (int blk = 0; blk < 4; ++blk)
#pragma unroll
                            for (int s2 = 0; s2 < 2; ++s2) { u32x4 ws4; ws4.x = cvtpk(S4[blk][8 * s2], S4[blk][8 * s2 + 1]); ws4.y = cvtpk(S4[blk][8 * s2 + 2], S4[blk][8 * s2 + 3]);
                                ws4.z = cvtpk(S4[blk][8 * s2 + 4], S4[blk][8 * s2 + 5]); ws4.w = cvtpk(S4[blk][8 * s2 + 6], S4[blk][8 * s2 + 7]);
                                o = __builtin_amdgcn_mfma_f32_32x32x16_bf16(__builtin_bit_cast(bf16x8, ws4), qdF[2 * blk + s2], o, 0, 0, 0); }
                        const int rc = rcof(step);
                        bf16_t* op = Odp + (size_t)(rc * 32 + r32) * D + hh * 256 + dvb * 32 + 4 * hi;
#pragma unroll
                        for (int g = 0; g < 4; ++g) { u32x2 w2; w2.x = cvtpk(o[4 * g], o[4 * g + 1]); w2.y = cvtpk(o[4 * g + 2], o[4 * g + 3]); *(u32x2*)(op + 8 * g) = w2; }
                    }
#pragma unroll
                    for (int blk = 0; blk < 4; ++blk) {
                        bf16x8 kt0, kt1;
                        { const int chunk = 4 * blk + 2 * trg + (trpp >> 1); const int wb = (trpp & 1) * 8;
                          const int tl = 4 * hi + trq, th = tl + 8;
                          const LAS unsigned char* pl = sb + tl * 256 + ((chunk ^ tl) << 4) + wb; const LAS unsigned char* ph = sb + th * 256 + ((chunk ^ th) << 4) + wb;
                          const s16x4 a0 = vtr(pl), a1 = vtr(ph), b0 = vtr(pl + 4096), b1 = vtr(ph + 4096);
                          kt0 = (bf16x8){a0[0], a0[1], a0[2], a0[3], a1[0], a1[1], a1[2], a1[3]}; kt1 = (bf16x8){b0[0], b0[1], b0[2], b0[3], b1[0], b1[1], b1[2], b1[3]}; }
                        S4[blk] = __builtin_amdgcn_mfma_f32_32x32x16_bf16(kt0, vF0, S4[blk], 0, 0, 0);
                        S4[blk] = __builtin_amdgcn_mfma_f32_32x32x16_bf16(kt1, vF1, S4[blk], 0, 0, 0);
#pragma unroll
                        for (int g = 0; g < 4; ++g) { const f32x4 e4 = *(const LAS f32x4*)(sb + 20480 + (32 * blk + 8 * g + 4 * hi) * 4);
                            S4[blk][4 * g] *= e4[0]; S4[blk][4 * g + 1] *= e4[1]; S4[blk][4 * g + 2] *= e4[2]; S4[blk][4 * g + 3] *= e4[3]; }
                    }
                }
                wait_bar(step + 3 < 136 ? 2 : (step + 2 < 136 ? 1 : 0));
                slot = (slot + 1) & 3;
            }
        }
        if (!split) {
            LAS float* scr = (LAS float*)(F.lds + wave * 16640); int base = 0;
            for (int e = 0; e < NEXP; ++e) {
                conv64_run(Conv64{args.in[I_MWG] + (size_t)e * D * EXD, args.in[I_MWU] + (size_t)e * D * EXD, EXD, 1024, N_GU1, wsp<bf16_t>(F, O_WGU1) + (size_t)e * N_GU1 * 1024 / 2, 3, 0, 0, 64.0f, 1}, scr, lane, gw, NGW, base);
                conv64_run(Conv64{args.in[I_MWD] + (size_t)e * EXD * D, nullptr, 1024, EXD, 1024, wsp<bf16_t>(F, O_WD1) + (size_t)e * 1024 * EXD / 2, 0, 1024, 1024, 64.0f, 1}, scr, lane, gw, NGW, base);
            }
        }
        }
    }
    SEAM(15);

    if (IN(16)) {
        const bf16_t* OFp = wsp<bf16_t>(F, O_OF); const bf16_t* OBp = wsp<bf16_t>(F, O_OB); const bf16_t* G1 = wsp<bf16_t>(F, O_G1); bf16_t* GA = wsp<bf16_t>(F, O_GA);
        const float* on = args.in[I_GONORM];
        for (int row = gw; row < RL; row += NGW) {
            const u32x4* pf = (const u32x4*)(OFp + (size_t)row * D + lane * 16); const u32x4* pb = (const u32x4*)(OBp + (size_t)row * D + lane * 16); const u32x4* pg = (const u32x4*)(G1 + (size_t)row * D + lane * 16);
            float v[16], gv[16];
#pragma unroll
            for (int q = 0; q < 2; ++q) { const u32x4 a = pf[q], bq = pb[q], gq = pg[q]; const unsigned aw[4] = {a.x, a.y, a.z, a.w}, bw[4] = {bq.x, bq.y, bq.z, bq.w}, gw4[4] = {gq.x, gq.y, gq.z, gq.w};
#pragma unroll
                for (int j = 0; j < 4; ++j) { v[8 * q + 2 * j] = bflo(aw[j]) + bflo(bw[j]); v[8 * q + 2 * j + 1] = bfhi(aw[j]) + bfhi(bw[j]); gv[8 * q + 2 * j] = bflo(gw4[j]); gv[8 * q + 2 * j + 1] = bfhi(gw4[j]); } }
            float ss = 0.f;
#pragma unroll
            for (int j = 0; j < 16; ++j) ss += v[j] * v[j];
            ss += __shfl_xor(ss, 1); ss += __shfl_xor(ss, 2); ss += __shfl_xor(ss, 4); ss += __shfl_xor(ss, 8);
            const float rstd = __builtin_amdgcn_rsqf(ss * (1.0f / 256.0f) + EPS);
            const int c0 = (lane & 15) * 16;
            unsigned ow[8];
#pragma unroll
            for (int j = 0; j < 8; ++j) { const float a = v[2 * j] * rstd * on[c0 + 2 * j] * silu_f(gv[2 * j]), bq = v[2 * j + 1] * rstd * on[c0 + 2 * j + 1] * silu_f(gv[2 * j + 1]); ow[j] = cvtpk(a, bq); }
            u32x4* po = (u32x4*)(GA + (size_t)row * D + lane * 16);
            u32x4 o0; o0.x = ow[0]; o0.y = ow[1]; o0.z = ow[2]; o0.w = ow[3]; po[0] = o0; u32x4 o1; o1.x = ow[4]; o1.y = ow[5]; o1.z = ow[6]; o1.w = ow[7]; po[1] = o1;
        }
    }
    SEAM(16);

    if (IN(17)) {
        pg8::DenseProb P{wsp<bf16_t>(F, O_GA), wsp<bf16_t>(F, O_WOUT1), 1024, 1024, 1024, {}}; P.ord.init(RL / 256, 4, F.G, (int)blockIdx.x);
        pg8::EpiBf16 E{(bf16_t*)Y, D, nullptr};
        pg8::gemm_phase(F.lds, P, E);
    }
    SEAM(17);

    if (IN(18)) {
        int* SEL = wsp<int>(F, O_SEL); int* ROWTOK = wsp<int>(F, O_ROWTOK);
        LAS float* wr_l = (LAS float*)F.lds;
        LAS int* se = (LAS int*)(F.lds + 32768);
        LAS float* sw = (LAS float*)(F.lds + 32768 + 512);
        LAS int* sbase = (LAS int*)(F.lds + 32768 + 1024);
        for (int i = tid; i < 8192; i += 512) wr_l[i] = args.in[I_MROUTER][i];
        __syncthreads();
        for (int tile = F.vcu; tile < RL / 64; tile += F.G) {
            for (int rr = 0; rr < 8; ++rr) {
                const int lr = wave * 8 + rr, row = tile * 64 + lr; const int b = row >> 12;
                float* hp = args.out + (size_t)row * D;
                f32x4 y[4], h[4], uo[4]; load_row_bf16((const bf16_t*)Y + (size_t)row * D, lane, y); load_row(hp, lane, h);
                const float rstd = __builtin_amdgcn_rsqf(row_ssq(y) * (1.0f / D) + EPS);
#pragma unroll
                for (int j = 0; j < 4; ++j) { const int c = 4 * lane + 256 * j; const f32x4 g = *(const f32x4*)(normg + 5 * D + c), mg = *(const f32x4*)(MV(1, b, 2) + c);
                    h[j] = h[j] + mg * (y[j] * rstd * g); *(f32x4*)(hp + c) = h[j]; }
                norm_mod_store(h, normg + 6 * D, MV(1, b, 3), MV(1, b, 4), nullptr, lane, uo, wsp<unsigned char>(F, O_U) + (size_t)row * D);
                float lg[8];
#pragma unroll
                for (int e = 0; e < 8; ++e) lg[e] = 0.f;
#pragma unroll
                for (int j = 0; j < 4; ++j)
#pragma unroll
                    for (int q = 0; q < 4; ++q) { const int k = 4 * lane + 256 * j + q; const LAS f32x4* wp = (const LAS f32x4*)(wr_l + k * 8); const f32x4 w0 = wp[0], w1 = wp[1]; const float uv = uo[j][q];
                        lg[0] += uv * w0[0]; lg[1] += uv * w0[1]; lg[2] += uv * w0[2]; lg[3] += uv * w0[3]; lg[4] += uv * w1[0]; lg[5] += uv * w1[1]; lg[6] += uv * w1[2]; lg[7] += uv * w1[3]; }
#pragma unroll
                for (int e = 0; e < 8; ++e) lg[e] = wave_sum(lg[e]) + args.in[I_MBROUTER][e];
                int e0 = 0; float l0 = lg[0];
#pragma unroll
                for (int e = 1; e < 8; ++e) if (lg[e] > l0) { l0 = lg[e]; e0 = e; }
                int e1 = -1; float l1 = -3.0e38f;
#pragma unroll
                for (int e = 0; e < 8; ++e) if (e != e0 && lg[e] > l1) { l1 = lg[e]; e1 = e; }
                const float p1 = __expf(l1 - l0), w0n = 1.0f / (1.0f + p1), w1n = p1 / (1.0f + p1);
                if (lane == 0) { se[lr * 2] = e0; se[lr * 2 + 1] = e1; sw[lr * 2] = w0n; sw[lr * 2 + 1] = w1n; }
            }
            __syncthreads();
            if (tid < 8) { int c = 0; for (int r2 = 0; r2 < 64; ++r2) c += (se[2 * r2] == tid) + (se[2 * r2 + 1] == tid);
                sbase[tid] = (int)__hip_atomic_fetch_add(ctl + CW_CNT + 64 * tid, (unsigned)c, RLX_AGENT); }
            __syncthreads();
            if (tid < 64) { const int e0 = se[2 * tid], e1 = se[2 * tid + 1]; int r0 = 0, r1 = 0;
                for (int r2 = 0; r2 < tid; ++r2) { const int a0 = se[2 * r2], a1 = se[2 * r2 + 1]; r0 += (a0 == e0) + (a1 == e0); r1 += (a0 == e1) + (a1 == e1); }
                const int p0 = sbase[e0] + r0, p1 = sbase[e1] + r1, tok = tile * 64 + tid;
                ROWTOK[e0 * CAPE + p0] = tok; ROWTOK[e1 * CAPE + p1] = tok;
                int* sp = SEL + (size_t)tok * 8; sp[0] = e0; sp[1] = p0; sp[2] = e1; sp[3] = p1; sp[4] = __float_as_int(sw[2 * tid]); sp[5] = __float_as_int(sw[2 * tid + 1]); }
            __syncthreads();
        }
    }
    SEAM(18);

    pg8::MoeTiles MT;
    if (IN(19) || IN(20) || IN(21)) {
        int acc = 0; MT.tp8 = 0ull; MT.c4a = 0ull; MT.c4b = 0ull;
#pragma unroll
        for (int e = 0; e < 8; ++e) { const int c = (int)__builtin_amdgcn_readfirstlane((int)__hip_atomic_load(ctl + CW_CNT + 64 * e, RLX_AGENT));
            if (e < 4) MT.c4a |= (unsigned long long)(unsigned)c << (16 * e); else MT.c4b |= (unsigned long long)(unsigned)c << (16 * (e - 4));
            MT.tp8 |= (unsigned long long)(unsigned)acc << (8 * e); acc += (c + 255) >> 8; }
        MT.nt = acc;
    }
    if (IN(19)) {
        pg8::MoeGuProb P{wsp<unsigned char>(F, O_U), wsp<unsigned char>(F, O_WGU1), 512, 512, {}, MT, wsp<int>(F, O_ROWTOK)}; P.ord.init(MT.nt, N_GU1 / 256, F.G, (int)blockIdx.x);
        pg8::EpiSwiglu8 E{wsp<unsigned char>(F, O_HM), EXD};
        pg8::gemm_phase(F.lds, P, E);
    }
    SEAM(19);
    if (IN(20)) {
        pg8::MoeDnProb P{wsp<unsigned char>(F, O_HM), wsp<unsigned char>(F, O_WD1), EXD / 2, EXD / 2, {}, MT}; P.ord.init(MT.nt, 4, F.G, (int)blockIdx.x);
        pg8::EpiBf16 E{wsp<bf16_t>(F, O_YE), D, nullptr};
        pg8::gemm_phase(F.lds, P, E);
    }
    SEAM(20);
    if (IN(21)) {
        const int* SEL = wsp<int>(F, O_SEL); const bf16_t* YE = wsp<bf16_t>(F, O_YE);
        for (int row = gw; row < RL; row += NGW) {
            const int b = row >> 12; const int* sp = SEL + (size_t)row * 8;
            const int e0 = sp[0], p0 = sp[1], e1 = sp[2], p1 = sp[3]; const float w0 = __int_as_float(sp[4]), w1 = __int_as_float(sp[5]);
            const int t0 = pg8::moe_tp(MT, e0), t1 = pg8::moe_tp(MT, e1);
            const bf16_t* y0 = YE + ((size_t)t0 * 256 + p0) * D; const bf16_t* y1 = YE + ((size_t)t1 * 256 + p1) * D;
            float* hp = args.out + (size_t)row * D;
            f32x4 y[4], h[4]; load_row(hp, lane, h);
#pragma unroll
            for (int j = 0; j < 4; ++j) { const int c = 4 * lane + 256 * j; const u32x2 a = *(const u32x2*)(y0 + c), bq = *(const u32x2*)(y1 + c);
                y[j][0] = w0 * bflo(a.x) + w1 * bflo(bq.x); y[j][1] = w0 * bfhi(a.x) + w1 * bfhi(bq.x); y[j][2] = w0 * bflo(a.y) + w1 * bflo(bq.y); y[j][3] = w0 * bfhi(a.y) + w1 * bfhi(bq.y); }
            const float rstd = __builtin_amdgcn_rsqf(row_ssq(y) * (1.0f / D) + EPS);
#pragma unroll
            for (int j = 0; j < 4; ++j) { const int c = 4 * lane + 256 * j; const f32x4 g = *(const f32x4*)(normg + 7 * D + c), mg = *(const f32x4*)(MV(1, b, 5) + c);
                *(f32x4*)(hp + c) = h[j] + mg * (y[j] * rstd * g); }
        }
    }
#undef IN
#undef SEAM
#undef MV
}

constexpr int N_PHASES = 22;
extern "C" void kernel_launch(void* const* d_in, const int* in_sizes, int n_in, void* d_out, int out_size, void* d_ws, size_t ws_size, hipStream_t stream) {
    static int grid = 0;
    if (grid == 0) {
        if (n_in != 27 || out_size != RL * D || ws_size < WS_END) { fprintf(stderr, "kernel_launch: unexpected shapes n_in %d out %d ws %zu (need %zu)\n", n_in, out_size, ws_size, (size_t)WS_END); grid = -1; return; }
        int dev = 0, cus = 0, per_cu = 0;
        if (hipGetDevice(&dev) != hipSuccess || hipDeviceGetAttribute(&cus, hipDeviceAttributeMultiprocessorCount, dev) != hipSuccess) { grid = -1; return; }
        if (hipFuncSetAttribute((const void*)mk_fwd, hipFuncAttributeMaxDynamicSharedMemorySize, LDS_BYTES) != hipSuccess) { fprintf(stderr, "kernel_launch: hipFuncSetAttribute failed\n"); grid = -1; return; }
        if (hipOccupancyMaxActiveBlocksPerMultiprocessor(&per_cu, (const void*)mk_fwd, 512, LDS_BYTES) != hipSuccess || per_cu < 1) { fprintf(stderr, "kernel_launch: occupancy query says %d\n", per_cu); }
        (void)hipGetLastError();
        grid = cus;
        if (grid > 256) grid = 256;
    }
    if (grid < 0) return;
    (void)hipMemsetAsync((char*)d_ws + O_CTL, 0, CTL_BYTES, stream);
    Args a{};
    for (int i = 0; i < 27; ++i) a.in[i] = (const float*)d_in[i];
    a.out = (float*)d_out; a.ws = (unsigned char*)d_ws;
#if MK_ONE_LAUNCH
    a.ph_lo = 0; a.ph_hi = N_PHASES;
    hipLaunchKernelGGL(mk_fwd, dim3(grid), dim3(512), LDS_BYTES, stream, a);
#else
    for (int p = 0; p < N_PHASES; ++p) { a.ph_lo = p; a.ph_hi = p + 1; for (int rep = 0; rep < (p == MK_REP ? 2 : 1); ++rep) hipLaunchKernelGGL(mk_fwd, dim3(grid), dim3(512), LDS_BYTES, stream, a); }
#endif
}
```

```cpp
#include <hip/hip_runtime.h>
#include <cstdio>
#include <cstdint>

#ifndef MK_ONE_LAUNCH
#define MK_ONE_LAUNCH 1
#endif
#ifndef MK_EPI2
#define MK_EPI2 0
#endif
#ifndef MK_REP
#define MK_REP -1
#endif

#define LAS __attribute__((address_space(3)))
#define GAS __attribute__((address_space(1)))
typedef unsigned short bf16_t;
typedef short bf16x8 __attribute__((ext_vector_type(8)));
typedef short s16x4 __attribute__((ext_vector_type(4)));
typedef float f32x4 __attribute__((ext_vector_type(4)));
typedef float f32x16 __attribute__((ext_vector_type(16)));
typedef unsigned u32x4 __attribute__((ext_vector_type(4)));
typedef unsigned u32x2 __attribute__((ext_vector_type(2)));
typedef float f32x2_t __attribute__((ext_vector_type(2)));
typedef __bf16 bf16x2_t __attribute__((ext_vector_type(2)));
#define RLX_AGENT __ATOMIC_RELAXED, __HIP_MEMORY_SCOPE_AGENT

__device__ __forceinline__ unsigned cvtpk(float lo, float hi) { f32x2_t v = {lo, hi}; bf16x2_t b = __builtin_convertvector(v, bf16x2_t); return __builtin_bit_cast(unsigned, b); }
__device__ __forceinline__ bf16_t f2bf(float f) { return (bf16_t)(cvtpk(f, 0.f) & 0xffffu); }
__device__ __forceinline__ float bflo(unsigned w) { return __uint_as_float(w << 16); }
__device__ __forceinline__ float bfhi(unsigned w) { return __uint_as_float(w & 0xffff0000u); }
__device__ __forceinline__ float bf2f(bf16_t b) { return __uint_as_float(((unsigned)b) << 16); }
__device__ __forceinline__ float wave_sum(float v) {
#pragma unroll
    for (int o = 1; o < 64; o <<= 1) v += __shfl_xor(v, o);
    return v;
}
__device__ __forceinline__ float fast_exp(float x) { return __builtin_amdgcn_exp2f(x * 1.4426950408889634f); }
__device__ __forceinline__ float clamp8(float x) { return __builtin_amdgcn_fmed3f(x, -448.0f, 448.0f); }
__device__ __forceinline__ unsigned pack_fp8x4(float a, float b, float c, float d) { int w = __builtin_amdgcn_cvt_pk_fp8_f32(clamp8(a), clamp8(b), 0, false); w = __builtin_amdgcn_cvt_pk_fp8_f32(clamp8(c), clamp8(d), w, true); return (unsigned)w; }
__device__ __forceinline__ float swiglu_f(float gp, float up, float k) { return (gp * up) * __builtin_amdgcn_rcpf(__builtin_fmaf(__builtin_amdgcn_exp2f(gp), k, k)); }
__device__ __forceinline__ float silu_f(float g) { return g * __builtin_amdgcn_rcpf(1.0f + fast_exp(-g)); }

#define XB_TMO      128
#define XB_XCNT(j)  (256  + 64 * (j))
#define XB_XSUB(j)  (1280 + 64 * (j))
#define XB_XGEN(j)  (2304 + 64 * (j))
#define XB_TOP      3328
#define XB_TOPGEN   3392
#define XCD_BAR_WORDS 3456
#define XB_SPIN_CAP (1u << 18)
__device__ __forceinline__ unsigned xb_ld(unsigned* p)              { return __hip_atomic_load(p, __ATOMIC_RELAXED, __HIP_MEMORY_SCOPE_AGENT); }
__device__ __forceinline__ unsigned xb_add(unsigned* p, unsigned v) { return __hip_atomic_fetch_add(p, v, __ATOMIC_RELAXED, __HIP_MEMORY_SCOPE_AGENT); }
__device__ __forceinline__ unsigned xb_xcc_id() { return (unsigned)__builtin_amdgcn_s_getreg((3 << 11) | 20) & 0xFu; }
#define XB_SPIN(cond, bar) do { unsigned _sp = 0; while (cond) { __builtin_amdgcn_s_sleep(1); \
    if ((++_sp & 255u) == 0u) { if (xb_ld(&(bar)[XB_TMO])) break; if (_sp > XB_SPIN_CAP) { atomicAdd(&(bar)[XB_TMO], 1u); break; } } } } while (0)
struct XcdBarrier { unsigned* bar; unsigned x; volatile LAS unsigned* st; };
__device__ __forceinline__ XcdBarrier xcd_barrier_post(unsigned* bar, volatile LAS unsigned* st) {
    XcdBarrier b; b.bar = bar; b.x = xb_xcc_id(); b.st = st;
    if (threadIdx.x == 0) (void)xb_add(&bar[XB_XCNT(b.x)], 1u);
    return b;
}
__device__ __forceinline__ void xcd_barrier_complete(unsigned* bar, unsigned x, unsigned& nloc, unsigned& nx) {
    const unsigned G = gridDim.x * gridDim.y * gridDim.z;
    unsigned sum, cnt, mine, sp = 0u;
    for (;;) {
        sum = 0u; cnt = 0u; mine = 0u;
#pragma unroll
        for (unsigned j = 0; j < 16; ++j) { const unsigned c = xb_ld(&bar[XB_XCNT(j)]); sum += c; cnt += (c > 0u) ? 1u : 0u; mine = (j == x) ? c : mine; }
        if (sum == G) break;
        __builtin_amdgcn_s_sleep(1);
        if ((++sp & 255u) == 0u) { if (xb_ld(&bar[XB_TMO])) break; if (sp > XB_SPIN_CAP) { atomicAdd(&bar[XB_TMO], 1u); break; } }
    }
    nloc = mine > 0u ? mine : 1u; nx = cnt > 0u ? cnt : 1u;
}
__device__ __forceinline__ void xcd_barrier(const XcdBarrier& b) {
    asm volatile("s_waitcnt vmcnt(0)" ::: "memory");
    __syncthreads();
    if (threadIdx.x == 0) {
        unsigned* bar = b.bar;
        __builtin_amdgcn_s_waitcnt(0);
        unsigned nloc = b.st[0], nx = b.st[1];
        if (nloc == 0u) { xcd_barrier_complete(bar, b.x, nloc, nx); b.st[0] = nloc; b.st[1] = nx; }
        const unsigned old = xb_add(&bar[XB_XSUB(b.x)], 1u);
        const unsigned gen = old / nloc;
        if (old + 1u == (gen + 1u) * nloc) {
            __builtin_amdgcn_fence(__ATOMIC_RELEASE, "agent");
            asm volatile("s_waitcnt vmcnt(0)" ::: "memory");
            const unsigned og = xb_add(&bar[XB_TOP], 1u);
            const unsigned tg = og / nx;
            if (og + 1u == (tg + 1u) * nx) xb_add(&bar[XB_TOPGEN], 1u);
            else XB_SPIN(xb_ld(&bar[XB_TOPGEN]) == tg, bar);
            __builtin_amdgcn_fence(__ATOMIC_ACQUIRE, "agent");
            xb_add(&bar[XB_XGEN(b.x)], 1u);
            asm volatile("s_waitcnt vmcnt(0)" ::: "memory");
        } else {
            XB_SPIN(xb_ld(&bar[XB_XGEN(b.x)]) == gen, bar);
            __builtin_amdgcn_fence(__ATOMIC_ACQUIRE, "agent");
            asm volatile("s_waitcnt vmcnt(0)" ::: "memory");
        }
    }
    __syncthreads();
}

constexpr int D = 1024, NB = 4, SEQ = 4096, CTX = 256;
constexpr int RL = NB * SEQ;
constexpr int RC = NB * CTX;
constexpr int R = RL + RC;
constexpr float EPS = 1e-6f;
constexpr float LOG2E = 1.4426950408889634f;
constexpr int N_IN0 = 1536, N_QA = 768, N_KVA = 1024, FFN = 2816, N_GU0 = 2 * FFN, N_IN1 = 3328, EXD = 3584, N_GU1 = 2 * EXD, NEXP = 8;
constexpr int CAPE = 16384;

constexpr size_t MiB = 1u << 20;
constexpr size_t O_CTL = 0;
constexpr size_t CTL_BYTES = 65536;
constexpr int CW_BAR = 0;
constexpr int CW_CNT = 8192;
constexpr size_t O_MODV = 1 * MiB;
constexpr size_t O_TAB16 = O_MODV + 256 * 1024;
constexpr size_t O_TAB32 = O_TAB16 + 8192;
constexpr size_t O_RSTDQ = O_TAB32 + 16384;
constexpr size_t O_RSTDKV = O_RSTDQ + 81920;
constexpr size_t O_SEL = 2 * MiB;
constexpr size_t O_ROWTOK = 3 * MiB;
constexpr size_t O_WGU1 = 4 * MiB;
constexpr size_t O_YE = O_WGU1;
constexpr size_t O_WD1 = 116 * MiB;
constexpr size_t O_WIN1 = 172 * MiB;
constexpr size_t O_WOUT1 = 179 * MiB;
constexpr size_t O_WIN0 = 181 * MiB;
constexpr size_t O_WUQ = 184 * MiB;
constexpr size_t O_WUKV = 185 * MiB;
constexpr size_t O_WOUT0 = 186 * MiB;
constexpr size_t O_WGU0 = 188 * MiB;
constexpr size_t O_WD0 = 199 * MiB;
constexpr size_t O_HC = 205 * MiB;
constexpr size_t O_U = 209 * MiB;
constexpr size_t O_Y = 243 * MiB;
constexpr size_t O_Z0 = 311 * MiB;
constexpr size_t O_QA = 362 * MiB;
constexpr size_t O_KVA = 388 * MiB;
constexpr size_t O_QB = 422 * MiB;
constexpr size_t O_KB = 439 * MiB;
constexpr size_t O_KR = 444 * MiB;
constexpr size_t O_AO = 446 * MiB;
constexpr size_t O_H0 = 311 * MiB;
constexpr size_t O_QK1 = 311 * MiB;
constexpr size_t O_V1 = 345 * MiB;
constexpr size_t O_G1 = 379 * MiB;
constexpr size_t O_RR = 413 * MiB;
constexpr size_t O_QDF = 422 * MiB, O_KIF = 439 * MiB, O_KTF = 456 * MiB, O_QDB = 473 * MiB;
constexpr size_t O_KIB = 243 * MiB, O_KTB = 260 * MiB, O_VT = 277 * MiB;
constexpr size_t O_ECL = 490 * MiB;
constexpr size_t O_OF = O_QK1, O_OB = O_V1;
constexpr size_t O_GA = O_QDF;
constexpr size_t O_HM = 243 * MiB;
constexpr size_t WS_END = 495 * MiB;
static_assert(O_HM + (size_t)34816 * EXD * 2 <= 482 * MiB, "HM");
static_assert(O_RR + (size_t)R * 256 * 2 <= O_QDF, "RR");
static_assert(O_ECL + (size_t)544 * 8 * 1024 <= WS_END, "ECL");

constexpr int RING_BYTES = 131072;
constexpr int LDS_BYTES = 163840;
constexpr int LDSCTL_OFF = LDS_BYTES - 256;

struct Args {
    const float* in[27];
    float* out; unsigned char* ws;
    int ph_lo, ph_hi;
};
enum { I_X = 0, I_C, I_CTX, I_CCTX, I_MODW, I_MODB, I_NORMG, I_AWIN, I_AQN, I_AWUQ, I_AKVN, I_AWUKV, I_AQKN, I_AWOUT, I_GWIN, I_GGATE2, I_GBGATE, I_GONORM, I_GWOUT,
       I_FWG, I_FWU, I_FWD, I_MROUTER, I_MBROUTER, I_MWG, I_MWU, I_MWD };

struct Conv { const float* s0; const float* s1; int Nsrc; int K; int Ndst; bf16_t* dst; int mode; const float* kscale; };
__device__ __forceinline__ int ilv64(int p) { return (p >> 5) * 32 + (p & 1) * 16 + ((p & 31) >> 1); }
__device__ __forceinline__ int ilv32(int p) { return (p >> 4) * 16 + (p & 1) * 8 + ((p & 15) >> 1); }
__device__ __forceinline__ const float* conv_col(const Conv& c, int n, float& sc) {
    sc = 1.0f;
    switch (c.mode) {
    case 0: return c.s0 + n;
    case 1: {
        if (n < 640) return c.s0 + n;
        if (n < 1152) { const int hh = (n - 640) >> 6, p = (n - 640) & 63; return c.s0 + 672 + hh * 64 + ilv64(p); }
        if (n < 1280) { const int hh = (n - 1152) >> 6, p = (n - 1152) & 63; return c.s0 + 1184 + hh * 64 + ilv64(p); }
        if (n < 1408) return c.s0 + 1312 + (n - 1280);
        if (n < 1440) return c.s0 + 640 + ilv32(n - 1408);
        return nullptr; }
    case 2: {
        if (n < 512) return c.s0 + (n >> 6) * 96 + (n & 63);
        const int hh = (n - 512) >> 5, p = (n - 512) & 31; return c.s0 + hh * 96 + 64 + ilv32(p); }
    case 3: {
        const int G = n >> 5, j = n & 31; return (j < 16) ? c.s0 + 16 * G + j : c.s1 + 16 * G + (j - 16); }
    case 4: {
        if (n >= 3104) return nullptr;
        if (n < 512) sc = 0.08838834764831845f;
        return c.s0 + n; }
    }
    return nullptr;
}
__device__ __forceinline__ void conv_item(const Conv& c, int item, LAS float* scr, int lane) {
    const int nblk = c.Ndst / 32, kb = item / nblk, nb = item % nblk, k0 = 64 * kb, n0 = 32 * nb;
    float sc; const float* cp = conv_col(c, n0 + (lane & 31), sc);
    const int kh = lane >> 5;
#pragma unroll 16
    for (int i = 0; i < 32; ++i) { const int kk = 2 * i + kh; float v = 0.f;
        if (cp) { v = cp[(size_t)(k0 + kk) * c.Nsrc] * sc; if (c.kscale) v *= c.kscale[k0 + kk]; }
        scr[kk * 33 + (lane & 31)] = v; }
    asm volatile("s_waitcnt lgkmcnt(0)" ::: "memory");
    const int ch = lane & 7;
#pragma unroll
    for (int j = 0; j < 4; ++j) { const int n = (lane >> 3) + 8 * j; const LAS float* s = scr + (8 * ch) * 33 + n;
        u32x4 o; o.x = cvtpk(s[0 * 33], s[1 * 33]); o.y = cvtpk(s[2 * 33], s[3 * 33]); o.z = cvtpk(s[4 * 33], s[5 * 33]); o.w = cvtpk(s[6 * 33], s[7 * 33]);
        *(u32x4*)(c.dst + (size_t)(n0 + n) * c.K + k0 + 8 * ch) = o; }
    asm volatile("s_waitcnt lgkmcnt(0)" ::: "memory");
}

struct Conv64 { const float* s0; const float* s1; int Nsrc; int K; int Ndst; bf16_t* dst; int mode; int nvalid; int nscaled; float rscale; int f8; };
struct Conv64Geo { int k0, n0, nd; bool valid; float sc; const float* src; };
__device__ __forceinline__ Conv64Geo conv64_geo(const Conv64& c, int item, int lane) {
    Conv64Geo g; const int nblk = c.Ndst / 64, kb = item / nblk, nb = item % nblk; g.k0 = 64 * kb; g.n0 = 64 * nb;
    const int c4 = lane & 15, kr = lane >> 4; g.valid = true; g.sc = 1.0f;
    if (c.mode == 3) { const int cc = 4 * (c4 & 7); g.src = c.s0 + ((c4 < 8) ? (long)0 : (long)(c.s1 - c.s0)) + 32 * nb + cc; g.nd = 32 * (cc >> 4) + ((c4 < 8) ? 0 : 16) + (cc & 15); g.sc = c.rscale * ((c4 < 8) ? -1.4426950408889634f : 1.0f); }
    else { g.nd = 4 * c4; g.src = c.s0 + g.n0 + g.nd; g.valid = (g.n0 + g.nd) < c.nvalid; if (g.n0 + g.nd < c.nscaled) g.sc = c.rscale; }
    g.src += (size_t)(g.k0 + kr) * c.Nsrc;
    return g;
}
__device__ __forceinline__ void conv64_load(const Conv64& c, int item, int lane, f32x4 (&v)[16]) {
    const Conv64Geo g = conv64_geo(c, item, lane);
#pragma unroll
    for (int i = 0; i < 16; ++i) v[i] = g.valid ? *(const f32x4*)(g.src + (size_t)(4 * i) * c.Nsrc) : (f32x4){0.f, 0.f, 0.f, 0.f};
}
__device__ __forceinline__ void conv64_store(const Conv64& c, int item, LAS float* scr, int lane, const f32x4 (&v)[16]) {
    const Conv64Geo g = conv64_geo(c, item, lane); const int kr = lane >> 4, nd = g.nd, k0 = g.k0, n0 = g.n0; const float sc = g.sc;
#pragma unroll
    for (int i = 0; i < 16; ++i) { LAS float* p = scr + (4 * i + kr) * 65 + nd; p[0] = v[i][0] * sc; p[1] = v[i][1] * sc; p[2] = v[i][2] * sc; p[3] = v[i][3] * sc; }
    asm volatile("s_waitcnt lgkmcnt(0)" ::: "memory");
    if (c.f8) {
        const int ch = lane & 3; unsigned char* d8 = (unsigned char*)c.dst;
#pragma unroll
        for (int it = 0; it < 4; ++it) { const int r = it * 16 + (lane >> 2); const LAS float* sp = scr + (16 * ch) * 65 + r; u32x4 o;
            o.x = pack_fp8x4(sp[0 * 65], sp[1 * 65], sp[2 * 65], sp[3 * 65]); o.y = pack_fp8x4(sp[4 * 65], sp[5 * 65], sp[6 * 65], sp[7 * 65]);
            o.z = pack_fp8x4(sp[8 * 65], sp[9 * 65], sp[10 * 65], sp[11 * 65]); o.w = pack_fp8x4(sp[12 * 65], sp[13 * 65], sp[14 * 65], sp[15 * 65]);
            *(u32x4*)(d8 + (size_t)(n0 + r) * c.K + k0 + 16 * ch) = o; }
    } else {
    const int ch = lane & 7;
#pragma unroll
    for (int it = 0; it < 8; ++it) { const int r = it * 8 + (lane >> 3); const LAS float* sp = scr + (8 * ch) * 65 + r;
        u32x4 o; o.x = cvtpk(sp[0 * 65], sp[1 * 65]); o.y = cvtpk(sp[2 * 65], sp[3 * 65]); o.z = cvtpk(sp[4 * 65], sp[5 * 65]); o.w = cvtpk(sp[6 * 65], sp[7 * 65]);
        *(u32x4*)(c.dst + (size_t)(n0 + r) * c.K + k0 + 8 * ch) = o; }
    }
    asm volatile("s_waitcnt lgkmcnt(0)" ::: "memory");
}

__device__ __forceinline__ void conv64_run(const Conv64& c, LAS float* scr, int lane, int gwi, int ngw, int& base) {
    const int n = (c.K / 64) * (c.Ndst / 64); int it = gwi - base; if (it < 0) it += ngw;
    if (it < n) { f32x4 va[16], vb[16]; conv64_load(c, it, lane, va);
        for (;;) { const int i2 = it + ngw; if (i2 < n) conv64_load(c, i2, lane, vb); conv64_store(c, it, scr, lane, va); if (i2 >= n) break;
                   const int i3 = i2 + ngw; if (i3 < n) conv64_load(c, i3, lane, va); conv64_store(c, i2, scr, lane, vb); if (i3 >= n) break; it = i3; } }
    base = (base + n) % ngw;
}

namespace pg8 {
constexpr int BM = 256, BK = 64, HALF = 128, HTB = HALF * BK * 2, STAGE_BYTES = 8 * HTB;
constexpr int NXCD = 8, WGM = 8;
__device__ __forceinline__ int lds_byte(int r, int c) { const int st = (r >> 4) * 2 + (c >> 5), rr = r & 15, cc = c & 31, ob = rr * 64 + cc * 2; return st * 1024 + (ob ^ (((ob >> 9) & 1) << 5)); }
__device__ __forceinline__ void stage_rc(int b, int& Rr, int& C) { const int st = b / 1024, sb = b % 1024, swz = sb ^ (((sb >> 9) & 1) << 5); Rr = (st >> 1) * 16 + swz / 64; C = (st & 1) * 32 + (swz % 64) / 2; }
__device__ __forceinline__ int perm32(int rho) { const int n = rho >> 4, i = rho & 15; return 8 * (i >> 2) + 4 * n + (i & 3); }
struct Unit { int pm, pn; };
typedef int v8i_t __attribute__((ext_vector_type(8)));
typedef int v4i_t __attribute__((ext_vector_type(4)));
__device__ __forceinline__ v8i_t cat8(bf16x8 a, bf16x8 b) { const v4i_t x = __builtin_bit_cast(v4i_t, a), y = __builtin_bit_cast(v4i_t, b); return __builtin_shufflevector(x, y, 0, 1, 2, 3, 4, 5, 6, 7); }
struct Order {
    int nM, nN, nwg, G, c;
    __device__ __forceinline__ void init(int nM_, int nN_, int G_, int c_) { nM = nM_; nN = nN_; nwg = nM * nN; G = G_; c = c_; }
    __device__ __forceinline__ bool next(int i, Unit& u) const {
        const long L = (long)i * G + c; if (L >= nwg) return false;
        int wgid = (int)L; { const int q = nwg / NXCD, r = nwg % NXCD, xcd = wgid % NXCD, off = wgid / NXCD; wgid = (xcd < r ? xcd * (q + 1) : r * (q + 1) + (xcd - r) * q) + off; }
        const int nig = WGM * nN, gid = wgid / nig, fm = gid * WGM, gsz = (nM - fm) < WGM ? (nM - fm) : WGM;
        u.pm = fm + ((wgid % nig) % gsz); u.pn = (wgid % nig) / gsz; return true;
    }
};

template <class Prob, class Epi>
__device__ __forceinline__ void gemm_phase(LAS unsigned char* lds, const Prob& P, const Epi& E) {
    const int tid = threadIdx.x, wid = __builtin_amdgcn_readfirstlane(tid >> 6), lane = tid & 63, wr = wid >> 2, wc = wid & 3, fr = lane & 15, fq = lane >> 4;
    const int K = P.K, nt = K / BK, ldb = P.ldb;
    int RA[2], CA[2]; unsigned voffB[2];
#pragma unroll
    for (int i = 0; i < 2; ++i) { int Rr, C; stage_rc(tid * 16 + i * 8192, Rr, C); const int Rb = Epi::PERM ? ((Rr & ~31) + perm32(Rr & 31)) : Rr;
        RA[i] = Rr; CA[i] = C; voffB[i] = (unsigned)(Rb * ldb + C) * 2u; }
    const size_t hstepB = (size_t)HALF * ldb * 2;
    const unsigned ldsw = (unsigned)wid * 1024u;
    const int aoff = lds_byte(wr * 64 + fr, fq * 8), boff = lds_byte(wc * 32 + fr, fq * 8);
    const char* Abase = (const char*)P.Abase;
    const int scl_a = P.sa * 0x01010101, scl_b = P.sb * 0x01010101;
#define PG8_SA(b, h) (((b) * 2 + (h)) * HTB)
#define PG8_SB(b, h) ((4 + (b) * 2 + (h)) * HTB)
#define PG8_STAGEB(bufoff, gbase) do { _Pragma("unroll") for (int _i = 0; _i < 2; ++_i) \
        __builtin_amdgcn_global_load_lds((const unsigned*)((const char*)(gbase) + voffB[_i]), (LAS unsigned*)(lds + (bufoff) + ldsw + _i * 8192), 16, 0, 0); } while (0)
#define PG8_STAGEA(bufoff, vo, h, kb) do { _Pragma("unroll") for (int _i = 0; _i < 2; ++_i) \
        __builtin_amdgcn_global_load_lds((const unsigned*)(Abase + (size_t)(kb) + (vo)[h][_i]), (LAS unsigned*)(lds + (bufoff) + ldsw + _i * 8192), 16, 0, 0); } while (0)
#define PG8_LDA(dst, b, h) do { _Pragma("unroll") for (int m = 0; m < 4; ++m) { if constexpr (Prob::FP8) dst##8[m] = cat8(*(const LAS bf16x8*)(lds + PG8_SA(b, h) + aoff + m * 2048), *(const LAS bf16x8*)(lds + PG8_SA(b, h) + aoff + m * 2048 + 1024)); \
        else { _Pragma("unroll") for (int k = 0; k < 2; ++k) dst[m][k] = *(const LAS bf16x8*)(lds + PG8_SA(b, h) + aoff + m * 2048 + k * 1024); } } } while (0)
#define PG8_LDB(dst, b, h) do { _Pragma("unroll") for (int n = 0; n < 2; ++n) { if constexpr (Prob::FP8) dst##8[n] = cat8(*(const LAS bf16x8*)(lds + PG8_SB(b, h) + boff + n * 2048), *(const LAS bf16x8*)(lds + PG8_SB(b, h) + boff + n * 2048 + 1024)); \
        else { _Pragma("unroll") for (int k = 0; k < 2; ++k) dst[n][k] = *(const LAS bf16x8*)(lds + PG8_SB(b, h) + boff + n * 2048 + k * 1024); } } } while (0)
#define PG8_MMA(ai, bj, At, Bt) do { __builtin_amdgcn_s_setprio(1); _Pragma("unroll") for (int m = 0; m < 4; ++m) _Pragma("unroll") for (int n = 0; n < 2; ++n) { \
        if constexpr (Prob::FP8) asm volatile("v_mfma_scale_f32_16x16x128_f8f6f4 %0, %1, %2, %0, %3, %4 op_sel_hi:[0,0,0]" : "+v"(acc[ai][bj][m][n]) : "v"(Bt##8[n]), "v"(At##8[m]), "v"(scl_b), "v"(scl_a)); \
        else { _Pragma("unroll") for (int k = 0; k < 2; ++k) acc[ai][bj][m][n] = __builtin_amdgcn_mfma_f32_16x16x32_bf16(Bt[n][k], At[m][k], acc[ai][bj][m][n], 0, 0, 0); } } \
        __builtin_amdgcn_s_setprio(0); } while (0)
#define PG8_WAIT_V(n) asm volatile("s_waitcnt vmcnt(" #n ")" ::: "memory")
#define PG8_WAIT_L(n) asm volatile("s_waitcnt lgkmcnt(" #n ")" ::: "memory")
#define PG8_BAR __builtin_amdgcn_s_barrier()
#define PG8_SCHED __builtin_amdgcn_sched_barrier(0)
    Unit cur, nxt; int ui = 0;
    if (!P.next(0, cur)) return;
    f32x4 acc[2][2][4][2];
#pragma unroll
    for (int a = 0; a < 2; ++a)
#pragma unroll
        for (int b = 0; b < 2; ++b)
#pragma unroll
            for (int m = 0; m < 4; ++m)
#pragma unroll
                for (int n = 0; n < 2; ++n) acc[a][b][m][n] = (f32x4){0.f, 0.f, 0.f, 0.f};
    bf16x8 At[4][2], B0[2][2], B1[2][2]; v8i_t At8[4], B08[2], B18[2];
    unsigned cvo[2][2], nvo[2][2];
#pragma unroll
    for (int h = 0; h < 2; ++h)
#pragma unroll
        for (int i = 0; i < 2; ++i) cvo[h][i] = P.a_off(cur, h * HALF + RA[i]) + (unsigned)CA[i] * 2u;
    const char* cB = P.b_ptr(cur);
    const size_t kstep = (size_t)(BK * 2);
    PG8_STAGEB(PG8_SB(0, 0), cB); PG8_STAGEB(PG8_SB(0, 1), cB + hstepB); PG8_STAGEA(PG8_SA(0, 0), cvo, 0, 0); PG8_STAGEA(PG8_SA(0, 1), cvo, 1, 0);
    if (wr == 1) PG8_BAR;
    PG8_WAIT_V(2); PG8_BAR;
    PG8_STAGEB(PG8_SB(1, 0), cB + kstep); PG8_STAGEA(PG8_SA(1, 0), cvo, 0, kstep); PG8_STAGEB(PG8_SB(1, 1), cB + hstepB + kstep);
    PG8_WAIT_V(6); PG8_BAR;
    for (;;) {
        const bool has_next = P.next(ui + 1, nxt);
        const char* nB = cB;
#pragma unroll
        for (int h = 0; h < 2; ++h)
#pragma unroll
            for (int i = 0; i < 2; ++i) nvo[h][i] = cvo[h][i];
        if (has_next) { nB = P.b_ptr(nxt);
#pragma unroll
            for (int h = 0; h < 2; ++h)
#pragma unroll
                for (int i = 0; i < 2; ++i) nvo[h][i] = P.a_off(nxt, h * HALF + RA[i]) + (unsigned)CA[i] * 2u; }
        for (int t = 0; t < nt; t += 2) {
            const bool last = (t == nt - 2);
            const size_t k1 = (size_t)(t + 1) * kstep;
            const size_t k2 = last ? 0 : (size_t)(t + 2) * kstep, k3 = k2 + kstep;
            unsigned vo2[2][2];
#pragma unroll
            for (int h = 0; h < 2; ++h)
#pragma unroll
                for (int i = 0; i < 2; ++i) vo2[h][i] = last ? nvo[h][i] : cvo[h][i];
            const char* b2 = (last ? nB : cB) + k2; const char* b3 = b2 + kstep;
            PG8_LDB(B0, 0, 0); PG8_LDB(B1, 0, 1); PG8_SCHED; PG8_LDA(At, 0, 0); PG8_STAGEA(PG8_SA(1, 1), cvo, 1, k1);
            PG8_WAIT_V(8); PG8_WAIT_L(0); PG8_BAR; PG8_MMA(0, 0, At, B0); PG8_MMA(0, 1, At, B1); PG8_BAR; PG8_SCHED;
            PG8_LDA(At, 0, 1); PG8_STAGEB(PG8_SB(0, 0), b2); PG8_STAGEB(PG8_SB(0, 1), b2 + hstepB); PG8_STAGEA(PG8_SA(0, 0), vo2, 0, k2);
            PG8_WAIT_V(8); PG8_WAIT_L(0); PG8_BAR; PG8_MMA(1, 0, At, B0); PG8_MMA(1, 1, At, B1); PG8_BAR; PG8_SCHED;
            PG8_LDB(B0, 1, 0); PG8_LDB(B1, 1, 1); PG8_SCHED; PG8_LDA(At, 1, 0); PG8_STAGEA(PG8_SA(0, 1), vo2, 1, k2);
            PG8_WAIT_V(8); PG8_WAIT_L(0); PG8_BAR; PG8_MMA(0, 0, At, B0); PG8_MMA(0, 1, At, B1); PG8_BAR; PG8_SCHED;
            PG8_LDA(At, 1, 1); PG8_STAGEB(PG8_SB(1, 0), b3); PG8_STAGEB(PG8_SB(1, 1), b3 + hstepB); PG8_STAGEA(PG8_SA(1, 0), vo2, 0, k3);
            PG8_WAIT_V(8); PG8_WAIT_L(0); PG8_BAR; PG8_MMA(1, 0, At, B0); PG8_MMA(1, 1, At, B1); PG8_BAR; PG8_SCHED;
        }
        if (wr == 0) PG8_BAR;
        if constexpr (Prob::FP8) asm volatile("s_nop 15\n\ts_nop 15" ::: "memory");
        if constexpr (Epi::STAGED) E.staged(acc, P, cur, wr, wc, fr, fq, lds + STAGE_BYTES, tid);
        else { E(acc, P, cur, wr, wc, fr, fq); if (MK_EPI2) { asm volatile("" ::: "memory"); E(acc, P, cur, wr, wc, fr, fq); } }
        if (!has_next) break;
#pragma unroll
        for (int a = 0; a < 2; ++a)
#pragma unroll
            for (int b = 0; b < 2; ++b)
#pragma unroll
                for (int m = 0; m < 4; ++m)
#pragma unroll
                    for (int n = 0; n < 2; ++n) acc[a][b][m][n] = (f32x4){0.f, 0.f, 0.f, 0.f};
        cur = nxt; cB = nB; ++ui;
#pragma unroll
        for (int h = 0; h < 2; ++h)
#pragma unroll
            for (int i = 0; i < 2; ++i) cvo[h][i] = nvo[h][i];
        if (wr == 1) PG8_BAR;
    }
    PG8_WAIT_V(0);
    PG8_BAR;
#undef PG8_SA
#undef PG8_SB
#undef PG8_STAGEA
#undef PG8_STAGEB
#undef PG8_LDA
#undef PG8_LDB
#undef PG8_MMA
#undef PG8_WAIT_V
#undef PG8_WAIT_L
#undef PG8_BAR
#undef PG8_SCHED
}

struct DenseProb {
    static constexpr bool FP8 = false; static constexpr int sa = 127, sb = 127;
    const bf16_t* Abase; const bf16_t* Bt; int K, lda, ldb; Order ord;
    __device__ __forceinline__ bool next(int i, Unit& u) const { return ord.next(i, u); }
    __device__ __forceinline__ unsigned a_off(const Unit& u, int r) const { return (unsigned)((size_t)(u.pm * BM + r) * lda * 2); }
    __device__ __forceinline__ const char* b_ptr(const Unit& u) const { return (const char*)Bt + (size_t)u.pn * BM * ldb * 2; }
    __device__ __forceinline__ int orow0(const Unit& u) const { return u.pm * BM; }
};
struct MoeTiles { unsigned long long tp8; unsigned long long c4a, c4b; int nt; };
__device__ __forceinline__ int moe_tp(const MoeTiles& T, int e) { return (int)((T.tp8 >> (8 * e)) & 0xffull); }
__device__ __forceinline__ int moe_cnt(const MoeTiles& T, int e) { const unsigned long long w = (e < 4) ? T.c4a : T.c4b; return (int)((w >> (16 * (e & 3))) & 0xffffull); }
__device__ __forceinline__ int moe_expert(const MoeTiles& T, int pm) { int e = 0;
#pragma unroll
    for (int j = 1; j < 8; ++j) e += (pm >= (int)((T.tp8 >> (8 * j)) & 0xffull)) ? 1 : 0;
    return e; }
struct MoeGuProb {
    static constexpr bool FP8 = true; static constexpr int sa = 125, sb = 121;
    const unsigned char* Abase; const unsigned char* Bt; int K, ldb; Order ord; MoeTiles T; const int* rowtok;
    __device__ __forceinline__ bool next(int i, Unit& u) const { return ord.next(i, u); }
    __device__ __forceinline__ unsigned a_off(const Unit& u, int r) const {
        const int e = moe_expert(T, u.pm); const int idx = (u.pm - moe_tp(T, e)) * BM + r; const int cm1 = moe_cnt(T, e) - 1;
        const int tok = rowtok[e * CAPE + (idx < cm1 ? idx : cm1)];
        return (unsigned)tok * (unsigned)D; }
    __device__ __forceinline__ const char* b_ptr(const Unit& u) const { const int e = moe_expert(T, u.pm); return (const char*)Bt + ((size_t)e * N_GU1 + (size_t)u.pn * BM) * D; }
    __device__ __forceinline__ int orow0(const Unit& u) const { return u.pm * BM; }
};
struct MoeDnProb {
    static constexpr bool FP8 = true; static constexpr int sa = 124, sb = 121;
    const unsigned char* Abase; const unsigned char* Bt; int K, ldb; Order ord; MoeTiles T;
    __device__ __forceinline__ bool next(int i, Unit& u) const { return ord.next(i, u); }
    __device__ __forceinline__ unsigned a_off(const Unit& u, int r) const { return (unsigned)((size_t)(u.pm * BM + r) * EXD); }
    __device__ __forceinline__ const char* b_ptr(const Unit& u) const { const int e = moe_expert(T, u.pm); return (const char*)Bt + ((size_t)e * D + (size_t)u.pn * BM) * EXD; }
    __device__ __forceinline__ int orow0(const Unit& u) const { return u.pm * BM; }
};

struct EpiF32 { static constexpr bool PERM = false; static constexpr bool STAGED = false; float* C; int ldc;
    template <class Prob> __device__ __forceinline__ void operator()(const f32x4 (&acc)[2][2][4][2], const Prob& P, const Unit& u, int wr, int wc, int fr, int fq) const {
        const int row0 = P.orow0(u) + wr * 64 + fr, col0 = u.pn * BM + wc * 32 + 4 * fq;
#pragma unroll
        for (int ai = 0; ai < 2; ++ai)
#pragma unroll
            for (int m = 0; m < 4; ++m) { float* rowp = C + (size_t)(row0 + ai * HALF + m * 16) * ldc + col0;
#pragma unroll
                for (int bj = 0; bj < 2; ++bj)
#pragma unroll
                    for (int n = 0; n < 2; ++n) *(f32x4*)(rowp + bj * HALF + n * 16) = acc[ai][bj][m][n]; }
    }
};
struct EpiBf16 { static constexpr bool PERM = true; static constexpr bool STAGED = false; bf16_t* O; int ldc; const float* rowscale;
    template <class Prob> __device__ __forceinline__ void operator()(const f32x4 (&acc)[2][2][4][2], const Prob& P, const Unit& u, int wr, int wc, int fr, int fq) const {
        const int row0 = P.orow0(u) + wr * 64 + fr, col0 = u.pn * BM + wc * 32 + 8 * fq;
#pragma unroll
        for (int ai = 0; ai < 2; ++ai)
#pragma unroll
            for (int m = 0; m < 4; ++m) { const int row = row0 + ai * HALF + m * 16; bf16_t* rowp = O + (size_t)row * ldc + col0; const float rs = rowscale ? rowscale[row] : 1.0f;
#pragma unroll
                for (int bj = 0; bj < 2; ++bj) { const f32x4 v0 = acc[ai][bj][m][0] * rs, v1 = acc[ai][bj][m][1] * rs;
                    u32x4 w; w.x = cvtpk(v0[0], v0[1]); w.y = cvtpk(v0[2], v0[3]); w.z = cvtpk(v1[0], v1[1]); w.w = cvtpk(v1[2], v1[3]);
                    *(u32x4*)(rowp + bj * HALF) = w; } }
    }
};
struct EpiIn1 { static constexpr bool PERM = true; static constexpr bool STAGED = false; bf16_t* QK; bf16_t* V; bf16_t* G; bf16_t* RRp;
    template <class Prob> __device__ __forceinline__ void operator()(const f32x4 (&acc)[2][2][4][2], const Prob& P, const Unit& u, int wr, int wc, int fr, int fq) const {
        const int t = u.pn >> 2; bf16_t* base = (t == 0) ? QK : (t == 1) ? V : (t == 2) ? G : RRp; const int ldc = (t == 3) ? 256 : 1024;
        const int row0 = P.orow0(u) + wr * 64 + fr, col0 = (u.pn & 3) * BM + wc * 32 + 8 * fq;
#pragma unroll
        for (int ai = 0; ai < 2; ++ai)
#pragma unroll
            for (int m = 0; m < 4; ++m) { const int row = row0 + ai * HALF + m * 16; bf16_t* rowp = base + (size_t)row * ldc + col0;
#pragma unroll
                for (int bj = 0; bj < 2; ++bj) { const f32x4 v0 = acc[ai][bj][m][0], v1 = acc[ai][bj][m][1];
                    u32x4 w; w.x = cvtpk(v0[0], v0[1]); w.y = cvtpk(v0[2], v0[3]); w.z = cvtpk(v1[0], v1[1]); w.w = cvtpk(v1[2], v1[3]);
                    *(u32x4*)(rowp + bj * HALF) = w; } }
    }
};
struct EpiQA { static constexpr bool PERM = true; static constexpr bool STAGED = false; bf16_t* O; const float* rstd; const float* tab16; float qscale;
    template <class Prob> __device__ __forceinline__ void operator()(const f32x4 (&acc)[2][2][4][2], const Prob& P, const Unit& u, int wr, int wc, int fr, int fq) const {
        const int row0 = P.orow0(u) + wr * 64 + fr, col0 = u.pn * BM + wc * 32 + 8 * fq;
        const bool ropet = (u.pn == 2);
#pragma unroll
        for (int ai = 0; ai < 2; ++ai)
#pragma unroll
            for (int m = 0; m < 4; ++m) { const int row = row0 + ai * HALF + m * 16; bf16_t* rowp = O + (size_t)row * N_QA + col0; const float rs = rstd[row] * qscale;
                f32x4 cs0 = {1.f, 1.f, 1.f, 1.f}, sn0 = {0.f, 0.f, 0.f, 0.f};
                if (ropet && row < RL) { const int tt = row & (SEQ - 1); const int pos = (fq >> 1) ? (tt & 63) : (tt >> 6); const int i0 = 4 * (fq & 1);
                    cs0 = *(const f32x4*)(tab16 + pos * 8 + i0); sn0 = *(const f32x4*)(tab16 + 512 + pos * 8 + i0); }
#pragma unroll
                for (int bj = 0; bj < 2; ++bj) { f32x4 v0 = acc[ai][bj][m][0] * rs, v1 = acc[ai][bj][m][1] * rs;
                    if (ropet) {
                        const f32x4 a = v0, b = v1;
                        v0[0] = a[0] * cs0[0] - a[1] * sn0[0]; v0[1] = a[1] * cs0[0] + a[0] * sn0[0];
                        v0[2] = a[2] * cs0[1] - a[3] * sn0[1]; v0[3] = a[3] * cs0[1] + a[2] * sn0[1];
                        v1[0] = b[0] * cs0[2] - b[1] * sn0[2]; v1[1] = b[1] * cs0[2] + b[0] * sn0[2];
                        v1[2] = b[2] * cs0[3] - b[3] * sn0[3]; v1[3] = b[3] * cs0[3] + b[2] * sn0[3]; }
                    u32x4 w; w.x = cvtpk(v0[0], v0[1]); w.y = cvtpk(v0[2], v0[3]); w.z = cvtpk(v1[0], v1[1]); w.w = cvtpk(v1[2], v1[3]);
                    *(u32x4*)(rowp + bj * HALF) = w; } }
    }
};
struct EpiSwiglu { static constexpr bool PERM = false; static constexpr bool STAGED = false; bf16_t* Hh; int ldh;
    template <class Prob> __device__ __forceinline__ void operator()(const f32x4 (&acc)[2][2][4][2], const Prob& P, const Unit& u, int wr, int wc, int fr, int fq) const {
        const int row0 = P.orow0(u) + wr * 64 + fr, col0 = (u.pn * BM + wc * 32) / 2 + 4 * fq;
#pragma unroll
        for (int ai = 0; ai < 2; ++ai)
#pragma unroll
            for (int m = 0; m < 4; ++m) { bf16_t* rowp = Hh + (size_t)(row0 + ai * HALF + m * 16) * ldh + col0;
#pragma unroll
                for (int bj = 0; bj < 2; ++bj) { const f32x4 g = acc[ai][bj][m][0], up = acc[ai][bj][m][1];
                    u32x2 w; w.x = cvtpk(swiglu_f(g[0], up[0], -1.4426950408889634f), swiglu_f(g[1], up[1], -1.4426950408889634f)); w.y = cvtpk(swiglu_f(g[2], up[2], -1.4426950408889634f), swiglu_f(g[3], up[3], -1.4426950408889634f));
                    *(u32x2*)(rowp + bj * (HALF / 2)) = w; } }
    }
};
struct EpiSwiglu8 { static constexpr bool PERM = false; static constexpr bool STAGED = true; unsigned char* Hh; int ldh;
    template <class Prob> __device__ __forceinline__ void staged(const f32x4 (&acc)[2][2][4][2], const Prob& P, const Unit& u, int wr, int wc, int fr, int fq, LAS unsigned char* stg, int tid) const {
        LAS unsigned char* sg = stg + wr * 8192;
        const int t = tid & 255;
        unsigned char* gbase = Hh + (size_t)(P.orow0(u) + wr * 64) * ldh + (size_t)u.pn * 128;
#pragma unroll
        for (int ai = 0; ai < 2; ++ai) {
#pragma unroll
            for (int m = 0; m < 4; ++m) { const int row = m * 16 + fr;
#pragma unroll
                for (int bj = 0; bj < 2; ++bj) { const f32x4 g = acc[ai][bj][m][0], up = acc[ai][bj][m][1]; const int p = bj * 4 + wc;
                    *(LAS unsigned*)(sg + row * 128 + ((p ^ (row & 7)) << 4) + 4 * fq) = pack_fp8x4(swiglu_f(g[0], up[0], -0.18033688011112042f), swiglu_f(g[1], up[1], -0.18033688011112042f), swiglu_f(g[2], up[2], -0.18033688011112042f), swiglu_f(g[3], up[3], -0.18033688011112042f)); } }
            asm volatile("s_waitcnt lgkmcnt(0)" ::: "memory"); __builtin_amdgcn_s_barrier(); asm volatile("" ::: "memory");
#pragma unroll
            for (int j = 0; j < 2; ++j) { const int row = (t >> 3) + 32 * j, p = t & 7;
                const u32x4 v = *(const LAS u32x4*)(sg + row * 128 + ((p ^ (row & 7)) << 4));
                *(u32x4*)(gbase + (size_t)(ai * HALF + row) * ldh + p * 16) = v; }
            if (ai == 0) { asm volatile("s_waitcnt lgkmcnt(0)" ::: "memory"); __builtin_amdgcn_s_barrier(); asm volatile("" ::: "memory"); }
        }
    }
};
}

struct Frame {
    LAS unsigned char* lds;
    unsigned char* ws;
    int tid, lane, wave, vcu, G;
};
template <class T> __device__ __forceinline__ T* wsp(const Frame& F, size_t off) { return (T*)(F.ws + off); }

__device__ __forceinline__ void load_row(const float* p, int lane, f32x4 (&v)[4]) {
    const f32x4* r = (const f32x4*)p + lane;
#pragma unroll
    for (int j = 0; j < 4; ++j) v[j] = r[64 * j];
}
__device__ __forceinline__ void load_row_bf16(const bf16_t* p, int lane, f32x4 (&v)[4]) {
#pragma unroll
    for (int j = 0; j < 4; ++j) { const u32x2 w = *(const u32x2*)(p + 4 * lane + 256 * j); v[j][0] = bflo(w.x); v[j][1] = bfhi(w.x); v[j][2] = bflo(w.y); v[j][3] = bfhi(w.y); }
}
__device__ __forceinline__ float row_ssq(const f32x4 (&v)[4]) { float s = 0.f;
#pragma unroll
    for (int j = 0; j < 4; ++j) s += (v[j][0] * v[j][0] + v[j][1] * v[j][1]) + (v[j][2] * v[j][2] + v[j][3] * v[j][3]);
    return wave_sum(s); }
__device__ __forceinline__ void norm_mod_store(const f32x4 (&h)[4], const float* g, const float* sh, const float* sc, bf16_t* urow, int lane, f32x4 (&uo)[4], unsigned char* u8row = nullptr) {
    const float rstd = __builtin_amdgcn_rsqf(row_ssq(h) * (1.0f / D) + EPS);
#pragma unroll
    for (int j = 0; j < 4; ++j) { const int c = 4 * lane + 256 * j; const f32x4 gg = *(const f32x4*)(g + c), s1 = *(const f32x4*)(sc + c), s0 = *(const f32x4*)(sh + c);
        const f32x4 uu = (h[j] * rstd * gg) * (1.0f + s1) + s0; uo[j] = uu;
        if (u8row) *(unsigned*)(u8row + c) = pack_fp8x4(4.0f * uu[0], 4.0f * uu[1], 4.0f * uu[2], 4.0f * uu[3]);
        else { u32x2 w; w.x = cvtpk(uu[0], uu[1]); w.y = cvtpk(uu[2], uu[3]); *(u32x2*)(urow + c) = w; } }
}
__device__ __forceinline__ int row_bidx(int row) { return row < RL ? (row >> 12) : 4; }

__device__ __forceinline__ void glds16(const void* gsrc, unsigned lds_dst) { unsigned keep;
    asm volatile("s_mov_b32 %0, m0\n\ts_mov_b32 m0, %2\n\ts_nop 0\n\tglobal_load_lds_dwordx4 %1, off\n\ts_mov_b32 m0, %0" : "=&s"(keep) : "v"(gsrc), "s"(lds_dst) : "memory"); }
__device__ __forceinline__ float max3f(float a, float b, float c) { float r; asm("v_max3_f32 %0, %1, %2, %3" : "=v"(r) : "v"(a), "v"(b), "v"(c)); return r; }
#define WAIT_BAR(N) asm volatile("s_waitcnt vmcnt(" #N ") lgkmcnt(0)\n\ts_barrier" ::: "memory")
template <int DQK> struct AttnSrc {
    const bf16_t* Q; int qpitch; const bf16_t* Qr;
    const bf16_t* Kn; int kpitch; const bf16_t* Kr; int krpitch;
    const bf16_t* V; int vpitch;
    bf16_t* O; int opitch;
};
__device__ __forceinline__ s16x4 vtr(const LAS unsigned char* p) { typedef short v4i16_t __attribute__((ext_vector_type(4))); return __builtin_bit_cast(s16x4, __builtin_amdgcn_ds_read_tr16_b64_v4i16((LAS v4i16_t*)p)); }
__device__ __forceinline__ int attn_krow(int kt, int lat0, int ctx0) { return kt < 64 ? lat0 + kt * 64 : ctx0 + (kt - 64) * 64; }
template <int DQK>
__device__ __forceinline__ void attn_unit(const Frame& F, const AttnSrc<DQK>& S, int q0, int lat0, int ctx0, int kt0, int kt1) {
    constexpr int NKS = DQK / 16, KB = DQK * 128, SLOT = KB + 8192;
    constexpr float THR = 8.0f;
    const int lane = F.lane, wid = F.wave, r32 = lane & 31, hi = lane >> 5;
    LAS unsigned char* lds = F.lds;
    constexpr bool QLDS = false;
    bf16x8 qf[QLDS ? 1 : NKS];
    LAS unsigned char* qfl = lds + 4 * SLOT + wid * (NKS * 1024) + lane * 16;
    { const bf16_t* qrow = S.Q + (size_t)(q0 + wid * 32 + r32) * S.qpitch;
#pragma unroll
      for (int ks = 0; ks < 4; ++ks) { const bf16x8 v = *(const bf16x8*)(qrow + ks * 16 + hi * 8); if (QLDS) *(LAS bf16x8*)(qfl + ks * 1024) = v; else qf[ks] = v; }
      if (DQK == 96) { const bf16_t* qr = S.Qr + (size_t)(q0 + wid * 32 + r32) * S.qpitch;
#pragma unroll
          for (int ks = 4; ks < NKS; ++ks) { const bf16x8 v = *(const bf16x8*)(qr + (ks - 4) * 16 + hi * 8); if (QLDS) *(LAS bf16x8*)(qfl + ks * 1024) = v; else qf[ks] = v; } } }
    const unsigned lds0 = (unsigned)(size_t)lds;
    auto dma = [&](int kt, int slot) {
        const int krow = attn_krow(kt, lat0, ctx0);
        const unsigned sb = lds0 + slot * SLOT;
        glds16(S.Kn + (size_t)(krow + lane) * S.kpitch + wid * 8, (unsigned)__builtin_amdgcn_readfirstlane(sb + wid * 1024));
        if (DQK == 96 && wid < 4) glds16(S.Kr + (size_t)(krow + lane) * S.krpitch + wid * 8, (unsigned)__builtin_amdgcn_readfirstlane(sb + (8 + wid) * 1024));
        glds16(S.V + (size_t)(krow + 16 * (wid & 3) + (lane >> 2)) * S.vpitch + (wid >> 2) * 32 + (lane & 3) * 8, (unsigned)__builtin_amdgcn_readfirstlane(sb + KB + wid * 1024));
    };
    auto wait_bar = [&](bool inflight) {
        if (!inflight) { WAIT_BAR(0); } else if (DQK == 96 && wid < 4) { WAIT_BAR(3); } else { WAIT_BAR(2); }
    };
    f32x16 oT[2]; f32x16 negm;
#pragma unroll
    for (int r = 0; r < 16; ++r) { oT[0][r] = 0.f; oT[1][r] = 0.f; negm[r] = 0.f; }
    float mrun = 0.f, lrun = 0.f;
    const int vlane = ((lane >> 4) & 1) * 32 + (lane & 3) * 8 + (4 * hi + ((lane & 15) >> 2)) * 64;
    auto qk = [&](int slot, f32x16& p0, f32x16& p1) {
        const LAS unsigned char* kb = lds + slot * SLOT + hi * 1024 + r32 * 16;
        p0 = negm; p1 = negm;
        bf16x8 ka = *(const LAS bf16x8*)(kb), kc = *(const LAS bf16x8*)(kb + 512);
#pragma unroll
        for (int ks = 0; ks < NKS; ++ks) {
            bf16x8 na = ka, nc = kc;
            if (ks + 1 < NKS) { na = *(const LAS bf16x8*)(kb + (ks + 1) * 2048); nc = *(const LAS bf16x8*)(kb + (ks + 1) * 2048 + 512); }
            const bf16x8 qv = QLDS ? *(const LAS bf16x8*)(qfl + ks * 1024) : qf[QLDS ? 0 : ks];
            p0 = __builtin_amdgcn_mfma_f32_32x32x16_bf16(ka, qv, p0, 0, 0, 0);
            p1 = __builtin_amdgcn_mfma_f32_32x32x16_bf16(kc, qv, p1, 0, 0, 0);
            ka = na; kc = nc;
        }
    };
    auto tilemax = [&](f32x16& p0, f32x16& p1) -> float {
        asm volatile("s_nop 15\n\ts_nop 7" : "+v"(p0), "+v"(p1));
        float a = max3f(p0[0], p0[1], p1[0]), b = max3f(p0[2], p0[3], p1[1]); a = max3f(a, p1[2], p1[3]);
#pragma unroll
        for (int r = 4; r < 16; r += 4) { a = max3f(a, p0[r], p0[r + 1]); b = max3f(b, p0[r + 2], p0[r + 3]); a = max3f(a, p1[r], p1[r + 1]); b = max3f(b, p1[r + 2], p1[r + 3]); }
        float tm = fmaxf(a, b);
        auto rr = __builtin_amdgcn_permlane32_swap(__float_as_uint(tm), __float_as_uint(tm), false, false); return fmaxf(__uint_as_float(rr[0]), __uint_as_float(rr[1]));
    };
    auto smpv = [&](f32x16& p0, f32x16& p1, int slot) -> bool {
        const float tm = tilemax(p0, p1);
        bool moved = false;
        if (__any(tm > THR)) {
            const float dl = fmaxf(tm, 0.f); mrun += dl; const float al = __builtin_amdgcn_exp2f(-dl); lrun *= al;
#pragma unroll
            for (int r = 0; r < 16; ++r) { p0[r] -= dl; p1[r] -= dl; negm[r] = -mrun; oT[0][r] *= al; oT[1][r] *= al; }
            moved = true;
        }
        float rs = 0.f;
#pragma unroll
        for (int r = 0; r < 16; ++r) { p0[r] = __builtin_amdgcn_exp2f(p0[r]); p1[r] = __builtin_amdgcn_exp2f(p1[r]); rs += p0[r] + p1[r]; }
        lrun += rs;
        bf16x8 pf[4];
        { u32x4 w;
          w.x = cvtpk(p0[0], p0[1]); w.y = cvtpk(p0[2], p0[3]); w.z = cvtpk(p0[4], p0[5]); w.w = cvtpk(p0[6], p0[7]); pf[0] = __builtin_bit_cast(bf16x8, w);
          w.x = cvtpk(p0[8], p0[9]); w.y = cvtpk(p0[10], p0[11]); w.z = cvtpk(p0[12], p0[13]); w.w = cvtpk(p0[14], p0[15]); pf[1] = __builtin_bit_cast(bf16x8, w);
          w.x = cvtpk(p1[0], p1[1]); w.y = cvtpk(p1[2], p1[3]); w.z = cvtpk(p1[4], p1[5]); w.w = cvtpk(p1[6], p1[7]); pf[2] = __builtin_bit_cast(bf16x8, w);
          w.x = cvtpk(p1[8], p1[9]); w.y = cvtpk(p1[10], p1[11]); w.z = cvtpk(p1[12], p1[13]); w.w = cvtpk(p1[14], p1[15]); pf[3] = __builtin_bit_cast(bf16x8, w); }
        const LAS unsigned char* vb = lds + slot * SLOT + KB + vlane;
        s16x4 lo = vtr(vb), hh = vtr(vb + 512);
#pragma unroll
        for (int i = 0; i < 8; ++i) {
            const int d0 = i >> 2, ks = i & 3;
            s16x4 nlo = lo, nhh = hh;
            if (i + 1 < 8) { const int o2 = ((i + 1) >> 2) * 4096 + ((i + 1) & 3) * 1024; nlo = vtr(vb + o2); nhh = vtr(vb + o2 + 512); }
            const bf16x8 vf = (bf16x8){lo[0], lo[1], lo[2], lo[3], hh[0], hh[1], hh[2], hh[3]};
            oT[d0] = __builtin_amdgcn_mfma_f32_32x32x16_bf16(vf, pf[ks], oT[d0], 0, 0, 0);
            lo = nlo; hh = nhh;
        }
        return moved;
    };
    dma(kt0, 0); dma(kt0 + 1, 1); dma(kt0 + 2, 2);
    wait_bar(true);
    f32x16 pA0, pA1, pB0, pB1;
    qk(0, pA0, pA1);
    { mrun = tilemax(pA0, pA1);
#pragma unroll
      for (int r = 0; r < 16; ++r) negm[r] = -mrun;
      qk(0, pA0, pA1); }
    int sc = 0;
    for (int kt = kt0; kt < kt1; kt += 2) {
        { const int s1 = (sc + 1) & 3, s3 = (sc + 3) & 3;
          if (kt + 3 < kt1) dma(kt + 3, s3);
          qk(s1, pB0, pB1);
          if (smpv(pA0, pA1, sc)) qk(s1, pB0, pB1);
          wait_bar(kt + 3 < kt1);
          sc = s1; }
        { const int s1 = (sc + 1) & 3, s3 = (sc + 3) & 3;
          if (kt + 4 < kt1) dma(kt + 4, s3);
          if (kt + 2 < kt1) qk(s1, pA0, pA1);
          if (smpv(pB0, pB1, sc) && kt + 2 < kt1) qk(s1, pA0, pA1);
          wait_bar(kt + 4 < kt1);
          sc = s1; }
    }
    { auto rr = __builtin_amdgcn_permlane32_swap(__float_as_uint(lrun), __float_as_uint(lrun), false, false); lrun = __uint_as_float(rr[0]) + __uint_as_float(rr[1]); }
    const float inv = 1.0f / lrun;
    bf16_t* orow = S.O + (size_t)(q0 + wid * 32 + r32) * S.opitch;
#pragma unroll
    for (int d0 = 0; d0 < 2; ++d0)
#pragma unroll
        for (int g = 0; g < 4; ++g) { u32x2 w; w.x = cvtpk(oT[d0][4 * g] * inv, oT[d0][4 * g + 1] * inv); w.y = cvtpk(oT[d0][4 * g + 2] * inv, oT[d0][4 * g + 3] * inv);
            *(u32x2*)(orow + 32 * d0 + 8 * g + 4 * hi) = w; }
}

__device__ __forceinline__ int sig5(int c) { return (c & ~12) | ((c & 8) >> 1) | ((c & 4) << 1); }

__global__ void __launch_bounds__(512, 2) mk_fwd(Args args) {
    extern __shared__ __attribute__((aligned(16))) unsigned char lds_raw[];
    Frame F;
    F.lds = (LAS unsigned char*)lds_raw; F.ws = args.ws;
    F.tid = threadIdx.x; F.lane = F.tid & 63; F.wave = __builtin_amdgcn_readfirstlane(F.tid >> 6);
    F.G = gridDim.x; { const int bx = blockIdx.x; F.vcu = (F.G % 8 == 0) ? (bx % 8) * (F.G / 8) + bx / 8 : bx; }
    volatile LAS unsigned* MISC = (volatile LAS unsigned*)(F.lds + LDSCTL_OFF);
    if (F.tid < 64) MISC[F.tid] = 0u;
    __syncthreads();
    unsigned* ctl = wsp<unsigned>(F, O_CTL);
#if MK_ONE_LAUNCH
    XcdBarrier bar = xcd_barrier_post(ctl + CW_BAR, MISC + 8);
#define GRID_BAR() xcd_barrier(bar)
#else
#define GRID_BAR() do {} while (0)
#endif
    const int lo = args.ph_lo, hi_ph = args.ph_hi;
#define IN(k) (lo <= (k) && (k) < hi_ph)
#define SEAM(k) do { if (IN(k) && IN((k) + 1)) GRID_BAR(); } while (0)
    const int lane = F.lane, wave = F.wave, tid = F.tid;
    const int gw = F.vcu * 8 + wave, NGW = F.G * 8;

    const float* x_in = args.in[I_X]; const float* ctx_in = args.in[I_CTX];
    float* MODV = wsp<float>(F, O_MODV);
    float* TAB16 = wsp<float>(F, O_TAB16); float* TAB32 = wsp<float>(F, O_TAB32);
    float* HC = wsp<float>(F, O_HC);
    bf16_t* U = wsp<bf16_t>(F, O_U);
    float* Y = wsp<float>(F, O_Y);
    const float* normg = args.in[I_NORMG];
#define MV(layer, bidx, k) (MODV + ((size_t)((layer) * 5 + (bidx)) * 6 + (k)) * D)

    if (IN(0)) {
        {
            LAS float* sc = (LAS float*)F.lds;
            LAS float* red = sc + 5 * 1024;
            for (int i = tid; i < 5 * 1024; i += 512) { const int b = i >> 10, k = i & 1023; const float cv = (b < 4) ? args.in[I_C][b * 1024 + k] : args.in[I_CCTX][k]; sc[i] = cv / (1.0f + __expf(-cv)); }
            __syncthreads();
            for (int unit = F.vcu; unit < 192; unit += F.G) {
                const int layer = unit / 96, cb = unit % 96, col = cb * 64 + lane;
                const float* W = args.in[I_MODW] + (size_t)layer * D * 6144 + col;
                float a0 = 0.f, a1 = 0.f, a2 = 0.f, a3 = 0.f, a4 = 0.f;
#pragma unroll 16
                for (int kk = 0; kk < 128; ++kk) { const int k = wave * 128 + kk; const float w = W[(size_t)k * 6144];
                    a0 += sc[k] * w; a1 += sc[1024 + k] * w; a2 += sc[2048 + k] * w; a3 += sc[3072 + k] * w; a4 += sc[4096 + k] * w; }
                red[(wave * 5 + 0) * 64 + lane] = a0; red[(wave * 5 + 1) * 64 + lane] = a1; red[(wave * 5 + 2) * 64 + lane] = a2; red[(wave * 5 + 3) * 64 + lane] = a3; red[(wave * 5 + 4) * 64 + lane] = a4;
                __syncthreads();
                if (tid < 320) { const int b = tid >> 6, cc = tid & 63; float s = 0.f;
#pragma unroll
                    for (int w = 0; w < 8; ++w) s += red[(w * 5 + b) * 64 + cc];
                    MODV[(size_t)(layer * 5 + b) * 6144 + cb * 64 + cc] = s + args.in[I_MODB][layer * 6144 + cb * 64 + cc]; }
                __syncthreads();
            }
        }
        if (blockIdx.x == 0) {
            for (int i = tid; i < 64 * 8; i += 512) { const int pos = i >> 3, f = i & 7; const float fr = powf(10000.0f, -(float)f / 8.0f), a = (float)pos * fr; TAB16[i] = cosf(a); TAB16[512 + i] = sinf(a); }
            for (int i = tid; i < 64 * 16; i += 512) { const int pos = i >> 4, f = i & 15; const float fr = powf(10000.0f, -(float)f / 16.0f), a = (float)pos * fr; TAB32[i] = cosf(a); TAB32[1024 + i] = sinf(a); }
        }
        {
            LAS float* scr = (LAS float*)(F.lds + wave * 16640);
            int base = 0;
            auto run = [&](const Conv& c) { const int n = (c.K / 64) * (c.Ndst / 32); for (int it = gw - base; it < n; it += NGW) { if (it >= 0) conv_item(c, it, scr, lane); }
                base = (base + n) % NGW; };
            auto run64 = [&](const Conv64& c) { conv64_run(c, scr, lane, gw, NGW, base); };
            run64(Conv64{args.in[I_FWG], args.in[I_FWU], FFN, 1024, N_GU0, wsp<bf16_t>(F, O_WGU0), 3, 0, 0, 1.0f, 0});
            run64(Conv64{args.in[I_FWD], nullptr, 1024, FFN, 1024, wsp<bf16_t>(F, O_WD0), 0, 1024, 0, 1.0f, 0});
            run64(Conv64{args.in[I_GWIN], nullptr, 3104, 1024, N_IN1, wsp<bf16_t>(F, O_WIN1), 0, 3104, 512, 0.08838834764831845f, 0});
            run64(Conv64{args.in[I_GWOUT], nullptr, 1024, 1024, 1024, wsp<bf16_t>(F, O_WOUT1), 0, 1024, 0, 1.0f, 0});
            run64(Conv64{args.in[I_AWOUT], nullptr, 1024, 1024, 1024, wsp<bf16_t>(F, O_WOUT0), 0, 1024, 0, 1.0f, 0});
            run(Conv{args.in[I_AWIN], nullptr, 1440, 1024, N_IN0, wsp<bf16_t>(F, O_WIN0), 1, nullptr});
            run(Conv{args.in[I_AWUQ], nullptr, 768, 384, N_QA, wsp<bf16_t>(F, O_WUQ), 2, args.in[I_AQN]});
            run(Conv{args.in[I_AWUKV], nullptr, 1024, 256, N_KVA, wsp<bf16_t>(F, O_WUKV), 0, args.in[I_AKVN]});
        }
    }
    SEAM(0);

    if (IN(1)) {
        for (int row = gw; row < R; row += NGW) {
            const float* hp = row < RL ? x_in + (size_t)row * D : ctx_in + (size_t)(row - RL) * D;
            f32x4 h[4], uo[4]; load_row(hp, lane, h);
            const int b = row_bidx(row);
            norm_mod_store(h, normg + 0 * D, MV(0, b, 0), MV(0, b, 1), U + (size_t)row * D, lane, uo);
        }
    }
    SEAM(1);

    if (IN(2)) {
        pg8::DenseProb P{U, wsp<bf16_t>(F, O_WIN0), 1024, 1024, 1024, {}}; P.ord.init(R / 256, N_IN0 / 256, F.G, (int)blockIdx.x);
        pg8::EpiBf16 E{wsp<bf16_t>(F, O_Z0), N_IN0, nullptr};
        pg8::gemm_phase(F.lds, P, E);
    }
    SEAM(2);

    if (IN(3)) {
        const bf16_t* Z0 = wsp<bf16_t>(F, O_Z0);
        float* RSQ = wsp<float>(F, O_RSTDQ); float* RSKV = wsp<float>(F, O_RSTDKV);
        bf16_t* QB = wsp<bf16_t>(F, O_QB); bf16_t* KBp = wsp<bf16_t>(F, O_KB); bf16_t* KR = wsp<bf16_t>(F, O_KR);
        const float* qkn = args.in[I_AQKN];
        for (int row = gw; row < R; row += NGW) {
            const unsigned* z32 = (const unsigned*)(Z0 + (size_t)row * N_IN0);
            float s = 0.f;
#pragma unroll
            for (int j = 0; j < 3; ++j) { const unsigned w = z32[lane + 64 * j]; const float a = bflo(w), b = bfhi(w); s += a * a + b * b; }
            s = wave_sum(s);
            float s2 = 0.f;
#pragma unroll
            for (int j = 0; j < 2; ++j) { const unsigned w = z32[192 + lane + 64 * j]; const float a = bflo(w), b = bfhi(w); s2 += a * a + b * b; }
            s2 = wave_sum(s2);
            if (lane == 0) { RSQ[row] = __builtin_amdgcn_rsqf(s * (1.0f / 384.0f) + EPS); RSKV[row] = __builtin_amdgcn_rsqf(s2 * (1.0f / 256.0f) + EPS); }
            const bool lat = row < RL; const int tt = row & (SEQ - 1);
#pragma unroll
            for (int which = 0; which < 2; ++which) {
                if (which == 1 && lane >= 16) break;
                const u32x4 w4 = *(const u32x4*)(Z0 + (size_t)row * N_IN0 + (which ? 1152 : 640) + lane * 8);
                float v[8] = {bflo(w4.x), bfhi(w4.x), bflo(w4.y), bfhi(w4.y), bflo(w4.z), bfhi(w4.z), bflo(w4.w), bfhi(w4.w)};
                float ss = 0.f;
#pragma unroll
                for (int j = 0; j < 8; ++j) ss += v[j] * v[j];
                ss += __shfl_xor(ss, 1); ss += __shfl_xor(ss, 2); ss += __shfl_xor(ss, 4);
                const float rstd = __builtin_amdgcn_rsqf(ss * (1.0f / 64.0f) + EPS);
                const int jp = lane & 7, half = jp >> 2, i0 = 4 * (jp & 3);
                const float* gn = qkn + which * 64 + half * 32;
#pragma unroll
                for (int pz = 0; pz < 4; ++pz) { v[2 * pz] *= rstd * gn[i0 + pz]; v[2 * pz + 1] *= rstd * gn[16 + i0 + pz]; }
                if (lat) { const int pos = half ? (tt & 63) : (tt >> 6);
                    const f32x4 cs = *(const f32x4*)(TAB32 + pos * 16 + i0), sn = *(const f32x4*)(TAB32 + 1024 + pos * 16 + i0);
#pragma unroll
                    for (int pz = 0; pz < 4; ++pz) { const float a = v[2 * pz], b = v[2 * pz + 1]; v[2 * pz] = a * cs[pz] - b * sn[pz]; v[2 * pz + 1] = b * cs[pz] + a * sn[pz]; } }
                const float osc = which ? 1.0f : 0.125f * LOG2E;
                u32x4 o; o.x = cvtpk(v[0] * osc, v[1] * osc); o.y = cvtpk(v[2] * osc, v[3] * osc); o.z = cvtpk(v[4] * osc, v[5] * osc); o.w = cvtpk(v[6] * osc, v[7] * osc);
                if (which == 0) *(u32x4*)(QB + (size_t)row * 512 + lane * 8) = o; else *(u32x4*)(KBp + (size_t)row * 128 + lane * 8) = o;
            }
            if (lane < 4) {
                const u32x4 w4 = *(const u32x4*)(Z0 + (size_t)row * N_IN0 + 1408 + lane * 8);
                float v[8] = {bflo(w4.x), bfhi(w4.x), bflo(w4.y), bfhi(w4.y), bflo(w4.z), bfhi(w4.z), bflo(w4.w), bfhi(w4.w)};
                if (lat) { const int half = lane >> 1, i0 = 4 * (lane & 1); const int pos = half ? (tt & 63) : (tt >> 6);
                    const f32x4 cs = *(const f32x4*)(TAB16 + pos * 8 + i0), sn = *(const f32x4*)(TAB16 + 512 + pos * 8 + i0);
#pragma unroll
                    for (int pz = 0; pz < 4; ++pz) { const float a = v[2 * pz], b = v[2 * pz + 1]; v[2 * pz] = a * cs[pz] - b * sn[pz]; v[2 * pz + 1] = b * cs[pz] + a * sn[pz]; } }
                u32x4 o; o.x = cvtpk(v[0], v[1]); o.y = cvtpk(v[2], v[3]); o.z = cvtpk(v[4], v[5]); o.w = cvtpk(v[6], v[7]);
                *(u32x4*)(KR + (size_t)row * 32 + lane * 8) = o;
            }
        }
    }
    SEAM(3);

    if (IN(4)) {
        { pg8::DenseProb P{wsp<bf16_t>(F, O_Z0), wsp<bf16_t>(F, O_WUQ), 384, N_IN0, 384, {}}; P.ord.init(R / 256, N_QA / 256, F.G, (int)blockIdx.x);
          pg8::EpiQA E{wsp<bf16_t>(F, O_QA), wsp<float>(F, O_RSTDQ), TAB16, 0.10206207261596577f * LOG2E};
          pg8::gemm_phase(F.lds, P, E); }
        { pg8::DenseProb P{wsp<bf16_t>(F, O_Z0) + 384, wsp<bf16_t>(F, O_WUKV), 256, N_IN0, 256, {}}; P.ord.init(R / 256, N_KVA / 256, F.G, (int)((blockIdx.x + F.G - (204 % F.G)) % F.G));
          pg8::EpiBf16 E{wsp<bf16_t>(F, O_KVA), N_KVA, wsp<float>(F, O_RSTDKV)};
          pg8::gemm_phase(F.lds, P, E); }
    }
    SEAM(4);

    if (IN(5)) {
        const bf16_t* QA = wsp<bf16_t>(F, O_QA); const bf16_t* KVA = wsp<bf16_t>(F, O_KVA); const bf16_t* QB = wsp<bf16_t>(F, O_QB);
        const bf16_t* KBp = wsp<bf16_t>(F, O_KB); const bf16_t* KR = wsp<bf16_t>(F, O_KR); const bf16_t* Z0 = wsp<bf16_t>(F, O_Z0);
        bf16_t* AO = wsp<bf16_t>(F, O_AO);
        for (int i = 0; i < 3; ++i) {
            int b, hh, q0, kt0, kt1;
            if (i < 2) { const int m = i * 256 + F.vcu; b = m >> 7; hh = (m >> 4) & 7; q0 = b * SEQ + (m & 15) * 256; kt0 = 0; kt1 = 68; }
            else { if (F.vcu >= 32) break; b = (F.vcu >> 3) & 3; hh = F.vcu & 7; q0 = RL + b * CTX; kt0 = 64; kt1 = 68; }
            const int lat0 = b * SEQ, ctx0 = RL + b * CTX;
            AttnSrc<96> S{QA + hh * 64, N_QA, QA + 512 + hh * 32, KVA + hh * 128, N_KVA, KR, 32, KVA + hh * 128 + 64, N_KVA, AO + hh * 64, D};
            attn_unit<96>(F, S, q0, lat0, ctx0, kt0, kt1);
        }
        for (int i = 0; i < 3; ++i) {
            int b, hh, q0, kt0, kt1;
            if (i < 2) { const int m = i * 256 + F.vcu; b = m >> 7; hh = (m >> 4) & 7; q0 = b * SEQ + (m & 15) * 256; kt0 = 0; kt1 = 68; }
            else { if (F.vcu < 32 || F.vcu >= 64) break; b = (F.vcu >> 3) & 3; hh = F.vcu & 7; q0 = RL + b * CTX; kt0 = 64; kt1 = 68; }
            const int lat0 = b * SEQ, ctx0 = RL + b * CTX; const int kvh = hh >> 2;
            AttnSrc<64> S{QB + hh * 64, 512, nullptr, KBp + kvh * 64, 128, nullptr, 0, Z0 + 1280 + kvh * 64, N_IN0, AO + 512 + hh * 64, D};
            attn_unit<64>(F, S, q0, lat0, ctx0, kt0, kt1);
        }
    }
    SEAM(5);

    if (IN(6)) {
        pg8::DenseProb P{wsp<bf16_t>(F, O_AO), wsp<bf16_t>(F, O_WOUT0), 1024, 1024, 1024, {}}; P.ord.init(RL / 256, 4, F.G, (int)blockIdx.x);
        pg8::EpiBf16 E{(bf16_t*)Y, D, nullptr};
        pg8::gemm_phase(F.lds, P, E);
    }
    SEAM(6);


    auto post0 = [&](int row) {
            const float* hp = row < RL ? x_in + (size_t)row * D : ctx_in + (size_t)(row - RL) * D;
            float* ho = row < RL ? args.out + (size_t)row * D : HC + (size_t)(row - RL) * D;
            const int b = row_bidx(row);
            f32x4 y[4], h[4], uo[4]; load_row_bf16((const bf16_t*)Y + (size_t)row * D, lane, y); load_row(hp, lane, h);
            const float rstd = __builtin_amdgcn_rsqf(row_ssq(y) * (1.0f / D) + EPS);
#pragma unroll
            for (int j = 0; j < 4; ++j) { const int c = 4 * lane + 256 * j; const f32x4 g = *(const f32x4*)(normg + 1 * D + c), mg = *(const f32x4*)(MV(0, b, 2) + c);
                h[j] = h[j] + mg * (y[j] * rstd * g); *(f32x4*)(ho + c) = h[j]; }
            norm_mod_store(h, normg + 2 * D, MV(0, b, 3), MV(0, b, 4), U + (size_t)row * D, lane, uo);
    };
    if (IN(7)) {
        const bool split = F.G > 32;
        if (!split || blockIdx.x < 16) {
            pg8::DenseProb P{wsp<bf16_t>(F, O_AO) + (size_t)RL * D, wsp<bf16_t>(F, O_WOUT0), 1024, 1024, 1024, {}}; P.ord.init(RC / 256, 4, split ? 16 : F.G, (int)blockIdx.x);
            pg8::EpiBf16 E{(bf16_t*)Y + (size_t)RL * D, D, nullptr};
            pg8::gemm_phase(F.lds, P, E);
        }
        if (!split) { for (int row = gw; row < RL; row += NGW) post0(row); }
        else if (blockIdx.x >= 16) { for (int row = ((int)blockIdx.x - 16) * 8 + wave; row < RL; row += (F.G - 16) * 8) post0(row); }
    }
    SEAM(7);
    if (IN(8)) { for (int row = RL + gw; row < R; row += NGW) post0(row); }
    SEAM(8);


    if (IN(9)) {
        pg8::DenseProb P{U, wsp<bf16_t>(F, O_WGU0), 1024, 1024, 1024, {}}; P.ord.init(R / 256, N_GU0 / 256, F.G, (int)blockIdx.x);
        pg8::EpiSwiglu E{wsp<bf16_t>(F, O_H0), FFN};
        pg8::gemm_phase(F.lds, P, E);
    }
    SEAM(9);
    if (IN(10)) {
        pg8::DenseProb P{wsp<bf16_t>(F, O_H0), wsp<bf16_t>(F, O_WD0), FFN, FFN, FFN, {}}; P.ord.init(RL / 256, 4, F.G, (int)blockIdx.x);
        pg8::EpiBf16 E{(bf16_t*)Y, D, nullptr};
        pg8::gemm_phase(F.lds, P, E);
    }
    SEAM(10);


    auto post1 = [&](int row) {
            float* hp = row < RL ? args.out + (size_t)row * D : HC + (size_t)(row - RL) * D;
            const int b = row_bidx(row);
            f32x4 y[4], h[4], uo[4]; load_row_bf16((const bf16_t*)Y + (size_t)row * D, lane, y); load_row(hp, lane, h);
            const float rstd = __builtin_amdgcn_rsqf(row_ssq(y) * (1.0f / D) + EPS);
#pragma unroll
            for (int j = 0; j < 4; ++j) { const int c = 4 * lane + 256 * j; const f32x4 g = *(const f32x4*)(normg + 3 * D + c), mg = *(const f32x4*)(MV(0, b, 5) + c);
                h[j] = h[j] + mg * (y[j] * rstd * g); *(f32x4*)(hp + c) = h[j]; }
            norm_mod_store(h, normg + 4 * D, MV(1, b, 0), MV(1, b, 1), U + (size_t)row * D, lane, uo);
    };
    if (IN(11)) {
        const bool split = F.G > 32;
        if (!split || blockIdx.x < 16) {
            pg8::DenseProb P{wsp<bf16_t>(F, O_H0) + (size_t)RL * FFN, wsp<bf16_t>(F, O_WD0), FFN, FFN, FFN, {}}; P.ord.init(RC / 256, 4, split ? 16 : F.G, (int)blockIdx.x);
            pg8::EpiBf16 E{(bf16_t*)Y + (size_t)RL * D, D, nullptr};
            pg8::gemm_phase(F.lds, P, E);
        }
        if (!split) { for (int row = gw; row < RL; row += NGW) post1(row); }
        else if (blockIdx.x >= 16) { for (int row = ((int)blockIdx.x - 16) * 8 + wave; row < RL; row += (F.G - 16) * 8) post1(row); }
    }
    SEAM(11);
    if (IN(12)) { for (int row = RL + gw; row < R; row += NGW) post1(row); }
    SEAM(12);


    if (IN(13)) {
        pg8::DenseProb P{U, wsp<bf16_t>(F, O_WIN1), 1024, 1024, 1024, {}}; P.ord.init(R / 256, N_IN1 / 256, F.G, (int)blockIdx.x);
        pg8::EpiIn1 E{wsp<bf16_t>(F, O_QK1), wsp<bf16_t>(F, O_V1), wsp<bf16_t>(F, O_G1), wsp<bf16_t>(F, O_RR)};
        pg8::gemm_phase(F.lds, P, E);
    }
    SEAM(13);

    if (IN(14)) {
        const bf16_t* QK1 = wsp<bf16_t>(F, O_QK1); const bf16_t* V1 = wsp<bf16_t>(F, O_V1); const bf16_t* RRp = wsp<bf16_t>(F, O_RR);
        bf16_t* QDd[2] = {wsp<bf16_t>(F, O_QDF), wsp<bf16_t>(F, O_QDB)}; bf16_t* KId[2] = {wsp<bf16_t>(F, O_KIF), wsp<bf16_t>(F, O_KIB)}; bf16_t* KTd[2] = {wsp<bf16_t>(F, O_KTF), wsp<bf16_t>(F, O_KTB)};
        bf16_t* VT = wsp<bf16_t>(F, O_VT); float* ECL = wsp<float>(F, O_ECL);
        LAS float* tot = (LAS float*)F.lds;
        const int dkp = tid & 63, dk0 = 2 * dkp, tq = tid >> 6;
        int hh_loaded = -1; float w2[2][16][2], bg[2][2];
        for (int item = F.vcu; item < 544 * 4; item += F.G) {
            const int rc = item >> 2, hh = item & 3, row0 = rc * 32;
            if (hh != hh_loaded) {
                hh_loaded = hh;
#pragma unroll
                for (int d = 0; d < 2; ++d) { const f32x2_t bv = *(const f32x2_t*)(args.in[I_GBGATE] + d * 512 + hh * 128 + dk0); bg[d][0] = bv[0]; bg[d][1] = bv[1];
#pragma unroll
                    for (int j = 0; j < 16; ++j) { const f32x2_t wv = *(const f32x2_t*)(args.in[I_GGATE2] + (size_t)(d * 16 + j) * 512 + hh * 128 + dk0); w2[d][j][0] = wv[0]; w2[d][j][1] = wv[1]; } }
            }
            float a[2][4][2];
#pragma unroll
            for (int i = 0; i < 4; ++i) { const int row = row0 + 4 * tq + i;
                const u32x4* rp = (const u32x4*)(RRp + (size_t)row * 256);
#pragma unroll
                for (int d = 0; d < 2; ++d) { const u32x4 r0 = rp[2 * d], r1 = rp[2 * d + 1];
                    const float rv[16] = {bflo(r0.x), bfhi(r0.x), bflo(r0.y), bfhi(r0.y), bflo(r0.z), bfhi(r0.z), bflo(r0.w), bfhi(r0.w), bflo(r1.x), bfhi(r1.x), bflo(r1.y), bfhi(r1.y), bflo(r1.z), bfhi(r1.z), bflo(r1.w), bfhi(r1.w)};
#pragma unroll
                    for (int c = 0; c < 2; ++c) { float z = bg[d][c];
#pragma unroll
                        for (int j = 0; j < 16; ++j) z += rv[j] * w2[d][j][c];
                        a[d][i][c] = (fminf(z, 0.f) - __logf(1.0f + __expf(-fabsf(z)))) * (1.0f / 16.0f); } } }
            float cf[4][2], sb[4][2];
#pragma unroll
            for (int c = 0; c < 2; ++c) { float sfw = 0.f;
#pragma unroll
                for (int i = 0; i < 4; ++i) { sfw += a[0][i][c]; cf[i][c] = sfw; }
                float sbw = 0.f;
#pragma unroll
                for (int i = 3; i >= 0; --i) { sbw += a[1][i][c]; sb[i][c] = sbw; } }
            *(LAS f32x2_t*)(tot + (0 * 8 + tq) * 128 + dk0) = (f32x2_t){cf[3][0], cf[3][1]};
            *(LAS f32x2_t*)(tot + (1 * 8 + tq) * 128 + dk0) = (f32x2_t){sb[0][0], sb[0][1]};
            __syncthreads();
            float offF[2] = {0.f, 0.f}, offB[2] = {0.f, 0.f}, clF[2] = {0.f, 0.f}, clB[2] = {0.f, 0.f};
#pragma unroll
            for (int g = 0; g < 8; ++g) { const f32x2_t tf = *(const LAS f32x2_t*)(tot + (0 * 8 + g) * 128 + dk0), tb = *(const LAS f32x2_t*)(tot + (1 * 8 + g) * 128 + dk0);
#pragma unroll
                for (int c = 0; c < 2; ++c) { clF[c] += tf[c]; clB[c] += tb[c]; if (g < tq) offF[c] += tf[c]; if (g > tq) offB[c] += tb[c]; } }
            __syncthreads();
            const int pc = hh * 128 + (dk0 & ~31) + sig5(dk0 & 31);
#pragma unroll
            for (int i = 0; i < 4; ++i) { const int row = row0 + 4 * tq + i;
                const unsigned qw = *(const unsigned*)(QK1 + (size_t)row * D + hh * 128 + dk0), kw = *(const unsigned*)(QK1 + (size_t)row * D + 512 + hh * 128 + dk0);
                const float q[2] = {bflo(qw), bfhi(qw)}, k[2] = {bflo(kw), bfhi(kw)};
                float qdv[2][2], kiv[2][2];
#pragma unroll
                for (int c = 0; c < 2; ++c) { const float cF = offF[c] + cf[i][c], cB = offB[c] + sb[i][c];
                    qdv[0][c] = q[c] * __expf(cF); kiv[0][c] = k[c] * __expf(-cF); qdv[1][c] = q[c] * __expf(cB); kiv[1][c] = k[c] * __expf(-cB); }
#pragma unroll
                for (int d = 0; d < 2; ++d) {
                    *(unsigned*)(QDd[d] + (size_t)row * 512 + pc) = cvtpk(qdv[d][0], qdv[d][1]);
                    const unsigned kp = cvtpk(kiv[d][0], kiv[d][1]);
                    *(unsigned*)(KId[d] + (size_t)row * 512 + pc) = kp;
                } }
            if (tq == 0) { *(f32x2_t*)(ECL + ((size_t)(rc * 2 + 0) * 4 + hh) * 256 + dk0) = (f32x2_t){__expf(clF[0]), __expf(clF[1])};
                           *(f32x2_t*)(ECL + ((size_t)(rc * 2 + 1) * 4 + hh) * 256 + dk0) = (f32x2_t){__expf(clB[0]), __expf(clB[1])}; }
            { const int dv = tid & 255, th = tid >> 8; unsigned vw[8];
#pragma unroll
              for (int i = 0; i < 16; ++i) { const unsigned bv = V1[(size_t)(row0 + 16 * th + i) * D + hh * 256 + dv];
                  const int cc = sig5(i);
                  if (cc & 1) vw[cc >> 1] |= bv << 16; else vw[cc >> 1] = bv; }
              bf16_t* vp = VT + ((size_t)rc * 1024 + hh * 256 + dv) * 32 + 16 * th;
              u32x4 o0; o0.x = vw[0]; o0.y = vw[1]; o0.z = vw[2]; o0.w = vw[3]; *(u32x4*)vp = o0;
              u32x4 o1; o1.x = vw[4]; o1.y = vw[5]; o1.z = vw[6]; o1.w = vw[7]; *(u32x4*)(vp + 8) = o1; }
        }
    }
    SEAM(14);

    if (IN(15)) {
        const int xl = blockIdx.x & 7, jj = blockIdx.x >> 3;
        const bool scan_role = (jj & 1) == 0;
        const int nscan = ((F.G >> 3) + 1) / 2 * 8, nconv = F.G - nscan;
        if ((F.G & 7) == 0 && nconv > 0 && !scan_role) {
            LAS float* scr = (LAS float*)(F.lds + wave * 16640);
            const int cidx = xl * (F.G >> 4) + (jj >> 1); int base = 0; const int gwi = cidx * 8 + wave, ngw = nconv * 8;
            for (int e = 0; e < NEXP; ++e) {
                conv64_run(Conv64{args.in[I_MWG] + (size_t)e * D * EXD, args.in[I_MWU] + (size_t)e * D * EXD, EXD, 1024, N_GU1, wsp<bf16_t>(F, O_WGU1) + (size_t)e * N_GU1 * 1024 / 2, 3, 0, 0, 64.0f, 1}, scr, lane, gwi, ngw, base);
                conv64_run(Conv64{args.in[I_MWD] + (size_t)e * EXD * D, nullptr, 1024, EXD, 1024, wsp<bf16_t>(F, O_WD1) + (size_t)e * 1024 * EXD / 2, 0, 1024, 1024, 64.0f, 1}, scr, lane, gwi, ngw, base);
            }
        } else {
        const bool split = (F.G & 7) == 0 && nconv > 0;
        const int sidx = split ? xl * ((F.G >> 4) + ((F.G >> 3) & 1)) + (jj >> 1) : F.vcu, nsw = split ? nscan : F.G;
        const bf16_t* VT = wsp<bf16_t>(F, O_VT); const float* ECL = wsp<float>(F, O_ECL);
        constexpr int SLOT = 8192 * 2 + 2 * 2048 + 1024;
        const int r32 = lane & 31, hi = lane >> 5;
        for (int unit = sidx; unit < 128; unit += nsw) {
            const int chain = unit >> 2, dvp = unit & 3, b = chain >> 3, hh = (chain >> 1) & 3, dir = chain & 1;
            const int dvb = dvp * 2 + (wave & 1);
            const bf16_t* QDp = wsp<bf16_t>(F, dir ? O_QDB : O_QDF); const bf16_t* KIp = wsp<bf16_t>(F, dir ? O_KIB : O_KIF);
            bf16_t* Odp = wsp<bf16_t>(F, dir ? O_OB : O_OF);
            auto rcof = [&](int step) { return step < 8 ? 512 + b * 8 + (dir ? 7 - step : step) : b * 128 + (dir ? 127 - (step - 8) : (step - 8)); };
            const unsigned lds0 = (unsigned)(size_t)F.lds;
            auto dma = [&](int step, int slot) {
                if (wave < 2) return;
                const int rc = rcof(step); const unsigned sb = lds0 + slot * SLOT;
#pragma unroll
                for (int i = 0; i < 4; ++i) { const int j = (wave - 2) + 6 * i; if (j >= 21) break;
                    if (j < 16) { const int p = j & 7; const int r = 4 * p + (lane >> 4), c = (lane & 15) ^ (r & 15);
                        glds16((j < 8 ? KIp : QDp) + (size_t)(rc * 32 + r) * 512 + hh * 128 + c * 8, (unsigned)__builtin_amdgcn_readfirstlane(sb + j * 1024)); }
                    else if (j < 20) { const int p = j - 16; const int r = 16 * (p & 1) + (lane >> 2), c = (lane & 3) ^ ((r >> 2) & 3);
                        glds16(VT + ((size_t)rc * 1024 + hh * 256 + (dvp * 2 + (p >> 1)) * 32 + r) * 32 + c * 8, (unsigned)__builtin_amdgcn_readfirstlane(sb + 16384 + p * 1024)); }
                    else glds16(ECL + ((size_t)(rc * 2 + dir) * 4 + hh) * 256 + lane * 4, (unsigned)__builtin_amdgcn_readfirstlane(sb + 20480)); }
            };
            auto wait_bar = [&](int ngrp) { if (wave < 2) { asm volatile("s_waitcnt lgkmcnt(0)\n\ts_barrier" ::: "memory"); }
                else if (ngrp == 0) { WAIT_BAR(0); } else if (ngrp == 1) { if (wave < 5) { WAIT_BAR(4); } else { WAIT_BAR(3); } } else { if (wave < 5) { WAIT_BAR(8); } else { WAIT_BAR(6); } } };
            f32x16 S4[4];
#pragma unroll
            for (int k = 0; k < 4; ++k)
#pragma unroll
                for (int r = 0; r < 16; ++r) S4[k][r] = 0.f;
            dma(0, 0); dma(1, 1); dma(2, 2);
            wait_bar(2);
            int slot = 0;
            for (int step = 0; step < 136; ++step) {
                if (step + 3 < 136) dma(step + 3, (slot + 3) & 3);
                if (wave < 2) {
                    const LAS unsigned char* sb = F.lds + slot * SLOT;
                    const int x15 = r32 & 15, x3 = (r32 >> 2) & 3;
                    const int trq = (lane & 15) >> 2, trp = lane & 3, trpp = ((trp & 1) << 1) | (trp >> 1), trg = (lane >> 4) & 1;
                    const LAS unsigned char* vbase = sb + 16384 + wave * 2048;
                    bf16x8 qdF[8], kiF[8];
#pragma unroll
                    for (int k = 0; k < 8; ++k) { qdF[k] = *(const LAS bf16x8*)(sb + 8192 + r32 * 256 + (((2 * k + hi) ^ x15) << 4)); kiF[k] = *(const LAS bf16x8*)(sb + r32 * 256 + (((2 * k + hi) ^ x15) << 4)); }
                    const bf16x8 vF0 = *(const LAS bf16x8*)(vbase + r32 * 64 + ((hi ^ x3) << 4)), vF1 = *(const LAS bf16x8*)(vbase + r32 * 64 + (((2 + hi) ^ x3) << 4));
                    __builtin_amdgcn_sched_barrier(0);
                    f32x16 o;
#pragma unroll
                    for (int r = 0; r < 16; ++r) o[r] = 0.f;
                    if (step >= 8) {
                        f32x16 sc;
#pragma unroll
                        for (int r = 0; r < 16; ++r) sc[r] = 0.f;
#pragma unroll
                        for (int k = 0; k < 8; ++k) sc = __builtin_amdgcn_mfma_f32_32x32x16_bf16(kiF[k], qdF[k], sc, 0, 0, 0);
#pragma unroll
                        for (int r = 0; r < 16; ++r) { const int s = (r & 3) + 8 * (r >> 2) + 4 * hi; const bool keep = dir ? (s >= r32) : (s <= r32); sc[r] = keep ? sc[r] : 0.f; }
                        u32x4 w; bf16x8 pf0, pf1;
                        w.x = cvtpk(sc[0], sc[1]); w.y = cvtpk(sc[2], sc[3]); w.z = cvtpk(sc[4], sc[5]); w.w = cvtpk(sc[6], sc[7]); pf0 = __builtin_bit_cast(bf16x8, w);
                        w.x = cvtpk(sc[8], sc[9]); w.y = cvtpk(sc[10], sc[11]); w.z = cvtpk(sc[12], sc[13]); w.w = cvtpk(sc[14], sc[15]); pf1 = __builtin_bit_cast(bf16x8, w);
                        o = __builtin_amdgcn_mfma_f32_32x32x16_bf16(vF0, pf0, o, 0, 0, 0);
                        o = __builtin_amdgcn_mfma_f32_32x32x16_bf16(vF1, pf1, o, 0, 0, 0);
#pragma unroll
                        for (int blk = 0; blk < 4; ++blk)
#pragma unroll
                            for (int s2 = 0; s2 < 2; ++s2) { u32x4 ws4; ws4.x = cvtpk(S4[blk][8 * s2], S4[blk][8 * s2 + 1]); ws4.y = cvtpk(S4[blk][8 * s2 + 2], S4[blk][8 * s2 + 3]);
                                ws4.z = cvtpk(S4[blk][8 * s2 + 4], S4[blk][8 * s2 + 5]); ws4.w = cvtpk(S4[blk][8 * s2 + 6], S4[blk][8 * s2 + 7]);
                                o = __builtin_amdgcn_mfma_f32_32x32x16_bf16(__builtin_bit_cast(bf16x8, ws4), qdF[2 * blk + s2], o, 0, 0, 0); }
                        const int rc = rcof(step);
                        bf16_t* op = Odp + (size_t)(rc * 32 + r32) * D + hh * 256 + dvb * 32 + 4 * hi;
#pragma unroll
                        for (int g = 0; g < 4; ++g) { u32x2 w2; w2.x = cvtpk(o[4 * g], o[4 * g + 1]); w2.y = cvtpk(o[4 * g + 2], o[4 * g + 3]); *(u32x2*)(op + 8 * g) = w2; }
                    }
#pragma unroll
                    for (int blk = 0; blk < 4; ++blk) {
                        bf16x8 kt0, kt1;
                        { const int chunk = 4 * blk + 2 * trg + (trpp >> 1); const int wb = (trpp & 1) * 8;
                          const int tl = 4 * hi + trq, th = tl + 8;
                          const LAS unsigned char* pl = sb + tl * 256 + ((chunk ^ tl) << 4) + wb; const LAS unsigned char* ph = sb + th * 256 + ((chunk ^ th) << 4) + wb;
                          const s16x4 a0 = vtr(pl), a1 = vtr(ph), b0 = vtr(pl + 4096), b1 = vtr(ph + 4096);
                          kt0 = (bf16x8){a0[0], a0[1], a0[2], a0[3], a1[0], a1[1], a1[2], a1[3]}; kt1 = (bf16x8){b0[0], b0[1], b0[2], b0[3], b1[0], b1[1], b1[2], b1[3]}; }
                        S4[blk] = __builtin_amdgcn_mfma_f32_32x32x16_bf16(kt0, vF0, S4[blk], 0, 0, 0);
                        S4[blk] = __builtin_amdgcn_mfma_f32_32x32x16_bf16(kt1, vF1, S4[blk], 0, 0, 0);
#pragma unroll
                        for (int g = 0; g < 4; ++g) { const f32x4 e4 = *(const LAS f32x4*)(sb + 20480 + (32 * blk + 8 * g + 4 * hi) * 4);
                            S4[blk][4 * g] *= e4[0]; S4[blk][4 * g + 1] *= e4[1]; S4[blk][4 * g + 2] *= e4[2]; S4[blk][4 * g + 3] *= e4[3]; }
                    }
                }
                wait_bar(step + 3 < 136 ? 2 : (step + 2 < 136 ? 1 : 0));
                slot = (slot + 1) & 3;
            }
        }
        if (!split) {
            LAS float* scr = (LAS float*)(F.lds + wave * 16640); int base = 0;
            for (int e = 0; e < NEXP; ++e) {
                conv64_run(Conv64{args.in[I_MWG] + (size_t)e * D * EXD, args.in[I_MWU] + (size_t)e * D * EXD, EXD, 1024, N_GU1, wsp<bf16_t>(F, O_WGU1) + (size_t)e * N_GU1 * 1024 / 2, 3, 0, 0, 64.0f, 1}, scr, lane, gw, NGW, base);
                conv64_run(Conv64{args.in[I_MWD] + (size_t)e * EXD * D, nullptr, 1024, EXD, 1024, wsp<bf16_t>(F, O_WD1) + (size_t)e * 1024 * EXD / 2, 0, 1024, 1024, 64.0f, 1}, scr, lane, gw, NGW, base);
            }
        }
        }
    }
    SEAM(15);

    if (IN(16)) {
        const bf16_t* OFp = wsp<bf16_t>(F, O_OF); const bf16_t* OBp = wsp<bf16_t>(F, O_OB); const bf16_t* G1 = wsp<bf16_t>(F, O_G1); bf16_t* GA = wsp<bf16_t>(F, O_GA);
        const float* on = args.in[I_GONORM];
        for (int row = gw; row < RL; row += NGW) {
            const u32x4* pf = (const u32x4*)(OFp + (size_t)row * D + lane * 16); const u32x4* pb = (const u32x4*)(OBp + (size_t)row * D + lane * 16); const u32x4* pg = (const u32x4*)(G1 + (size_t)row * D + lane * 16);
            float v[16], gv[16];
#pragma unroll
            for (int q = 0; q < 2; ++q) { const u32x4 a = pf[q], bq = pb[q], gq = pg[q]; const unsigned aw[4] = {a.x, a.y, a.z, a.w}, bw[4] = {bq.x, bq.y, bq.z, bq.w}, gw4[4] = {gq.x, gq.y, gq.z, gq.w};
#pragma unroll
                for (int j = 0; j < 4; ++j) { v[8 * q + 2 * j] = bflo(aw[j]) + bflo(bw[j]); v[8 * q + 2 * j + 1] = bfhi(aw[j]) + bfhi(bw[j]); gv[8 * q + 2 * j] = bflo(gw4[j]); gv[8 * q + 2 * j + 1] = bfhi(gw4[j]); } }
            float ss = 0.f;
#pragma unroll
            for (int j = 0; j < 16; ++j) ss += v[j] * v[j];
            ss += __shfl_xor(ss, 1); ss += __shfl_xor(ss, 2); ss += __shfl_xor(ss, 4); ss += __shfl_xor(ss, 8);
            const float rstd = __builtin_amdgcn_rsqf(ss * (1.0f / 256.0f) + EPS);
            const int c0 = (lane & 15) * 16;
            unsigned ow[8];
#pragma unroll
            for (int j = 0; j < 8; ++j) { const float a = v[2 * j] * rstd * on[c0 + 2 * j] * silu_f(gv[2 * j]), bq = v[2 * j + 1] * rstd * on[c0 + 2 * j + 1] * silu_f(gv[2 * j + 1]); ow[j] = cvtpk(a, bq); }
            u32x4* po = (u32x4*)(GA + (size_t)row * D + lane * 16);
            u32x4 o0; o0.x = ow[0]; o0.y = ow[1]; o0.z = ow[2]; o0.w = ow[3]; po[0] = o0; u32x4 o1; o1.x = ow[4]; o1.y = ow[5]; o1.z = ow[6]; o1.w = ow[7]; po[1] = o1;
        }
    }
    SEAM(16);

    if (IN(17)) {
        pg8::DenseProb P{wsp<bf16_t>(F, O_GA), wsp<bf16_t>(F, O_WOUT1), 1024, 1024, 1024, {}}; P.ord.init(RL / 256, 4, F.G, (int)blockIdx.x);
        pg8::EpiBf16 E{(bf16_t*)Y, D, nullptr};
        pg8::gemm_phase(F.lds, P, E);
    }
    SEAM(17);

    if (IN(18)) {
        int* SEL = wsp<int>(F, O_SEL); int* ROWTOK = wsp<int>(F, O_ROWTOK);
        LAS float* wr_l = (LAS float*)F.lds;
        LAS int* se = (LAS int*)(F.lds + 32768);
        LAS float* sw = (LAS float*)(F.lds + 32768 + 512);
        LAS int* sbase = (LAS int*)(F.lds + 32768 + 1024);
        for (int i = tid; i < 8192; i += 512) wr_l[i] = args.in[I_MROUTER][i];
        __syncthreads();
        for (int tile = F.vcu; tile < RL / 64; tile += F.G) {
            for (int rr = 0; rr < 8; ++rr) {
                const int lr = wave * 8 + rr, row = tile * 64 + lr; const int b = row >> 12;
                float* hp = args.out + (size_t)row * D;
                f32x4 y[4], h[4], uo[4]; load_row_bf16((const bf16_t*)Y + (size_t)row * D, lane, y); load_row(hp, lane, h);
                const float rstd = __builtin_amdgcn_rsqf(row_ssq(y) * (1.0f / D) + EPS);
#pragma unroll
                for (int j = 0; j < 4; ++j) { const int c = 4 * lane + 256 * j; const f32x4 g = *(const f32x4*)(normg + 5 * D + c), mg = *(const f32x4*)(MV(1, b, 2) + c);
                    h[j] = h[j] + mg * (y[j] * rstd * g); *(f32x4*)(hp + c) = h[j]; }
                norm_mod_store(h, normg + 6 * D, MV(1, b, 3), MV(1, b, 4), nullptr, lane, uo, wsp<unsigned char>(F, O_U) + (size_t)row * D);
                float lg[8];
#pragma unroll
                for (int e = 0; e < 8; ++e) lg[e] = 0.f;
#pragma unroll
                for (int j = 0; j < 4; ++j)
#pragma unroll
                    for (int q = 0; q < 4; ++q) { const int k = 4 * lane + 256 * j + q; const LAS f32x4* wp = (const LAS f32x4*)(wr_l + k * 8); const f32x4 w0 = wp[0], w1 = wp[1]; const float uv = uo[j][q];
                        lg[0] += uv * w0[0]; lg[1] += uv * w0[1]; lg[2] += uv * w0[2]; lg[3] += uv * w0[3]; lg[4] += uv * w1[0]; lg[5] += uv * w1[1]; lg[6] += uv * w1[2]; lg[7] += uv * w1[3]; }
#pragma unroll
                for (int e = 0; e < 8; ++e) lg[e] = wave_sum(lg[e]) + args.in[I_MBROUTER][e];
                int e0 = 0; float l0 = lg[0];
#pragma unroll
                for (int e = 1; e < 8; ++e) if (lg[e] > l0) { l0 = lg[e]; e0 = e; }
                int e1 = -1; float l1 = -3.0e38f;
#pragma unroll
                for (int e = 0; e < 8; ++e) if (e != e0 && lg[e] > l1) { l1 = lg[e]; e1 = e; }
                const float p1 = __expf(l1 - l0), w0n = 1.0f / (1.0f + p1), w1n = p1 / (1.0f + p1);
                if (lane == 0) { se[lr * 2] = e0; se[lr * 2 + 1] = e1; sw[lr * 2] = w0n; sw[lr * 2 + 1] = w1n; }
            }
            __syncthreads();
            if (tid < 8) { int c = 0; for (int r2 = 0; r2 < 64; ++r2) c += (se[2 * r2] == tid) + (se[2 * r2 + 1] == tid);
                sbase[tid] = (int)__hip_atomic_fetch_add(ctl + CW_CNT + 64 * tid, (unsigned)c, RLX_AGENT); }
            __syncthreads();
            if (tid < 64) { const int e0 = se[2 * tid], e1 = se[2 * tid + 1]; int r0 = 0, r1 = 0;
                for (int r2 = 0; r2 < tid; ++r2) { const int a0 = se[2 * r2], a1 = se[2 * r2 + 1]; r0 += (a0 == e0) + (a1 == e0); r1 += (a0 == e1) + (a1 == e1); }
                const int p0 = sbase[e0] + r0, p1 = sbase[e1] + r1, tok = tile * 64 + tid;
                ROWTOK[e0 * CAPE + p0] = tok; ROWTOK[e1 * CAPE + p1] = tok;
                int* sp = SEL + (size_t)tok * 8; sp[0] = e0; sp[1] = p0; sp[2] = e1; sp[3] = p1; sp[4] = __float_as_int(sw[2 * tid]); sp[5] = __float_as_int(sw[2 * tid + 1]); }
            __syncthreads();
        }
    }
    SEAM(18);

    pg8::MoeTiles MT;
    if (IN(19) || IN(20) || IN(21)) {
        int acc = 0; MT.tp8 = 0ull; MT.c4a = 0ull; MT.c4b = 0ull;
#pragma unroll
        for (int e = 0; e < 8; ++e) { const int c = (int)__builtin_amdgcn_readfirstlane((int)__hip_atomic_load(ctl + CW_CNT + 64 * e, RLX_AGENT));
            if (e < 4) MT.c4a |= (unsigned long long)(unsigned)c << (16 * e); else MT.c4b |= (unsigned long long)(unsigned)c << (16 * (e - 4));
            MT.tp8 |= (unsigned long long)(unsigned)acc << (8 * e); acc += (c + 255) >> 8; }
        MT.nt = acc;
    }
    if (IN(19)) {
        pg8::MoeGuProb P{wsp<unsigned char>(F, O_U), wsp<unsigned char>(F, O_WGU1), 512, 512, {}, MT, wsp<int>(F, O_ROWTOK)}; P.ord.init(MT.nt, N_GU1 / 256, F.G, (int)blockIdx.x);
        pg8::EpiSwiglu8 E{wsp<unsigned char>(F, O_HM), EXD};
        pg8::gemm_phase(F.lds, P, E);
    }
    SEAM(19);
    if (IN(20)) {
        pg8::MoeDnProb P{wsp<unsigned char>(F, O_HM), wsp<unsigned char>(F, O_WD1), EXD / 2, EXD / 2, {}, MT}; P.ord.init(MT.nt, 4, F.G, (int)blockIdx.x);
        pg8::EpiBf16 E{wsp<bf16_t>(F, O_YE), D, nullptr};
        pg8::gemm_phase(F.lds, P, E);
    }
    SEAM(20);
    if (IN(21)) {
        const int* SEL = wsp<int>(F, O_SEL); const bf16_t* YE = wsp<bf16_t>(F, O_YE);
        for (int row = gw; row < RL; row += NGW) {
            const int b = row >> 12; const int* sp = SEL + (size_t)row * 8;
            const int e0 = sp[0], p0 = sp[1], e1 = sp[2], p1 = sp[3]; const float w0 = __int_as_float(sp[4]), w1 = __int_as_float(sp[5]);
            const int t0 = pg8::moe_tp(MT, e0), t1 = pg8::moe_tp(MT, e1);
            const bf16_t* y0 = YE + ((size_t)t0 * 256 + p0) * D; const bf16_t* y1 = YE + ((size_t)t1 * 256 + p1) * D;
            float* hp = args.out + (size_t)row * D;
            f32x4 y[4], h[4]; load_row(hp, lane, h);
#pragma unroll
            for (int j = 0; j < 4; ++j) { const int c = 4 * lane + 256 * j; const u32x2 a = *(const u32x2*)(y0 + c), bq = *(const u32x2*)(y1 + c);
                y[j][0] = w0 * bflo(a.x) + w1 * bflo(bq.x); y[j][1] = w0 * bfhi(a.x) + w1 * bfhi(bq.x); y[j][2] = w0 * bflo(a.y) + w1 * bflo(bq.y); y[j][3] = w0 * bfhi(a.y) + w1 * bfhi(bq.y); }
            const float rstd = __builtin_amdgcn_rsqf(row_ssq(y) * (1.0f / D) + EPS);
#pragma unroll
            for (int j = 0; j < 4; ++j) { const int c = 4 * lane + 256 * j; const f32x4 g = *(const f32x4*)(normg + 7 * D + c), mg = *(const f32x4*)(MV(1, b, 5) + c);
                *(f32x4*)(hp + c) = h[j] + mg * (y[j] * rstd * g); }
        }
    }
#undef IN
#undef SEAM
#undef MV
}

constexpr int N_PHASES = 22;
extern "C" void kernel_launch(void* const* d_in, const int* in_sizes, int n_in, void* d_out, int out_size, void* d_ws, size_t ws_size, hipStream_t stream) {
    static int grid = 0;
    if (grid == 0) {
        if (n_in != 27 || out_size != RL * D || ws_size < WS_END) { fprintf(stderr, "kernel_launch: unexpected shapes n_in %d out %d ws %zu (need %zu)\n", n_in, out_size, ws_size, (size_t)WS_END); grid = -1; return; }
        int dev = 0, cus = 0, per_cu = 0;
        if (hipGetDevice(&dev) != hipSuccess || hipDeviceGetAttribute(&cus, hipDeviceAttributeMultiprocessorCount, dev) != hipSuccess) { grid = -1; return; }
        if (hipFuncSetAttribute((const void*)mk_fwd, hipFuncAttributeMaxDynamicSharedMemorySize, LDS_BYTES) != hipSuccess) { fprintf(stderr, "kernel_launch: hipFuncSetAttribute failed\n"); grid = -1; return; }
        if (hipOccupancyMaxActiveBlocksPerMultiprocessor(&per_cu, (const void*)mk_fwd, 512, LDS_BYTES) != hipSuccess || per_cu < 1) { fprintf(stderr, "kernel_launch: occupancy query says %d\n", per_cu); }
        (void)hipGetLastError();
        grid = cus;
        if (grid > 256) grid = 256;
    }
    if (grid < 0) return;
    (void)hipMemsetAsync((char*)d_ws + O_CTL, 0, CTL_BYTES, stream);
    Args a{};
    for (int i = 0; i < 27; ++i) a.in[i] = (const float*)d_in[i];
    a.out = (float*)d_out; a.ws = (unsigned char*)d_ws;
#if MK_ONE_LAUNCH
    a.ph_lo = 0; a.ph_hi = N_PHASES;
    hipLaunchKernelGGL(mk_fwd, dim3(grid), dim3(512), LDS_BYTES, stream, a);
#else
    for (int p = 0; p < N_PHASES; ++p) { a.ph_lo = p; a.ph_hi = p + 1; for (int rep = 0; rep < (p == MK_REP ? 2 : 1); ++rep) hipLaunchKernelGGL(mk_fwd, dim3(grid), dim3(512), LDS_BYTES, stream, a); }
#endif
}
```

```cpp
#include <hip/hip_runtime.h>
#include <cstdio>
#include <cstdint>

#ifndef MK_ONE_LAUNCH
#define MK_ONE_LAUNCH 1
#endif
#ifndef MK_EPI2
#define MK_EPI2 0
#endif
#ifndef MK_REP
#define MK_REP -1
#endif

#define LAS __attribute__((address_space(3)))
#define GAS __attribute__((address_space(1)))
typedef unsigned short bf16_t;
typedef short bf16x8 __attribute__((ext_vector_type(8)));
typedef short s16x4 __attribute__((ext_vector_type(4)));
typedef float f32x4 __attribute__((ext_vector_type(4)));
typedef float f32x16 __attribute__((ext_vector_type(16)));
typedef unsigned u32x4 __attribute__((ext_vector_type(4)));
typedef unsigned u32x2 __attribute__((ext_vector_type(2)));
typedef float f32x2_t __attribute__((ext_vector_type(2)));
typedef __bf16 bf16x2_t __attribute__((ext_vector_type(2)));
#define RLX_AGENT __ATOMIC_RELAXED, __HIP_MEMORY_SCOPE_AGENT

__device__ __forceinline__ unsigned cvtpk(float lo, float hi) { f32x2_t v = {lo, hi}; bf16x2_t b = __builtin_convertvector(v, bf16x2_t); return __builtin_bit_cast(unsigned, b); }
__device__ __forceinline__ bf16_t f2bf(float f) { return (bf16_t)(cvtpk(f, 0.f) & 0xffffu); }
__device__ __forceinline__ float bflo(unsigned w) { return __uint_as_float(w << 16); }
__device__ __forceinline__ float bfhi(unsigned w) { return __uint_as_float(w & 0xffff0000u); }
__device__ __forceinline__ float bf2f(bf16_t b) { return __uint_as_float(((unsigned)b) << 16); }
__device__ __forceinline__ float wave_sum(float v) {
#pragma unroll
    for (int o = 1; o < 64; o <<= 1) v += __shfl_xor(v, o);
    return v;
}
__device__ __forceinline__ float fast_exp(float x) { return __builtin_amdgcn_exp2f(x * 1.4426950408889634f); }
__device__ __forceinline__ float clamp8(float x) { return __builtin_amdgcn_fmed3f(x, -448.0f, 448.0f); }
__device__ __forceinline__ unsigned pack_fp8x4(float a, float b, float c, float d) { int w = __builtin_amdgcn_cvt_pk_fp8_f32(clamp8(a), clamp8(b), 0, false); w = __builtin_amdgcn_cvt_pk_fp8_f32(clamp8(c), clamp8(d), w, true); return (unsigned)w; }
__device__ __forceinline__ float swiglu_f(float gp, float up, float k) { return (gp * up) * __builtin_amdgcn_rcpf(__builtin_fmaf(__builtin_amdgcn_exp2f(gp), k, k)); }
__device__ __forceinline__ float silu_f(float g) { return g * __builtin_amdgcn_rcpf(1.0f + fast_exp(-g)); }

#define XB_TMO      128
#define XB_XCNT(j)  (256  + 64 * (j))
#define XB_XSUB(j)  (1280 + 64 * (j))
#define XB_XGEN(j)  (2304 + 64 * (j))
#define XB_TOP      3328
#define XB_TOPGEN   3392
#define XCD_BAR_WORDS 3456
#define XB_SPIN_CAP (1u << 18)
__device__ __forceinline__ unsigned xb_ld(unsigned* p)              { return __hip_atomic_load(p, __ATOMIC_RELAXED, __HIP_MEMORY_SCOPE_AGENT); }
__device__ __forceinline__ unsigned xb_add(unsigned* p, unsigned v) { return __hip_atomic_fetch_add(p, v, __ATOMIC_RELAXED, __HIP_MEMORY_SCOPE_AGENT); }
__device__ __forceinline__ unsigned xb_xcc_id() { return (unsigned)__builtin_amdgcn_s_getreg((3 << 11) | 20) & 0xFu; }
#define XB_SPIN(cond, bar) do { unsigned _sp = 0; while (cond) { __builtin_amdgcn_s_sleep(1); \
    if ((++_sp & 255u) == 0u) { if (xb_ld(&(bar)[XB_TMO])) break; if (_sp > XB_SPIN_CAP) { atomicAdd(&(bar)[XB_TMO], 1u); break; } } } } while (0)
struct XcdBarrier { unsigned* bar; unsigned x; volatile LAS unsigned* st; };
__device__ __forceinline__ XcdBarrier xcd_barrier_post(unsigned* bar, volatile LAS unsigned* st) {
    XcdBarrier b; b.bar = bar; b.x = xb_xcc_id(); b.st = st;
    if (threadIdx.x == 0) (void)xb_add(&bar[XB_XCNT(b.x)], 1u);
    return b;
}
__device__ __forceinline__ void xcd_barrier_complete(unsigned* bar, unsigned x, unsigned& nloc, unsigned& nx) {
    const unsigned G = gridDim.x * gridDim.y * gridDim.z;
    unsigned sum, cnt, mine, sp = 0u;
    for (;;) {
        sum = 0u; cnt = 0u; mine = 0u;
#pragma unroll
        for (unsigned j = 0; j < 16; ++j) { const unsigned c = xb_ld(&bar[XB_XCNT(j)]); sum += c; cnt += (c > 0u) ? 1u : 0u; mine = (j == x) ? c : mine; }
        if (sum == G) break;
        __builtin_amdgcn_s_sleep(1);
        if ((++sp & 255u) == 0u) { if (xb_ld(&bar[XB_TMO])) break; if (sp > XB_SPIN_CAP) { atomicAdd(&bar[XB_TMO], 1u); break; } }
    }
    nloc = mine > 0u ? mine : 1u; nx = cnt > 0u ? cnt : 1u;
}
__device__ __forceinline__ void xcd_barrier(const XcdBarrier& b) {
    asm volatile("s_waitcnt vmcnt(0)" ::: "memory");
    __syncthreads();
    if (threadIdx.x == 0) {
        unsigned* bar = b.bar;
        __builtin_amdgcn_s_waitcnt(0);
        unsigned nloc = b.st[0], nx = b.st[1];
        if (nloc == 0u) { xcd_barrier_complete(bar, b.x, nloc, nx); b.st[0] = nloc; b.st[1] = nx; }
        const unsigned old = xb_add(&bar[XB_XSUB(b.x)], 1u);
        const unsigned gen = old / nloc;
        if (old + 1u == (gen + 1u) * nloc) {
            __builtin_amdgcn_fence(__ATOMIC_RELEASE, "agent");
            asm volatile("s_waitcnt vmcnt(0)" ::: "memory");
            const unsigned og = xb_add(&bar[XB_TOP], 1u);
            const unsigned tg = og / nx;
            if (og + 1u == (tg + 1u) * nx) xb_add(&bar[XB_TOPGEN], 1u);
            else XB_SPIN(xb_ld(&bar[XB_TOPGEN]) == tg, bar);
            __builtin_amdgcn_fence(__ATOMIC_ACQUIRE, "agent");
            xb_add(&bar[XB_XGEN(b.x)], 1u);
            asm volatile("s_waitcnt vmcnt(0)" ::: "memory");
        } else {
            XB_SPIN(xb_ld(&bar[XB_XGEN(b.x)]) == gen, bar);
            __builtin_amdgcn_fence(__ATOMIC_ACQUIRE, "agent");
            asm volatile("s_waitcnt vmcnt(0)" ::: "memory");
        }
    }
    __syncthreads();
}

constexpr int D = 1024, NB = 4, SEQ = 4096, CTX = 256;
constexpr int RL = NB * SEQ;
constexpr int RC = NB * CTX;
constexpr int R = RL + RC;
constexpr float EPS = 1e-6f;
constexpr float LOG2E = 1.4426950408889634f;
constexpr int N_IN0 = 1536, N_QA = 768, N_KVA = 1024, FFN = 2816, N_GU0 = 2 * FFN, N_IN1 = 3328, EXD = 3584, N_GU1 = 2 * EXD, NEXP = 8;
constexpr int CAPE = 16384;

constexpr size_t MiB = 1u << 20;
constexpr size_t O_CTL = 0;
constexpr size_t CTL_BYTES = 65536;
constexpr int CW_BAR = 0;
constexpr int CW_CNT = 8192;
constexpr size_t O_MODV = 1 * MiB;
constexpr size_t O_TAB16 = O_MODV + 256 * 1024;
constexpr size_t O_TAB32 = O_TAB16 + 8192;
constexpr size_t O_RSTDQ = O_TAB32 + 16384;
constexpr size_t O_RSTDKV = O_RSTDQ + 81920;
constexpr size_t O_SEL = 2 * MiB;
constexpr size_t O_ROWTOK = 3 * MiB;
constexpr size_t O_WGU1 = 4 * MiB;
constexpr size_t O_YE = O_WGU1;
constexpr size_t O_WD1 = 116 * MiB;
constexpr size_t O_WIN1 = 172 * MiB;
constexpr size_t O_WOUT1 = 179 * MiB;
constexpr size_t O_WIN0 = 181 * MiB;
constexpr size_t O_WUQ = 184 * MiB;
constexpr size_t O_WUKV = 185 * MiB;
constexpr size_t O_WOUT0 = 186 * MiB;
constexpr size_t O_WGU0 = 188 * MiB;
constexpr size_t O_WD0 = 199 * MiB;
constexpr size_t O_HC = 205 * MiB;
constexpr size_t O_U = 209 * MiB;
constexpr size_t O_Y = 243 * MiB;
constexpr size_t O_Z0 = 311 * MiB;
constexpr size_t O_QA = 362 * MiB;
constexpr size_t O_KVA = 388 * MiB;
constexpr size_t O_QB = 422 * MiB;
constexpr size_t O_KB = 439 * MiB;
constexpr size_t O_KR = 444 * MiB;
constexpr size_t O_AO = 446 * MiB;
constexpr size_t O_H0 = 311 * MiB;
constexpr size_t O_QK1 = 311 * MiB;
constexpr size_t O_V1 = 345 * MiB;
constexpr size_t O_G1 = 379 * MiB;
constexpr size_t O_RR = 413 * MiB;
constexpr size_t O_QDF = 422 * MiB, O_KIF = 439 * MiB, O_KTF = 456 * MiB, O_QDB = 473 * MiB;
constexpr size_t O_KIB = 243 * MiB, O_KTB = 260 * MiB, O_VT = 277 * MiB;
constexpr size_t O_ECL = 490 * MiB;
constexpr size_t O_OF = O_QK1, O_OB = O_V1;
constexpr size_t O_GA = O_QDF;
constexpr size_t O_HM = 243 * MiB;
constexpr size_t WS_END = 495 * MiB;
static_assert(O_HM + (size_t)34816 * EXD * 2 <= 482 * MiB, "HM");
static_assert(O_RR + (size_t)R * 256 * 2 <= O_QDF, "RR");
static_assert(O_ECL + (size_t)544 * 8 * 1024 <= WS_END, "ECL");

constexpr int RING_BYTES = 131072;
constexpr int LDS_BYTES = 163840;
constexpr int LDSCTL_OFF = LDS_BYTES - 256;

struct Args {
    const float* in[27];
    float* out; unsigned char* ws;
    int ph_lo, ph_hi;
};
enum { I_X = 0, I_C, I_CTX, I_CCTX, I_MODW, I_MODB, I_NORMG, I_AWIN, I_AQN, I_AWUQ, I_AKVN, I_AWUKV, I_AQKN, I_AWOUT, I_GWIN, I_GGATE2, I_GBGATE, I_GONORM, I_GWOUT,
       I_FWG, I_FWU, I_FWD, I_MROUTER, I_MBROUTER, I_MWG, I_MWU, I_MWD };

struct Conv { const float* s0; const float* s1; int Nsrc; int K; int Ndst; bf16_t* dst; int mode; const float* kscale; };
__device__ __forceinline__ int ilv64(int p) { return (p >> 5) * 32 + (p & 1) * 16 + ((p & 31) >> 1); }
__device__ __forceinline__ int ilv32(int p) { return (p >> 4) * 16 + (p & 1) * 8 + ((p & 15) >> 1); }
__device__ __forceinline__ const float* conv_col(const Conv& c, int n, float& sc) {
    sc = 1.0f;
    switch (c.mode) {
    case 0: return c.s0 + n;
    case 1: {
        if (n < 640) return c.s0 + n;
        if (n < 1152) { const int hh = (n - 640) >> 6, p = (n - 640) & 63; return c.s0 + 672 + hh * 64 + ilv64(p); }
        if (n < 1280) { const int hh = (n - 1152) >> 6, p = (n - 1152) & 63; return c.s0 + 1184 + hh * 64 + ilv64(p); }
        if (n < 1408) return c.s0 + 1312 + (n - 1280);
        if (n < 1440) return c.s0 + 640 + ilv32(n - 1408);
        return nullptr; }
    case 2: {
        if (n < 512) return c.s0 + (n >> 6) * 96 + (n & 63);
        const int hh = (n - 512) >> 5, p = (n - 512) & 31; return c.s0 + hh * 96 + 64 + ilv32(p); }
    case 3: {
        const int G = n >> 5, j = n & 31; return (j < 16) ? c.s0 + 16 * G + j : c.s1 + 16 * G + (j - 16); }
    case 4: {
        if (n >= 3104) return nullptr;
        if (n < 512) sc = 0.08838834764831845f;
        return c.s0 + n; }
    }
    return nullptr;
}
__device__ __forceinline__ void conv_item(const Conv& c, int item, LAS float* scr, int lane) {
    const int nblk = c.Ndst / 32, kb = item / nblk, nb = item % nblk, k0 = 64 * kb, n0 = 32 * nb;
    float sc; const float* cp = conv_col(c, n0 + (lane & 31), sc);
    const int kh = lane >> 5;
#pragma unroll 16
    for (int i = 0; i < 32; ++i) { const int kk = 2 * i + kh; float v = 0.f;
        if (cp) { v = cp[(size_t)(k0 + kk) * c.Nsrc] * sc; if (c.kscale) v *= c.kscale[k0 + kk]; }
        scr[kk * 33 + (lane & 31)] = v; }
    asm volatile("s_waitcnt lgkmcnt(0)" ::: "memory");
    const int ch = lane & 7;
#pragma unroll
    for (int j = 0; j < 4; ++j) { const int n = (lane >> 3) + 8 * j; const LAS float* s = scr + (8 * ch) * 33 + n;
        u32x4 o; o.x = cvtpk(s[0 * 33], s[1 * 33]); o.y = cvtpk(s[2 * 33], s[3 * 33]); o.z = cvtpk(s[4 * 33], s[5 * 33]); o.w = cvtpk(s[6 * 33], s[7 * 33]);
        *(u32x4*)(c.dst + (size_t)(n0 + n) * c.K + k0 + 8 * ch) = o; }
    asm volatile("s_waitcnt lgkmcnt(0)" ::: "memory");
}

struct Conv64 { const float* s0; const float* s1; int Nsrc; int K; int Ndst; bf16_t* dst; int mode; int nvalid; int nscaled; float rscale; int f8; };
struct Conv64Geo { int k0, n0, nd; bool valid; float sc; const float* src; };
__device__ __forceinline__ Conv64Geo conv64_geo(const Conv64& c, int item, int lane) {
    Conv64Geo g; const int nblk = c.Ndst / 64, kb = item / nblk, nb = item % nblk; g.k0 = 64 * kb; g.n0 = 64 * nb;
    const int c4 = lane & 15, kr = lane >> 4; g.valid = true; g.sc = 1.0f;
    if (c.mode == 3) { const int cc = 4 * (c4 & 7); g.src = c.s0 + ((c4 < 8) ? (long)0 : (long)(c.s1 - c.s0)) + 32 * nb + cc; g.nd = 32 * (cc >> 4) + ((c4 < 8) ? 0 : 16) + (cc & 15); g.sc = c.rscale * ((c4 < 8) ? -1.4426950408889634f : 1.0f); }
    else { g.nd = 4 * c4; g.src = c.s0 + g.n0 + g.nd; g.valid = (g.n0 + g.nd) < c.nvalid; if (g.n0 + g.nd < c.nscaled) g.sc = c.rscale; }
    g.src += (size_t)(g.k0 + kr) * c.Nsrc;
    return g;
}
__device__ __forceinline__ void conv64_load(const Conv64& c, int item, int lane, f32x4 (&v)[16]) {
    const Conv64Geo g = conv64_geo(c, item, lane);
#pragma unroll
    for (int i = 0; i < 16; ++i) v[i] = g.valid ? *(const f32x4*)(g.src + (size_t)(4 * i) * c.Nsrc) : (f32x4){0.f, 0.f, 0.f, 0.f};
}
__device__ __forceinline__ void conv64_store(const Conv64& c, int item, LAS float* scr, int lane, const f32x4 (&v)[16]) {
    const Conv64Geo g = conv64_geo(c, item, lane); const int kr = lane >> 4, nd = g.nd, k0 = g.k0, n0 = g.n0; const float sc = g.sc;
#pragma unroll
    for (int i = 0; i < 16; ++i) { LAS float* p = scr + (4 * i + kr) * 65 + nd; p[0] = v[i][0] * sc; p[1] = v[i][1] * sc; p[2] = v[i][2] * sc; p[3] = v[i][3] * sc; }
    asm volatile("s_waitcnt lgkmcnt(0)" ::: "memory");
    if (c.f8) {
        const int ch = lane & 3; unsigned char* d8 = (unsigned char*)c.dst;
#pragma unroll
        for (int it = 0; it < 4; ++it) { const int r = it * 16 + (lane >> 2); const LAS float* sp = scr + (16 * ch) * 65 + r; u32x4 o;
            o.x = pack_fp8x4(sp[0 * 65], sp[1 * 65], sp[2 * 65], sp[3 * 65]); o.y = pack_fp8x4(sp[4 * 65], sp[5 * 65], sp[6 * 65], sp[7 * 65]);
            o.z = pack_fp8x4(sp[8 * 65], sp[9 * 65], sp[10 * 65], sp[11 * 65]); o.w = pack_fp8x4(sp[12 * 65], sp[13 * 65], sp[14 * 65], sp[15 * 65]);
            *(u32x4*)(d8 + (size_t)(n0 + r) * c.K + k0 + 16 * ch) = o; }
    } else {
    const int ch = lane & 7;
#pragma unroll
    for (int it = 0; it < 8; ++it) { const int r = it * 8 + (lane >> 3); const LAS float* sp = scr + (8 * ch) * 65 + r;
        u32x4 o; o.x = cvtpk(sp[0 * 65], sp[1 * 65]); o.y = cvtpk(sp[2 * 65], sp[3 * 65]); o.z = cvtpk(sp[4 * 65], sp[5 * 65]); o.w = cvtpk(sp[6 * 65], sp[7 * 65]);
        *(u32x4*)(c.dst + (size_t)(n0 + r) * c.K + k0 + 8 * ch) = o; }
    }
    asm volatile("s_waitcnt lgkmcnt(0)" ::: "memory");
}

__device__ __forceinline__ void conv64_run(const Conv64& c, LAS float* scr, int lane, int gwi, int ngw, int& base) {
    const int n = (c.K / 64) * (c.Ndst / 64); int it = gwi - base; if (it < 0) it += ngw;
    if (it < n) { f32x4 va[16], vb[16]; conv64_load(c, it, lane, va);
        for (;;) { const int i2 = it + ngw; if (i2 < n) conv64_load(c, i2, lane, vb); conv64_store(c, it, scr, lane, va); if (i2 >= n) break;
                   const int i3 = i2 + ngw; if (i3 < n) conv64_load(c, i3, lane, va); conv64_store(c, i2, scr, lane, vb); if (i3 >= n) break; it = i3; } }
    base = (base + n) % ngw;
}

namespace pg8 {
constexpr int BM = 256, BK = 64, HALF = 128, HTB = HALF * BK * 2, STAGE_BYTES = 8 * HTB;
constexpr int NXCD = 8, WGM = 8;
__device__ __forceinline__ int lds_byte(int r, int c) { const int st = (r >> 4) * 2 + (c >> 5), rr = r & 15, cc = c & 31, ob = rr * 64 + cc * 2; return st * 1024 + (ob ^ (((ob >> 9) & 1) << 5)); }
__device__ __forceinline__ void stage_rc(int b, int& Rr, int& C) { const int st = b / 1024, sb = b % 1024, swz = sb ^ (((sb >> 9) & 1) << 5); Rr = (st >> 1) * 16 + swz / 64; C = (st & 1) * 32 + (swz % 64) / 2; }
__device__ __forceinline__ int perm32(int rho) { const int n = rho >> 4, i = rho & 15; return 8 * (i >> 2) + 4 * n + (i & 3); }
struct Unit { int pm, pn; };
typedef int v8i_t __attribute__((ext_vector_type(8)));
typedef int v4i_t __attribute__((ext_vector_type(4)));
__device__ __forceinline__ v8i_t cat8(bf16x8 a, bf16x8 b) { const v4i_t x = __builtin_bit_cast(v4i_t, a), y = __builtin_bit_cast(v4i_t, b); return __builtin_shufflevector(x, y, 0, 1, 2, 3, 4, 5, 6, 7); }
struct Order {
    int nM, nN, nwg, G, c;
    __device__ __forceinline__ void init(int nM_, int nN_, int G_, int c_) { nM = nM_; nN = nN_; nwg = nM * nN; G = G_; c = c_; }
    __device__ __forceinline__ bool next(int i, Unit& u) const {
        const long L = (long)i * G + c; if (L >= nwg) return false;
        int wgid = (int)L; { const int q = nwg / NXCD, r = nwg % NXCD, xcd = wgid % NXCD, off = wgid / NXCD; wgid = (xcd < r ? xcd * (q + 1) : r * (q + 1) + (xcd - r) * q) + off; }
        const int nig = WGM * nN, gid = wgid / nig, fm = gid * WGM, gsz = (nM - fm) < WGM ? (nM - fm) : WGM;
        u.pm = fm + ((wgid % nig) % gsz); u.pn = (wgid % nig) / gsz; return true;
    }
};

template <class Prob, class Epi>
__device__ __forceinline__ void gemm_phase(LAS unsigned char* lds, const Prob& P, const Epi& E) {
    const int tid = threadIdx.x, wid = __builtin_amdgcn_readfirstlane(tid >> 6), lane = tid & 63, wr = wid >> 2, wc = wid & 3, fr = lane & 15, fq = lane >> 4;
    const int K = P.K, nt = K / BK, ldb = P.ldb;
    int RA[2], CA[2]; unsigned voffB[2];
#pragma unroll
    for (int i = 0; i < 2; ++i) { int Rr, C; stage_rc(tid * 16 + i * 8192, Rr, C); const int Rb = Epi::PERM ? ((Rr & ~31) + perm32(Rr & 31)) : Rr;
        RA[i] = Rr; CA[i] = C; voffB[i] = (unsigned)(Rb * ldb + C) * 2u; }
    const size_t hstepB = (size_t)HALF * ldb * 2;
    const unsigned ldsw = (unsigned)wid * 1024u;
    const int aoff = lds_byte(wr * 64 + fr, fq * 8), boff = lds_byte(wc * 32 + fr, fq * 8);
    const char* Abase = (const char*)P.Abase;
    const int scl_a = P.sa * 0x01010101, scl_b = P.sb * 0x01010101;
#define PG8_SA(b, h) (((b) * 2 + (h)) * HTB)
#define PG8_SB(b, h) ((4 + (b) * 2 + (h)) * HTB)
#define PG8_STAGEB(bufoff, gbase) do { _Pragma("unroll") for (int _i = 0; _i < 2; ++_i) \
        __builtin_amdgcn_global_load_lds((const unsigned*)((const char*)(gbase) + voffB[_i]), (LAS unsigned*)(lds + (bufoff) + ldsw + _i * 8192), 16, 0, 0); } while (0)
#define PG8_STAGEA(bufoff, vo, h, kb) do { _Pragma("unroll") for (int _i = 0; _i < 2; ++_i) \
        __builtin_amdgcn_global_load_lds((const unsigned*)(Abase + (size_t)(kb) + (vo)[h][_i]), (LAS unsigned*)(lds + (bufoff) + ldsw + _i * 8192), 16, 0, 0); } while (0)
#define PG8_LDA(dst, b, h) do { _Pragma("unroll") for (int m = 0; m < 4; ++m) { if constexpr (Prob::FP8) dst##8[m] = cat8(*(const LAS bf16x8*)(lds + PG8_SA(b, h) + aoff + m * 2048), *(const LAS bf16x8*)(lds + PG8_SA(b, h) + aoff + m * 2048 + 1024)); \
        else { _Pragma("unroll") for (int k = 0; k < 2; ++k) dst[m][k] = *(const LAS bf16x8*)(lds + PG8_SA(b, h) + aoff + m * 2048 + k * 1024); } } } while (0)
#define PG8_LDB(dst, b, h) do { _Pragma("unroll") for (int n = 0; n < 2; ++n) { if constexpr (Prob::FP8) dst##8[n] = cat8(*(const LAS bf16x8*)(lds + PG8_SB(b, h) + boff + n * 2048), *(const LAS bf16x8*)(lds + PG8_SB(b, h) + boff + n * 2048 + 1024)); \
        else { _Pragma("unroll") for (int k = 0; k < 2; ++k) dst[n][k] = *(const LAS bf16x8*)(lds + PG8_SB(b, h) + boff + n * 2048 + k * 1024); } } } while (0)
#define PG8_MMA(ai, bj, At, Bt) do { __builtin_amdgcn_s_setprio(1); _Pragma("unroll") for (int m = 0; m < 4; ++m) _Pragma("unroll") for (int n = 0; n < 2; ++n) { \
        if constexpr (Prob::FP8) asm volatile("v_mfma_scale_f32_16x16x128_f8f6f4 %0, %1, %2, %0, %3, %4 op_sel_hi:[0,0,0]" : "+v"(acc[ai][bj][m][n]) : "v"(Bt##8[n]), "v"(At##8[m]), "v"(scl_b), "v"(scl_a)); \
        else { _Pragma("unroll") for (int k = 0; k < 2; ++k) acc[ai][bj][m][n] = __builtin_amdgcn_mfma_f32_16x16x32_bf16(Bt[n][k], At[m][k], acc[ai][bj][m][n], 0, 0, 0); } } \
        __builtin_amdgcn_s_setprio(0); } while (0)
#define PG8_WAIT_V(n) asm volatile("s_waitcnt vmcnt(" #n ")" ::: "memory")
#define PG8_WAIT_L(n) asm volatile("s_waitcnt lgkmcnt(" #n ")" ::: "memory")
#define PG8_BAR __builtin_amdgcn_s_barrier()
#define PG8_SCHED __builtin_amdgcn_sched_barrier(0)
    Unit cur, nxt; int ui = 0;
    if (!P.next(0, cur)) return;
    f32x4 acc[2][2][4][2];
#pragma unroll
    for (int a = 0; a < 2; ++a)
#pragma unroll
        for (int b = 0; b < 2; ++b)
#pragma unroll
            for (int m = 0; m < 4; ++m)
#pragma unroll
                for (int n = 0; n < 2; ++n) acc[a][b][m][n] = (f32x4){0.f, 0.f, 0.f, 0.f};
    bf16x8 At[4][2], B0[2][2], B1[2][2]; v8i_t At8[4], B08[2], B18[2];
    unsigned cvo[2][2], nvo[2][2];
#pragma unroll
    for (int h = 0; h < 2; ++h)
#pragma unroll
        for (int i = 0; i < 2; ++i) cvo[h][i] = P.a_off(cur, h * HALF + RA[i]) + (unsigned)CA[i] * 2u;
    const char* cB = P.b_ptr(cur);
    const size_t kstep = (size_t)(BK * 2);
    PG8_STAGEB(PG8_SB(0, 0), cB); PG8_STAGEB(PG8_SB(0, 1), cB + hstepB); PG8_STAGEA(PG8_SA(0, 0), cvo, 0, 0); PG8_STAGEA(PG8_SA(0, 1), cvo, 1, 0);
    if (wr == 1) PG8_BAR;
    PG8_WAIT_V(2); PG8_BAR;
    PG8_STAGEB(PG8_SB(1, 0), cB + kstep); PG8_STAGEA(PG8_SA(1, 0), cvo, 0, kstep); PG8_STAGEB(PG8_SB(1, 1), cB + hstepB + kstep);
    PG8_WAIT_V(6); PG8_BAR;
    for (;;) {
        const bool has_next = P.next(ui + 1, nxt);
        const char* nB = cB;
#pragma unroll
        for (int h = 0; h < 2; ++h)
#pragma unroll
            for (int i = 0; i < 2; ++i) nvo[h][i] = cvo[h][i];
        if (has_next) { nB = P.b_ptr(nxt);
#pragma unroll
            for (int h = 0; h < 2; ++h)
#pragma unroll
                for (int i = 0; i < 2; ++i) nvo[h][i] = P.a_off(nxt, h * HALF + RA[i]) + (unsigned)CA[i] * 2u; }
        for (int t = 0; t < nt; t += 2) {
            const bool last = (t == nt - 2);
            const size_t k1 = (size_t)(t + 1) * kstep;
            const size_t k2 = last ? 0 : (size_t)(t + 2) * kstep, k3 = k2 + kstep;
            unsigned vo2[2][2];
#pragma unroll
            for (int h = 0; h < 2; ++h)
#pragma unroll
                for (int i = 0; i < 2; ++i) vo2[h][i] = last ? nvo[h][i] : cvo[h][i];
            const char* b2 = (last ? nB : cB) + k2; const char* b3 = b2 + kstep;
            PG8_LDB(B0, 0, 0); PG8_LDB(B1, 0, 1); PG8_SCHED; PG8_LDA(At, 0, 0); PG8_STAGEA(PG8_SA(1, 1), cvo, 1, k1);
            PG8_WAIT_V(8); PG8_WAIT_L(0); PG8_BAR; PG8_MMA(0, 0, At, B0); PG8_MMA(0, 1, At, B1); PG8_BAR; PG8_SCHED;
            PG8_LDA(At, 0, 1); PG8_STAGEB(PG8_SB(0, 0), b2); PG8_STAGEB(PG8_SB(0, 1), b2 + hstepB); PG8_STAGEA(PG8_SA(0, 0), vo2, 0, k2);
            PG8_WAIT_V(8); PG8_WAIT_L(0); PG8_BAR; PG8_MMA(1, 0, At, B0); PG8_MMA(1, 1, At, B1); PG8_BAR; PG8_SCHED;
            PG8_LDB(B0, 1, 0); PG8_LDB(B1, 1, 1); PG8_SCHED; PG8_LDA(At, 1, 0); PG8_STAGEA(PG8_SA(0, 1), vo2, 1, k2);
            PG8_WAIT_V(8); PG8_WAIT_L(0); PG8_BAR; PG8_MMA(0, 0, At, B0); PG8_MMA(0, 1, At, B1); PG8_BAR; PG8_SCHED;
            PG8_LDA(At, 1, 1); PG8_STAGEB(PG8_SB(1, 0), b3); PG8_STAGEB(PG8_SB(1, 1), b3 + hstepB); PG8_STAGEA(PG8_SA(1, 0), vo2, 0, k3);
            PG8_WAIT_V(8); PG8_WAIT_L(0); PG8_BAR; PG8_MMA(1, 0, At, B0); PG8_MMA(1, 1, At, B1); PG8_BAR; PG8_SCHED;
        }
        if (wr == 0) PG8_BAR;
        if constexpr (Prob::FP8) asm volatile("s_nop 15\n\ts_nop 15" ::: "memory");
        if constexpr (Epi::STAGED) E.staged(acc, P, cur, wr, wc, fr, fq, lds + STAGE_BYTES, tid);
        else { E(acc, P, cur, wr, wc, fr, fq); if (MK_EPI2) { asm volatile("" ::: "memory"); E(acc, P, cur, wr, wc, fr, fq); } }
        if (!has_next) break;
#pragma unroll
        for (int a = 0; a < 2; ++a)
#pragma unroll
            for (int b = 0; b < 2; ++b)
#pragma unroll
                for (int m = 0; m < 4; ++m)
#pragma unroll
                    for (int n = 0; n < 2; ++n) acc[a][b][m][n] = (f32x4){0.f, 0.f, 0.f, 0.f};
        cur = nxt; cB = nB; ++ui;
#pragma unroll
        for (int h = 0; h < 2; ++h)
#pragma unroll
            for (int i = 0; i < 2; ++i) cvo[h][i] = nvo[h][i];
        if (wr == 1) PG8_BAR;
    }
    PG8_WAIT_V(0);
    PG8_BAR;
#undef PG8_SA
#undef PG8_SB
#undef PG8_STAGEA
#undef PG8_STAGEB
#undef PG8_LDA
#undef PG8_LDB
#undef PG8_MMA
#undef PG8_WAIT_V
#undef PG8_WAIT_L
#undef PG8_BAR
#undef PG8_SCHED
}

struct DenseProb {
    static constexpr bool FP8 = false; static constexpr int sa = 127, sb = 127;
    const bf16_t* Abase; const bf16_t* Bt; int K, lda, ldb; Order ord;
    __device__ __forceinline__ bool next(int i, Unit& u) const { return ord.next(i, u); }
    __device__ __forceinline__ unsigned a_off(const Unit& u, int r) const { return (unsigned)((size_t)(u.pm * BM + r) * lda * 2); }
    __device__ __forceinline__ const char* b_ptr(const Unit& u) const { return (const char*)Bt + (size_t)u.pn * BM * ldb * 2; }
    __device__ __forceinline__ int orow0(const Unit& u) const { return u.pm * BM; }
};
template <int SA, int SB> struct DenseProb8 {
    static constexpr bool FP8 = true; static constexpr int sa = SA, sb = SB;
    const unsigned char* Abase; const unsigned char* Bt; int K, ldb; int lda; Order ord;
    __device__ __forceinline__ bool next(int i, Unit& u) const { return ord.next(i, u); }
    __device__ __forceinline__ unsigned a_off(const Unit& u, int r) const { return (unsigned)((size_t)(u.pm * BM + r) * lda); }
    __device__ __forceinline__ const char* b_ptr(const Unit& u) const { return (const char*)Bt + (size_t)u.pn * BM * ldb * 2; }
    __device__ __forceinline__ int orow0(const Unit& u) const { return u.pm * BM; }
};
struct MoeTiles { unsigned long long tp8; unsigned long long c4a, c4b; int nt; };
__device__ __forceinline__ int moe_tp(const MoeTiles& T, int e) { return (int)((T.tp8 >> (8 * e)) & 0xffull); }
__device__ __forceinline__ int moe_cnt(const MoeTiles& T, int e) { const unsigned long long w = (e < 4) ? T.c4a : T.c4b; return (int)((w >> (16 * (e & 3))) & 0xffffull); }
__device__ __forceinline__ int moe_expert(const MoeTiles& T, int pm) { int e = 0;
#pragma unroll
    for (int j = 1; j < 8; ++j) e += (pm >= (int)((T.tp8 >> (8 * j)) & 0xffull)) ? 1 : 0;
    return e; }
struct MoeGuProb {
    static constexpr bool FP8 = true; static constexpr int sa = 125, sb = 121;
    const unsigned char* Abase; const unsigned char* Bt; int K, ldb; Order ord; MoeTiles T; const int* rowtok;
    __device__ __forceinline__ bool next(int i, Unit& u) const { return ord.next(i, u); }
    __device__ __forceinline__ unsigned a_off(const Unit& u, int r) const {
        const int e = moe_expert(T, u.pm); const int idx = (u.pm - moe_tp(T, e)) * BM + r; const int cm1 = moe_cnt(T, e) - 1;
        const int tok = rowtok[e * CAPE + (idx < cm1 ? idx : cm1)];
        return (unsigned)tok * (unsigned)D; }
    __device__ __forceinline__ const char* b_ptr(const Unit& u) const { const int e = moe_expert(T, u.pm); return (const char*)Bt + ((size_t)e * N_GU1 + (size_t)u.pn * BM) * D; }
    __device__ __forceinline__ int orow0(const Unit& u) const { return u.pm * BM; }
};
struct MoeDnProb {
    static constexpr bool FP8 = true; static constexpr int sa = 124, sb = 121;
    const unsigned char* Abase; const unsigned char* Bt; int K, ldb; Order ord; MoeTiles T;
    __device__ __forceinline__ bool next(int i, Unit& u) const { return ord.next(i, u); }
    __device__ __forceinline__ unsigned a_off(const Unit& u, int r) const { return (unsigned)((size_t)(u.pm * BM + r) * EXD); }
    __device__ __forceinline__ const char* b_ptr(const Unit& u) const { const int e = moe_expert(T, u.pm); return (const char*)Bt + ((size_t)e * D + (size_t)u.pn * BM) * EXD; }
    __device__ __forceinline__ int orow0(const Unit& u) const { return u.pm * BM; }
};

struct EpiF32 { static constexpr bool PERM = false; static constexpr bool STAGED = false; float* C; int ldc;
    template <class Prob> __device__ __forceinline__ void operator()(const f32x4 (&acc)[2][2][4][2], const Prob& P, const Unit& u, int wr, int wc, int fr, int fq) const {
        const int row0 = P.orow0(u) + wr * 64 + fr, col0 = u.pn * BM + wc * 32 + 4 * fq;
#pragma unroll
        for (int ai = 0; ai < 2; ++ai)
#pragma unroll
            for (int m = 0; m < 4; ++m) { float* rowp = C + (size_t)(row0 + ai * HALF + m * 16) * ldc + col0;
#pragma unroll
                for (int bj = 0; bj < 2; ++bj)
#pragma unroll
                    for (int n = 0; n < 2; ++n) *(f32x4*)(rowp + bj * HALF + n * 16) = acc[ai][bj][m][n]; }
    }
};
struct EpiBf16 { static constexpr bool PERM = true; static constexpr bool STAGED = false; bf16_t* O; int ldc; const float* rowscale;
    template <class Prob> __device__ __forceinline__ void operator()(const f32x4 (&acc)[2][2][4][2], const Prob& P, const Unit& u, int wr, int wc, int fr, int fq) const {
        const int row0 = P.orow0(u) + wr * 64 + fr, col0 = u.pn * BM + wc * 32 + 8 * fq;
#pragma unroll
        for (int ai = 0; ai < 2; ++ai)
#pragma unroll
            for (int m = 0; m < 4; ++m) { const int row = row0 + ai * HALF + m * 16; bf16_t* rowp = O + (size_t)row * ldc + col0; const float rs = rowscale ? rowscale[row] : 1.0f;
#pragma unroll
                for (int bj = 0; bj < 2; ++bj) { const f32x4 v0 = acc[ai][bj][m][0] * rs, v1 = acc[ai][bj][m][1] * rs;
                    u32x4 w; w.x = cvtpk(v0[0], v0[1]); w.y = cvtpk(v0[2], v0[3]); w.z = cvtpk(v1[0], v1[1]); w.w = cvtpk(v1[2], v1[3]);
                    *(u32x4*)(rowp + bj * HALF) = w; } }
    }
};
struct EpiIn1 { static constexpr bool PERM = true; static constexpr bool STAGED = false; bf16_t* QK; bf16_t* V; bf16_t* G; bf16_t* RRp;
    template <class Prob> __device__ __forceinline__ void operator()(const f32x4 (&acc)[2][2][4][2], const Prob& P, const Unit& u, int wr, int wc, int fr, int fq) const {
        const int t = u.pn >> 2; bf16_t* base = (t == 0) ? QK : (t == 1) ? V : (t == 2) ? G : RRp; const int ldc = (t == 3) ? 256 : 1024;
        const int row0 = P.orow0(u) + wr * 64 + fr, col0 = (u.pn & 3) * BM + wc * 32 + 8 * fq;
#pragma unroll
        for (int ai = 0; ai < 2; ++ai)
#pragma unroll
            for (int m = 0; m < 4; ++m) { const int row = row0 + ai * HALF + m * 16; bf16_t* rowp = base + (size_t)row * ldc + col0;
#pragma unroll
                for (int bj = 0; bj < 2; ++bj) { const f32x4 v0 = acc[ai][bj][m][0], v1 = acc[ai][bj][m][1];
                    u32x4 w; w.x = cvtpk(v0[0], v0[1]); w.y = cvtpk(v0[2], v0[3]); w.z = cvtpk(v1[0], v1[1]); w.w = cvtpk(v1[2], v1[3]);
                    *(u32x4*)(rowp + bj * HALF) = w; } }
    }
};
struct EpiQA { static constexpr bool PERM = true; static constexpr bool STAGED = false; bf16_t* O; const float* rstd; const float* tab16; float qscale;
    template <class Prob> __device__ __forceinline__ void operator()(const f32x4 (&acc)[2][2][4][2], const Prob& P, const Unit& u, int wr, int wc, int fr, int fq) const {
        const int row0 = P.orow0(u) + wr * 64 + fr, col0 = u.pn * BM + wc * 32 + 8 * fq;
        const bool ropet = (u.pn == 2);
#pragma unroll
        for (int ai = 0; ai < 2; ++ai)
#pragma unroll
            for (int m = 0; m < 4; ++m) { const int row = row0 + ai * HALF + m * 16; bf16_t* rowp = O + (size_t)row * N_QA + col0; const float rs = rstd[row] * qscale;
                f32x4 cs0 = {1.f, 1.f, 1.f, 1.f}, sn0 = {0.f, 0.f, 0.f, 0.f};
                if (ropet && row < RL) { const int tt = row & (SEQ - 1); const int pos = (fq >> 1) ? (tt & 63) : (tt >> 6); const int i0 = 4 * (fq & 1);
                    cs0 = *(const f32x4*)(tab16 + pos * 8 + i0); sn0 = *(const f32x4*)(tab16 + 512 + pos * 8 + i0); }
#pragma unroll
                for (int bj = 0; bj < 2; ++bj) { f32x4 v0 = acc[ai][bj][m][0] * rs, v1 = acc[ai][bj][m][1] * rs;
                    if (ropet) {
                        const f32x4 a = v0, b = v1;
                        v0[0] = a[0] * cs0[0] - a[1] * sn0[0]; v0[1] = a[1] * cs0[0] + a[0] * sn0[0];
                        v0[2] = a[2] * cs0[1] - a[3] * sn0[1]; v0[3] = a[3] * cs0[1] + a[2] * sn0[1];
                        v1[0] = b[0] * cs0[2] - b[1] * sn0[2]; v1[1] = b[1] * cs0[2] + b[0] * sn0[2];
                        v1[2] = b[2] * cs0[3] - b[3] * sn0[3]; v1[3] = b[3] * cs0[3] + b[2] * sn0[3]; }
                    u32x4 w; w.x = cvtpk(v0[0], v0[1]); w.y = cvtpk(v0[2], v0[3]); w.z = cvtpk(v1[0], v1[1]); w.w = cvtpk(v1[2], v1[3]);
                    *(u32x4*)(rowp + bj * HALF) = w; } }
    }
};
struct EpiSwiglu { static constexpr bool PERM = false; static constexpr bool STAGED = false; bf16_t* Hh; int ldh;
    template <class Prob> __device__ __forceinline__ void operator()(const f32x4 (&acc)[2][2][4][2], const Prob& P, const Unit& u, int wr, int wc, int fr, int fq) const {
        const int row0 = P.orow0(u) + wr * 64 + fr, col0 = (u.pn * BM + wc * 32) / 2 + 4 * fq;
#pragma unroll
        for (int ai = 0; ai < 2; ++ai)
#pragma unroll
            for (int m = 0; m < 4; ++m) { bf16_t* rowp = Hh + (size_t)(row0 + ai * HALF + m * 16) * ldh + col0;
#pragma unroll
                for (int bj = 0; bj < 2; ++bj) { const f32x4 g = acc[ai][bj][m][0], up = acc[ai][bj][m][1];
                    u32x2 w; w.x = cvtpk(swiglu_f(g[0], up[0], -1.4426950408889634f), swiglu_f(g[1], up[1], -1.4426950408889634f)); w.y = cvtpk(swiglu_f(g[2], up[2], -1.4426950408889634f), swiglu_f(g[3], up[3], -1.4426950408889634f));
                    *(u32x2*)(rowp + bj * (HALF / 2)) = w; } }
    }
};
struct EpiSwiglu8 { static constexpr bool PERM = false; static constexpr bool STAGED = true; unsigned char* Hh; int ldh;
    template <class Prob> __device__ __forceinline__ void staged(const f32x4 (&acc)[2][2][4][2], const Prob& P, const Unit& u, int wr, int wc, int fr, int fq, LAS unsigned char* stg, int tid) const {
        LAS unsigned char* sg = stg + wr * 8192;
        const int t = tid & 255;
        unsigned char* gbase = Hh + (size_t)(P.orow0(u) + wr * 64) * ldh + (size_t)u.pn * 128;
#pragma unroll
        for (int ai = 0; ai < 2; ++ai) {
#pragma unroll
            for (int m = 0; m < 4; ++m) { const int row = m * 16 + fr;
#pragma unroll
                for (int bj = 0; bj < 2; ++bj) { const f32x4 g = acc[ai][bj][m][0], up = acc[ai][bj][m][1]; const int p = bj * 4 + wc;
                    *(LAS unsigned*)(sg + row * 128 + ((p ^ (row & 7)) << 4) + 4 * fq) = pack_fp8x4(swiglu_f(g[0], up[0], -0.18033688011112042f), swiglu_f(g[1], up[1], -0.18033688011112042f), swiglu_f(g[2], up[2], -0.18033688011112042f), swiglu_f(g[3], up[3], -0.18033688011112042f)); } }
            asm volatile("s_waitcnt lgkmcnt(0)" ::: "memory"); __builtin_amdgcn_s_barrier(); asm volatile("" ::: "memory");
#pragma unroll
            for (int j = 0; j < 2; ++j) { const int row = (t >> 3) + 32 * j, p = t & 7;
                const u32x4 v = *(const LAS u32x4*)(sg + row * 128 + ((p ^ (row & 7)) << 4));
                *(u32x4*)(gbase + (size_t)(ai * HALF + row) * ldh + p * 16) = v; }
            if (ai == 0) { asm volatile("s_waitcnt lgkmcnt(0)" ::: "memory"); __builtin_amdgcn_s_barrier(); asm volatile("" ::: "memory"); }
        }
    }
};
}

struct Frame {
    LAS unsigned char* lds;
    unsigned char* ws;
    int tid, lane, wave, vcu, G;
};
template <class T> __device__ __forceinline__ T* wsp(const Frame& F, size_t off) { return (T*)(F.ws + off); }

__device__ __forceinline__ void load_row(const float* p, int lane, f32x4 (&v)[4]) {
    const f32x4* r = (const f32x4*)p + lane;
#pragma unroll
    for (int j = 0; j < 4; ++j) v[j] = r[64 * j];
}
__device__ __forceinline__ void load_row_bf16(const bf16_t* p, int lane, f32x4 (&v)[4]) {
#pragma unroll
    for (int j = 0; j < 4; ++j) { const u32x2 w = *(const u32x2*)(p + 4 * lane + 256 * j); v[j][0] = bflo(w.x); v[j][1] = bfhi(w.x); v[j][2] = bflo(w.y); v[j][3] = bfhi(w.y); }
}
__device__ __forceinline__ float row_ssq(const f32x4 (&v)[4]) { float s = 0.f;
#pragma unroll
    for (int j = 0; j < 4; ++j) s += (v[j][0] * v[j][0] + v[j][1] * v[j][1]) + (v[j][2] * v[j][2] + v[j][3] * v[j][3]);
    return wave_sum(s); }
__device__ __forceinline__ void norm_mod_store(const f32x4 (&h)[4], const float* g, const float* sh, const float* sc, bf16_t* urow, int lane, f32x4 (&uo)[4], unsigned char* u8row = nullptr) {
    const float rstd = __builtin_amdgcn_rsqf(row_ssq(h) * (1.0f / D) + EPS);
#pragma unroll
    for (int j = 0; j < 4; ++j) { const int c = 4 * lane + 256 * j; const f32x4 gg = *(const f32x4*)(g + c), s1 = *(const f32x4*)(sc + c), s0 = *(const f32x4*)(sh + c);
        const f32x4 uu = (h[j] * rstd * gg) * (1.0f + s1) + s0; uo[j] = uu;
        if (u8row) *(unsigned*)(u8row + c) = pack_fp8x4(4.0f * uu[0], 4.0f * uu[1], 4.0f * uu[2], 4.0f * uu[3]);
        else { u32x2 w; w.x = cvtpk(uu[0], uu[1]); w.y = cvtpk(uu[2], uu[3]); *(u32x2*)(urow + c) = w; } }
}
__device__ __forceinline__ int row_bidx(int row) { return row < RL ? (row >> 12) : 4; }

__device__ __forceinline__ void glds16(const void* gsrc, unsigned lds_dst) { unsigned keep;
    asm volatile("s_mov_b32 %0, m0\n\ts_mov_b32 m0, %2\n\ts_nop 0\n\tglobal_load_lds_dwordx4 %1, off\n\ts_mov_b32 m0, %0" : "=&s"(keep) : "v"(gsrc), "s"(lds_dst) : "memory"); }
__device__ __forceinline__ float max3f(float a, float b, float c) { float r; asm("v_max3_f32 %0, %1, %2, %3" : "=v"(r) : "v"(a), "v"(b), "v"(c)); return r; }
#define WAIT_BAR(N) asm volatile("s_waitcnt vmcnt(" #N ") lgkmcnt(0)\n\ts_barrier" ::: "memory")
template <int DQK> struct AttnSrc {
    const bf16_t* Q; int qpitch; const bf16_t* Qr;
    const bf16_t* Kn; int kpitch; const bf16_t* Kr; int krpitch;
    const bf16_t* V; int vpitch;
    bf16_t* O; int opitch;
};
__device__ __forceinline__ s16x4 vtr(const LAS unsigned char* p) { typedef short v4i16_t __attribute__((ext_vector_type(4))); return __builtin_bit_cast(s16x4, __builtin_amdgcn_ds_read_tr16_b64_v4i16((LAS v4i16_t*)p)); }
__device__ __forceinline__ int attn_krow(int kt, int lat0, int ctx0) { return kt < 64 ? lat0 + kt * 64 : ctx0 + (kt - 64) * 64; }
template <int DQK>
__device__ __forceinline__ void attn_unit(const Frame& F, const AttnSrc<DQK>& S, int q0, int lat0, int ctx0, int kt0, int kt1) {
    constexpr int NKS = DQK / 16, KB = DQK * 128, SLOT = KB + 8192;
    constexpr float THR = 8.0f;
    const int lane = F.lane, wid = F.wave, r32 = lane & 31, hi = lane >> 5;
    LAS unsigned char* lds = F.lds;
    constexpr bool QLDS = false;
    bf16x8 qf[QLDS ? 1 : NKS];
    LAS unsigned char* qfl = lds + 4 * SLOT + wid * (NKS * 1024) + lane * 16;
    { const bf16_t* qrow = S.Q + (size_t)(q0 + wid * 32 + r32) * S.qpitch;
#pragma unroll
      for (int ks = 0; ks < 4; ++ks) { const bf16x8 v = *(const bf16x8*)(qrow + ks * 16 + hi * 8); if (QLDS) *(LAS bf16x8*)(qfl + ks * 1024) = v; else qf[ks] = v; }
      if (DQK == 96) { const bf16_t* qr = S.Qr + (size_t)(q0 + wid * 32 + r32) * S.qpitch;
#pragma unroll
          for (int ks = 4; ks < NKS; ++ks) { const bf16x8 v = *(const bf16x8*)(qr + (ks - 4) * 16 + hi * 8); if (QLDS) *(LAS bf16x8*)(qfl + ks * 1024) = v; else qf[ks] = v; } } }
    const unsigned lds0 = (unsigned)(size_t)lds;
    auto dma = [&](int kt, int slot) {
        const int krow = attn_krow(kt, lat0, ctx0);
        const unsigned sb = lds0 + slot * SLOT;
        glds16(S.Kn + (size_t)(krow + lane) * S.kpitch + wid * 8, (unsigned)__builtin_amdgcn_readfirstlane(sb + wid * 1024));
        if (DQK == 96 && wid < 4) glds16(S.Kr + (size_t)(krow + lane) * S.krpitch + wid * 8, (unsigned)__builtin_amdgcn_readfirstlane(sb + (8 + wid) * 1024));
        glds16(S.V + (size_t)(krow + 16 * (wid & 3) + (lane >> 2)) * S.vpitch + (wid >> 2) * 32 + (lane & 3) * 8, (unsigned)__builtin_amdgcn_readfirstlane(sb + KB + wid * 1024));
    };
    auto wait_bar = [&](bool inflight) {
        if (!inflight) { WAIT_BAR(0); } else if (DQK == 96 && wid < 4) { WAIT_BAR(3); } else { WAIT_BAR(2); }
    };
    f32x16 oT[2]; f32x16 negm;
#pragma unroll
    for (int r = 0; r < 16; ++r) { oT[0][r] = 0.f; oT[1][r] = 0.f; negm[r] = 0.f; }
    float mrun = 0.f, lrun = 0.f;
    const int vlane = ((lane >> 4) & 1) * 32 + (lane & 3) * 8 + (4 * hi + ((lane & 15) >> 2)) * 64;
    auto qk = [&](int slot, f32x16& p0, f32x16& p1) {
        const LAS unsigned char* kb = lds + slot * SLOT + hi * 1024 + r32 * 16;
        p0 = negm; p1 = negm;
        bf16x8 ka = *(const LAS bf16x8*)(kb), kc = *(const LAS bf16x8*)(kb + 512);
#pragma unroll
        for (int ks = 0; ks < NKS; ++ks) {
            bf16x8 na = ka, nc = kc;
            if (ks + 1 < NKS) { na = *(const LAS bf16x8*)(kb + (ks + 1) * 2048); nc = *(const LAS bf16x8*)(kb + (ks + 1) * 2048 + 512); }
            const bf16x8 qv = QLDS ? *(const LAS bf16x8*)(qfl + ks * 1024) : qf[QLDS ? 0 : ks];
            p0 = __builtin_amdgcn_mfma_f32_32x32x16_bf16(ka, qv, p0, 0, 0, 0);
            p1 = __builtin_amdgcn_mfma_f32_32x32x16_bf16(kc, qv, p1, 0, 0, 0);
            ka = na; kc = nc;
        }
    };
    auto tilemax = [&](f32x16& p0, f32x16& p1) -> float {
        asm volatile("s_nop 15\n\ts_nop 7" : "+v"(p0), "+v"(p1));
        float a = max3f(p0[0], p0[1], p1[0]), b = max3f(p0[2], p0[3], p1[1]); a = max3f(a, p1[2], p1[3]);
#pragma unroll
        for (int r = 4; r < 16; r += 4) { a = max3f(a, p0[r], p0[r + 1]); b = max3f(b, p0[r + 2], p0[r + 3]); a = max3f(a, p1[r], p1[r + 1]); b = max3f(b, p1[r + 2], p1[r + 3]); }
        float tm = fmaxf(a, b);
        auto rr = __builtin_amdgcn_permlane32_swap(__float_as_uint(tm), __float_as_uint(tm), false, false); return fmaxf(__uint_as_float(rr[0]), __uint_as_float(rr[1]));
    };
    auto smpv = [&](f32x16& p0, f32x16& p1, int slot) -> bool {
        const float tm = tilemax(p0, p1);
        bool moved = false;
        if (__any(tm > THR)) {
            const float dl = fmaxf(tm, 0.f); mrun += dl; const float al = __builtin_amdgcn_exp2f(-dl); lrun *= al;
#pragma unroll
            for (int r = 0; r < 16; ++r) { p0[r] -= dl; p1[r] -= dl; negm[r] = -mrun; oT[0][r] *= al; oT[1][r] *= al; }
            moved = true;
        }
        float rs = 0.f;
#pragma unroll
        for (int r = 0; r < 16; ++r) { p0[r] = __builtin_amdgcn_exp2f(p0[r]); p1[r] = __builtin_amdgcn_exp2f(p1[r]); rs += p0[r] + p1[r]; }
        lrun += rs;
        bf16x8 pf[4];
        { u32x4 w;
          w.x = cvtpk(p0[0], p0[1]); w.y = cvtpk(p0[2], p0[3]); w.z = cvtpk(p0[4], p0[5]); w.w = cvtpk(p0[6], p0[7]); pf[0] = __builtin_bit_cast(bf16x8, w);
          w.x = cvtpk(p0[8], p0[9]); w.y = cvtpk(p0[10], p0[11]); w.z = cvtpk(p0[12], p0[13]); w.w = cvtpk(p0[14], p0[15]); pf[1] = __builtin_bit_cast(bf16x8, w);
          w.x = cvtpk(p1[0], p1[1]); w.y = cvtpk(p1[2], p1[3]); w.z = cvtpk(p1[4], p1[5]); w.w = cvtpk(p1[6], p1[7]); pf[2] = __builtin_bit_cast(bf16x8, w);
          w.x = cvtpk(p1[8], p1[9]); w.y = cvtpk(p1[10], p1[11]); w.z = cvtpk(p1[12], p1[13]); w.w = cvtpk(p1[14], p1[15]); pf[3] = __builtin_bit_cast(bf16x8, w); }
        const LAS unsigned char* vb = lds + slot * SLOT + KB + vlane;
        s16x4 lo = vtr(vb), hh = vtr(vb + 512);
#pragma unroll
        for (int i = 0; i < 8; ++i) {
            const int d0 = i >> 2, ks = i & 3;
            s16x4 nlo = lo, nhh = hh;
            if (i + 1 < 8) { const int o2 = ((i + 1) >> 2) * 4096 + ((i + 1) & 3) * 1024; nlo = vtr(vb + o2); nhh = vtr(vb + o2 + 512); }
            const bf16x8 vf = (bf16x8){lo[0], lo[1], lo[2], lo[3], hh[0], hh[1], hh[2], hh[3]};
            oT[d0] = __builtin_amdgcn_mfma_f32_32x32x16_bf16(vf, pf[ks], oT[d0], 0, 0, 0);
            lo = nlo; hh = nhh;
        }
        return moved;
    };
    dma(kt0, 0); dma(kt0 + 1, 1); dma(kt0 + 2, 2);
    wait_bar(true);
    f32x16 pA0, pA1, pB0, pB1;
    qk(0, pA0, pA1);
    { mrun = tilemax(pA0, pA1);
#pragma unroll
      for (int r = 0; r < 16; ++r) negm[r] = -mrun;
      qk(0, pA0, pA1); }
    int sc = 0;
    for (int kt = kt0; kt < kt1; kt += 2) {
        { const int s1 = (sc + 1) & 3, s3 = (sc + 3) & 3;
          if (kt + 3 < kt1) dma(kt + 3, s3);
          qk(s1, pB0, pB1);
          if (smpv(pA0, pA1, sc)) qk(s1, pB0, pB1);
          wait_bar(kt + 3 < kt1);
          sc = s1; }
        { const int s1 = (sc + 1) & 3, s3 = (sc + 3) & 3;
          if (kt + 4 < kt1) dma(kt + 4, s3);
          if (kt + 2 < kt1) qk(s1, pA0, pA1);
          if (smpv(pB0, pB1, sc) && kt + 2 < kt1) qk(s1, pA0, pA1);
          wait_bar(kt + 4 < kt1);
          sc = s1; }
    }
    { auto rr = __builtin_amdgcn_permlane32_swap(__float_as_uint(lrun), __float_as_uint(lrun), false, false); lrun = __uint_as_float(rr[0]) + __uint_as_float(rr[1]); }
    const float inv = 1.0f / lrun;
    bf16_t* orow = S.O + (size_t)(q0 + wid * 32 + r32) * S.opitch;
#pragma unroll
    for (int d0 = 0; d0 < 2; ++d0)
#pragma unroll
        for (int g = 0; g < 4; ++g) { u32x2 w; w.x = cvtpk(oT[d0][4 * g] * inv, oT[d0][4 * g + 1] * inv); w.y = cvtpk(oT[d0][4 * g + 2] * inv, oT[d0][4 * g + 3] * inv);
            *(u32x2*)(orow + 32 * d0 + 8 * g + 4 * hi) = w; }
}

__device__ __forceinline__ int sig5(int c) { return (c & ~12) | ((c & 8) >> 1) | ((c & 4) << 1); }

__global__ void __launch_bounds__(512, 2) mk_fwd(Args args) {
    extern __shared__ __attribute__((aligned(16))) unsigned char lds_raw[];
    Frame F;
    F.lds = (LAS unsigned char*)lds_raw; F.ws = args.ws;
    F.tid = threadIdx.x; F.lane = F.tid & 63; F.wave = __builtin_amdgcn_readfirstlane(F.tid >> 6);
    F.G = gridDim.x; { const int bx = blockIdx.x; F.vcu = (F.G % 8 == 0) ? (bx % 8) * (F.G / 8) + bx / 8 : bx; }
    volatile LAS unsigned* MISC = (volatile LAS unsigned*)(F.lds + LDSCTL_OFF);
    if (F.tid < 64) MISC[F.tid] = 0u;
    __syncthreads();
    unsigned* ctl = wsp<unsigned>(F, O_CTL);
#if MK_ONE_LAUNCH
    XcdBarrier bar = xcd_barrier_post(ctl + CW_BAR, MISC + 8);
#define GRID_BAR() xcd_barrier(bar)
#else
#define GRID_BAR() do {} while (0)
#endif
    const int lo = args.ph_lo, hi_ph = args.ph_hi;
#define IN(k) (lo <= (k) && (k) < hi_ph)
#define SEAM(k) do { if (IN(k) && IN((k) + 1)) GRID_BAR(); } while (0)
    const int lane = F.lane, wave = F.wave, tid = F.tid;
    const int gw = F.vcu * 8 + wave, NGW = F.G * 8;

    const float* x_in = args.in[I_X]; const float* ctx_in = args.in[I_CTX];
    float* MODV = wsp<float>(F, O_MODV);
    float* TAB16 = wsp<float>(F, O_TAB16); float* TAB32 = wsp<float>(F, O_TAB32);
    float* HC = wsp<float>(F, O_HC);
    bf16_t* U = wsp<bf16_t>(F, O_U);
    float* Y = wsp<float>(F, O_Y);
    const float* normg = args.in[I_NORMG];
#define MV(layer, bidx, k) (MODV + ((size_t)((layer) * 5 + (bidx)) * 6 + (k)) * D)

    if (IN(0)) {
        {
            LAS float* sc = (LAS float*)F.lds;
            LAS float* red = sc + 5 * 1024;
            for (int i = tid; i < 5 * 1024; i += 512) { const int b = i >> 10, k = i & 1023; const float cv = (b < 4) ? args.in[I_C][b * 1024 + k] : args.in[I_CCTX][k]; sc[i] = cv / (1.0f + __expf(-cv)); }
            __syncthreads();
            for (int unit = F.vcu; unit < 192; unit += F.G) {
                const int layer = unit / 96, cb = unit % 96, col = cb * 64 + lane;
                const float* W = args.in[I_MODW] + (size_t)layer * D * 6144 + col;
                float a0 = 0.f, a1 = 0.f, a2 = 0.f, a3 = 0.f, a4 = 0.f;
#pragma unroll 16
                for (int kk = 0; kk < 128; ++kk) { const int k = wave * 128 + kk; const float w = W[(size_t)k * 6144];
                    a0 += sc[k] * w; a1 += sc[1024 + k] * w; a2 += sc[2048 + k] * w; a3 += sc[3072 + k] * w; a4 += sc[4096 + k] * w; }
                red[(wave * 5 + 0) * 64 + lane] = a0; red[(wave * 5 + 1) * 64 + lane] = a1; red[(wave * 5 + 2) * 64 + lane] = a2; red[(wave * 5 + 3) * 64 + lane] = a3; red[(wave * 5 + 4) * 64 + lane] = a4;
                __syncthreads();
                if (tid < 320) { const int b = tid >> 6, cc = tid & 63; float s = 0.f;
#pragma unroll
                    for (int w = 0; w < 8; ++w) s += red[(w * 5 + b) * 64 + cc];
                    MODV[(size_t)(layer * 5 + b) * 6144 + cb * 64 + cc] = s + args.in[I_MODB][layer * 6144 + cb * 64 + cc]; }
                __syncthreads();
            }
        }
        if (blockIdx.x == 0) {
            for (int i = tid; i < 64 * 8; i += 512) { const int pos = i >> 3, f = i & 7; const float fr = powf(10000.0f, -(float)f / 8.0f), a = (float)pos * fr; TAB16[i] = cosf(a); TAB16[512 + i] = sinf(a); }
            for (int i = tid; i < 64 * 16; i += 512) { const int pos = i >> 4, f = i & 15; const float fr = powf(10000.0f, -(float)f / 16.0f), a = (float)pos * fr; TAB32[i] = cosf(a); TAB32[1024 + i] = sinf(a); }
        }
        {
            LAS float* scr = (LAS float*)(F.lds + wave * 16640);
            int base = 0;
            auto run = [&](const Conv& c) { const int n = (c.K / 64) * (c.Ndst / 32); for (int it = gw - base; it < n; it += NGW) { if (it >= 0) conv_item(c, it, scr, lane); }
                base = (base + n) % NGW; };
            auto run64 = [&](const Conv64& c) { conv64_run(c, scr, lane, gw, NGW, base); };
            run64(Conv64{args.in[I_FWG], args.in[I_FWU], FFN, 1024, N_GU0, wsp<bf16_t>(F, O_WGU0), 3, 0, 0, 64.0f, 1});
            run64(Conv64{args.in[I_FWD], nullptr, 1024, FFN, 1024, wsp<bf16_t>(F, O_WD0), 0, 1024, 0, 1.0f, 0});
            run64(Conv64{args.in[I_GWIN], nullptr, 3104, 1024, N_IN1, wsp<bf16_t>(F, O_WIN1), 0, 3104, 512, 0.08838834764831845f, 0});
            run64(Conv64{args.in[I_GWOUT], nullptr, 1024, 1024, 1024, wsp<bf16_t>(F, O_WOUT1), 0, 1024, 0, 1.0f, 0});
            run64(Conv64{args.in[I_AWOUT], nullptr, 1024, 1024, 1024, wsp<bf16_t>(F, O_WOUT0), 0, 1024, 0, 1.0f, 0});
            run(Conv{args.in[I_AWIN], nullptr, 1440, 1024, N_IN0, wsp<bf16_t>(F, O_WIN0), 1, nullptr});
            run(Conv{args.in[I_AWUQ], nullptr, 768, 384, N_QA, wsp<bf16_t>(F, O_WUQ), 2, args.in[I_AQN]});
            run(Conv{args.in[I_AWUKV], nullptr, 1024, 256, N_KVA, wsp<bf16_t>(F, O_WUKV), 0, args.in[I_AKVN]});
        }
    }
    SEAM(0);

    if (IN(1)) {
        for (int row = gw; row < R; row += NGW) {
            const float* hp = row < RL ? x_in + (size_t)row * D : ctx_in + (size_t)(row - RL) * D;
            f32x4 h[4], uo[4]; load_row(hp, lane, h);
            const int b = row_bidx(row);
            norm_mod_store(h, normg + 0 * D, MV(0, b, 0), MV(0, b, 1), U + (size_t)row * D, lane, uo);
        }
    }
    SEAM(1);

    if (IN(2)) {
        pg8::DenseProb P{U, wsp<bf16_t>(F, O_WIN0), 1024, 1024, 1024, {}}; P.ord.init(R / 256, N_IN0 / 256, F.G, (int)blockIdx.x);
        pg8::EpiBf16 E{wsp<bf16_t>(F, O_Z0), N_IN0, nullptr};
        pg8::gemm_phase(F.lds, P, E);
    }
    SEAM(2);

    if (IN(3)) {
        const bf16_t* Z0 = wsp<bf16_t>(F, O_Z0);
        float* RSQ = wsp<float>(F, O_RSTDQ); float* RSKV = wsp<float>(F, O_RSTDKV);
        bf16_t* QB = wsp<bf16_t>(F, O_QB); bf16_t* KBp = wsp<bf16_t>(F, O_KB); bf16_t* KR = wsp<bf16_t>(F, O_KR);
        const float* qkn = args.in[I_AQKN];
        for (int row = gw; row < R; row += NGW) {
            const unsigned* z32 = (const unsigned*)(Z0 + (size_t)row * N_IN0);
            float s = 0.f;
#pragma unroll
            for (int j = 0; j < 3; ++j) { const unsigned w = z32[lane + 64 * j]; const float a = bflo(w), b = bfhi(w); s += a * a + b * b; }
            s = wave_sum(s);
            float s2 = 0.f;
#pragma unroll
            for (int j = 0; j < 2; ++j) { const unsigned w = z32[192 + lane + 64 * j]; const float a = bflo(w), b = bfhi(w); s2 += a * a + b * b; }
            s2 = wave_sum(s2);
            if (lane == 0) { RSQ[row] = __builtin_amdgcn_rsqf(s * (1.0f / 384.0f) + EPS); RSKV[row] = __builtin_amdgcn_rsqf(s2 * (1.0f / 256.0f) + EPS); }
            const bool lat = row < RL; const int tt = row & (SEQ - 1);
#pragma unroll
            for (int which = 0; which < 2; ++which) {
                if (which == 1 && lane >= 16) break;
                const u32x4 w4 = *(const u32x4*)(Z0 + (size_t)row * N_IN0 + (which ? 1152 : 640) + lane * 8);
                float v[8] = {bflo(w4.x), bfhi(w4.x), bflo(w4.y), bfhi(w4.y), bflo(w4.z), bfhi(w4.z), bflo(w4.w), bfhi(w4.w)};
                float ss = 0.f;
#pragma unroll
                for (int j = 0; j < 8; ++j) ss += v[j] * v[j];
                ss += __shfl_xor(ss, 1); ss += __shfl_xor(ss, 2); ss += __shfl_xor(ss, 4);
                const float rstd = __builtin_amdgcn_rsqf(ss * (1.0f / 64.0f) + EPS);
                const int jp = lane & 7, half = jp >> 2, i0 = 4 * (jp & 3);
                const float* gn = qkn + which * 64 + half * 32;
#pragma unroll
                for (int pz = 0; pz < 4; ++pz) { v[2 * pz] *= rstd * gn[i0 + pz]; v[2 * pz + 1] *= rstd * gn[16 + i0 + pz]; }
                if (lat) { const int pos = half ? (tt & 63) : (tt >> 6);
                    const f32x4 cs = *(const f32x4*)(TAB32 + pos * 16 + i0), sn = *(const f32x4*)(TAB32 + 1024 + pos * 16 + i0);
#pragma unroll
                    for (int pz = 0; pz < 4; ++pz) { const float a = v[2 * pz], b = v[2 * pz + 1]; v[2 * pz] = a * cs[pz] - b * sn[pz]; v[2 * pz + 1] = b * cs[pz] + a * sn[pz]; } }
                const float osc = which ? 1.0f : 0.125f * LOG2E;
                u32x4 o; o.x = cvtpk(v[0] * osc, v[1] * osc); o.y = cvtpk(v[2] * osc, v[3] * osc); o.z = cvtpk(v[4] * osc, v[5] * osc); o.w = cvtpk(v[6] * osc, v[7] * osc);
                if (which == 0) *(u32x4*)(QB + (size_t)row * 512 + lane * 8) = o; else *(u32x4*)(KBp + (size_t)row * 128 + lane * 8) = o;
            }
            if (lane < 4) {
                const u32x4 w4 = *(const u32x4*)(Z0 + (size_t)row * N_IN0 + 1408 + lane * 8);
                float v[8] = {bflo(w4.x), bfhi(w4.x), bflo(w4.y), bfhi(w4.y), bflo(w4.z), bfhi(w4.z), bflo(w4.w), bfhi(w4.w)};
                if (lat) { const int half = lane >> 1, i0 = 4 * (lane & 1); const int pos = half ? (tt & 63) : (tt >> 6);
                    const f32x4 cs = *(const f32x4*)(TAB16 + pos * 8 + i0), sn = *(const f32x4*)(TAB16 + 512 + pos * 8 + i0);
#pragma unroll
                    for (int pz = 0; pz < 4; ++pz) { const float a = v[2 * pz], b = v[2 * pz + 1]; v[2 * pz] = a * cs[pz] - b * sn[pz]; v[2 * pz + 1] = b * cs[pz] + a * sn[pz]; } }
                u32x4 o; o.x = cvtpk(v[0], v[1]); o.y = cvtpk(v[2], v[3]); o.z = cvtpk(v[4], v[5]); o.w = cvtpk(v[6], v[7]);
                *(u32x4*)(KR + (size_t)row * 32 + lane * 8) = o;
            }
        }
    }
    SEAM(3);

    if (IN(4)) {
        { pg8::DenseProb P{wsp<bf16_t>(F, O_Z0), wsp<bf16_t>(F, O_WUQ), 384, N_IN0, 384, {}}; P.ord.init(R / 256, N_QA / 256, F.G, (int)blockIdx.x);
          pg8::EpiQA E{wsp<bf16_t>(F, O_QA), wsp<float>(F, O_RSTDQ), TAB16, 0.10206207261596577f * LOG2E};
          pg8::gemm_phase(F.lds, P, E); }
        { pg8::DenseProb P{wsp<bf16_t>(F, O_Z0) + 384, wsp<bf16_t>(F, O_WUKV), 256, N_IN0, 256, {}}; P.ord.init(R / 256, N_KVA / 256, F.G, (int)((blockIdx.x + F.G - (204 % F.G)) % F.G));
          pg8::EpiBf16 E{wsp<bf16_t>(F, O_KVA), N_KVA, wsp<float>(F, O_RSTDKV)};
          pg8::gemm_phase(F.lds, P, E); }
    }
    SEAM(4);

    if (IN(5)) {
        const bf16_t* QA = wsp<bf16_t>(F, O_QA); const bf16_t* KVA = wsp<bf16_t>(F, O_KVA); const bf16_t* QB = wsp<bf16_t>(F, O_QB);
        const bf16_t* KBp = wsp<bf16_t>(F, O_KB); const bf16_t* KR = wsp<bf16_t>(F, O_KR); const bf16_t* Z0 = wsp<bf16_t>(F, O_Z0);
        bf16_t* AO = wsp<bf16_t>(F, O_AO);
        for (int i = 0; i < 3; ++i) {
            int b, hh, q0, kt0, kt1;
            if (i < 2) { const int m = i * 256 + F.vcu; b = m >> 7; hh = (m >> 4) & 7; q0 = b * SEQ + (m & 15) * 256; kt0 = 0; kt1 = 68; }
            else { if (F.vcu >= 32) break; b = (F.vcu >> 3) & 3; hh = F.vcu & 7; q0 = RL + b * CTX; kt0 = 64; kt1 = 68; }
            const int lat0 = b * SEQ, ctx0 = RL + b * CTX;
            AttnSrc<96> S{QA + hh * 64, N_QA, QA + 512 + hh * 32, KVA + hh * 128, N_KVA, KR, 32, KVA + hh * 128 + 64, N_KVA, AO + hh * 64, D};
            attn_unit<96>(F, S, q0, lat0, ctx0, kt0, kt1);
        }
        for (int i = 0; i < 3; ++i) {
            int b, hh, q0, kt0, kt1;
            if (i < 2) { const int m = i * 256 + F.vcu; b = m >> 7; hh = (m >> 4) & 7; q0 = b * SEQ + (m & 15) * 256; kt0 = 0; kt1 = 68; }
            else { if (F.vcu < 32 || F.vcu >= 64) break; b = (F.vcu >> 3) & 3; hh = F.vcu & 7; q0 = RL + b * CTX; kt0 = 64; kt1 = 68; }
            const int lat0 = b * SEQ, ctx0 = RL + b * CTX; const int kvh = hh >> 2;
            AttnSrc<64> S{QB + hh * 64, 512, nullptr, KBp + kvh * 64, 128, nullptr, 0, Z0 + 1280 + kvh * 64, N_IN0, AO + 512 + hh * 64, D};
            attn_unit<64>(F, S, q0, lat0, ctx0, kt0, kt1);
        }
    }
    SEAM(5);

    if (IN(6)) {
        pg8::DenseProb P{wsp<bf16_t>(F, O_AO), wsp<bf16_t>(F, O_WOUT0), 1024, 1024, 1024, {}}; P.ord.init(RL / 256, 4, F.G, (int)blockIdx.x);
        pg8::EpiBf16 E{(bf16_t*)Y, D, nullptr};
        pg8::gemm_phase(F.lds, P, E);
    }
    SEAM(6);


    auto post0 = [&](int row) {
            const float* hp = row < RL ? x_in + (size_t)row * D : ctx_in + (size_t)(row - RL) * D;
            float* ho = row < RL ? args.out + (size_t)row * D : HC + (size_t)(row - RL) * D;
            const int b = row_bidx(row);
            f32x4 y[4], h[4], uo[4]; load_row_bf16((const bf16_t*)Y + (size_t)row * D, lane, y); load_row(hp, lane, h);
            const float rstd = __builtin_amdgcn_rsqf(row_ssq(y) * (1.0f / D) + EPS);
#pragma unroll
            for (int j = 0; j < 4; ++j) { const int c = 4 * lane + 256 * j; const f32x4 g = *(const f32x4*)(normg + 1 * D + c), mg = *(const f32x4*)(MV(0, b, 2) + c);
                h[j] = h[j] + mg * (y[j] * rstd * g); *(f32x4*)(ho + c) = h[j]; }
            norm_mod_store(h, normg + 2 * D, MV(0, b, 3), MV(0, b, 4), nullptr, lane, uo, wsp<unsigned char>(F, O_U) + (size_t)row * D);
    };
    if (IN(7)) {
        const bool split = F.G > 32;
        if (!split || blockIdx.x < 16) {
            pg8::DenseProb P{wsp<bf16_t>(F, O_AO) + (size_t)RL * D, wsp<bf16_t>(F, O_WOUT0), 1024, 1024, 1024, {}}; P.ord.init(RC / 256, 4, split ? 16 : F.G, (int)blockIdx.x);
            pg8::EpiBf16 E{(bf16_t*)Y + (size_t)RL * D, D, nullptr};
            pg8::gemm_phase(F.lds, P, E);
        }
        if (!split) { for (int row = gw; row < RL; row += NGW) post0(row); }
        else if (blockIdx.x >= 16) { for (int row = ((int)blockIdx.x - 16) * 8 + wave; row < RL; row += (F.G - 16) * 8) post0(row); }
    }
    SEAM(7);
    if (IN(8)) { for (int row = RL + gw; row < R; row += NGW) post0(row); }
    SEAM(8);


    if (IN(9)) {
        pg8::DenseProb8<125, 121> P{wsp<unsigned char>(F, O_U), wsp<unsigned char>(F, O_WGU0), 512, 512, 1024, {}}; P.ord.init(R / 256, N_GU0 / 256, F.G, (int)blockIdx.x);
        pg8::EpiSwiglu E{wsp<bf16_t>(F, O_H0), FFN};
        pg8::gemm_phase(F.lds, P, E);
    }
    SEAM(9);
    if (IN(10)) {
        pg8::DenseProb P{wsp<bf16_t>(F, O_H0), wsp<bf16_t>(F, O_WD0), FFN, FFN, FFN, {}}; P.ord.init(RL / 256, 4, F.G, (int)blockIdx.x);
        pg8::EpiBf16 E{(bf16_t*)Y, D, nullptr};
        pg8::gemm_phase(F.lds, P, E);
    }
    SEAM(10);


    auto post1 = [&](int row) {
            float* hp = row < RL ? args.out + (size_t)row * D : HC + (size_t)(row - RL) * D;
            const int b = row_bidx(row);
            f32x4 y[4], h[4], uo[4]; load_row_bf16((const bf16_t*)Y + (size_t)row * D, lane, y); load_row(hp, lane, h);
            const float rstd = __builtin_amdgcn_rsqf(row_ssq(y) * (1.0f / D) + EPS);
#pragma unroll
            for (int j = 0; j < 4; ++j) { const int c = 4 * lane + 256 * j; const f32x4 g = *(const f32x4*)(normg + 3 * D + c), mg = *(const f32x4*)(MV(0, b, 5) + c);
                h[j] = h[j] + mg * (y[j] * rstd * g); *(f32x4*)(hp + c) = h[j]; }
            norm_mod_store(h, normg + 4 * D, MV(1, b, 0), MV(1, b, 1), U + (size_t)row * D, lane, uo);
    };
    if (IN(11)) {
        const bool split = F.G > 32;
        if (!split || blockIdx.x < 16) {
            pg8::DenseProb P{wsp<bf16_t>(F, O_H0) + (size_t)RL * FFN, wsp<bf16_t>(F, O_WD0), FFN, FFN, FFN, {}}; P.ord.init(RC / 256, 4, split ? 16 : F.G, (int)blockIdx.x);
            pg8::EpiBf16 E{(bf16_t*)Y + (size_t)RL * D, D, nullptr};
            pg8::gemm_phase(F.lds, P, E);
        }
        if (!split) { for (int row = gw; row < RL; row += NGW) post1(row); }
        else if (blockIdx.x >= 16) { for (int row = ((int)blockIdx.x - 16) * 8 + wave; row < RL; row += (F.G - 16) * 8) post1(row); }
    }
    SEAM(11);
    if (IN(12)) { for (int row = RL + gw; row < R; row += NGW) post1(row); }
    SEAM(12);


    if (IN(13)) {
        pg8::DenseProb P{U, wsp<bf16_t>(F, O_WIN1), 1024, 1024, 1024, {}}; P.ord.init(R / 256, N_IN1 / 256, F.G, (int)blockIdx.x);
        pg8::EpiIn1 E{wsp<bf16_t>(F, O_QK1), wsp<bf16_t>(F, O_V1), wsp<bf16_t>(F, O_G1), wsp<bf16_t>(F, O_RR)};
        pg8::gemm_phase(F.lds, P, E);
    }
    SEAM(13);

    if (IN(14)) {
        const bf16_t* QK1 = wsp<bf16_t>(F, O_QK1); const bf16_t* V1 = wsp<bf16_t>(F, O_V1); const bf16_t* RRp = wsp<bf16_t>(F, O_RR);
        bf16_t* QDd[2] = {wsp<bf16_t>(F, O_QDF), wsp<bf16_t>(F, O_QDB)}; bf16_t* KId[2] = {wsp<bf16_t>(F, O_KIF), wsp<bf16_t>(F, O_KIB)}; bf16_t* KTd[2] = {wsp<bf16_t>(F, O_KTF), wsp<bf16_t>(F, O_KTB)};
        bf16_t* VT = wsp<bf16_t>(F, O_VT); float* ECL = wsp<float>(F, O_ECL);
        LAS float* tot = (LAS float*)F.lds;
        const int dkp = tid & 63, dk0 = 2 * dkp, tq = tid >> 6;
        int hh_loaded = -1; float w2[2][16][2], bg[2][2];
        for (int item = F.vcu; item < 544 * 4; item += F.G) {
            const int rc = item >> 2, hh = item & 3, row0 = rc * 32;
            if (hh != hh_loaded) {
                hh_loaded = hh;
#pragma unroll
                for (int d = 0; d < 2; ++d) { const f32x2_t bv = *(const f32x2_t*)(args.in[I_GBGATE] + d * 512 + hh * 128 + dk0); bg[d][0] = bv[0]; bg[d][1] = bv[1];
#pragma unroll
                    for (int j = 0; j < 16; ++j) { const f32x2_t wv = *(const f32x2_t*)(args.in[I_GGATE2] + (size_t)(d * 16 + j) * 512 + hh * 128 + dk0); w2[d][j][0] = wv[0]; w2[d][j][1] = wv[1]; } }
            }
            float a[2][4][2];
#pragma unroll
            for (int i = 0; i < 4; ++i) { const int row = row0 + 4 * tq + i;
                const u32x4* rp = (const u32x4*)(RRp + (size_t)row * 256);
#pragma unroll
                for (int d = 0; d < 2; ++d) { const u32x4 r0 = rp[2 * d], r1 = rp[2 * d + 1];
                    const float rv[16] = {bflo(r0.x), bfhi(r0.x), bflo(r0.y), bfhi(r0.y), bflo(r0.z), bfhi(r0.z), bflo(r0.w), bfhi(r0.w), bflo(r1.x), bfhi(r1.x), bflo(r1.y), bfhi(r1.y), bflo(r1.z), bfhi(r1.z), bflo(r1.w), bfhi(r1.w)};
#pragma unroll
                    for (int c = 0; c < 2; ++c) { float z = bg[d][c];
#pragma unroll
                        for (int j = 0; j < 16; ++j) z += rv[j] * w2[d][j][c];
                        a[d][i][c] = (fminf(z, 0.f) - __logf(1.0f + __expf(-fabsf(z)))) * (1.0f / 16.0f); } } }
            float cf[4][2], sb[4][2];
#pragma unroll
            for (int c = 0; c < 2; ++c) { float sfw = 0.f;
#pragma unroll
                for (int i = 0; i < 4; ++i) { sfw += a[0][i][c]; cf[i][c] = sfw; }
                float sbw = 0.f;
#pragma unroll
                for (int i = 3; i >= 0; --i) { sbw += a[1][i][c]; sb[i][c] = sbw; } }
            *(LAS f32x2_t*)(tot + (0 * 8 + tq) * 128 + dk0) = (f32x2_t){cf[3][0], cf[3][1]};
            *(LAS f32x2_t*)(tot + (1 * 8 + tq) * 128 + dk0) = (f32x2_t){sb[0][0], sb[0][1]};
            __syncthreads();
            float offF[2] = {0.f, 0.f}, offB[2] = {0.f, 0.f}, clF[2] = {0.f, 0.f}, clB[2] = {0.f, 0.f};
#pragma unroll
            for (int g = 0; g < 8; ++g) { const f32x2_t tf = *(const LAS f32x2_t*)(tot + (0 * 8 + g) * 128 + dk0), tb = *(const LAS f32x2_t*)(tot + (1 * 8 + g) * 128 + dk0);
#pragma unroll
                for (int c = 0; c < 2; ++c) { clF[c] += tf[c]; clB[c] += tb[c]; if (g < tq) offF[c] += tf[c]; if (g > tq) offB[c] += tb[c]; } }
            __syncthreads();
            const int pc = hh * 128 + (dk0 & ~31) + sig5(dk0 & 31);
#pragma unroll
            for (int i = 0; i < 4; ++i) { const int row = row0 + 4 * tq + i;
                const unsigned qw = *(const unsigned*)(QK1 + (size_t)row * D + hh * 128 + dk0), kw = *(const unsigned*)(QK1 + (size_t)row * D + 512 + hh * 128 + dk0);
                const float q[2] = {bflo(qw), bfhi(qw)}, k[2] = {bflo(kw), bfhi(kw)};
                float qdv[2][2], kiv[2][2];
#pragma unroll
                for (int c = 0; c < 2; ++c) { const float cF = offF[c] + cf[i][c], cB = offB[c] + sb[i][c];
                    qdv[0][c] = q[c] * __expf(cF); kiv[0][c] = k[c] * __expf(-cF); qdv[1][c] = q[c] * __expf(cB); kiv[1][c] = k[c] * __expf(-cB); }
#pragma unroll
                for (int d = 0; d < 2; ++d) {
                    *(unsigned*)(QDd[d] + (size_t)row * 512 + pc) = cvtpk(qdv[d][0], qdv[d][1]);
                    const unsigned kp = cvtpk(kiv[d][0], kiv[d][1]);
                    *(unsigned*)(KId[d] + (size_t)row * 512 + pc) = kp;
                } }
            if (tq == 0) { *(f32x2_t*)(ECL + ((size_t)(rc * 2 + 0) * 4 + hh) * 256 + dk0) = (f32x2_t){__expf(clF[0]), __expf(clF[1])};
                           *(f32x2_t*)(ECL + ((size_t)(rc * 2 + 1) * 4 + hh) * 256 + dk0) = (f32x2_t){__expf(clB[0]), __expf(clB[1])}; }
            { const int dv = tid & 255, th = tid >> 8; unsigned vw[8];
#pragma unroll
              for (int i = 0; i < 16; ++i) { const unsigned bv = V1[(size_t)(row0 + 16 * th + i) * D + hh * 256 + dv];
                  const int cc = sig5(i);
                  if (cc & 1) vw[cc >> 1] |= bv << 16; else vw[cc >> 1] = bv; }
              bf16_t* vp = VT + ((size_t)rc * 1024 + hh * 256 + dv) * 32 + 16 * th;
              u32x4 o0; o0.x = vw[0]; o0.y = vw[1]; o0.z = vw[2]; o0.w = vw[3]; *(u32x4*)vp = o0;
              u32x4 o1; o1.x = vw[4]; o1.y = vw[5]; o1.z = vw[6]; o1.w = vw[7]; *(u32x4*)(vp + 8) = o1; }
        }
    }
    SEAM(14);

    if (IN(15)) {
        const int xl = blockIdx.x & 7, jj = blockIdx.x >> 3;
        const bool scan_role = (jj & 1) == 0;
        const int nscan = ((F.G >> 3) + 1) / 2 * 8, nconv = F.G - nscan;
        if ((F.G & 7) == 0 && nconv > 0 && !scan_role) {
            LAS float* scr = (LAS float*)(F.lds + wave * 16640);
            const int cidx = xl * (F.G >> 4) + (jj >> 1); int base = 0; const int gwi = cidx * 8 + wave, ngw = nconv * 8;
            for (int e = 0; e < NEXP; ++e) {
                conv64_run(Conv64{args.in[I_MWG] + (size_t)e * D * EXD, args.in[I_MWU] + (size_t)e * D * EXD, EXD, 1024, N_GU1, wsp<bf16_t>(F, O_WGU1) + (size_t)e * N_GU1 * 1024 / 2, 3, 0, 0, 64.0f, 1}, scr, lane, gwi, ngw, base);
                conv64_run(Conv64{args.in[I_MWD] + (size_t)e * EXD * D, nullptr, 1024, EXD, 1024, wsp<bf16_t>(F, O_WD1) + (size_t)e * 1024 * EXD / 2, 0, 1024, 1024, 64.0f, 1}, scr, lane, gwi, ngw, base);
            }
        } else {
        const bool split = (F.G & 7) == 0 && nconv > 0;
        const int sidx = split ? xl * ((F.G >> 4) + ((F.G >> 3) & 1)) + (jj >> 1) : F.vcu, nsw = split ? nscan : F.G;
        const bf16_t* VT = wsp<bf16_t>(F, O_VT); const float* ECL = wsp<float>(F, O_ECL);
        constexpr int SLOT = 8192 * 2 + 2 * 2048 + 1024;
        const int r32 = lane & 31, hi = lane >> 5;
        for (int unit = sidx; unit < 128; unit += nsw) {
            const int chain = unit >> 2, dvp = unit & 3, b = chain >> 3, hh = (chain >> 1) & 3, dir = chain & 1;
            const int dvb = dvp * 2 + (wave & 1);
            const bf16_t* QDp = wsp<bf16_t>(F, dir ? O_QDB : O_QDF); const bf16_t* KIp = wsp<bf16_t>(F, dir ? O_KIB : O_KIF);
            bf16_t* Odp = wsp<bf16_t>(F, dir ? O_OB : O_OF);
            auto rcof = [&](int step) { return step < 8 ? 512 + b * 8 + (dir ? 7 - step : step) : b * 128 + (dir ? 127 - (step - 8) : (step - 8)); };
            const unsigned lds0 = (unsigned)(size_t)F.lds;
            auto dma = [&](int step, int slot) {
                if (wave < 2) return;
                const int rc = rcof(step); const unsigned sb = lds0 + slot * SLOT;
#pragma unroll
                for (int i = 0; i < 4; ++i) { const int j = (wave - 2) + 6 * i; if (j >= 21) break;
                    if (j < 16) { const int p = j & 7; const int r = 4 * p + (lane >> 4), c = (lane & 15) ^ (r & 15);
                        glds16((j < 8 ? KIp : QDp) + (size_t)(rc * 32 + r) * 512 + hh * 128 + c * 8, (unsigned)__builtin_amdgcn_readfirstlane(sb + j * 1024)); }
                    else if (j < 20) { const int p = j - 16; const int r = 16 * (p & 1) + (lane >> 2), c = (lane & 3) ^ ((r >> 2) & 3);
                        glds16(VT + ((size_t)rc * 1024 + hh * 256 + (dvp * 2 + (p >> 1)) * 32 + r) * 32 + c * 8, (unsigned)__builtin_amdgcn_readfirstlane(sb + 16384 + p * 1024)); }
                    else glds16(ECL + ((size_t)(rc * 2 + dir) * 4 + hh) * 256 + lane * 4, (unsigned)__builtin_amdgcn_readfirstlane(sb + 20480)); }
            };
            auto wait_bar = [&](int ngrp) { if (wave < 2) { asm volatile("s_waitcnt lgkmcnt(0)\n\ts_barrier" ::: "memory"); }
                else if (ngrp == 0) { WAIT_BAR(0); } else if (ngrp == 1) { if (wave < 5) { WAIT_BAR(4); } else { WAIT_BAR(3); } } else { if (wave < 5) { WAIT_BAR(8); } else { WAIT_BAR(6); } } };
            f32x16 S4[4];
#pragma unroll
            for (int k = 0; k < 4; ++k)
#pragma unroll
                for (int r = 0; r < 16; ++r) S4[k][r] = 0.f;
            dma(0, 0); dma(1, 1); dma(2, 2);
            wait_bar(2);
            int slot = 0;
            for (int step = 0; step < 136; ++step) {
                if (step + 3 < 136) dma(step + 3, (slot + 3) & 3);
                if (wave < 2) {
                    const LAS unsigned char* sb = F.lds + slot * SLOT;
                    const int x15 = r32 & 15, x3 = (r32 >> 2) & 3;
                    const int trq = (lane & 15) >> 2, trp = lane & 3, trpp = ((trp & 1) << 1) | (trp >> 1), trg = (lane >> 4) & 1;
                    const LAS unsigned char* vbase = sb + 16384 + wave * 2048;
                    bf16x8 qdF[8], kiF[8];
#pragma unroll
                    for (int k = 0; k < 8; ++k) { qdF[k] = *(const LAS bf16x8*)(sb + 8192 + r32 * 256 + (((2 * k + hi) ^ x15) << 4)); kiF[k] = *(const LAS bf16x8*)(sb + r32 * 256 + (((2 * k + hi) ^ x15) << 4)); }
                    const bf16x8 vF0 = *(const LAS bf16x8*)(vbase + r32 * 64 + ((hi ^ x3) << 4)), vF1 = *(const LAS bf16x8*)(vbase + r32 * 64 + (((2 + hi) ^ x3) << 4));
                    __builtin_amdgcn_sched_barrier(0);
                    f32x16 o;
#pragma unroll
                    for (int r = 0; r < 16; ++r) o[r] = 0.f;
                    if (step >= 8) {
                        f32x16 sc;
#pragma unroll
                        for (int r = 0; r < 16; ++r) sc[r] = 0.f;
#pragma unroll
                        for (int k = 0; k < 8; ++k) sc = __builtin_amdgcn_mfma_f32_32x32x16_bf16(kiF[k], qdF[k], sc, 0, 0, 0);
#pragma unroll
                        for (int r = 0; r < 16; ++r) { const int s = (r & 3) + 8 * (r >> 2) + 4 * hi; const bool keep = dir ? (s >= r32) : (s <= r32); sc[r] = keep ? sc[r] : 0.f; }
                        u32x4 w; bf16x8 pf0, pf1;
                        w.x = cvtpk(sc[0], sc[1]); w.y = cvtpk(sc[2], sc[3]); w.z = cvtpk(sc[4], sc[5]); w.w = cvtpk(sc[6], sc[7]); pf0 = __builtin_bit_cast(bf16x8, w);
                        w.x = cvtpk(sc[8], sc[9]); w.y = cvtpk(sc[10], sc[11]); w.z = cvtpk(sc[12], sc[13]); w.w = cvtpk(sc[14], sc[15]); pf1 = __builtin_bit_cast(bf16x8, w);
                        o = __builtin_amdgcn_mfma_f32_32x32x16_bf16(vF0, pf0, o, 0, 0, 0);
                        o = __builtin_amdgcn_mfma_f32_32x32x16_bf16(vF1, pf1, o, 0, 0, 0);
#pragma unroll
                        for (int blk = 0; blk < 4; ++blk)
#pragma unroll
                            for (int s2 = 0; s2 < 2; ++s2) { u32x4 ws4; ws4.x = cvtpk(S4[blk][8 * s2], S4[blk][8 * s2 + 1]); ws4.y = cvtpk(S4[blk][8 * s2 + 2], S4[blk][8 * s2 + 3]);
                                ws4.z = cvtpk(S4[blk][8 * s2 + 4], S4[blk][8 * s2 + 5]); ws4.w = cvtpk(S4[blk][8 * s2 + 6], S4[blk][8 * s2 + 7]);
                                o = __builtin_amdgcn_mfma_f32_32x32x16_bf16(__builtin_bit_cast(bf16x8, ws4), qdF[2 * blk + s2], o, 0, 0, 0); }
                        const int rc = rcof(step);
                        bf16_t* op = Odp + (size_t)(rc * 32 + r32) * D + hh * 256 + dvb * 32 + 4 * hi;
#pragma unroll
                        for (int g = 0; g < 4; ++g) { u32x2 w2; w2.x = cvtpk(o[4 * g], o[4 * g + 1]); w2.y = cvtpk(o[4 * g + 2], o[4 * g + 3]); *(u32x2*)(op + 8 * g) = w2; }
                    }
#pragma unroll
                    for (int blk = 0; blk < 4; ++blk) {
                        bf16x8 kt0, kt1;
                        { const int chunk = 4 * blk + 2 * trg + (trpp >> 1); const int wb = (trpp & 1) * 8;
                          const int tl = 4 * hi + trq, th = tl + 8;
                          const LAS unsigned char* pl = sb + tl * 256 + ((chunk ^ tl) << 4) + wb; const LAS unsigned char* ph = sb + th * 256 + ((chunk ^ th) << 4) + wb;
                          const s16x4 a0 = vtr(pl), a1 = vtr(ph), b0 = vtr(pl + 4096), b1 = vtr(ph + 4096);
                          kt0 = (bf16x8){a0[0], a0[1], a0[2], a0[3], a1[0], a1[1], a1[2], a1[3]}; kt1 = (bf16x8){b0[0], b0[1], b0[2], b0[3], b1[0], b1[1], b1[2], b1[3]}; }
                        S4[blk] = __builtin_amdgcn_mfma_f32_32x32x16_bf16(kt0, vF0, S4[blk], 0, 0, 0);
                        S4[blk] = __builtin_amdgcn_mfma_f32_32x32x16_bf16(kt1, vF1, S4[blk], 0, 0, 0);
#pragma unroll
                        for (int g = 0; g < 4; ++g) { const f32x4 e4 = *(const LAS f32x4*)(sb + 20480 + (32 * blk + 8 * g + 4 * hi) * 4);
                            S4[blk][4 * g] *= e4[0]; S4[blk][4 * g + 1] *= e4[1]; S4[blk][4 * g + 2] *= e4[2]; S4[blk][4 * g + 3] *= e4[3]; }
                    }
                }
                wait_bar(step + 3 < 136 ? 2 : (step + 2 < 136 ? 1 : 0));
                slot = (slot + 1) & 3;
            }
        }
        if (!split) {
            LAS float* scr = (LAS float*)(F.lds + wave * 16640); int base = 0;
            for (int e = 0; e < NEXP; ++e) {
                conv64_run(Conv64{args.in[I_MWG] + (size_t)e * D * EXD, args.in[I_MWU] + (size_t)e * D * EXD, EXD, 1024, N_GU1, wsp<bf16_t>(F, O_WGU1) + (size_t)e * N_GU1 * 1024 / 2, 3, 0, 0, 64.0f, 1}, scr, lane, gw, NGW, base);
                conv64_run(Conv64{args.in[I_MWD] + (size_t)e * EXD * D, nullptr, 1024, EXD, 1024, wsp<bf16_t>(F, O_WD1) + (size_t)e * 1024 * EXD / 2, 0, 1024, 1024, 64.0f, 1}, scr, lane, gw, NGW, base);
            }
        }
        }
    }
    SEAM(15);

    if (IN(16)) {
        const bf16_t* OFp = wsp<bf16_t>(F, O_OF); const bf16_t* OBp = wsp<bf16_t>(F, O_OB); const bf16_t* G1 = wsp<bf16_t>(F, O_G1); bf16_t* GA = wsp<bf16_t>(F, O_GA);
        const float* on = args.in[I_GONORM];
        for (int row = gw; row < RL; row += NGW) {
            const u32x4* pf = (const u32x4*)(OFp + (size_t)row * D + lane * 16); const u32x4* pb = (const u32x4*)(OBp + (size_t)row * D + lane * 16); const u32x4* pg = (const u32x4*)(G1 + (size_t)row * D + lane * 16);
            float v[16], gv[16];
#pragma unroll
            for (int q = 0; q < 2; ++q) { const u32x4 a = pf[q], bq = pb[q], gq = pg[q]; const unsigned aw[4] = {a.x, a.y, a.z, a.w}, bw[4] = {bq.x, bq.y, bq.z, bq.w}, gw4[4] = {gq.x, gq.y, gq.z, gq.w};
#pragma unroll
                for (int j = 0; j < 4; ++j) { v[8 * q + 2 * j] = bflo(aw[j]) + bflo(bw[j]); v[8 * q + 2 * j + 1] = bfhi(aw[j]) + bfhi(bw[j]); gv[8 * q + 2 * j] = bflo(gw4[j]); gv[8 * q + 2 * j + 1] = bfhi(gw4[j]); } }
            float ss = 0.f;
#pragma unroll
            for (int j = 0; j < 16; ++j) ss += v[j] * v[j];
            ss += __shfl_xor(ss, 1); ss += __shfl_xor(ss, 2); ss += __shfl_xor(ss, 4); ss += __shfl_xor(ss, 8);
            const float rstd = __builtin_amdgcn_rsqf(ss * (1.0f / 256.0f) + EPS);
            const int c0 = (lane & 15) * 16;
            unsigned ow[8];
#pragma unroll
            for (int j = 0; j < 8; ++j) { const float a = v[2 * j] * rstd * on[c0 + 2 * j] * silu_f(gv[2 * j]), bq = v[2 * j + 1] * rstd * on[c0 + 2 * j + 1] * silu_f(gv[2 * j + 1]); ow[j] = cvtpk(a, bq); }
            u32x4* po = (u32x4*)(GA + (size_t)row * D + lane * 16);
            u32x4 o0; o0.x = ow[0]; o0.y = ow[1]; o0.z = ow[2]; o0.w = ow[3]; po[0] = o0; u32x4 o1; o1.x = ow[4]; o1.y = ow[5]; o1.z = ow[6]; o1.w = ow[7]; po[1] = o1;
        }
    }
    SEAM(16);

    if (IN(17)) {
        pg8::DenseProb P{wsp<bf16_t>(F, O_GA), wsp<bf16_t>(F, O_WOUT1), 1024, 1024, 1024, {}}; P.ord.init(RL / 256, 4, F.G, (int)blockIdx.x);
        pg8::EpiBf16 E{(bf16_t*)Y, D, nullptr};
        pg8::gemm_phase(F.lds, P, E);
    }
    SEAM(17);

    if (IN(18)) {
        int* SEL = wsp<int>(F, O_SEL); int* ROWTOK = wsp<int>(F, O_ROWTOK);
        LAS float* wr_l = (LAS float*)F.lds;
        LAS int* se = (LAS int*)(F.lds + 32768);
        LAS float* sw = (LAS float*)(F.lds + 32768 + 512);
        LAS int* sbase = (LAS int*)(F.lds + 32768 + 1024);
        for (int i = tid; i < 8192; i += 512) wr_l[i] = args.in[I_MROUTER][i];
        __syncthreads();
        for (int tile = F.vcu; tile < RL / 64; tile += F.G) {
            for (int rr = 0; rr < 8; ++rr) {
                const int lr = wave * 8 + rr, row = tile * 64 + lr; const int b = row >> 12;
                float* hp = args.out + (size_t)row * D;
                f32x4 y[4], h[4], uo[4]; load_row_bf16((const bf16_t*)Y + (size_t)row * D, lane, y); load_row(hp, lane, h);
                const float rstd = __builtin_amdgcn_rsqf(row_ssq(y) * (1.0f / D) + EPS);
#pragma unroll
                for (int j = 0; j < 4; ++j) { const int c = 4 * lane + 256 * j; const f32x4 g = *(const f32x4*)(normg + 5 * D + c), mg = *(const f32x4*)(MV(1, b, 2) + c);
                    h[j] = h[j] + mg * (y[j] * rstd * g); *(f32x4*)(hp + c) = h[j]; }
                norm_mod_store(h, normg + 6 * D, MV(1, b, 3), MV(1, b, 4), nullptr, lane, uo, wsp<unsigned char>(F, O_U) + (size_t)row * D);
                float lg[8];
#pragma unroll
                for (int e = 0; e < 8; ++e) lg[e] = 0.f;
#pragma unroll
                for (int j = 0; j < 4; ++j)
#pragma unroll
                    for (int q = 0; q < 4; ++q) { const int k = 4 * lane + 256 * j + q; const LAS f32x4* wp = (const LAS f32x4*)(wr_l + k * 8); const f32x4 w0 = wp[0], w1 = wp[1]; const float uv = uo[j][q];
                        lg[0] += uv * w0[0]; lg[1] += uv * w0[1]; lg[2] += uv * w0[2]; lg[3] += uv * w0[3]; lg[4] += uv * w1[0]; lg[5] += uv * w1[1]; lg[6] += uv * w1[2]; lg[7] += uv * w1[3]; }
#pragma unroll
                for (int e = 0; e < 8; ++e) lg[e] = wave_sum(lg[e]) + args.in[I_MBROUTER][e];
                int e0 = 0; float l0 = lg[0];
#pragma unroll
                for (int e = 1; e < 8; ++e) if (lg[e] > l0) { l0 = lg[e]; e0 = e; }
                int e1 = -1; float l1 = -3.0e38f;
#pragma unroll
                for (int e = 0; e < 8; ++e) if (e != e0 && lg[e] > l1) { l1 = lg[e]; e1 = e; }
                const float p1 = __expf(l1 - l0), w0n = 1.0f / (1.0f + p1), w1n = p1 / (1.0f + p1);
                if (lane == 0) { se[lr * 2] = e0; se[lr * 2 + 1] = e1; sw[lr * 2] = w0n; sw[lr * 2 + 1] = w1n; }
            }
            __syncthreads();
            if (tid < 8) { int c = 0; for (int r2 = 0; r2 < 64; ++r2) c += (se[2 * r2] == tid) + (se[2 * r2 + 1] == tid);
                sbase[tid] = (int)__hip_atomic_fetch_add(ctl + CW_CNT + 64 * tid, (unsigned)c, RLX_AGENT); }
            __syncthreads();
            if (tid < 64) { const int e0 = se[2 * tid], e1 = se[2 * tid + 1]; int r0 = 0, r1 = 0;
                for (int r2 = 0; r2 < tid; ++r2) { const int a0 = se[2 * r2], a1 = se[2 * r2 + 1]; r0 += (a0 == e0) + (a1 == e0); r1 += (a0 == e1) + (a1 == e1); }
                const int p0 = sbase[e0] + r0, p1 = sbase[e1] + r1, tok = tile * 64 + tid;
                ROWTOK[e0 * CAPE + p0] = tok; ROWTOK[e1 * CAPE + p1] = tok;
                int* sp = SEL + (size_t)tok * 8; sp[0] = e0; sp[1] = p0; sp[2] = e1; sp[3] = p1; sp[4] = __float_as_int(sw[2 * tid]); sp[5] = __float_as_int(sw[2 * tid + 1]); }
            __syncthreads();
        }
    }
    SEAM(18);

    pg8::MoeTiles MT;
    if (IN(19) || IN(20) || IN(21)) {
        int acc = 0; MT.tp8 = 0ull; MT.c4a = 0ull; MT.c4b = 0ull;
#pragma unroll
        for (int e = 0; e < 8; ++e) { const int c = (int)__builtin_amdgcn_readfirstlane((int)__hip_atomic_load(ctl + CW_CNT + 64 * e, RLX_AGENT));
            if (e < 4) MT.c4a |= (unsigned long long)(unsigned)c << (16 * e); else MT.c4b |= (unsigned long long)(unsigned)c << (16 * (e - 4));
            MT.tp8 |= (unsigned long long)(unsigned)acc << (8 * e); acc += (c + 255) >> 8; }
        MT.nt = acc;
    }
    if (IN(19)) {
        pg8::MoeGuProb P{wsp<unsigned char>(F, O_U), wsp<unsigned char>(F, O_WGU1), 512, 512, {}, MT, wsp<int>(F, O_ROWTOK)}; P.ord.init(MT.nt, N_GU1 / 256, F.G, (int)blockIdx.x);
        pg8::EpiSwiglu8 E{wsp<unsigned char>(F, O_HM), EXD};
        pg8::gemm_phase(F.lds, P, E);
    }
    SEAM(19);
    if (IN(20)) {
        pg8::MoeDnProb P{wsp<unsigned char>(F, O_HM), wsp<unsigned char>(F, O_WD1), EXD / 2, EXD / 2, {}, MT}; P.ord.init(MT.nt, 4, F.G, (int)blockIdx.x);
        pg8::EpiBf16 E{wsp<bf16_t>(F, O_YE), D, nullptr};
        pg8::gemm_phase(F.lds, P, E);
    }
    SEAM(20);
    if (IN(21)) {
        const int* SEL = wsp<int>(F, O_SEL); const bf16_t* YE = wsp<bf16_t>(F, O_YE);
        for (int row = gw; row < RL; row += NGW) {
            const int b = row >> 12; const int* sp = SEL + (size_t)row * 8;
            const int e0 = sp[0], p0 = sp[1], e1 = sp[2], p1 = sp[3]; const float w0 = __int_as_float(sp[4]), w1 = __int_as_float(sp[5]);
            const int t0 = pg8::moe_tp(MT, e0), t1 = pg8::moe_tp(MT, e1);
            const bf16_t* y0 = YE + ((size_t)t0 * 256 + p0) * D; const bf16_t* y1 = YE + ((size_t)t1 * 256 + p1) * D;
            float* hp = args.out + (size_t)row * D;
            f32x4 y[4], h[4]; load_row(hp, lane, h);
#pragma unroll
            for (int j = 0; j < 4; ++j) { const int c = 4 * lane + 256 * j; const u32x2 a = *(const u32x2*)(y0 + c), bq = *(const u32x2*)(y1 + c);
                y[j][0] = w0 * bflo(a.x) + w1 * bflo(bq.x); y[j][1] = w0 * bfhi(a.x) + w1 * bfhi(bq.x); y[j][2] = w0 * bflo(a.y) + w1 * bflo(bq.y); y[j][3] = w0 * bfhi(a.y) + w1 * bfhi(bq.y); }
            const float rstd = __builtin_amdgcn_rsqf(row_ssq(y) * (1.0f / D) + EPS);
#pragma unroll
            for (int j = 0; j < 4; ++j) { const int c = 4 * lane + 256 * j; const f32x4 g = *(const f32x4*)(normg + 7 * D + c), mg = *(const f32x4*)(MV(1, b, 5) + c);
                *(f32x4*)(hp + c) = h[j] + mg * (y[j] * rstd * g); }
        }
    }
#undef IN
#undef SEAM
#undef MV
}

constexpr int N_PHASES = 22;
extern "C" void kernel_launch(void* const* d_in, const int* in_sizes, int n_in, void* d_out, int out_size, void* d_ws, size_t ws_size, hipStream_t stream) {
    static int grid = 0;
    if (grid == 0) {
        if (n_in != 27 || out_size != RL * D || ws_size < WS_END) { fprintf(stderr, "kernel_launch: unexpected shapes n_in %d out %d ws %zu (need %zu)\n", n_in, out_size, ws_size, (size_t)WS_END); grid = -1; return; }
        int dev = 0, cus = 0, per_cu = 0;
        if (hipGetDevice(&dev) != hipSuccess || hipDeviceGetAttribute(&cus, hipDeviceAttributeMultiprocessorCount, dev) != hipSuccess) { grid = -1; return; }
        if (hipFuncSetAttribute((const void*)mk_fwd, hipFuncAttributeMaxDynamicSharedMemorySize, LDS_BYTES) != hipSuccess) { fprintf(stderr, "kernel_launch: hipFuncSetAttribute failed\n"); grid = -1; return; }
        if (hipOccupancyMaxActiveBlocksPerMultiprocessor(&per_cu, (const void*)mk_fwd, 512, LDS_BYTES) != hipSuccess || per_cu < 1) { fprintf(stderr, "kernel_launch: occupancy query says %d\n", per_cu); }
        (void)hipGetLastError();
        grid = cus;
        if (grid > 256) grid = 256;
    }
    if (grid < 0) return;
    (void)hipMemsetAsync((char*)d_ws + O_CTL, 0, CTL_BYTES, stream);
    Args a{};
    for (int i = 0; i < 27; ++i) a.in[i] = (const float*)d_in[i];
    a.out = (float*)d_out; a.ws = (unsigned char*)d_ws;
#if MK_ONE_LAUNCH
    a.ph_lo = 0; a.ph_hi = N_PHASES;
    hipLaunchKernelGGL(mk_fwd, dim3(grid), dim3(512), LDS_BYTES, stream, a);
#else
    for (int p = 0; p < N_PHASES; ++p) { a.ph_lo = p; a.ph_hi = p + 1; for (int rep = 0; rep < (p == MK_REP ? 2 : 1); ++rep) hipLaunchKernelGGL(mk_fwd, dim3(grid), dim3(512), LDS_BYTES, stream, a); }
#endif
}
```

```cpp
#include <hip/hip_runtime.h>
#include <cstdio>
#include <cstdint>

#ifndef MK_ONE_LAUNCH
#define MK_ONE_LAUNCH 1
#endif
#ifndef MK_EPI2
#define MK_EPI2 0
#endif
#ifndef MK_REP
#define MK_REP -1
#endif

#define LAS __attribute__((address_space(3)))
#define GAS __attribute__((address_space(1)))
typedef unsigned short bf16_t;
typedef short bf16x8 __attribute__((ext_vector_type(8)));
typedef short s16x4 __attribute__((ext_vector_type(4)));
typedef float f32x4 __attribute__((ext_vector_type(4)));
typedef float f32x16 __attribute__((ext_vector_type(16)));
typedef unsigned u32x4 __attribute__((ext_vector_type(4)));
typedef unsigned u32x2 __attribute__((ext_vector_type(2)));
typedef float f32x2_t __attribute__((ext_vector_type(2)));
typedef __bf16 bf16x2_t __attribute__((ext_vector_type(2)));
#define RLX_AGENT __ATOMIC_RELAXED, __HIP_MEMORY_SCOPE_AGENT

__device__ __forceinline__ unsigned cvtpk(float lo, float hi) { f32x2_t v = {lo, hi}; bf16x2_t b = __builtin_convertvector(v, bf16x2_t); return __builtin_bit_cast(unsigned, b); }
__device__ __forceinline__ bf16_t f2bf(float f) { return (bf16_t)(cvtpk(f, 0.f) & 0xffffu); }
__device__ __forceinline__ float bflo(unsigned w) { return __uint_as_float(w << 16); }
__device__ __forceinline__ float bfhi(unsigned w) { return __uint_as_float(w & 0xffff0000u); }
__device__ __forceinline__ float bf2f(bf16_t b) { return __uint_as_float(((unsigned)b) << 16); }
__device__ __forceinline__ float wave_sum(float v) {
#pragma unroll
    for (int o = 1; o < 64; o <<= 1) v += __shfl_xor(v, o);
    return v;
}
__device__ __forceinline__ float fast_exp(float x) { return __builtin_amdgcn_exp2f(x * 1.4426950408889634f); }
__device__ __forceinline__ float clamp8(float x) { return __builtin_amdgcn_fmed3f(x, -448.0f, 448.0f); }
__device__ __forceinline__ unsigned pack_fp8x4(float a, float b, float c, float d) { int w = __builtin_amdgcn_cvt_pk_fp8_f32(clamp8(a), clamp8(b), 0, false); w = __builtin_amdgcn_cvt_pk_fp8_f32(clamp8(c), clamp8(d), w, true); return (unsigned)w; }
__device__ __forceinline__ float swiglu_f(float gp, float up, float k) { return (gp * up) * __builtin_amdgcn_rcpf(__builtin_fmaf(__builtin_amdgcn_exp2f(gp), k, k)); }
__device__ __forceinline__ float silu_f(float g) { return g * __builtin_amdgcn_rcpf(1.0f + fast_exp(-g)); }

#define XB_TMO      128
#define XB_XCNT(j)  (256  + 64 * (j))
#define XB_XSUB(j)  (1280 + 64 * (j))
#define XB_XGEN(j)  (2304 + 64 * (j))
#define XB_TOP      3328
#define XB_TOPGEN   3392
#define XCD_BAR_WORDS 3456
#define XB_SPIN_CAP (1u << 18)
__device__ __forceinline__ unsigned xb_ld(unsigned* p)              { return __hip_atomic_load(p, __ATOMIC_RELAXED, __HIP_MEMORY_SCOPE_AGENT); }
__device__ __forceinline__ unsigned xb_add(unsigned* p, unsigned v) { return __hip_atomic_fetch_add(p, v, __ATOMIC_RELAXED, __HIP_MEMORY_SCOPE_AGENT); }
__device__ __forceinline__ unsigned xb_xcc_id() { return (unsigned)__builtin_amdgcn_s_getreg((3 << 11) | 20) & 0xFu; }
#define XB_SPIN(cond, bar) do { unsigned _sp = 0; while (cond) { __builtin_amdgcn_s_sleep(1); \
    if ((++_sp & 255u) == 0u) { if (xb_ld(&(bar)[XB_TMO])) break; if (_sp > XB_SPIN_CAP) { atomicAdd(&(bar)[XB_TMO], 1u); break; } } } } while (0)
struct XcdBarrier { unsigned* bar; unsigned x; volatile LAS unsigned* st; };
__device__ __forceinline__ XcdBarrier xcd_barrier_post(unsigned* bar, volatile LAS unsigned* st) {
    XcdBarrier b; b.bar = bar; b.x = xb_xcc_id(); b.st = st;
    if (threadIdx.x == 0) (void)xb_add(&bar[XB_XCNT(b.x)], 1u);
    return b;
}
__device__ __forceinline__ void xcd_barrier_complete(unsigned* bar, unsigned x, unsigned& nloc, unsigned& nx) {
    const unsigned G = gridDim.x * gridDim.y * gridDim.z;
    unsigned sum, cnt, mine, sp = 0u;
    for (;;) {
        sum = 0u; cnt = 0u; mine = 0u;
#pragma unroll
        for (unsigned j = 0; j < 16; ++j) { const unsigned c = xb_ld(&bar[XB_XCNT(j)]); sum += c; cnt += (c > 0u) ? 1u : 0u; mine = (j == x) ? c : mine; }
        if (sum == G) break;
        __builtin_amdgcn_s_sleep(1);
        if ((++sp & 255u) == 0u) { if (xb_ld(&bar[XB_TMO])) break; if (sp > XB_SPIN_CAP) { atomicAdd(&bar[XB_TMO], 1u); break; } }
    }
    nloc = mine > 0u ? mine : 1u; nx = cnt > 0u ? cnt : 1u;
}
__device__ __forceinline__ void xcd_barrier(const XcdBarrier& b) {
    asm volatile("s_waitcnt vmcnt(0)" ::: "memory");
    __syncthreads();
    if (threadIdx.x == 0) {
        unsigned* bar = b.bar;
        __builtin_amdgcn_s_waitcnt(0);
        unsigned nloc = b.st[0], nx = b.st[1];
        if (nloc == 0u) { xcd_barrier_complete(bar, b.x, nloc, nx); b.st[0] = nloc; b.st[1] = nx; }
        const unsigned old = xb_add(&bar[XB_XSUB(b.x)], 1u);
        const unsigned gen = old / nloc;
        if (old + 1u == (gen + 1u) * nloc) {
            __builtin_amdgcn_fence(__ATOMIC_RELEASE, "agent");
            asm volatile("s_waitcnt vmcnt(0)" ::: "memory");
            const unsigned og = xb_add(&bar[XB_TOP], 1u);
            const unsigned tg = og / nx;
            if (og + 1u == (tg + 1u) * nx) xb_add(&bar[XB_TOPGEN], 1u);
            else XB_SPIN(xb_ld(&bar[XB_TOPGEN]) == tg, bar);
            __builtin_amdgcn_fence(__ATOMIC_ACQUIRE, "agent");
            xb_add(&bar[XB_XGEN(b.x)], 1u);
            asm volatile("s_waitcnt vmcnt(0)" ::: "memory");
        } else {
            XB_SPIN(xb_ld(&bar[XB_XGEN(b.x)]) == gen, bar);
            __builtin_amdgcn_fence(__ATOMIC_ACQUIRE, "agent");
            asm volatile("s_waitcnt vmcnt(0)" ::: "memory");
        }
    }
    __syncthreads();
}

constexpr int D = 1024, NB = 4, SEQ = 4096, CTX = 256;
constexpr int RL = NB * SEQ;
constexpr int RC = NB * CTX;
constexpr int R = RL + RC;
constexpr float EPS = 1e-6f;
constexpr float LOG2E = 1.4426950408889634f;
constexpr int N_IN0 = 1536, N_QA = 768, N_KVA = 1024, FFN = 2816, N_GU0 = 2 * FFN, N_IN1 = 3328, EXD = 3584, N_GU1 = 2 * EXD, NEXP = 8;
constexpr int CAPE = 16384;

constexpr size_t MiB = 1u << 20;
constexpr size_t O_CTL = 0;
constexpr size_t CTL_BYTES = 65536;
constexpr int CW_BAR = 0;
constexpr int CW_CNT = 8192;
constexpr size_t O_MODV = 1 * MiB;
constexpr size_t O_TAB16 = O_MODV + 256 * 1024;
constexpr size_t O_TAB32 = O_TAB16 + 8192;
constexpr size_t O_RSTDQ = O_TAB32 + 16384;
constexpr size_t O_RSTDKV = O_RSTDQ + 81920;
constexpr size_t O_SEL = 2 * MiB;
constexpr size_t O_ROWTOK = 3 * MiB;
constexpr size_t O_WGU1 = 4 * MiB;
constexpr size_t O_YE = O_WGU1;
constexpr size_t O_WD1 = 116 * MiB;
constexpr size_t O_WIN1 = 172 * MiB;
constexpr size_t O_WOUT1 = 179 * MiB;
constexpr size_t O_WIN0 = 181 * MiB;
constexpr size_t O_WUQ = 184 * MiB;
constexpr size_t O_WUKV = 185 * MiB;
constexpr size_t O_WOUT0 = 186 * MiB;
constexpr size_t O_WGU0 = 188 * MiB;
constexpr size_t O_WD0 = 199 * MiB;
constexpr size_t O_HC = 205 * MiB;
constexpr size_t O_U = 209 * MiB;
constexpr size_t O_Y = 243 * MiB;
constexpr size_t O_Z0 = 311 * MiB;
constexpr size_t O_QA = 362 * MiB;
constexpr size_t O_KVA = 388 * MiB;
constexpr size_t O_QB = 422 * MiB;
constexpr size_t O_KB = 439 * MiB;
constexpr size_t O_KR = 444 * MiB;
constexpr size_t O_AO = 446 * MiB;
constexpr size_t O_H0 = 311 * MiB;
constexpr size_t O_QK1 = 311 * MiB;
constexpr size_t O_V1 = 345 * MiB;
constexpr size_t O_G1 = 379 * MiB;
constexpr size_t O_RR = 413 * MiB;
constexpr size_t O_QDF = 422 * MiB, O_KIF = 439 * MiB, O_KTF = 456 * MiB, O_QDB = 473 * MiB;
constexpr size_t O_KIB = 243 * MiB, O_KTB = 260 * MiB, O_VT = 277 * MiB;
constexpr size_t O_ECL = 490 * MiB;
constexpr size_t O_OF = O_QK1, O_OB = O_V1;
constexpr size_t O_GA = O_QDF;
constexpr size_t O_HM = 243 * MiB;
constexpr size_t WS_END = 495 * MiB;
static_assert(O_HM + (size_t)34816 * EXD * 2 <= 482 * MiB, "HM");
static_assert(O_RR + (size_t)R * 256 * 2 <= O_QDF, "RR");
static_assert(O_ECL + (size_t)544 * 8 * 1024 <= WS_END, "ECL");

constexpr int RING_BYTES = 131072;
constexpr int LDS_BYTES = 163840;
constexpr int LDSCTL_OFF = LDS_BYTES - 256;

struct Args {
    const float* in[27];
    float* out; unsigned char* ws;
    int ph_lo, ph_hi;
};
enum { I_X = 0, I_C, I_CTX, I_CCTX, I_MODW, I_MODB, I_NORMG, I_AWIN, I_AQN, I_AWUQ, I_AKVN, I_AWUKV, I_AQKN, I_AWOUT, I_GWIN, I_GGATE2, I_GBGATE, I_GONORM, I_GWOUT,
       I_FWG, I_FWU, I_FWD, I_MROUTER, I_MBROUTER, I_MWG, I_MWU, I_MWD };

struct Conv { const float* s0; const float* s1; int Nsrc; int K; int Ndst; bf16_t* dst; int mode; const float* kscale; };
__device__ __forceinline__ int ilv64(int p) { return (p >> 5) * 32 + (p & 1) * 16 + ((p & 31) >> 1); }
__device__ __forceinline__ int ilv32(int p) { return (p >> 4) * 16 + (p & 1) * 8 + ((p & 15) >> 1); }
__device__ __forceinline__ const float* conv_col(const Conv& c, int n, float& sc) {
    sc = 1.0f;
    switch (c.mode) {
    case 0: return c.s0 + n;
    case 1: {
        if (n < 640) return c.s0 + n;
        if (n < 1152) { const int hh = (n - 640) >> 6, p = (n - 640) & 63; return c.s0 + 672 + hh * 64 + ilv64(p); }
        if (n < 1280) { const int hh = (n - 1152) >> 6, p = (n - 1152) & 63; return c.s0 + 1184 + hh * 64 + ilv64(p); }
        if (n < 1408) return c.s0 + 1312 + (n - 1280);
        if (n < 1440) return c.s0 + 640 + ilv32(n - 1408);
        return nullptr; }
    case 2: {
        if (n < 512) return c.s0 + (n >> 6) * 96 + (n & 63);
        const int hh = (n - 512) >> 5, p = (n - 512) & 31; return c.s0 + hh * 96 + 64 + ilv32(p); }
    case 3: {
        const int G = n >> 5, j = n & 31; return (j < 16) ? c.s0 + 16 * G + j : c.s1 + 16 * G + (j - 16); }
    case 4: {
        if (n >= 3104) return nullptr;
        if (n < 512) sc = 0.08838834764831845f;
        return c.s0 + n; }
    }
    return nullptr;
}
__device__ __forceinline__ void conv_item(const Conv& c, int item, LAS float* scr, int lane) {
    const int nblk = c.Ndst / 32, kb = item / nblk, nb = item % nblk, k0 = 64 * kb, n0 = 32 * nb;
    float sc; const float* cp = conv_col(c, n0 + (lane & 31), sc);
    const int kh = lane >> 5;
#pragma unroll 16
    for (int i = 0; i < 32; ++i) { const int kk = 2 * i + kh; float v = 0.f;
        if (cp) { v = cp[(size_t)(k0 + kk) * c.Nsrc] * sc; if (c.kscale) v *= c.kscale[k0 + kk]; }
        scr[kk * 33 + (lane & 31)] = v; }
    asm volatile("s_waitcnt lgkmcnt(0)" ::: "memory");
    const int ch = lane & 7;
#pragma unroll
    for (int j = 0; j < 4; ++j) { const int n = (lane >> 3) + 8 * j; const LAS float* s = scr + (8 * ch) * 33 + n;
        u32x4 o; o.x = cvtpk(s[0 * 33], s[1 * 33]); o.y = cvtpk(s[2 * 33], s[3 * 33]); o.z = cvtpk(s[4 * 33], s[5 * 33]); o.w = cvtpk(s[6 * 33], s[7 * 33]);
        *(u32x4*)(c.dst + (size_t)(n0 + n) * c.K + k0 + 8 * ch) = o; }
    asm volatile("s_waitcnt lgkmcnt(0)" ::: "memory");
}

struct Conv64 { const float* s0; const float* s1; int Nsrc; int K; int Ndst; bf16_t* dst; int mode; int nvalid; int nscaled; float rscale; int f8; };
struct Conv64Geo { int k0, n0, nd; bool valid; float sc; const float* src; };
__device__ __forceinline__ Conv64Geo conv64_geo(const Conv64& c, int item, int lane) {
    Conv64Geo g; const int nblk = c.Ndst / 64, kb = item / nblk, nb = item % nblk; g.k0 = 64 * kb; g.n0 = 64 * nb;
    const int c4 = lane & 15, kr = lane >> 4; g.valid = true; g.sc = 1.0f;
    if (c.mode == 3) { const int cc = 4 * (c4 & 7); g.src = c.s0 + ((c4 < 8) ? (long)0 : (long)(c.s1 - c.s0)) + 32 * nb + cc; g.nd = 32 * (cc >> 4) + ((c4 < 8) ? 0 : 16) + (cc & 15); g.sc = c.rscale * ((c4 < 8) ? -1.4426950408889634f : 1.0f); }
    else { g.nd = 4 * c4; g.src = c.s0 + g.n0 + g.nd; g.valid = (g.n0 + g.nd) < c.nvalid; if (g.n0 + g.nd < c.nscaled) g.sc = c.rscale; }
    g.src += (size_t)(g.k0 + kr) * c.Nsrc;
    return g;
}
__device__ __forceinline__ void conv64_load(const Conv64& c, int item, int lane, f32x4 (&v)[16]) {
    const Conv64Geo g = conv64_geo(c, item, lane);
#pragma unroll
    for (int i = 0; i < 16; ++i) v[i] = g.valid ? *(const f32x4*)(g.src + (size_t)(4 * i) * c.Nsrc) : (f32x4){0.f, 0.f, 0.f, 0.f};
}
__device__ __forceinline__ void conv64_store(const Conv64& c, int item, LAS float* scr, int lane, const f32x4 (&v)[16]) {
    const Conv64Geo g = conv64_geo(c, item, lane); const int kr = lane >> 4, nd = g.nd, k0 = g.k0, n0 = g.n0; const float sc = g.sc;
#pragma unroll
    for (int i = 0; i < 16; ++i) { LAS float* p = scr + (4 * i + kr) * 65 + nd; p[0] = v[i][0] * sc; p[1] = v[i][1] * sc; p[2] = v[i][2] * sc; p[3] = v[i][3] * sc; }
    asm volatile("s_waitcnt lgkmcnt(0)" ::: "memory");
    if (c.f8) {
        const int ch = lane & 3; unsigned char* d8 = (unsigned char*)c.dst;
#pragma unroll
        for (int it = 0; it < 4; ++it) { const int r = it * 16 + (lane >> 2); const LAS float* sp = scr + (16 * ch) * 65 + r; u32x4 o;
            o.x = pack_fp8x4(sp[0 * 65], sp[1 * 65], sp[2 * 65], sp[3 * 65]); o.y = pack_fp8x4(sp[4 * 65], sp[5 * 65], sp[6 * 65], sp[7 * 65]);
            o.z = pack_fp8x4(sp[8 * 65], sp[9 * 65], sp[10 * 65], sp[11 * 65]); o.w = pack_fp8x4(sp[12 * 65], sp[13 * 65], sp[14 * 65], sp[15 * 65]);
            *(u32x4*)(d8 + (size_t)(n0 + r) * c.K + k0 + 16 * ch) = o; }
    } else {
    const int ch = lane & 7;
#pragma unroll
    for (int it = 0; it < 8; ++it) { const int r = it * 8 + (lane >> 3); const LAS float* sp = scr + (8 * ch) * 65 + r;
        u32x4 o; o.x = cvtpk(sp[0 * 65], sp[1 * 65]); o.y = cvtpk(sp[2 * 65], sp[3 * 65]); o.z = cvtpk(sp[4 * 65], sp[5 * 65]); o.w = cvtpk(sp[6 * 65], sp[7 * 65]);
        *(u32x4*)(c.dst + (size_t)(n0 + r) * c.K + k0 + 8 * ch) = o; }
    }
    asm volatile("s_waitcnt lgkmcnt(0)" ::: "memory");
}

__device__ __forceinline__ void conv64_run(const Conv64& c, LAS float* scr, int lane, int gwi, int ngw, int& base) {
    const int n = (c.K / 64) * (c.Ndst / 64); int it = gwi - base; if (it < 0) it += ngw;
    if (it < n) { f32x4 va[16], vb[16]; conv64_load(c, it, lane, va);
        for (;;) { const int i2 = it + ngw; if (i2 < n) conv64_load(c, i2, lane, vb); conv64_store(c, it, scr, lane, va); if (i2 >= n) break;
                   const int i3 = i2 + ngw; if (i3 < n) conv64_load(c, i3, lane, va); conv64_store(c, i2, scr, lane, vb); if (i3 >= n) break; it = i3; } }
    base = (base + n) % ngw;
}

namespace pg8 {
constexpr int BM = 256, BK = 64, HALF = 128, HTB = HALF * BK * 2, STAGE_BYTES = 8 * HTB;
constexpr int NXCD = 8, WGM = 8;
__device__ __forceinline__ int lds_byte(int r, int c) { const int st = (r >> 4) * 2 + (c >> 5), rr = r & 15, cc = c & 31, ob = rr * 64 + cc * 2; return st * 1024 + (ob ^ (((ob >> 9) & 1) << 5)); }
__device__ __forceinline__ void stage_rc(int b, int& Rr, int& C) { const int st = b / 1024, sb = b % 1024, swz = sb ^ (((sb >> 9) & 1) << 5); Rr = (st >> 1) * 16 + swz / 64; C = (st & 1) * 32 + (swz % 64) / 2; }
__device__ __forceinline__ int perm32(int rho) { const int n = rho >> 4, i = rho & 15; return 8 * (i >> 2) + 4 * n + (i & 3); }
struct Unit { int pm, pn; };
typedef int v8i_t __attribute__((ext_vector_type(8)));
typedef int v4i_t __attribute__((ext_vector_type(4)));
__device__ __forceinline__ v8i_t cat8(bf16x8 a, bf16x8 b) { const v4i_t x = __builtin_bit_cast(v4i_t, a), y = __builtin_bit_cast(v4i_t, b); return __builtin_shufflevector(x, y, 0, 1, 2, 3, 4, 5, 6, 7); }
struct Order {
    int nM, nN, nwg, G, c;
    __device__ __forceinline__ void init(int nM_, int nN_, int G_, int c_) { nM = nM_; nN = nN_; nwg = nM * nN; G = G_; c = c_; }
    __device__ __forceinline__ bool next(int i, Unit& u) const {
        const long L = (long)i * G + c; if (L >= nwg) return false;
        int wgid = (int)L; { const int q = nwg / NXCD, r = nwg % NXCD, xcd = wgid % NXCD, off = wgid / NXCD; wgid = (xcd < r ? xcd * (q + 1) : r * (q + 1) + (xcd - r) * q) + off; }
        const int nig = WGM * nN, gid = wgid / nig, fm = gid * WGM, gsz = (nM - fm) < WGM ? (nM - fm) : WGM;
        u.pm = fm + ((wgid % nig) % gsz); u.pn = (wgid % nig) / gsz; return true;
    }
};

template <class Prob, class Epi>
__device__ __forceinline__ void gemm_phase(LAS unsigned char* lds, const Prob& P, const Epi& E) {
    const int tid = threadIdx.x, wid = __builtin_amdgcn_readfirstlane(tid >> 6), lane = tid & 63, wr = wid >> 2, wc = wid & 3, fr = lane & 15, fq = lane >> 4;
    const int K = P.K, nt = K / BK, ldb = P.ldb;
    int RA[2], CA[2]; unsigned voffB[2];
#pragma unroll
    for (int i = 0; i < 2; ++i) { int Rr, C; stage_rc(tid * 16 + i * 8192, Rr, C); const int Rb = Epi::PERM ? ((Rr & ~31) + perm32(Rr & 31)) : Rr;
        RA[i] = Rr; CA[i] = C; voffB[i] = (unsigned)(Rb * ldb + C) * 2u; }
    const size_t hstepB = (size_t)HALF * ldb * 2;
    const unsigned ldsw = (unsigned)wid * 1024u;
    const int aoff = lds_byte(wr * 64 + fr, fq * 8), boff = lds_byte(wc * 32 + fr, fq * 8);
    const char* Abase = (const char*)P.Abase;
    const int scl_a = P.sa * 0x01010101, scl_b = P.sb * 0x01010101;
#define PG8_SA(b, h) (((b) * 2 + (h)) * HTB)
#define PG8_SB(b, h) ((4 + (b) * 2 + (h)) * HTB)
#define PG8_STAGEB(bufoff, gbase) do { _Pragma("unroll") for (int _i = 0; _i < 2; ++_i) \
        __builtin_amdgcn_global_load_lds((const unsigned*)((const char*)(gbase) + voffB[_i]), (LAS unsigned*)(lds + (bufoff) + ldsw + _i * 8192), 16, 0, 0); } while (0)
#define PG8_STAGEA(bufoff, vo, h, kb) do { _Pragma("unroll") for (int _i = 0; _i < 2; ++_i) \
        __builtin_amdgcn_global_load_lds((const unsigned*)(Abase + (size_t)(kb) + (vo)[h][_i]), (LAS unsigned*)(lds + (bufoff) + ldsw + _i * 8192), 16, 0, 0); } while (0)
#define PG8_LDA(dst, b, h) do { _Pragma("unroll") for (int m = 0; m < 4; ++m) { if constexpr (Prob::FP8) dst##8[m] = cat8(*(const LAS bf16x8*)(lds + PG8_SA(b, h) + aoff + m * 2048), *(const LAS bf16x8*)(lds + PG8_SA(b, h) + aoff + m * 2048 + 1024)); \
        else { _Pragma("unroll") for (int k = 0; k < 2; ++k) dst[m][k] = *(const LAS bf16x8*)(lds + PG8_SA(b, h) + aoff + m * 2048 + k * 1024); } } } while (0)
#define PG8_LDB(dst, b, h) do { _Pragma("unroll") for (int n = 0; n < 2; ++n) { if constexpr (Prob::FP8) dst##8[n] = cat8(*(const LAS bf16x8*)(lds + PG8_SB(b, h) + boff + n * 2048), *(const LAS bf16x8*)(lds + PG8_SB(b, h) + boff + n * 2048 + 1024)); \
        else { _Pragma("unroll") for (int k = 0; k < 2; ++k) dst[n][k] = *(const LAS bf16x8*)(lds + PG8_SB(b, h) + boff + n * 2048 + k * 1024); } } } while (0)
#define PG8_MMA(ai, bj, At, Bt) do { __builtin_amdgcn_s_setprio(1); _Pragma("unroll") for (int m = 0; m < 4; ++m) _Pragma("unroll") for (int n = 0; n < 2; ++n) { \
        if constexpr (Prob::FP8) asm volatile("v_mfma_scale_f32_16x16x128_f8f6f4 %0, %1, %2, %0, %3, %4 op_sel_hi:[0,0,0]" : "+v"(acc[ai][bj][m][n]) : "v"(Bt##8[n]), "v"(At##8[m]), "v"(scl_b), "v"(scl_a)); \
        else { _Pragma("unroll") for (int k = 0; k < 2; ++k) acc[ai][bj][m][n] = __builtin_amdgcn_mfma_f32_16x16x32_bf16(Bt[n][k], At[m][k], acc[ai][bj][m][n], 0, 0, 0); } } \
        __builtin_amdgcn_s_setprio(0); } while (0)
#define PG8_WAIT_V(n) asm volatile("s_waitcnt vmcnt(" #n ")" ::: "memory")
#define PG8_WAIT_L(n) asm volatile("s_waitcnt lgkmcnt(" #n ")" ::: "memory")
#define PG8_BAR __builtin_amdgcn_s_barrier()
#define PG8_SCHED __builtin_amdgcn_sched_barrier(0)
    Unit cur, nxt; int ui = 0;
    if (!P.next(0, cur)) return;
    f32x4 acc[2][2][4][2];
#pragma unroll
    for (int a = 0; a < 2; ++a)
#pragma unroll
        for (int b = 0; b < 2; ++b)
#pragma unroll
            for (int m = 0; m < 4; ++m)
#pragma unroll
                for (int n = 0; n < 2; ++n) acc[a][b][m][n] = (f32x4){0.f, 0.f, 0.f, 0.f};
    bf16x8 At[4][2], B0[2][2], B1[2][2]; v8i_t At8[4], B08[2], B18[2];
    unsigned cvo[2][2], nvo[2][2];
#pragma unroll
    for (int h = 0; h < 2; ++h)
#pragma unroll
        for (int i = 0; i < 2; ++i) cvo[h][i] = P.a_off(cur, h * HALF + RA[i]) + (unsigned)CA[i] * 2u;
    const char* cB = P.b_ptr(cur);
    const size_t kstep = (size_t)(BK * 2);
    PG8_STAGEB(PG8_SB(0, 0), cB); PG8_STAGEB(PG8_SB(0, 1), cB + hstepB); PG8_STAGEA(PG8_SA(0, 0), cvo, 0, 0); PG8_STAGEA(PG8_SA(0, 1), cvo, 1, 0);
    if (wr == 1) PG8_BAR;
    PG8_WAIT_V(2); PG8_BAR;
    PG8_STAGEB(PG8_SB(1, 0), cB + kstep); PG8_STAGEA(PG8_SA(1, 0), cvo, 0, kstep); PG8_STAGEB(PG8_SB(1, 1), cB + hstepB + kstep);
    PG8_WAIT_V(6); PG8_BAR;
    for (;;) {
        const bool has_next = P.next(ui + 1, nxt);
        const char* nB = cB;
#pragma unroll
        for (int h = 0; h < 2; ++h)
#pragma unroll
            for (int i = 0; i < 2; ++i) nvo[h][i] = cvo[h][i];
        if (has_next) { nB = P.b_ptr(nxt);
#pragma unroll
            for (int h = 0; h < 2; ++h)
#pragma unroll
                for (int i = 0; i < 2; ++i) nvo[h][i] = P.a_off(nxt, h * HALF + RA[i]) + (unsigned)CA[i] * 2u; }
        for (int t = 0; t < nt; t += 2) {
            const bool last = (t == nt - 2);
            const size_t k1 = (size_t)(t + 1) * kstep;
            const size_t k2 = last ? 0 : (size_t)(t + 2) * kstep, k3 = k2 + kstep;
            unsigned vo2[2][2];
#pragma unroll
            for (int h = 0; h < 2; ++h)
#pragma unroll
                for (int i = 0; i < 2; ++i) vo2[h][i] = last ? nvo[h][i] : cvo[h][i];
            const char* b2 = (last ? nB : cB) + k2; const char* b3 = b2 + kstep;
            PG8_LDB(B0, 0, 0); PG8_LDB(B1, 0, 1); PG8_SCHED; PG8_LDA(At, 0, 0); PG8_STAGEA(PG8_SA(1, 1), cvo, 1, k1);
            PG8_WAIT_V(8); PG8_WAIT_L(0); PG8_BAR; PG8_MMA(0, 0, At, B0); PG8_MMA(0, 1, At, B1); PG8_BAR; PG8_SCHED;
            PG8_LDA(At, 0, 1); PG8_STAGEB(PG8_SB(0, 0), b2); PG8_STAGEB(PG8_SB(0, 1), b2 + hstepB); PG8_STAGEA(PG8_SA(0, 0), vo2, 0, k2);
            PG8_WAIT_V(8); PG8_WAIT_L(0); PG8_BAR; PG8_MMA(1, 0, At, B0); PG8_MMA(1, 1, At, B1); PG8_BAR; PG8_SCHED;
            PG8_LDB(B0, 1, 0); PG8_LDB(B1, 1, 1); PG8_SCHED; PG8_LDA(At, 1, 0); PG8_STAGEA(PG8_SA(0, 1), vo2, 1, k2);
            PG8_WAIT_V(8); PG8_WAIT_L(0); PG8_BAR; PG8_MMA(0, 0, At, B0); PG8_MMA(0, 1, At, B1); PG8_BAR; PG8_SCHED;
            PG8_LDA(At, 1, 1); PG8_STAGEB(PG8_SB(1, 0), b3); PG8_STAGEB(PG8_SB(1, 1), b3 + hstepB); PG8_STAGEA(PG8_SA(1, 0), vo2, 0, k3);
            PG8_WAIT_V(8); PG8_WAIT_L(0); PG8_BAR; PG8_MMA(1, 0, At, B0); PG8_MMA(1, 1, At, B1); PG8_BAR; PG8_SCHED;
        }
        if (wr == 0) PG8_BAR;
        if constexpr (Prob::FP8) asm volatile("s_nop 15\n\ts_nop 15" ::: "memory");
        if constexpr (Epi::STAGED) E.staged(acc, P, cur, wr, wc, fr, fq, lds + STAGE_BYTES, tid);
        else { E(acc, P, cur, wr, wc, fr, fq); if (MK_EPI2) { asm volatile("" ::: "memory"); E(acc, P, cur, wr, wc, fr, fq); } }
        if (!has_next) break;
#pragma unroll
        for (int a = 0; a < 2; ++a)
#pragma unroll
            for (int b = 0; b < 2; ++b)
#pragma unroll
                for (int m = 0; m < 4; ++m)
#pragma unroll
                    for (int n = 0; n < 2; ++n) acc[a][b][m][n] = (f32x4){0.f, 0.f, 0.f, 0.f};
        cur = nxt; cB = nB; ++ui;
#pragma unroll
        for (int h = 0; h < 2; ++h)
#pragma unroll
            for (int i = 0; i < 2; ++i) cvo[h][i] = nvo[h][i];
        if (wr == 1) PG8_BAR;
    }
    PG8_WAIT_V(0);
    PG8_BAR;
#undef PG8_SA
#undef PG8_SB
#undef PG8_STAGEA
#undef PG8_STAGEB
#undef PG8_LDA
#undef PG8_LDB
#undef PG8_MMA
#undef PG8_WAIT_V
#undef PG8_WAIT_L
#undef PG8_BAR
#undef PG8_SCHED
}

struct DenseProb {
    static constexpr bool FP8 = false; static constexpr int sa = 127, sb = 127;
    const bf16_t* Abase; const bf16_t* Bt; int K, lda, ldb; Order ord;
    __device__ __forceinline__ bool next(int i, Unit& u) const { return ord.next(i, u); }
    __device__ __forceinline__ unsigned a_off(const Unit& u, int r) const { return (unsigned)((size_t)(u.pm * BM + r) * lda * 2); }
    __device__ __forceinline__ const char* b_ptr(const Unit& u) const { return (const char*)Bt + (size_t)u.pn * BM * ldb * 2; }
    __device__ __forceinline__ int orow0(const Unit& u) const { return u.pm * BM; }
};
template <int SA, int SB> struct DenseProb8 {
    static constexpr bool FP8 = true; static constexpr int sa = SA, sb = SB;
    const unsigned char* Abase; const unsigned char* Bt; int K, ldb; int lda; Order ord;
    __device__ __forceinline__ bool next(int i, Unit& u) const { return ord.next(i, u); }
    __device__ __forceinline__ unsigned a_off(const Unit& u, int r) const { return (unsigned)((size_t)(u.pm * BM + r) * lda); }
    __device__ __forceinline__ const char* b_ptr(const Unit& u) const { return (const char*)Bt + (size_t)u.pn * BM * ldb * 2; }
    __device__ __forceinline__ int orow0(const Unit& u) const { return u.pm * BM; }
};
struct MoeTiles { unsigned long long tp8; unsigned long long c4a, c4b; int nt; };
__device__ __forceinline__ int moe_tp(const MoeTiles& T, int e) { return (int)((T.tp8 >> (8 * e)) & 0xffull); }
__device__ __forceinline__ int moe_cnt(const MoeTiles& T, int e) { const unsigned long long w = (e < 4) ? T.c4a : T.c4b; return (int)((w >> (16 * (e & 3))) & 0xffffull); }
__device__ __forceinline__ int moe_expert(const MoeTiles& T, int pm) { int e = 0;
#pragma unroll
    for (int j = 1; j < 8; ++j) e += (pm >= (int)((T.tp8 >> (8 * j)) & 0xffull)) ? 1 : 0;
    return e; }
struct MoeGuProb {
    static constexpr bool FP8 = true; static constexpr int sa = 125, sb = 121;
    const unsigned char* Abase; const unsigned char* Bt; int K, ldb; Order ord; MoeTiles T; const int* rowtok;
    __device__ __forceinline__ bool next(int i, Unit& u) const { return ord.next(i, u); }
    __device__ __forceinline__ unsigned a_off(const Unit& u, int r) const {
        const int e = moe_expert(T, u.pm); const int idx = (u.pm - moe_tp(T, e)) * BM + r; const int cm1 = moe_cnt(T, e) - 1;
        const int tok = rowtok[e * CAPE + (idx < cm1 ? idx : cm1)];
        return (unsigned)tok * (unsigned)D; }
    __device__ __forceinline__ const char* b_ptr(const Unit& u) const { const int e = moe_expert(T, u.pm); return (const char*)Bt + ((size_t)e * N_GU1 + (size_t)u.pn * BM) * D; }
    __device__ __forceinline__ int orow0(const Unit& u) const { return u.pm * BM; }
};
struct MoeDnProb {
    static constexpr bool FP8 = true; static constexpr int sa = 124, sb = 121;
    const unsigned char* Abase; const unsigned char* Bt; int K, ldb; Order ord; MoeTiles T;
    __device__ __forceinline__ bool next(int i, Unit& u) const { return ord.next(i, u); }
    __device__ __forceinline__ unsigned a_off(const Unit& u, int r) const { return (unsigned)((size_t)(u.pm * BM + r) * EXD); }
    __device__ __forceinline__ const char* b_ptr(const Unit& u) const { const int e = moe_expert(T, u.pm); return (const char*)Bt + ((size_t)e * D + (size_t)u.pn * BM) * EXD; }
    __device__ __forceinline__ int orow0(const Unit& u) const { return u.pm * BM; }
};

struct EpiF32 { static constexpr bool PERM = false; static constexpr bool STAGED = false; float* C; int ldc;
    template <class Prob> __device__ __forceinline__ void operator()(const f32x4 (&acc)[2][2][4][2], const Prob& P, const Unit& u, int wr, int wc, int fr, int fq) const {
        const int row0 = P.orow0(u) + wr * 64 + fr, col0 = u.pn * BM + wc * 32 + 4 * fq;
#pragma unroll
        for (int ai = 0; ai < 2; ++ai)
#pragma unroll
            for (int m = 0; m < 4; ++m) { float* rowp = C + (size_t)(row0 + ai * HALF + m * 16) * ldc + col0;
#pragma unroll
                for (int bj = 0; bj < 2; ++bj)
#pragma unroll
                    for (int n = 0; n < 2; ++n) *(f32x4*)(rowp + bj * HALF + n * 16) = acc[ai][bj][m][n]; }
    }
};
struct EpiBf16 { static constexpr bool PERM = true; static constexpr bool STAGED = false; bf16_t* O; int ldc; const float* rowscale;
    template <class Prob> __device__ __forceinline__ void operator()(const f32x4 (&acc)[2][2][4][2], const Prob& P, const Unit& u, int wr, int wc, int fr, int fq) const {
        const int row0 = P.orow0(u) + wr * 64 + fr, col0 = u.pn * BM + wc * 32 + 8 * fq;
#pragma unroll
        for (int ai = 0; ai < 2; ++ai)
#pragma unroll
            for (int m = 0; m < 4; ++m) { const int row = row0 + ai * HALF + m * 16; bf16_t* rowp = O + (size_t)row * ldc + col0; const float rs = rowscale ? rowscale[row] : 1.0f;
#pragma unroll
                for (int bj = 0; bj < 2; ++bj) { const f32x4 v0 = acc[ai][bj][m][0] * rs, v1 = acc[ai][bj][m][1] * rs;
                    u32x4 w; w.x = cvtpk(v0[0], v0[1]); w.y = cvtpk(v0[2], v0[3]); w.z = cvtpk(v1[0], v1[1]); w.w = cvtpk(v1[2], v1[3]);
                    *(u32x4*)(rowp + bj * HALF) = w; } }
    }
};
struct EpiIn1 { static constexpr bool PERM = true; static constexpr bool STAGED = false; bf16_t* QK; bf16_t* V; bf16_t* G; bf16_t* RRp;
    template <class Prob> __device__ __forceinline__ void operator()(const f32x4 (&acc)[2][2][4][2], const Prob& P, const Unit& u, int wr, int wc, int fr, int fq) const {
        const int t = u.pn >> 2; bf16_t* base = (t == 0) ? QK : (t == 1) ? V : (t == 2) ? G : RRp; const int ldc = (t == 3) ? 256 : 1024;
        const int row0 = P.orow0(u) + wr * 64 + fr, col0 = (u.pn & 3) * BM + wc * 32 + 8 * fq;
#pragma unroll
        for (int ai = 0; ai < 2; ++ai)
#pragma unroll
            for (int m = 0; m < 4; ++m) { const int row = row0 + ai * HALF + m * 16; bf16_t* rowp = base + (size_t)row * ldc + col0;
#pragma unroll
                for (int bj = 0; bj < 2; ++bj) { const f32x4 v0 = acc[ai][bj][m][0], v1 = acc[ai][bj][m][1];
                    u32x4 w; w.x = cvtpk(v0[0], v0[1]); w.y = cvtpk(v0[2], v0[3]); w.z = cvtpk(v1[0], v1[1]); w.w = cvtpk(v1[2], v1[3]);
                    *(u32x4*)(rowp + bj * HALF) = w; } }
    }
};
struct EpiQA { static constexpr bool PERM = true; static constexpr bool STAGED = false; bf16_t* O; const float* rstd; const float* tab16; float qscale;
    template <class Prob> __device__ __forceinline__ void operator()(const f32x4 (&acc)[2][2][4][2], const Prob& P, const Unit& u, int wr, int wc, int fr, int fq) const {
        const int row0 = P.orow0(u) + wr * 64 + fr, col0 = u.pn * BM + wc * 32 + 8 * fq;
        const bool ropet = (u.pn == 2);
#pragma unroll
        for (int ai = 0; ai < 2; ++ai)
#pragma unroll
            for (int m = 0; m < 4; ++m) { const int row = row0 + ai * HALF + m * 16; bf16_t* rowp = O + (size_t)row * N_QA + col0; const float rs = rstd[row] * qscale;
                f32x4 cs0 = {1.f, 1.f, 1.f, 1.f}, sn0 = {0.f, 0.f, 0.f, 0.f};
                if (ropet && row < RL) { const int tt = row & (SEQ - 1); const int pos = (fq >> 1) ? (tt & 63) : (tt >> 6); const int i0 = 4 * (fq & 1);
                    cs0 = *(const f32x4*)(tab16 + pos * 8 + i0); sn0 = *(const f32x4*)(tab16 + 512 + pos * 8 + i0); }
#pragma unroll
                for (int bj = 0; bj < 2; ++bj) { f32x4 v0 = acc[ai][bj][m][0] * rs, v1 = acc[ai][bj][m][1] * rs;
                    if (ropet) {
                        const f32x4 a = v0, b = v1;
                        v0[0] = a[0] * cs0[0] - a[1] * sn0[0]; v0[1] = a[1] * cs0[0] + a[0] * sn0[0];
                        v0[2] = a[2] * cs0[1] - a[3] * sn0[1]; v0[3] = a[3] * cs0[1] + a[2] * sn0[1];
                        v1[0] = b[0] * cs0[2] - b[1] * sn0[2]; v1[1] = b[1] * cs0[2] + b[0] * sn0[2];
                        v1[2] = b[2] * cs0[3] - b[3] * sn0[3]; v1[3] = b[3] * cs0[3] + b[2] * sn0[3]; }
                    u32x4 w; w.x = cvtpk(v0[0], v0[1]); w.y = cvtpk(v0[2], v0[3]); w.z = cvtpk(v1[0], v1[1]); w.w = cvtpk(v1[2], v1[3]);
                    *(u32x4*)(rowp + bj * HALF) = w; } }
    }
};
struct EpiSwiglu { static constexpr bool PERM = false; static constexpr bool STAGED = false; bf16_t* Hh; int ldh;
    template <class Prob> __device__ __forceinline__ void operator()(const f32x4 (&acc)[2][2][4][2], const Prob& P, const Unit& u, int wr, int wc, int fr, int fq) const {
        const int row0 = P.orow0(u) + wr * 64 + fr, col0 = (u.pn * BM + wc * 32) / 2 + 4 * fq;
#pragma unroll
        for (int ai = 0; ai < 2; ++ai)
#pragma unroll
            for (int m = 0; m < 4; ++m) { bf16_t* rowp = Hh + (size_t)(row0 + ai * HALF + m * 16) * ldh + col0;
#pragma unroll
                for (int bj = 0; bj < 2; ++bj) { const f32x4 g = acc[ai][bj][m][0], up = acc[ai][bj][m][1];
                    u32x2 w; w.x = cvtpk(swiglu_f(g[0], up[0], -1.4426950408889634f), swiglu_f(g[1], up[1], -1.4426950408889634f)); w.y = cvtpk(swiglu_f(g[2], up[2], -1.4426950408889634f), swiglu_f(g[3], up[3], -1.4426950408889634f));
                    *(u32x2*)(rowp + bj * (HALF / 2)) = w; } }
    }
};
struct EpiSwiglu8 { static constexpr bool PERM = false; static constexpr bool STAGED = true; unsigned char* Hh; int ldh;
    template <class Prob> __device__ __forceinline__ void staged(const f32x4 (&acc)[2][2][4][2], const Prob& P, const Unit& u, int wr, int wc, int fr, int fq, LAS unsigned char* stg, int tid) const {
        LAS unsigned char* sg = stg + wr * 8192;
        const int t = tid & 255;
        unsigned char* gbase = Hh + (size_t)(P.orow0(u) + wr * 64) * ldh + (size_t)u.pn * 128;
#pragma unroll
        for (int ai = 0; ai < 2; ++ai) {
#pragma unroll
            for (int m = 0; m < 4; ++m) { const int row = m * 16 + fr;
#pragma unroll
                for (int bj = 0; bj < 2; ++bj) { const f32x4 g = acc[ai][bj][m][0], up = acc[ai][bj][m][1]; const int p = bj * 4 + wc;
                    *(LAS unsigned*)(sg + row * 128 + ((p ^ (row & 7)) << 4) + 4 * fq) = pack_fp8x4(swiglu_f(g[0], up[0], -0.18033688011112042f), swiglu_f(g[1], up[1], -0.18033688011112042f), swiglu_f(g[2], up[2], -0.18033688011112042f), swiglu_f(g[3], up[3], -0.18033688011112042f)); } }
            asm volatile("s_waitcnt lgkmcnt(0)" ::: "memory"); __builtin_amdgcn_s_barrier(); asm volatile("" ::: "memory");
#pragma unroll
            for (int j = 0; j < 2; ++j) { const int row = (t >> 3) + 32 * j, p = t & 7;
                const u32x4 v = *(const LAS u32x4*)(sg + row * 128 + ((p ^ (row & 7)) << 4));
                *(u32x4*)(gbase + (size_t)(ai * HALF + row) * ldh + p * 16) = v; }
            if (ai == 0) { asm volatile("s_waitcnt lgkmcnt(0)" ::: "memory"); __builtin_amdgcn_s_barrier(); asm volatile("" ::: "memory"); }
        }
    }
};
}

struct Frame {
    LAS unsigned char* lds;
    unsigned char* ws;
    int tid, lane, wave, vcu, G;
};
template <class T> __device__ __forceinline__ T* wsp(const Frame& F, size_t off) { return (T*)(F.ws + off); }

__device__ __forceinline__ void load_row(const float* p, int lane, f32x4 (&v)[4]) {
    const f32x4* r = (const f32x4*)p + lane;
#pragma unroll
    for (int j = 0; j < 4; ++j) v[j] = r[64 * j];
}
__device__ __forceinline__ void load_row_bf16(const bf16_t* p, int lane, f32x4 (&v)[4]) {
#pragma unroll
    for (int j = 0; j < 4; ++j) { const u32x2 w = *(const u32x2*)(p + 4 * lane + 256 * j); v[j][0] = bflo(w.x); v[j][1] = bfhi(w.x); v[j][2] = bflo(w.y); v[j][3] = bfhi(w.y); }
}
__device__ __forceinline__ float row_ssq(const f32x4 (&v)[4]) { float s = 0.f;
#pragma unroll
    for (int j = 0; j < 4; ++j) s += (v[j][0] * v[j][0] + v[j][1] * v[j][1]) + (v[j][2] * v[j][2] + v[j][3] * v[j][3]);
    return wave_sum(s); }
__device__ __forceinline__ void norm_mod_store(const f32x4 (&h)[4], const float* g, const float* sh, const float* sc, bf16_t* urow, int lane, f32x4 (&uo)[4], unsigned char* u8row = nullptr) {
    const float rstd = __builtin_amdgcn_rsqf(row_ssq(h) * (1.0f / D) + EPS);
#pragma unroll
    for (int j = 0; j < 4; ++j) { const int c = 4 * lane + 256 * j; const f32x4 gg = *(const f32x4*)(g + c), s1 = *(const f32x4*)(sc + c), s0 = *(const f32x4*)(sh + c);
        const f32x4 uu = (h[j] * rstd * gg) * (1.0f + s1) + s0; uo[j] = uu;
        if (u8row) *(unsigned*)(u8row + c) = pack_fp8x4(4.0f * uu[0], 4.0f * uu[1], 4.0f * uu[2], 4.0f * uu[3]);
        else { u32x2 w; w.x = cvtpk(uu[0], uu[1]); w.y = cvtpk(uu[2], uu[3]); *(u32x2*)(urow + c) = w; } }
}
__device__ __forceinline__ int row_bidx(int row) { return row < RL ? (row >> 12) : 4; }

__device__ __forceinline__ void glds16(const void* gsrc, unsigned lds_dst) { unsigned keep;
    asm volatile("s_mov_b32 %0, m0\n\ts_mov_b32 m0, %2\n\ts_nop 0\n\tglobal_load_lds_dwordx4 %1, off\n\ts_mov_b32 m0, %0" : "=&s"(keep) : "v"(gsrc), "s"(lds_dst) : "memory"); }
__device__ __forceinline__ float max3f(float a, float b, float c) { float r; asm("v_max3_f32 %0, %1, %2, %3" : "=v"(r) : "v"(a), "v"(b), "v"(c)); return r; }
#define WAIT_BAR(N) asm volatile("s_waitcnt vmcnt(" #N ") lgkmcnt(0)\n\ts_barrier" ::: "memory")
template <int DQK> struct AttnSrc {
    const bf16_t* Q; int qpitch; const bf16_t* Qr;
    const bf16_t* Kn; int kpitch; const bf16_t* Kr; int krpitch;
    const bf16_t* V; int vpitch;
    bf16_t* O; int opitch;
};
__device__ __forceinline__ s16x4 vtr(const LAS unsigned char* p) { typedef short v4i16_t __attribute__((ext_vector_type(4))); return __builtin_bit_cast(s16x4, __builtin_amdgcn_ds_read_tr16_b64_v4i16((LAS v4i16_t*)p)); }
__device__ __forceinline__ int attn_krow(int kt, int lat0, int ctx0) { return kt < 64 ? lat0 + kt * 64 : ctx0 + (kt - 64) * 64; }
__device__ __forceinline__ f32x16 mfma_first(bf16x8 a, bf16x8 b, const f32x16& c) { f32x16 d; asm volatile("s_nop 4\n\tv_mfma_f32_32x32x16_bf16 %0, %1, %2, %3" : "=&v"(d) : "v"(a), "v"(b), "v"(c)); return d; }
template <int DQK>
__device__ __forceinline__ void attn_unit(const Frame& F, const AttnSrc<DQK>& S, int q0, int lat0, int ctx0, int kt0, int kt1) {
    constexpr int NKS = DQK / 16, KB = DQK * 128, SLOT = KB + 8192;
    constexpr float THR = 8.0f;
    const int lane = F.lane, wid = F.wave, r32 = lane & 31, hi = lane >> 5;
    LAS unsigned char* lds = F.lds;
    constexpr bool QLDS = false;
    bf16x8 qf[QLDS ? 1 : NKS];
    LAS unsigned char* qfl = lds + 4 * SLOT + wid * (NKS * 1024) + lane * 16;
    { const bf16_t* qrow = S.Q + (size_t)(q0 + wid * 32 + r32) * S.qpitch;
#pragma unroll
      for (int ks = 0; ks < 4; ++ks) { const bf16x8 v = *(const bf16x8*)(qrow + ks * 16 + hi * 8); if (QLDS) *(LAS bf16x8*)(qfl + ks * 1024) = v; else qf[ks] = v; }
      if (DQK == 96) { const bf16_t* qr = S.Qr + (size_t)(q0 + wid * 32 + r32) * S.qpitch;
#pragma unroll
          for (int ks = 4; ks < NKS; ++ks) { const bf16x8 v = *(const bf16x8*)(qr + (ks - 4) * 16 + hi * 8); if (QLDS) *(LAS bf16x8*)(qfl + ks * 1024) = v; else qf[ks] = v; } } }
    const unsigned lds0 = (unsigned)(size_t)lds;
    auto dma = [&](int kt, int slot) {
        const int krow = attn_krow(kt, lat0, ctx0);
        const unsigned sb = lds0 + slot * SLOT;
        glds16(S.Kn + (size_t)(krow + lane) * S.kpitch + wid * 8, (unsigned)__builtin_amdgcn_readfirstlane(sb + wid * 1024));
        if (DQK == 96 && wid < 4) glds16(S.Kr + (size_t)(krow + lane) * S.krpitch + wid * 8, (unsigned)__builtin_amdgcn_readfirstlane(sb + (8 + wid) * 1024));
        glds16(S.V + (size_t)(krow + 16 * (wid & 3) + (lane >> 2)) * S.vpitch + (wid >> 2) * 32 + (lane & 3) * 8, (unsigned)__builtin_amdgcn_readfirstlane(sb + KB + wid * 1024));
    };
    auto wait_bar = [&](bool inflight) {
        if (!inflight) { WAIT_BAR(0); } else if (DQK == 96 && wid < 4) { WAIT_BAR(3); } else { WAIT_BAR(2); }
    };
    f32x16 oT[2]; f32x16 negm;
#pragma unroll
    for (int r = 0; r < 16; ++r) { oT[0][r] = 0.f; oT[1][r] = 0.f; negm[r] = 0.f; }
    float mrun = 0.f, lrun = 0.f;
    const int vlane = ((lane >> 4) & 1) * 32 + (lane & 3) * 8 + (4 * hi + ((lane & 15) >> 2)) * 64;
    auto qk = [&](int slot, f32x16& p0, f32x16& p1) {
        const LAS unsigned char* kb = lds + slot * SLOT + hi * 1024 + r32 * 16;
        p0 = negm; p1 = negm;
        bf16x8 ka = *(const LAS bf16x8*)(kb), kc = *(const LAS bf16x8*)(kb + 512);
#pragma unroll
        for (int ks = 0; ks < NKS; ++ks) {
            bf16x8 na = ka, nc = kc;
            if (ks + 1 < NKS) { na = *(const LAS bf16x8*)(kb + (ks + 1) * 2048); nc = *(const LAS bf16x8*)(kb + (ks + 1) * 2048 + 512); }
            const bf16x8 qv = QLDS ? *(const LAS bf16x8*)(qfl + ks * 1024) : qf[QLDS ? 0 : ks];
            p0 = __builtin_amdgcn_mfma_f32_32x32x16_bf16(ka, qv, p0, 0, 0, 0);
            p1 = __builtin_amdgcn_mfma_f32_32x32x16_bf16(kc, qv, p1, 0, 0, 0);
            ka = na; kc = nc;
        }
    };
    auto tilemax = [&](f32x16& p0, f32x16& p1) -> float {
        asm volatile("s_nop 15\n\ts_nop 7" : "+v"(p0), "+v"(p1));
        float a = max3f(p0[0], p0[1], p1[0]), b = max3f(p0[2], p0[3], p1[1]); a = max3f(a, p1[2], p1[3]);
#pragma unroll
        for (int r = 4; r < 16; r += 4) { a = max3f(a, p0[r], p0[r + 1]); b = max3f(b, p0[r + 2], p0[r + 3]); a = max3f(a, p1[r], p1[r + 1]); b = max3f(b, p1[r + 2], p1[r + 3]); }
        float tm = fmaxf(a, b);
        auto rr = __builtin_amdgcn_permlane32_swap(__float_as_uint(tm), __float_as_uint(tm), false, false); return fmaxf(__uint_as_float(rr[0]), __uint_as_float(rr[1]));
    };
    auto step = [&](f32x16& c0, f32x16& c1, f32x16& n0, f32x16& n1, int slot_c, int slot_n) {
        const float tm = tilemax(c0, c1);
        if (__any(tm > THR)) {
            const float dl = fmaxf(tm, 0.f); mrun += dl; const float al = __builtin_amdgcn_exp2f(-dl); lrun *= al;
#pragma unroll
            for (int r = 0; r < 16; ++r) { c0[r] -= dl; c1[r] -= dl; negm[r] = -mrun; oT[0][r] *= al; oT[1][r] *= al; }
        }
        float rs = 0.f;
        {
            const LAS unsigned char* kb = lds + slot_n * SLOT + hi * 1024 + r32 * 16;
            bf16x8 ka = *(const LAS bf16x8*)(kb), kc = *(const LAS bf16x8*)(kb + 512);
#pragma unroll
            for (int ks = 0; ks < NKS; ++ks) {
                bf16x8 na = ka, nc = kc;
                if (ks + 1 < NKS) { na = *(const LAS bf16x8*)(kb + (ks + 1) * 2048); nc = *(const LAS bf16x8*)(kb + (ks + 1) * 2048 + 512); }
                if (ks == 0) { n0 = mfma_first(ka, qf[0], negm); n1 = mfma_first(kc, qf[0], negm); }
                else { n0 = __builtin_amdgcn_mfma_f32_32x32x16_bf16(ka, qf[ks], n0, 0, 0, 0);
                       n1 = __builtin_amdgcn_mfma_f32_32x32x16_bf16(kc, qf[ks], n1, 0, 0, 0); }
                ka = na; kc = nc;
#pragma unroll
                for (int r = (16 * ks) / NKS; r < (16 * (ks + 1)) / NKS; ++r) { c0[r] = __builtin_amdgcn_exp2f(c0[r]); c1[r] = __builtin_amdgcn_exp2f(c1[r]); rs += c0[r] + c1[r]; }
            }
        }
        lrun += rs;
        bf16x8 pf[4];
        { u32x4 w;
          w.x = cvtpk(c0[0], c0[1]); w.y = cvtpk(c0[2], c0[3]); w.z = cvtpk(c0[4], c0[5]); w.w = cvtpk(c0[6], c0[7]); pf[0] = __builtin_bit_cast(bf16x8, w);
          w.x = cvtpk(c0[8], c0[9]); w.y = cvtpk(c0[10], c0[11]); w.z = cvtpk(c0[12], c0[13]); w.w = cvtpk(c0[14], c0[15]); pf[1] = __builtin_bit_cast(bf16x8, w);
          w.x = cvtpk(c1[0], c1[1]); w.y = cvtpk(c1[2], c1[3]); w.z = cvtpk(c1[4], c1[5]); w.w = cvtpk(c1[6], c1[7]); pf[2] = __builtin_bit_cast(bf16x8, w);
          w.x = cvtpk(c1[8], c1[9]); w.y = cvtpk(c1[10], c1[11]); w.z = cvtpk(c1[12], c1[13]); w.w = cvtpk(c1[14], c1[15]); pf[3] = __builtin_bit_cast(bf16x8, w); }
        const LAS unsigned char* vb = lds + slot_c * SLOT + KB + vlane;
        s16x4 lo = vtr(vb), hh = vtr(vb + 512);
#pragma unroll
        for (int i = 0; i < 8; ++i) {
            const int d0 = i >> 2, ks = i & 3;
            s16x4 nlo = lo, nhh = hh;
            if (i + 1 < 8) { const int o2 = ((i + 1) >> 2) * 4096 + ((i + 1) & 3) * 1024; nlo = vtr(vb + o2); nhh = vtr(vb + o2 + 512); }
            const bf16x8 vf = (bf16x8){lo[0], lo[1], lo[2], lo[3], hh[0], hh[1], hh[2], hh[3]};
            oT[d0] = __builtin_amdgcn_mfma_f32_32x32x16_bf16(vf, pf[ks], oT[d0], 0, 0, 0);
            lo = nlo; hh = nhh;
        }
    };
    dma(kt0, 0); dma(kt0 + 1, 1); dma(kt0 + 2, 2);
    wait_bar(true);
    f32x16 pA0, pA1, pB0, pB1;
    qk(0, pA0, pA1);
    { mrun = tilemax(pA0, pA1);
#pragma unroll
      for (int r = 0; r < 16; ++r) negm[r] = -mrun;
      qk(0, pA0, pA1); }
    int sc = 0;
    for (int kt = kt0; kt < kt1; kt += 2) {
        { const int s1 = (sc + 1) & 3, s3 = (sc + 3) & 3;
          if (kt + 3 < kt1) dma(kt + 3, s3);
          step(pA0, pA1, pB0, pB1, sc, s1);
          wait_bar(kt + 3 < kt1);
          sc = s1; }
        { const int s1 = (sc + 1) & 3, s3 = (sc + 3) & 3;
          if (kt + 4 < kt1) dma(kt + 4, s3);
          step(pB0, pB1, pA0, pA1, sc, s1);
          wait_bar(kt + 4 < kt1);
          sc = s1; }
    }
    { auto rr = __builtin_amdgcn_permlane32_swap(__float_as_uint(lrun), __float_as_uint(lrun), false, false); lrun = __uint_as_float(rr[0]) + __uint_as_float(rr[1]); }
    const float inv = 1.0f / lrun;
    bf16_t* orow = S.O + (size_t)(q0 + wid * 32 + r32) * S.opitch;
#pragma unroll
    for (int d0 = 0; d0 < 2; ++d0)
#pragma unroll
        for (int g = 0; g < 4; ++g) { u32x2 w; w.x = cvtpk(oT[d0][4 * g] * inv, oT[d0][4 * g + 1] * inv); w.y = cvtpk(oT[d0][4 * g + 2] * inv, oT[d0][4 * g + 3] * inv);
            *(u32x2*)(orow + 32 * d0 + 8 * g + 4 * hi) = w; }
}

__device__ __forceinline__ int sig5(int c) { return (c & ~12) | ((c & 8) >> 1) | ((c & 4) << 1); }

__global__ void __launch_bounds__(512, 2) mk_fwd(Args args) {
    extern __shared__ __attribute__((aligned(16))) unsigned char lds_raw[];
    Frame F;
    F.lds = (LAS unsigned char*)lds_raw; F.ws = args.ws;
    F.tid = threadIdx.x; F.lane = F.tid & 63; F.wave = __builtin_amdgcn_readfirstlane(F.tid >> 6);
    F.G = gridDim.x; { const int bx = blockIdx.x; F.vcu = (F.G % 8 == 0) ? (bx % 8) * (F.G / 8) + bx / 8 : bx; }
    volatile LAS unsigned* MISC = (volatile LAS unsigned*)(F.lds + LDSCTL_OFF);
    if (F.tid < 64) MISC[F.tid] = 0u;
    __syncthreads();
    unsigned* ctl = wsp<unsigned>(F, O_CTL);
#if MK_ONE_LAUNCH
    XcdBarrier bar = xcd_barrier_post(ctl + CW_BAR, MISC + 8);
#define GRID_BAR() xcd_barrier(bar)
#else
#define GRID_BAR() do {} while (0)
#endif
    const int lo = args.ph_lo, hi_ph = args.ph_hi;
#define IN(k) (lo <= (k) && (k) < hi_ph)
#define SEAM(k) do { if (IN(k) && IN((k) + 1)) GRID_BAR(); } while (0)
    const int lane = F.lane, wave = F.wave, tid = F.tid;
    const int gw = F.vcu * 8 + wave, NGW = F.G * 8;

    const float* x_in = args.in[I_X]; const float* ctx_in = args.in[I_CTX];
    float* MODV = wsp<float>(F, O_MODV);
    float* TAB16 = wsp<float>(F, O_TAB16); float* TAB32 = wsp<float>(F, O_TAB32);
    float* HC = wsp<float>(F, O_HC);
    bf16_t* U = wsp<bf16_t>(F, O_U);
    float* Y = wsp<float>(F, O_Y);
    const float* normg = args.in[I_NORMG];
#define MV(layer, bidx, k) (MODV + ((size_t)((layer) * 5 + (bidx)) * 6 + (k)) * D)

    if (IN(0)) {
        {
            LAS float* sc = (LAS float*)F.lds;
            LAS float* red = sc + 5 * 1024;
            for (int i = tid; i < 5 * 1024; i += 512) { const int b = i >> 10, k = i & 1023; const float cv = (b < 4) ? args.in[I_C][b * 1024 + k] : args.in[I_CCTX][k]; sc[i] = cv / (1.0f + __expf(-cv)); }
            __syncthreads();
            for (int unit = F.vcu; unit < 192; unit += F.G) {
                const int layer = unit / 96, cb = unit % 96, col = cb * 64 + lane;
                const float* W = args.in[I_MODW] + (size_t)layer * D * 6144 + col;
                float a0 = 0.f, a1 = 0.f, a2 = 0.f, a3 = 0.f, a4 = 0.f;
#pragma unroll 16
                for (int kk = 0; kk < 128; ++kk) { const int k = wave * 128 + kk; const float w = W[(size_t)k * 6144];
                    a0 += sc[k] * w; a1 += sc[1024 + k] * w; a2 += sc[2048 + k] * w; a3 += sc[3072 + k] * w; a4 += sc[4096 + k] * w; }
                red[(wave * 5 + 0) * 64 + lane] = a0; red[(wave * 5 + 1) * 64 + lane] = a1; red[(wave * 5 + 2) * 64 + lane] = a2; red[(wave * 5 + 3) * 64 + lane] = a3; red[(wave * 5 + 4) * 64 + lane] = a4;
                __syncthreads();
                if (tid < 320) { const int b = tid >> 6, cc = tid & 63; float s = 0.f;
#pragma unroll
                    for (int w = 0; w < 8; ++w) s += red[(w * 5 + b) * 64 + cc];
                    MODV[(size_t)(layer * 5 + b) * 6144 + cb * 64 + cc] = s + args.in[I_MODB][layer * 6144 + cb * 64 + cc]; }
                __syncthreads();
            }
        }
        if (blockIdx.x == 0) {
            for (int i = tid; i < 64 * 8; i += 512) { const int pos = i >> 3, f = i & 7; const float fr = powf(10000.0f, -(float)f / 8.0f), a = (float)pos * fr; TAB16[i] = cosf(a); TAB16[512 + i] = sinf(a); }
            for (int i = tid; i < 64 * 16; i += 512) { const int pos = i >> 4, f = i & 15; const float fr = powf(10000.0f, -(float)f / 16.0f), a = (float)pos * fr; TAB32[i] = cosf(a); TAB32[1024 + i] = sinf(a); }
        }
        {
            LAS float* scr = (LAS float*)(F.lds + wave * 16640);
            int base = 0;
            auto run = [&](const Conv& c) { const int n = (c.K / 64) * (c.Ndst / 32); for (int it = gw - base; it < n; it += NGW) { if (it >= 0) conv_item(c, it, scr, lane); }
                base = (base + n) % NGW; };
            auto run64 = [&](const Conv64& c) { conv64_run(c, scr, lane, gw, NGW, base); };
            run64(Conv64{args.in[I_FWG], args.in[I_FWU], FFN, 1024, N_GU0, wsp<bf16_t>(F, O_WGU0), 3, 0, 0, 64.0f, 1});
            run64(Conv64{args.in[I_FWD], nullptr, 1024, FFN, 1024, wsp<bf16_t>(F, O_WD0), 0, 1024, 0, 1.0f, 0});
            run64(Conv64{args.in[I_GWIN], nullptr, 3104, 1024, N_IN1, wsp<bf16_t>(F, O_WIN1), 0, 3104, 512, 0.08838834764831845f, 0});
            run64(Conv64{args.in[I_GWOUT], nullptr, 1024, 1024, 1024, wsp<bf16_t>(F, O_WOUT1), 0, 1024, 0, 1.0f, 0});
            run64(Conv64{args.in[I_AWOUT], nullptr, 1024, 1024, 1024, wsp<bf16_t>(F, O_WOUT0), 0, 1024, 0, 1.0f, 0});
            run(Conv{args.in[I_AWIN], nullptr, 1440, 1024, N_IN0, wsp<bf16_t>(F, O_WIN0), 1, nullptr});
            run(Conv{args.in[I_AWUQ], nullptr, 768, 384, N_QA, wsp<bf16_t>(F, O_WUQ), 2, args.in[I_AQN]});
            run(Conv{args.in[I_AWUKV], nullptr, 1024, 256, N_KVA, wsp<bf16_t>(F, O_WUKV), 0, args.in[I_AKVN]});
        }
    }
    SEAM(0);

    if (IN(1)) {
        for (int row = gw; row < R; row += NGW) {
            const float* hp = row < RL ? x_in + (size_t)row * D : ctx_in + (size_t)(row - RL) * D;
            f32x4 h[4], uo[4]; load_row(hp, lane, h);
            const int b = row_bidx(row);
            norm_mod_store(h, normg + 0 * D, MV(0, b, 0), MV(0, b, 1), U + (size_t)row * D, lane, uo);
        }
    }
    SEAM(1);

    if (IN(2)) {
        pg8::DenseProb P{U, wsp<bf16_t>(F, O_WIN0), 1024, 1024, 1024, {}}; P.ord.init(R / 256, N_IN0 / 256, F.G, (int)blockIdx.x);
        pg8::EpiBf16 E{wsp<bf16_t>(F, O_Z0), N_IN0, nullptr};
        pg8::gemm_phase(F.lds, P, E);
    }
    SEAM(2);

    if (IN(3)) {
        const bf16_t* Z0 = wsp<bf16_t>(F, O_Z0);
        float* RSQ = wsp<float>(F, O_RSTDQ); float* RSKV = wsp<float>(F, O_RSTDKV);
        bf16_t* QB = wsp<bf16_t>(F, O_QB); bf16_t* KBp = wsp<bf16_t>(F, O_KB); bf16_t* KR = wsp<bf16_t>(F, O_KR);
        const float* qkn = args.in[I_AQKN];
        for (int row = gw; row < R; row += NGW) {
            const unsigned* z32 = (const unsigned*)(Z0 + (size_t)row * N_IN0);
            float s = 0.f;
#pragma unroll
            for (int j = 0; j < 3; ++j) { const unsigned w = z32[lane + 64 * j]; const float a = bflo(w), b = bfhi(w); s += a * a + b * b; }
            s = wave_sum(s);
            float s2 = 0.f;
#pragma unroll
            for (int j = 0; j < 2; ++j) { const unsigned w = z32[192 + lane + 64 * j]; const float a = bflo(w), b = bfhi(w); s2 += a * a + b * b; }
            s2 = wave_sum(s2);
            if (lane == 0) { RSQ[row] = __builtin_amdgcn_rsqf(s * (1.0f / 384.0f) + EPS); RSKV[row] = __builtin_amdgcn_rsqf(s2 * (1.0f / 256.0f) + EPS); }
            const bool lat = row < RL; const int tt = row & (SEQ - 1);
#pragma unroll
            for (int which = 0; which < 2; ++which) {
                if (which == 1 && lane >= 16) break;
                const u32x4 w4 = *(const u32x4*)(Z0 + (size_t)row * N_IN0 + (which ? 1152 : 640) + lane * 8);
                float v[8] = {bflo(w4.x), bfhi(w4.x), bflo(w4.y), bfhi(w4.y), bflo(w4.z), bfhi(w4.z), bflo(w4.w), bfhi(w4.w)};
                float ss = 0.f;
#pragma unroll
                for (int j = 0; j < 8; ++j) ss += v[j] * v[j];
                ss += __shfl_xor(ss, 1); ss += __shfl_xor(ss, 2); ss += __shfl_xor(ss, 4);
                const float rstd = __builtin_amdgcn_rsqf(ss * (1.0f / 64.0f) + EPS);
                const int jp = lane & 7, half = jp >> 2, i0 = 4 * (jp & 3);
                const float* gn = qkn + which * 64 + half * 32;
#pragma unroll
                for (int pz = 0; pz < 4; ++pz) { v[2 * pz] *= rstd * gn[i0 + pz]; v[2 * pz + 1] *= rstd * gn[16 + i0 + pz]; }
                if (lat) { const int pos = half ? (tt & 63) : (tt >> 6);
                    const f32x4 cs = *(const f32x4*)(TAB32 + pos * 16 + i0), sn = *(const f32x4*)(TAB32 + 1024 + pos * 16 + i0);
#pragma unroll
                    for (int pz = 0; pz < 4; ++pz) { const float a = v[2 * pz], b = v[2 * pz + 1]; v[2 * pz] = a * cs[pz] - b * sn[pz]; v[2 * pz + 1] = b * cs[pz] + a * sn[pz]; } }
                const float osc = which ? 1.0f : 0.125f * LOG2E;
                u32x4 o; o.x = cvtpk(v[0] * osc, v[1] * osc); o.y = cvtpk(v[2] * osc, v[3] * osc); o.z = cvtpk(v[4] * osc, v[5] * osc); o.w = cvtpk(v[6] * osc, v[7] * osc);
                if (which == 0) *(u32x4*)(QB + (size_t)row * 512 + lane * 8) = o; else *(u32x4*)(KBp + (size_t)row * 128 + lane * 8) = o;
            }
            if (lane < 4) {
                const u32x4 w4 = *(const u32x4*)(Z0 + (size_t)row * N_IN0 + 1408 + lane * 8);
                float v[8] = {bflo(w4.x), bfhi(w4.x), bflo(w4.y), bfhi(w4.y), bflo(w4.z), bfhi(w4.z), bflo(w4.w), bfhi(w4.w)};
                if (lat) { const int half = lane >> 1, i0 = 4 * (lane & 1); const int pos = half ? (tt & 63) : (tt >> 6);
                    const f32x4 cs = *(const f32x4*)(TAB16 + pos * 8 + i0), sn = *(const f32x4*)(TAB16 + 512 + pos * 8 + i0);
#pragma unroll
                    for (int pz = 0; pz < 4; ++pz) { const float a = v[2 * pz], b = v[2 * pz + 1]; v[2 * pz] = a * cs[pz] - b * sn[pz]; v[2 * pz + 1] = b * cs[pz] + a * sn[pz]; } }
                u32x4 o; o.x = cvtpk(v[0], v[1]); o.y = cvtpk(v[2], v[3]); o.z = cvtpk(v[4], v[5]); o.w = cvtpk(v[6], v[7]);
                *(u32x4*)(KR + (size_t)row * 32 + lane * 8) = o;
            }
        }
    }
    SEAM(3);

    if (IN(4)) {
        { pg8::DenseProb P{wsp<bf16_t>(F, O_Z0), wsp<bf16_t>(F, O_WUQ), 384, N_IN0, 384, {}}; P.ord.init(R / 256, N_QA / 256, F.G, (int)blockIdx.x);
          pg8::EpiQA E{wsp<bf16_t>(F, O_QA), wsp<float>(F, O_RSTDQ), TAB16, 0.10206207261596577f * LOG2E};
          pg8::gemm_phase(F.lds, P, E); }
        { pg8::DenseProb P{wsp<bf16_t>(F, O_Z0) + 384, wsp<bf16_t>(F, O_WUKV), 256, N_IN0, 256, {}}; P.ord.init(R / 256, N_KVA / 256, F.G, (int)((blockIdx.x + F.G - (204 % F.G)) % F.G));
          pg8::EpiBf16 E{wsp<bf16_t>(F, O_KVA), N_KVA, wsp<float>(F, O_RSTDKV)};
          pg8::gemm_phase(F.lds, P, E); }
    }
    SEAM(4);

    if (IN(5)) {
        const bf16_t* QA = wsp<bf16_t>(F, O_QA); const bf16_t* KVA = wsp<bf16_t>(F, O_KVA); const bf16_t* QB = wsp<bf16_t>(F, O_QB);
        const bf16_t* KBp = wsp<bf16_t>(F, O_KB); const bf16_t* KR = wsp<bf16_t>(F, O_KR); const bf16_t* Z0 = wsp<bf16_t>(F, O_Z0);
        bf16_t* AO = wsp<bf16_t>(F, O_AO);
        for (int i = 0; i < 3; ++i) {
            int b, hh, q0, kt0, kt1;
            if (i < 2) { const int m = i * 256 + F.vcu; b = m >> 7; hh = (m >> 4) & 7; q0 = b * SEQ + (m & 15) * 256; kt0 = 0; kt1 = 68; }
            else { if (F.vcu >= 32) break; b = (F.vcu >> 3) & 3; hh = F.vcu & 7; q0 = RL + b * CTX; kt0 = 64; kt1 = 68; }
            const int lat0 = b * SEQ, ctx0 = RL + b * CTX;
            AttnSrc<96> S{QA + hh * 64, N_QA, QA + 512 + hh * 32, KVA + hh * 128, N_KVA, KR, 32, KVA + hh * 128 + 64, N_KVA, AO + hh * 64, D};
            attn_unit<96>(F, S, q0, lat0, ctx0, kt0, kt1);
        }
        for (int i = 0; i < 3; ++i) {
            int b, hh, q0, kt0, kt1;
            if (i < 2) { const int m = i * 256 + F.vcu; b = m >> 7; hh = (m >> 4) & 7; q0 = b * SEQ + (m & 15) * 256; kt0 = 0; kt1 = 68; }
            else { if (F.vcu < 32 || F.vcu >= 64) break; b = (F.vcu >> 3) & 3; hh = F.vcu & 7; q0 = RL + b * CTX; kt0 = 64; kt1 = 68; }
            const int lat0 = b * SEQ, ctx0 = RL + b * CTX; const int kvh = hh >> 2;
            AttnSrc<64> S{QB + hh * 64, 512, nullptr, KBp + kvh * 64, 128, nullptr, 0, Z0 + 1280 + kvh * 64, N_IN0, AO + 512 + hh * 64, D};
            attn_unit<64>(F, S, q0, lat0, ctx0, kt0, kt1);
        }
    }
    SEAM(5);

    if (IN(6)) {
        pg8::DenseProb P{wsp<bf16_t>(F, O_AO), wsp<bf16_t>(F, O_WOUT0), 1024, 1024, 1024, {}}; P.ord.init(RL / 256, 4, F.G, (int)blockIdx.x);
        pg8::EpiBf16 E{(bf16_t*)Y, D, nullptr};
        pg8::gemm_phase(F.lds, P, E);
    }
    SEAM(6);


    auto post0 = [&](int row) {
            const float* hp = row < RL ? x_in + (size_t)row * D : ctx_in + (size_t)(row - RL) * D;
            float* ho = row < RL ? args.out + (size_t)row * D : HC + (size_t)(row - RL) * D;
            const int b = row_bidx(row);
            f32x4 y[4], h[4], uo[4]; load_row_bf16((const bf16_t*)Y + (size_t)row * D, lane, y); load_row(hp, lane, h);
            const float rstd = __builtin_amdgcn_rsqf(row_ssq(y) * (1.0f / D) + EPS);
#pragma unroll
            for (int j = 0; j < 4; ++j) { const int c = 4 * lane + 256 * j; const f32x4 g = *(const f32x4*)(normg + 1 * D + c), mg = *(const f32x4*)(MV(0, b, 2) + c);
                h[j] = h[j] + mg * (y[j] * rstd * g); *(f32x4*)(ho + c) = h[j]; }
            norm_mod_store(h, normg + 2 * D, MV(0, b, 3), MV(0, b, 4), nullptr, lane, uo, wsp<unsigned char>(F, O_U) + (size_t)row * D);
    };
    if (IN(7)) {
        const bool split = F.G > 32;
        if (!split || blockIdx.x < 16) {
            pg8::DenseProb P{wsp<bf16_t>(F, O_AO) + (size_t)RL * D, wsp<bf16_t>(F, O_WOUT0), 1024, 1024, 1024, {}}; P.ord.init(RC / 256, 4, split ? 16 : F.G, (int)blockIdx.x);
            pg8::EpiBf16 E{(bf16_t*)Y + (size_t)RL * D, D, nullptr};
            pg8::gemm_phase(F.lds, P, E);
        }
        if (!split) { for (int row = gw; row < RL; row += NGW) post0(row); }
        else if (blockIdx.x >= 16) { for (int row = ((int)blockIdx.x - 16) * 8 + wave; row < RL; row += (F.G - 16) * 8) post0(row); }
    }
    SEAM(7);
    if (IN(8)) { for (int row = RL + gw; row < R; row += NGW) post0(row); }
    SEAM(8);


    if (IN(9)) {
        pg8::DenseProb8<125, 121> P{wsp<unsigned char>(F, O_U), wsp<unsigned char>(F, O_WGU0), 512, 512, 1024, {}}; P.ord.init(R / 256, N_GU0 / 256, F.G, (int)blockIdx.x);
        pg8::EpiSwiglu E{wsp<bf16_t>(F, O_H0), FFN};
        pg8::gemm_phase(F.lds, P, E);
    }
    SEAM(9);
    if (IN(10)) {
        pg8::DenseProb P{wsp<bf16_t>(F, O_H0), wsp<bf16_t>(F, O_WD0), FFN, FFN, FFN, {}}; P.ord.init(RL / 256, 4, F.G, (int)blockIdx.x);
        pg8::EpiBf16 E{(bf16_t*)Y, D, nullptr};
        pg8::gemm_phase(F.lds, P, E);
    }
    SEAM(10);


    auto post1 = [&](int row) {
            float* hp = row < RL ? args.out + (size_t)row * D : HC + (size_t)(row - RL) * D;
            const int b = row_bidx(row);
            f32x4 y[4], h[4], uo[4]; load_row_bf16((const bf16_t*)Y + (size_t)row * D, lane, y); load_row(hp, lane, h);
            const float rstd = __builtin_amdgcn_rsqf(row_ssq(y) * (1.0f / D) + EPS);
#pragma unroll
            for (int j = 0; j < 4; ++j) { const int c = 4 * lane + 256 * j; const f32x4 g = *(const f32x4*)(normg + 3 * D + c), mg = *(const f32x4*)(MV(0, b, 5) + c);
                h[j] = h[j] + mg * (y[j] * rstd * g); *(f32x4*)(hp + c) = h[j]; }
            norm_mod_store(h, normg + 4 * D, MV(1, b, 0), MV(1, b, 1), U + (size_t)row * D, lane, uo);
    };
    if (IN(11)) {
        const bool split = F.G > 32;
        if (!split || blockIdx.x < 16) {
            pg8::DenseProb P{wsp<bf16_t>(F, O_H0) + (size_t)RL * FFN, wsp<bf16_t>(F, O_WD0), FFN, FFN, FFN, {}}; P.ord.init(RC / 256, 4, split ? 16 : F.G, (int)blockIdx.x);
            pg8::EpiBf16 E{(bf16_t*)Y + (size_t)RL * D, D, nullptr};
            pg8::gemm_phase(F.lds, P, E);
        }
        if (!split) { for (int row = gw; row < RL; row += NGW) post1(row); }
        else if (blockIdx.x >= 16) { for (int row = ((int)blockIdx.x - 16) * 8 + wave; row < RL; row += (F.G - 16) * 8) post1(row); }
    }
    SEAM(11);
    if (IN(12)) { for (int row = RL + gw; row < R; row += NGW) post1(row); }
    SEAM(12);


    if (IN(13)) {
        pg8::DenseProb P{U, wsp<bf16_t>(F, O_WIN1), 1024, 1024, 1024, {}}; P.ord.init(R / 256, N_IN1 / 256, F.G, (int)blockIdx.x);
        pg8::EpiIn1 E{wsp<bf16_t>(F, O_QK1), wsp<bf16_t>(F, O_V1), wsp<bf16_t>(F, O_G1), wsp<bf16_t>(F, O_RR)};
        pg8::gemm_phase(F.lds, P, E);
    }
    SEAM(13);

    if (IN(14)) {
        const bf16_t* QK1 = wsp<bf16_t>(F, O_QK1); const bf16_t* V1 = wsp<bf16_t>(F, O_V1); const bf16_t* RRp = wsp<bf16_t>(F, O_RR);
        bf16_t* QDd[2] = {wsp<bf16_t>(F, O_QDF), wsp<bf16_t>(F, O_QDB)}; bf16_t* KId[2] = {wsp<bf16_t>(F, O_KIF), wsp<bf16_t>(F, O_KIB)}; bf16_t* KTd[2] = {wsp<bf16_t>(F, O_KTF), wsp<bf16_t>(F, O_KTB)};
        bf16_t* VT = wsp<bf16_t>(F, O_VT); float* ECL = wsp<float>(F, O_ECL);
        LAS float* tot = (LAS float*)F.lds;
        const int dkp = tid & 63, dk0 = 2 * dkp, tq = tid >> 6;
        int hh_loaded = -1; float w2[2][16][2], bg[2][2];
        for (int item = F.vcu; item < 544 * 4; item += F.G) {
            const int rc = item >> 2, hh = item & 3, row0 = rc * 32;
            if (hh != hh_loaded) {
                hh_loaded = hh;
#pragma unroll
                for (int d = 0; d < 2; ++d) { const f32x2_t bv = *(const f32x2_t*)(args.in[I_GBGATE] + d * 512 + hh * 128 + dk0); bg[d][0] = bv[0]; bg[d][1] = bv[1];
#pragma unroll
                    for (int j = 0; j < 16; ++j) { const f32x2_t wv = *(const f32x2_t*)(args.in[I_GGATE2] + (size_t)(d * 16 + j) * 512 + hh * 128 + dk0); w2[d][j][0] = wv[0]; w2[d][j][1] = wv[1]; } }
            }
            float a[2][4][2];
#pragma unroll
            for (int i = 0; i < 4; ++i) { const int row = row0 + 4 * tq + i;
                const u32x4* rp = (const u32x4*)(RRp + (size_t)row * 256);
#pragma unroll
                for (int d = 0; d < 2; ++d) { const u32x4 r0 = rp[2 * d], r1 = rp[2 * d + 1];
                    const float rv[16] = {bflo(r0.x), bfhi(r0.x), bflo(r0.y), bfhi(r0.y), bflo(r0.z), bfhi(r0.z), bflo(r0.w), bfhi(r0.w), bflo(r1.x), bfhi(r1.x), bflo(r1.y), bfhi(r1.y), bflo(r1.z), bfhi(r1.z), bflo(r1.w), bfhi(r1.w)};
#pragma unroll
                    for (int c = 0; c < 2; ++c) { float z = bg[d][c];
#pragma unroll
                        for (int j = 0; j < 16; ++j) z += rv[j] * w2[d][j][c];
                        a[d][i][c] = (fminf(z, 0.f) - __logf(1.0f + __expf(-fabsf(z)))) * (1.0f / 16.0f); } } }
            float cf[4][2], sb[4][2];
#pragma unroll
            for (int c = 0; c < 2; ++c) { float sfw = 0.f;
#pragma unroll
                for (int i = 0; i < 4; ++i) { sfw += a[0][i][c]; cf[i][c] = sfw; }
                float sbw = 0.f;
#pragma unroll
                for (int i = 3; i >= 0; --i) { sbw += a[1][i][c]; sb[i][c] = sbw; } }
            *(LAS f32x2_t*)(tot + (0 * 8 + tq) * 128 + dk0) = (f32x2_t){cf[3][0], cf[3][1]};
            *(LAS f32x2_t*)(tot + (1 * 8 + tq) * 128 + dk0) = (f32x2_t){sb[0][0], sb[0][1]};
            __syncthreads();
            float offF[2] = {0.f, 0.f}, offB[2] = {0.f, 0.f}, clF[2] = {0.f, 0.f}, clB[2] = {0.f, 0.f};
#pragma unroll
            for (int g = 0; g < 8; ++g) { const f32x2_t tf = *(const LAS f32x2_t*)(tot + (0 * 8 + g) * 128 + dk0), tb = *(const LAS f32x2_t*)(tot + (1 * 8 + g) * 128 + dk0);
#pragma unroll
                for (int c = 0; c < 2; ++c) { clF[c] += tf[c]; clB[c] += tb[c]; if (g < tq) offF[c] += tf[c]; if (g > tq) offB[c] += tb[c]; } }
            __syncthreads();
            const int pc = hh * 128 + (dk0 & ~31) + sig5(dk0 & 31);
#pragma unroll
            for (int i = 0; i < 4; ++i) { const int row = row0 + 4 * tq + i;
                const unsigned qw = *(const unsigned*)(QK1 + (size_t)row * D + hh * 128 + dk0), kw = *(const unsigned*)(QK1 + (size_t)row * D + 512 + hh * 128 + dk0);
                const float q[2] = {bflo(qw), bfhi(qw)}, k[2] = {bflo(kw), bfhi(kw)};
                float qdv[2][2], kiv[2][2];
#pragma unroll
                for (int c = 0; c < 2; ++c) { const float cF = offF[c] + cf[i][c], cB = offB[c] + sb[i][c];
                    qdv[0][c] = q[c] * __expf(cF); kiv[0][c] = k[c] * __expf(-cF); qdv[1][c] = q[c] * __expf(cB); kiv[1][c] = k[c] * __expf(-cB); }
#pragma unroll
                for (int d = 0; d < 2; ++d) {
                    *(unsigned*)(QDd[d] + (size_t)row * 512 + pc) = cvtpk(qdv[d][0], qdv[d][1]);
                    const unsigned kp = cvtpk(kiv[d][0], kiv[d][1]);
                    *(unsigned*)(KId[d] + (size_t)row * 512 + pc) = kp;
                } }
            if (tq == 0) { *(f32x2_t*)(ECL + ((size_t)(rc * 2 + 0) * 4 + hh) * 256 + dk0) = (f32x2_t){__expf(clF[0]), __expf(clF[1])};
                           *(f32x2_t*)(ECL + ((size_t)(rc * 2 + 1) * 4 + hh) * 256 + dk0) = (f32x2_t){__expf(clB[0]), __expf(clB[1])}; }
            { const int dv = tid & 255, th = tid >> 8; unsigned vw[8];
#pragma unroll
              for (int i = 0; i < 16; ++i) { const unsigned bv = V1[(size_t)(row0 + 16 * th + i) * D + hh * 256 + dv];
                  const int cc = sig5(i);
                  if (cc & 1) vw[cc >> 1] |= bv << 16; else vw[cc >> 1] = bv; }
              bf16_t* vp = VT + ((size_t)rc * 1024 + hh * 256 + dv) * 32 + 16 * th;
              u32x4 o0; o0.x = vw[0]; o0.y = vw[1]; o0.z = vw[2]; o0.w = vw[3]; *(u32x4*)vp = o0;
              u32x4 o1; o1.x = vw[4]; o1.y = vw[5]; o1.z = vw[6]; o1.w = vw[7]; *(u32x4*)(vp + 8) = o1; }
        }
    }
    SEAM(14);

    if (IN(15)) {
        const int xl = blockIdx.x & 7, jj = blockIdx.x >> 3;
        const bool scan_role = (jj & 1) == 0;
        const int nscan = ((F.G >> 3) + 1) / 2 * 8, nconv = F.G - nscan;
        if ((F.G & 7) == 0 && nconv > 0 && !scan_role) {
            LAS float* scr = (LAS float*)(F.lds + wave * 16640);
            const int cidx = xl * (F.G >> 4) + (jj >> 1); int base = 0; const int gwi = cidx * 8 + wave, ngw = nconv * 8;
            for (int e = 0; e < NEXP; ++e) {
                conv64_run(Conv64{args.in[I_MWG] + (size_t)e * D * EXD, args.in[I_MWU] + (size_t)e * D * EXD, EXD, 1024, N_GU1, wsp<bf16_t>(F, O_WGU1) + (size_t)e * N_GU1 * 1024 / 2, 3, 0, 0, 64.0f, 1}, scr, lane, gwi, ngw, base);
                conv64_run(Conv64{args.in[I_MWD] + (size_t)e * EXD * D, nullptr, 1024, EXD, 1024, wsp<bf16_t>(F, O_WD1) + (size_t)e * 1024 * EXD / 2, 0, 1024, 1024, 64.0f, 1}, scr, lane, gwi, ngw, base);
            }
        } else {
        const bool split = (F.G & 7) == 0 && nconv > 0;
        const int sidx = split ? xl * ((F.G >> 4) + ((F.G >> 3) & 1)) + (jj >> 1) : F.vcu, nsw = split ? nscan : F.G;
        const bf16_t* VT = wsp<bf16_t>(F, O_VT); const float* ECL = wsp<float>(F, O_ECL);
        constexpr int SLOT = 8192 * 2 + 2 * 2048 + 1024;
        const int r32 = lane & 31, hi = lane >> 5;
        for (int unit = sidx; unit < 128; unit += nsw) {
            const int chain = unit >> 2, dvp = unit & 3, b = chain >> 3, hh = (chain >> 1) & 3, dir = chain & 1;
            const int dvb = dvp * 2 + (wave & 1);
            const bf16_t* QDp = wsp<bf16_t>(F, dir ? O_QDB : O_QDF); const bf16_t* KIp = wsp<bf16_t>(F, dir ? O_KIB : O_KIF);
            bf16_t* Odp = wsp<bf16_t>(F, dir ? O_OB : O_OF);
            auto rcof = [&](int step) { return step < 8 ? 512 + b * 8 + (dir ? 7 - step : step) : b * 128 + (dir ? 127 - (step - 8) : (step - 8)); };
            const unsigned lds0 = (unsigned)(size_t)F.lds;
            auto dma = [&](int step, int slot) {
                if (wave < 2) return;
                const int rc = rcof(step); const unsigned sb = lds0 + slot * SLOT;
#pragma unroll
                for (int i = 0; i < 4; ++i) { const int j = (wave - 2) + 6 * i; if (j >= 21) break;
                    if (j < 16) { const int p = j & 7; const int r = 4 * p + (lane >> 4), c = (lane & 15) ^ (r & 15);
                        glds16((j < 8 ? KIp : QDp) + (size_t)(rc * 32 + r) * 512 + hh * 128 + c * 8, (unsigned)__builtin_amdgcn_readfirstlane(sb + j * 1024)); }
                    else if (j < 20) { const int p = j - 16; const int r = 16 * (p & 1) + (lane >> 2), c = (lane & 3) ^ ((r >> 2) & 3);
                        glds16(VT + ((size_t)rc * 1024 + hh * 256 + (dvp * 2 + (p >> 1)) * 32 + r) * 32 + c * 8, (unsigned)__builtin_amdgcn_readfirstlane(sb + 16384 + p * 1024)); }
                    else glds16(ECL + ((size_t)(rc * 2 + dir) * 4 + hh) * 256 + lane * 4, (unsigned)__builtin_amdgcn_readfirstlane(sb + 20480)); }
            };
            auto wait_bar = [&](int ngrp) { if (wave < 2) { asm volatile("s_waitcnt lgkmcnt(0)\n\ts_barrier" ::: "memory"); }
                else if (ngrp == 0) { WAIT_BAR(0); } else if (ngrp == 1) { if (wave < 5) { WAIT_BAR(4); } else { WAIT_BAR(3); } } else { if (wave < 5) { WAIT_BAR(8); } else { WAIT_BAR(6); } } };
            f32x16 S4[4];
#pragma unroll
            for (int k = 0; k < 4; ++k)
#pragma unroll
                for (int r = 0; r < 16; ++r) S4[k][r] = 0.f;
            dma(0, 0); dma(1, 1); dma(2, 2);
            wait_bar(2);
            int slot = 0;
            for (int step = 0; step < 136; ++step) {
                if (step + 3 < 136) dma(step + 3, (slot + 3) & 3);
                if (wave < 2) {
                    const LAS unsigned char* sb = F.lds + slot * SLOT;
                    const int x15 = r32 & 15, x3 = (r32 >> 2) & 3;
                    const int trq = (lane & 15) >> 2, trp = lane & 3, trpp = ((trp & 1) << 1) | (trp >> 1), trg = (lane >> 4) & 1;
                    const LAS unsigned char* vbase = sb + 16384 + wave * 2048;
                    bf16x8 qdF[8], kiF[8];
#pragma unroll
                    for (int k = 0; k < 8; ++k) { qdF[k] = *(const LAS bf16x8*)(sb + 8192 + r32 * 256 + (((2 * k + hi) ^ x15) << 4)); kiF[k] = *(const LAS bf16x8*)(sb + r32 * 256 + (((2 * k + hi) ^ x15) << 4)); }
                    const bf16x8 vF0 = *(const LAS bf16x8*)(vbase + r32 * 64 + ((hi ^ x3) << 4)), vF1 = *(const LAS bf16x8*)(vbase + r32 * 64 + (((2 + hi) ^ x3) << 4));
                    __builtin_amdgcn_sched_barrier(0);
                    f32x16 o;
#pragma unroll
                    for (int r = 0; r < 16; ++r) o[r] = 0.f;
                    if (step >= 8) {
                        f32x16 sc;
#pragma unroll
                        for (int r = 0; r < 16; ++r) sc[r] = 0.f;
#pragma unroll
                        for (int k = 0; k < 8; ++k) sc = __builtin_amdgcn_mfma_f32_32x32x16_bf16(kiF[k], qdF[k], sc, 0, 0, 0);
#pragma unroll
                        for (int r = 0; r < 16; ++r) { const int s = (r & 3) + 8 * (r >> 2) + 4 * hi; const bool keep = dir ? (s >= r32) : (s <= r32); sc[r] = keep ? sc[r] : 0.f; }
                        u32x4 w; bf16x8 pf0, pf1;
                        w.x = cvtpk(sc[0], sc[1]); w.y = cvtpk(sc[2], sc[3]); w.z = cvtpk(sc[4], sc[5]); w.w = cvtpk(sc[6], sc[7]); pf0 = __builtin_bit_cast(bf16x8, w);
                        w.x = cvtpk(sc[8], sc[9]); w.y = cvtpk(sc[10], sc[11]); w.z = cvtpk(sc[12], sc[13]); w.w = cvtpk(sc[14], sc[15]); pf1 = __builtin_bit_cast(bf16x8, w);
                        o = __builtin_amdgcn_mfma_f32_32x32x16_bf16(vF0, pf0, o, 0, 0, 0);
                        o = __builtin_amdgcn_mfma_f32_32x32x16_bf16(vF1, pf1, o, 0, 0, 0);
#pragma unroll
                        for (int blk = 0; blk < 4; ++blk)
#pragma unroll
                            for (int s2 = 0; s2 < 2; ++s2) { u32x4 ws4; ws4.x = cvtpk(S4[blk][8 * s2], S4[blk][8 * s2 + 1]); ws4.y = cvtpk(S4[blk][8 * s2 + 2], S4[blk][8 * s2 + 3]);
                                ws4.z = cvtpk(S4[blk][8 * s2 + 4], S4[blk][8 * s2 + 5]); ws4.w = cvtpk(S4[blk][8 * s2 + 6], S4[blk][8 * s2 + 7]);
                                o = __builtin_amdgcn_mfma_f32_32x32x16_bf16(__builtin_bit_cast(bf16x8, ws4), qdF[2 * blk + s2], o, 0, 0, 0); }
                        const int rc = rcof(step);
                        bf16_t* op = Odp + (size_t)(rc * 32 + r32) * D + hh * 256 + dvb * 32 + 4 * hi;
#pragma unroll
                        for (int g = 0; g < 4; ++g) { u32x2 w2; w2.x = cvtpk(o[4 * g], o[4 * g + 1]); w2.y = cvtpk(o[4 * g + 2], o[4 * g + 3]); *(u32x2*)(op + 8 * g) = w2; }
                    }
#pragma unroll
                    for (int blk = 0; blk < 4; ++blk) {
                        bf16x8 kt0, kt1;
                        { const int chunk = 4 * blk + 2 * trg + (trpp >> 1); const int wb = (trpp & 1) * 8;
                          const int tl = 4 * hi + trq, th = tl + 8;
                          const LAS unsigned char* pl = sb + tl * 256 + ((chunk ^ tl) << 4) + wb; const LAS unsigned char* ph = sb + th * 256 + ((chunk ^ th) << 4) + wb;
                          const s16x4 a0 = vtr(pl), a1 = vtr(ph), b0 = vtr(pl + 4096), b1 = vtr(ph + 4096);
                          kt0 = (bf16x8){a0[0], a0[1], a0[2], a0[3], a1[0], a1[1], a1[2], a1[3]}; kt1 = (bf16x8){b0[0], b0[1], b0[2], b0[3], b1[0], b1[1], b1[2], b1[3]}; }
                        S4[blk] = __builtin_amdgcn_mfma_f32_32x32x16_bf16(kt0, vF0, S4[blk], 0, 0, 0);
                        S4[blk] = __builtin_amdgcn_mfma_f32_32x32x16_bf16(kt1, vF1, S4[blk], 0, 0, 0);
#pragma unroll
                        for (int g = 0; g < 4; ++g) { const f32x4 e4 = *(const LAS f32x4*)(sb + 20480 + (32 * blk + 8 * g + 4 * hi) * 4);
                            S4[blk][4 * g] *= e4[0]; S4[blk][4 * g + 1] *= e4[1]; S4[blk][4 * g + 2] *= e4[2]; S4[blk][4 * g + 3] *= e4[3]; }
                    }
                }
                wait_bar(step + 3 < 136 ? 2 : (step + 2 < 136 ? 1 : 0));
                slot = (slot + 1) & 3;
            }
        }
        if (!split) {
            LAS float* scr = (LAS float*)(F.lds + wave * 16640); int base = 0;
            for (int e = 0; e < NEXP; ++e) {
                conv64_run(Conv64{args.in[I_MWG] + (size_t)e * D * EXD, args.in[I_MWU] + (size_t)e * D * EXD, EXD, 1024, N_GU1, wsp<bf16_t>(F, O_WGU1) + (size_t)e * N_GU1 * 1024 / 2, 3, 0, 0, 64.0f, 1}, scr, lane, gw, NGW, base);
                conv64_run(Conv64{args.in[I_MWD] + (size_t)e * EXD * D, nullptr, 1024, EXD, 1024, wsp<bf16_t>(F, O_WD1) + (size_t)e * 1024 * EXD / 2, 0, 1024, 1024, 64.0f, 1}, scr, lane, gw, NGW, base);
            }
        }
        }
    }
    SEAM(15);

    if (IN(16)) {
        const bf16_t* OFp = wsp<bf16_t>(F, O_OF); const bf16_t* OBp = wsp<bf16_t>(F, O_OB); const bf16_t* G1 = wsp<bf16_t>(F, O_G1); bf16_t* GA = wsp<bf16_t>(F, O_GA);
        const float* on = args.in[I_GONORM];
        for (int row = gw; row < RL; row += NGW) {
            const u32x4* pf = (const u32x4*)(OFp + (size_t)row * D + lane * 16); const u32x4* pb = (const u32x4*)(OBp + (size_t)row * D + lane * 16); const u32x4* pg = (const u32x4*)(G1 + (size_t)row * D + lane * 16);
            float v[16], gv[16];
#pragma unroll
            for (int q = 0; q < 2; ++q) { const u32x4 a = pf[q], bq = pb[q], gq = pg[q]; const unsigned aw[4] = {a.x, a.y, a.z, a.w}, bw[4] = {bq.x, bq.y, bq.z, bq.w}, gw4[4] = {gq.x, gq.y, gq.z, gq.w};
#pragma unroll
                for (int j = 0; j < 4; ++j) { v[8 * q + 2 * j] = bflo(aw[j]) + bflo(bw[j]); v[8 * q + 2 * j + 1] = bfhi(aw[j]) + bfhi(bw[j]); gv[8 * q + 2 * j] = bflo(gw4[j]); gv[8 * q + 2 * j + 1] = bfhi(gw4[j]); } }
            float ss = 0.f;
#pragma unroll
            for (int j = 0; j < 16; ++j) ss += v[j] * v[j];
            ss += __shfl_xor(ss, 1); ss += __shfl_xor(ss, 2); ss += __shfl_xor(ss, 4); ss += __shfl_xor(ss, 8);
            const float rstd = __builtin_amdgcn_rsqf(ss * (1.0f / 256.0f) + EPS);
            const int c0 = (lane & 15) * 16;
            unsigned ow[8];
#pragma unroll
            for (int j = 0; j < 8; ++j) { const float a = v[2 * j] * rstd * on[c0 + 2 * j] * silu_f(gv[2 * j]), bq = v[2 * j + 1] * rstd * on[c0 + 2 * j + 1] * silu_f(gv[2 * j + 1]); ow[j] = cvtpk(a, bq); }
            u32x4* po = (u32x4*)(GA + (size_t)row * D + lane * 16);
            u32x4 o0; o0.x = ow[0]; o0.y = ow[1]; o0.z = ow[2]; o0.w = ow[3]; po[0] = o0; u32x4 o1; o1.x = ow[4]; o1.y = ow[5]; o1.z = ow[6]; o1.w = ow[7]; po[1] = o1;
        }
    }
    SEAM(16);

    if (IN(17)) {
        pg8::DenseProb P{wsp<bf16_t>(F, O_GA), wsp<bf16_t>(F, O_WOUT1), 1024, 1024, 1024, {}}; P.ord.init(RL / 256, 4, F.G, (int)blockIdx.x);
        pg8::EpiBf16 E{(bf16_t*)Y, D, nullptr};
        pg8::gemm_phase(F.lds, P, E);
    }
    SEAM(17);

    if (IN(18)) {
        int* SEL = wsp<int>(F, O_SEL); int* ROWTOK = wsp<int>(F, O_ROWTOK);
        LAS float* wr_l = (LAS float*)F.lds;
        LAS int* se = (LAS int*)(F.lds + 32768);
        LAS float* sw = (LAS float*)(F.lds + 32768 + 512);
        LAS int* sbase = (LAS int*)(F.lds + 32768 + 1024);
        for (int i = tid; i < 8192; i += 512) wr_l[i] = args.in[I_MROUTER][i];
        __syncthreads();
        for (int tile = F.vcu; tile < RL / 64; tile += F.G) {
            for (int rr = 0; rr < 8; ++rr) {
                const int lr = wave * 8 + rr, row = tile * 64 + lr; const int b = row >> 12;
                float* hp = args.out + (size_t)row * D;
                f32x4 y[4], h[4], uo[4]; load_row_bf16((const bf16_t*)Y + (size_t)row * D, lane, y); load_row(hp, lane, h);
                const float rstd = __builtin_amdgcn_rsqf(row_ssq(y) * (1.0f / D) + EPS);
#pragma unroll
                for (int j = 0; j < 4; ++j) { const int c = 4 * lane + 256 * j; const f32x4 g = *(const f32x4*)(normg + 5 * D + c), mg = *(const f32x4*)(MV(1, b, 2) + c);
                    h[j] = h[j] + mg * (y[j] * rstd * g); *(f32x4*)(hp + c) = h[j]; }
                norm_mod_store(h, normg + 6 * D, MV(1, b, 3), MV(1, b, 4), nullptr, lane, uo, wsp<unsigned char>(F, O_U) + (size_t)row * D);
                float lg[8];
#pragma unroll
                for (int e = 0; e < 8; ++e) lg[e] = 0.f;
#pragma unroll
                for (int j = 0; j < 4; ++j)
#pragma unroll
                    for (int q = 0; q < 4; ++q) { const int k = 4 * lane + 256 * j + q; const LAS f32x4* wp = (const LAS f32x4*)(wr_l + k * 8); const f32x4 w0 = wp[0], w1 = wp[1]; const float uv = uo[j][q];
                        lg[0] += uv * w0[0]; lg[1] += uv * w0[1]; lg[2] += uv * w0[2]; lg[3] += uv * w0[3]; lg[4] += uv * w1[0]; lg[5] += uv * w1[1]; lg[6] += uv * w1[2]; lg[7] += uv * w1[3]; }
#pragma unroll
                for (int e = 0; e < 8; ++e) lg[e] = wave_sum(lg[e]) + args.in[I_MBROUTER][e];
                int e0 = 0; float l0 = lg[0];
#pragma unroll
                for (int e = 1; e < 8; ++e) if (lg[e] > l0) { l0 = lg[e]; e0 = e; }
                int e1 = -1; float l1 = -3.0e38f;
#pragma unroll
                for (int e = 0; e < 8; ++e) if (e != e0 && lg[e] > l1) { l1 = lg[e]; e1 = e; }
                const float p1 = __expf(l1 - l0), w0n = 1.0f / (1.0f + p1), w1n = p1 / (1.0f + p1);
                if (lane == 0) { se[lr * 2] = e0; se[lr * 2 + 1] = e1; sw[lr * 2] = w0n; sw[lr * 2 + 1] = w1n; }
            }
            __syncthreads();
            if (tid < 8) { int c = 0; for (int r2 = 0; r2 < 64; ++r2) c += (se[2 * r2] == tid) + (se[2 * r2 + 1] == tid);
                sbase[tid] = (int)__hip_atomic_fetch_add(ctl + CW_CNT + 64 * tid, (unsigned)c, RLX_AGENT); }
            __syncthreads();
            if (tid < 64) { const int e0 = se[2 * tid], e1 = se[2 * tid + 1]; int r0 = 0, r1 = 0;
                for (int r2 = 0; r2 < tid; ++r2) { const int a0 = se[2 * r2], a1 = se[2 * r2 + 1]; r0 += (a0 == e0) + (a1 == e0); r1 += (a0 == e1) + (a1 == e1); }
                const int p0 = sbase[e0] + r0, p1 = sbase[e1] + r1, tok = tile * 64 + tid;
                ROWTOK[e0 * CAPE + p0] = tok; ROWTOK[e1 * CAPE + p1] = tok;
                int* sp = SEL + (size_t)tok * 8; sp[0] = e0; sp[1] = p0; sp[2] = e1; sp[3] = p1; sp[4] = __float_as_int(sw[2 * tid]); sp[5] = __float_as_int(sw[2 * tid + 1]); }
            __syncthreads();
        }
    }
    SEAM(18);

    pg8::MoeTiles MT;
    if (IN(19) || IN(20) || IN(21)) {
        int acc = 0; MT.tp8 = 0ull; MT.c4a = 0ull; MT.c4b = 0ull;
#pragma unroll
        for (int e = 0; e < 8; ++e) { const int c = (int)__builtin_amdgcn_readfirstlane((int)__hip_atomic_load(ctl + CW_CNT + 64 * e, RLX_AGENT));
            if (e < 4) MT.c4a |= (unsigned long long)(unsigned)c << (16 * e); else MT.c4b |= (unsigned long long)(unsigned)c << (16 * (e - 4));
            MT.tp8 |= (unsigned long long)(unsigned)acc << (8 * e); acc += (c + 255) >> 8; }
        MT.nt = acc;
    }
    if (IN(19)) {
        pg8::MoeGuProb P{wsp<unsigned char>(F, O_U), wsp<unsigned char>(F, O_WGU1), 512, 512, {}, MT, wsp<int>(F, O_ROWTOK)}; P.ord.init(MT.nt, N_GU1 / 256, F.G, (int)blockIdx.x);
        pg8::EpiSwiglu8 E{wsp<unsigned char>(F, O_HM), EXD};
        pg8::gemm_phase(F.lds, P, E);
    }
    SEAM(19);
    if (IN(20)) {
        pg8::MoeDnProb P{wsp<unsigned char>(F, O_HM), wsp<unsigned char>(F, O_WD1), EXD / 2, EXD / 2, {}, MT}; P.ord.init(MT.nt, 4, F.G, (int)blockIdx.x);
        pg8::EpiBf16 E{wsp<bf16_t>(F, O_YE), D, nullptr};
        pg8::gemm_phase(F.lds, P, E);
    }
    SEAM(20);
    if (IN(21)) {
        const int* SEL = wsp<int>(F, O_SEL); const bf16_t* YE = wsp<bf16_t>(F, O_YE);
        for (int row = gw; row < RL; row += NGW) {
            const int b = row >> 12; const int* sp = SEL + (size_t)row * 8;
            const int e0 = sp[0], p0 = sp[1], e1 = sp[2], p1 = sp[3]; const float w0 = __int_as_float(sp[4]), w1 = __int_as_float(sp[5]);
            const int t0 = pg8::moe_tp(MT, e0), t1 = pg8::moe_tp(MT, e1);
            const bf16_t* y0 = YE + ((size_t)t0 * 256 + p0) * D; const bf16_t* y1 = YE + ((size_t)t1 * 256 + p1) * D;
            float* hp = args.out + (size_t)row * D;
            f32x4 y[4], h[4]; load_row(hp, lane, h);
#pragma unroll
            for (int j = 0; j < 4; ++j) { const int c = 4 * lane + 256 * j; const u32x2 a = *(const u32x2*)(y0 + c), bq = *(const u32x2*)(y1 + c);
                y[j][0] = w0 * bflo(a.x) + w1 * bflo(bq.x); y[j][1] = w0 * bfhi(a.x) + w1 * bfhi(bq.x); y[j][2] = w0 * bflo(a.y) + w1 * bflo(bq.y); y[j][3] = w0 * bfhi(a.y) + w1 * bfhi(bq.y); }
            const float rstd = __builtin_amdgcn_rsqf(row_ssq(y) * (1.0f / D) + EPS);
#pragma unroll
            for (int j = 0; j < 4; ++j) { const int c = 4 * lane + 256 * j; const f32x4 g = *(const f32x4*)(normg + 7 * D + c), mg = *(const f32x4*)(MV(1, b, 5) + c);
                *(f32x4*)(hp + c) = h[j] + mg * (y[j] * rstd * g); }
        }
    }
#undef IN
#undef SEAM
#undef MV
}

constexpr int N_PHASES = 22;
extern "C" void kernel_launch(void* const* d_in, const int* in_sizes, int n_in, void* d_out, int out_size, void* d_ws, size_t ws_size, hipStream_t stream) {
    static int grid = 0;
    if (grid == 0) {
        if (n_in != 27 || out_size != RL * D || ws_size < WS_END) { fprintf(stderr, "kernel_launch: unexpected shapes n_in %d out %d ws %zu (need %zu)\n", n_in, out_size, ws_size, (size_t)WS_END); grid = -1; return; }
        int dev = 0, cus = 0, per_cu = 0;
        if (hipGetDevice(&dev) != hipSuccess || hipDeviceGetAttribute(&cus, hipDeviceAttributeMultiprocessorCount, dev) != hipSuccess) { grid = -1; return; }
        if (hipFuncSetAttribute((const void*)mk_fwd, hipFuncAttributeMaxDynamicSharedMemorySize, LDS_BYTES) != hipSuccess) { fprintf(stderr, "kernel_launch: hipFuncSetAttribute failed\n"); grid = -1; return; }
        if (hipOccupancyMaxActiveBlocksPerMultiprocessor(&per_cu, (const void*)mk_fwd, 512, LDS_BYTES) != hipSuccess || per_cu < 1) { fprintf(stderr, "kernel_launch: occupancy query says %d\n", per_cu); }
        (void)hipGetLastError();
        grid = cus;
        if (grid > 256) grid = 256;
    }
    if (grid < 0) return;
    (void)hipMemsetAsync((char*)d_ws + O_CTL, 0, CTL_BYTES, stream);
    Args a{};
    for (int i = 0; i < 27; ++i) a.in[i] = (const float*)d_in[i];
    a.out = (float*)d_out; a.ws = (unsigned char*)d_ws;
#if MK_ONE_LAUNCH
    a.ph_lo = 0; a.ph_hi = N_PHASES;
    hipLaunchKernelGGL(mk_fwd, dim3(grid), dim3(512), LDS_BYTES, stream, a);
#else
    for (int p = 0; p < N_PHASES; ++p) { a.ph_lo = p; a.ph_hi = p + 1; for (int rep = 0; rep < (p == MK_REP ? 2 : 1); ++rep) hipLaunchKernelGGL(mk_fwd, dim3(grid), dim3(512), LDS_BYTES, stream, a); }
#endif
}
```

```cpp
#include <hip/hip_runtime.h>
#include <cstdio>
#include <cstdint>

#ifndef MK_ONE_LAUNCH
#define MK_ONE_LAUNCH 1
#endif
#ifndef MK_EPI2
#define MK_EPI2 0
#endif
#ifndef MK_REP
#define MK_REP -1
#endif

#define LAS __attribute__((address_space(3)))
#define GAS __attribute__((address_space(1)))
typedef unsigned short bf16_t;
typedef short bf16x8 __attribute__((ext_vector_type(8)));
typedef short s16x4 __attribute__((ext_vector_type(4)));
typedef float f32x4 __attribute__((ext_vector_type(4)));
typedef float f32x16 __attribute__((ext_vector_type(16)));
typedef unsigned u32x4 __attribute__((ext_vector_type(4)));
typedef unsigned u32x2 __attribute__((ext_vector_type(2)));
typedef float f32x2_t __attribute__((ext_vector_type(2)));
typedef __bf16 bf16x2_t __attribute__((ext_vector_type(2)));
#define RLX_AGENT __ATOMIC_RELAXED, __HIP_MEMORY_SCOPE_AGENT

__device__ __forceinline__ unsigned cvtpk(float lo, float hi) { f32x2_t v = {lo, hi}; bf16x2_t b = __builtin_convertvector(v, bf16x2_t); return __builtin_bit_cast(unsigned, b); }
__device__ __forceinline__ bf16_t f2bf(float f) { return (bf16_t)(cvtpk(f, 0.f) & 0xffffu); }
__device__ __forceinline__ float bflo(unsigned w) { return __uint_as_float(w << 16); }
__device__ __forceinline__ float bfhi(unsigned w) { return __uint_as_float(w & 0xffff0000u); }
__device__ __forceinline__ float bf2f(bf16_t b) { return __uint_as_float(((unsigned)b) << 16); }
__device__ __forceinline__ float wave_sum(float v) {
#pragma unroll
    for (int o = 1; o < 64; o <<= 1) v += __shfl_xor(v, o);
    return v;
}
__device__ __forceinline__ float fast_exp(float x) { return __builtin_amdgcn_exp2f(x * 1.4426950408889634f); }
__device__ __forceinline__ float clamp8(float x) { return __builtin_amdgcn_fmed3f(x, -448.0f, 448.0f); }
__device__ __forceinline__ unsigned pack_fp8x4(float a, float b, float c, float d) { int w = __builtin_amdgcn_cvt_pk_fp8_f32(clamp8(a), clamp8(b), 0, false); w = __builtin_amdgcn_cvt_pk_fp8_f32(clamp8(c), clamp8(d), w, true); return (unsigned)w; }
__device__ __forceinline__ float swiglu_f(float gp, float up, float k) { return (gp * up) * __builtin_amdgcn_rcpf(__builtin_fmaf(__builtin_amdgcn_exp2f(gp), k, k)); }
__device__ __forceinline__ float silu_f(float g) { return g * __builtin_amdgcn_rcpf(1.0f + fast_exp(-g)); }

#define XB_TMO      128
#define XB_XCNT(j)  (256  + 64 * (j))
#define XB_XSUB(j)  (1280 + 64 * (j))
#define XB_XGEN(j)  (2304 + 64 * (j))
#define XB_TOP      3328
#define XB_TOPGEN   3392
#define XCD_BAR_WORDS 3456
#define XB_SPIN_CAP (1u << 18)
__device__ __forceinline__ unsigned xb_ld(unsigned* p)              { return __hip_atomic_load(p, __ATOMIC_RELAXED, __HIP_MEMORY_SCOPE_AGENT); }
__device__ __forceinline__ unsigned xb_add(unsigned* p, unsigned v) { return __hip_atomic_fetch_add(p, v, __ATOMIC_RELAXED, __HIP_MEMORY_SCOPE_AGENT); }
__device__ __forceinline__ unsigned xb_xcc_id() { return (unsigned)__builtin_amdgcn_s_getreg((3 << 11) | 20) & 0xFu; }
#define XB_SPIN(cond, bar) do { unsigned _sp = 0; while (cond) { __builtin_amdgcn_s_sleep(1); \
    if ((++_sp & 255u) == 0u) { if (xb_ld(&(bar)[XB_TMO])) break; if (_sp > XB_SPIN_CAP) { atomicAdd(&(bar)[XB_TMO], 1u); break; } } } } while (0)
struct XcdBarrier { unsigned* bar; unsigned x; volatile LAS unsigned* st; };
__device__ __forceinline__ XcdBarrier xcd_barrier_post(unsigned* bar, volatile LAS unsigned* st) {
    XcdBarrier b; b.bar = bar; b.x = xb_xcc_id(); b.st = st;
    if (threadIdx.x == 0) (void)xb_add(&bar[XB_XCNT(b.x)], 1u);
    return b;
}
__device__ __forceinline__ void xcd_barrier_complete(unsigned* bar, unsigned x, unsigned& nloc, unsigned& nx) {
    const unsigned G = gridDim.x * gridDim.y * gridDim.z;
    unsigned sum, cnt, mine, sp = 0u;
    for (;;) {
        sum = 0u; cnt = 0u; mine = 0u;
#pragma unroll
        for (unsigned j = 0; j < 16; ++j) { const unsigned c = xb_ld(&bar[XB_XCNT(j)]); sum += c; cnt += (c > 0u) ? 1u : 0u; mine = (j == x) ? c : mine; }
        if (sum == G) break;
        __builtin_amdgcn_s_sleep(1);
        if ((++sp & 255u) == 0u) { if (xb_ld(&bar[XB_TMO])) break; if (sp > XB_SPIN_CAP) { atomicAdd(&bar[XB_TMO], 1u); break; } }
    }
    nloc = mine > 0u ? mine : 1u; nx = cnt > 0u ? cnt : 1u;
}
__device__ __forceinline__ void xcd_barrier(const XcdBarrier& b) {
    asm volatile("s_waitcnt vmcnt(0)" ::: "memory");
    __syncthreads();
    if (threadIdx.x == 0) {
        unsigned* bar = b.bar;
        __builtin_amdgcn_s_waitcnt(0);
        unsigned nloc = b.st[0], nx = b.st[1];
        if (nloc == 0u) { xcd_barrier_complete(bar, b.x, nloc, nx); b.st[0] = nloc; b.st[1] = nx; }
        const unsigned old = xb_add(&bar[XB_XSUB(b.x)], 1u);
        const unsigned gen = old / nloc;
        if (old + 1u == (gen + 1u) * nloc) {
            __builtin_amdgcn_fence(__ATOMIC_RELEASE, "agent");
            asm volatile("s_waitcnt vmcnt(0)" ::: "memory");
            const unsigned og = xb_add(&bar[XB_TOP], 1u);
            const unsigned tg = og / nx;
            if (og + 1u == (tg + 1u) * nx) xb_add(&bar[XB_TOPGEN], 1u);
            else XB_SPIN(xb_ld(&bar[XB_TOPGEN]) == tg, bar);
            __builtin_amdgcn_fence(__ATOMIC_ACQUIRE, "agent");
            xb_add(&bar[XB_XGEN(b.x)], 1u);
            asm volatile("s_waitcnt vmcnt(0)" ::: "memory");
        } else {
            XB_SPIN(xb_ld(&bar[XB_XGEN(b.x)]) == gen, bar);
            __builtin_amdgcn_fence(__ATOMIC_ACQUIRE, "agent");
            asm volatile("s_waitcnt vmcnt(0)" ::: "memory");
        }
    }
    __syncthreads();
}

constexpr int D = 1024, NB = 4, SEQ = 4096, CTX = 256;
constexpr int RL = NB * SEQ;
constexpr int RC = NB * CTX;
constexpr int R = RL + RC;
constexpr float EPS = 1e-6f;
constexpr float LOG2E = 1.4426950408889634f;
constexpr int N_IN0 = 1536, N_QA = 768, N_KVA = 1024, FFN = 2816, N_GU0 = 2 * FFN, N_IN1 = 3328, EXD = 3584, N_GU1 = 2 * EXD, NEXP = 8;
constexpr int CAPE = 16384;

constexpr size_t MiB = 1u << 20;
constexpr size_t O_CTL = 0;
constexpr size_t CTL_BYTES = 65536;
constexpr int CW_BAR = 0;
constexpr int CW_CNT = 8192;
constexpr size_t O_MODV = 1 * MiB;
constexpr size_t O_TAB16 = O_MODV + 256 * 1024;
constexpr size_t O_TAB32 = O_TAB16 + 8192;
constexpr size_t O_RSTDQ = O_TAB32 + 16384;
constexpr size_t O_RSTDKV = O_RSTDQ + 81920;
constexpr size_t O_SEL = 2 * MiB;
constexpr size_t O_ROWTOK = 3 * MiB;
constexpr size_t O_WGU1 = 4 * MiB;
constexpr size_t O_YE = O_WGU1;
constexpr size_t O_WD1 = 116 * MiB;
constexpr size_t O_WIN1 = 172 * MiB;
constexpr size_t O_WOUT1 = 179 * MiB;
constexpr size_t O_WIN0 = 181 * MiB;
constexpr size_t O_WUQ = 184 * MiB;
constexpr size_t O_WUKV = 185 * MiB;
constexpr size_t O_WOUT0 = 186 * MiB;
constexpr size_t O_WGU0 = 188 * MiB;
constexpr size_t O_WD0 = 199 * MiB;
constexpr size_t O_HC = 205 * MiB;
constexpr size_t O_U = 209 * MiB;
constexpr size_t O_Y = 243 * MiB;
constexpr size_t O_Z0 = 311 * MiB;
constexpr size_t O_QA = 362 * MiB;
constexpr size_t O_KVA = 388 * MiB;
constexpr size_t O_QB = 422 * MiB;
constexpr size_t O_KB = 439 * MiB;
constexpr size_t O_KR = 444 * MiB;
constexpr size_t O_AO = 446 * MiB;
constexpr size_t O_H0 = 311 * MiB;
constexpr size_t O_QK1 = 311 * MiB;
constexpr size_t O_V1 = 345 * MiB;
constexpr size_t O_G1 = 379 * MiB;
constexpr size_t O_RR = 413 * MiB;
constexpr size_t O_QDF = 422 * MiB, O_KIF = 439 * MiB, O_KTF = 456 * MiB, O_QDB = 473 * MiB;
constexpr size_t O_KIB = 243 * MiB, O_KTB = 260 * MiB, O_VT = 277 * MiB;
constexpr size_t O_ECL = 490 * MiB;
constexpr size_t O_OF = O_QK1, O_OB = O_V1;
constexpr size_t O_GA = O_QDF;
constexpr size_t O_HM = 243 * MiB;
constexpr size_t WS_END = 495 * MiB;
static_assert(O_HM + (size_t)34816 * EXD * 2 <= 482 * MiB, "HM");
static_assert(O_RR + (size_t)R * 256 * 2 <= O_QDF, "RR");
static_assert(O_ECL + (size_t)544 * 8 * 1024 <= WS_END, "ECL");

constexpr int RING_BYTES = 131072;
constexpr int LDS_BYTES = 163840;
constexpr int LDSCTL_OFF = LDS_BYTES - 256;

struct Args {
    const float* in[27];
    float* out; unsigned char* ws;
    int ph_lo, ph_hi;
};
enum { I_X = 0, I_C, I_CTX, I_CCTX, I_MODW, I_MODB, I_NORMG, I_AWIN, I_AQN, I_AWUQ, I_AKVN, I_AWUKV, I_AQKN, I_AWOUT, I_GWIN, I_GGATE2, I_GBGATE, I_GONORM, I_GWOUT,
       I_FWG, I_FWU, I_FWD, I_MROUTER, I_MBROUTER, I_MWG, I_MWU, I_MWD };

struct Conv { const float* s0; const float* s1; int Nsrc; int K; int Ndst; bf16_t* dst; int mode; const float* kscale; };
__device__ __forceinline__ int ilv64(int p) { return (p >> 5) * 32 + (p & 1) * 16 + ((p & 31) >> 1); }
__device__ __forceinline__ int ilv32(int p) { return (p >> 4) * 16 + (p & 1) * 8 + ((p & 15) >> 1); }
__device__ __forceinline__ const float* conv_col(const Conv& c, int n, float& sc) {
    sc = 1.0f;
    switch (c.mode) {
    case 0: return c.s0 + n;
    case 1: {
        if (n < 640) return c.s0 + n;
        if (n < 1152) { const int hh = (n - 640) >> 6, p = (n - 640) & 63; return c.s0 + 672 + hh * 64 + ilv64(p); }
        if (n < 1280) { const int hh = (n - 1152) >> 6, p = (n - 1152) & 63; return c.s0 + 1184 + hh * 64 + ilv64(p); }
        if (n < 1408) return c.s0 + 1312 + (n - 1280);
        if (n < 1440) return c.s0 + 640 + ilv32(n - 1408);
        return nullptr; }
    case 2: {
        if (n < 512) return c.s0 + (n >> 6) * 96 + (n & 63);
        const int hh = (n - 512) >> 5, p = (n - 512) & 31; return c.s0 + hh * 96 + 64 + ilv32(p); }
    case 3: {
        const int G = n >> 5, j = n & 31; return (j < 16) ? c.s0 + 16 * G + j : c.s1 + 16 * G + (j - 16); }
    case 4: {
        if (n >= 3104) return nullptr;
        if (n < 512) sc = 0.08838834764831845f;
        return c.s0 + n; }
    }
    return nullptr;
}
__device__ __forceinline__ void conv_item(const Conv& c, int item, LAS float* scr, int lane) {
    const int nblk = c.Ndst / 32, kb = item / nblk, nb = item % nblk, k0 = 64 * kb, n0 = 32 * nb;
    float sc; const float* cp = conv_col(c, n0 + (lane & 31), sc);
    const int kh = lane >> 5;
#pragma unroll 16
    for (int i = 0; i < 32; ++i) { const int kk = 2 * i + kh; float v = 0.f;
        if (cp) { v = cp[(size_t)(k0 + kk) * c.Nsrc] * sc; if (c.kscale) v *= c.kscale[k0 + kk]; }
        scr[kk * 33 + (lane & 31)] = v; }
    asm volatile("s_waitcnt lgkmcnt(0)" ::: "memory");
    const int ch = lane & 7;
#pragma unroll
    for (int j = 0; j < 4; ++j) { const int n = (lane >> 3) + 8 * j; const LAS float* s = scr + (8 * ch) * 33 + n;
        u32x4 o; o.x = cvtpk(s[0 * 33], s[1 * 33]); o.y = cvtpk(s[2 * 33], s[3 * 33]); o.z = cvtpk(s[4 * 33], s[5 * 33]); o.w = cvtpk(s[6 * 33], s[7 * 33]);
        *(u32x4*)(c.dst + (size_t)(n0 + n) * c.K + k0 + 8 * ch) = o; }
    asm volatile("s_waitcnt lgkmcnt(0)" ::: "memory");
}

struct Conv64 { const float* s0; const float* s1; int Nsrc; int K; int Ndst; bf16_t* dst; int mode; int nvalid; int nscaled; float rscale; int f8; };
struct Conv64Geo { int k0, n0, nd; bool valid; float sc; const float* src; };
__device__ __forceinline__ Conv64Geo conv64_geo(const Conv64& c, int item, int lane) {
    Conv64Geo g; const int nblk = c.Ndst / 64, kb = item / nblk, nb = item % nblk; g.k0 = 64 * kb; g.n0 = 64 * nb;
    const int c4 = lane & 15, kr = lane >> 4; g.valid = true; g.sc = 1.0f;
    if (c.mode == 3) { const int cc = 4 * (c4 & 7); g.src = c.s0 + ((c4 < 8) ? (long)0 : (long)(c.s1 - c.s0)) + 32 * nb + cc; g.nd = 32 * (cc >> 4) + ((c4 < 8) ? 0 : 16) + (cc & 15); g.sc = c.rscale * ((c4 < 8) ? -1.4426950408889634f : 1.0f); }
    else { g.nd = 4 * c4; g.src = c.s0 + g.n0 + g.nd; g.valid = (g.n0 + g.nd) < c.nvalid; if (g.n0 + g.nd < c.nscaled) g.sc = c.rscale; }
    g.src += (size_t)(g.k0 + kr) * c.Nsrc;
    return g;
}
__device__ __forceinline__ void conv64_load(const Conv64& c, int item, int lane, f32x4 (&v)[16]) {
    const Conv64Geo g = conv64_geo(c, item, lane);
#pragma unroll
    for (int i = 0; i < 16; ++i) v[i] = g.valid ? *(const f32x4*)(g.src + (size_t)(4 * i) * c.Nsrc) : (f32x4){0.f, 0.f, 0.f, 0.f};
}
__device__ __forceinline__ void conv64_store(const Conv64& c, int item, LAS float* scr, int lane, const f32x4 (&v)[16]) {
    const Conv64Geo g = conv64_geo(c, item, lane); const int kr = lane >> 4, nd = g.nd, k0 = g.k0, n0 = g.n0; const float sc = g.sc;
#pragma unroll
    for (int i = 0; i < 16; ++i) { LAS float* p = scr + (4 * i + kr) * 65 + nd; p[0] = v[i][0] * sc; p[1] = v[i][1] * sc; p[2] = v[i][2] * sc; p[3] = v[i][3] * sc; }
    asm volatile("s_waitcnt lgkmcnt(0)" ::: "memory");
    if (c.f8) {
        const int ch = lane & 3; unsigned char* d8 = (unsigned char*)c.dst;
#pragma unroll
        for (int it = 0; it < 4; ++it) { const int r = it * 16 + (lane >> 2); const LAS float* sp = scr + (16 * ch) * 65 + r; u32x4 o;
            o.x = pack_fp8x4(sp[0 * 65], sp[1 * 65], sp[2 * 65], sp[3 * 65]); o.y = pack_fp8x4(sp[4 * 65], sp[5 * 65], sp[6 * 65], sp[7 * 65]);
            o.z = pack_fp8x4(sp[8 * 65], sp[9 * 65], sp[10 * 65], sp[11 * 65]); o.w = pack_fp8x4(sp[12 * 65], sp[13 * 65], sp[14 * 65], sp[15 * 65]);
            *(u32x4*)(d8 + (size_t)(n0 + r) * c.K + k0 + 16 * ch) = o; }
    } else {
    const int ch = lane & 7;
#pragma unroll
    for (int it = 0; it < 8; ++it) { const int r = it * 8 + (lane >> 3); const LAS float* sp = scr + (8 * ch) * 65 + r;
        u32x4 o; o.x = cvtpk(sp[0 * 65], sp[1 * 65]); o.y = cvtpk(sp[2 * 65], sp[3 * 65]); o.z = cvtpk(sp[4 * 65], sp[5 * 65]); o.w = cvtpk(sp[6 * 65], sp[7 * 65]);
        *(u32x4*)(c.dst + (size_t)(n0 + r) * c.K + k0 + 8 * ch) = o; }
    }
    asm volatile("s_waitcnt lgkmcnt(0)" ::: "memory");
}

__device__ __forceinline__ void conv64_run(const Conv64& c, LAS float* scr, int lane, int gwi, int ngw, int& base) {
    const int n = (c.K / 64) * (c.Ndst / 64); int it = gwi - base; if (it < 0) it += ngw;
    if (it < n) { f32x4 va[16], vb[16]; conv64_load(c, it, lane, va);
        for (;;) { const int i2 = it + ngw; if (i2 < n) conv64_load(c, i2, lane, vb); conv64_store(c, it, scr, lane, va); if (i2 >= n) break;
                   const int i3 = i2 + ngw; if (i3 < n) conv64_load(c, i3, lane, va); conv64_store(c, i2, scr, lane, vb); if (i3 >= n) break; it = i3; } }
    base = (base + n) % ngw;
}

namespace pg8 {
constexpr int BM = 256, BK = 64, HALF = 128, HTB = HALF * BK * 2, STAGE_BYTES = 8 * HTB;
constexpr int NXCD = 8, WGM = 8;
__device__ __forceinline__ int lds_byte(int r, int c) { const int st = (r >> 4) * 2 + (c >> 5), rr = r & 15, cc = c & 31, ob = rr * 64 + cc * 2; return st * 1024 + (ob ^ (((ob >> 9) & 1) << 5)); }
__device__ __forceinline__ void stage_rc(int b, int& Rr, int& C) { const int st = b / 1024, sb = b % 1024, swz = sb ^ (((sb >> 9) & 1) << 5); Rr = (st >> 1) * 16 + swz / 64; C = (st & 1) * 32 + (swz % 64) / 2; }
__device__ __forceinline__ int perm32(int rho) { const int n = rho >> 4, i = rho & 15; return 8 * (i >> 2) + 4 * n + (i & 3); }
struct Unit { int pm, pn; };
typedef int v8i_t __attribute__((ext_vector_type(8)));
typedef int v4i_t __attribute__((ext_vector_type(4)));
__device__ __forceinline__ v8i_t cat8(bf16x8 a, bf16x8 b) { const v4i_t x = __builtin_bit_cast(v4i_t, a), y = __builtin_bit_cast(v4i_t, b); return __builtin_shufflevector(x, y, 0, 1, 2, 3, 4, 5, 6, 7); }
struct Order {
    int nM, nN, nwg, G, c;
    __device__ __forceinline__ void init(int nM_, int nN_, int G_, int c_) { nM = nM_; nN = nN_; nwg = nM * nN; G = G_; c = c_; }
    __device__ __forceinline__ bool next(int i, Unit& u) const {
        const long L = (long)i * G + c; if (L >= nwg) return false;
        int wgid = (int)L; { const int q = nwg / NXCD, r = nwg % NXCD, xcd = wgid % NXCD, off = wgid / NXCD; wgid = (xcd < r ? xcd * (q + 1) : r * (q + 1) + (xcd - r) * q) + off; }
        const int nig = WGM * nN, gid = wgid / nig, fm = gid * WGM, gsz = (nM - fm) < WGM ? (nM - fm) : WGM;
        u.pm = fm + ((wgid % nig) % gsz); u.pn = (wgid % nig) / gsz; return true;
    }
};

template <class Prob, class Epi>
__device__ __forceinline__ void gemm_phase(LAS unsigned char* lds, const Prob& P, const Epi& E) {
    const int tid = threadIdx.x, wid = __builtin_amdgcn_readfirstlane(tid >> 6), lane = tid & 63, wr = wid >> 2, wc = wid & 3, fr = lane & 15, fq = lane >> 4;
    const int K = P.K, nt = K / BK, ldb = P.ldb;
    int RA[2], CA[2]; unsigned voffB[2];
#pragma unroll
    for (int i = 0; i < 2; ++i) { int Rr, C; stage_rc(tid * 16 + i * 8192, Rr, C); const int Rb = Epi::PERM ? ((Rr & ~31) + perm32(Rr & 31)) : Rr;
        RA[i] = Rr; CA[i] = C; voffB[i] = (unsigned)(Rb * ldb + C) * 2u; }
    const size_t hstepB = (size_t)HALF * ldb * 2;
    const unsigned ldsw = (unsigned)wid * 1024u;
    const int aoff = lds_byte(wr * 64 + fr, fq * 8), boff = lds_byte(wc * 32 + fr, fq * 8);
    const char* Abase = (const char*)P.Abase;
    const int scl_a = P.sa * 0x01010101, scl_b = P.sb * 0x01010101;
#define PG8_SA(b, h) (((b) * 2 + (h)) * HTB)
#define PG8_SB(b, h) ((4 + (b) * 2 + (h)) * HTB)
#define PG8_STAGEB(bufoff, gbase) do { _Pragma("unroll") for (int _i = 0; _i < 2; ++_i) \
        __builtin_amdgcn_global_load_lds((const unsigned*)((const char*)(gbase) + voffB[_i]), (LAS unsigned*)(lds + (bufoff) + ldsw + _i * 8192), 16, 0, 0); } while (0)
#define PG8_STAGEA(bufoff, vo, h, kb) do { _Pragma("unroll") for (int _i = 0; _i < 2; ++_i) \
        __builtin_amdgcn_global_load_lds((const unsigned*)(Abase + (size_t)(kb) + (vo)[h][_i]), (LAS unsigned*)(lds + (bufoff) + ldsw + _i * 8192), 16, 0, 0); } while (0)
#define PG8_LDA(dst, b, h) do { _Pragma("unroll") for (int m = 0; m < 4; ++m) { if constexpr (Prob::FP8) dst##8[m] = cat8(*(const LAS bf16x8*)(lds + PG8_SA(b, h) + aoff + m * 2048), *(const LAS bf16x8*)(lds + PG8_SA(b, h) + aoff + m * 2048 + 1024)); \
        else { _Pragma("unroll") for (int k = 0; k < 2; ++k) dst[m][k] = *(const LAS bf16x8*)(lds + PG8_SA(b, h) + aoff + m * 2048 + k * 1024); } } } while (0)
#define PG8_LDB(dst, b, h) do { _Pragma("unroll") for (int n = 0; n < 2; ++n) { if constexpr (Prob::FP8) dst##8[n] = cat8(*(const LAS bf16x8*)(lds + PG8_SB(b, h) + boff + n * 2048), *(const LAS bf16x8*)(lds + PG8_SB(b, h) + boff + n * 2048 + 1024)); \
        else { _Pragma("unroll") for (int k = 0; k < 2; ++k) dst[n][k] = *(const LAS bf16x8*)(lds + PG8_SB(b, h) + boff + n * 2048 + k * 1024); } } } while (0)
#define PG8_MMA(ai, bj, At, Bt) do { __builtin_amdgcn_s_setprio(1); _Pragma("unroll") for (int m = 0; m < 4; ++m) _Pragma("unroll") for (int n = 0; n < 2; ++n) { \
        if constexpr (Prob::FP8) asm volatile("v_mfma_scale_f32_16x16x128_f8f6f4 %0, %1, %2, %0, %3, %4 op_sel_hi:[0,0,0]" : "+v"(acc[ai][bj][m][n]) : "v"(Bt##8[n]), "v"(At##8[m]), "v"(scl_b), "v"(scl_a)); \
        else { _Pragma("unroll") for (int k = 0; k < 2; ++k) acc[ai][bj][m][n] = __builtin_amdgcn_mfma_f32_16x16x32_bf16(Bt[n][k], At[m][k], acc[ai][bj][m][n], 0, 0, 0); } } \
        __builtin_amdgcn_s_setprio(0); } while (0)
#define PG8_WAIT_V(n) asm volatile("s_waitcnt vmcnt(" #n ")" ::: "memory")
#define PG8_WAIT_L(n) asm volatile("s_waitcnt lgkmcnt(" #n ")" ::: "memory")
#define PG8_BAR __builtin_amdgcn_s_barrier()
#define PG8_SCHED __builtin_amdgcn_sched_barrier(0)
    Unit cur, nxt; int ui = 0;
    if (!P.next(0, cur)) return;
    f32x4 acc[2][2][4][2];
#pragma unroll
    for (int a = 0; a < 2; ++a)
#pragma unroll
        for (int b = 0; b < 2; ++b)
#pragma unroll
            for (int m = 0; m < 4; ++m)
#pragma unroll
                for (int n = 0; n < 2; ++n) acc[a][b][m][n] = (f32x4){0.f, 0.f, 0.f, 0.f};
    bf16x8 At[4][2], B0[2][2], B1[2][2]; v8i_t At8[4], B08[2], B18[2];
    unsigned cvo[2][2], nvo[2][2];
#pragma unroll
    for (int h = 0; h < 2; ++h)
#pragma unroll
        for (int i = 0; i < 2; ++i) cvo[h][i] = P.a_off(cur, h * HALF + RA[i]) + (unsigned)CA[i] * 2u;
    const char* cB = P.b_ptr(cur);
    const size_t kstep = (size_t)(BK * 2);
    PG8_STAGEB(PG8_SB(0, 0), cB); PG8_STAGEB(PG8_SB(0, 1), cB + hstepB); PG8_STAGEA(PG8_SA(0, 0), cvo, 0, 0); PG8_STAGEA(PG8_SA(0, 1), cvo, 1, 0);
    if (wr == 1) PG8_BAR;
    PG8_WAIT_V(2); PG8_BAR;
    PG8_STAGEB(PG8_SB(1, 0), cB + kstep); PG8_STAGEA(PG8_SA(1, 0), cvo, 0, kstep); PG8_STAGEB(PG8_SB(1, 1), cB + hstepB + kstep);
    PG8_WAIT_V(6); PG8_BAR;
    for (;;) {
        const bool has_next = P.next(ui + 1, nxt);
        const char* nB = cB;
#pragma unroll
        for (int h = 0; h < 2; ++h)
#pragma unroll
            for (int i = 0; i < 2; ++i) nvo[h][i] = cvo[h][i];
        if (has_next) { nB = P.b_ptr(nxt);
#pragma unroll
            for (int h = 0; h < 2; ++h)
#pragma unroll
                for (int i = 0; i < 2; ++i) nvo[h][i] = P.a_off(nxt, h * HALF + RA[i]) + (unsigned)CA[i] * 2u; }
        for (int t = 0; t < nt; t += 2) {
            const bool last = (t == nt - 2);
            const size_t k1 = (size_t)(t + 1) * kstep;
            const size_t k2 = last ? 0 : (size_t)(t + 2) * kstep, k3 = k2 + kstep;
            unsigned vo2[2][2];
#pragma unroll
            for (int h = 0; h < 2; ++h)
#pragma unroll
                for (int i = 0; i < 2; ++i) vo2[h][i] = last ? nvo[h][i] : cvo[h][i];
            const char* b2 = (last ? nB : cB) + k2; const char* b3 = b2 + kstep;
            PG8_LDB(B0, 0, 0); PG8_LDB(B1, 0, 1); PG8_SCHED; PG8_LDA(At, 0, 0); PG8_STAGEA(PG8_SA(1, 1), cvo, 1, k1);
            PG8_WAIT_V(8); PG8_WAIT_L(0); PG8_BAR; PG8_MMA(0, 0, At, B0); PG8_MMA(0, 1, At, B1); PG8_BAR; PG8_SCHED;
            PG8_LDA(At, 0, 1); PG8_STAGEB(PG8_SB(0, 0), b2); PG8_STAGEB(PG8_SB(0, 1), b2 + hstepB); PG8_STAGEA(PG8_SA(0, 0), vo2, 0, k2);
            PG8_WAIT_V(8); PG8_WAIT_L(0); PG8_BAR; PG8_MMA(1, 0, At, B0); PG8_MMA(1, 1, At, B1); PG8_BAR; PG8_SCHED;
            PG8_LDB(B0, 1, 0); PG8_LDB(B1, 1, 1); PG8_SCHED; PG8_LDA(At, 1, 0); PG8_STAGEA(PG8_SA(0, 1), vo2, 1, k2);
            PG8_WAIT_V(8); PG8_WAIT_L(0); PG8_BAR; PG8_MMA(0, 0, At, B0); PG8_MMA(0, 1, At, B1); PG8_BAR; PG8_SCHED;
            PG8_LDA(At, 1, 1); PG8_STAGEB(PG8_SB(1, 0), b3); PG8_STAGEB(PG8_SB(1, 1), b3 + hstepB); PG8_STAGEA(PG8_SA(1, 0), vo2, 0, k3);
            PG8_WAIT_V(8); PG8_WAIT_L(0); PG8_BAR; PG8_MMA(1, 0, At, B0); PG8_MMA(1, 1, At, B1); PG8_BAR; PG8_SCHED;
        }
        if (wr == 0) PG8_BAR;
        if constexpr (Prob::FP8) asm volatile("s_nop 15\n\ts_nop 15" ::: "memory");
        if constexpr (Epi::STAGED) E.staged(acc, P, cur, wr, wc, fr, fq, lds + STAGE_BYTES, tid);
        else { E(acc, P, cur, wr, wc, fr, fq); if (MK_EPI2) { asm volatile("" ::: "memory"); E(acc, P, cur, wr, wc, fr, fq); } }
        if (!has_next) break;
#pragma unroll
        for (int a = 0; a < 2; ++a)
#pragma unroll
            for (int b = 0; b < 2; ++b)
#pragma unroll
                for (int m = 0; m < 4; ++m)
#pragma unroll
                    for (int n = 0; n < 2; ++n) acc[a][b][m][n] = (f32x4){0.f, 0.f, 0.f, 0.f};
        cur = nxt; cB = nB; ++ui;
#pragma unroll
        for (int h = 0; h < 2; ++h)
#pragma unroll
            for (int i = 0; i < 2; ++i) cvo[h][i] = nvo[h][i];
        if (wr == 1) PG8_BAR;
    }
    PG8_WAIT_V(0);
    PG8_BAR;
#undef PG8_SA
#undef PG8_SB
#undef PG8_STAGEA
#undef PG8_STAGEB
#undef PG8_LDA
#undef PG8_LDB
#undef PG8_MMA
#undef PG8_WAIT_V
#undef PG8_WAIT_L
#undef PG8_BAR
#undef PG8_SCHED
}

struct DenseProb {
    static constexpr bool FP8 = false; static constexpr int sa = 127, sb = 127;
    const bf16_t* Abase; const bf16_t* Bt; int K, lda, ldb; Order ord;
    __device__ __forceinline__ bool next(int i, Unit& u) const { return ord.next(i, u); }
    __device__ __forceinline__ unsigned a_off(const Unit& u, int r) const { return (unsigned)((size_t)(u.pm * BM + r) * lda * 2); }
    __device__ __forceinline__ const char* b_ptr(const Unit& u) const { return (const char*)Bt + (size_t)u.pn * BM * ldb * 2; }
    __device__ __forceinline__ int orow0(const Unit& u) const { return u.pm * BM; }
};
template <int SA, int SB> struct DenseProb8 {
    static constexpr bool FP8 = true; static constexpr int sa = SA, sb = SB;
    const unsigned char* Abase; const unsigned char* Bt; int K, ldb; int lda; Order ord;
    __device__ __forceinline__ bool next(int i, Unit& u) const { return ord.next(i, u); }
    __device__ __forceinline__ unsigned a_off(const Unit& u, int r) const { return (unsigned)((size_t)(u.pm * BM + r) * lda); }
    __device__ __forceinline__ const char* b_ptr(const Unit& u) const { return (const char*)Bt + (size_t)u.pn * BM * ldb * 2; }
    __device__ __forceinline__ int orow0(const Unit& u) const { return u.pm * BM; }
};
struct MoeTiles { unsigned long long tp8; unsigned long long c4a, c4b; int nt; };
__device__ __forceinline__ int moe_tp(const MoeTiles& T, int e) { return (int)((T.tp8 >> (8 * e)) & 0xffull); }
__device__ __forceinline__ int moe_cnt(const MoeTiles& T, int e) { const unsigned long long w = (e < 4) ? T.c4a : T.c4b; return (int)((w >> (16 * (e & 3))) & 0xffffull); }
__device__ __forceinline__ int moe_expert(const MoeTiles& T, int pm) { int e = 0;
#pragma unroll
    for (int j = 1; j < 8; ++j) e += (pm >= (int)((T.tp8 >> (8 * j)) & 0xffull)) ? 1 : 0;
    return e; }
struct MoeGuProb {
    static constexpr bool FP8 = true; static constexpr int sa = 125, sb = 121;
    const unsigned char* Abase; const unsigned char* Bt; int K, ldb; Order ord; MoeTiles T; const int* rowtok;
    __device__ __forceinline__ bool next(int i, Unit& u) const { return ord.next(i, u); }
    __device__ __forceinline__ unsigned a_off(const Unit& u, int r) const {
        const int e = moe_expert(T, u.pm); const int idx = (u.pm - moe_tp(T, e)) * BM + r; const int cm1 = moe_cnt(T, e) - 1;
        const int tok = rowtok[e * CAPE + (idx < cm1 ? idx : cm1)];
        return (unsigned)tok * (unsigned)D; }
    __device__ __forceinline__ const char* b_ptr(const Unit& u) const { const int e = moe_expert(T, u.pm); return (const char*)Bt + ((size_t)e * N_GU1 + (size_t)u.pn * BM) * D; }
    __device__ __forceinline__ int orow0(const Unit& u) const { return u.pm * BM; }
};
struct MoeDnProb {
    static constexpr bool FP8 = true; static constexpr int sa = 124, sb = 121;
    const unsigned char* Abase; const unsigned char* Bt; int K, ldb; Order ord; MoeTiles T;
    __device__ __forceinline__ bool next(int i, Unit& u) const { return ord.next(i, u); }
    __device__ __forceinline__ unsigned a_off(const Unit& u, int r) const { return (unsigned)((size_t)(u.pm * BM + r) * EXD); }
    __device__ __forceinline__ const char* b_ptr(const Unit& u) const { const int e = moe_expert(T, u.pm); return (const char*)Bt + ((size_t)e * D + (size_t)u.pn * BM) * EXD; }
    __device__ __forceinline__ int orow0(const Unit& u) const { return u.pm * BM; }
};

struct EpiF32 { static constexpr bool PERM = false; static constexpr bool STAGED = false; float* C; int ldc;
    template <class Prob> __device__ __forceinline__ void operator()(const f32x4 (&acc)[2][2][4][2], const Prob& P, const Unit& u, int wr, int wc, int fr, int fq) const {
        const int row0 = P.orow0(u) + wr * 64 + fr, col0 = u.pn * BM + wc * 32 + 4 * fq;
#pragma unroll
        for (int ai = 0; ai < 2; ++ai)
#pragma unroll
            for (int m = 0; m < 4; ++m) { float* rowp = C + (size_t)(row0 + ai * HALF + m * 16) * ldc + col0;
#pragma unroll
                for (int bj = 0; bj < 2; ++bj)
#pragma unroll
                    for (int n = 0; n < 2; ++n) *(f32x4*)(rowp + bj * HALF + n * 16) = acc[ai][bj][m][n]; }
    }
};
struct EpiBf16 { static constexpr bool PERM = true; static constexpr bool STAGED = false; bf16_t* O; int ldc; const float* rowscale;
    template <class Prob> __device__ __forceinline__ void operator()(const f32x4 (&acc)[2][2][4][2], const Prob& P, const Unit& u, int wr, int wc, int fr, int fq) const {
        const int row0 = P.orow0(u) + wr * 64 + fr, col0 = u.pn * BM + wc * 32 + 8 * fq;
#pragma unroll
        for (int ai = 0; ai < 2; ++ai)
#pragma unroll
            for (int m = 0; m < 4; ++m) { const int row = row0 + ai * HALF + m * 16; bf16_t* rowp = O + (size_t)row * ldc + col0; const float rs = rowscale ? rowscale[row] : 1.0f;
#pragma unroll
                for (int bj = 0; bj < 2; ++bj) { const f32x4 v0 = acc[ai][bj][m][0] * rs, v1 = acc[ai][bj][m][1] * rs;
                    u32x4 w; w.x = cvtpk(v0[0], v0[1]); w.y = cvtpk(v0[2], v0[3]); w.z = cvtpk(v1[0], v1[1]); w.w = cvtpk(v1[2], v1[3]);
                    *(u32x4*)(rowp + bj * HALF) = w; } }
    }
};
struct EpiIn1 { static constexpr bool PERM = true; static constexpr bool STAGED = false; bf16_t* QK; bf16_t* V; bf16_t* G; bf16_t* RRp;
    template <class Prob> __device__ __forceinline__ void operator()(const f32x4 (&acc)[2][2][4][2], const Prob& P, const Unit& u, int wr, int wc, int fr, int fq) const {
        const int t = u.pn >> 2; bf16_t* base = (t == 0) ? QK : (t == 1) ? V : (t == 2) ? G : RRp; const int ldc = (t == 3) ? 256 : 1024;
        const int row0 = P.orow0(u) + wr * 64 + fr, col0 = (u.pn & 3) * BM + wc * 32 + 8 * fq;
#pragma unroll
        for (int ai = 0; ai < 2; ++ai)
#pragma unroll
            for (int m = 0; m < 4; ++m) { const int row = row0 + ai * HALF + m * 16; bf16_t* rowp = base + (size_t)row * ldc + col0;
#pragma unroll
                for (int bj = 0; bj < 2; ++bj) { const f32x4 v0 = acc[ai][bj][m][0], v1 = acc[ai][bj][m][1];
                    u32x4 w; w.x = cvtpk(v0[0], v0[1]); w.y = cvtpk(v0[2], v0[3]); w.z = cvtpk(v1[0], v1[1]); w.w = cvtpk(v1[2], v1[3]);
                    *(u32x4*)(rowp + bj * HALF) = w; } }
    }
};
struct EpiQA { static constexpr bool PERM = true; static constexpr bool STAGED = false; bf16_t* O; const float* rstd; const float* tab16; float qscale;
    template <class Prob> __device__ __forceinline__ void operator()(const f32x4 (&acc)[2][2][4][2], const Prob& P, const Unit& u, int wr, int wc, int fr, int fq) const {
        const int row0 = P.orow0(u) + wr * 64 + fr, col0 = u.pn * BM + wc * 32 + 8 * fq;
        const bool ropet = (u.pn == 2);
#pragma unroll
        for (int ai = 0; ai < 2; ++ai)
#pragma unroll
            for (int m = 0; m < 4; ++m) { const int row = row0 + ai * HALF + m * 16; bf16_t* rowp = O + (size_t)row * N_QA + col0; const float rs = rstd[row] * qscale;
                f32x4 cs0 = {1.f, 1.f, 1.f, 1.f}, sn0 = {0.f, 0.f, 0.f, 0.f};
                if (ropet && row < RL) { const int tt = row & (SEQ - 1); const int pos = (fq >> 1) ? (tt & 63) : (tt >> 6); const int i0 = 4 * (fq & 1);
                    cs0 = *(const f32x4*)(tab16 + pos * 8 + i0); sn0 = *(const f32x4*)(tab16 + 512 + pos * 8 + i0); }
#pragma unroll
                for (int bj = 0; bj < 2; ++bj) { f32x4 v0 = acc[ai][bj][m][0] * rs, v1 = acc[ai][bj][m][1] * rs;
                    if (ropet) {
                        const f32x4 a = v0, b = v1;
                        v0[0] = a[0] * cs0[0] - a[1] * sn0[0]; v0[1] = a[1] * cs0[0] + a[0] * sn0[0];
                        v0[2] = a[2] * cs0[1] - a[3] * sn0[1]; v0[3] = a[3] * cs0[1] + a[2] * sn0[1];
                        v1[0] = b[0] * cs0[2] - b[1] * sn0[2]; v1[1] = b[1] * cs0[2] + b[0] * sn0[2];
                        v1[2] = b[2] * cs0[3] - b[3] * sn0[3]; v1[3] = b[3] * cs0[3] + b[2] * sn0[3]; }
                    u32x4 w; w.x = cvtpk(v0[0], v0[1]); w.y = cvtpk(v0[2], v0[3]); w.z = cvtpk(v1[0], v1[1]); w.w = cvtpk(v1[2], v1[3]);
                    *(u32x4*)(rowp + bj * HALF) = w; } }
    }
};
struct EpiSwiglu { static constexpr bool PERM = false; static constexpr bool STAGED = false; bf16_t* Hh; int ldh;
    template <class Prob> __device__ __forceinline__ void operator()(const f32x4 (&acc)[2][2][4][2], const Prob& P, const Unit& u, int wr, int wc, int fr, int fq) const {
        const int row0 = P.orow0(u) + wr * 64 + fr, col0 = (u.pn * BM + wc * 32) / 2 + 4 * fq;
#pragma unroll
        for (int ai = 0; ai < 2; ++ai)
#pragma unroll
            for (int m = 0; m < 4; ++m) { bf16_t* rowp = Hh + (size_t)(row0 + ai * HALF + m * 16) * ldh + col0;
#pragma unroll
                for (int bj = 0; bj < 2; ++bj) { const f32x4 g = acc[ai][bj][m][0], up = acc[ai][bj][m][1];
                    u32x2 w; w.x = cvtpk(swiglu_f(g[0], up[0], -1.4426950408889634f), swiglu_f(g[1], up[1], -1.4426950408889634f)); w.y = cvtpk(swiglu_f(g[2], up[2], -1.4426950408889634f), swiglu_f(g[3], up[3], -1.4426950408889634f));
                    *(u32x2*)(rowp + bj * (HALF / 2)) = w; } }
    }
};
struct EpiSwiglu8 { static constexpr bool PERM = false; static constexpr bool STAGED = true; unsigned char* Hh; int ldh;
    template <class Prob> __device__ __forceinline__ void staged(const f32x4 (&acc)[2][2][4][2], const Prob& P, const Unit& u, int wr, int wc, int fr, int fq, LAS unsigned char* stg, int tid) const {
        LAS unsigned char* sg = stg + wr * 8192;
        const int t = tid & 255;
        unsigned char* gbase = Hh + (size_t)(P.orow0(u) + wr * 64) * ldh + (size_t)u.pn * 128;
#pragma unroll
        for (int ai = 0; ai < 2; ++ai) {
#pragma unroll
            for (int m = 0; m < 4; ++m) { const int row = m * 16 + fr;
#pragma unroll
                for (int bj = 0; bj < 2; ++bj) { const f32x4 g = acc[ai][bj][m][0], up = acc[ai][bj][m][1]; const int p = bj * 4 + wc;
                    *(LAS unsigned*)(sg + row * 128 + ((p ^ (row & 7)) << 4) + 4 * fq) = pack_fp8x4(swiglu_f(g[0], up[0], -0.18033688011112042f), swiglu_f(g[1], up[1], -0.18033688011112042f), swiglu_f(g[2], up[2], -0.18033688011112042f), swiglu_f(g[3], up[3], -0.18033688011112042f)); } }
            asm volatile("s_waitcnt lgkmcnt(0)" ::: "memory"); __builtin_amdgcn_s_barrier(); asm volatile("" ::: "memory");
#pragma unroll
            for (int j = 0; j < 2; ++j) { const int row = (t >> 3) + 32 * j, p = t & 7;
                const u32x4 v = *(const LAS u32x4*)(sg + row * 128 + ((p ^ (row & 7)) << 4));
                *(u32x4*)(gbase + (size_t)(ai * HALF + row) * ldh + p * 16) = v; }
            if (ai == 0) { asm volatile("s_waitcnt lgkmcnt(0)" ::: "memory"); __builtin_amdgcn_s_barrier(); asm volatile("" ::: "memory"); }
        }
    }
};
}

struct Frame {
    LAS unsigned char* lds;
    unsigned char* ws;
    int tid, lane, wave, vcu, G;
};
template <class T> __device__ __forceinline__ T* wsp(const Frame& F, size_t off) { return (T*)(F.ws + off); }

__device__ __forceinline__ void load_row(const float* p, int lane, f32x4 (&v)[4]) {
    const f32x4* r = (const f32x4*)p + lane;
#pragma unroll
    for (int j = 0; j < 4; ++j) v[j] = r[64 * j];
}
__device__ __forceinline__ void load_row_bf16(const bf16_t* p, int lane, f32x4 (&v)[4]) {
#pragma unroll
    for (int j = 0; j < 4; ++j) { const u32x2 w = *(const u32x2*)(p + 4 * lane + 256 * j); v[j][0] = bflo(w.x); v[j][1] = bfhi(w.x); v[j][2] = bflo(w.y); v[j][3] = bfhi(w.y); }
}
__device__ __forceinline__ float row_ssq(const f32x4 (&v)[4]) { float s = 0.f;
#pragma unroll
    for (int j = 0; j < 4; ++j) s += (v[j][0] * v[j][0] + v[j][1] * v[j][1]) + (v[j][2] * v[j][2] + v[j][3] * v[j][3]);
    return wave_sum(s); }
__device__ __forceinline__ void norm_mod_store(const f32x4 (&h)[4], const float* g, const float* sh, const float* sc, bf16_t* urow, int lane, f32x4 (&uo)[4], unsigned char* u8row = nullptr) {
    const float rstd = __builtin_amdgcn_rsqf(row_ssq(h) * (1.0f / D) + EPS);
#pragma unroll
    for (int j = 0; j < 4; ++j) { const int c = 4 * lane + 256 * j; const f32x4 gg = *(const f32x4*)(g + c), s1 = *(const f32x4*)(sc + c), s0 = *(const f32x4*)(sh + c);
        const f32x4 uu = (h[j] * rstd * gg) * (1.0f + s1) + s0; uo[j] = uu;
        if (u8row) *(unsigned*)(u8row + c) = pack_fp8x4(4.0f * uu[0], 4.0f * uu[1], 4.0f * uu[2], 4.0f * uu[3]);
        else { u32x2 w; w.x = cvtpk(uu[0], uu[1]); w.y = cvtpk(uu[2], uu[3]); *(u32x2*)(urow + c) = w; } }
}
__device__ __forceinline__ int row_bidx(int row) { return row < RL ? (row >> 12) : 4; }

__device__ __forceinline__ void glds16(const void* gsrc, unsigned lds_dst) { unsigned keep;
    asm volatile("s_mov_b32 %0, m0\n\ts_mov_b32 m0, %2\n\ts_nop 0\n\tglobal_load_lds_dwordx4 %1, off\n\ts_mov_b32 m0, %0" : "=&s"(keep) : "v"(gsrc), "s"(lds_dst) : "memory"); }
__device__ __forceinline__ float max3f(float a, float b, float c) { float r; asm("v_max3_f32 %0, %1, %2, %3" : "=v"(r) : "v"(a), "v"(b), "v"(c)); return r; }
#define WAIT_BAR(N) asm volatile("s_waitcnt vmcnt(" #N ") lgkmcnt(0)\n\ts_barrier" ::: "memory")
template <int DQK> struct AttnSrc {
    const bf16_t* Q; int qpitch; const bf16_t* Qr;
    const bf16_t* Kn; int kpitch; const bf16_t* Kr; int krpitch;
    const bf16_t* V; int vpitch;
    bf16_t* O; int opitch;
};
__device__ __forceinline__ s16x4 vtr(const LAS unsigned char* p) { typedef short v4i16_t __attribute__((ext_vector_type(4))); return __builtin_bit_cast(s16x4, __builtin_amdgcn_ds_read_tr16_b64_v4i16((LAS v4i16_t*)p)); }
__device__ __forceinline__ int attn_krow(int kt, int lat0, int ctx0) { return kt < 64 ? lat0 + kt * 64 : ctx0 + (kt - 64) * 64; }
__device__ __forceinline__ f32x16 mfma_first(bf16x8 a, bf16x8 b, const f32x16& c) { f32x16 d; asm volatile("s_nop 4\n\tv_mfma_f32_32x32x16_bf16 %0, %1, %2, %3" : "=&v"(d) : "v"(a), "v"(b), "v"(c)); return d; }
template <int DQK, bool SAFE>
__device__ __forceinline__ bool attn_run(const Frame& F, const AttnSrc<DQK>& S, int q0, int lat0, int ctx0, int kt0, int kt1) {
    constexpr int NKS = DQK / 16, KB = DQK * 128, SLOT = KB + 8192;
    constexpr float THR = 8.0f;
    constexpr float BIG = 1.0e12f;
    bool ovf = false;
    const int lane = F.lane, wid = F.wave, r32 = lane & 31, hi = lane >> 5;
    LAS unsigned char* lds = F.lds;
    constexpr bool QLDS = false;
    bf16x8 qf[QLDS ? 1 : NKS];
    LAS unsigned char* qfl = lds + 4 * SLOT + wid * (NKS * 1024) + lane * 16;
    { const bf16_t* qrow = S.Q + (size_t)(q0 + wid * 32 + r32) * S.qpitch;
#pragma unroll
      for (int ks = 0; ks < 4; ++ks) { const bf16x8 v = *(const bf16x8*)(qrow + ks * 16 + hi * 8); if (QLDS) *(LAS bf16x8*)(qfl + ks * 1024) = v; else qf[ks] = v; }
      if (DQK == 96) { const bf16_t* qr = S.Qr + (size_t)(q0 + wid * 32 + r32) * S.qpitch;
#pragma unroll
          for (int ks = 4; ks < NKS; ++ks) { const bf16x8 v = *(const bf16x8*)(qr + (ks - 4) * 16 + hi * 8); if (QLDS) *(LAS bf16x8*)(qfl + ks * 1024) = v; else qf[ks] = v; } } }
    const unsigned lds0 = (unsigned)(size_t)lds;
    auto dma = [&](int kt, int slot) {
        const int krow = attn_krow(kt, lat0, ctx0);
        const unsigned sb = lds0 + slot * SLOT;
        glds16(S.Kn + (size_t)(krow + lane) * S.kpitch + wid * 8, (unsigned)__builtin_amdgcn_readfirstlane(sb + wid * 1024));
        if (DQK == 96 && wid < 4) glds16(S.Kr + (size_t)(krow + lane) * S.krpitch + wid * 8, (unsigned)__builtin_amdgcn_readfirstlane(sb + (8 + wid) * 1024));
        glds16(S.V + (size_t)(krow + 16 * (wid & 3) + (lane >> 2)) * S.vpitch + (wid >> 2) * 32 + (lane & 3) * 8, (unsigned)__builtin_amdgcn_readfirstlane(sb + KB + wid * 1024));
    };
    auto wait_bar = [&](bool inflight) {
        if (!inflight) { WAIT_BAR(0); } else if (DQK == 96 && wid < 4) { WAIT_BAR(3); } else { WAIT_BAR(2); }
    };
    f32x16 oT[2]; f32x16 negm;
#pragma unroll
    for (int r = 0; r < 16; ++r) { oT[0][r] = 0.f; oT[1][r] = 0.f; negm[r] = 0.f; }
    float mrun = 0.f, lrun = 0.f;
    const int vlane = ((lane >> 4) & 1) * 32 + (lane & 3) * 8 + (4 * hi + ((lane & 15) >> 2)) * 64;
    auto qk = [&](int slot, f32x16& p0, f32x16& p1) {
        const LAS unsigned char* kb = lds + slot * SLOT + hi * 1024 + r32 * 16;
        p0 = negm; p1 = negm;
        bf16x8 ka = *(const LAS bf16x8*)(kb), kc = *(const LAS bf16x8*)(kb + 512);
#pragma unroll
        for (int ks = 0; ks < NKS; ++ks) {
            bf16x8 na = ka, nc = kc;
            if (ks + 1 < NKS) { na = *(const LAS bf16x8*)(kb + (ks + 1) * 2048); nc = *(const LAS bf16x8*)(kb + (ks + 1) * 2048 + 512); }
            const bf16x8 qv = QLDS ? *(const LAS bf16x8*)(qfl + ks * 1024) : qf[QLDS ? 0 : ks];
            p0 = __builtin_amdgcn_mfma_f32_32x32x16_bf16(ka, qv, p0, 0, 0, 0);
            p1 = __builtin_amdgcn_mfma_f32_32x32x16_bf16(kc, qv, p1, 0, 0, 0);
            ka = na; kc = nc;
        }
    };
    auto tilemax = [&](f32x16& p0, f32x16& p1) -> float {
        asm volatile("s_nop 15\n\ts_nop 7" : "+v"(p0), "+v"(p1));
        float a = max3f(p0[0], p0[1], p1[0]), b = max3f(p0[2], p0[3], p1[1]); a = max3f(a, p1[2], p1[3]);
#pragma unroll
        for (int r = 4; r < 16; r += 4) { a = max3f(a, p0[r], p0[r + 1]); b = max3f(b, p0[r + 2], p0[r + 3]); a = max3f(a, p1[r], p1[r + 1]); b = max3f(b, p1[r + 2], p1[r + 3]); }
        float tm = fmaxf(a, b);
        auto rr = __builtin_amdgcn_permlane32_swap(__float_as_uint(tm), __float_as_uint(tm), false, false); return fmaxf(__uint_as_float(rr[0]), __uint_as_float(rr[1]));
    };
    auto step = [&](f32x16& c0, f32x16& c1, f32x16& n0, f32x16& n1, int slot_c, int slot_n) {
        if constexpr (SAFE) {
            const float tm = tilemax(c0, c1);
            if (__any(tm > THR)) {
                const float dl = fmaxf(tm, 0.f); mrun += dl; const float al = __builtin_amdgcn_exp2f(-dl); lrun *= al;
#pragma unroll
                for (int r = 0; r < 16; ++r) { c0[r] -= dl; c1[r] -= dl; negm[r] = -mrun; oT[0][r] *= al; oT[1][r] *= al; }
            }
        }
        float rs = 0.f;
        {
            const LAS unsigned char* kb = lds + slot_n * SLOT + hi * 1024 + r32 * 16;
            bf16x8 ka = *(const LAS bf16x8*)(kb), kc = *(const LAS bf16x8*)(kb + 512);
#pragma unroll
            for (int ks = 0; ks < NKS; ++ks) {
                bf16x8 na = ka, nc = kc;
                if (ks + 1 < NKS) { na = *(const LAS bf16x8*)(kb + (ks + 1) * 2048); nc = *(const LAS bf16x8*)(kb + (ks + 1) * 2048 + 512); }
                if (ks == 0) { n0 = mfma_first(ka, qf[0], negm); n1 = mfma_first(kc, qf[0], negm); }
                else { n0 = __builtin_amdgcn_mfma_f32_32x32x16_bf16(ka, qf[ks], n0, 0, 0, 0);
                       n1 = __builtin_amdgcn_mfma_f32_32x32x16_bf16(kc, qf[ks], n1, 0, 0, 0); }
                ka = na; kc = nc;
#pragma unroll
                for (int r = (16 * ks) / NKS; r < (16 * (ks + 1)) / NKS; ++r) { c0[r] = __builtin_amdgcn_exp2f(c0[r]); c1[r] = __builtin_amdgcn_exp2f(c1[r]); rs += c0[r] + c1[r]; }
            }
        }
        bool mv = false; float dl = 0.f;
        if constexpr (!SAFE) mv = __any(!(rs < BIG));
        lrun += rs;
        bf16x8 pf[4];
        { u32x4 w;
          w.x = cvtpk(c0[0], c0[1]); w.y = cvtpk(c0[2], c0[3]); w.z = cvtpk(c0[4], c0[5]); w.w = cvtpk(c0[6], c0[7]); pf[0] = __builtin_bit_cast(bf16x8, w);
          w.x = cvtpk(c0[8], c0[9]); w.y = cvtpk(c0[10], c0[11]); w.z = cvtpk(c0[12], c0[13]); w.w = cvtpk(c0[14], c0[15]); pf[1] = __builtin_bit_cast(bf16x8, w);
          w.x = cvtpk(c1[0], c1[1]); w.y = cvtpk(c1[2], c1[3]); w.z = cvtpk(c1[4], c1[5]); w.w = cvtpk(c1[6], c1[7]); pf[2] = __builtin_bit_cast(bf16x8, w);
          w.x = cvtpk(c1[8], c1[9]); w.y = cvtpk(c1[10], c1[11]); w.z = cvtpk(c1[12], c1[13]); w.w = cvtpk(c1[14], c1[15]); pf[3] = __builtin_bit_cast(bf16x8, w); }
        const LAS unsigned char* vb = lds + slot_c * SLOT + KB + vlane;
        s16x4 lo = vtr(vb), hh = vtr(vb + 512);
#pragma unroll
        for (int i = 0; i < 8; ++i) {
            const int d0 = i >> 2, ks = i & 3;
            s16x4 nlo = lo, nhh = hh;
            if (i + 1 < 8) { const int o2 = ((i + 1) >> 2) * 4096 + ((i + 1) & 3) * 1024; nlo = vtr(vb + o2); nhh = vtr(vb + o2 + 512); }
            const bf16x8 vf = (bf16x8){lo[0], lo[1], lo[2], lo[3], hh[0], hh[1], hh[2], hh[3]};
            oT[d0] = __builtin_amdgcn_mfma_f32_32x32x16_bf16(vf, pf[ks], oT[d0], 0, 0, 0);
            lo = nlo; hh = nhh;
        }
        if constexpr (!SAFE) {
            if (mv) {
                auto rr = __builtin_amdgcn_permlane32_swap(__float_as_uint(rs), __float_as_uint(rs), false, false);
                const float rrow = __uint_as_float(rr[0]) + __uint_as_float(rr[1]);
                ovf = ovf || !(rrow < 1.0e30f);
                const int ex = __builtin_amdgcn_frexp_expf(rrow) - 1;
                dl = (float)(ex > 0 ? ex : 0); const float al = __builtin_amdgcn_exp2f(-dl); lrun *= al;
#pragma unroll
                for (int r = 0; r < 16; ++r) { n0[r] -= dl; n1[r] -= dl; negm[r] -= dl; oT[0][r] *= al; oT[1][r] *= al; }
            }
        }
    };
    dma(kt0, 0); dma(kt0 + 1, 1); dma(kt0 + 2, 2);
    wait_bar(true);
    f32x16 pA0, pA1, pB0, pB1;
    qk(0, pA0, pA1);
    { mrun = tilemax(pA0, pA1);
#pragma unroll
      for (int r = 0; r < 16; ++r) negm[r] = -mrun;
      qk(0, pA0, pA1); }
    int sc = 0;
    for (int kt = kt0; kt < kt1; kt += 2) {
        { const int s1 = (sc + 1) & 3, s3 = (sc + 3) & 3;
          if (kt + 3 < kt1) dma(kt + 3, s3);
          step(pA0, pA1, pB0, pB1, sc, s1);
          wait_bar(kt + 3 < kt1);
          sc = s1; }
        { const int s1 = (sc + 1) & 3, s3 = (sc + 3) & 3;
          if (kt + 4 < kt1) dma(kt + 4, s3);
          step(pB0, pB1, pA0, pA1, sc, s1);
          wait_bar(kt + 4 < kt1);
          sc = s1; }
    }
    { auto rr = __builtin_amdgcn_permlane32_swap(__float_as_uint(lrun), __float_as_uint(lrun), false, false); lrun = __uint_as_float(rr[0]) + __uint_as_float(rr[1]); }
    const float inv = 1.0f / lrun;
    bf16_t* orow = S.O + (size_t)(q0 + wid * 32 + r32) * S.opitch;
#pragma unroll
    for (int d0 = 0; d0 < 2; ++d0)
#pragma unroll
        for (int g = 0; g < 4; ++g) { u32x2 w; w.x = cvtpk(oT[d0][4 * g] * inv, oT[d0][4 * g + 1] * inv); w.y = cvtpk(oT[d0][4 * g + 2] * inv, oT[d0][4 * g + 3] * inv);
            *(u32x2*)(orow + 32 * d0 + 8 * g + 4 * hi) = w; }
    return ovf;
}
template <int DQK>
__device__ __forceinline__ void attn_unit(const Frame& F, const AttnSrc<DQK>& S, int q0, int lat0, int ctx0, int kt0, int kt1) {
    volatile LAS unsigned* flag = (volatile LAS unsigned*)(F.lds + LDSCTL_OFF);
    const bool ovf = attn_run<DQK, false>(F, S, q0, lat0, ctx0, kt0, kt1);
    if (__any(ovf) && F.lane == 0) flag[0] = 1u;
    __syncthreads();
    const bool redo = __builtin_amdgcn_readfirstlane((int)flag[0]) != 0;
    __syncthreads();
    if (redo) { if (F.tid == 0) flag[0] = 0u; (void)attn_run<DQK, true>(F, S, q0, lat0, ctx0, kt0, kt1); }
}

__device__ __forceinline__ int sig5(int c) { return (c & ~12) | ((c & 8) >> 1) | ((c & 4) << 1); }

__global__ void __launch_bounds__(512, 2) mk_fwd(Args args) {
    extern __shared__ __attribute__((aligned(16))) unsigned char lds_raw[];
    Frame F;
    F.lds = (LAS unsigned char*)lds_raw; F.ws = args.ws;
    F.tid = threadIdx.x; F.lane = F.tid & 63; F.wave = __builtin_amdgcn_readfirstlane(F.tid >> 6);
    F.G = gridDim.x; { const int bx = blockIdx.x; F.vcu = (F.G % 8 == 0) ? (bx % 8) * (F.G / 8) + bx / 8 : bx; }
    volatile LAS unsigned* MISC = (volatile LAS unsigned*)(F.lds + LDSCTL_OFF);
    if (F.tid < 64) MISC[F.tid] = 0u;
    __syncthreads();
    unsigned* ctl = wsp<unsigned>(F, O_CTL);
#if MK_ONE_LAUNCH
    XcdBarrier bar = xcd_barrier_post(ctl + CW_BAR, MISC + 8);
#define GRID_BAR() xcd_barrier(bar)
#else
#define GRID_BAR() do {} while (0)
#endif
    const int lo = args.ph_lo, hi_ph = args.ph_hi;
#define IN(k) (lo <= (k) && (k) < hi_ph)
#define SEAM(k) do { if (IN(k) && IN((k) + 1)) GRID_BAR(); } while (0)
    const int lane = F.lane, wave = F.wave, tid = F.tid;
    const int gw = F.vcu * 8 + wave, NGW = F.G * 8;

    const float* x_in = args.in[I_X]; const float* ctx_in = args.in[I_CTX];
    float* MODV = wsp<float>(F, O_MODV);
    float* TAB16 = wsp<float>(F, O_TAB16); float* TAB32 = wsp<float>(F, O_TAB32);
    float* HC = wsp<float>(F, O_HC);
    bf16_t* U = wsp<bf16_t>(F, O_U);
    float* Y = wsp<float>(F, O_Y);
    const float* normg = args.in[I_NORMG];
#define MV(layer, bidx, k) (MODV + ((size_t)((layer) * 5 + (bidx)) * 6 + (k)) * D)

    if (IN(0)) {
        {
            LAS float* sc = (LAS float*)F.lds;
            LAS float* red = sc + 5 * 1024;
            for (int i = tid; i < 5 * 1024; i += 512) { const int b = i >> 10, k = i & 1023; const float cv = (b < 4) ? args.in[I_C][b * 1024 + k] : args.in[I_CCTX][k]; sc[i] = cv / (1.0f + __expf(-cv)); }
            __syncthreads();
            for (int unit = F.vcu; unit < 192; unit += F.G) {
                const int layer = unit / 96, cb = unit % 96, col = cb * 64 + lane;
                const float* W = args.in[I_MODW] + (size_t)layer * D * 6144 + col;
                float a0 = 0.f, a1 = 0.f, a2 = 0.f, a3 = 0.f, a4 = 0.f;
#pragma unroll 16
                for (int kk = 0; kk < 128; ++kk) { const int k = wave * 128 + kk; const float w = W[(size_t)k * 6144];
                    a0 += sc[k] * w; a1 += sc[1024 + k] * w; a2 += sc[2048 + k] * w; a3 += sc[3072 + k] * w; a4 += sc[4096 + k] * w; }
                red[(wave * 5 + 0) * 64 + lane] = a0; red[(wave * 5 + 1) * 64 + lane] = a1; red[(wave * 5 + 2) * 64 + lane] = a2; red[(wave * 5 + 3) * 64 + lane] = a3; red[(wave * 5 + 4) * 64 + lane] = a4;
                __syncthreads();
                if (tid < 320) { const int b = tid >> 6, cc = tid & 63; float s = 0.f;
#pragma unroll
                    for (int w = 0; w < 8; ++w) s += red[(w * 5 + b) * 64 + cc];
                    MODV[(size_t)(layer * 5 + b) * 6144 + cb * 64 + cc] = s + args.in[I_MODB][layer * 6144 + cb * 64 + cc]; }
                __syncthreads();
            }
        }
        if (blockIdx.x == 0) {
            for (int i = tid; i < 64 * 8; i += 512) { const int pos = i >> 3, f = i & 7; const float fr = powf(10000.0f, -(float)f / 8.0f), a = (float)pos * fr; TAB16[i] = cosf(a); TAB16[512 + i] = sinf(a); }
            for (int i = tid; i < 64 * 16; i += 512) { const int pos = i >> 4, f = i & 15; const float fr = powf(10000.0f, -(float)f / 16.0f), a = (float)pos * fr; TAB32[i] = cosf(a); TAB32[1024 + i] = sinf(a); }
        }
        {
            LAS float* scr = (LAS float*)(F.lds + wave * 16640);
            int base = 0;
            auto run = [&](const Conv& c) { const int n = (c.K / 64) * (c.Ndst / 32); for (int it = gw - base; it < n; it += NGW) { if (it >= 0) conv_item(c, it, scr, lane); }
                base = (base + n) % NGW; };
            auto run64 = [&](const Conv64& c) { conv64_run(c, scr, lane, gw, NGW, base); };
            run64(Conv64{args.in[I_FWG], args.in[I_FWU], FFN, 1024, N_GU0, wsp<bf16_t>(F, O_WGU0), 3, 0, 0, 64.0f, 1});
            run64(Conv64{args.in[I_FWD], nullptr, 1024, FFN, 1024, wsp<bf16_t>(F, O_WD0), 0, 1024, 0, 1.0f, 0});
            run64(Conv64{args.in[I_GWIN], nullptr, 3104, 1024, N_IN1, wsp<bf16_t>(F, O_WIN1), 0, 3104, 512, 0.08838834764831845f, 0});
            run64(Conv64{args.in[I_GWOUT], nullptr, 1024, 1024, 1024, wsp<bf16_t>(F, O_WOUT1), 0, 1024, 0, 1.0f, 0});
            run64(Conv64{args.in[I_AWOUT], nullptr, 1024, 1024, 1024, wsp<bf16_t>(F, O_WOUT0), 0, 1024, 0, 1.0f, 0});
            run(Conv{args.in[I_AWIN], nullptr, 1440, 1024, N_IN0, wsp<bf16_t>(F, O_WIN0), 1, nullptr});
            run(Conv{args.in[I_AWUQ], nullptr, 768, 384, N_QA, wsp<bf16_t>(F, O_WUQ), 2, args.in[I_AQN]});
            run(Conv{args.in[I_AWUKV], nullptr, 1024, 256, N_KVA, wsp<bf16_t>(F, O_WUKV), 0, args.in[I_AKVN]});
        }
    }
    SEAM(0);

    if (IN(1)) {
        for (int row = gw; row < R; row += NGW) {
            const float* hp = row < RL ? x_in + (size_t)row * D : ctx_in + (size_t)(row - RL) * D;
            f32x4 h[4], uo[4]; load_row(hp, lane, h);
            const int b = row_bidx(row);
            norm_mod_store(h, normg + 0 * D, MV(0, b, 0), MV(0, b, 1), U + (size_t)row * D, lane, uo);
        }
    }
    SEAM(1);

    if (IN(2)) {
        pg8::DenseProb P{U, wsp<bf16_t>(F, O_WIN0), 1024, 1024, 1024, {}}; P.ord.init(R / 256, N_IN0 / 256, F.G, (int)blockIdx.x);
        pg8::EpiBf16 E{wsp<bf16_t>(F, O_Z0), N_IN0, nullptr};
        pg8::gemm_phase(F.lds, P, E);
    }
    SEAM(2);

    if (IN(3)) {
        const bf16_t* Z0 = wsp<bf16_t>(F, O_Z0);
        float* RSQ = wsp<float>(F, O_RSTDQ); float* RSKV = wsp<float>(F, O_RSTDKV);
        bf16_t* QB = wsp<bf16_t>(F, O_QB); bf16_t* KBp = wsp<bf16_t>(F, O_KB); bf16_t* KR = wsp<bf16_t>(F, O_KR);
        const float* qkn = args.in[I_AQKN];
        for (int row = gw; row < R; row += NGW) {
            const unsigned* z32 = (const unsigned*)(Z0 + (size_t)row * N_IN0);
            float s = 0.f;
#pragma unroll
            for (int j = 0; j < 3; ++j) { const unsigned w = z32[lane + 64 * j]; const float a = bflo(w), b = bfhi(w); s += a * a + b * b; }
            s = wave_sum(s);
            float s2 = 0.f;
#pragma unroll
            for (int j = 0; j < 2; ++j) { const unsigned w = z32[192 + lane + 64 * j]; const float a = bflo(w), b = bfhi(w); s2 += a * a + b * b; }
            s2 = wave_sum(s2);
            if (lane == 0) { RSQ[row] = __builtin_amdgcn_rsqf(s * (1.0f / 384.0f) + EPS); RSKV[row] = __builtin_amdgcn_rsqf(s2 * (1.0f / 256.0f) + EPS); }
            const bool lat = row < RL; const int tt = row & (SEQ - 1);
#pragma unroll
            for (int which = 0; which < 2; ++which) {
                if (which == 1 && lane >= 16) break;
                const u32x4 w4 = *(const u32x4*)(Z0 + (size_t)row * N_IN0 + (which ? 1152 : 640) + lane * 8);
                float v[8] = {bflo(w4.x), bfhi(w4.x), bflo(w4.y), bfhi(w4.y), bflo(w4.z), bfhi(w4.z), bflo(w4.w), bfhi(w4.w)};
                float ss = 0.f;
#pragma unroll
                for (int j = 0; j < 8; ++j) ss += v[j] * v[j];
                ss += __shfl_xor(ss, 1); ss += __shfl_xor(ss, 2); ss += __shfl_xor(ss, 4);
                const float rstd = __builtin_amdgcn_rsqf(ss * (1.0f / 64.0f) + EPS);
                const int jp = lane & 7, half = jp >> 2, i0 = 4 * (jp & 3);
                const float* gn = qkn + which * 64 + half * 32;
#pragma unroll
                for (int pz = 0; pz < 4; ++pz) { v[2 * pz] *= rstd * gn[i0 + pz]; v[2 * pz + 1] *= rstd * gn[16 + i0 + pz]; }
                if (lat) { const int pos = half ? (tt & 63) : (tt >> 6);
                    const f32x4 cs = *(const f32x4*)(TAB32 + pos * 16 + i0), sn = *(const f32x4*)(TAB32 + 1024 + pos * 16 + i0);
#pragma unroll
                    for (int pz = 0; pz < 4; ++pz) { const float a = v[2 * pz], b = v[2 * pz + 1]; v[2 * pz] = a * cs[pz] - b * sn[pz]; v[2 * pz + 1] = b * cs[pz] + a * sn[pz]; } }
                const float osc = which ? 1.0f : 0.125f * LOG2E;
                u32x4 o; o.x = cvtpk(v[0] * osc, v[1] * osc); o.y = cvtpk(v[2] * osc, v[3] * osc); o.z = cvtpk(v[4] * osc, v[5] * osc); o.w = cvtpk(v[6] * osc, v[7] * osc);
                if (which == 0) *(u32x4*)(QB + (size_t)row * 512 + lane * 8) = o; else *(u32x4*)(KBp + (size_t)row * 128 + lane * 8) = o;
            }
            if (lane < 4) {
                const u32x4 w4 = *(const u32x4*)(Z0 + (size_t)row * N_IN0 + 1408 + lane * 8);
                float v[8] = {bflo(w4.x), bfhi(w4.x), bflo(w4.y), bfhi(w4.y), bflo(w4.z), bfhi(w4.z), bflo(w4.w), bfhi(w4.w)};
                if (lat) { const int half = lane >> 1, i0 = 4 * (lane & 1); const int pos = half ? (tt & 63) : (tt >> 6);
                    const f32x4 cs = *(const f32x4*)(TAB16 + pos * 8 + i0), sn = *(const f32x4*)(TAB16 + 512 + pos * 8 + i0);
#pragma unroll
                    for (int pz = 0; pz < 4; ++pz) { const float a = v[2 * pz], b = v[2 * pz + 1]; v[2 * pz] = a * cs[pz] - b * sn[pz]; v[2 * pz + 1] = b * cs[pz] + a * sn[pz]; } }
                u32x4 o; o.x = cvtpk(v[0], v[1]); o.y = cvtpk(v[2], v[3]); o.z = cvtpk(v[4], v[5]); o.w = cvtpk(v[6], v[7]);
                *(u32x4*)(KR + (size_t)row * 32 + lane * 8) = o;
            }
        }
    }
    SEAM(3);

    if (IN(4)) {
        { pg8::DenseProb P{wsp<bf16_t>(F, O_Z0), wsp<bf16_t>(F, O_WUQ), 384, N_IN0, 384, {}}; P.ord.init(R / 256, N_QA / 256, F.G, (int)blockIdx.x);
          pg8::EpiQA E{wsp<bf16_t>(F, O_QA), wsp<float>(F, O_RSTDQ), TAB16, 0.10206207261596577f * LOG2E};
          pg8::gemm_phase(F.lds, P, E); }
        { pg8::DenseProb P{wsp<bf16_t>(F, O_Z0) + 384, wsp<bf16_t>(F, O_WUKV), 256, N_IN0, 256, {}}; P.ord.init(R / 256, N_KVA / 256, F.G, (int)((blockIdx.x + F.G - (204 % F.G)) % F.G));
          pg8::EpiBf16 E{wsp<bf16_t>(F, O_KVA), N_KVA, wsp<float>(F, O_RSTDKV)};
          pg8::gemm_phase(F.lds, P, E); }
    }
    SEAM(4);

    if (IN(5)) {
        const bf16_t* QA = wsp<bf16_t>(F, O_QA); const bf16_t* KVA = wsp<bf16_t>(F, O_KVA); const bf16_t* QB = wsp<bf16_t>(F, O_QB);
        const bf16_t* KBp = wsp<bf16_t>(F, O_KB); const bf16_t* KR = wsp<bf16_t>(F, O_KR); const bf16_t* Z0 = wsp<bf16_t>(F, O_Z0);
        bf16_t* AO = wsp<bf16_t>(F, O_AO);
        for (int i = 0; i < 3; ++i) {
            int b, hh, q0, kt0, kt1;
            if (i < 2) { const int m = i * 256 + F.vcu; b = m >> 7; hh = (m >> 4) & 7; q0 = b * SEQ + (m & 15) * 256; kt0 = 0; kt1 = 68; }
            else { if (F.vcu >= 32) break; b = (F.vcu >> 3) & 3; hh = F.vcu & 7; q0 = RL + b * CTX; kt0 = 64; kt1 = 68; }
            const int lat0 = b * SEQ, ctx0 = RL + b * CTX;
            AttnSrc<96> S{QA + hh * 64, N_QA, QA + 512 + hh * 32, KVA + hh * 128, N_KVA, KR, 32, KVA + hh * 128 + 64, N_KVA, AO + hh * 64, D};
            attn_unit<96>(F, S, q0, lat0, ctx0, kt0, kt1);
        }
        for (int i = 0; i < 3; ++i) {
            int b, hh, q0, kt0, kt1;
            if (i < 2) { const int m = i * 256 + F.vcu; b = m >> 7; hh = (m >> 4) & 7; q0 = b * SEQ + (m & 15) * 256; kt0 = 0; kt1 = 68; }
            else { if (F.vcu < 32 || F.vcu >= 64) break; b = (F.vcu >> 3) & 3; hh = F.vcu & 7; q0 = RL + b * CTX; kt0 = 64; kt1 = 68; }
            const int lat0 = b * SEQ, ctx0 = RL + b * CTX; const int kvh = hh >> 2;
            AttnSrc<64> S{QB + hh * 64, 512, nullptr, KBp + kvh * 64, 128, nullptr, 0, Z0 + 1280 + kvh * 64, N_IN0, AO + 512 + hh * 64, D};
            attn_unit<64>(F, S, q0, lat0, ctx0, kt0, kt1);
        }
    }
    SEAM(5);

    if (IN(6)) {
        pg8::DenseProb P{wsp<bf16_t>(F, O_AO), wsp<bf16_t>(F, O_WOUT0), 1024, 1024, 1024, {}}; P.ord.init(RL / 256, 4, F.G, (int)blockIdx.x);
        pg8::EpiBf16 E{(bf16_t*)Y, D, nullptr};
        pg8::gemm_phase(F.lds, P, E);
    }
    SEAM(6);


    auto post0 = [&](int row) {
            const float* hp = row < RL ? x_in + (size_t)row * D : ctx_in + (size_t)(row - RL) * D;
            float* ho = row < RL ? args.out + (size_t)row * D : HC + (size_t)(row - RL) * D;
            const int b = row_bidx(row);
            f32x4 y[4], h[4], uo[4]; load_row_bf16((const bf16_t*)Y + (size_t)row * D, lane, y); load_row(hp, lane, h);
            const float rstd = __builtin_amdgcn_rsqf(row_ssq(y) * (1.0f / D) + EPS);
#pragma unroll
            for (int j = 0; j < 4; ++j) { const int c = 4 * lane + 256 * j; const f32x4 g = *(const f32x4*)(normg + 1 * D + c), mg = *(const f32x4*)(MV(0, b, 2) + c);
                h[j] = h[j] + mg * (y[j] * rstd * g); *(f32x4*)(ho + c) = h[j]; }
            norm_mod_store(h, normg + 2 * D, MV(0, b, 3), MV(0, b, 4), nullptr, lane, uo, wsp<unsigned char>(F, O_U) + (size_t)row * D);
    };
    if (IN(7)) {
        const bool split = F.G > 32;
        if (!split || blockIdx.x < 16) {
            pg8::DenseProb P{wsp<bf16_t>(F, O_AO) + (size_t)RL * D, wsp<bf16_t>(F, O_WOUT0), 1024, 1024, 1024, {}}; P.ord.init(RC / 256, 4, split ? 16 : F.G, (int)blockIdx.x);
            pg8::EpiBf16 E{(bf16_t*)Y + (size_t)RL * D, D, nullptr};
            pg8::gemm_phase(F.lds, P, E);
        }
        if (!split) { for (int row = gw; row < RL; row += NGW) post0(row); }
        else if (blockIdx.x >= 16) { for (int row = ((int)blockIdx.x - 16) * 8 + wave; row < RL; row += (F.G - 16) * 8) post0(row); }
    }
    SEAM(7);
    if (IN(8)) { for (int row = RL + gw; row < R; row += NGW) post0(row); }
    SEAM(8);


    if (IN(9)) {
        pg8::DenseProb8<125, 121> P{wsp<unsigned char>(F, O_U), wsp<unsigned char>(F, O_WGU0), 512, 512, 1024, {}}; P.ord.init(R / 256, N_GU0 / 256, F.G, (int)blockIdx.x);
        pg8::EpiSwiglu E{wsp<bf16_t>(F, O_H0), FFN};
        pg8::gemm_phase(F.lds, P, E);
    }
    SEAM(9);
    if (IN(10)) {
        pg8::DenseProb P{wsp<bf16_t>(F, O_H0), wsp<bf16_t>(F, O_WD0), FFN, FFN, FFN, {}}; P.ord.init(RL / 256, 4, F.G, (int)blockIdx.x);
        pg8::EpiBf16 E{(bf16_t*)Y, D, nullptr};
        pg8::gemm_phase(F.lds, P, E);
    }
    SEAM(10);


    auto post1 = [&](int row) {
            float* hp = row < RL ? args.out + (size_t)row * D : HC + (size_t)(row - RL) * D;
            const int b = row_bidx(row);
            f32x4 y[4], h[4], uo[4]; load_row_bf16((const bf16_t*)Y + (size_t)row * D, lane, y); load_row(hp, lane, h);
            const float rstd = __builtin_amdgcn_rsqf(row_ssq(y) * (1.0f / D) + EPS);
#pragma unroll
            for (int j = 0; j < 4; ++j) { const int c = 4 * lane + 256 * j; const f32x4 g = *(const f32x4*)(normg + 3 * D + c), mg = *(const f32x4*)(MV(0, b, 5) + c);
                h[j] = h[j] + mg * (y[j] * rstd * g); *(f32x4*)(hp + c) = h[j]; }
            norm_mod_store(h, normg + 4 * D, MV(1, b, 0), MV(1, b, 1), U + (size_t)row * D, lane, uo);
    };
    if (IN(11)) {
        const bool split = F.G > 32;
        if (!split || blockIdx.x < 16) {
            pg8::DenseProb P{wsp<bf16_t>(F, O_H0) + (size_t)RL * FFN, wsp<bf16_t>(F, O_WD0), FFN, FFN, FFN, {}}; P.ord.init(RC / 256, 4, split ? 16 : F.G, (int)blockIdx.x);
            pg8::EpiBf16 E{(bf16_t*)Y + (size_t)RL * D, D, nullptr};
            pg8::gemm_phase(F.lds, P, E);
        }
        if (!split) { for (int row = gw; row < RL; row += NGW) post1(row); }
        else if (blockIdx.x >= 16) { for (int row = ((int)blockIdx.x - 16) * 8 + wave; row < RL; row += (F.G - 16) * 8) post1(row); }
    }
    SEAM(11);
    if (IN(12)) { for (int row = RL + gw; row < R; row += NGW) post1(row); }
    SEAM(12);


    if (IN(13)) {
        pg8::DenseProb P{U, wsp<bf16_t>(F, O_WIN1), 1024, 1024, 1024, {}}; P.ord.init(R / 256, N_IN1 / 256, F.G, (int)blockIdx.x);
        pg8::EpiIn1 E{wsp<bf16_t>(F, O_QK1), wsp<bf16_t>(F, O_V1), wsp<bf16_t>(F, O_G1), wsp<bf16_t>(F, O_RR)};
        pg8::gemm_phase(F.lds, P, E);
    }
    SEAM(13);

    if (IN(14)) {
        const bf16_t* QK1 = wsp<bf16_t>(F, O_QK1); const bf16_t* V1 = wsp<bf16_t>(F, O_V1); const bf16_t* RRp = wsp<bf16_t>(F, O_RR);
        bf16_t* QDd[2] = {wsp<bf16_t>(F, O_QDF), wsp<bf16_t>(F, O_QDB)}; bf16_t* KId[2] = {wsp<bf16_t>(F, O_KIF), wsp<bf16_t>(F, O_KIB)}; bf16_t* KTd[2] = {wsp<bf16_t>(F, O_KTF), wsp<bf16_t>(F, O_KTB)};
        bf16_t* VT = wsp<bf16_t>(F, O_VT); float* ECL = wsp<float>(F, O_ECL);
        LAS float* tot = (LAS float*)F.lds;
        const int dkp = tid & 63, dk0 = 2 * dkp, tq = tid >> 6;
        int hh_loaded = -1; float w2[2][16][2], bg[2][2];
        for (int item = F.vcu; item < 544 * 4; item += F.G) {
            const int rc = item >> 2, hh = item & 3, row0 = rc * 32;
            if (hh != hh_loaded) {
                hh_loaded = hh;
#pragma unroll
                for (int d = 0; d < 2; ++d) { const f32x2_t bv = *(const f32x2_t*)(args.in[I_GBGATE] + d * 512 + hh * 128 + dk0); bg[d][0] = bv[0]; bg[d][1] = bv[1];
#pragma unroll
                    for (int j = 0; j < 16; ++j) { const f32x2_t wv = *(const f32x2_t*)(args.in[I_GGATE2] + (size_t)(d * 16 + j) * 512 + hh * 128 + dk0); w2[d][j][0] = wv[0]; w2[d][j][1] = wv[1]; } }
            }
            float a[2][4][2];
#pragma unroll
            for (int i = 0; i < 4; ++i) { const int row = row0 + 4 * tq + i;
                const u32x4* rp = (const u32x4*)(RRp + (size_t)row * 256);
#pragma unroll
                for (int d = 0; d < 2; ++d) { const u32x4 r0 = rp[2 * d], r1 = rp[2 * d + 1];
                    const float rv[16] = {bflo(r0.x), bfhi(r0.x), bflo(r0.y), bfhi(r0.y), bflo(r0.z), bfhi(r0.z), bflo(r0.w), bfhi(r0.w), bflo(r1.x), bfhi(r1.x), bflo(r1.y), bfhi(r1.y), bflo(r1.z), bfhi(r1.z), bflo(r1.w), bfhi(r1.w)};
#pragma unroll
                    for (int c = 0; c < 2; ++c) { float z = bg[d][c];
#pragma unroll
                        for (int j = 0; j < 16; ++j) z += rv[j] * w2[d][j][c];
                        a[d][i][c] = (fminf(z, 0.f) - __logf(1.0f + __expf(-fabsf(z)))) * (1.0f / 16.0f); } } }
            float cf[4][2], sb[4][2];
#pragma unroll
            for (int c = 0; c < 2; ++c) { float sfw = 0.f;
#pragma unroll
                for (int i = 0; i < 4; ++i) { sfw += a[0][i][c]; cf[i][c] = sfw; }
                float sbw = 0.f;
#pragma unroll
                for (int i = 3; i >= 0; --i) { sbw += a[1][i][c]; sb[i][c] = sbw; } }
            *(LAS f32x2_t*)(tot + (0 * 8 + tq) * 128 + dk0) = (f32x2_t){cf[3][0], cf[3][1]};
            *(LAS f32x2_t*)(tot + (1 * 8 + tq) * 128 + dk0) = (f32x2_t){sb[0][0], sb[0][1]};
            __syncthreads();
            float offF[2] = {0.f, 0.f}, offB[2] = {0.f, 0.f}, clF[2] = {0.f, 0.f}, clB[2] = {0.f, 0.f};
#pragma unroll
            for (int g = 0; g < 8; ++g) { const f32x2_t tf = *(const LAS f32x2_t*)(tot + (0 * 8 + g) * 128 + dk0), tb = *(const LAS f32x2_t*)(tot + (1 * 8 + g) * 128 + dk0);
#pragma unroll
                for (int c = 0; c < 2; ++c) { clF[c] += tf[c]; clB[c] += tb[c]; if (g < tq) offF[c] += tf[c]; if (g > tq) offB[c] += tb[c]; } }
            __syncthreads();
            const int pc = hh * 128 + (dk0 & ~31) + sig5(dk0 & 31);
#pragma unroll
            for (int i = 0; i < 4; ++i) { const int row = row0 + 4 * tq + i;
                const unsigned qw = *(const unsigned*)(QK1 + (size_t)row * D + hh * 128 + dk0), kw = *(const unsigned*)(QK1 + (size_t)row * D + 512 + hh * 128 + dk0);
                const float q[2] = {bflo(qw), bfhi(qw)}, k[2] = {bflo(kw), bfhi(kw)};
                float qdv[2][2], kiv[2][2];
#pragma unroll
                for (int c = 0; c < 2; ++c) { const float cF = offF[c] + cf[i][c], cB = offB[c] + sb[i][c];
                    qdv[0][c] = q[c] * __expf(cF); kiv[0][c] = k[c] * __expf(-cF); qdv[1][c] = q[c] * __expf(cB); kiv[1][c] = k[c] * __expf(-cB); }
#pragma unroll
                for (int d = 0; d < 2; ++d) {
                    *(unsigned*)(QDd[d] + (size_t)row * 512 + pc) = cvtpk(qdv[d][0], qdv[d][1]);
                    const unsigned kp = cvtpk(kiv[d][0], kiv[d][1]);
                    *(unsigned*)(KId[d] + (size_t)row * 512 + pc) = kp;
                } }
            if (tq == 0) { *(f32x2_t*)(ECL + ((size_t)(rc * 2 + 0) * 4 + hh) * 256 + dk0) = (f32x2_t){__expf(clF[0]), __expf(clF[1])};
                           *(f32x2_t*)(ECL + ((size_t)(rc * 2 + 1) * 4 + hh) * 256 + dk0) = (f32x2_t){__expf(clB[0]), __expf(clB[1])}; }
            { const int dv = tid & 255, th = tid >> 8; unsigned vw[8];
#pragma unroll
              for (int i = 0; i < 16; ++i) { const unsigned bv = V1[(size_t)(row0 + 16 * th + i) * D + hh * 256 + dv];
                  const int cc = sig5(i);
                  if (cc & 1) vw[cc >> 1] |= bv << 16; else vw[cc >> 1] = bv; }
              bf16_t* vp = VT + ((size_t)rc * 1024 + hh * 256 + dv) * 32 + 16 * th;
              u32x4 o0; o0.x = vw[0]; o0.y = vw[1]; o0.z = vw[2]; o0.w = vw[3]; *(u32x4*)vp = o0;
              u32x4 o1; o1.x = vw[4]; o1.y = vw[5]; o1.z = vw[6]; o1.w = vw[7]; *(u32x4*)(vp + 8) = o1; }
        }
    }
    SEAM(14);

    if (IN(15)) {
        const int xl = blockIdx.x & 7, jj = blockIdx.x >> 3;
        const bool scan_role = (jj & 1) == 0;
        const int nscan = ((F.G >> 3) + 1) / 2 * 8, nconv = F.G - nscan;
        if ((F.G & 7) == 0 && nconv > 0 && !scan_role) {
            LAS float* scr = (LAS float*)(F.lds + wave * 16640);
            const int cidx = xl * (F.G >> 4) + (jj >> 1); int base = 0; const int gwi = cidx * 8 + wave, ngw = nconv * 8;
            for (int e = 0; e < NEXP; ++e) {
                conv64_run(Conv64{args.in[I_MWG] + (size_t)e * D * EXD, args.in[I_MWU] + (size_t)e * D * EXD, EXD, 1024, N_GU1, wsp<bf16_t>(F, O_WGU1) + (size_t)e * N_GU1 * 1024 / 2, 3, 0, 0, 64.0f, 1}, scr, lane, gwi, ngw, base);
                conv64_run(Conv64{args.in[I_MWD] + (size_t)e * EXD * D, nullptr, 1024, EXD, 1024, wsp<bf16_t>(F, O_WD1) + (size_t)e * 1024 * EXD / 2, 0, 1024, 1024, 64.0f, 1}, scr, lane, gwi, ngw, base);
            }
        } else {
        const bool split = (F.G & 7) == 0 && nconv > 0;
        const int sidx = split ? xl * ((F.G >> 4) + ((F.G >> 3) & 1)) + (jj >> 1) : F.vcu, nsw = split ? nscan : F.G;
        const bf16_t* VT = wsp<bf16_t>(F, O_VT); const float* ECL = wsp<float>(F, O_ECL);
        constexpr int SLOT = 8192 * 2 + 2 * 2048 + 1024;
        const int r32 = lane & 31, hi = lane >> 5;
        for (int unit = sidx; unit < 128; unit += nsw) {
            const int chain = unit >> 2, dvp = unit & 3, b = chain >> 3, hh = (chain >> 1) & 3, dir = chain & 1;
            const int dvb = dvp * 2 + (wave & 1);
            const bf16_t* QDp = wsp<bf16_t>(F, dir ? O_QDB : O_QDF); const bf16_t* KIp = wsp<bf16_t>(F, dir ? O_KIB : O_KIF);
            bf16_t* Odp = wsp<bf16_t>(F, dir ? O_OB : O_OF);
            auto rcof = [&](int step) { return step < 8 ? 512 + b * 8 + (dir ? 7 - step : step) : b * 128 + (dir ? 127 - (step - 8) : (step - 8)); };
            const unsigned lds0 = (unsigned)(size_t)F.lds;
            auto dma = [&](int step, int slot) {
                if (wave < 2) return;
                const int rc = rcof(step); const unsigned sb = lds0 + slot * SLOT;
#pragma unroll
                for (int i = 0; i < 4; ++i) { const int j = (wave - 2) + 6 * i; if (j >= 21) break;
                    if (j < 16) { const int p = j & 7; const int r = 4 * p + (lane >> 4), c = (lane & 15) ^ (r & 15);
                        glds16((j < 8 ? KIp : QDp) + (size_t)(rc * 32 + r) * 512 + hh * 128 + c * 8, (unsigned)__builtin_amdgcn_readfirstlane(sb + j * 1024)); }
                    else if (j < 20) { const int p = j - 16; const int r = 16 * (p & 1) + (lane >> 2), c = (lane & 3) ^ ((r >> 2) & 3);
                        glds16(VT + ((size_t)rc * 1024 + hh * 256 + (dvp * 2 + (p >> 1)) * 32 + r) * 32 + c * 8, (unsigned)__builtin_amdgcn_readfirstlane(sb + 16384 + p * 1024)); }
                    else glds16(ECL + ((size_t)(rc * 2 + dir) * 4 + hh) * 256 + lane * 4, (unsigned)__builtin_amdgcn_readfirstlane(sb + 20480)); }
            };
            auto wait_bar = [&](int ngrp) { if (wave < 2) { asm volatile("s_waitcnt lgkmcnt(0)\n\ts_barrier" ::: "memory"); }
                else if (ngrp == 0) { WAIT_BAR(0); } else if (ngrp == 1) { if (wave < 5) { WAIT_BAR(4); } else { WAIT_BAR(3); } } else { if (wave < 5) { WAIT_BAR(8); } else { WAIT_BAR(6); } } };
            f32x16 S4[4];
#pragma unroll
            for (int k = 0; k < 4; ++k)
#pragma unroll
                for (int r = 0; r < 16; ++r) S4[k][r] = 0.f;
            dma(0, 0); dma(1, 1); dma(2, 2);
            wait_bar(2);
            int slot = 0;
            for (int step = 0; step < 136; ++step) {
                if (step + 3 < 136) dma(step + 3, (slot + 3) & 3);
                if (wave < 2) {
                    const LAS unsigned char* sb = F.lds + slot * SLOT;
                    const int x15 = r32 & 15, x3 = (r32 >> 2) & 3;
                    const int trq = (lane & 15) >> 2, trp = lane & 3, trpp = ((trp & 1) << 1) | (trp >> 1), trg = (lane >> 4) & 1;
                    const LAS unsigned char* vbase = sb + 16384 + wave * 2048;
                    bf16x8 qdF[8], kiF[8];
#pragma unroll
                    for (int k = 0; k < 8; ++k) { qdF[k] = *(const LAS bf16x8*)(sb + 8192 + r32 * 256 + (((2 * k + hi) ^ x15) << 4)); kiF[k] = *(const LAS bf16x8*)(sb + r32 * 256 + (((2 * k + hi) ^ x15) << 4)); }
                    const bf16x8 vF0 = *(const LAS bf16x8*)(vbase + r32 * 64 + ((hi ^ x3) << 4)), vF1 = *(const LAS bf16x8*)(vbase + r32 * 64 + (((2 + hi) ^ x3) << 4));
                    __builtin_amdgcn_sched_barrier(0);
                    f32x16 o;
#pragma unroll
                    for (int r = 0; r < 16; ++r) o[r] = 0.f;
                    if (step >= 8) {
                        f32x16 sc;
#pragma unroll
                        for (int r = 0; r < 16; ++r) sc[r] = 0.f;
#pragma unroll
                        for (int k = 0; k < 8; ++k) sc = __builtin_amdgcn_mfma_f32_32x32x16_bf16(kiF[k], qdF[k], sc, 0, 0, 0);
#pragma unroll
                        for (int r = 0; r < 16; ++r) { const int s = (r & 3) + 8 * (r >> 2) + 4 * hi; const bool keep = dir ? (s >= r32) : (s <= r32); sc[r] = keep ? sc[r] : 0.f; }
                        u32x4 w; bf16x8 pf0, pf1;
                        w.x = cvtpk(sc[0], sc[1]); w.y = cvtpk(sc[2], sc[3]); w.z = cvtpk(sc[4], sc[5]); w.w = cvtpk(sc[6], sc[7]); pf0 = __builtin_bit_cast(bf16x8, w);
                        w.x = cvtpk(sc[8], sc[9]); w.y = cvtpk(sc[10], sc[11]); w.z = cvtpk(sc[12], sc[13]); w.w = cvtpk(sc[14], sc[15]); pf1 = __builtin_bit_cast(bf16x8, w);
                        o = __builtin_amdgcn_mfma_f32_32x32x16_bf16(vF0, pf0, o, 0, 0, 0);
                        o = __builtin_amdgcn_mfma_f32_32x32x16_bf16(vF1, pf1, o, 0, 0, 0);
#pragma unroll
                        for (int blk = 0; blk < 4; ++blk)
#pragma unroll
                            for (int s2 = 0; s2 < 2; ++s2) { u32x4 ws4; ws4.x = cvtpk(S4[blk][8 * s2], S4[blk][8 * s2 + 1]); ws4.y = cvtpk(S4[blk][8 * s2 + 2], S4[blk][8 * s2 + 3]);
                                ws4.z = cvtpk(S4[blk][8 * s2 + 4], S4[blk][8 * s2 + 5]); ws4.w = cvtpk(S4[blk][8 * s2 + 6], S4[blk][8 * s2 + 7]);
                                o = __builtin_amdgcn_mfma_f32_32x32x16_bf16(__builtin_bit_cast(bf16x8, ws4), qdF[2 * blk + s2], o, 0, 0, 0); }
                        const int rc = rcof(step);
                        bf16_t* op = Odp + (size_t)(rc * 32 + r32) * D + hh * 256 + dvb * 32 + 4 * hi;
#pragma unroll
                        for (int g = 0; g < 4; ++g) { u32x2 w2; w2.x = cvtpk(o[4 * g], o[4 * g + 1]); w2.y = cvtpk(o[4 * g + 2], o[4 * g + 3]); *(u32x2*)(op + 8 * g) = w2; }
                    }
#pragma unroll
                    for (int blk = 0; blk < 4; ++blk) {
                        bf16x8 kt0, kt1;
                        { const int chunk = 4 * blk + 2 * trg + (trpp >> 1); const int wb = (trpp & 1) * 8;
                          const int tl = 4 * hi + trq, th = tl + 8;
                          const LAS unsigned char* pl = sb + tl * 256 + ((chunk ^ tl) << 4) + wb; const LAS unsigned char* ph = sb + th * 256 + ((chunk ^ th) << 4) + wb;
                          const s16x4 a0 = vtr(pl), a1 = vtr(ph), b0 = vtr(pl + 4096), b1 = vtr(ph + 4096);
                          kt0 = (bf16x8){a0[0], a0[1], a0[2], a0[3], a1[0], a1[1], a1[2], a1[3]}; kt1 = (bf16x8){b0[0], b0[1], b0[2], b0[3], b1[0], b1[1], b1[2], b1[3]}; }
                        S4[blk] = __builtin_amdgcn_mfma_f32_32x32x16_bf16(kt0, vF0, S4[blk], 0, 0, 0);
                        S4[blk] = __builtin_amdgcn_mfma_f32_32x32x16_bf16(kt1, vF1, S4[blk], 0, 0, 0);
#pragma unroll
                        for (int g = 0; g < 4; ++g) { const f32x4 e4 = *(const LAS f32x4*)(sb + 20480 + (32 * blk + 8 * g + 4 * hi) * 4);
                            S4[blk][4 * g] *= e4[0]; S4[blk][4 * g + 1] *= e4[1]; S4[blk][4 * g + 2] *= e4[2]; S4[blk][4 * g + 3] *= e4[3]; }
                    }
                }
                wait_bar(step + 3 < 136 ? 2 : (step + 2 < 136 ? 1 : 0));
                slot = (slot + 1) & 3;
            }
        }
        if (!split) {
            LAS float* scr = (LAS float*)(F.lds + wave * 16640); int base = 0;
            for (int e = 0; e < NEXP; ++e) {
                conv64_run(Conv64{args.in[I_MWG] + (size_t)e * D * EXD, args.in[I_MWU] + (size_t)e * D * EXD, EXD, 1024, N_GU1, wsp<bf16_t>(F, O_WGU1) + (size_t)e * N_GU1 * 1024 / 2, 3, 0, 0, 64.0f, 1}, scr, lane, gw, NGW, base);
                conv64_run(Conv64{args.in[I_MWD] + (size_t)e * EXD * D, nullptr, 1024, EXD, 1024, wsp<bf16_t>(F, O_WD1) + (size_t)e * 1024 * EXD / 2, 0, 1024, 1024, 64.0f, 1}, scr, lane, gw, NGW, base);
            }
        }
        }
    }
    SEAM(15);

    if (IN(16)) {
        const bf16_t* OFp = wsp<bf16_t>(F, O_OF); const bf16_t* OBp = wsp<bf16_t>(F, O_OB); const bf16_t* G1 = wsp<bf16_t>(F, O_G1); bf16_t* GA = wsp<bf16_t>(F, O_GA);
        const float* on = args.in[I_GONORM];
        for (int row = gw; row < RL; row += NGW) {
            const u32x4* pf = (const u32x4*)(OFp + (size_t)row * D + lane * 16); const u32x4* pb = (const u32x4*)(OBp + (size_t)row * D + lane * 16); const u32x4* pg = (const u32x4*)(G1 + (size_t)row * D + lane * 16);
            float v[16], gv[16];
#pragma unroll
            for (int q = 0; q < 2; ++q) { const u32x4 a = pf[q], bq = pb[q], gq = pg[q]; const unsigned aw[4] = {a.x, a.y, a.z, a.w}, bw[4] = {bq.x, bq.y, bq.z, bq.w}, gw4[4] = {gq.x, gq.y, gq.z, gq.w};
#pragma unroll
                for (int j = 0; j < 4; ++j) { v[8 * q + 2 * j] = bflo(aw[j]) + bflo(bw[j]); v[8 * q + 2 * j + 1] = bfhi(aw[j]) + bfhi(bw[j]); gv[8 * q + 2 * j] = bflo(gw4[j]); gv[8 * q + 2 * j + 1] = bfhi(gw4[j]); } }
            float ss = 0.f;
#pragma unroll
            for (int j = 0; j < 16; ++j) ss += v[j] * v[j];
            ss += __shfl_xor(ss, 1); ss += __shfl_xor(ss, 2); ss += __shfl_xor(ss, 4); ss += __shfl_xor(ss, 8);
            const float rstd = __builtin_amdgcn_rsqf(ss * (1.0f / 256.0f) + EPS);
            const int c0 = (lane & 15) * 16;
            unsigned ow[8];
#pragma unroll
            for (int j = 0; j < 8; ++j) { const float a = v[2 * j] * rstd * on[c0 + 2 * j] * silu_f(gv[2 * j]), bq = v[2 * j + 1] * rstd * on[c0 + 2 * j + 1] * silu_f(gv[2 * j + 1]); ow[j] = cvtpk(a, bq); }
            u32x4* po = (u32x4*)(GA + (size_t)row * D + lane * 16);
            u32x4 o0; o0.x = ow[0]; o0.y = ow[1]; o0.z = ow[2]; o0.w = ow[3]; po[0] = o0; u32x4 o1; o1.x = ow[4]; o1.y = ow[5]; o1.z = ow[6]; o1.w = ow[7]; po[1] = o1;
        }
    }
    SEAM(16);

    if (IN(17)) {
        pg8::DenseProb P{wsp<bf16_t>(F, O_GA), wsp<bf16_t>(F, O_WOUT1), 1024, 1024, 1024, {}}; P.ord.init(RL / 256, 4, F.G, (int)blockIdx.x);
        pg8::EpiBf16 E{(bf16_t*)Y, D, nullptr};
        pg8::gemm_phase(F.lds, P, E);
    }
    SEAM(17);

    if (IN(18)) {
        int* SEL = wsp<int>(F, O_SEL); int* ROWTOK = wsp<int>(F, O_ROWTOK);
        LAS float* wr_l = (LAS float*)F.lds;
        LAS int* se = (LAS int*)(F.lds + 32768);
        LAS float* sw = (LAS float*)(F.lds + 32768 + 512);
        LAS int* sbase = (LAS int*)(F.lds + 32768 + 1024);
        for (int i = tid; i < 8192; i += 512) wr_l[i] = args.in[I_MROUTER][i];
        __syncthreads();
        for (int tile = F.vcu; tile < RL / 64; tile += F.G) {
            for (int rr = 0; rr < 8; ++rr) {
                const int lr = wave * 8 + rr, row = tile * 64 + lr; const int b = row >> 12;
                float* hp = args.out + (size_t)row * D;
                f32x4 y[4], h[4], uo[4]; load_row_bf16((const bf16_t*)Y + (size_t)row * D, lane, y); load_row(hp, lane, h);
                const float rstd = __builtin_amdgcn_rsqf(row_ssq(y) * (1.0f / D) + EPS);
#pragma unroll
                for (int j = 0; j < 4; ++j) { const int c = 4 * lane + 256 * j; const f32x4 g = *(const f32x4*)(normg + 5 * D + c), mg = *(const f32x4*)(MV(1, b, 2) + c);
                    h[j] = h[j] + mg * (y[j] * rstd * g); *(f32x4*)(hp + c) = h[j]; }
                norm_mod_store(h, normg + 6 * D, MV(1, b, 3), MV(1, b, 4), nullptr, lane, uo, wsp<unsigned char>(F, O_U) + (size_t)row * D);
                float lg[8];
#pragma unroll
                for (int e = 0; e < 8; ++e) lg[e] = 0.f;
#pragma unroll
                for (int j = 0; j < 4; ++j)
#pragma unroll
                    for (int q = 0; q < 4; ++q) { const int k = 4 * lane + 256 * j + q; const LAS f32x4* wp = (const LAS f32x4*)(wr_l + k * 8); const f32x4 w0 = wp[0], w1 = wp[1]; const float uv = uo[j][q];
                        lg[0] += uv * w0[0]; lg[1] += uv * w0[1]; lg[2] += uv * w0[2]; lg[3] += uv * w0[3]; lg[4] += uv * w1[0]; lg[5] += uv * w1[1]; lg[6] += uv * w1[2]; lg[7] += uv * w1[3]; }
#pragma unroll
                for (int e = 0; e < 8; ++e) lg[e] = wave_sum(lg[e]) + args.in[I_MBROUTER][e];
                int e0 = 0; float l0 = lg[0];
#pragma unroll
                for (int e = 1; e < 8; ++e) if (lg[e] > l0) { l0 = lg[e]; e0 = e; }
                int e1 = -1; float l1 = -3.0e38f;
#pragma unroll
                for (int e = 0; e < 8; ++e) if (e != e0 && lg[e] > l1) { l1 = lg[e]; e1 = e; }
                const float p1 = __expf(l1 - l0), w0n = 1.0f / (1.0f + p1), w1n = p1 / (1.0f + p1);
                if (lane == 0) { se[lr * 2] = e0; se[lr * 2 + 1] = e1; sw[lr * 2] = w0n; sw[lr * 2 + 1] = w1n; }
            }
            __syncthreads();
            if (tid < 8) { int c = 0; for (int r2 = 0; r2 < 64; ++r2) c += (se[2 * r2] == tid) + (se[2 * r2 + 1] == tid);
                sbase[tid] = (int)__hip_atomic_fetch_add(ctl + CW_CNT + 64 * tid, (unsigned)c, RLX_AGENT); }
            __syncthreads();
            if (tid < 64) { const int e0 = se[2 * tid], e1 = se[2 * tid + 1]; int r0 = 0, r1 = 0;
                for (int r2 = 0; r2 < tid; ++r2) { const int a0 = se[2 * r2], a1 = se[2 * r2 + 1]; r0 += (a0 == e0) + (a1 == e0); r1 += (a0 == e1) + (a1 == e1); }
                const int p0 = sbase[e0] + r0, p1 = sbase[e1] + r1, tok = tile * 64 + tid;
                ROWTOK[e0 * CAPE + p0] = tok; ROWTOK[e1 * CAPE + p1] = tok;
                int* sp = SEL + (size_t)tok * 8; sp[0] = e0; sp[1] = p0; sp[2] = e1; sp[3] = p1; sp[4] = __float_as_int(sw[2 * tid]); sp[5] = __float_as_int(sw[2 * tid + 1]); }
            __syncthreads();
        }
    }
    SEAM(18);

    pg8::MoeTiles MT;
    if (IN(19) || IN(20) || IN(21)) {
        int acc = 0; MT.tp8 = 0ull; MT.c4a = 0ull; MT.c4b = 0ull;
#pragma unroll
        for (int e = 0; e < 8; ++e) { const int c = (int)__builtin_amdgcn_readfirstlane((int)__hip_atomic_load(ctl + CW_CNT + 64 * e, RLX_AGENT));
            if (e < 4) MT.c4a |= (unsigned long long)(unsigned)c << (16 * e); else MT.c4b |= (unsigned long long)(unsigned)c << (16 * (e - 4));
            MT.tp8 |= (unsigned long long)(unsigned)acc << (8 * e); acc += (c + 255) >> 8; }
        MT.nt = acc;
    }
    if (IN(19)) {
        pg8::MoeGuProb P{wsp<unsigned char>(F, O_U), wsp<unsigned char>(F, O_WGU1), 512, 512, {}, MT, wsp<int>(F, O_ROWTOK)}; P.ord.init(MT.nt, N_GU1 / 256, F.G, (int)blockIdx.x);
        pg8::EpiSwiglu8 E{wsp<unsigned char>(F, O_HM), EXD};
        pg8::gemm_phase(F.lds, P, E);
    }
    SEAM(19);
    if (IN(20)) {
        pg8::MoeDnProb P{wsp<unsigned char>(F, O_HM), wsp<unsigned char>(F, O_WD1), EXD / 2, EXD / 2, {}, MT}; P.ord.init(MT.nt, 4, F.G, (int)blockIdx.x);
        pg8::EpiBf16 E{wsp<bf16_t>(F, O_YE), D, nullptr};
        pg8::gemm_phase(F.lds, P, E);
    }
    SEAM(20);
    if (IN(21)) {
        const int* SEL = wsp<int>(F, O_SEL); const bf16_t* YE = wsp<bf16_t>(F, O_YE);
        for (int row = gw; row < RL; row += NGW) {
            const int b = row >> 12; const int* sp = SEL + (size_t)row * 8;
            const int e0 = sp[0], p0 = sp[1], e1 = sp[2], p1 = sp[3]; const float w0 = __int_as_float(sp[4]), w1 = __int_as_float(sp[5]);
            const int t0 = pg8::moe_tp(MT, e0), t1 = pg8::moe_tp(MT, e1);
            const bf16_t* y0 = YE + ((size_t)t0 * 256 + p0) * D; const bf16_t* y1 = YE + ((size_t)t1 * 256 + p1) * D;
            float* hp = args.out + (size_t)row * D;
            f32x4 y[4], h[4]; load_row(hp, lane, h);
#pragma unroll
            for (int j = 0; j < 4; ++j) { const int c = 4 * lane + 256 * j; const u32x2 a = *(const u32x2*)(y0 + c), bq = *(const u32x2*)(y1 + c);
                y[j][0] = w0 * bflo(a.x) + w1 * bflo(bq.x); y[j][1] = w0 * bfhi(a.x) + w1 * bfhi(bq.x); y[j][2] = w0 * bflo(a.y) + w1 * bflo(bq.y); y[j][3] = w0 * bfhi(a.y) + w1 * bfhi(bq.y); }
            const float rstd = __builtin_amdgcn_rsqf(row_ssq(y) * (1.0f / D) + EPS);
#pragma unroll
            for (int j = 0; j < 4; ++j) { const int c = 4 * lane + 256 * j; const f32x4 g = *(const f32x4*)(normg + 7 * D + c), mg = *(const f32x4*)(MV(1, b, 5) + c);
                *(f32x4*)(hp + c) = h[j] + mg * (y[j] * rstd * g); }
        }
    }
#undef IN
#undef SEAM
#undef MV
}

constexpr int N_PHASES = 22;
extern "C" void kernel_launch(void* const* d_in, const int* in_sizes, int n_in, void* d_out, int out_size, void* d_ws, size_t ws_size, hipStream_t stream) {
    static int grid = 0;
    if (grid == 0) {
        if (n_in != 27 || out_size != RL * D || ws_size < WS_END) { fprintf(stderr, "kernel_launch: unexpected shapes n_in %d out %d ws %zu (need %zu)\n", n_in, out_size, ws_size, (size_t)WS_END); grid = -1; return; }
        int dev = 0, cus = 0, per_cu = 0;
        if (hipGetDevice(&dev) != hipSuccess || hipDeviceGetAttribute(&cus, hipDeviceAttributeMultiprocessorCount, dev) != hipSuccess) { grid = -1; return; }
        if (hipFuncSetAttribute((const void*)mk_fwd, hipFuncAttributeMaxDynamicSharedMemorySize, LDS_BYTES) != hipSuccess) { fprintf(stderr, "kernel_launch: hipFuncSetAttribute failed\n"); grid = -1; return; }
        if (hipOccupancyMaxActiveBlocksPerMultiprocessor(&per_cu, (const void*)mk_fwd, 512, LDS_BYTES) != hipSuccess || per_cu < 1) { fprintf(stderr, "kernel_launch: occupancy query says %d\n", per_cu); }
        (void)hipGetLastError();
        grid = cus;
        if (grid > 256) grid = 256;
    }
    if (grid < 0) return;
    (void)hipMemsetAsync((char*)d_ws + O_CTL, 0, CTL_BYTES, stream);
    Args a{};
    for (int i = 0; i < 27; ++i) a.in[i] = (const float*)d_in[i];
    a.out = (float*)d_out; a.ws = (unsigned char*)d_ws;
#if MK_ONE_LAUNCH
    a.ph_lo = 0; a.ph_hi = N_PHASES;
    hipLaunchKernelGGL(mk_fwd, dim3(grid), dim3(512), LDS_BYTES, stream, a);
#else
    for (int p = 0; p < N_PHASES; ++p) { a.ph_lo = p; a.ph_hi = p + 1; for (int rep = 0; rep < (p == MK_REP ? 2 : 1); ++rep) hipLaunchKernelGGL(mk_fwd, dim3(grid), dim3(512), LDS_BYTES, stream, a); }
#endif
}
```

```cpp
#include <hip/hip_runtime.h>
#include <cstdio>
#include <cstdint>

#ifndef MK_ONE_LAUNCH
#define MK_ONE_LAUNCH 1
#endif
#ifndef MK_EPI2
#define MK_EPI2 0
#endif
#ifndef MK_REP
#define MK_REP -1
#endif

#define LAS __attribute__((address_space(3)))
#define GAS __attribute__((address_space(1)))
typedef unsigned short bf16_t;
typedef short bf16x8 __attribute__((ext_vector_type(8)));
typedef short s16x4 __attribute__((ext_vector_type(4)));
typedef float f32x4 __attribute__((ext_vector_type(4)));
typedef float f32x16 __attribute__((ext_vector_type(16)));
typedef unsigned u32x4 __attribute__((ext_vector_type(4)));
typedef unsigned u32x2 __attribute__((ext_vector_type(2)));
typedef float f32x2_t __attribute__((ext_vector_type(2)));
typedef __bf16 bf16x2_t __attribute__((ext_vector_type(2)));
#define RLX_AGENT __ATOMIC_RELAXED, __HIP_MEMORY_SCOPE_AGENT

__device__ __forceinline__ unsigned cvtpk(float lo, float hi) { f32x2_t v = {lo, hi}; bf16x2_t b = __builtin_convertvector(v, bf16x2_t); return __builtin_bit_cast(unsigned, b); }
__device__ __forceinline__ bf16_t f2bf(float f) { return (bf16_t)(cvtpk(f, 0.f) & 0xffffu); }
__device__ __forceinline__ float bflo(unsigned w) { return __uint_as_float(w << 16); }
__device__ __forceinline__ float bfhi(unsigned w) { return __uint_as_float(w & 0xffff0000u); }
__device__ __forceinline__ float bf2f(bf16_t b) { return __uint_as_float(((unsigned)b) << 16); }
__device__ __forceinline__ float wave_sum(float v) {
#pragma unroll
    for (int o = 1; o < 64; o <<= 1) v += __shfl_xor(v, o);
    return v;
}
__device__ __forceinline__ float fast_exp(float x) { return __builtin_amdgcn_exp2f(x * 1.4426950408889634f); }
__device__ __forceinline__ float clamp8(float x) { return __builtin_amdgcn_fmed3f(x, -448.0f, 448.0f); }
__device__ __forceinline__ unsigned pack_fp8x4(float a, float b, float c, float d) { int w = __builtin_amdgcn_cvt_pk_fp8_f32(clamp8(a), clamp8(b), 0, false); w = __builtin_amdgcn_cvt_pk_fp8_f32(clamp8(c), clamp8(d), w, true); return (unsigned)w; }
__device__ __forceinline__ float swiglu_f(float gp, float up, float k) { return (gp * up) * __builtin_amdgcn_rcpf(__builtin_fmaf(__builtin_amdgcn_exp2f(gp), k, k)); }
__device__ __forceinline__ float silu_f(float g) { return g * __builtin_amdgcn_rcpf(1.0f + fast_exp(-g)); }

#define XB_TMO      128
#define XB_XCNT(j)  (256  + 64 * (j))
#define XB_XSUB(j)  (1280 + 64 * (j))
#define XB_XGEN(j)  (2304 + 64 * (j))
#define XB_TOP      3328
#define XB_TOPGEN   3392
#define XCD_BAR_WORDS 3456
#define XB_SPIN_CAP (1u << 18)
__device__ __forceinline__ unsigned xb_ld(unsigned* p)              { return __hip_atomic_load(p, __ATOMIC_RELAXED, __HIP_MEMORY_SCOPE_AGENT); }
__device__ __forceinline__ unsigned xb_add(unsigned* p, unsigned v) { return __hip_atomic_fetch_add(p, v, __ATOMIC_RELAXED, __HIP_MEMORY_SCOPE_AGENT); }
__device__ __forceinline__ unsigned xb_xcc_id() { return (unsigned)__builtin_amdgcn_s_getreg((3 << 11) | 20) & 0xFu; }
#define XB_SPIN(cond, bar) do { unsigned _sp = 0; while (cond) { __builtin_amdgcn_s_sleep(1); \
    if ((++_sp & 255u) == 0u) { if (xb_ld(&(bar)[XB_TMO])) break; if (_sp > XB_SPIN_CAP) { atomicAdd(&(bar)[XB_TMO], 1u); break; } } } } while (0)
struct XcdBarrier { unsigned* bar; unsigned x; volatile LAS unsigned* st; };
__device__ __forceinline__ XcdBarrier xcd_barrier_post(unsigned* bar, volatile LAS unsigned* st) {
    XcdBarrier b; b.bar = bar; b.x = xb_xcc_id(); b.st = st;
    if (threadIdx.x == 0) (void)xb_add(&bar[XB_XCNT(b.x)], 1u);
    return b;
}
__device__ __forceinline__ void xcd_barrier_complete(unsigned* bar, unsigned x, unsigned& nloc, unsigned& nx) {
    const unsigned G = gridDim.x * gridDim.y * gridDim.z;
    unsigned sum, cnt, mine, sp = 0u;
    for (;;) {
        sum = 0u; cnt = 0u; mine = 0u;
#pragma unroll
        for (unsigned j = 0; j < 16; ++j) { const unsigned c = xb_ld(&bar[XB_XCNT(j)]); sum += c; cnt += (c > 0u) ? 1u : 0u; mine = (j == x) ? c : mine; }
        if (sum == G) break;
        __builtin_amdgcn_s_sleep(1);
        if ((++sp & 255u) == 0u) { if (xb_ld(&bar[XB_TMO])) break; if (sp > XB_SPIN_CAP) { atomicAdd(&bar[XB_TMO], 1u); break; } }
    }
    nloc = mine > 0u ? mine : 1u; nx = cnt > 0u ? cnt : 1u;
}
__device__ __forceinline__ void xcd_barrier(const XcdBarrier& b) {
    asm volatile("s_waitcnt vmcnt(0)" ::: "memory");
    __syncthreads();
    if (threadIdx.x == 0) {
        unsigned* bar = b.bar;
        __builtin_amdgcn_s_waitcnt(0);
        unsigned nloc = b.st[0], nx = b.st[1];
        if (nloc == 0u) { xcd_barrier_complete(bar, b.x, nloc, nx); b.st[0] = nloc; b.st[1] = nx; }
        const unsigned old = xb_add(&bar[XB_XSUB(b.x)], 1u);
        const unsigned gen = old / nloc;
        if (old + 1u == (gen + 1u) * nloc) {
            __builtin_amdgcn_fence(__ATOMIC_RELEASE, "agent");
            asm volatile("s_waitcnt vmcnt(0)" ::: "memory");
            const unsigned og = xb_add(&bar[XB_TOP], 1u);
            const unsigned tg = og / nx;
            if (og + 1u == (tg + 1u) * nx) xb_add(&bar[XB_TOPGEN], 1u);
            else XB_SPIN(xb_ld(&bar[XB_TOPGEN]) == tg, bar);
            __builtin_amdgcn_fence(__ATOMIC_ACQUIRE, "agent");
            xb_add(&bar[XB_XGEN(b.x)], 1u);
            asm volatile("s_waitcnt vmcnt(0)" ::: "memory");
        } else {
            XB_SPIN(xb_ld(&bar[XB_XGEN(b.x)]) == gen, bar);
            __builtin_amdgcn_fence(__ATOMIC_ACQUIRE, "agent");
            asm volatile("s_waitcnt vmcnt(0)" ::: "memory");
        }
    }
    __syncthreads();
}

constexpr int D = 1024, NB = 4, SEQ = 4096, CTX = 256;
constexpr int RL = NB * SEQ;
constexpr int RC = NB * CTX;
constexpr int R = RL + RC;
constexpr float EPS = 1e-6f;
constexpr float LOG2E = 1.4426950408889634f;
constexpr int N_IN0 = 1536, N_QA = 768, N_KVA = 1024, FFN = 2816, N_GU0 = 2 * FFN, N_IN1 = 3328, EXD = 3584, N_GU1 = 2 * EXD, NEXP = 8;
constexpr int CAPE = 16384;

constexpr size_t MiB = 1u << 20;
constexpr size_t O_CTL = 0;
constexpr size_t CTL_BYTES = 65536;
constexpr int CW_BAR = 0;
constexpr int CW_CNT = 8192;
constexpr size_t O_MODV = 1 * MiB;
constexpr size_t O_TAB16 = O_MODV + 256 * 1024;
constexpr size_t O_TAB32 = O_TAB16 + 8192;
constexpr size_t O_RSTDQ = O_TAB32 + 16384;
constexpr size_t O_RSTDKV = O_RSTDQ + 81920;
constexpr size_t O_SEL = 2 * MiB;
constexpr size_t O_ROWTOK = 3 * MiB;
constexpr size_t O_WGU1 = 4 * MiB;
constexpr size_t O_YE = O_WGU1;
constexpr size_t O_WD1 = 116 * MiB;
constexpr size_t O_WIN1 = 172 * MiB;
constexpr size_t O_WOUT1 = 179 * MiB;
constexpr size_t O_WIN0 = 181 * MiB;
constexpr size_t O_WUQ = 184 * MiB;
constexpr size_t O_WUKV = 185 * MiB;
constexpr size_t O_WOUT0 = 186 * MiB;
constexpr size_t O_WGU0 = 188 * MiB;
constexpr size_t O_WD0 = 199 * MiB;
constexpr size_t O_HC = 205 * MiB;
constexpr size_t O_U = 209 * MiB;
constexpr size_t O_Y = 243 * MiB;
constexpr size_t O_Z0 = 311 * MiB;
constexpr size_t O_QA = 362 * MiB;
constexpr size_t O_KVA = 388 * MiB;
constexpr size_t O_QB = 422 * MiB;
constexpr size_t O_KB = 439 * MiB;
constexpr size_t O_KR = 444 * MiB;
constexpr size_t O_AO = 446 * MiB;
constexpr size_t O_H0 = 311 * MiB;
constexpr size_t O_QK1 = 311 * MiB;
constexpr size_t O_V1 = 345 * MiB;
constexpr size_t O_G1 = 379 * MiB;
constexpr size_t O_RR = 413 * MiB;
constexpr size_t O_QDF = 422 * MiB, O_KIF = 439 * MiB, O_KTF = 456 * MiB, O_QDB = 473 * MiB;
constexpr size_t O_KIB = 243 * MiB, O_KTB = 260 * MiB, O_VT = 277 * MiB;
constexpr size_t O_ECL = 490 * MiB;
constexpr size_t O_OF = O_QK1, O_OB = O_V1;
constexpr size_t O_GA = O_QDF;
constexpr size_t O_HM = 243 * MiB;
constexpr size_t WS_END = 495 * MiB;
static_assert(O_HM + (size_t)34816 * EXD * 2 <= 482 * MiB, "HM");
static_assert(O_RR + (size_t)R * 256 * 2 <= O_QDF, "RR");
static_assert(O_ECL + (size_t)544 * 8 * 1024 <= WS_END, "ECL");

constexpr int RING_BYTES = 131072;
constexpr int LDS_BYTES = 163840;
constexpr int LDSCTL_OFF = LDS_BYTES - 256;

struct Args {
    const float* in[27];
    float* out; unsigned char* ws;
    int ph_lo, ph_hi;
};
enum { I_X = 0, I_C, I_CTX, I_CCTX, I_MODW, I_MODB, I_NORMG, I_AWIN, I_AQN, I_AWUQ, I_AKVN, I_AWUKV, I_AQKN, I_AWOUT, I_GWIN, I_GGATE2, I_GBGATE, I_GONORM, I_GWOUT,
       I_FWG, I_FWU, I_FWD, I_MROUTER, I_MBROUTER, I_MWG, I_MWU, I_MWD };

struct Conv { const float* s0; const float* s1; int Nsrc; int K; int Ndst; bf16_t* dst; int mode; const float* kscale; };
__device__ __forceinline__ int ilv64(int p) { return (p >> 5) * 32 + (p & 1) * 16 + ((p & 31) >> 1); }
__device__ __forceinline__ int ilv32(int p) { return (p >> 4) * 16 + (p & 1) * 8 + ((p & 15) >> 1); }
__device__ __forceinline__ const float* conv_col(const Conv& c, int n, float& sc) {
    sc = 1.0f;
    switch (c.mode) {
    case 0: return c.s0 + n;
    case 1: {
        if (n < 640) return c.s0 + n;
        if (n < 1152) { const int hh = (n - 640) >> 6, p = (n - 640) & 63; return c.s0 + 672 + hh * 64 + ilv64(p); }
        if (n < 1280) { const int hh = (n - 1152) >> 6, p = (n - 1152) & 63; return c.s0 + 1184 + hh * 64 + ilv64(p); }
        if (n < 1408) return c.s0 + 1312 + (n - 1280);
        if (n < 1440) return c.s0 + 640 + ilv32(n - 1408);
        return nullptr; }
    case 2: {
        if (n < 512) return c.s0 + (n >> 6) * 96 + (n & 63);
        const int hh = (n - 512) >> 5, p = (n - 512) & 31; return c.s0 + hh * 96 + 64 + ilv32(p); }
    case 3: {
        const int G = n >> 5, j = n & 31; return (j < 16) ? c.s0 + 16 * G + j : c.s1 + 16 * G + (j - 16); }
    case 4: {
        if (n >= 3104) return nullptr;
        if (n < 512) sc = 0.08838834764831845f;
        return c.s0 + n; }
    }
    return nullptr;
}
__device__ __forceinline__ void conv_item(const Conv& c, int item, LAS float* scr, int lane) {
    const int nblk = c.Ndst / 32, kb = item / nblk, nb = item % nblk, k0 = 64 * kb, n0 = 32 * nb;
    float sc; const float* cp = conv_col(c, n0 + (lane & 31), sc);
    const int kh = lane >> 5;
#pragma unroll 16
    for (int i = 0; i < 32; ++i) { const int kk = 2 * i + kh; float v = 0.f;
        if (cp) { v = cp[(size_t)(k0 + kk) * c.Nsrc] * sc; if (c.kscale) v *= c.kscale[k0 + kk]; }
        scr[kk * 33 + (lane & 31)] = v; }
    asm volatile("s_waitcnt lgkmcnt(0)" ::: "memory");
    const int ch = lane & 7;
#pragma unroll
    for (int j = 0; j < 4; ++j) { const int n = (lane >> 3) + 8 * j; const LAS float* s = scr + (8 * ch) * 33 + n;
        u32x4 o; o.x = cvtpk(s[0 * 33], s[1 * 33]); o.y = cvtpk(s[2 * 33], s[3 * 33]); o.z = cvtpk(s[4 * 33], s[5 * 33]); o.w = cvtpk(s[6 * 33], s[7 * 33]);
        *(u32x4*)(c.dst + (size_t)(n0 + n) * c.K + k0 + 8 * ch) = o; }
    asm volatile("s_waitcnt lgkmcnt(0)" ::: "memory");
}

struct Conv64 { const float* s0; const float* s1; int Nsrc; int K; int Ndst; bf16_t* dst; int mode; int nvalid; int nscaled; float rscale; int f8; };
struct Conv64Geo { int k0, n0, nd; bool valid; float sc; const float* src; };
__device__ __forceinline__ Conv64Geo conv64_geo(const Conv64& c, int item, int lane) {
    Conv64Geo g; const int nblk = c.Ndst / 64, kb = item / nblk, nb = item % nblk; g.k0 = 64 * kb; g.n0 = 64 * nb;
    const int c4 = lane & 15, kr = lane >> 4; g.valid = true; g.sc = 1.0f;
    if (c.mode == 3) { const int cc = 4 * (c4 & 7); g.src = c.s0 + ((c4 < 8) ? (long)0 : (long)(c.s1 - c.s0)) + 32 * nb + cc; g.nd = 32 * (cc >> 4) + ((c4 < 8) ? 0 : 16) + (cc & 15); g.sc = c.rscale * ((c4 < 8) ? -1.4426950408889634f : 1.0f); }
    else { g.nd = 4 * c4; g.src = c.s0 + g.n0 + g.nd; g.valid = (g.n0 + g.nd) < c.nvalid; if (g.n0 + g.nd < c.nscaled) g.sc = c.rscale; }
    g.src += (size_t)(g.k0 + kr) * c.Nsrc;
    return g;
}
__device__ __forceinline__ void conv64_load(const Conv64& c, int item, int lane, f32x4 (&v)[16]) {
    const Conv64Geo g = conv64_geo(c, item, lane);
#pragma unroll
    for (int i = 0; i < 16; ++i) v[i] = g.valid ? *(const f32x4*)(g.src + (size_t)(4 * i) * c.Nsrc) : (f32x4){0.f, 0.f, 0.f, 0.f};
}
__device__ __forceinline__ void conv64_store(const Conv64& c, int item, LAS float* scr, int lane, const f32x4 (&v)[16]) {
    const Conv64Geo g = conv64_geo(c, item, lane); const int kr = lane >> 4, nd = g.nd, k0 = g.k0, n0 = g.n0; const float sc = g.sc;
#pragma unroll
    for (int i = 0; i < 16; ++i) { LAS float* p = scr + (4 * i + kr) * 65 + nd; p[0] = v[i][0] * sc; p[1] = v[i][1] * sc; p[2] = v[i][2] * sc; p[3] = v[i][3] * sc; }
    asm volatile("s_waitcnt lgkmcnt(0)" ::: "memory");
    if (c.f8) {
        const int ch = lane & 3; unsigned char* d8 = (unsigned char*)c.dst;
#pragma unroll
        for (int it = 0; it < 4; ++it) { const int r = it * 16 + (lane >> 2); const LAS float* sp = scr + (16 * ch) * 65 + r; u32x4 o;
            o.x = pack_fp8x4(sp[0 * 65], sp[1 * 65], sp[2 * 65], sp[3 * 65]); o.y = pack_fp8x4(sp[4 * 65], sp[5 * 65], sp[6 * 65], sp[7 * 65]);
            o.z = pack_fp8x4(sp[8 * 65], sp[9 * 65], sp[10 * 65], sp[11 * 65]); o.w = pack_fp8x4(sp[12 * 65], sp[13 * 65], sp[14 * 65], sp[15 * 65]);
            *(u32x4*)(d8 + (size_t)(n0 + r) * c.K + k0 + 16 * ch) = o; }
    } else {
    const int ch = lane & 7;
#pragma unroll
    for (int it = 0; it < 8; ++it) { const int r = it * 8 + (lane >> 3); const LAS float* sp = scr + (8 * ch) * 65 + r;
        u32x4 o; o.x = cvtpk(sp[0 * 65], sp[1 * 65]); o.y = cvtpk(sp[2 * 65], sp[3 * 65]); o.z = cvtpk(sp[4 * 65], sp[5 * 65]); o.w = cvtpk(sp[6 * 65], sp[7 * 65]);
        *(u32x4*)(c.dst + (size_t)(n0 + r) * c.K + k0 + 8 * ch) = o; }
    }
    asm volatile("s_waitcnt lgkmcnt(0)" ::: "memory");
}

__device__ __forceinline__ void conv64_run(const Conv64& c, LAS float* scr, int lane, int gwi, int ngw, int& base) {
    const int n = (c.K / 64) * (c.Ndst / 64); int it = gwi - base; if (it < 0) it += ngw;
    if (it < n) { f32x4 va[16], vb[16]; conv64_load(c, it, lane, va);
        for (;;) { const int i2 = it + ngw; if (i2 < n) conv64_load(c, i2, lane, vb); conv64_store(c, it, scr, lane, va); if (i2 >= n) break;
                   const int i3 = i2 + ngw; if (i3 < n) conv64_load(c, i3, lane, va); conv64_store(c, i2, scr, lane, vb); if (i3 >= n) break; it = i3; } }
    base = (base + n) % ngw;
}

namespace pg8 {
constexpr int BM = 256, BK = 64, HALF = 128, HTB = HALF * BK * 2, STAGE_BYTES = 8 * HTB;
constexpr int NXCD = 8, WGM = 8;
__device__ __forceinline__ int lds_byte(int r, int c) { const int st = (r >> 4) * 2 + (c >> 5), rr = r & 15, cc = c & 31, ob = rr * 64 + cc * 2; return st * 1024 + (ob ^ (((ob >> 9) & 1) << 5)); }
__device__ __forceinline__ void stage_rc(int b, int& Rr, int& C) { const int st = b / 1024, sb = b % 1024, swz = sb ^ (((sb >> 9) & 1) << 5); Rr = (st >> 1) * 16 + swz / 64; C = (st & 1) * 32 + (swz % 64) / 2; }
__device__ __forceinline__ int perm32(int rho) { const int n = rho >> 4, i = rho & 15; return 8 * (i >> 2) + 4 * n + (i & 3); }
struct Unit { int pm, pn; };
typedef int v8i_t __attribute__((ext_vector_type(8)));
typedef int v4i_t __attribute__((ext_vector_type(4)));
__device__ __forceinline__ v8i_t cat8(bf16x8 a, bf16x8 b) { const v4i_t x = __builtin_bit_cast(v4i_t, a), y = __builtin_bit_cast(v4i_t, b); return __builtin_shufflevector(x, y, 0, 1, 2, 3, 4, 5, 6, 7); }
struct Order {
    int nM, nN, nwg, G, c;
    __device__ __forceinline__ void init(int nM_, int nN_, int G_, int c_) { nM = nM_; nN = nN_; nwg = nM * nN; G = G_; c = c_; }
    __device__ __forceinline__ bool next(int i, Unit& u) const {
        const long L = (long)i * G + c; if (L >= nwg) return false;
        int wgid = (int)L; { const int q = nwg / NXCD, r = nwg % NXCD, xcd = wgid % NXCD, off = wgid / NXCD; wgid = (xcd < r ? xcd * (q + 1) : r * (q + 1) + (xcd - r) * q) + off; }
        const int nig = WGM * nN, gid = wgid / nig, fm = gid * WGM, gsz = (nM - fm) < WGM ? (nM - fm) : WGM;
        u.pm = fm + ((wgid % nig) % gsz); u.pn = (wgid % nig) / gsz; return true;
    }
};

template <class Prob, class Epi>
__device__ __forceinline__ void gemm_phase(LAS unsigned char* lds, const Prob& P, const Epi& E) {
    const int tid = threadIdx.x, wid = __builtin_amdgcn_readfirstlane(tid >> 6), lane = tid & 63, wr = wid >> 2, wc = wid & 3, fr = lane & 15, fq = lane >> 4;
    const int K = P.K, nt = K / BK, ldb = P.ldb;
    int RA[2], CA[2]; unsigned voffB[2];
#pragma unroll
    for (int i = 0; i < 2; ++i) { int Rr, C; stage_rc(tid * 16 + i * 8192, Rr, C); const int Rb = Epi::PERM ? ((Rr & ~31) + perm32(Rr & 31)) : Rr;
        RA[i] = Rr; CA[i] = C; voffB[i] = (unsigned)(Rb * ldb + C) * 2u; }
    const size_t hstepB = (size_t)HALF * ldb * 2;
    const unsigned ldsw = (unsigned)wid * 1024u;
    const int aoff = lds_byte(wr * 64 + fr, fq * 8), boff = lds_byte(wc * 32 + fr, fq * 8);
    const char* Abase = (const char*)P.Abase;
    const int scl_a = P.sa * 0x01010101, scl_b = P.sb * 0x01010101;
#define PG8_SA(b, h) (((b) * 2 + (h)) * HTB)
#define PG8_SB(b, h) ((4 + (b) * 2 + (h)) * HTB)
#define PG8_STAGEB(bufoff, gbase) do { _Pragma("unroll") for (int _i = 0; _i < 2; ++_i) \
        __builtin_amdgcn_global_load_lds((const unsigned*)((const char*)(gbase) + voffB[_i]), (LAS unsigned*)(lds + (bufoff) + ldsw + _i * 8192), 16, 0, 0); } while (0)
#define PG8_STAGEA(bufoff, vo, h, kb) do { _Pragma("unroll") for (int _i = 0; _i < 2; ++_i) \
        __builtin_amdgcn_global_load_lds((const unsigned*)(Abase + (size_t)(kb) + (vo)[h][_i]), (LAS unsigned*)(lds + (bufoff) + ldsw + _i * 8192), 16, 0, 0); } while (0)
#define PG8_LDA(dst, b, h) do { _Pragma("unroll") for (int m = 0; m < 4; ++m) { if constexpr (Prob::FP8) dst##8[m] = cat8(*(const LAS bf16x8*)(lds + PG8_SA(b, h) + aoff + m * 2048), *(const LAS bf16x8*)(lds + PG8_SA(b, h) + aoff + m * 2048 + 1024)); \
        else { _Pragma("unroll") for (int k = 0; k < 2; ++k) dst[m][k] = *(const LAS bf16x8*)(lds + PG8_SA(b, h) + aoff + m * 2048 + k * 1024); } } } while (0)
#define PG8_LDB(dst, b, h) do { _Pragma("unroll") for (int n = 0; n < 2; ++n) { if constexpr (Prob::FP8) dst##8[n] = cat8(*(const LAS bf16x8*)(lds + PG8_SB(b, h) + boff + n * 2048), *(const LAS bf16x8*)(lds + PG8_SB(b, h) + boff + n * 2048 + 1024)); \
        else { _Pragma("unroll") for (int k = 0; k < 2; ++k) dst[n][k] = *(const LAS bf16x8*)(lds + PG8_SB(b, h) + boff + n * 2048 + k * 1024); } } } while (0)
#define PG8_MMA(ai, bj, At, Bt) do { __builtin_amdgcn_s_setprio(1); _Pragma("unroll") for (int m = 0; m < 4; ++m) _Pragma("unroll") for (int n = 0; n < 2; ++n) { \
        if constexpr (Prob::FP8) asm volatile("v_mfma_scale_f32_16x16x128_f8f6f4 %0, %1, %2, %0, %3, %4 op_sel_hi:[0,0,0]" : "+v"(acc[ai][bj][m][n]) : "v"(Bt##8[n]), "v"(At##8[m]), "v"(scl_b), "v"(scl_a)); \
        else { _Pragma("unroll") for (int k = 0; k < 2; ++k) acc[ai][bj][m][n] = __builtin_amdgcn_mfma_f32_16x16x32_bf16(Bt[n][k], At[m][k], acc[ai][bj][m][n], 0, 0, 0); } } \
        __builtin_amdgcn_s_setprio(0); } while (0)
#define PG8_WAIT_V(n) asm volatile("s_waitcnt vmcnt(" #n ")" ::: "memory")
#define PG8_WAIT_L(n) asm volatile("s_waitcnt lgkmcnt(" #n ")" ::: "memory")
#define PG8_BAR __builtin_amdgcn_s_barrier()
#define PG8_SCHED __builtin_amdgcn_sched_barrier(0)
    Unit cur, nxt; int ui = 0;
    if (!P.next(0, cur)) return;
    f32x4 acc[2][2][4][2];
#pragma unroll
    for (int a = 0; a < 2; ++a)
#pragma unroll
        for (int b = 0; b < 2; ++b)
#pragma unroll
            for (int m = 0; m < 4; ++m)
#pragma unroll
                for (int n = 0; n < 2; ++n) acc[a][b][m][n] = (f32x4){0.f, 0.f, 0.f, 0.f};
    bf16x8 At[4][2], B0[2][2], B1[2][2]; v8i_t At8[4], B08[2], B18[2];
    unsigned cvo[2][2], nvo[2][2];
#pragma unroll
    for (int h = 0; h < 2; ++h)
#pragma unroll
        for (int i = 0; i < 2; ++i) cvo[h][i] = P.a_off(cur, h * HALF + RA[i]) + (unsigned)CA[i] * 2u;
    const char* cB = P.b_ptr(cur);
    const size_t kstep = (size_t)(BK * 2);
    PG8_STAGEB(PG8_SB(0, 0), cB); PG8_STAGEB(PG8_SB(0, 1), cB + hstepB); PG8_STAGEA(PG8_SA(0, 0), cvo, 0, 0); PG8_STAGEA(PG8_SA(0, 1), cvo, 1, 0);
    if (wr == 1) PG8_BAR;
    PG8_WAIT_V(2); PG8_BAR;
    PG8_STAGEB(PG8_SB(1, 0), cB + kstep); PG8_STAGEA(PG8_SA(1, 0), cvo, 0, kstep); PG8_STAGEB(PG8_SB(1, 1), cB + hstepB + kstep);
    PG8_WAIT_V(6); PG8_BAR;
    for (;;) {
        const bool has_next = P.next(ui + 1, nxt);
        const char* nB = cB;
#pragma unroll
        for (int h = 0; h < 2; ++h)
#pragma unroll
            for (int i = 0; i < 2; ++i) nvo[h][i] = cvo[h][i];
        if (has_next) { nB = P.b_ptr(nxt);
#pragma unroll
            for (int h = 0; h < 2; ++h)
#pragma unroll
                for (int i = 0; i < 2; ++i) nvo[h][i] = P.a_off(nxt, h * HALF + RA[i]) + (unsigned)CA[i] * 2u; }
        for (int t = 0; t < nt; t += 2) {
            const bool last = (t == nt - 2);
            const size_t k1 = (size_t)(t + 1) * kstep;
            const size_t k2 = last ? 0 : (size_t)(t + 2) * kstep, k3 = k2 + kstep;
            unsigned vo2[2][2];
#pragma unroll
            for (int h = 0; h < 2; ++h)
#pragma unroll
                for (int i = 0; i < 2; ++i) vo2[h][i] = last ? nvo[h][i] : cvo[h][i];
            const char* b2 = (last ? nB : cB) + k2; const char* b3 = b2 + kstep;
            PG8_LDB(B0, 0, 0); PG8_LDB(B1, 0, 1); PG8_SCHED; PG8_LDA(At, 0, 0); PG8_STAGEA(PG8_SA(1, 1), cvo, 1, k1);
            PG8_WAIT_V(8); PG8_WAIT_L(0); PG8_BAR; PG8_MMA(0, 0, At, B0); PG8_MMA(0, 1, At, B1); PG8_BAR; PG8_SCHED;
            PG8_LDA(At, 0, 1); PG8_STAGEB(PG8_SB(0, 0), b2); PG8_STAGEB(PG8_SB(0, 1), b2 + hstepB); PG8_STAGEA(PG8_SA(0, 0), vo2, 0, k2);
            PG8_WAIT_V(8); PG8_WAIT_L(0); PG8_BAR; PG8_MMA(1, 0, At, B0); PG8_MMA(1, 1, At, B1); PG8_BAR; PG8_SCHED;
            PG8_LDB(B0, 1, 0); PG8_LDB(B1, 1, 1); PG8_SCHED; PG8_LDA(At, 1, 0); PG8_STAGEA(PG8_SA(0, 1), vo2, 1, k2);
            PG8_WAIT_V(8); PG8_WAIT_L(0); PG8_BAR; PG8_MMA(0, 0, At, B0); PG8_MMA(0, 1, At, B1); PG8_BAR; PG8_SCHED;
            PG8_LDA(At, 1, 1); PG8_STAGEB(PG8_SB(1, 0), b3); PG8_STAGEB(PG8_SB(1, 1), b3 + hstepB); PG8_STAGEA(PG8_SA(1, 0), vo2, 0, k3);
            PG8_WAIT_V(8); PG8_WAIT_L(0); PG8_BAR; PG8_MMA(1, 0, At, B0); PG8_MMA(1, 1, At, B1); PG8_BAR; PG8_SCHED;
        }
        if (wr == 0) PG8_BAR;
        if constexpr (Prob::FP8) asm volatile("s_nop 15\n\ts_nop 15" ::: "memory");
        if constexpr (Epi::STAGED) E.staged(acc, P, cur, wr, wc, fr, fq, lds + STAGE_BYTES, tid);
        else { E(acc, P, cur, wr, wc, fr, fq); if (MK_EPI2) { asm volatile("" ::: "memory"); E(acc, P, cur, wr, wc, fr, fq); } }
        if (!has_next) break;
#pragma unroll
        for (int a = 0; a < 2; ++a)
#pragma unroll
            for (int b = 0; b < 2; ++b)
#pragma unroll
                for (int m = 0; m < 4; ++m)
#pragma unroll
                    for (int n = 0; n < 2; ++n) acc[a][b][m][n] = (f32x4){0.f, 0.f, 0.f, 0.f};
        cur = nxt; cB = nB; ++ui;
#pragma unroll
        for (int h = 0; h < 2; ++h)
#pragma unroll
            for (int i = 0; i < 2; ++i) cvo[h][i] = nvo[h][i];
        if (wr == 1) PG8_BAR;
    }
    PG8_WAIT_V(0);
    PG8_BAR;
#undef PG8_SA
#undef PG8_SB
#undef PG8_STAGEA
#undef PG8_STAGEB
#undef PG8_LDA
#undef PG8_LDB
#undef PG8_MMA
#undef PG8_WAIT_V
#undef PG8_WAIT_L
#undef PG8_BAR
#undef PG8_SCHED
}

struct DenseProb {
    static constexpr bool FP8 = false; static constexpr int sa = 127, sb = 127;
    const bf16_t* Abase; const bf16_t* Bt; int K, lda, ldb; Order ord;
    __device__ __forceinline__ bool next(int i, Unit& u) const { return ord.next(i, u); }
    __device__ __forceinline__ unsigned a_off(const Unit& u, int r) const { return (unsigned)((size_t)(u.pm * BM + r) * lda * 2); }
    __device__ __forceinline__ const char* b_ptr(const Unit& u) const { return (const char*)Bt + (size_t)u.pn * BM * ldb * 2; }
    __device__ __forceinline__ int orow0(const Unit& u) const { return u.pm * BM; }
};
template <int SA, int SB> struct DenseProb8 {
    static constexpr bool FP8 = true; static constexpr int sa = SA, sb = SB;
    const unsigned char* Abase; const unsigned char* Bt; int K, ldb; int lda; Order ord;
    __device__ __forceinline__ bool next(int i, Unit& u) const { return ord.next(i, u); }
    __device__ __forceinline__ unsigned a_off(const Unit& u, int r) const { return (unsigned)((size_t)(u.pm * BM + r) * lda); }
    __device__ __forceinline__ const char* b_ptr(const Unit& u) const { return (const char*)Bt + (size_t)u.pn * BM * ldb * 2; }
    __device__ __forceinline__ int orow0(const Unit& u) const { return u.pm * BM; }
};
struct MoeTiles { unsigned long long tp8; unsigned long long c4a, c4b; int nt; };
__device__ __forceinline__ int moe_tp(const MoeTiles& T, int e) { return (int)((T.tp8 >> (8 * e)) & 0xffull); }
__device__ __forceinline__ int moe_cnt(const MoeTiles& T, int e) { const unsigned long long w = (e < 4) ? T.c4a : T.c4b; return (int)((w >> (16 * (e & 3))) & 0xffffull); }
__device__ __forceinline__ int moe_expert(const MoeTiles& T, int pm) { int e = 0;
#pragma unroll
    for (int j = 1; j < 8; ++j) e += (pm >= (int)((T.tp8 >> (8 * j)) & 0xffull)) ? 1 : 0;
    return e; }
struct MoeGuProb {
    static constexpr bool FP8 = true; static constexpr int sa = 125, sb = 121;
    const unsigned char* Abase; const unsigned char* Bt; int K, ldb; Order ord; MoeTiles T; const int* rowtok;
    __device__ __forceinline__ bool next(int i, Unit& u) const { return ord.next(i, u); }
    __device__ __forceinline__ unsigned a_off(const Unit& u, int r) const {
        const int e = moe_expert(T, u.pm); const int idx = (u.pm - moe_tp(T, e)) * BM + r; const int cm1 = moe_cnt(T, e) - 1;
        const int tok = rowtok[e * CAPE + (idx < cm1 ? idx : cm1)];
        return (unsigned)tok * (unsigned)D; }
    __device__ __forceinline__ const char* b_ptr(const Unit& u) const { const int e = moe_expert(T, u.pm); return (const char*)Bt + ((size_t)e * N_GU1 + (size_t)u.pn * BM) * D; }
    __device__ __forceinline__ int orow0(const Unit& u) const { return u.pm * BM; }
};
struct MoeDnProb {
    static constexpr bool FP8 = true; static constexpr int sa = 124, sb = 121;
    const unsigned char* Abase; const unsigned char* Bt; int K, ldb; Order ord; MoeTiles T;
    __device__ __forceinline__ bool next(int i, Unit& u) const { return ord.next(i, u); }
    __device__ __forceinline__ unsigned a_off(const Unit& u, int r) const { return (unsigned)((size_t)(u.pm * BM + r) * EXD); }
    __device__ __forceinline__ const char* b_ptr(const Unit& u) const { const int e = moe_expert(T, u.pm); return (const char*)Bt + ((size_t)e * D + (size_t)u.pn * BM) * EXD; }
    __device__ __forceinline__ int orow0(const Unit& u) const { return u.pm * BM; }
};

struct EpiF32 { static constexpr bool PERM = false; static constexpr bool STAGED = false; float* C; int ldc;
    template <class Prob> __device__ __forceinline__ void operator()(const f32x4 (&acc)[2][2][4][2], const Prob& P, const Unit& u, int wr, int wc, int fr, int fq) const {
        const int row0 = P.orow0(u) + wr * 64 + fr, col0 = u.pn * BM + wc * 32 + 4 * fq;
#pragma unroll
        for (int ai = 0; ai < 2; ++ai)
#pragma unroll
            for (int m = 0; m < 4; ++m) { float* rowp = C + (size_t)(row0 + ai * HALF + m * 16) * ldc + col0;
#pragma unroll
                for (int bj = 0; bj < 2; ++bj)
#pragma unroll
                    for (int n = 0; n < 2; ++n) *(f32x4*)(rowp + bj * HALF + n * 16) = acc[ai][bj][m][n]; }
    }
};
struct EpiBf16 { static constexpr bool PERM = true; static constexpr bool STAGED = false; bf16_t* O; int ldc; const float* rowscale;
    template <class Prob> __device__ __forceinline__ void operator()(const f32x4 (&acc)[2][2][4][2], const Prob& P, const Unit& u, int wr, int wc, int fr, int fq) const {
        const int row0 = P.orow0(u) + wr * 64 + fr, col0 = u.pn * BM + wc * 32 + 8 * fq;
#pragma unroll
        for (int ai = 0; ai < 2; ++ai)
#pragma unroll
            for (int m = 0; m < 4; ++m) { const int row = row0 + ai * HALF + m * 16; bf16_t* rowp = O + (size_t)row * ldc + col0; const float rs = rowscale ? rowscale[row] : 1.0f;
#pragma unroll
                for (int bj = 0; bj < 2; ++bj) { const f32x4 v0 = acc[ai][bj][m][0] * rs, v1 = acc[ai][bj][m][1] * rs;
                    u32x4 w; w.x = cvtpk(v0[0], v0[1]); w.y = cvtpk(v0[2], v0[3]); w.z = cvtpk(v1[0], v1[1]); w.w = cvtpk(v1[2], v1[3]);
                    *(u32x4*)(rowp + bj * HALF) = w; } }
    }
};
struct EpiIn1 { static constexpr bool PERM = true; static constexpr bool STAGED = false; bf16_t* QK; bf16_t* V; bf16_t* G; bf16_t* RRp;
    template <class Prob> __device__ __forceinline__ void operator()(const f32x4 (&acc)[2][2][4][2], const Prob& P, const Unit& u, int wr, int wc, int fr, int fq) const {
        const int t = u.pn >> 2; bf16_t* base = (t == 0) ? QK : (t == 1) ? V : (t == 2) ? G : RRp; const int ldc = (t == 3) ? 256 : 1024;
        const int row0 = P.orow0(u) + wr * 64 + fr, col0 = (u.pn & 3) * BM + wc * 32 + 8 * fq;
#pragma unroll
        for (int ai = 0; ai < 2; ++ai)
#pragma unroll
            for (int m = 0; m < 4; ++m) { const int row = row0 + ai * HALF + m * 16; bf16_t* rowp = base + (size_t)row * ldc + col0;
#pragma unroll
                for (int bj = 0; bj < 2; ++bj) { const f32x4 v0 = acc[ai][bj][m][0], v1 = acc[ai][bj][m][1];
                    u32x4 w; w.x = cvtpk(v0[0], v0[1]); w.y = cvtpk(v0[2], v0[3]); w.z = cvtpk(v1[0], v1[1]); w.w = cvtpk(v1[2], v1[3]);
                    *(u32x4*)(rowp + bj * HALF) = w; } }
    }
};
struct EpiQA { static constexpr bool PERM = true; static constexpr bool STAGED = false; bf16_t* O; const float* rstd; const float* tab16; float qscale;
    template <class Prob> __device__ __forceinline__ void operator()(const f32x4 (&acc)[2][2][4][2], const Prob& P, const Unit& u, int wr, int wc, int fr, int fq) const {
        const int row0 = P.orow0(u) + wr * 64 + fr, col0 = u.pn * BM + wc * 32 + 8 * fq;
        const bool ropet = (u.pn == 2);
#pragma unroll
        for (int ai = 0; ai < 2; ++ai)
#pragma unroll
            for (int m = 0; m < 4; ++m) { const int row = row0 + ai * HALF + m * 16; bf16_t* rowp = O + (size_t)row * N_QA + col0; const float rs = rstd[row] * qscale;
                f32x4 cs0 = {1.f, 1.f, 1.f, 1.f}, sn0 = {0.f, 0.f, 0.f, 0.f};
                if (ropet && row < RL) { const int tt = row & (SEQ - 1); const int pos = (fq >> 1) ? (tt & 63) : (tt >> 6); const int i0 = 4 * (fq & 1);
                    cs0 = *(const f32x4*)(tab16 + pos * 8 + i0); sn0 = *(const f32x4*)(tab16 + 512 + pos * 8 + i0); }
#pragma unroll
                for (int bj = 0; bj < 2; ++bj) { f32x4 v0 = acc[ai][bj][m][0] * rs, v1 = acc[ai][bj][m][1] * rs;
                    if (ropet) {
                        const f32x4 a = v0, b = v1;
                        v0[0] = a[0] * cs0[0] - a[1] * sn0[0]; v0[1] = a[1] * cs0[0] + a[0] * sn0[0];
                        v0[2] = a[2] * cs0[1] - a[3] * sn0[1]; v0[3] = a[3] * cs0[1] + a[2] * sn0[1];
                        v1[0] = b[0] * cs0[2] - b[1] * sn0[2]; v1[1] = b[1] * cs0[2] + b[0] * sn0[2];
                        v1[2] = b[2] * cs0[3] - b[3] * sn0[3]; v1[3] = b[3] * cs0[3] + b[2] * sn0[3]; }
                    u32x4 w; w.x = cvtpk(v0[0], v0[1]); w.y = cvtpk(v0[2], v0[3]); w.z = cvtpk(v1[0], v1[1]); w.w = cvtpk(v1[2], v1[3]);
                    *(u32x4*)(rowp + bj * HALF) = w; } }
    }
};
struct EpiSwiglu { static constexpr bool PERM = false; static constexpr bool STAGED = false; bf16_t* Hh; int ldh;
    template <class Prob> __device__ __forceinline__ void operator()(const f32x4 (&acc)[2][2][4][2], const Prob& P, const Unit& u, int wr, int wc, int fr, int fq) const {
        const int row0 = P.orow0(u) + wr * 64 + fr, col0 = (u.pn * BM + wc * 32) / 2 + 4 * fq;
#pragma unroll
        for (int ai = 0; ai < 2; ++ai)
#pragma unroll
            for (int m = 0; m < 4; ++m) { bf16_t* rowp = Hh + (size_t)(row0 + ai * HALF + m * 16) * ldh + col0;
#pragma unroll
                for (int bj = 0; bj < 2; ++bj) { const f32x4 g = acc[ai][bj][m][0], up = acc[ai][bj][m][1];
                    u32x2 w; w.x = cvtpk(swiglu_f(g[0], up[0], -1.4426950408889634f), swiglu_f(g[1], up[1], -1.4426950408889634f)); w.y = cvtpk(swiglu_f(g[2], up[2], -1.4426950408889634f), swiglu_f(g[3], up[3], -1.4426950408889634f));
                    *(u32x2*)(rowp + bj * (HALF / 2)) = w; } }
    }
};
struct EpiSwiglu8 { static constexpr bool PERM = false; static constexpr bool STAGED = true; unsigned char* Hh; int ldh;
    template <class Prob> __device__ __forceinline__ void staged(const f32x4 (&acc)[2][2][4][2], const Prob& P, const Unit& u, int wr, int wc, int fr, int fq, LAS unsigned char* stg, int tid) const {
        LAS unsigned char* sg = stg + wr * 8192;
        const int t = tid & 255;
        unsigned char* gbase = Hh + (size_t)(P.orow0(u) + wr * 64) * ldh + (size_t)u.pn * 128;
#pragma unroll
        for (int ai = 0; ai < 2; ++ai) {
#pragma unroll
            for (int m = 0; m < 4; ++m) { const int row = m * 16 + fr;
#pragma unroll
                for (int bj = 0; bj < 2; ++bj) { const f32x4 g = acc[ai][bj][m][0], up = acc[ai][bj][m][1]; const int p = bj * 4 + wc;
                    *(LAS unsigned*)(sg + row * 128 + ((p ^ (row & 7)) << 4) + 4 * fq) = pack_fp8x4(swiglu_f(g[0], up[0], -0.18033688011112042f), swiglu_f(g[1], up[1], -0.18033688011112042f), swiglu_f(g[2], up[2], -0.18033688011112042f), swiglu_f(g[3], up[3], -0.18033688011112042f)); } }
            asm volatile("s_waitcnt lgkmcnt(0)" ::: "memory"); __builtin_amdgcn_s_barrier(); asm volatile("" ::: "memory");
#pragma unroll
            for (int j = 0; j < 2; ++j) { const int row = (t >> 3) + 32 * j, p = t & 7;
                const u32x4 v = *(const LAS u32x4*)(sg + row * 128 + ((p ^ (row & 7)) << 4));
                *(u32x4*)(gbase + (size_t)(ai * HALF + row) * ldh + p * 16) = v; }
            if (ai == 0) { asm volatile("s_waitcnt lgkmcnt(0)" ::: "memory"); __builtin_amdgcn_s_barrier(); asm volatile("" ::: "memory"); }
        }
    }
};
}

struct Frame {
    LAS unsigned char* lds;
    unsigned char* ws;
    int tid, lane, wave, vcu, G;
};
template <class T> __device__ __forceinline__ T* wsp(const Frame& F, size_t off) { return (T*)(F.ws + off); }

__device__ __forceinline__ void load_row(const float* p, int lane, f32x4 (&v)[4]) {
    const f32x4* r = (const f32x4*)p + lane;
#pragma unroll
    for (int j = 0; j < 4; ++j) v[j] = r[64 * j];
}
__device__ __forceinline__ void load_row_bf16(const bf16_t* p, int lane, f32x4 (&v)[4]) {
#pragma unroll
    for (int j = 0; j < 4; ++j) { const u32x2 w = *(const u32x2*)(p + 4 * lane + 256 * j); v[j][0] = bflo(w.x); v[j][1] = bfhi(w.x); v[j][2] = bflo(w.y); v[j][3] = bfhi(w.y); }
}
__device__ __forceinline__ float row_ssq(const f32x4 (&v)[4]) { float s = 0.f;
#pragma unroll
    for (int j = 0; j < 4; ++j) s += (v[j][0] * v[j][0] + v[j][1] * v[j][1]) + (v[j][2] * v[j][2] + v[j][3] * v[j][3]);
    return wave_sum(s); }
__device__ __forceinline__ void norm_mod_store(const f32x4 (&h)[4], const float* g, const float* sh, const float* sc, bf16_t* urow, int lane, f32x4 (&uo)[4], unsigned char* u8row = nullptr) {
    const float rstd = __builtin_amdgcn_rsqf(row_ssq(h) * (1.0f / D) + EPS);
#pragma unroll
    for (int j = 0; j < 4; ++j) { const int c = 4 * lane + 256 * j; const f32x4 gg = *(const f32x4*)(g + c), s1 = *(const f32x4*)(sc + c), s0 = *(const f32x4*)(sh + c);
        const f32x4 uu = (h[j] * rstd * gg) * (1.0f + s1) + s0; uo[j] = uu;
        if (u8row) *(unsigned*)(u8row + c) = pack_fp8x4(4.0f * uu[0], 4.0f * uu[1], 4.0f * uu[2], 4.0f * uu[3]);
        else { u32x2 w; w.x = cvtpk(uu[0], uu[1]); w.y = cvtpk(uu[2], uu[3]); *(u32x2*)(urow + c) = w; } }
}
__device__ __forceinline__ int row_bidx(int row) { return row < RL ? (row >> 12) : 4; }

__device__ __forceinline__ void glds16(const void* gsrc, unsigned lds_dst) { unsigned keep;
    asm volatile("s_mov_b32 %0, m0\n\ts_mov_b32 m0, %2\n\ts_nop 0\n\tglobal_load_lds_dwordx4 %1, off\n\ts_mov_b32 m0, %0" : "=&s"(keep) : "v"(gsrc), "s"(lds_dst) : "memory"); }
__device__ __forceinline__ float max3f(float a, float b, float c) { float r; asm("v_max3_f32 %0, %1, %2, %3" : "=v"(r) : "v"(a), "v"(b), "v"(c)); return r; }
#define WAIT_BAR(N) asm volatile("s_waitcnt vmcnt(" #N ") lgkmcnt(0)\n\ts_barrier" ::: "memory")
template <int DQK> struct AttnSrc {
    const bf16_t* Q; int qpitch; const bf16_t* Qr;
    const bf16_t* Kn; int kpitch; const bf16_t* Kr; int krpitch;
    const bf16_t* V; int vpitch;
    bf16_t* O; int opitch;
};
__device__ __forceinline__ s16x4 vtr(const LAS unsigned char* p) { typedef short v4i16_t __attribute__((ext_vector_type(4))); return __builtin_bit_cast(s16x4, __builtin_amdgcn_ds_read_tr16_b64_v4i16((LAS v4i16_t*)p)); }
__device__ __forceinline__ int attn_krow(int kt, int lat0, int ctx0) { return kt < 64 ? lat0 + kt * 64 : ctx0 + (kt - 64) * 64; }
__device__ __forceinline__ f32x16 mfma_first(bf16x8 a, bf16x8 b, const f32x16& c) { f32x16 d; asm volatile("s_nop 4\n\tv_mfma_f32_32x32x16_bf16 %0, %1, %2, %3" : "=&v"(d) : "v"(a), "v"(b), "v"(c)); return d; }
template <int DQK, bool SAFE>
__device__ __forceinline__ bool attn_run(const Frame& F, const AttnSrc<DQK>& S, int q0, int lat0, int ctx0, int kt0, int kt1) {
    constexpr int NKS = DQK / 16, KB = DQK * 128, SLOT = KB + 8192;
    constexpr float THR = 8.0f;
    constexpr float BIG = 1.0e12f;
    bool ovf = false;
    const int lane = F.lane, wid = F.wave, r32 = lane & 31, hi = lane >> 5;
    LAS unsigned char* lds = F.lds;
    constexpr bool QLDS = false;
    bf16x8 qf[QLDS ? 1 : NKS];
    LAS unsigned char* qfl = lds + 4 * SLOT + wid * (NKS * 1024) + lane * 16;
    { const bf16_t* qrow = S.Q + (size_t)(q0 + wid * 32 + r32) * S.qpitch;
#pragma unroll
      for (int ks = 0; ks < 4; ++ks) { const bf16x8 v = *(const bf16x8*)(qrow + ks * 16 + hi * 8); if (QLDS) *(LAS bf16x8*)(qfl + ks * 1024) = v; else qf[ks] = v; }
      if (DQK == 96) { const bf16_t* qr = S.Qr + (size_t)(q0 + wid * 32 + r32) * S.qpitch;
#pragma unroll
          for (int ks = 4; ks < NKS; ++ks) { const bf16x8 v = *(const bf16x8*)(qr + (ks - 4) * 16 + hi * 8); if (QLDS) *(LAS bf16x8*)(qfl + ks * 1024) = v; else qf[ks] = v; } } }
    const unsigned lds0 = (unsigned)(size_t)lds;
    auto dma = [&](int kt, int slot) {
        const int krow = attn_krow(kt, lat0, ctx0);
        const unsigned sb = lds0 + slot * SLOT;
        glds16(S.Kn + (size_t)(krow + lane) * S.kpitch + wid * 8, (unsigned)__builtin_amdgcn_readfirstlane(sb + wid * 1024));
        if (DQK == 96 && wid < 4) glds16(S.Kr + (size_t)(krow + lane) * S.krpitch + wid * 8, (unsigned)__builtin_amdgcn_readfirstlane(sb + (8 + wid) * 1024));
        glds16(S.V + (size_t)(krow + 16 * (wid & 3) + (lane >> 2)) * S.vpitch + (wid >> 2) * 32 + (lane & 3) * 8, (unsigned)__builtin_amdgcn_readfirstlane(sb + KB + wid * 1024));
    };
    auto wait_bar = [&](bool inflight) {
        if (!inflight) { WAIT_BAR(0); } else if (DQK == 96 && wid < 4) { WAIT_BAR(3); } else { WAIT_BAR(2); }
    };
    f32x16 oT[2]; f32x16 negm;
#pragma unroll
    for (int r = 0; r < 16; ++r) { oT[0][r] = 0.f; oT[1][r] = 0.f; negm[r] = 0.f; }
    float mrun = 0.f, lrun = 0.f;
    const int vlane = ((lane >> 4) & 1) * 32 + (lane & 3) * 8 + (4 * hi + ((lane & 15) >> 2)) * 64;
    auto qk = [&](int slot, f32x16& p0, f32x16& p1) {
        const LAS unsigned char* kb = lds + slot * SLOT + hi * 1024 + r32 * 16;
        p0 = negm; p1 = negm;
        bf16x8 ka = *(const LAS bf16x8*)(kb), kc = *(const LAS bf16x8*)(kb + 512);
#pragma unroll
        for (int ks = 0; ks < NKS; ++ks) {
            bf16x8 na = ka, nc = kc;
            if (ks + 1 < NKS) { na = *(const LAS bf16x8*)(kb + (ks + 1) * 2048); nc = *(const LAS bf16x8*)(kb + (ks + 1) * 2048 + 512); }
            const bf16x8 qv = QLDS ? *(const LAS bf16x8*)(qfl + ks * 1024) : qf[QLDS ? 0 : ks];
            p0 = __builtin_amdgcn_mfma_f32_32x32x16_bf16(ka, qv, p0, 0, 0, 0);
            p1 = __builtin_amdgcn_mfma_f32_32x32x16_bf16(kc, qv, p1, 0, 0, 0);
            ka = na; kc = nc;
        }
    };
    auto tilemax = [&](f32x16& p0, f32x16& p1) -> float {
        asm volatile("s_nop 15\n\ts_nop 7" : "+v"(p0), "+v"(p1));
        float a = max3f(p0[0], p0[1], p1[0]), b = max3f(p0[2], p0[3], p1[1]); a = max3f(a, p1[2], p1[3]);
#pragma unroll
        for (int r = 4; r < 16; r += 4) { a = max3f(a, p0[r], p0[r + 1]); b = max3f(b, p0[r + 2], p0[r + 3]); a = max3f(a, p1[r], p1[r + 1]); b = max3f(b, p1[r + 2], p1[r + 3]); }
        float tm = fmaxf(a, b);
        auto rr = __builtin_amdgcn_permlane32_swap(__float_as_uint(tm), __float_as_uint(tm), false, false); return fmaxf(__uint_as_float(rr[0]), __uint_as_float(rr[1]));
    };
    auto step = [&](f32x16& c0, f32x16& c1, f32x16& n0, f32x16& n1, int slot_c, int slot_n) {
        if constexpr (SAFE) {
            const float tm = tilemax(c0, c1);
            if (__any(tm > THR)) {
                const float dl = fmaxf(tm, 0.f); mrun += dl; const float al = __builtin_amdgcn_exp2f(-dl); lrun *= al;
#pragma unroll
                for (int r = 0; r < 16; ++r) { c0[r] -= dl; c1[r] -= dl; negm[r] = -mrun; oT[0][r] *= al; oT[1][r] *= al; }
            }
        }
        float rs = 0.f;
        {
            const LAS unsigned char* kb = lds + slot_n * SLOT + hi * 1024 + r32 * 16;
            bf16x8 ka = *(const LAS bf16x8*)(kb), kc = *(const LAS bf16x8*)(kb + 512);
#pragma unroll
            for (int ks = 0; ks < NKS; ++ks) {
                bf16x8 na = ka, nc = kc;
                if (ks + 1 < NKS) { na = *(const LAS bf16x8*)(kb + (ks + 1) * 2048); nc = *(const LAS bf16x8*)(kb + (ks + 1) * 2048 + 512); }
                if (ks == 0) { n0 = mfma_first(ka, qf[0], negm); n1 = mfma_first(kc, qf[0], negm); }
                else { n0 = __builtin_amdgcn_mfma_f32_32x32x16_bf16(ka, qf[ks], n0, 0, 0, 0);
                       n1 = __builtin_amdgcn_mfma_f32_32x32x16_bf16(kc, qf[ks], n1, 0, 0, 0); }
                ka = na; kc = nc;
#pragma unroll
                for (int r = (16 * ks) / NKS; r < (16 * (ks + 1)) / NKS; ++r) { c0[r] = __builtin_amdgcn_exp2f(c0[r]); c1[r] = __builtin_amdgcn_exp2f(c1[r]); rs += c0[r] + c1[r]; }
            }
        }
        bool mv = false; float dl = 0.f;
        if constexpr (!SAFE) mv = __any(!(rs < BIG));
        lrun += rs;
        bf16x8 pf[4];
        { u32x4 w;
          w.x = cvtpk(c0[0], c0[1]); w.y = cvtpk(c0[2], c0[3]); w.z = cvtpk(c0[4], c0[5]); w.w = cvtpk(c0[6], c0[7]); pf[0] = __builtin_bit_cast(bf16x8, w);
          w.x = cvtpk(c0[8], c0[9]); w.y = cvtpk(c0[10], c0[11]); w.z = cvtpk(c0[12], c0[13]); w.w = cvtpk(c0[14], c0[15]); pf[1] = __builtin_bit_cast(bf16x8, w);
          w.x = cvtpk(c1[0], c1[1]); w.y = cvtpk(c1[2], c1[3]); w.z = cvtpk(c1[4], c1[5]); w.w = cvtpk(c1[6], c1[7]); pf[2] = __builtin_bit_cast(bf16x8, w);
          w.x = cvtpk(c1[8], c1[9]); w.y = cvtpk(c1[10], c1[11]); w.z = cvtpk(c1[12], c1[13]); w.w = cvtpk(c1[14], c1[15]); pf[3] = __builtin_bit_cast(bf16x8, w); }
        const LAS unsigned char* vb = lds + slot_c * SLOT + KB + vlane;
        s16x4 lo = vtr(vb), hh = vtr(vb + 512);
#pragma unroll
        for (int i = 0; i < 8; ++i) {
            const int d0 = i >> 2, ks = i & 3;
            s16x4 nlo = lo, nhh = hh;
            if (i + 1 < 8) { const int o2 = ((i + 1) >> 2) * 4096 + ((i + 1) & 3) * 1024; nlo = vtr(vb + o2); nhh = vtr(vb + o2 + 512); }
            const bf16x8 vf = (bf16x8){lo[0], lo[1], lo[2], lo[3], hh[0], hh[1], hh[2], hh[3]};
            oT[d0] = __builtin_amdgcn_mfma_f32_32x32x16_bf16(vf, pf[ks], oT[d0], 0, 0, 0);
            lo = nlo; hh = nhh;
        }
        if constexpr (!SAFE) {
            if (mv) {
                auto rr = __builtin_amdgcn_permlane32_swap(__float_as_uint(rs), __float_as_uint(rs), false, false);
                const float rrow = __uint_as_float(rr[0]) + __uint_as_float(rr[1]);
                ovf = ovf || !(rrow < 1.0e30f);
                const int ex = __builtin_amdgcn_frexp_expf(rrow) - 1;
                dl = (float)(ex > 0 ? ex : 0); const float al = __builtin_amdgcn_exp2f(-dl); lrun *= al;
#pragma unroll
                for (int r = 0; r < 16; ++r) { n0[r] -= dl; n1[r] -= dl; negm[r] -= dl; oT[0][r] *= al; oT[1][r] *= al; }
            }
        }
    };
    dma(kt0, 0); dma(kt0 + 1, 1); dma(kt0 + 2, 2);
    wait_bar(true);
    f32x16 pA0, pA1, pB0, pB1;
    qk(0, pA0, pA1);
    { mrun = tilemax(pA0, pA1);
#pragma unroll
      for (int r = 0; r < 16; ++r) negm[r] = -mrun;
      qk(0, pA0, pA1); }
    int sc = 0;
    for (int kt = kt0; kt < kt1; kt += 2) {
        { const int s1 = (sc + 1) & 3, s3 = (sc + 3) & 3;
          if (kt + 3 < kt1) dma(kt + 3, s3);
          step(pA0, pA1, pB0, pB1, sc, s1);
          wait_bar(kt + 3 < kt1);
          sc = s1; }
        { const int s1 = (sc + 1) & 3, s3 = (sc + 3) & 3;
          if (kt + 4 < kt1) dma(kt + 4, s3);
          step(pB0, pB1, pA0, pA1, sc, s1);
          wait_bar(kt + 4 < kt1);
          sc = s1; }
    }
    { auto rr = __builtin_amdgcn_permlane32_swap(__float_as_uint(lrun), __float_as_uint(lrun), false, false); lrun = __uint_as_float(rr[0]) + __uint_as_float(rr[1]); }
    const float inv = 1.0f / lrun;
    bf16_t* orow = S.O + (size_t)(q0 + wid * 32 + r32) * S.opitch;
#pragma unroll
    for (int d0 = 0; d0 < 2; ++d0)
#pragma unroll
        for (int g = 0; g < 4; ++g) { u32x2 w; w.x = cvtpk(oT[d0][4 * g] * inv, oT[d0][4 * g + 1] * inv); w.y = cvtpk(oT[d0][4 * g + 2] * inv, oT[d0][4 * g + 3] * inv);
            *(u32x2*)(orow + 32 * d0 + 8 * g + 4 * hi) = w; }
    return ovf;
}
template <int DQK>
__device__ __forceinline__ bool attn_fast(const Frame& F, const AttnSrc<DQK>& S, int q0, int lat0, int ctx0, int kt0, int kt1) {
    constexpr int NKS = DQK / 16, KB = DQK * 128, SLOT = KB + 8192, NS = 5;
    constexpr float BIG = 1.0e12f;
    bool ovf = false;
    const int lane = F.lane, wid = F.wave, r32 = lane & 31, hi = lane >> 5;
    LAS unsigned char* lds = F.lds;
    bf16x8 qf[NKS];
    { const bf16_t* qrow = S.Q + (size_t)(q0 + wid * 32 + r32) * S.qpitch;
#pragma unroll
      for (int ks = 0; ks < 4; ++ks) qf[ks] = *(const bf16x8*)(qrow + ks * 16 + hi * 8);
      if (DQK == 96) { const bf16_t* qr = S.Qr + (size_t)(q0 + wid * 32 + r32) * S.qpitch;
#pragma unroll
          for (int ks = 4; ks < NKS; ++ks) qf[ks] = *(const bf16x8*)(qr + (ks - 4) * 16 + hi * 8); } }
    const unsigned lds0 = (unsigned)(size_t)lds;
    auto dma = [&](int kt, int slot) {
        const int krow = attn_krow(kt, lat0, ctx0);
        const unsigned sb = lds0 + slot * SLOT;
        glds16(S.Kn + (size_t)(krow + lane) * S.kpitch + wid * 8, (unsigned)__builtin_amdgcn_readfirstlane(sb + wid * 1024));
        if (DQK == 96 && wid < 4) glds16(S.Kr + (size_t)(krow + lane) * S.krpitch + wid * 8, (unsigned)__builtin_amdgcn_readfirstlane(sb + (8 + wid) * 1024));
        glds16(S.V + (size_t)(krow + 16 * (wid & 3) + (lane >> 2)) * S.vpitch + (wid >> 2) * 32 + (lane & 3) * 8, (unsigned)__builtin_amdgcn_readfirstlane(sb + KB + wid * 1024));
    };
    auto wait_bar = [&](bool inflight) {
        if (!inflight) { WAIT_BAR(0); } else if (DQK == 96 && wid < 4) { WAIT_BAR(3); } else { WAIT_BAR(2); }
    };
    f32x16 oT[2]; f32x16 negm;
#pragma unroll
    for (int r = 0; r < 16; ++r) { oT[0][r] = 0.f; oT[1][r] = 0.f; negm[r] = 0.f; }
    float lrun = 0.f;
    const int vlane = ((lane >> 4) & 1) * 32 + (lane & 3) * 8 + (4 * hi + ((lane & 15) >> 2)) * 64;
    auto qk = [&](int slot, f32x16& p0, f32x16& p1) {
        const LAS unsigned char* kb = lds + slot * SLOT + hi * 1024 + r32 * 16;
        p0 = negm; p1 = negm;
        bf16x8 ka = *(const LAS bf16x8*)(kb), kc = *(const LAS bf16x8*)(kb + 512);
#pragma unroll
        for (int ks = 0; ks < NKS; ++ks) {
            bf16x8 na = ka, nc = kc;
            if (ks + 1 < NKS) { na = *(const LAS bf16x8*)(kb + (ks + 1) * 2048); nc = *(const LAS bf16x8*)(kb + (ks + 1) * 2048 + 512); }
            p0 = __builtin_amdgcn_mfma_f32_32x32x16_bf16(ka, qf[ks], p0, 0, 0, 0);
            p1 = __builtin_amdgcn_mfma_f32_32x32x16_bf16(kc, qf[ks], p1, 0, 0, 0);
            ka = na; kc = nc;
        }
    };
    bf16x8 pf[4];
#pragma unroll
    for (int j = 0; j < 4; ++j) pf[j] = (bf16x8){0, 0, 0, 0, 0, 0, 0, 0};
    auto step = [&](f32x16& c0, f32x16& c1, f32x16& n0, f32x16& n1, int slot_p, int slot_n) {
        float rs = 0.f;
        asm volatile("" : "+v"(c0), "+v"(c1));
        const LAS unsigned char* kb = lds + slot_n * SLOT + hi * 1024 + r32 * 16;
        const LAS unsigned char* vb = lds + slot_p * SLOT + KB + vlane;
        bf16x8 ka = *(const LAS bf16x8*)(kb), kc = *(const LAS bf16x8*)(kb + 512);
        s16x4 lo = vtr(vb), hh = vtr(vb + 512);
#pragma unroll
        for (int ks = 0; ks < NKS; ++ks) {
            bf16x8 na = ka, nc = kc;
            if (ks + 1 < NKS) { na = *(const LAS bf16x8*)(kb + (ks + 1) * 2048); nc = *(const LAS bf16x8*)(kb + (ks + 1) * 2048 + 512); }
            if (ks == 0) { n0 = mfma_first(ka, qf[0], negm); n1 = mfma_first(kc, qf[0], negm); }
            else { n0 = __builtin_amdgcn_mfma_f32_32x32x16_bf16(ka, qf[ks], n0, 0, 0, 0);
                   n1 = __builtin_amdgcn_mfma_f32_32x32x16_bf16(kc, qf[ks], n1, 0, 0, 0); }
            ka = na; kc = nc;
#pragma unroll
            for (int i = (8 * ks) / NKS; i < (8 * (ks + 1)) / NKS; ++i) {
                s16x4 nlo = lo, nhh = hh;
                if (i + 1 < 8) { const int o2 = ((i + 1) >> 2) * 4096 + ((i + 1) & 3) * 1024; nlo = vtr(vb + o2); nhh = vtr(vb + o2 + 512); }
                const bf16x8 vf = (bf16x8){lo[0], lo[1], lo[2], lo[3], hh[0], hh[1], hh[2], hh[3]};
                oT[i >> 2] = __builtin_amdgcn_mfma_f32_32x32x16_bf16(vf, pf[i & 3], oT[i >> 2], 0, 0, 0);
                lo = nlo; hh = nhh;
            }
#pragma unroll
            for (int r = (16 * ks) / NKS; r < (16 * (ks + 1)) / NKS; ++r) { c0[r] = __builtin_amdgcn_exp2f(c0[r]); c1[r] = __builtin_amdgcn_exp2f(c1[r]); rs = (rs + c0[r]) + c1[r]; }
            __builtin_amdgcn_sched_barrier(0);
        }
        ovf = ovf || !(rs < BIG);
        lrun += rs;
        { u32x4 w;
          w.x = cvtpk(c0[0], c0[1]); w.y = cvtpk(c0[2], c0[3]); w.z = cvtpk(c0[4], c0[5]); w.w = cvtpk(c0[6], c0[7]); pf[0] = __builtin_bit_cast(bf16x8, w);
          w.x = cvtpk(c0[8], c0[9]); w.y = cvtpk(c0[10], c0[11]); w.z = cvtpk(c0[12], c0[13]); w.w = cvtpk(c0[14], c0[15]); pf[1] = __builtin_bit_cast(bf16x8, w);
          w.x = cvtpk(c1[0], c1[1]); w.y = cvtpk(c1[2], c1[3]); w.z = cvtpk(c1[4], c1[5]); w.w = cvtpk(c1[6], c1[7]); pf[2] = __builtin_bit_cast(bf16x8, w);
          w.x = cvtpk(c1[8], c1[9]); w.y = cvtpk(c1[10], c1[11]); w.z = cvtpk(c1[12], c1[13]); w.w = cvtpk(c1[14], c1[15]); pf[3] = __builtin_bit_cast(bf16x8, w); }
        asm volatile("" : "+v"(pf[0]), "+v"(pf[1]), "+v"(pf[2]), "+v"(pf[3]), "+v"(lrun));
    };
    dma(kt0, 0); dma(kt0 + 1, 1); dma(kt0 + 2, 2);
    wait_bar(true);
    f32x16 pA0, pA1, pB0, pB1;
    qk(0, pA0, pA1);
    {
        asm volatile("s_nop 15\n\ts_nop 7" : "+v"(pA0), "+v"(pA1));
        float a = max3f(pA0[0], pA0[1], pA1[0]), b = max3f(pA0[2], pA0[3], pA1[1]); a = max3f(a, pA1[2], pA1[3]);
#pragma unroll
        for (int r = 4; r < 16; r += 4) { a = max3f(a, pA0[r], pA0[r + 1]); b = max3f(b, pA0[r + 2], pA0[r + 3]); a = max3f(a, pA1[r], pA1[r + 1]); b = max3f(b, pA1[r + 2], pA1[r + 3]); }
        float tm = fmaxf(a, b);
        auto rr = __builtin_amdgcn_permlane32_swap(__float_as_uint(tm), __float_as_uint(tm), false, false); tm = fmaxf(__uint_as_float(rr[0]), __uint_as_float(rr[1]));
#pragma unroll
        for (int r = 0; r < 16; ++r) negm[r] = -tm;
        qk(0, pA0, pA1); }
    int sc = 0;
    for (int kt = kt0; kt < kt1; kt += 2) {
        { const int sp = (kt == kt0) ? sc : (sc == 0 ? NS - 1 : sc - 1), s1 = (sc == NS - 1) ? 0 : sc + 1, s3 = (sc + 3 >= NS) ? sc + 3 - NS : sc + 3;
          if (kt + 3 < kt1) dma(kt + 3, s3);
          step(pA0, pA1, pB0, pB1, sp, s1);
          wait_bar(kt + 3 < kt1);
          sc = s1; }
        { const int sp = (sc == 0) ? NS - 1 : sc - 1, s1 = (sc == NS - 1) ? 0 : sc + 1, s3 = (sc + 3 >= NS) ? sc + 3 - NS : sc + 3;
          if (kt + 4 < kt1) dma(kt + 4, s3);
          step(pB0, pB1, pA0, pA1, sp, s1);
          wait_bar(kt + 4 < kt1);
          sc = s1; }
    }
    {
        const int sp = (sc == 0) ? NS - 1 : sc - 1;
        const LAS unsigned char* vb = lds + sp * SLOT + KB + vlane;
        s16x4 lo = vtr(vb), hh = vtr(vb + 512);
#pragma unroll
        for (int i = 0; i < 8; ++i) {
            s16x4 nlo = lo, nhh = hh;
            if (i + 1 < 8) { const int o2 = ((i + 1) >> 2) * 4096 + ((i + 1) & 3) * 1024; nlo = vtr(vb + o2); nhh = vtr(vb + o2 + 512); }
            const bf16x8 vf = (bf16x8){lo[0], lo[1], lo[2], lo[3], hh[0], hh[1], hh[2], hh[3]};
            oT[i >> 2] = __builtin_amdgcn_mfma_f32_32x32x16_bf16(vf, pf[i & 3], oT[i >> 2], 0, 0, 0);
            lo = nlo; hh = nhh;
        }
    }
    { auto rr = __builtin_amdgcn_permlane32_swap(__float_as_uint(lrun), __float_as_uint(lrun), false, false); lrun = __uint_as_float(rr[0]) + __uint_as_float(rr[1]); }
    const float inv = 1.0f / lrun;
    bf16_t* orow = S.O + (size_t)(q0 + wid * 32 + r32) * S.opitch;
#pragma unroll
    for (int d0 = 0; d0 < 2; ++d0)
#pragma unroll
        for (int g = 0; g < 4; ++g) { u32x2 w; w.x = cvtpk(oT[d0][4 * g] * inv, oT[d0][4 * g + 1] * inv); w.y = cvtpk(oT[d0][4 * g + 2] * inv, oT[d0][4 * g + 3] * inv);
            *(u32x2*)(orow + 32 * d0 + 8 * g + 4 * hi) = w; }
    return ovf;
}
template <int DQK>
__device__ __forceinline__ void attn_unit(const Frame& F, const AttnSrc<DQK>& S, int q0, int lat0, int ctx0, int kt0, int kt1) {
    volatile LAS unsigned* flag = (volatile LAS unsigned*)(F.lds + LDSCTL_OFF);
    const bool ovf = attn_fast<DQK>(F, S, q0, lat0, ctx0, kt0, kt1);
    if (__any(ovf) && F.lane == 0) flag[0] = 1u;
    __syncthreads();
    const bool redo = __builtin_amdgcn_readfirstlane((int)flag[0]) != 0;
    __syncthreads();
    if (redo) { if (F.tid == 0) flag[0] = 0u; (void)attn_run<DQK, true>(F, S, q0, lat0, ctx0, kt0, kt1); }
}

__device__ __forceinline__ int sig5(int c) { return (c & ~12) | ((c & 8) >> 1) | ((c & 4) << 1); }

__global__ void __launch_bounds__(512, 2) mk_fwd(Args args) {
    extern __shared__ __attribute__((aligned(16))) unsigned char lds_raw[];
    Frame F;
    F.lds = (LAS unsigned char*)lds_raw; F.ws = args.ws;
    F.tid = threadIdx.x; F.lane = F.tid & 63; F.wave = __builtin_amdgcn_readfirstlane(F.tid >> 6);
    F.G = gridDim.x; { const int bx = blockIdx.x; F.vcu = (F.G % 8 == 0) ? (bx % 8) * (F.G / 8) + bx / 8 : bx; }
    volatile LAS unsigned* MISC = (volatile LAS unsigned*)(F.lds + LDSCTL_OFF);
    if (F.tid < 64) MISC[F.tid] = 0u;
    __syncthreads();
    unsigned* ctl = wsp<unsigned>(F, O_CTL);
#if MK_ONE_LAUNCH
    XcdBarrier bar = xcd_barrier_post(ctl + CW_BAR, MISC + 8);
#define GRID_BAR() xcd_barrier(bar)
#else
#define GRID_BAR() do {} while (0)
#endif
    const int lo = args.ph_lo, hi_ph = args.ph_hi;
#define IN(k) (lo <= (k) && (k) < hi_ph)
#define SEAM(k) do { if (IN(k) && IN((k) + 1)) GRID_BAR(); } while (0)
    const int lane = F.lane, wave = F.wave, tid = F.tid;
    const int gw = F.vcu * 8 + wave, NGW = F.G * 8;

    const float* x_in = args.in[I_X]; const float* ctx_in = args.in[I_CTX];
    float* MODV = wsp<float>(F, O_MODV);
    float* TAB16 = wsp<float>(F, O_TAB16); float* TAB32 = wsp<float>(F, O_TAB32);
    float* HC = wsp<float>(F, O_HC);
    bf16_t* U = wsp<bf16_t>(F, O_U);
    float* Y = wsp<float>(F, O_Y);
    const float* normg = args.in[I_NORMG];
#define MV(layer, bidx, k) (MODV + ((size_t)((layer) * 5 + (bidx)) * 6 + (k)) * D)

    if (IN(0)) {
        {
            LAS float* sc = (LAS float*)F.lds;
            LAS float* red = sc + 5 * 1024;
            for (int i = tid; i < 5 * 1024; i += 512) { const int b = i >> 10, k = i & 1023; const float cv = (b < 4) ? args.in[I_C][b * 1024 + k] : args.in[I_CCTX][k]; sc[i] = cv / (1.0f + __expf(-cv)); }
            __syncthreads();
            for (int unit = F.vcu; unit < 192; unit += F.G) {
                const int layer = unit / 96, cb = unit % 96, col = cb * 64 + lane;
                const float* W = args.in[I_MODW] + (size_t)layer * D * 6144 + col;
                float a0 = 0.f, a1 = 0.f, a2 = 0.f, a3 = 0.f, a4 = 0.f;
#pragma unroll 16
                for (int kk = 0; kk < 128; ++kk) { const int k = wave * 128 + kk; const float w = W[(size_t)k * 6144];
                    a0 += sc[k] * w; a1 += sc[1024 + k] * w; a2 += sc[2048 + k] * w; a3 += sc[3072 + k] * w; a4 += sc[4096 + k] * w; }
                red[(wave * 5 + 0) * 64 + lane] = a0; red[(wave * 5 + 1) * 64 + lane] = a1; red[(wave * 5 + 2) * 64 + lane] = a2; red[(wave * 5 + 3) * 64 + lane] = a3; red[(wave * 5 + 4) * 64 + lane] = a4;
                __syncthreads();
                if (tid < 320) { const int b = tid >> 6, cc = tid & 63; float s = 0.f;
#pragma unroll
                    for (int w = 0; w < 8; ++w) s += red[(w * 5 + b) * 64 + cc];
                    MODV[(size_t)(layer * 5 + b) * 6144 + cb * 64 + cc] = s + args.in[I_MODB][layer * 6144 + cb * 64 + cc]; }
                __syncthreads();
            }
        }
        if (blockIdx.x == 0) {
            for (int i = tid; i < 64 * 8; i += 512) { const int pos = i >> 3, f = i & 7; const float fr = powf(10000.0f, -(float)f / 8.0f), a = (float)pos * fr; TAB16[i] = cosf(a); TAB16[512 + i] = sinf(a); }
            for (int i = tid; i < 64 * 16; i += 512) { const int pos = i >> 4, f = i & 15; const float fr = powf(10000.0f, -(float)f / 16.0f), a = (float)pos * fr; TAB32[i] = cosf(a); TAB32[1024 + i] = sinf(a); }
        }
        {
            LAS float* scr = (LAS float*)(F.lds + wave * 16640);
            int base = 0;
            auto run = [&](const Conv& c) { const int n = (c.K / 64) * (c.Ndst / 32); for (int it = gw - base; it < n; it += NGW) { if (it >= 0) conv_item(c, it, scr, lane); }
                base = (base + n) % NGW; };
            auto run64 = [&](const Conv64& c) { conv64_run(c, scr, lane, gw, NGW, base); };
            run64(Conv64{args.in[I_FWG], args.in[I_FWU], FFN, 1024, N_GU0, wsp<bf16_t>(F, O_WGU0), 3, 0, 0, 64.0f, 1});
            run64(Conv64{args.in[I_FWD], nullptr, 1024, FFN, 1024, wsp<bf16_t>(F, O_WD0), 0, 1024, 0, 1.0f, 0});
            run64(Conv64{args.in[I_GWIN], nullptr, 3104, 1024, N_IN1, wsp<bf16_t>(F, O_WIN1), 0, 3104, 512, 0.08838834764831845f, 0});
            run64(Conv64{args.in[I_GWOUT], nullptr, 1024, 1024, 1024, wsp<bf16_t>(F, O_WOUT1), 0, 1024, 0, 1.0f, 0});
            run64(Conv64{args.in[I_AWOUT], nullptr, 1024, 1024, 1024, wsp<bf16_t>(F, O_WOUT0), 0, 1024, 0, 1.0f, 0});
            run(Conv{args.in[I_AWIN], nullptr, 1440, 1024, N_IN0, wsp<bf16_t>(F, O_WIN0), 1, nullptr});
            run(Conv{args.in[I_AWUQ], nullptr, 768, 384, N_QA, wsp<bf16_t>(F, O_WUQ), 2, args.in[I_AQN]});
            run(Conv{args.in[I_AWUKV], nullptr, 1024, 256, N_KVA, wsp<bf16_t>(F, O_WUKV), 0, args.in[I_AKVN]});
        }
    }
    SEAM(0);

    if (IN(1)) {
        for (int row = gw; row < R; row += NGW) {
            const float* hp = row < RL ? x_in + (size_t)row * D : ctx_in + (size_t)(row - RL) * D;
            f32x4 h[4], uo[4]; load_row(hp, lane, h);
            const int b = row_bidx(row);
            norm_mod_store(h, normg + 0 * D, MV(0, b, 0), MV(0, b, 1), U + (size_t)row * D, lane, uo);
        }
    }
    SEAM(1);

    if (IN(2)) {
        pg8::DenseProb P{U, wsp<bf16_t>(F, O_WIN0), 1024, 1024, 1024, {}}; P.ord.init(R / 256, N_IN0 / 256, F.G, (int)blockIdx.x);
        pg8::EpiBf16 E{wsp<bf16_t>(F, O_Z0), N_IN0, nullptr};
        pg8::gemm_phase(F.lds, P, E);
    }
    SEAM(2);

    if (IN(3)) {
        const bf16_t* Z0 = wsp<bf16_t>(F, O_Z0);
        float* RSQ = wsp<float>(F, O_RSTDQ); float* RSKV = wsp<float>(F, O_RSTDKV);
        bf16_t* QB = wsp<bf16_t>(F, O_QB); bf16_t* KBp = wsp<bf16_t>(F, O_KB); bf16_t* KR = wsp<bf16_t>(F, O_KR);
        const float* qkn = args.in[I_AQKN];
        for (int row = gw; row < R; row += NGW) {
            const unsigned* z32 = (const unsigned*)(Z0 + (size_t)row * N_IN0);
            float s = 0.f;
#pragma unroll
            for (int j = 0; j < 3; ++j) { const unsigned w = z32[lane + 64 * j]; const float a = bflo(w), b = bfhi(w); s += a * a + b * b; }
            s = wave_sum(s);
            float s2 = 0.f;
#pragma unroll
            for (int j = 0; j < 2; ++j) { const unsigned w = z32[192 + lane + 64 * j]; const float a = bflo(w), b = bfhi(w); s2 += a * a + b * b; }
            s2 = wave_sum(s2);
            if (lane == 0) { RSQ[row] = __builtin_amdgcn_rsqf(s * (1.0f / 384.0f) + EPS); RSKV[row] = __builtin_amdgcn_rsqf(s2 * (1.0f / 256.0f) + EPS); }
            const bool lat = row < RL; const int tt = row & (SEQ - 1);
#pragma unroll
            for (int which = 0; which < 2; ++which) {
                if (which == 1 && lane >= 16) break;
                const u32x4 w4 = *(const u32x4*)(Z0 + (size_t)row * N_IN0 + (which ? 1152 : 640) + lane * 8);
                float v[8] = {bflo(w4.x), bfhi(w4.x), bflo(w4.y), bfhi(w4.y), bflo(w4.z), bfhi(w4.z), bflo(w4.w), bfhi(w4.w)};
                float ss = 0.f;
#pragma unroll
                for (int j = 0; j < 8; ++j) ss += v[j] * v[j];
                ss += __shfl_xor(ss, 1); ss += __shfl_xor(ss, 2); ss += __shfl_xor(ss, 4);
                const float rstd = __builtin_amdgcn_rsqf(ss * (1.0f / 64.0f) + EPS);
                const int jp = lane & 7, half = jp >> 2, i0 = 4 * (jp & 3);
                const float* gn = qkn + which * 64 + half * 32;
#pragma unroll
                for (int pz = 0; pz < 4; ++pz) { v[2 * pz] *= rstd * gn[i0 + pz]; v[2 * pz + 1] *= rstd * gn[16 + i0 + pz]; }
                if (lat) { const int pos = half ? (tt & 63) : (tt >> 6);
                    const f32x4 cs = *(const f32x4*)(TAB32 + pos * 16 + i0), sn = *(const f32x4*)(TAB32 + 1024 + pos * 16 + i0);
#pragma unroll
                    for (int pz = 0; pz < 4; ++pz) { const float a = v[2 * pz], b = v[2 * pz + 1]; v[2 * pz] = a * cs[pz] - b * sn[pz]; v[2 * pz + 1] = b * cs[pz] + a * sn[pz]; } }
                const float osc = which ? 1.0f : 0.125f * LOG2E;
                u32x4 o; o.x = cvtpk(v[0] * osc, v[1] * osc); o.y = cvtpk(v[2] * osc, v[3] * osc); o.z = cvtpk(v[4] * osc, v[5] * osc); o.w = cvtpk(v[6] * osc, v[7] * osc);
                if (which == 0) *(u32x4*)(QB + (size_t)row * 512 + lane * 8) = o; else *(u32x4*)(KBp + (size_t)row * 128 + lane * 8) = o;
            }
            if (lane < 4) {
                const u32x4 w4 = *(const u32x4*)(Z0 + (size_t)row * N_IN0 + 1408 + lane * 8);
                float v[8] = {bflo(w4.x), bfhi(w4.x), bflo(w4.y), bfhi(w4.y), bflo(w4.z), bfhi(w4.z), bflo(w4.w), bfhi(w4.w)};
                if (lat) { const int half = lane >> 1, i0 = 4 * (lane & 1); const int pos = half ? (tt & 63) : (tt >> 6);
                    const f32x4 cs = *(const f32x4*)(TAB16 + pos * 8 + i0), sn = *(const f32x4*)(TAB16 + 512 + pos * 8 + i0);
#pragma unroll
                    for (int pz = 0; pz < 4; ++pz) { const float a = v[2 * pz], b = v[2 * pz + 1]; v[2 * pz] = a * cs[pz] - b * sn[pz]; v[2 * pz + 1] = b * cs[pz] + a * sn[pz]; } }
                u32x4 o; o.x = cvtpk(v[0], v[1]); o.y = cvtpk(v[2], v[3]); o.z = cvtpk(v[4], v[5]); o.w = cvtpk(v[6], v[7]);
                *(u32x4*)(KR + (size_t)row * 32 + lane * 8) = o;
            }
        }
    }
    SEAM(3);

    if (IN(4)) {
        { pg8::DenseProb P{wsp<bf16_t>(F, O_Z0), wsp<bf16_t>(F, O_WUQ), 384, N_IN0, 384, {}}; P.ord.init(R / 256, N_QA / 256, F.G, (int)blockIdx.x);
          pg8::EpiQA E{wsp<bf16_t>(F, O_QA), wsp<float>(F, O_RSTDQ), TAB16, 0.10206207261596577f * LOG2E};
          pg8::gemm_phase(F.lds, P, E); }
        { pg8::DenseProb P{wsp<bf16_t>(F, O_Z0) + 384, wsp<bf16_t>(F, O_WUKV), 256, N_IN0, 256, {}}; P.ord.init(R / 256, N_KVA / 256, F.G, (int)((blockIdx.x + F.G - (204 % F.G)) % F.G));
          pg8::EpiBf16 E{wsp<bf16_t>(F, O_KVA), N_KVA, wsp<float>(F, O_RSTDKV)};
          pg8::gemm_phase(F.lds, P, E); }
    }
    SEAM(4);

    if (IN(5)) {
        const bf16_t* QA = wsp<bf16_t>(F, O_QA); const bf16_t* KVA = wsp<bf16_t>(F, O_KVA); const bf16_t* QB = wsp<bf16_t>(F, O_QB);
        const bf16_t* KBp = wsp<bf16_t>(F, O_KB); const bf16_t* KR = wsp<bf16_t>(F, O_KR); const bf16_t* Z0 = wsp<bf16_t>(F, O_Z0);
        bf16_t* AO = wsp<bf16_t>(F, O_AO);
        for (int i = 0; i < 3; ++i) {
            int b, hh, q0, kt0, kt1;
            if (i < 2) { const int m = i * 256 + F.vcu; b = m >> 7; hh = (m >> 4) & 7; q0 = b * SEQ + (m & 15) * 256; kt0 = 0; kt1 = 68; }
            else { if (F.vcu >= 32) break; b = (F.vcu >> 3) & 3; hh = F.vcu & 7; q0 = RL + b * CTX; kt0 = 64; kt1 = 68; }
            const int lat0 = b * SEQ, ctx0 = RL + b * CTX;
            AttnSrc<96> S{QA + hh * 64, N_QA, QA + 512 + hh * 32, KVA + hh * 128, N_KVA, KR, 32, KVA + hh * 128 + 64, N_KVA, AO + hh * 64, D};
            attn_unit<96>(F, S, q0, lat0, ctx0, kt0, kt1);
        }
        for (int i = 0; i < 3; ++i) {
            int b, hh, q0, kt0, kt1;
            if (i < 2) { const int m = i * 256 + F.vcu; b = m >> 7; hh = (m >> 4) & 7; q0 = b * SEQ + (m & 15) * 256; kt0 = 0; kt1 = 68; }
            else { if (F.vcu < 32 || F.vcu >= 64) break; b = (F.vcu >> 3) & 3; hh = F.vcu & 7; q0 = RL + b * CTX; kt0 = 64; kt1 = 68; }
            const int lat0 = b * SEQ, ctx0 = RL + b * CTX; const int kvh = hh >> 2;
            AttnSrc<64> S{QB + hh * 64, 512, nullptr, KBp + kvh * 64, 128, nullptr, 0, Z0 + 1280 + kvh * 64, N_IN0, AO + 512 + hh * 64, D};
            attn_unit<64>(F, S, q0, lat0, ctx0, kt0, kt1);
        }
    }
    SEAM(5);

    if (IN(6)) {
        pg8::DenseProb P{wsp<bf16_t>(F, O_AO), wsp<bf16_t>(F, O_WOUT0), 1024, 1024, 1024, {}}; P.ord.init(RL / 256, 4, F.G, (int)blockIdx.x);
        pg8::EpiBf16 E{(bf16_t*)Y, D, nullptr};
        pg8::gemm_phase(F.lds, P, E);
    }
    SEAM(6);


    auto post0 = [&](int row) {
            const float* hp = row < RL ? x_in + (size_t)row * D : ctx_in + (size_t)(row - RL) * D;
            float* ho = row < RL ? args.out + (size_t)row * D : HC + (size_t)(row - RL) * D;
            const int b = row_bidx(row);
            f32x4 y[4], h[4], uo[4]; load_row_bf16((const bf16_t*)Y + (size_t)row * D, lane, y); load_row(hp, lane, h);
            const float rstd = __builtin_amdgcn_rsqf(row_ssq(y) * (1.0f / D) + EPS);
#pragma unroll
            for (int j = 0; j < 4; ++j) { const int c = 4 * lane + 256 * j; const f32x4 g = *(const f32x4*)(normg + 1 * D + c), mg = *(const f32x4*)(MV(0, b, 2) + c);
                h[j] = h[j] + mg * (y[j] * rstd * g); *(f32x4*)(ho + c) = h[j]; }
            norm_mod_store(h, normg + 2 * D, MV(0, b, 3), MV(0, b, 4), nullptr, lane, uo, wsp<unsigned char>(F, O_U) + (size_t)row * D);
    };
    if (IN(7)) {
        const bool split = F.G > 32;
        if (!split || blockIdx.x < 16) {
            pg8::DenseProb P{wsp<bf16_t>(F, O_AO) + (size_t)RL * D, wsp<bf16_t>(F, O_WOUT0), 1024, 1024, 1024, {}}; P.ord.init(RC / 256, 4, split ? 16 : F.G, (int)blockIdx.x);
            pg8::EpiBf16 E{(bf16_t*)Y + (size_t)RL * D, D, nullptr};
            pg8::gemm_phase(F.lds, P, E);
        }
        if (!split) { for (int row = gw; row < RL; row += NGW) post0(row); }
        else if (blockIdx.x >= 16) { for (int row = ((int)blockIdx.x - 16) * 8 + wave; row < RL; row += (F.G - 16) * 8) post0(row); }
    }
    SEAM(7);
    if (IN(8)) { for (int row = RL + gw; row < R; row += NGW) post0(row); }
    SEAM(8);


    if (IN(9)) {
        pg8::DenseProb8<125, 121> P{wsp<unsigned char>(F, O_U), wsp<unsigned char>(F, O_WGU0), 512, 512, 1024, {}}; P.ord.init(R / 256, N_GU0 / 256, F.G, (int)blockIdx.x);
        pg8::EpiSwiglu E{wsp<bf16_t>(F, O_H0), FFN};
        pg8::gemm_phase(F.lds, P, E);
    }
    SEAM(9);
    if (IN(10)) {
        pg8::DenseProb P{wsp<bf16_t>(F, O_H0), wsp<bf16_t>(F, O_WD0), FFN, FFN, FFN, {}}; P.ord.init(RL / 256, 4, F.G, (int)blockIdx.x);
        pg8::EpiBf16 E{(bf16_t*)Y, D, nullptr};
        pg8::gemm_phase(F.lds, P, E);
    }
    SEAM(10);


    auto post1 = [&](int row) {
            float* hp = row < RL ? args.out + (size_t)row * D : HC + (size_t)(row - RL) * D;
            const int b = row_bidx(row);
            f32x4 y[4], h[4], uo[4]; load_row_bf16((const bf16_t*)Y + (size_t)row * D, lane, y); load_row(hp, lane, h);
            const float rstd = __builtin_amdgcn_rsqf(row_ssq(y) * (1.0f / D) + EPS);
#pragma unroll
            for (int j = 0; j < 4; ++j) { const int c = 4 * lane + 256 * j; const f32x4 g = *(const f32x4*)(normg + 3 * D + c), mg = *(const f32x4*)(MV(0, b, 5) + c);
                h[j] = h[j] + mg * (y[j] * rstd * g); *(f32x4*)(hp + c) = h[j]; }
            norm_mod_store(h, normg + 4 * D, MV(1, b, 0), MV(1, b, 1), U + (size_t)row * D, lane, uo);
    };
    if (IN(11)) {
        const bool split = F.G > 32;
        if (!split || blockIdx.x < 16) {
            pg8::DenseProb P{wsp<bf16_t>(F, O_H0) + (size_t)RL * FFN, wsp<bf16_t>(F, O_WD0), FFN, FFN, FFN, {}}; P.ord.init(RC / 256, 4, split ? 16 : F.G, (int)blockIdx.x);
            pg8::EpiBf16 E{(bf16_t*)Y + (size_t)RL * D, D, nullptr};
            pg8::gemm_phase(F.lds, P, E);
        }
        if (!split) { for (int row = gw; row < RL; row += NGW) post1(row); }
        else if (blockIdx.x >= 16) { for (int row = ((int)blockIdx.x - 16) * 8 + wave; row < RL; row += (F.G - 16) * 8) post1(row); }
    }
    SEAM(11);
    if (IN(12)) { for (int row = RL + gw; row < R; row += NGW) post1(row); }
    SEAM(12);


    if (IN(13)) {
        pg8::DenseProb P{U, wsp<bf16_t>(F, O_WIN1), 1024, 1024, 1024, {}}; P.ord.init(R / 256, N_IN1 / 256, F.G, (int)blockIdx.x);
        pg8::EpiIn1 E{wsp<bf16_t>(F, O_QK1), wsp<bf16_t>(F, O_V1), wsp<bf16_t>(F, O_G1), wsp<bf16_t>(F, O_RR)};
        pg8::gemm_phase(F.lds, P, E);
    }
    SEAM(13);

    if (IN(14)) {
        const bf16_t* QK1 = wsp<bf16_t>(F, O_QK1); const bf16_t* V1 = wsp<bf16_t>(F, O_V1); const bf16_t* RRp = wsp<bf16_t>(F, O_RR);
        bf16_t* QDd[2] = {wsp<bf16_t>(F, O_QDF), wsp<bf16_t>(F, O_QDB)}; bf16_t* KId[2] = {wsp<bf16_t>(F, O_KIF), wsp<bf16_t>(F, O_KIB)}; bf16_t* KTd[2] = {wsp<bf16_t>(F, O_KTF), wsp<bf16_t>(F, O_KTB)};
        bf16_t* VT = wsp<bf16_t>(F, O_VT); float* ECL = wsp<float>(F, O_ECL);
        LAS float* tot = (LAS float*)F.lds;
        const int dkp = tid & 63, dk0 = 2 * dkp, tq = tid >> 6;
        int hh_loaded = -1; float w2[2][16][2], bg[2][2];
        for (int item = F.vcu; item < 544 * 4; item += F.G) {
            const int rc = item >> 2, hh = item & 3, row0 = rc * 32;
            if (hh != hh_loaded) {
                hh_loaded = hh;
#pragma unroll
                for (int d = 0; d < 2; ++d) { const f32x2_t bv = *(const f32x2_t*)(args.in[I_GBGATE] + d * 512 + hh * 128 + dk0); bg[d][0] = bv[0]; bg[d][1] = bv[1];
#pragma unroll
                    for (int j = 0; j < 16; ++j) { const f32x2_t wv = *(const f32x2_t*)(args.in[I_GGATE2] + (size_t)(d * 16 + j) * 512 + hh * 128 + dk0); w2[d][j][0] = wv[0]; w2[d][j][1] = wv[1]; } }
            }
            float a[2][4][2];
#pragma unroll
            for (int i = 0; i < 4; ++i) { const int row = row0 + 4 * tq + i;
                const u32x4* rp = (const u32x4*)(RRp + (size_t)row * 256);
#pragma unroll
                for (int d = 0; d < 2; ++d) { const u32x4 r0 = rp[2 * d], r1 = rp[2 * d + 1];
                    const float rv[16] = {bflo(r0.x), bfhi(r0.x), bflo(r0.y), bfhi(r0.y), bflo(r0.z), bfhi(r0.z), bflo(r0.w), bfhi(r0.w), bflo(r1.x), bfhi(r1.x), bflo(r1.y), bfhi(r1.y), bflo(r1.z), bfhi(r1.z), bflo(r1.w), bfhi(r1.w)};
#pragma unroll
                    for (int c = 0; c < 2; ++c) { float z = bg[d][c];
#pragma unroll
                        for (int j = 0; j < 16; ++j) z += rv[j] * w2[d][j][c];
                        a[d][i][c] = (fminf(z, 0.f) - __logf(1.0f + __expf(-fabsf(z)))) * (1.0f / 16.0f); } } }
            float cf[4][2], sb[4][2];
#pragma unroll
            for (int c = 0; c < 2; ++c) { float sfw = 0.f;
#pragma unroll
                for (int i = 0; i < 4; ++i) { sfw += a[0][i][c]; cf[i][c] = sfw; }
                float sbw = 0.f;
#pragma unroll
                for (int i = 3; i >= 0; --i) { sbw += a[1][i][c]; sb[i][c] = sbw; } }
            *(LAS f32x2_t*)(tot + (0 * 8 + tq) * 128 + dk0) = (f32x2_t){cf[3][0], cf[3][1]};
            *(LAS f32x2_t*)(tot + (1 * 8 + tq) * 128 + dk0) = (f32x2_t){sb[0][0], sb[0][1]};
            __syncthreads();
            float offF[2] = {0.f, 0.f}, offB[2] = {0.f, 0.f}, clF[2] = {0.f, 0.f}, clB[2] = {0.f, 0.f};
#pragma unroll
            for (int g = 0; g < 8; ++g) { const f32x2_t tf = *(const LAS f32x2_t*)(tot + (0 * 8 + g) * 128 + dk0), tb = *(const LAS f32x2_t*)(tot + (1 * 8 + g) * 128 + dk0);
#pragma unroll
                for (int c = 0; c < 2; ++c) { clF[c] += tf[c]; clB[c] += tb[c]; if (g < tq) offF[c] += tf[c]; if (g > tq) offB[c] += tb[c]; } }
            __syncthreads();
            const int pc = hh * 128 + (dk0 & ~31) + sig5(dk0 & 31);
#pragma unroll
            for (int i = 0; i < 4; ++i) { const int row = row0 + 4 * tq + i;
                const unsigned qw = *(const unsigned*)(QK1 + (size_t)row * D + hh * 128 + dk0), kw = *(const unsigned*)(QK1 + (size_t)row * D + 512 + hh * 128 + dk0);
                const float q[2] = {bflo(qw), bfhi(qw)}, k[2] = {bflo(kw), bfhi(kw)};
                float qdv[2][2], kiv[2][2];
#pragma unroll
                for (int c = 0; c < 2; ++c) { const float cF = offF[c] + cf[i][c], cB = offB[c] + sb[i][c];
                    qdv[0][c] = q[c] * __expf(cF); kiv[0][c] = k[c] * __expf(-cF); qdv[1][c] = q[c] * __expf(cB); kiv[1][c] = k[c] * __expf(-cB); }
#pragma unroll
                for (int d = 0; d < 2; ++d) {
                    *(unsigned*)(QDd[d] + (size_t)row * 512 + pc) = cvtpk(qdv[d][0], qdv[d][1]);
                    const unsigned kp = cvtpk(kiv[d][0], kiv[d][1]);
                    *(unsigned*)(KId[d] + (size_t)row * 512 + pc) = kp;
                } }
            if (tq == 0) { *(f32x2_t*)(ECL + ((size_t)(rc * 2 + 0) * 4 + hh) * 256 + dk0) = (f32x2_t){__expf(clF[0]), __expf(clF[1])};
                           *(f32x2_t*)(ECL + ((size_t)(rc * 2 + 1) * 4 + hh) * 256 + dk0) = (f32x2_t){__expf(clB[0]), __expf(clB[1])}; }
            { const int dv = tid & 255, th = tid >> 8; unsigned vw[8];
#pragma unroll
              for (int i = 0; i < 16; ++i) { const unsigned bv = V1[(size_t)(row0 + 16 * th + i) * D + hh * 256 + dv];
                  const int cc = sig5(i);
                  if (cc & 1) vw[cc >> 1] |= bv << 16; else vw[cc >> 1] = bv; }
              bf16_t* vp = VT + ((size_t)rc * 1024 + hh * 256 + dv) * 32 + 16 * th;
              u32x4 o0; o0.x = vw[0]; o0.y = vw[1]; o0.z = vw[2]; o0.w = vw[3]; *(u32x4*)vp = o0;
              u32x4 o1; o1.x = vw[4]; o1.y = vw[5]; o1.z = vw[6]; o1.w = vw[7]; *(u32x4*)(vp + 8) = o1; }
        }
    }
    SEAM(14);

    if (IN(15)) {
        const int xl = blockIdx.x & 7, jj = blockIdx.x >> 3;
        const bool scan_role = (jj & 1) == 0;
        const int nscan = ((F.G >> 3) + 1) / 2 * 8, nconv = F.G - nscan;
        if ((F.G & 7) == 0 && nconv > 0 && !scan_role) {
            LAS float* scr = (LAS float*)(F.lds + wave * 16640);
            const int cidx = xl * (F.G >> 4) + (jj >> 1); int base = 0; const int gwi = cidx * 8 + wave, ngw = nconv * 8;
            for (int e = 0; e < NEXP; ++e) {
                conv64_run(Conv64{args.in[I_MWG] + (size_t)e * D * EXD, args.in[I_MWU] + (size_t)e * D * EXD, EXD, 1024, N_GU1, wsp<bf16_t>(F, O_WGU1) + (size_t)e * N_GU1 * 1024 / 2, 3, 0, 0, 64.0f, 1}, scr, lane, gwi, ngw, base);
                conv64_run(Conv64{args.in[I_MWD] + (size_t)e * EXD * D, nullptr, 1024, EXD, 1024, wsp<bf16_t>(F, O_WD1) + (size_t)e * 1024 * EXD / 2, 0, 1024, 1024, 64.0f, 1}, scr, lane, gwi, ngw, base);
            }
        } else {
        const bool split = (F.G & 7) == 0 && nconv > 0;
        const int sidx = split ? xl * ((F.G >> 4) + ((F.G >> 3) & 1)) + (jj >> 1) : F.vcu, nsw = split ? nscan : F.G;
        const bf16_t* VT = wsp<bf16_t>(F, O_VT); const float* ECL = wsp<float>(F, O_ECL);
        constexpr int SLOT = 8192 * 2 + 2 * 2048 + 1024;
        const int r32 = lane & 31, hi = lane >> 5;
        for (int unit = sidx; unit < 128; unit += nsw) {
            const int chain = unit >> 2, dvp = unit & 3, b = chain >> 3, hh = (chain >> 1) & 3, dir = chain & 1;
            const int dvb = dvp * 2 + (wave & 1);
            const bf16_t* QDp = wsp<bf16_t>(F, dir ? O_QDB : O_QDF); const bf16_t* KIp = wsp<bf16_t>(F, dir ? O_KIB : O_KIF);
            bf16_t* Odp = wsp<bf16_t>(F, dir ? O_OB : O_OF);
            auto rcof = [&](int step) { return step < 8 ? 512 + b * 8 + (dir ? 7 - step : step) : b * 128 + (dir ? 127 - (step - 8) : (step - 8)); };
            const unsigned lds0 = (unsigned)(size_t)F.lds;
            auto dma = [&](int step, int slot) {
                if (wave < 2) return;
                const int rc = rcof(step); const unsigned sb = lds0 + slot * SLOT;
#pragma unroll
                for (int i = 0; i < 4; ++i) { const int j = (wave - 2) + 6 * i; if (j >= 21) break;
                    if (j < 16) { const int p = j & 7; const int r = 4 * p + (lane >> 4), c = (lane & 15) ^ (r & 15);
                        glds16((j < 8 ? KIp : QDp) + (size_t)(rc * 32 + r) * 512 + hh * 128 + c * 8, (unsigned)__builtin_amdgcn_readfirstlane(sb + j * 1024)); }
                    else if (j < 20) { const int p = j - 16; const int r = 16 * (p & 1) + (lane >> 2), c = (lane & 3) ^ ((r >> 2) & 3);
                        glds16(VT + ((size_t)rc * 1024 + hh * 256 + (dvp * 2 + (p >> 1)) * 32 + r) * 32 + c * 8, (unsigned)__builtin_amdgcn_readfirstlane(sb + 16384 + p * 1024)); }
                    else glds16(ECL + ((size_t)(rc * 2 + dir) * 4 + hh) * 256 + lane * 4, (unsigned)__builtin_amdgcn_readfirstlane(sb + 20480)); }
            };
            auto wait_bar = [&](int ngrp) { if (wave < 2) { asm volatile("s_waitcnt lgkmcnt(0)\n\ts_barrier" ::: "memory"); }
                else if (ngrp == 0) { WAIT_BAR(0); } else if (ngrp == 1) { if (wave < 5) { WAIT_BAR(4); } else { WAIT_BAR(3); } } else { if (wave < 5) { WAIT_BAR(8); } else { WAIT_BAR(6); } } };
            f32x16 S4[4];
#pragma unroll
            for (int k = 0; k < 4; ++k)
#pragma unroll
                for (int r = 0; r < 16; ++r) S4[k][r] = 0.f;
            dma(0, 0); dma(1, 1); dma(2, 2);
            wait_bar(2);
            int slot = 0;
            for (int step = 0; step < 136; ++step) {
                if (step + 3 < 136) dma(step + 3, (slot + 3) & 3);
                if (wave < 2) {
                    const LAS unsigned char* sb = F.lds + slot * SLOT;
                    const int x15 = r32 & 15, x3 = (r32 >> 2) & 3;
                    const int trq = (lane & 15) >> 2, trp = lane & 3, trpp = ((trp & 1) << 1) | (trp >> 1), trg = (lane >> 4) & 1;
                    const LAS unsigned char* vbase = sb + 16384 + wave * 2048;
                    bf16x8 qdF[8], kiF[8];
#pragma unroll
                    for (int k = 0; k < 8; ++k) { qdF[k] = *(const LAS bf16x8*)(sb + 8192 + r32 * 256 + (((2 * k + hi) ^ x15) << 4)); kiF[k] = *(const LAS bf16x8*)(sb + r32 * 256 + (((2 * k + hi) ^ x15) << 4)); }
                    const bf16x8 vF0 = *(const LAS bf16x8*)(vbase + r32 * 64 + ((hi ^ x3) << 4)), vF1 = *(const LAS bf16x8*)(vbase + r32 * 64 + (((2 + hi) ^ x3) << 4));
                    __builtin_amdgcn_sched_barrier(0);
                    f32x16 o;
#pragma unroll
                    for (int r = 0; r < 16; ++r) o[r] = 0.f;
                    if (step >= 8) {
                        f32x16 sc;
#pragma unroll
                        for (int r = 0; r < 16; ++r) sc[r] = 0.f;
#pragma unroll
                        for (int k = 0; k < 8; ++k) sc = __builtin_amdgcn_mfma_f32_32x32x16_bf16(kiF[k], qdF[k], sc, 0, 0, 0);
#pragma unroll
                        for (int r = 0; r < 16; ++r) { const int s = (r & 3) + 8 * (r >> 2) + 4 * hi; const bool keep = dir ? (s >= r32) : (s <= r32); sc[r] = keep ? sc[r] : 0.f; }
                        u32x4 w; bf16x8 pf0, pf1;
                        w.x = cvtpk(sc[0], sc[1]); w.y = cvtpk(sc[2], sc[3]); w.z = cvtpk(sc[4], sc[5]); w.w = cvtpk(sc[6], sc[7]); pf0 = __builtin_bit_cast(bf16x8, w);
                        w.x = cvtpk(sc[8], sc[9]); w.y = cvtpk(sc[10], sc[11]); w.z = cvtpk(sc[12], sc[13]); w.w = cvtpk(sc[14], sc[15]); pf1 = __builtin_bit_cast(bf16x8, w);
                        o = __builtin_amdgcn_mfma_f32_32x32x16_bf16(vF0, pf0, o, 0, 0, 0);
                        o = __builtin_amdgcn_mfma_f32_32x32x16_bf16(vF1, pf1, o, 0, 0, 0);
#pragma unroll
                        for (int blk = 0; blk < 4; ++blk)
#pragma unroll
                            for (int s2 = 0; s2 < 2; ++s2) { u32x4 ws4; ws4.x = cvtpk(S4[blk][8 * s2], S4[blk][8 * s2 + 1]); ws4.y = cvtpk(S4[blk][8 * s2 + 2], S4[blk][8 * s2 + 3]);
                                ws4.z = cvtpk(S4[blk][8 * s2 + 4], S4[blk][8 * s2 + 5]); ws4.w = cvtpk(S4[blk][8 * s2 + 6], S4[blk][8 * s2 + 7]);
                                o = __builtin_amdgcn_mfma_f32_32x32x16_bf16(__builtin_bit_cast(bf16x8, ws4), qdF[2 * blk + s2], o, 0, 0, 0); }
                        const int rc = rcof(step);
                        bf16_t* op = Odp + (size_t)(rc * 32 + r32) * D + hh * 256 + dvb * 32 + 4 * hi;
#pragma unroll
                        for (int g = 0; g < 4; ++g) { u32x2 w2; w2.x = cvtpk(o[4 * g], o[4 * g + 1]); w2.y = cvtpk(o[4 * g + 2], o[4 * g + 3]); *(u32x2*)(op + 8 * g) = w2; }
                    }
#pragma unroll
                    for (int blk = 0; blk < 4; ++blk) {
                        bf16x8 kt0, kt1;
                        { const int chunk = 4 * blk + 2 * trg + (trpp >> 1); const int wb = (trpp & 1) * 8;
                          const int tl = 4 * hi + trq, th = tl + 8;
                          const LAS unsigned char* pl = sb + tl * 256 + ((chunk ^ tl) << 4) + wb; const LAS unsigned char* ph = sb + th * 256 + ((chunk ^ th) << 4) + wb;
                          const s16x4 a0 = vtr(pl), a1 = vtr(ph), b0 = vtr(pl + 4096), b1 = vtr(ph + 4096);
                          kt0 = (bf16x8){a0[0], a0[1], a0[2], a0[3], a1[0], a1[1], a1[2], a1[3]}; kt1 = (bf16x8){b0[0], b0[1], b0[2], b0[3], b1[0], b1[1], b1[2], b1[3]}; }
                        S4[blk] = __builtin_amdgcn_mfma_f32_32x32x16_bf16(kt0, vF0, S4[blk], 0, 0, 0);
                        S4[blk] = __builtin_amdgcn_mfma_f32_32x32x16_bf16(kt1, vF1, S4[blk], 0, 0, 0);
#pragma unroll
                        for (int g = 0; g < 4; ++g) { const f32x4 e4 = *(const LAS f32x4*)(sb + 20480 + (32 * blk + 8 * g + 4 * hi) * 4);
                            S4[blk][4 * g] *= e4[0]; S4[blk][4 * g + 1] *= e4[1]; S4[blk][4 * g + 2] *= e4[2]; S4[blk][4 * g + 3] *= e4[3]; }
                    }
                }
                wait_bar(step + 3 < 136 ? 2 : (step + 2 < 136 ? 1 : 0));
                slot = (slot + 1) & 3;
            }
        }
        if (!split) {
            LAS float* scr = (LAS float*)(F.lds + wave * 16640); int base = 0;
            for (int e = 0; e < NEXP; ++e) {
                conv64_run(Conv64{args.in[I_MWG] + (size_t)e * D * EXD, args.in[I_MWU] + (size_t)e * D * EXD, EXD, 1024, N_GU1, wsp<bf16_t>(F, O_WGU1) + (size_t)e * N_GU1 * 1024 / 2, 3, 0, 0, 64.0f, 1}, scr, lane, gw, NGW, base);
                conv64_run(Conv64{args.in[I_MWD] + (size_t)e * EXD * D, nullptr, 1024, EXD, 1024, wsp<bf16_t>(F, O_WD1) + (size_t)e * 1024 * EXD / 2, 0, 1024, 1024, 64.0f, 1}, scr, lane, gw, NGW, base);
            }
        }
        }
    }
    SEAM(15);

    if (IN(16)) {
        const bf16_t* OFp = wsp<bf16_t>(F, O_OF); const bf16_t* OBp = wsp<bf16_t>(F, O_OB); const bf16_t* G1 = wsp<bf16_t>(F, O_G1); bf16_t* GA = wsp<bf16_t>(F, O_GA);
        const float* on = args.in[I_GONORM];
        for (int row = gw; row < RL; row += NGW) {
            const u32x4* pf = (const u32x4*)(OFp + (size_t)row * D + lane * 16); const u32x4* pb = (const u32x4*)(OBp + (size_t)row * D + lane * 16); const u32x4* pg = (const u32x4*)(G1 + (size_t)row * D + lane * 16);
            float v[16], gv[16];
#pragma unroll
            for (int q = 0; q < 2; ++q) { const u32x4 a = pf[q], bq = pb[q], gq = pg[q]; const unsigned aw[4] = {a.x, a.y, a.z, a.w}, bw[4] = {bq.x, bq.y, bq.z, bq.w}, gw4[4] = {gq.x, gq.y, gq.z, gq.w};
#pragma unroll
                for (int j = 0; j < 4; ++j) { v[8 * q + 2 * j] = bflo(aw[j]) + bflo(bw[j]); v[8 * q + 2 * j + 1] = bfhi(aw[j]) + bfhi(bw[j]); gv[8 * q + 2 * j] = bflo(gw4[j]); gv[8 * q + 2 * j + 1] = bfhi(gw4[j]); } }
            float ss = 0.f;
#pragma unroll
            for (int j = 0; j < 16; ++j) ss += v[j] * v[j];
            ss += __shfl_xor(ss, 1); ss += __shfl_xor(ss, 2); ss += __shfl_xor(ss, 4); ss += __shfl_xor(ss, 8);
            const float rstd = __builtin_amdgcn_rsqf(ss * (1.0f / 256.0f) + EPS);
            const int c0 = (lane & 15) * 16;
            unsigned ow[8];
#pragma unroll
            for (int j = 0; j < 8; ++j) { const float a = v[2 * j] * rstd * on[c0 + 2 * j] * silu_f(gv[2 * j]), bq = v[2 * j + 1] * rstd * on[c0 + 2 * j + 1] * silu_f(gv[2 * j + 1]); ow[j] = cvtpk(a, bq); }
            u32x4* po = (u32x4*)(GA + (size_t)row * D + lane * 16);
            u32x4 o0; o0.x = ow[0]; o0.y = ow[1]; o0.z = ow[2]; o0.w = ow[3]; po[0] = o0; u32x4 o1; o1.x = ow[4]; o1.y = ow[5]; o1.z = ow[6]; o1.w = ow[7]; po[1] = o1;
        }
    }
    SEAM(16);

    if (IN(17)) {
        pg8::DenseProb P{wsp<bf16_t>(F, O_GA), wsp<bf16_t>(F, O_WOUT1), 1024, 1024, 1024, {}}; P.ord.init(RL / 256, 4, F.G, (int)blockIdx.x);
        pg8::EpiBf16 E{(bf16_t*)Y, D, nullptr};
        pg8::gemm_phase(F.lds, P, E);
    }
    SEAM(17);

    if (IN(18)) {
        int* SEL = wsp<int>(F, O_SEL); int* ROWTOK = wsp<int>(F, O_ROWTOK);
        LAS float* wr_l = (LAS float*)F.lds;
        LAS int* se = (LAS int*)(F.lds + 32768);
        LAS float* sw = (LAS float*)(F.lds + 32768 + 512);
        LAS int* sbase = (LAS int*)(F.lds + 32768 + 1024);
        for (int i = tid; i < 8192; i += 512) wr_l[i] = args.in[I_MROUTER][i];
        __syncthreads();
        for (int tile = F.vcu; tile < RL / 64; tile += F.G) {
            for (int rr = 0; rr < 8; ++rr) {
                const int lr = wave * 8 + rr, row = tile * 64 + lr; const int b = row >> 12;
                float* hp = args.out + (size_t)row * D;
                f32x4 y[4], h[4], uo[4]; load_row_bf16((const bf16_t*)Y + (size_t)row * D, lane, y); load_row(hp, lane, h);
                const float rstd = __builtin_amdgcn_rsqf(row_ssq(y) * (1.0f / D) + EPS);
#pragma unroll
                for (int j = 0; j < 4; ++j) { const int c = 4 * lane + 256 * j; const f32x4 g = *(const f32x4*)(normg + 5 * D + c), mg = *(const f32x4*)(MV(1, b, 2) + c);
                    h[j] = h[j] + mg * (y[j] * rstd * g); *(f32x4*)(hp + c) = h[j]; }
                norm_mod_store(h, normg + 6 * D, MV(1, b, 3), MV(1, b, 4), nullptr, lane, uo, wsp<unsigned char>(F, O_U) + (size_t)row * D);
                float lg[8];
#pragma unroll
                for (int e = 0; e < 8; ++e) lg[e] = 0.f;
#pragma unroll
                for (int j = 0; j < 4; ++j)
#pragma unroll
                    for (int q = 0; q < 4; ++q) { const int k = 4 * lane + 256 * j + q; const LAS f32x4* wp = (const LAS f32x4*)(wr_l + k * 8); const f32x4 w0 = wp[0], w1 = wp[1]; const float uv = uo[j][q];
                        lg[0] += uv * w0[0]; lg[1] += uv * w0[1]; lg[2] += uv * w0[2]; lg[3] += uv * w0[3]; lg[4] += uv * w1[0]; lg[5] += uv * w1[1]; lg[6] += uv * w1[2]; lg[7] += uv * w1[3]; }
#pragma unroll
                for (int e = 0; e < 8; ++e) lg[e] = wave_sum(lg[e]) + args.in[I_MBROUTER][e];
                int e0 = 0; float l0 = lg[0];
#pragma unroll
                for (int e = 1; e < 8; ++e) if (lg[e] > l0) { l0 = lg[e]; e0 = e; }
                int e1 = -1; float l1 = -3.0e38f;
#pragma unroll
                for (int e = 0; e < 8; ++e) if (e != e0 && lg[e] > l1) { l1 = lg[e]; e1 = e; }
                const float p1 = __expf(l1 - l0), w0n = 1.0f / (1.0f + p1), w1n = p1 / (1.0f + p1);
                if (lane == 0) { se[lr * 2] = e0; se[lr * 2 + 1] = e1; sw[lr * 2] = w0n; sw[lr * 2 + 1] = w1n; }
            }
            __syncthreads();
            if (tid < 8) { int c = 0; for (int r2 = 0; r2 < 64; ++r2) c += (se[2 * r2] == tid) + (se[2 * r2 + 1] == tid);
                sbase[tid] = (int)__hip_atomic_fetch_add(ctl + CW_CNT + 64 * tid, (unsigned)c, RLX_AGENT); }
            __syncthreads();
            if (tid < 64) { const int e0 = se[2 * tid], e1 = se[2 * tid + 1]; int r0 = 0, r1 = 0;
                for (int r2 = 0; r2 < tid; ++r2) { const int a0 = se[2 * r2], a1 = se[2 * r2 + 1]; r0 += (a0 == e0) + (a1 == e0); r1 += (a0 == e1) + (a1 == e1); }
                const int p0 = sbase[e0] + r0, p1 = sbase[e1] + r1, tok = tile * 64 + tid;
                ROWTOK[e0 * CAPE + p0] = tok; ROWTOK[e1 * CAPE + p1] = tok;
                int* sp = SEL + (size_t)tok * 8; sp[0] = e0; sp[1] = p0; sp[2] = e1; sp[3] = p1; sp[4] = __float_as_int(sw[2 * tid]); sp[5] = __float_as_int(sw[2 * tid + 1]); }
            __syncthreads();
        }
    }
    SEAM(18);

    pg8::MoeTiles MT;
    if (IN(19) || IN(20) || IN(21)) {
        int acc = 0; MT.tp8 = 0ull; MT.c4a = 0ull; MT.c4b = 0ull;
#pragma unroll
        for (int e = 0; e < 8; ++e) { const int c = (int)__builtin_amdgcn_readfirstlane((int)__hip_atomic_load(ctl + CW_CNT + 64 * e, RLX_AGENT));
            if (e < 4) MT.c4a |= (unsigned long long)(unsigned)c << (16 * e); else MT.c4b |= (unsigned long long)(unsigned)c << (16 * (e - 4));
            MT.tp8 |= (unsigned long long)(unsigned)acc << (8 * e); acc += (c + 255) >> 8; }
        MT.nt = acc;
    }
    if (IN(19)) {
        pg8::MoeGuProb P{wsp<unsigned char>(F, O_U), wsp<unsigned char>(F, O_WGU1), 512, 512, {}, MT, wsp<int>(F, O_ROWTOK)}; P.ord.init(MT.nt, N_GU1 / 256, F.G, (int)blockIdx.x);
        pg8::EpiSwiglu8 E{wsp<unsigned char>(F, O_HM), EXD};
        pg8::gemm_phase(F.lds, P, E);
    }
    SEAM(19);
    if (IN(20)) {
        pg8::MoeDnProb P{wsp<unsigned char>(F, O_HM), wsp<unsigned char>(F, O_WD1), EXD / 2, EXD / 2, {}, MT}; P.ord.init(MT.nt, 4, F.G, (int)blockIdx.x);
        pg8::EpiBf16 E{wsp<bf16_t>(F, O_YE), D, nullptr};
        pg8::gemm_phase(F.lds, P, E);
    }
    SEAM(20);
    if (IN(21)) {
        const int* SEL = wsp<int>(F, O_SEL); const bf16_t* YE = wsp<bf16_t>(F, O_YE);
        for (int row = gw; row < RL; row += NGW) {
            const int b = row >> 12; const int* sp = SEL + (size_t)row * 8;
            const int e0 = sp[0], p0 = sp[1], e1 = sp[2], p1 = sp[3]; const float w0 = __int_as_float(sp[4]), w1 = __int_as_float(sp[5]);
            const int t0 = pg8::moe_tp(MT, e0), t1 = pg8::moe_tp(MT, e1);
            const bf16_t* y0 = YE + ((size_t)t0 * 256 + p0) * D; const bf16_t* y1 = YE + ((size_t)t1 * 256 + p1) * D;
            float* hp = args.out + (size_t)row * D;
            f32x4 y[4], h[4]; load_row(hp, lane, h);
#pragma unroll
            for (int j = 0; j < 4; ++j) { const int c = 4 * lane + 256 * j; const u32x2 a = *(const u32x2*)(y0 + c), bq = *(const u32x2*)(y1 + c);
                y[j][0] = w0 * bflo(a.x) + w1 * bflo(bq.x); y[j][1] = w0 * bfhi(a.x) + w1 * bfhi(bq.x); y[j][2] = w0 * bflo(a.y) + w1 * bflo(bq.y); y[j][3] = w0 * bfhi(a.y) + w1 * bfhi(bq.y); }
            const float rstd = __builtin_amdgcn_rsqf(row_ssq(y) * (1.0f / D) + EPS);
#pragma unroll
            for (int j = 0; j < 4; ++j) { const int c = 4 * lane + 256 * j; const f32x4 g = *(const f32x4*)(normg + 7 * D + c), mg = *(const f32x4*)(MV(1, b, 5) + c);
                *(f32x4*)(hp + c) = h[j] + mg * (y[j] * rstd * g); }
        }
    }
#undef IN
#undef SEAM
#undef MV
}

constexpr int N_PHASES = 22;
extern "C" void kernel_launch(void* const* d_in, const int* in_sizes, int n_in, void* d_out, int out_size, void* d_ws, size_t ws_size, hipStream_t stream) {
    static int grid = 0;
    if (grid == 0) {
        if (n_in != 27 || out_size != RL * D || ws_size < WS_END) { fprintf(stderr, "kernel_launch: unexpected shapes n_in %d out %d ws %zu (need %zu)\n", n_in, out_size, ws_size, (size_t)WS_END); grid = -1; return; }
        int dev = 0, cus = 0, per_cu = 0;
        if (hipGetDevice(&dev) != hipSuccess || hipDeviceGetAttribute(&cus, hipDeviceAttributeMultiprocessorCount, dev) != hipSuccess) { grid = -1; return; }
        if (hipFuncSetAttribute((const void*)mk_fwd, hipFuncAttributeMaxDynamicSharedMemorySize, LDS_BYTES) != hipSuccess) { fprintf(stderr, "kernel_launch: hipFuncSetAttribute failed\n"); grid = -1; return; }
        if (hipOccupancyMaxActiveBlocksPerMultiprocessor(&per_cu, (const void*)mk_fwd, 512, LDS_BYTES) != hipSuccess || per_cu < 1) { fprintf(stderr, "kernel_launch: occupancy query says %d\n", per_cu); }
        (void)hipGetLastError();
        grid = cus;
        if (grid > 256) grid = 256;
    }
    if (grid < 0) return;
    (void)hipMemsetAsync((char*)d_ws + O_CTL, 0, CTL_BYTES, stream);
    Args a{};
    for (int i = 0; i < 27; ++i) a.in[i] = (const float*)d_in[i];
    a.out = (float*)d_out; a.ws = (unsigned char*)d_ws;
#if MK_ONE_LAUNCH
    a.ph_lo = 0; a.ph_hi = N_PHASES;
    hipLaunchKernelGGL(mk_fwd, dim3(grid), dim3(512), LDS_BYTES, stream, a);
#else
    for (int p = 0; p < N_PHASES; ++p) { a.ph_lo = p; a.ph_hi = p + 1; for (int rep = 0; rep < (p == MK_REP ? 2 : 1); ++rep) hipLaunchKernelGGL(mk_fwd, dim3(grid), dim3(512), LDS_BYTES, stream, a); }
#endif
}
```

```cpp
#include <hip/hip_runtime.h>
#include <cstdio>
#include <cstdint>

#ifndef MK_ONE_LAUNCH
#define MK_ONE_LAUNCH 1
#endif
#ifndef MK_EPI2
#define MK_EPI2 0
#endif
#ifndef MK_REP
#define MK_REP -1
#endif

#define LAS __attribute__((address_space(3)))
#define GAS __attribute__((address_space(1)))
typedef unsigned short bf16_t;
typedef short bf16x8 __attribute__((ext_vector_type(8)));
typedef short s16x4 __attribute__((ext_vector_type(4)));
typedef float f32x4 __attribute__((ext_vector_type(4)));
typedef float f32x16 __attribute__((ext_vector_type(16)));
typedef unsigned u32x4 __attribute__((ext_vector_type(4)));
typedef unsigned u32x2 __attribute__((ext_vector_type(2)));
typedef float f32x2_t __attribute__((ext_vector_type(2)));
typedef __bf16 bf16x2_t __attribute__((ext_vector_type(2)));
#define RLX_AGENT __ATOMIC_RELAXED, __HIP_MEMORY_SCOPE_AGENT

__device__ __forceinline__ unsigned cvtpk(float lo, float hi) { f32x2_t v = {lo, hi}; bf16x2_t b = __builtin_convertvector(v, bf16x2_t); return __builtin_bit_cast(unsigned, b); }
__device__ __forceinline__ bf16_t f2bf(float f) { return (bf16_t)(cvtpk(f, 0.f) & 0xffffu); }
__device__ __forceinline__ float bflo(unsigned w) { return __uint_as_float(w << 16); }
__device__ __forceinline__ float bfhi(unsigned w) { return __uint_as_float(w & 0xffff0000u); }
__device__ __forceinline__ float bf2f(bf16_t b) { return __uint_as_float(((unsigned)b) << 16); }
__device__ __forceinline__ float wave_sum(float v) {
#pragma unroll
    for (int o = 1; o < 64; o <<= 1) v += __shfl_xor(v, o);
    return v;
}
__device__ __forceinline__ float fast_exp(float x) { return __builtin_amdgcn_exp2f(x * 1.4426950408889634f); }
__device__ __forceinline__ float clamp8(float x) { return __builtin_amdgcn_fmed3f(x, -448.0f, 448.0f); }
__device__ __forceinline__ unsigned pack_fp8x4(float a, float b, float c, float d) { int w = __builtin_amdgcn_cvt_pk_fp8_f32(clamp8(a), clamp8(b), 0, false); w = __builtin_amdgcn_cvt_pk_fp8_f32(clamp8(c), clamp8(d), w, true); return (unsigned)w; }
__device__ __forceinline__ float swiglu_f(float gp, float up, float k) { return (gp * up) * __builtin_amdgcn_rcpf(__builtin_fmaf(__builtin_amdgcn_exp2f(gp), k, k)); }
__device__ __forceinline__ float silu_f(float g) { return g * __builtin_amdgcn_rcpf(1.0f + fast_exp(-g)); }

#define XB_TMO      128
#define XB_XCNT(j)  (256  + 64 * (j))
#define XB_XSUB(j)  (1280 + 64 * (j))
#define XB_XGEN(j)  (2304 + 64 * (j))
#define XB_TOP      3328
#define XB_TOPGEN   3392
#define XCD_BAR_WORDS 3456
#define XB_SPIN_CAP (1u << 18)
__device__ __forceinline__ unsigned xb_ld(unsigned* p)              { return __hip_atomic_load(p, __ATOMIC_RELAXED, __HIP_MEMORY_SCOPE_AGENT); }
__device__ __forceinline__ unsigned xb_add(unsigned* p, unsigned v) { return __hip_atomic_fetch_add(p, v, __ATOMIC_RELAXED, __HIP_MEMORY_SCOPE_AGENT); }
__device__ __forceinline__ unsigned xb_xcc_id() { return (unsigned)__builtin_amdgcn_s_getreg((3 << 11) | 20) & 0xFu; }
#define XB_SPIN(cond, bar) do { unsigned _sp = 0; while (cond) { __builtin_amdgcn_s_sleep(1); \
    if ((++_sp & 255u) == 0u) { if (xb_ld(&(bar)[XB_TMO])) break; if (_sp > XB_SPIN_CAP) { atomicAdd(&(bar)[XB_TMO], 1u); break; } } } } while (0)
struct XcdBarrier { unsigned* bar; unsigned x; volatile LAS unsigned* st; };
__device__ __forceinline__ XcdBarrier xcd_barrier_post(unsigned* bar, volatile LAS unsigned* st) {
    XcdBarrier b; b.bar = bar; b.x = xb_xcc_id(); b.st = st;
    if (threadIdx.x == 0) (void)xb_add(&bar[XB_XCNT(b.x)], 1u);
    return b;
}
__device__ __forceinline__ void xcd_barrier_complete(unsigned* bar, unsigned x, unsigned& nloc, unsigned& nx) {
    const unsigned G = gridDim.x * gridDim.y * gridDim.z;
    unsigned sum, cnt, mine, sp = 0u;
    for (;;) {
        sum = 0u; cnt = 0u; mine = 0u;
#pragma unroll
        for (unsigned j = 0; j < 16; ++j) { const unsigned c = xb_ld(&bar[XB_XCNT(j)]); sum += c; cnt += (c > 0u) ? 1u : 0u; mine = (j == x) ? c : mine; }
        if (sum == G) break;
        __builtin_amdgcn_s_sleep(1);
        if ((++sp & 255u) == 0u) { if (xb_ld(&bar[XB_TMO])) break; if (sp > XB_SPIN_CAP) { atomicAdd(&bar[XB_TMO], 1u); break; } }
    }
    nloc = mine > 0u ? mine : 1u; nx = cnt > 0u ? cnt : 1u;
}
__device__ __forceinline__ void xcd_barrier(const XcdBarrier& b) {
    asm volatile("s_waitcnt vmcnt(0)" ::: "memory");
    __syncthreads();
    if (threadIdx.x == 0) {
        unsigned* bar = b.bar;
        __builtin_amdgcn_s_waitcnt(0);
        unsigned nloc = b.st[0], nx = b.st[1];
        if (nloc == 0u) { xcd_barrier_complete(bar, b.x, nloc, nx); b.st[0] = nloc; b.st[1] = nx; }
        const unsigned old = xb_add(&bar[XB_XSUB(b.x)], 1u);
        const unsigned gen = old / nloc;
        if (old + 1u == (gen + 1u) * nloc) {
            __builtin_amdgcn_fence(__ATOMIC_RELEASE, "agent");
            asm volatile("s_waitcnt vmcnt(0)" ::: "memory");
            const unsigned og = xb_add(&bar[XB_TOP], 1u);
            const unsigned tg = og / nx;
            if (og + 1u == (tg + 1u) * nx) xb_add(&bar[XB_TOPGEN], 1u);
            else XB_SPIN(xb_ld(&bar[XB_TOPGEN]) == tg, bar);
            __builtin_amdgcn_fence(__ATOMIC_ACQUIRE, "agent");
            xb_add(&bar[XB_XGEN(b.x)], 1u);
            asm volatile("s_waitcnt vmcnt(0)" ::: "memory");
        } else {
            XB_SPIN(xb_ld(&bar[XB_XGEN(b.x)]) == gen, bar);
            __builtin_amdgcn_fence(__ATOMIC_ACQUIRE, "agent");
            asm volatile("s_waitcnt vmcnt(0)" ::: "memory");
        }
    }
    __syncthreads();
}

constexpr int D = 1024, NB = 4, SEQ = 4096, CTX = 256;
constexpr int RL = NB * SEQ;
constexpr int RC = NB * CTX;
constexpr int R = RL + RC;
constexpr float EPS = 1e-6f;
constexpr float LOG2E = 1.4426950408889634f;
constexpr int N_IN0 = 1536, N_QA = 768, N_KVA = 1024, FFN = 2816, N_GU0 = 2 * FFN, N_IN1 = 3328, EXD = 3584, N_GU1 = 2 * EXD, NEXP = 8;
constexpr int CAPE = 16384;

constexpr size_t MiB = 1u << 20;
constexpr size_t O_CTL = 0;
constexpr size_t CTL_BYTES = 65536;
constexpr int CW_BAR = 0;
constexpr int CW_CNT = 8192;
constexpr size_t O_MODV = 1 * MiB;
constexpr size_t O_TAB16 = O_MODV + 256 * 1024;
constexpr size_t O_TAB32 = O_TAB16 + 8192;
constexpr size_t O_RSTDQ = O_TAB32 + 16384;
constexpr size_t O_RSTDKV = O_RSTDQ + 81920;
constexpr size_t O_SEL = 2 * MiB;
constexpr size_t O_ROWTOK = 3 * MiB;
constexpr size_t O_WGU1 = 4 * MiB;
constexpr size_t O_YE = O_WGU1;
constexpr size_t O_WD1 = 116 * MiB;
constexpr size_t O_WIN1 = 172 * MiB;
constexpr size_t O_WOUT1 = 179 * MiB;
constexpr size_t O_WIN0 = 181 * MiB;
constexpr size_t O_WUQ = 184 * MiB;
constexpr size_t O_WUKV = 185 * MiB;
constexpr size_t O_WOUT0 = 186 * MiB;
constexpr size_t O_WGU0 = 188 * MiB;
constexpr size_t O_WD0 = 199 * MiB;
constexpr size_t O_HC = 205 * MiB;
constexpr size_t O_U = 209 * MiB;
constexpr size_t O_Y = 243 * MiB;
constexpr size_t O_Z0 = 311 * MiB;
constexpr size_t O_QA = 362 * MiB;
constexpr size_t O_KVA = 388 * MiB;
constexpr size_t O_QB = 422 * MiB;
constexpr size_t O_KB = 439 * MiB;
constexpr size_t O_KR = 444 * MiB;
constexpr size_t O_AO = 446 * MiB;
constexpr size_t O_H0 = 311 * MiB;
constexpr size_t O_QK1 = 311 * MiB;
constexpr size_t O_V1 = 345 * MiB;
constexpr size_t O_G1 = 379 * MiB;
constexpr size_t O_RR = 413 * MiB;
constexpr size_t O_QDF = 422 * MiB, O_KIF = 439 * MiB, O_KTF = 456 * MiB, O_QDB = 473 * MiB;
constexpr size_t O_KIB = 243 * MiB, O_KTB = 260 * MiB, O_VT = 277 * MiB;
constexpr size_t O_ECL = 490 * MiB;
constexpr size_t O_OF = O_QK1, O_OB = O_V1;
constexpr size_t O_GA = O_QDF;
constexpr size_t O_HM = 243 * MiB;
constexpr size_t WS_END = 495 * MiB;
static_assert(O_HM + (size_t)34816 * EXD * 2 <= 482 * MiB, "HM");
static_assert(O_RR + (size_t)R * 256 * 2 <= O_QDF, "RR");
static_assert(O_ECL + (size_t)544 * 8 * 1024 <= WS_END, "ECL");

constexpr int RING_BYTES = 131072;
constexpr int LDS_BYTES = 163840;
constexpr int LDSCTL_OFF = LDS_BYTES - 256;

struct Args {
    const float* in[27];
    float* out; unsigned char* ws;
    int ph_lo, ph_hi;
};
enum { I_X = 0, I_C, I_CTX, I_CCTX, I_MODW, I_MODB, I_NORMG, I_AWIN, I_AQN, I_AWUQ, I_AKVN, I_AWUKV, I_AQKN, I_AWOUT, I_GWIN, I_GGATE2, I_GBGATE, I_GONORM, I_GWOUT,
       I_FWG, I_FWU, I_FWD, I_MROUTER, I_MBROUTER, I_MWG, I_MWU, I_MWD };

struct Conv { const float* s0; const float* s1; int Nsrc; int K; int Ndst; bf16_t* dst; int mode; const float* kscale; };
__device__ __forceinline__ int ilv64(int p) { return (p >> 5) * 32 + (p & 1) * 16 + ((p & 31) >> 1); }
__device__ __forceinline__ int ilv32(int p) { return (p >> 4) * 16 + (p & 1) * 8 + ((p & 15) >> 1); }
__device__ __forceinline__ const float* conv_col(const Conv& c, int n, float& sc) {
    sc = 1.0f;
    switch (c.mode) {
    case 0: return c.s0 + n;
    case 1: {
        if (n < 640) return c.s0 + n;
        if (n < 1152) { const int hh = (n - 640) >> 6, p = (n - 640) & 63; return c.s0 + 672 + hh * 64 + ilv64(p); }
        if (n < 1280) { const int hh = (n - 1152) >> 6, p = (n - 1152) & 63; return c.s0 + 1184 + hh * 64 + ilv64(p); }
        if (n < 1408) return c.s0 + 1312 + (n - 1280);
        if (n < 1440) return c.s0 + 640 + ilv32(n - 1408);
        return nullptr; }
    case 2: {
        if (n < 512) return c.s0 + (n >> 6) * 96 + (n & 63);
        const int hh = (n - 512) >> 5, p = (n - 512) & 31; return c.s0 + hh * 96 + 64 + ilv32(p); }
    case 3: {
        const int G = n >> 5, j = n & 31; return (j < 16) ? c.s0 + 16 * G + j : c.s1 + 16 * G + (j - 16); }
    case 4: {
        if (n >= 3104) return nullptr;
        if (n < 512) sc = 0.08838834764831845f;
        return c.s0 + n; }
    }
    return nullptr;
}
__device__ __forceinline__ void conv_item(const Conv& c, int item, LAS float* scr, int lane) {
    const int nblk = c.Ndst / 32, kb = item / nblk, nb = item % nblk, k0 = 64 * kb, n0 = 32 * nb;
    float sc; const float* cp = conv_col(c, n0 + (lane & 31), sc);
    const int kh = lane >> 5;
#pragma unroll 16
    for (int i = 0; i < 32; ++i) { const int kk = 2 * i + kh; float v = 0.f;
        if (cp) { v = cp[(size_t)(k0 + kk) * c.Nsrc] * sc; if (c.kscale) v *= c.kscale[k0 + kk]; }
        scr[kk * 33 + (lane & 31)] = v; }
    asm volatile("s_waitcnt lgkmcnt(0)" ::: "memory");
    const int ch = lane & 7;
#pragma unroll
    for (int j = 0; j < 4; ++j) { const int n = (lane >> 3) + 8 * j; const LAS float* s = scr + (8 * ch) * 33 + n;
        u32x4 o; o.x = cvtpk(s[0 * 33], s[1 * 33]); o.y = cvtpk(s[2 * 33], s[3 * 33]); o.z = cvtpk(s[4 * 33], s[5 * 33]); o.w = cvtpk(s[6 * 33], s[7 * 33]);
        *(u32x4*)(c.dst + (size_t)(n0 + n) * c.K + k0 + 8 * ch) = o; }
    asm volatile("s_waitcnt lgkmcnt(0)" ::: "memory");
}

struct Conv64 { const float* s0; const float* s1; int Nsrc; int K; int Ndst; bf16_t* dst; int mode; int nvalid; int nscaled; float rscale; int f8; };
struct Conv64Geo { int k0, n0, nd; bool valid; float sc; const float* src; };
__device__ __forceinline__ Conv64Geo conv64_geo(const Conv64& c, int item, int lane) {
    Conv64Geo g; const int nblk = c.Ndst / 64, kb = item / nblk, nb = item % nblk; g.k0 = 64 * kb; g.n0 = 64 * nb;
    const int c4 = lane & 15, kr = lane >> 4; g.valid = true; g.sc = 1.0f;
    if (c.mode == 3) { const int cc = 4 * (c4 & 7); g.src = c.s0 + ((c4 < 8) ? (long)0 : (long)(c.s1 - c.s0)) + 32 * nb + cc; g.nd = 32 * (cc >> 4) + ((c4 < 8) ? 0 : 16) + (cc & 15); g.sc = c.rscale * ((c4 < 8) ? -1.4426950408889634f : 1.0f); }
    else { g.nd = 4 * c4; g.src = c.s0 + g.n0 + g.nd; g.valid = (g.n0 + g.nd) < c.nvalid; if (g.n0 + g.nd < c.nscaled) g.sc = c.rscale; }
    g.src += (size_t)(g.k0 + kr) * c.Nsrc;
    return g;
}
__device__ __forceinline__ void conv64_load(const Conv64& c, int item, int lane, f32x4 (&v)[16]) {
    const Conv64Geo g = conv64_geo(c, item, lane);
#pragma unroll
    for (int i = 0; i < 16; ++i) v[i] = g.valid ? *(const f32x4*)(g.src + (size_t)(4 * i) * c.Nsrc) : (f32x4){0.f, 0.f, 0.f, 0.f};
}
__device__ __forceinline__ void conv64_store(const Conv64& c, int item, LAS float* scr, int lane, const f32x4 (&v)[16]) {
    const Conv64Geo g = conv64_geo(c, item, lane); const int kr = lane >> 4, nd = g.nd, k0 = g.k0, n0 = g.n0; const float sc = g.sc;
#pragma unroll
    for (int i = 0; i < 16; ++i) { LAS float* p = scr + (4 * i + kr) * 65 + nd; p[0] = v[i][0] * sc; p[1] = v[i][1] * sc; p[2] = v[i][2] * sc; p[3] = v[i][3] * sc; }
    asm volatile("s_waitcnt lgkmcnt(0)" ::: "memory");
    if (c.f8) {
        const int ch = lane & 3; unsigned char* d8 = (unsigned char*)c.dst;
#pragma unroll
        for (int it = 0; it < 4; ++it) { const int r = it * 16 + (lane >> 2); const LAS float* sp = scr + (16 * ch) * 65 + r; u32x4 o;
            o.x = pack_fp8x4(sp[0 * 65], sp[1 * 65], sp[2 * 65], sp[3 * 65]); o.y = pack_fp8x4(sp[4 * 65], sp[5 * 65], sp[6 * 65], sp[7 * 65]);
            o.z = pack_fp8x4(sp[8 * 65], sp[9 * 65], sp[10 * 65], sp[11 * 65]); o.w = pack_fp8x4(sp[12 * 65], sp[13 * 65], sp[14 * 65], sp[15 * 65]);
            *(u32x4*)(d8 + (size_t)(n0 + r) * c.K + k0 + 16 * ch) = o; }
    } else {
    const int ch = lane & 7;
#pragma unroll
    for (int it = 0; it < 8; ++it) { const int r = it * 8 + (lane >> 3); const LAS float* sp = scr + (8 * ch) * 65 + r;
        u32x4 o; o.x = cvtpk(sp[0 * 65], sp[1 * 65]); o.y = cvtpk(sp[2 * 65], sp[3 * 65]); o.z = cvtpk(sp[4 * 65], sp[5 * 65]); o.w = cvtpk(sp[6 * 65], sp[7 * 65]);
        *(u32x4*)(c.dst + (size_t)(n0 + r) * c.K + k0 + 8 * ch) = o; }
    }
    asm volatile("s_waitcnt lgkmcnt(0)" ::: "memory");
}

__device__ __forceinline__ void conv64_run(const Conv64& c, LAS float* scr, int lane, int gwi, int ngw, int& base) {
    const int n = (c.K / 64) * (c.Ndst / 64); int it = gwi - base; if (it < 0) it += ngw;
    if (it < n) { f32x4 va[16], vb[16]; conv64_load(c, it, lane, va);
        for (;;) { const int i2 = it + ngw; if (i2 < n) conv64_load(c, i2, lane, vb); conv64_store(c, it, scr, lane, va); if (i2 >= n) break;
                   const int i3 = i2 + ngw; if (i3 < n) conv64_load(c, i3, lane, va); conv64_store(c, i2, scr, lane, vb); if (i3 >= n) break; it = i3; } }
    base = (base + n) % ngw;
}

namespace pg8 {
constexpr int BM = 256, BK = 64, HALF = 128, HTB = HALF * BK * 2, STAGE_BYTES = 8 * HTB;
constexpr int NXCD = 8, WGM = 8;
__device__ __forceinline__ int lds_byte(int r, int c) { const int st = (r >> 4) * 2 + (c >> 5), rr = r & 15, cc = c & 31, ob = rr * 64 + cc * 2; return st * 1024 + (ob ^ (((ob >> 9) & 1) << 5)); }
__device__ __forceinline__ void stage_rc(int b, int& Rr, int& C) { const int st = b / 1024, sb = b % 1024, swz = sb ^ (((sb >> 9) & 1) << 5); Rr = (st >> 1) * 16 + swz / 64; C = (st & 1) * 32 + (swz % 64) / 2; }
__device__ __forceinline__ int perm32(int rho) { const int n = rho >> 4, i = rho & 15; return 8 * (i >> 2) + 4 * n + (i & 3); }
struct Unit { int pm, pn; };
typedef int v8i_t __attribute__((ext_vector_type(8)));
typedef int v4i_t __attribute__((ext_vector_type(4)));
__device__ __forceinline__ v8i_t cat8(bf16x8 a, bf16x8 b) { const v4i_t x = __builtin_bit_cast(v4i_t, a), y = __builtin_bit_cast(v4i_t, b); return __builtin_shufflevector(x, y, 0, 1, 2, 3, 4, 5, 6, 7); }
struct Order {
    int nM, nN, nwg, G, c;
    __device__ __forceinline__ void init(int nM_, int nN_, int G_, int c_) { nM = nM_; nN = nN_; nwg = nM * nN; G = G_; c = c_; }
    __device__ __forceinline__ bool next(int i, Unit& u) const {
        const long L = (long)i * G + c; if (L >= nwg) return false;
        int wgid = (int)L; { const int q = nwg / NXCD, r = nwg % NXCD, xcd = wgid % NXCD, off = wgid / NXCD; wgid = (xcd < r ? xcd * (q + 1) : r * (q + 1) + (xcd - r) * q) + off; }
        const int nig = WGM * nN, gid = wgid / nig, fm = gid * WGM, gsz = (nM - fm) < WGM ? (nM - fm) : WGM;
        u.pm = fm + ((wgid % nig) % gsz); u.pn = (wgid % nig) / gsz; return true;
    }
};

template <class Prob, class Epi>
__device__ __forceinline__ void gemm_phase(LAS unsigned char* lds, const Prob& P, const Epi& E) {
    const int tid = threadIdx.x, wid = __builtin_amdgcn_readfirstlane(tid >> 6), lane = tid & 63, wr = wid >> 2, wc = wid & 3, fr = lane & 15, fq = lane >> 4;
    const int K = P.K, nt = K / BK, ldb = P.ldb;
    int RA[2], CA[2]; unsigned voffB[2];
#pragma unroll
    for (int i = 0; i < 2; ++i) { int Rr, C; stage_rc(tid * 16 + i * 8192, Rr, C); const int Rb = Epi::PERM ? ((Rr & ~31) + perm32(Rr & 31)) : Rr;
        RA[i] = Rr; CA[i] = C; voffB[i] = (unsigned)(Rb * ldb + C) * 2u; }
    const size_t hstepB = (size_t)HALF * ldb * 2;
    const unsigned ldsw = (unsigned)wid * 1024u;
    const int aoff = lds_byte(wr * 64 + fr, fq * 8), boff = lds_byte(wc * 32 + fr, fq * 8);
    const char* Abase = (const char*)P.Abase;
    const int scl_a = P.sa * 0x01010101, scl_b = P.sb * 0x01010101;
#define PG8_SA(b, h) (((b) * 2 + (h)) * HTB)
#define PG8_SB(b, h) ((4 + (b) * 2 + (h)) * HTB)
#define PG8_STAGEB(bufoff, gbase) do { _Pragma("unroll") for (int _i = 0; _i < 2; ++_i) \
        __builtin_amdgcn_global_load_lds((const unsigned*)((const char*)(gbase) + voffB[_i]), (LAS unsigned*)(lds + (bufoff) + ldsw + _i * 8192), 16, 0, 0); } while (0)
#define PG8_STAGEA(bufoff, vo, h, kb) do { _Pragma("unroll") for (int _i = 0; _i < 2; ++_i) \
        __builtin_amdgcn_global_load_lds((const unsigned*)(Abase + (size_t)(kb) + (vo)[h][_i]), (LAS unsigned*)(lds + (bufoff) + ldsw + _i * 8192), 16, 0, 0); } while (0)
#define PG8_LDA(dst, b, h) do { _Pragma("unroll") for (int m = 0; m < 4; ++m) { if constexpr (Prob::FP8) dst##8[m] = cat8(*(const LAS bf16x8*)(lds + PG8_SA(b, h) + aoff + m * 2048), *(const LAS bf16x8*)(lds + PG8_SA(b, h) + aoff + m * 2048 + 1024)); \
        else { _Pragma("unroll") for (int k = 0; k < 2; ++k) dst[m][k] = *(const LAS bf16x8*)(lds + PG8_SA(b, h) + aoff + m * 2048 + k * 1024); } } } while (0)
#define PG8_LDB(dst, b, h) do { _Pragma("unroll") for (int n = 0; n < 2; ++n) { if constexpr (Prob::FP8) dst##8[n] = cat8(*(const LAS bf16x8*)(lds + PG8_SB(b, h) + boff + n * 2048), *(const LAS bf16x8*)(lds + PG8_SB(b, h) + boff + n * 2048 + 1024)); \
        else { _Pragma("unroll") for (int k = 0; k < 2; ++k) dst[n][k] = *(const LAS bf16x8*)(lds + PG8_SB(b, h) + boff + n * 2048 + k * 1024); } } } while (0)
#define PG8_MMA(ai, bj, At, Bt) do { __builtin_amdgcn_s_setprio(1); _Pragma("unroll") for (int m = 0; m < 4; ++m) _Pragma("unroll") for (int n = 0; n < 2; ++n) { \
        if constexpr (Prob::FP8) asm volatile("v_mfma_scale_f32_16x16x128_f8f6f4 %0, %1, %2, %0, %3, %4 op_sel_hi:[0,0,0]" : "+v"(acc[ai][bj][m][n]) : "v"(Bt##8[n]), "v"(At##8[m]), "v"(scl_b), "v"(scl_a)); \
        else { _Pragma("unroll") for (int k = 0; k < 2; ++k) acc[ai][bj][m][n] = __builtin_amdgcn_mfma_f32_16x16x32_bf16(Bt[n][k], At[m][k], acc[ai][bj][m][n], 0, 0, 0); } } \
        __builtin_amdgcn_s_setprio(0); } while (0)
#define PG8_WAIT_V(n) asm volatile("s_waitcnt vmcnt(" #n ")" ::: "memory")
#define PG8_WAIT_L(n) asm volatile("s_waitcnt lgkmcnt(" #n ")" ::: "memory")
#define PG8_BAR __builtin_amdgcn_s_barrier()
#define PG8_SCHED __builtin_amdgcn_sched_barrier(0)
    Unit cur, nxt; int ui = 0;
    if (!P.next(0, cur)) return;
    f32x4 acc[2][2][4][2];
#pragma unroll
    for (int a = 0; a < 2; ++a)
#pragma unroll
        for (int b = 0; b < 2; ++b)
#pragma unroll
            for (int m = 0; m < 4; ++m)
#pragma unroll
                for (int n = 0; n < 2; ++n) acc[a][b][m][n] = (f32x4){0.f, 0.f, 0.f, 0.f};
    bf16x8 At[4][2], B0[2][2], B1[2][2]; v8i_t At8[4], B08[2], B18[2];
    unsigned cvo[2][2], nvo[2][2];
#pragma unroll
    for (int h = 0; h < 2; ++h)
#pragma unroll
        for (int i = 0; i < 2; ++i) cvo[h][i] = P.a_off(cur, h * HALF + RA[i]) + (unsigned)CA[i] * 2u;
    const char* cB = P.b_ptr(cur);
    const size_t kstep = (size_t)(BK * 2);
    PG8_STAGEB(PG8_SB(0, 0), cB); PG8_STAGEB(PG8_SB(0, 1), cB + hstepB); PG8_STAGEA(PG8_SA(0, 0), cvo, 0, 0); PG8_STAGEA(PG8_SA(0, 1), cvo, 1, 0);
    if (wr == 1) PG8_BAR;
    PG8_WAIT_V(2); PG8_BAR;
    PG8_STAGEB(PG8_SB(1, 0), cB + kstep); PG8_STAGEA(PG8_SA(1, 0), cvo, 0, kstep); PG8_STAGEB(PG8_SB(1, 1), cB + hstepB + kstep);
    PG8_WAIT_V(6); PG8_BAR;
    for (;;) {
        const bool has_next = P.next(ui + 1, nxt);
        const char* nB = cB;
#pragma unroll
        for (int h = 0; h < 2; ++h)
#pragma unroll
            for (int i = 0; i < 2; ++i) nvo[h][i] = cvo[h][i];
        if (has_next) { nB = P.b_ptr(nxt);
#pragma unroll
            for (int h = 0; h < 2; ++h)
#pragma unroll
                for (int i = 0; i < 2; ++i) nvo[h][i] = P.a_off(nxt, h * HALF + RA[i]) + (unsigned)CA[i] * 2u; }
        for (int t = 0; t < nt; t += 2) {
            const bool last = (t == nt - 2);
            const size_t k1 = (size_t)(t + 1) * kstep;
            const size_t k2 = last ? 0 : (size_t)(t + 2) * kstep, k3 = k2 + kstep;
            unsigned vo2[2][2];
#pragma unroll
            for (int h = 0; h < 2; ++h)
#pragma unroll
                for (int i = 0; i < 2; ++i) vo2[h][i] = last ? nvo[h][i] : cvo[h][i];
            const char* b2 = (last ? nB : cB) + k2; const char* b3 = b2 + kstep;
            PG8_LDB(B0, 0, 0); PG8_LDB(B1, 0, 1); PG8_SCHED; PG8_LDA(At, 0, 0); PG8_STAGEA(PG8_SA(1, 1), cvo, 1, k1);
            PG8_WAIT_V(8); PG8_WAIT_L(0); PG8_BAR; PG8_MMA(0, 0, At, B0); PG8_MMA(0, 1, At, B1); PG8_BAR; PG8_SCHED;
            PG8_LDA(At, 0, 1); PG8_STAGEB(PG8_SB(0, 0), b2); PG8_STAGEB(PG8_SB(0, 1), b2 + hstepB); PG8_STAGEA(PG8_SA(0, 0), vo2, 0, k2);
            PG8_WAIT_V(8); PG8_WAIT_L(0); PG8_BAR; PG8_MMA(1, 0, At, B0); PG8_MMA(1, 1, At, B1); PG8_BAR; PG8_SCHED;
            PG8_LDB(B0, 1, 0); PG8_LDB(B1, 1, 1); PG8_SCHED; PG8_LDA(At, 1, 0); PG8_STAGEA(PG8_SA(0, 1), vo2, 1, k2);
            PG8_WAIT_V(8); PG8_WAIT_L(0); PG8_BAR; PG8_MMA(0, 0, At, B0); PG8_MMA(0, 1, At, B1); PG8_BAR; PG8_SCHED;
            PG8_LDA(At, 1, 1); PG8_STAGEB(PG8_SB(1, 0), b3); PG8_STAGEB(PG8_SB(1, 1), b3 + hstepB); PG8_STAGEA(PG8_SA(1, 0), vo2, 0, k3);
            PG8_WAIT_V(8); PG8_WAIT_L(0); PG8_BAR; PG8_MMA(1, 0, At, B0); PG8_MMA(1, 1, At, B1); PG8_BAR; PG8_SCHED;
        }
        if (wr == 0) PG8_BAR;
        if constexpr (Prob::FP8) asm volatile("s_nop 15\n\ts_nop 15" ::: "memory");
        if constexpr (Epi::STAGED) E.staged(acc, P, cur, wr, wc, fr, fq, lds + STAGE_BYTES, tid);
        else { E(acc, P, cur, wr, wc, fr, fq); if (MK_EPI2) { asm volatile("" ::: "memory"); E(acc, P, cur, wr, wc, fr, fq); } }
        if (!has_next) break;
#pragma unroll
        for (int a = 0; a < 2; ++a)
#pragma unroll
            for (int b = 0; b < 2; ++b)
#pragma unroll
                for (int m = 0; m < 4; ++m)
#pragma unroll
                    for (int n = 0; n < 2; ++n) acc[a][b][m][n] = (f32x4){0.f, 0.f, 0.f, 0.f};
        cur = nxt; cB = nB; ++ui;
#pragma unroll
        for (int h = 0; h < 2; ++h)
#pragma unroll
            for (int i = 0; i < 2; ++i) cvo[h][i] = nvo[h][i];
        if (wr == 1) PG8_BAR;
    }
    PG8_WAIT_V(0);
    PG8_BAR;
#undef PG8_SA
#undef PG8_SB
#undef PG8_STAGEA
#undef PG8_STAGEB
#undef PG8_LDA
#undef PG8_LDB
#undef PG8_MMA
#undef PG8_WAIT_V
#undef PG8_WAIT_L
#undef PG8_BAR
#undef PG8_SCHED
}

struct DenseProb {
    static constexpr bool FP8 = false; static constexpr int sa = 127, sb = 127;
    const bf16_t* Abase; const bf16_t* Bt; int K, lda, ldb; Order ord;
    __device__ __forceinline__ bool next(int i, Unit& u) const { return ord.next(i, u); }
    __device__ __forceinline__ unsigned a_off(const Unit& u, int r) const { return (unsigned)((size_t)(u.pm * BM + r) * lda * 2); }
    __device__ __forceinline__ const char* b_ptr(const Unit& u) const { return (const char*)Bt + (size_t)u.pn * BM * ldb * 2; }
    __device__ __forceinline__ int orow0(const Unit& u) const { return u.pm * BM; }
};
template <int SA, int SB> struct DenseProb8 {
    static constexpr bool FP8 = true; static constexpr int sa = SA, sb = SB;
    const unsigned char* Abase; const unsigned char* Bt; int K, ldb; int lda; Order ord;
    __device__ __forceinline__ bool next(int i, Unit& u) const { return ord.next(i, u); }
    __device__ __forceinline__ unsigned a_off(const Unit& u, int r) const { return (unsigned)((size_t)(u.pm * BM + r) * lda); }
    __device__ __forceinline__ const char* b_ptr(const Unit& u) const { return (const char*)Bt + (size_t)u.pn * BM * ldb * 2; }
    __device__ __forceinline__ int orow0(const Unit& u) const { return u.pm * BM; }
};
struct MoeTiles { unsigned long long tp8; unsigned long long c4a, c4b; int nt; };
__device__ __forceinline__ int moe_tp(const MoeTiles& T, int e) { return (int)((T.tp8 >> (8 * e)) & 0xffull); }
__device__ __forceinline__ int moe_cnt(const MoeTiles& T, int e) { const unsigned long long w = (e < 4) ? T.c4a : T.c4b; return (int)((w >> (16 * (e & 3))) & 0xffffull); }
__device__ __forceinline__ int moe_expert(const MoeTiles& T, int pm) { int e = 0;
#pragma unroll
    for (int j = 1; j < 8; ++j) e += (pm >= (int)((T.tp8 >> (8 * j)) & 0xffull)) ? 1 : 0;
    return e; }
struct MoeGuProb {
    static constexpr bool FP8 = true; static constexpr int sa = 125, sb = 121;
    const unsigned char* Abase; const unsigned char* Bt; int K, ldb; Order ord; MoeTiles T; const int* rowtok;
    __device__ __forceinline__ bool next(int i, Unit& u) const { return ord.next(i, u); }
    __device__ __forceinline__ unsigned a_off(const Unit& u, int r) const {
        const int e = moe_expert(T, u.pm); const int idx = (u.pm - moe_tp(T, e)) * BM + r; const int cm1 = moe_cnt(T, e) - 1;
        const int tok = rowtok[e * CAPE + (idx < cm1 ? idx : cm1)];
        return (unsigned)tok * (unsigned)D; }
    __device__ __forceinline__ const char* b_ptr(const Unit& u) const { const int e = moe_expert(T, u.pm); return (const char*)Bt + ((size_t)e * N_GU1 + (size_t)u.pn * BM) * D; }
    __device__ __forceinline__ int orow0(const Unit& u) const { return u.pm * BM; }
};
struct MoeDnProb {
    static constexpr bool FP8 = true; static constexpr int sa = 124, sb = 121;
    const unsigned char* Abase; const unsigned char* Bt; int K, ldb; Order ord; MoeTiles T;
    __device__ __forceinline__ bool next(int i, Unit& u) const { return ord.next(i, u); }
    __device__ __forceinline__ unsigned a_off(const Unit& u, int r) const { return (unsigned)((size_t)(u.pm * BM + r) * EXD); }
    __device__ __forceinline__ const char* b_ptr(const Unit& u) const { const int e = moe_expert(T, u.pm); return (const char*)Bt + ((size_t)e * D + (size_t)u.pn * BM) * EXD; }
    __device__ __forceinline__ int orow0(const Unit& u) const { return u.pm * BM; }
};

struct EpiF32 { static constexpr bool PERM = false; static constexpr bool STAGED = false; float* C; int ldc;
    template <class Prob> __device__ __forceinline__ void operator()(const f32x4 (&acc)[2][2][4][2], const Prob& P, const Unit& u, int wr, int wc, int fr, int fq) const {
        const int row0 = P.orow0(u) + wr * 64 + fr, col0 = u.pn * BM + wc * 32 + 4 * fq;
#pragma unroll
        for (int ai = 0; ai < 2; ++ai)
#pragma unroll
            for (int m = 0; m < 4; ++m) { float* rowp = C + (size_t)(row0 + ai * HALF + m * 16) * ldc + col0;
#pragma unroll
                for (int bj = 0; bj < 2; ++bj)
#pragma unroll
                    for (int n = 0; n < 2; ++n) *(f32x4*)(rowp + bj * HALF + n * 16) = acc[ai][bj][m][n]; }
    }
};
struct EpiBf16 { static constexpr bool PERM = true; static constexpr bool STAGED = false; bf16_t* O; int ldc; const float* rowscale;
    template <class Prob> __device__ __forceinline__ void operator()(const f32x4 (&acc)[2][2][4][2], const Prob& P, const Unit& u, int wr, int wc, int fr, int fq) const {
        const int row0 = P.orow0(u) + wr * 64 + fr, col0 = u.pn * BM + wc * 32 + 8 * fq;
#pragma unroll
        for (int ai = 0; ai < 2; ++ai)
#pragma unroll
            for (int m = 0; m < 4; ++m) { const int row = row0 + ai * HALF + m * 16; bf16_t* rowp = O + (size_t)row * ldc + col0; const float rs = rowscale ? rowscale[row] : 1.0f;
#pragma unroll
                for (int bj = 0; bj < 2; ++bj) { const f32x4 v0 = acc[ai][bj][m][0] * rs, v1 = acc[ai][bj][m][1] * rs;
                    u32x4 w; w.x = cvtpk(v0[0], v0[1]); w.y = cvtpk(v0[2], v0[3]); w.z = cvtpk(v1[0], v1[1]); w.w = cvtpk(v1[2], v1[3]);
                    *(u32x4*)(rowp + bj * HALF) = w; } }
    }
};
struct EpiIn1 { static constexpr bool PERM = true; static constexpr bool STAGED = false; bf16_t* QK; bf16_t* V; bf16_t* G; bf16_t* RRp;
    template <class Prob> __device__ __forceinline__ void operator()(const f32x4 (&acc)[2][2][4][2], const Prob& P, const Unit& u, int wr, int wc, int fr, int fq) const {
        const int t = u.pn >> 2; bf16_t* base = (t == 0) ? QK : (t == 1) ? V : (t == 2) ? G : RRp; const int ldc = (t == 3) ? 256 : 1024;
        const int row0 = P.orow0(u) + wr * 64 + fr, col0 = (u.pn & 3) * BM + wc * 32 + 8 * fq;
#pragma unroll
        for (int ai = 0; ai < 2; ++ai)
#pragma unroll
            for (int m = 0; m < 4; ++m) { const int row = row0 + ai * HALF + m * 16; bf16_t* rowp = base + (size_t)row * ldc + col0;
#pragma unroll
                for (int bj = 0; bj < 2; ++bj) { const f32x4 v0 = acc[ai][bj][m][0], v1 = acc[ai][bj][m][1];
                    u32x4 w; w.x = cvtpk(v0[0], v0[1]); w.y = cvtpk(v0[2], v0[3]); w.z = cvtpk(v1[0], v1[1]); w.w = cvtpk(v1[2], v1[3]);
                    *(u32x4*)(rowp + bj * HALF) = w; } }
    }
};
struct EpiQA { static constexpr bool PERM = true; static constexpr bool STAGED = false; bf16_t* O; const float* rstd; const float* tab16; float qscale;
    template <class Prob> __device__ __forceinline__ void operator()(const f32x4 (&acc)[2][2][4][2], const Prob& P, const Unit& u, int wr, int wc, int fr, int fq) const {
        const int row0 = P.orow0(u) + wr * 64 + fr, col0 = u.pn * BM + wc * 32 + 8 * fq;
        const bool ropet = (u.pn == 2);
#pragma unroll
        for (int ai = 0; ai < 2; ++ai)
#pragma unroll
            for (int m = 0; m < 4; ++m) { const int row = row0 + ai * HALF + m * 16; bf16_t* rowp = O + (size_t)row * N_QA + col0; const float rs = rstd[row] * qscale;
                f32x4 cs0 = {1.f, 1.f, 1.f, 1.f}, sn0 = {0.f, 0.f, 0.f, 0.f};
                if (ropet && row < RL) { const int tt = row & (SEQ - 1); const int pos = (fq >> 1) ? (tt & 63) : (tt >> 6); const int i0 = 4 * (fq & 1);
                    cs0 = *(const f32x4*)(tab16 + pos * 8 + i0); sn0 = *(const f32x4*)(tab16 + 512 + pos * 8 + i0); }
#pragma unroll
                for (int bj = 0; bj < 2; ++bj) { f32x4 v0 = acc[ai][bj][m][0] * rs, v1 = acc[ai][bj][m][1] * rs;
                    if (ropet) {
                        const f32x4 a = v0, b = v1;
                        v0[0] = a[0] * cs0[0] - a[1] * sn0[0]; v0[1] = a[1] * cs0[0] + a[0] * sn0[0];
                        v0[2] = a[2] * cs0[1] - a[3] * sn0[1]; v0[3] = a[3] * cs0[1] + a[2] * sn0[1];
                        v1[0] = b[0] * cs0[2] - b[1] * sn0[2]; v1[1] = b[1] * cs0[2] + b[0] * sn0[2];
                        v1[2] = b[2] * cs0[3] - b[3] * sn0[3]; v1[3] = b[3] * cs0[3] + b[2] * sn0[3]; }
                    u32x4 w; w.x = cvtpk(v0[0], v0[1]); w.y = cvtpk(v0[2], v0[3]); w.z = cvtpk(v1[0], v1[1]); w.w = cvtpk(v1[2], v1[3]);
                    *(u32x4*)(rowp + bj * HALF) = w; } }
    }
};
struct EpiSwiglu { static constexpr bool PERM = false; static constexpr bool STAGED = false; bf16_t* Hh; int ldh;
    template <class Prob> __device__ __forceinline__ void operator()(const f32x4 (&acc)[2][2][4][2], const Prob& P, const Unit& u, int wr, int wc, int fr, int fq) const {
        const int row0 = P.orow0(u) + wr * 64 + fr, col0 = (u.pn * BM + wc * 32) / 2 + 4 * fq;
#pragma unroll
        for (int ai = 0; ai < 2; ++ai)
#pragma unroll
            for (int m = 0; m < 4; ++m) { bf16_t* rowp = Hh + (size_t)(row0 + ai * HALF + m * 16) * ldh + col0;
#pragma unroll
                for (int bj = 0; bj < 2; ++bj) { const f32x4 g = acc[ai][bj][m][0], up = acc[ai][bj][m][1];
                    u32x2 w; w.x = cvtpk(swiglu_f(g[0], up[0], -1.4426950408889634f), swiglu_f(g[1], up[1], -1.4426950408889634f)); w.y = cvtpk(swiglu_f(g[2], up[2], -1.4426950408889634f), swiglu_f(g[3], up[3], -1.4426950408889634f));
                    *(u32x2*)(rowp + bj * (HALF / 2)) = w; } }
    }
};
struct EpiSwiglu8 { static constexpr bool PERM = false; static constexpr bool STAGED = true; unsigned char* Hh; int ldh;
    template <class Prob> __device__ __forceinline__ void staged(const f32x4 (&acc)[2][2][4][2], const Prob& P, const Unit& u, int wr, int wc, int fr, int fq, LAS unsigned char* stg, int tid) const {
        LAS unsigned char* sg = stg + wr * 8192;
        const int t = tid & 255;
        unsigned char* gbase = Hh + (size_t)(P.orow0(u) + wr * 64) * ldh + (size_t)u.pn * 128;
#pragma unroll
        for (int ai = 0; ai < 2; ++ai) {
#pragma unroll
            for (int m = 0; m < 4; ++m) { const int row = m * 16 + fr;
#pragma unroll
                for (int bj = 0; bj < 2; ++bj) { const f32x4 g = acc[ai][bj][m][0], up = acc[ai][bj][m][1]; const int p = bj * 4 + wc;
                    *(LAS unsigned*)(sg + row * 128 + ((p ^ (row & 7)) << 4) + 4 * fq) = pack_fp8x4(swiglu_f(g[0], up[0], -0.18033688011112042f), swiglu_f(g[1], up[1], -0.18033688011112042f), swiglu_f(g[2], up[2], -0.18033688011112042f), swiglu_f(g[3], up[3], -0.18033688011112042f)); } }
            asm volatile("s_waitcnt lgkmcnt(0)" ::: "memory"); __builtin_amdgcn_s_barrier(); asm volatile("" ::: "memory");
#pragma unroll
            for (int j = 0; j < 2; ++j) { const int row = (t >> 3) + 32 * j, p = t & 7;
                const u32x4 v = *(const LAS u32x4*)(sg + row * 128 + ((p ^ (row & 7)) << 4));
                *(u32x4*)(gbase + (size_t)(ai * HALF + row) * ldh + p * 16) = v; }
            if (ai == 0) { asm volatile("s_waitcnt lgkmcnt(0)" ::: "memory"); __builtin_amdgcn_s_barrier(); asm volatile("" ::: "memory"); }
        }
    }
};
}

struct Frame {
    LAS unsigned char* lds;
    unsigned char* ws;
    int tid, lane, wave, vcu, G;
};
template <class T> __device__ __forceinline__ T* wsp(const Frame& F, size_t off) { return (T*)(F.ws + off); }

__device__ __forceinline__ void load_row(const float* p, int lane, f32x4 (&v)[4]) {
    const f32x4* r = (const f32x4*)p + lane;
#pragma unroll
    for (int j = 0; j < 4; ++j) v[j] = r[64 * j];
}
__device__ __forceinline__ void load_row_bf16(const bf16_t* p, int lane, f32x4 (&v)[4]) {
#pragma unroll
    for (int j = 0; j < 4; ++j) { const u32x2 w = *(const u32x2*)(p + 4 * lane + 256 * j); v[j][0] = bflo(w.x); v[j][1] = bfhi(w.x); v[j][2] = bflo(w.y); v[j][3] = bfhi(w.y); }
}
__device__ __forceinline__ float row_ssq(const f32x4 (&v)[4]) { float s = 0.f;
#pragma unroll
    for (int j = 0; j < 4; ++j) s += (v[j][0] * v[j][0] + v[j][1] * v[j][1]) + (v[j][2] * v[j][2] + v[j][3] * v[j][3]);
    return wave_sum(s); }
__device__ __forceinline__ void norm_mod_store(const f32x4 (&h)[4], const float* g, const float* sh, const float* sc, bf16_t* urow, int lane, f32x4 (&uo)[4], unsigned char* u8row = nullptr) {
    const float rstd = __builtin_amdgcn_rsqf(row_ssq(h) * (1.0f / D) + EPS);
#pragma unroll
    for (int j = 0; j < 4; ++j) { const int c = 4 * lane + 256 * j; const f32x4 gg = *(const f32x4*)(g + c), s1 = *(const f32x4*)(sc + c), s0 = *(const f32x4*)(sh + c);
        const f32x4 uu = (h[j] * rstd * gg) * (1.0f + s1) + s0; uo[j] = uu;
        if (u8row) *(unsigned*)(u8row + c) = pack_fp8x4(4.0f * uu[0], 4.0f * uu[1], 4.0f * uu[2], 4.0f * uu[3]);
        else { u32x2 w; w.x = cvtpk(uu[0], uu[1]); w.y = cvtpk(uu[2], uu[3]); *(u32x2*)(urow + c) = w; } }
}
__device__ __forceinline__ int row_bidx(int row) { return row < RL ? (row >> 12) : 4; }

__device__ __forceinline__ void glds16(const void* gsrc, unsigned lds_dst) { unsigned keep;
    asm volatile("s_mov_b32 %0, m0\n\ts_mov_b32 m0, %2\n\ts_nop 0\n\tglobal_load_lds_dwordx4 %1, off\n\ts_mov_b32 m0, %0" : "=&s"(keep) : "v"(gsrc), "s"(lds_dst) : "memory"); }
__device__ __forceinline__ float max3f(float a, float b, float c) { float r; asm("v_max3_f32 %0, %1, %2, %3" : "=v"(r) : "v"(a), "v"(b), "v"(c)); return r; }
#define WAIT_BAR(N) asm volatile("s_waitcnt vmcnt(" #N ") lgkmcnt(0)\n\ts_barrier" ::: "memory")
template <int DQK> struct AttnSrc {
    const bf16_t* Q; int qpitch; const bf16_t* Qr;
    const bf16_t* Kn; int kpitch; const bf16_t* Kr; int krpitch;
    const bf16_t* V; int vpitch;
    bf16_t* O; int opitch;
};
__device__ __forceinline__ s16x4 vtr(const LAS unsigned char* p) { typedef short v4i16_t __attribute__((ext_vector_type(4))); return __builtin_bit_cast(s16x4, __builtin_amdgcn_ds_read_tr16_b64_v4i16((LAS v4i16_t*)p)); }
__device__ __forceinline__ int attn_krow(int kt, int lat0, int ctx0) { return kt < 64 ? lat0 + kt * 64 : ctx0 + (kt - 64) * 64; }
__device__ __forceinline__ f32x16 mfma_first(bf16x8 a, bf16x8 b, const f32x16& c) { f32x16 d; asm volatile("s_nop 4\n\tv_mfma_f32_32x32x16_bf16 %0, %1, %2, %3" : "=&v"(d) : "v"(a), "v"(b), "v"(c)); return d; }
template <int DQK, bool SAFE>
__device__ __forceinline__ bool attn_run(const Frame& F, const AttnSrc<DQK>& S, int q0, int lat0, int ctx0, int kt0, int kt1) {
    constexpr int NKS = DQK / 16, KB = DQK * 128, SLOT = KB + 8192;
    constexpr float THR = 8.0f;
    constexpr float BIG = 1.0e12f;
    bool ovf = false;
    const int lane = F.lane, wid = F.wave, r32 = lane & 31, hi = lane >> 5;
    LAS unsigned char* lds = F.lds;
    constexpr bool QLDS = false;
    bf16x8 qf[QLDS ? 1 : NKS];
    LAS unsigned char* qfl = lds + 4 * SLOT + wid * (NKS * 1024) + lane * 16;
    { const bf16_t* qrow = S.Q + (size_t)(q0 + wid * 32 + r32) * S.qpitch;
#pragma unroll
      for (int ks = 0; ks < 4; ++ks) { const bf16x8 v = *(const bf16x8*)(qrow + ks * 16 + hi * 8); if (QLDS) *(LAS bf16x8*)(qfl + ks * 1024) = v; else qf[ks] = v; }
      if (DQK == 96) { const bf16_t* qr = S.Qr + (size_t)(q0 + wid * 32 + r32) * S.qpitch;
#pragma unroll
          for (int ks = 4; ks < NKS; ++ks) { const bf16x8 v = *(const bf16x8*)(qr + (ks - 4) * 16 + hi * 8); if (QLDS) *(LAS bf16x8*)(qfl + ks * 1024) = v; else qf[ks] = v; } } }
    const unsigned lds0 = (unsigned)(size_t)lds;
    auto dma = [&](int kt, int slot) {
        const int krow = attn_krow(kt, lat0, ctx0);
        const unsigned sb = lds0 + slot * SLOT;
        glds16(S.Kn + (size_t)(krow + lane) * S.kpitch + wid * 8, (unsigned)__builtin_amdgcn_readfirstlane(sb + wid * 1024));
        if (DQK == 96 && wid < 4) glds16(S.Kr + (size_t)(krow + lane) * S.krpitch + wid * 8, (unsigned)__builtin_amdgcn_readfirstlane(sb + (8 + wid) * 1024));
        glds16(S.V + (size_t)(krow + 16 * (wid & 3) + (lane >> 2)) * S.vpitch + (wid >> 2) * 32 + (lane & 3) * 8, (unsigned)__builtin_amdgcn_readfirstlane(sb + KB + wid * 1024));
    };
    auto wait_bar = [&](bool inflight) {
        if (!inflight) { WAIT_BAR(0); } else if (DQK == 96 && wid < 4) { WAIT_BAR(3); } else { WAIT_BAR(2); }
    };
    f32x16 oT[2]; f32x16 negm;
#pragma unroll
    for (int r = 0; r < 16; ++r) { oT[0][r] = 0.f; oT[1][r] = 0.f; negm[r] = 0.f; }
    float mrun = 0.f, lrun = 0.f;
    const int vlane = ((lane >> 4) & 1) * 32 + (lane & 3) * 8 + (4 * hi + ((lane & 15) >> 2)) * 64;
    auto qk = [&](int slot, f32x16& p0, f32x16& p1) {
        const LAS unsigned char* kb = lds + slot * SLOT + hi * 1024 + r32 * 16;
        p0 = negm; p1 = negm;
        bf16x8 ka = *(const LAS bf16x8*)(kb), kc = *(const LAS bf16x8*)(kb + 512);
#pragma unroll
        for (int ks = 0; ks < NKS; ++ks) {
            bf16x8 na = ka, nc = kc;
            if (ks + 1 < NKS) { na = *(const LAS bf16x8*)(kb + (ks + 1) * 2048); nc = *(const LAS bf16x8*)(kb + (ks + 1) * 2048 + 512); }
            const bf16x8 qv = QLDS ? *(const LAS bf16x8*)(qfl + ks * 1024) : qf[QLDS ? 0 : ks];
            p0 = __builtin_amdgcn_mfma_f32_32x32x16_bf16(ka, qv, p0, 0, 0, 0);
            p1 = __builtin_amdgcn_mfma_f32_32x32x16_bf16(kc, qv, p1, 0, 0, 0);
            ka = na; kc = nc;
        }
    };
    auto tilemax = [&](f32x16& p0, f32x16& p1) -> float {
        asm volatile("s_nop 15\n\ts_nop 7" : "+v"(p0), "+v"(p1));
        float a = max3f(p0[0], p0[1], p1[0]), b = max3f(p0[2], p0[3], p1[1]); a = max3f(a, p1[2], p1[3]);
#pragma unroll
        for (int r = 4; r < 16; r += 4) { a = max3f(a, p0[r], p0[r + 1]); b = max3f(b, p0[r + 2], p0[r + 3]); a = max3f(a, p1[r], p1[r + 1]); b = max3f(b, p1[r + 2], p1[r + 3]); }
        float tm = fmaxf(a, b);
        auto rr = __builtin_amdgcn_permlane32_swap(__float_as_uint(tm), __float_as_uint(tm), false, false); return fmaxf(__uint_as_float(rr[0]), __uint_as_float(rr[1]));
    };
    auto step = [&](f32x16& c0, f32x16& c1, f32x16& n0, f32x16& n1, int slot_c, int slot_n) {
        if constexpr (SAFE) {
            const float tm = tilemax(c0, c1);
            if (__any(tm > THR)) {
                const float dl = fmaxf(tm, 0.f); mrun += dl; const float al = __builtin_amdgcn_exp2f(-dl); lrun *= al;
#pragma unroll
                for (int r = 0; r < 16; ++r) { c0[r] -= dl; c1[r] -= dl; negm[r] = -mrun; oT[0][r] *= al; oT[1][r] *= al; }
            }
        }
        float rs = 0.f;
        {
            const LAS unsigned char* kb = lds + slot_n * SLOT + hi * 1024 + r32 * 16;
            bf16x8 ka = *(const LAS bf16x8*)(kb), kc = *(const LAS bf16x8*)(kb + 512);
#pragma unroll
            for (int ks = 0; ks < NKS; ++ks) {
                bf16x8 na = ka, nc = kc;
                if (ks + 1 < NKS) { na = *(const LAS bf16x8*)(kb + (ks + 1) * 2048); nc = *(const LAS bf16x8*)(kb + (ks + 1) * 2048 + 512); }
                if (ks == 0) { n0 = mfma_first(ka, qf[0], negm); n1 = mfma_first(kc, qf[0], negm); }
                else { n0 = __builtin_amdgcn_mfma_f32_32x32x16_bf16(ka, qf[ks], n0, 0, 0, 0);
                       n1 = __builtin_amdgcn_mfma_f32_32x32x16_bf16(kc, qf[ks], n1, 0, 0, 0); }
                ka = na; kc = nc;
#pragma unroll
                for (int r = (16 * ks) / NKS; r < (16 * (ks + 1)) / NKS; ++r) { c0[r] = __builtin_amdgcn_exp2f(c0[r]); c1[r] = __builtin_amdgcn_exp2f(c1[r]); rs += c0[r] + c1[r]; }
            }
        }
        bool mv = false; float dl = 0.f;
        if constexpr (!SAFE) mv = __any(!(rs < BIG));
        lrun += rs;
        bf16x8 pf[4];
        { u32x4 w;
          w.x = cvtpk(c0[0], c0[1]); w.y = cvtpk(c0[2], c0[3]); w.z = cvtpk(c0[4], c0[5]); w.w = cvtpk(c0[6], c0[7]); pf[0] = __builtin_bit_cast(bf16x8, w);
          w.x = cvtpk(c0[8], c0[9]); w.y = cvtpk(c0[10], c0[11]); w.z = cvtpk(c0[12], c0[13]); w.w = cvtpk(c0[14], c0[15]); pf[1] = __builtin_bit_cast(bf16x8, w);
          w.x = cvtpk(c1[0], c1[1]); w.y = cvtpk(c1[2], c1[3]); w.z = cvtpk(c1[4], c1[5]); w.w = cvtpk(c1[6], c1[7]); pf[2] = __builtin_bit_cast(bf16x8, w);
          w.x = cvtpk(c1[8], c1[9]); w.y = cvtpk(c1[10], c1[11]); w.z = cvtpk(c1[12], c1[13]); w.w = cvtpk(c1[14], c1[15]); pf[3] = __builtin_bit_cast(bf16x8, w); }
        const LAS unsigned char* vb = lds + slot_c * SLOT + KB + vlane;
        s16x4 lo = vtr(vb), hh = vtr(vb + 512);
#pragma unroll
        for (int i = 0; i < 8; ++i) {
            const int d0 = i >> 2, ks = i & 3;
            s16x4 nlo = lo, nhh = hh;
            if (i + 1 < 8) { const int o2 = ((i + 1) >> 2) * 4096 + ((i + 1) & 3) * 1024; nlo = vtr(vb + o2); nhh = vtr(vb + o2 + 512); }
            const bf16x8 vf = (bf16x8){lo[0], lo[1], lo[2], lo[3], hh[0], hh[1], hh[2], hh[3]};
            oT[d0] = __builtin_amdgcn_mfma_f32_32x32x16_bf16(vf, pf[ks], oT[d0], 0, 0, 0);
            lo = nlo; hh = nhh;
        }
        if constexpr (!SAFE) {
            if (mv) {
                auto rr = __builtin_amdgcn_permlane32_swap(__float_as_uint(rs), __float_as_uint(rs), false, false);
                const float rrow = __uint_as_float(rr[0]) + __uint_as_float(rr[1]);
                ovf = ovf || !(rrow < 1.0e30f);
                const int ex = __builtin_amdgcn_frexp_expf(rrow) - 1;
                dl = (float)(ex > 0 ? ex : 0); const float al = __builtin_amdgcn_exp2f(-dl); lrun *= al;
#pragma unroll
                for (int r = 0; r < 16; ++r) { n0[r] -= dl; n1[r] -= dl; negm[r] -= dl; oT[0][r] *= al; oT[1][r] *= al; }
            }
        }
    };
    dma(kt0, 0); dma(kt0 + 1, 1); dma(kt0 + 2, 2);
    wait_bar(true);
    f32x16 pA0, pA1, pB0, pB1;
    qk(0, pA0, pA1);
    { mrun = tilemax(pA0, pA1);
#pragma unroll
      for (int r = 0; r < 16; ++r) negm[r] = -mrun;
      qk(0, pA0, pA1); }
    int sc = 0;
    for (int kt = kt0; kt < kt1; kt += 2) {
        { const int s1 = (sc + 1) & 3, s3 = (sc + 3) & 3;
          if (kt + 3 < kt1) dma(kt + 3, s3);
          step(pA0, pA1, pB0, pB1, sc, s1);
          wait_bar(kt + 3 < kt1);
          sc = s1; }
        { const int s1 = (sc + 1) & 3, s3 = (sc + 3) & 3;
          if (kt + 4 < kt1) dma(kt + 4, s3);
          step(pB0, pB1, pA0, pA1, sc, s1);
          wait_bar(kt + 4 < kt1);
          sc = s1; }
    }
    { auto rr = __builtin_amdgcn_permlane32_swap(__float_as_uint(lrun), __float_as_uint(lrun), false, false); lrun = __uint_as_float(rr[0]) + __uint_as_float(rr[1]); }
    const float inv = 1.0f / lrun;
    bf16_t* orow = S.O + (size_t)(q0 + wid * 32 + r32) * S.opitch;
#pragma unroll
    for (int d0 = 0; d0 < 2; ++d0)
#pragma unroll
        for (int g = 0; g < 4; ++g) { u32x2 w; w.x = cvtpk(oT[d0][4 * g] * inv, oT[d0][4 * g + 1] * inv); w.y = cvtpk(oT[d0][4 * g + 2] * inv, oT[d0][4 * g + 3] * inv);
            *(u32x2*)(orow + 32 * d0 + 8 * g + 4 * hi) = w; }
    return ovf;
}
template <int DQK>
__device__ __forceinline__ bool attn_fast(const Frame& F, const AttnSrc<DQK>& S, int q0, int lat0, int ctx0, int kt0, int kt1) {
    constexpr int NKS = DQK / 16, KB = DQK * 128, SLOT = KB + 8192, NS = 5;
    constexpr float BIG = 1.0e12f;
    bool ovf = false;
    const int lane = F.lane, wid = F.wave, r32 = lane & 31, hi = lane >> 5;
    LAS unsigned char* lds = F.lds;
    bf16x8 qf[NKS];
    { const bf16_t* qrow = S.Q + (size_t)(q0 + wid * 32 + r32) * S.qpitch;
#pragma unroll
      for (int ks = 0; ks < 4; ++ks) qf[ks] = *(const bf16x8*)(qrow + ks * 16 + hi * 8);
      if (DQK == 96) { const bf16_t* qr = S.Qr + (size_t)(q0 + wid * 32 + r32) * S.qpitch;
#pragma unroll
          for (int ks = 4; ks < NKS; ++ks) qf[ks] = *(const bf16x8*)(qr + (ks - 4) * 16 + hi * 8); } }
    const unsigned lds0 = (unsigned)(size_t)lds;
    auto dma = [&](int kt, int slot) {
        const int krow = attn_krow(kt, lat0, ctx0);
        const unsigned sb = lds0 + slot * SLOT;
        glds16(S.Kn + (size_t)(krow + lane) * S.kpitch + wid * 8, (unsigned)__builtin_amdgcn_readfirstlane(sb + wid * 1024));
        if (DQK == 96 && wid < 4) glds16(S.Kr + (size_t)(krow + lane) * S.krpitch + wid * 8, (unsigned)__builtin_amdgcn_readfirstlane(sb + (8 + wid) * 1024));
        glds16(S.V + (size_t)(krow + 16 * (wid & 3) + (lane >> 2)) * S.vpitch + (wid >> 2) * 32 + (lane & 3) * 8, (unsigned)__builtin_amdgcn_readfirstlane(sb + KB + wid * 1024));
    };
    auto wait_bar = [&](bool inflight) {
        if (!inflight) { WAIT_BAR(0); } else if (DQK == 96 && wid < 4) { WAIT_BAR(3); } else { WAIT_BAR(2); }
    };
    f32x16 oT[2]; f32x16 negm;
#pragma unroll
    for (int r = 0; r < 16; ++r) { oT[0][r] = 0.f; oT[1][r] = 0.f; negm[r] = 0.f; }
    float lrun = 0.f;
    const int vlane = ((lane >> 4) & 1) * 32 + (lane & 3) * 8 + (4 * hi + ((lane & 15) >> 2)) * 64;
    auto qk = [&](int slot, f32x16& p0, f32x16& p1) {
        const LAS unsigned char* kb = lds + slot * SLOT + hi * 1024 + r32 * 16;
        p0 = negm; p1 = negm;
        bf16x8 ka = *(const LAS bf16x8*)(kb), kc = *(const LAS bf16x8*)(kb + 512);
#pragma unroll
        for (int ks = 0; ks < NKS; ++ks) {
            bf16x8 na = ka, nc = kc;
            if (ks + 1 < NKS) { na = *(const LAS bf16x8*)(kb + (ks + 1) * 2048); nc = *(const LAS bf16x8*)(kb + (ks + 1) * 2048 + 512); }
            p0 = __builtin_amdgcn_mfma_f32_32x32x16_bf16(ka, qf[ks], p0, 0, 0, 0);
            p1 = __builtin_amdgcn_mfma_f32_32x32x16_bf16(kc, qf[ks], p1, 0, 0, 0);
            ka = na; kc = nc;
        }
    };
    bf16x8 pf[4];
#pragma unroll
    for (int j = 0; j < 4; ++j) pf[j] = (bf16x8){0, 0, 0, 0, 0, 0, 0, 0};
    auto step = [&](f32x16& c0, f32x16& c1, f32x16& n0, f32x16& n1, int slot_p, int slot_n) {
        float rs = 0.f;
        asm volatile("" : "+v"(c0), "+v"(c1));
        const LAS unsigned char* kb = lds + slot_n * SLOT + hi * 1024 + r32 * 16;
        const LAS unsigned char* vb = lds + slot_p * SLOT + KB + vlane;
        bf16x8 ka = *(const LAS bf16x8*)(kb), kc = *(const LAS bf16x8*)(kb + 512);
        s16x4 lo = vtr(vb), hh = vtr(vb + 512);
#pragma unroll
        for (int ks = 0; ks < NKS; ++ks) {
            bf16x8 na = ka, nc = kc;
            if (ks + 1 < NKS) { na = *(const LAS bf16x8*)(kb + (ks + 1) * 2048); nc = *(const LAS bf16x8*)(kb + (ks + 1) * 2048 + 512); }
            if (ks == 0) { n0 = mfma_first(ka, qf[0], negm); n1 = mfma_first(kc, qf[0], negm); }
            else { n0 = __builtin_amdgcn_mfma_f32_32x32x16_bf16(ka, qf[ks], n0, 0, 0, 0);
                   n1 = __builtin_amdgcn_mfma_f32_32x32x16_bf16(kc, qf[ks], n1, 0, 0, 0); }
            ka = na; kc = nc;
#pragma unroll
            for (int i = (8 * ks) / NKS; i < (8 * (ks + 1)) / NKS; ++i) {
                s16x4 nlo = lo, nhh = hh;
                if (i + 1 < 8) { const int o2 = ((i + 1) >> 2) * 4096 + ((i + 1) & 3) * 1024; nlo = vtr(vb + o2); nhh = vtr(vb + o2 + 512); }
                const bf16x8 vf = (bf16x8){lo[0], lo[1], lo[2], lo[3], hh[0], hh[1], hh[2], hh[3]};
                oT[i >> 2] = __builtin_amdgcn_mfma_f32_32x32x16_bf16(vf, pf[i & 3], oT[i >> 2], 0, 0, 0);
                lo = nlo; hh = nhh;
            }
#pragma unroll
            for (int r = (16 * ks) / NKS; r < (16 * (ks + 1)) / NKS; ++r) { c0[r] = __builtin_amdgcn_exp2f(c0[r]); c1[r] = __builtin_amdgcn_exp2f(c1[r]); rs = (rs + c0[r]) + c1[r]; }
            __builtin_amdgcn_sched_barrier(0);
        }
        ovf = ovf || !(rs < BIG);
        lrun += rs;
        { u32x4 w;
          w.x = cvtpk(c0[0], c0[1]); w.y = cvtpk(c0[2], c0[3]); w.z = cvtpk(c0[4], c0[5]); w.w = cvtpk(c0[6], c0[7]); pf[0] = __builtin_bit_cast(bf16x8, w);
          w.x = cvtpk(c0[8], c0[9]); w.y = cvtpk(c0[10], c0[11]); w.z = cvtpk(c0[12], c0[13]); w.w = cvtpk(c0[14], c0[15]); pf[1] = __builtin_bit_cast(bf16x8, w);
          w.x = cvtpk(c1[0], c1[1]); w.y = cvtpk(c1[2], c1[3]); w.z = cvtpk(c1[4], c1[5]); w.w = cvtpk(c1[6], c1[7]); pf[2] = __builtin_bit_cast(bf16x8, w);
          w.x = cvtpk(c1[8], c1[9]); w.y = cvtpk(c1[10], c1[11]); w.z = cvtpk(c1[12], c1[13]); w.w = cvtpk(c1[14], c1[15]); pf[3] = __builtin_bit_cast(bf16x8, w); }
        asm volatile("" : "+v"(pf[0]), "+v"(pf[1]), "+v"(pf[2]), "+v"(pf[3]), "+v"(lrun));
    };
    dma(kt0, 0); dma(kt0 + 1, 1); dma(kt0 + 2, 2);
    wait_bar(true);
    f32x16 pA0, pA1, pB0, pB1;
    qk(0, pA0, pA1);
    {
        asm volatile("s_nop 15\n\ts_nop 7" : "+v"(pA0), "+v"(pA1));
        float a = max3f(pA0[0], pA0[1], pA1[0]), b = max3f(pA0[2], pA0[3], pA1[1]); a = max3f(a, pA1[2], pA1[3]);
#pragma unroll
        for (int r = 4; r < 16; r += 4) { a = max3f(a, pA0[r], pA0[r + 1]); b = max3f(b, pA0[r + 2], pA0[r + 3]); a = max3f(a, pA1[r], pA1[r + 1]); b = max3f(b, pA1[r + 2], pA1[r + 3]); }
        float tm = fmaxf(a, b);
        auto rr = __builtin_amdgcn_permlane32_swap(__float_as_uint(tm), __float_as_uint(tm), false, false); tm = fmaxf(__uint_as_float(rr[0]), __uint_as_float(rr[1]));
#pragma unroll
        for (int r = 0; r < 16; ++r) negm[r] = -tm;
        qk(0, pA0, pA1); }
    int sc = 0;
    for (int kt = kt0; kt < kt1; kt += 2) {
        { const int sp = (kt == kt0) ? sc : (sc == 0 ? NS - 1 : sc - 1), s1 = (sc == NS - 1) ? 0 : sc + 1, s3 = (sc + 3 >= NS) ? sc + 3 - NS : sc + 3;
          if (kt + 3 < kt1) dma(kt + 3, s3);
          step(pA0, pA1, pB0, pB1, sp, s1);
          wait_bar(kt + 3 < kt1);
          sc = s1; }
        { const int sp = (sc == 0) ? NS - 1 : sc - 1, s1 = (sc == NS - 1) ? 0 : sc + 1, s3 = (sc + 3 >= NS) ? sc + 3 - NS : sc + 3;
          if (kt + 4 < kt1) dma(kt + 4, s3);
          step(pB0, pB1, pA0, pA1, sp, s1);
          wait_bar(kt + 4 < kt1);
          sc = s1; }
    }
    {
        const int sp = (sc == 0) ? NS - 1 : sc - 1;
        const LAS unsigned char* vb = lds + sp * SLOT + KB + vlane;
        s16x4 lo = vtr(vb), hh = vtr(vb + 512);
#pragma unroll
        for (int i = 0; i < 8; ++i) {
            s16x4 nlo = lo, nhh = hh;
            if (i + 1 < 8) { const int o2 = ((i + 1) >> 2) * 4096 + ((i + 1) & 3) * 1024; nlo = vtr(vb + o2); nhh = vtr(vb + o2 + 512); }
            const bf16x8 vf = (bf16x8){lo[0], lo[1], lo[2], lo[3], hh[0], hh[1], hh[2], hh[3]};
            oT[i >> 2] = __builtin_amdgcn_mfma_f32_32x32x16_bf16(vf, pf[i & 3], oT[i >> 2], 0, 0, 0);
            lo = nlo; hh = nhh;
        }
    }
    { auto rr = __builtin_amdgcn_permlane32_swap(__float_as_uint(lrun), __float_as_uint(lrun), false, false); lrun = __uint_as_float(rr[0]) + __uint_as_float(rr[1]); }
    const float inv = 1.0f / lrun;
    bf16_t* orow = S.O + (size_t)(q0 + wid * 32 + r32) * S.opitch;
#pragma unroll
    for (int d0 = 0; d0 < 2; ++d0)
#pragma unroll
        for (int g = 0; g < 4; ++g) { u32x2 w; w.x = cvtpk(oT[d0][4 * g] * inv, oT[d0][4 * g + 1] * inv); w.y = cvtpk(oT[d0][4 * g + 2] * inv, oT[d0][4 * g + 3] * inv);
            *(u32x2*)(orow + 32 * d0 + 8 * g + 4 * hi) = w; }
    return ovf;
}
template <int DQK>
__device__ __forceinline__ void attn_unit(const Frame& F, const AttnSrc<DQK>& S, int q0, int lat0, int ctx0, int kt0, int kt1) {
    volatile LAS unsigned* flag = (volatile LAS unsigned*)(F.lds + LDSCTL_OFF);
    const bool ovf = attn_fast<DQK>(F, S, q0, lat0, ctx0, kt0, kt1);
    if (__any(ovf) && F.lane == 0) flag[0] = 1u;
    __syncthreads();
    const bool redo = __builtin_amdgcn_readfirstlane((int)flag[0]) != 0;
    __syncthreads();
    if (redo) { if (F.tid == 0) flag[0] = 0u; (void)attn_run<DQK, true>(F, S, q0, lat0, ctx0, kt0, kt1); }
}

__device__ __forceinline__ int sig5(int c) { return (c & ~12) | ((c & 8) >> 1) | ((c & 4) << 1); }

__global__ void __launch_bounds__(512, 2) mk_fwd(Args args) {
    extern __shared__ __attribute__((aligned(16))) unsigned char lds_raw[];
    Frame F;
    F.lds = (LAS unsigned char*)lds_raw; F.ws = args.ws;
    F.tid = threadIdx.x; F.lane = F.tid & 63; F.wave = __builtin_amdgcn_readfirstlane(F.tid >> 6);
    F.G = gridDim.x; { const int bx = blockIdx.x; F.vcu = (F.G % 8 == 0) ? (bx % 8) * (F.G / 8) + bx / 8 : bx; }
    volatile LAS unsigned* MISC = (volatile LAS unsigned*)(F.lds + LDSCTL_OFF);
    if (F.tid < 64) MISC[F.tid] = 0u;
    __syncthreads();
    unsigned* ctl = wsp<unsigned>(F, O_CTL);
#if MK_ONE_LAUNCH
    XcdBarrier bar = xcd_barrier_post(ctl + CW_BAR, MISC + 8);
#define GRID_BAR() xcd_barrier(bar)
#else
#define GRID_BAR() do {} while (0)
#endif
    const int lo = args.ph_lo, hi_ph = args.ph_hi;
#define IN(k) (lo <= (k) && (k) < hi_ph)
#define SEAM(k) do { if (IN(k) && IN((k) + 1)) GRID_BAR(); } while (0)
    const int lane = F.lane, wave = F.wave, tid = F.tid;
    const int gw = F.vcu * 8 + wave, NGW = F.G * 8;

    const float* x_in = args.in[I_X]; const float* ctx_in = args.in[I_CTX];
    float* MODV = wsp<float>(F, O_MODV);
    float* TAB16 = wsp<float>(F, O_TAB16); float* TAB32 = wsp<float>(F, O_TAB32);
    float* HC = wsp<float>(F, O_HC);
    bf16_t* U = wsp<bf16_t>(F, O_U);
    float* Y = wsp<float>(F, O_Y);
    const float* normg = args.in[I_NORMG];
#define MV(layer, bidx, k) (MODV + ((size_t)((layer) * 5 + (bidx)) * 6 + (k)) * D)

    if (IN(0)) {
        {
            LAS float* sc = (LAS float*)F.lds;
            LAS float* red = sc + 5 * 1024;
            for (int i = tid; i < 5 * 1024; i += 512) { const int b = i >> 10, k = i & 1023; const float cv = (b < 4) ? args.in[I_C][b * 1024 + k] : args.in[I_CCTX][k]; sc[i] = cv / (1.0f + __expf(-cv)); }
            __syncthreads();
            for (int unit = F.vcu; unit < 192; unit += F.G) {
                const int layer = unit / 96, cb = unit % 96, col = cb * 64 + lane;
                const float* W = args.in[I_MODW] + (size_t)layer * D * 6144 + col;
                float a0 = 0.f, a1 = 0.f, a2 = 0.f, a3 = 0.f, a4 = 0.f;
#pragma unroll 16
                for (int kk = 0; kk < 128; ++kk) { const int k = wave * 128 + kk; const float w = W[(size_t)k * 6144];
                    a0 += sc[k] * w; a1 += sc[1024 + k] * w; a2 += sc[2048 + k] * w; a3 += sc[3072 + k] * w; a4 += sc[4096 + k] * w; }
                red[(wave * 5 + 0) * 64 + lane] = a0; red[(wave * 5 + 1) * 64 + lane] = a1; red[(wave * 5 + 2) * 64 + lane] = a2; red[(wave * 5 + 3) * 64 + lane] = a3; red[(wave * 5 + 4) * 64 + lane] = a4;
                __syncthreads();
                if (tid < 320) { const int b = tid >> 6, cc = tid & 63; float s = 0.f;
#pragma unroll
                    for (int w = 0; w < 8; ++w) s += red[(w * 5 + b) * 64 + cc];
                    MODV[(size_t)(layer * 5 + b) * 6144 + cb * 64 + cc] = s + args.in[I_MODB][layer * 6144 + cb * 64 + cc]; }
                __syncthreads();
            }
        }
        if (blockIdx.x == 0) {
            for (int i = tid; i < 64 * 8; i += 512) { const int pos = i >> 3, f = i & 7; const float fr = powf(10000.0f, -(float)f / 8.0f), a = (float)pos * fr; TAB16[i] = cosf(a); TAB16[512 + i] = sinf(a); }
            for (int i = tid; i < 64 * 16; i += 512) { const int pos = i >> 4, f = i & 15; const float fr = powf(10000.0f, -(float)f / 16.0f), a = (float)pos * fr; TAB32[i] = cosf(a); TAB32[1024 + i] = sinf(a); }
        }
        {
            LAS float* scr = (LAS float*)(F.lds + wave * 16640);
            int base = 0;
            auto run = [&](const Conv& c) { const int n = (c.K / 64) * (c.Ndst / 32); for (int it = gw - base; it < n; it += NGW) { if (it >= 0) conv_item(c, it, scr, lane); }
                base = (base + n) % NGW; };
            auto run64 = [&](const Conv64& c) { conv64_run(c, scr, lane, gw, NGW, base); };
            run64(Conv64{args.in[I_FWG], args.in[I_FWU], FFN, 1024, N_GU0, wsp<bf16_t>(F, O_WGU0), 3, 0, 0, 64.0f, 1});
            run64(Conv64{args.in[I_FWD], nullptr, 1024, FFN, 1024, wsp<bf16_t>(F, O_WD0), 0, 1024, 0, 1.0f, 0});
            run64(Conv64{args.in[I_GWIN], nullptr, 3104, 1024, N_IN1, wsp<bf16_t>(F, O_WIN1), 0, 3104, 512, 0.08838834764831845f, 0});
            run64(Conv64{args.in[I_GWOUT], nullptr, 1024, 1024, 1024, wsp<bf16_t>(F, O_WOUT1), 0, 1024, 0, 1.0f, 0});
            run64(Conv64{args.in[I_AWOUT], nullptr, 1024, 1024, 1024, wsp<bf16_t>(F, O_WOUT0), 0, 1024, 0, 1.0f, 0});
            run(Conv{args.in[I_AWIN], nullptr, 1440, 1024, N_IN0, wsp<bf16_t>(F, O_WIN0), 1, nullptr});
            run(Conv{args.in[I_AWUQ], nullptr, 768, 384, N_QA, wsp<bf16_t>(F, O_WUQ), 2, args.in[I_AQN]});
            run(Conv{args.in[I_AWUKV], nullptr, 1024, 256, N_KVA, wsp<bf16_t>(F, O_WUKV), 0, args.in[I_AKVN]});
        }
    }
    SEAM(0);

    if (IN(1)) {
        for (int row = gw; row < R; row += NGW) {
            const float* hp = row < RL ? x_in + (size_t)row * D : ctx_in + (size_t)(row - RL) * D;
            f32x4 h[4], uo[4]; load_row(hp, lane, h);
            const int b = row_bidx(row);
            norm_mod_store(h, normg + 0 * D, MV(0, b, 0), MV(0, b, 1), U + (size_t)row * D, lane, uo);
        }
    }
    SEAM(1);

    if (IN(2)) {
        pg8::DenseProb P{U, wsp<bf16_t>(F, O_WIN0), 1024, 1024, 1024, {}}; P.ord.init(R / 256, N_IN0 / 256, F.G, (int)blockIdx.x);
        pg8::EpiBf16 E{wsp<bf16_t>(F, O_Z0), N_IN0, nullptr};
        pg8::gemm_phase(F.lds, P, E);
    }
    SEAM(2);

    if (IN(3)) {
        const bf16_t* Z0 = wsp<bf16_t>(F, O_Z0);
        float* RSQ = wsp<float>(F, O_RSTDQ); float* RSKV = wsp<float>(F, O_RSTDKV);
        bf16_t* QB = wsp<bf16_t>(F, O_QB); bf16_t* KBp = wsp<bf16_t>(F, O_KB); bf16_t* KR = wsp<bf16_t>(F, O_KR);
        const float* qkn = args.in[I_AQKN];
        for (int row = gw; row < R; row += NGW) {
            const unsigned* z32 = (const unsigned*)(Z0 + (size_t)row * N_IN0);
            float s = 0.f;
#pragma unroll
            for (int j = 0; j < 3; ++j) { const unsigned w = z32[lane + 64 * j]; const float a = bflo(w), b = bfhi(w); s += a * a + b * b; }
            s = wave_sum(s);
            float s2 = 0.f;
#pragma unroll
            for (int j = 0; j < 2; ++j) { const unsigned w = z32[192 + lane + 64 * j]; const float a = bflo(w), b = bfhi(w); s2 += a * a + b * b; }
            s2 = wave_sum(s2);
            if (lane == 0) { RSQ[row] = __builtin_amdgcn_rsqf(s * (1.0f / 384.0f) + EPS); RSKV[row] = __builtin_amdgcn_rsqf(s2 * (1.0f / 256.0f) + EPS); }
            const bool lat = row < RL; const int tt = row & (SEQ - 1);
#pragma unroll
            for (int which = 0; which < 2; ++which) {
                if (which == 1 && lane >= 16) break;
                const u32x4 w4 = *(const u32x4*)(Z0 + (size_t)row * N_IN0 + (which ? 1152 : 640) + lane * 8);
                float v[8] = {bflo(w4.x), bfhi(w4.x), bflo(w4.y), bfhi(w4.y), bflo(w4.z), bfhi(w4.z), bflo(w4.w), bfhi(w4.w)};
                float ss = 0.f;
#pragma unroll
                for (int j = 0; j < 8; ++j) ss += v[j] * v[j];
                ss += __shfl_xor(ss, 1); ss += __shfl_xor(ss, 2); ss += __shfl_xor(ss, 4);
                const float rstd = __builtin_amdgcn_rsqf(ss * (1.0f / 64.0f) + EPS);
                const int jp = lane & 7, half = jp >> 2, i0 = 4 * (jp & 3);
                const float* gn = qkn + which * 64 + half * 32;
#pragma unroll
                for (int pz = 0; pz < 4; ++pz) { v[2 * pz] *= rstd * gn[i0 + pz]; v[2 * pz + 1] *= rstd * gn[16 + i0 + pz]; }
                if (lat) { const int pos = half ? (tt & 63) : (tt >> 6);
                    const f32x4 cs = *(const f32x4*)(TAB32 + pos * 16 + i0), sn = *(const f32x4*)(TAB32 + 1024 + pos * 16 + i0);
#pragma unroll
                    for (int pz = 0; pz < 4; ++pz) { const float a = v[2 * pz], b = v[2 * pz + 1]; v[2 * pz] = a * cs[pz] - b * sn[pz]; v[2 * pz + 1] = b * cs[pz] + a * sn[pz]; } }
                const float osc = which ? 1.0f : 0.125f * LOG2E;
                u32x4 o; o.x = cvtpk(v[0] * osc, v[1] * osc); o.y = cvtpk(v[2] * osc, v[3] * osc); o.z = cvtpk(v[4] * osc, v[5] * osc); o.w = cvtpk(v[6] * osc, v[7] * osc);
                if (which == 0) *(u32x4*)(QB + (size_t)row * 512 + lane * 8) = o; else *(u32x4*)(KBp + (size_t)row * 128 + lane * 8) = o;
            }
            if (lane < 4) {
                const u32x4 w4 = *(const u32x4*)(Z0 + (size_t)row * N_IN0 + 1408 + lane * 8);
                float v[8] = {bflo(w4.x), bfhi(w4.x), bflo(w4.y), bfhi(w4.y), bflo(w4.z), bfhi(w4.z), bflo(w4.w), bfhi(w4.w)};
                if (lat) { const int half = lane >> 1, i0 = 4 * (lane & 1); const int pos = half ? (tt & 63) : (tt >> 6);
                    const f32x4 cs = *(const f32x4*)(TAB16 + pos * 8 + i0), sn = *(const f32x4*)(TAB16 + 512 + pos * 8 + i0);
#pragma unroll
                    for (int pz = 0; pz < 4; ++pz) { const float a = v[2 * pz], b = v[2 * pz + 1]; v[2 * pz] = a * cs[pz] - b * sn[pz]; v[2 * pz + 1] = b * cs[pz] + a * sn[pz]; } }
                u32x4 o; o.x = cvtpk(v[0], v[1]); o.y = cvtpk(v[2], v[3]); o.z = cvtpk(v[4], v[5]); o.w = cvtpk(v[6], v[7]);
                *(u32x4*)(KR + (size_t)row * 32 + lane * 8) = o;
            }
        }
    }
    SEAM(3);

    if (IN(4)) {
        { pg8::DenseProb P{wsp<bf16_t>(F, O_Z0), wsp<bf16_t>(F, O_WUQ), 384, N_IN0, 384, {}}; P.ord.init(R / 256, N_QA / 256, F.G, (int)blockIdx.x);
          pg8::EpiQA E{wsp<bf16_t>(F, O_QA), wsp<float>(F, O_RSTDQ), TAB16, 0.10206207261596577f * LOG2E};
          pg8::gemm_phase(F.lds, P, E); }
        { pg8::DenseProb P{wsp<bf16_t>(F, O_Z0) + 384, wsp<bf16_t>(F, O_WUKV), 256, N_IN0, 256, {}}; P.ord.init(R / 256, N_KVA / 256, F.G, (int)((blockIdx.x + F.G - (204 % F.G)) % F.G));
          pg8::EpiBf16 E{wsp<bf16_t>(F, O_KVA), N_KVA, wsp<float>(F, O_RSTDKV)};
          pg8::gemm_phase(F.lds, P, E); }
    }
    SEAM(4);

    if (IN(5)) {
        const bf16_t* QA = wsp<bf16_t>(F, O_QA); const bf16_t* KVA = wsp<bf16_t>(F, O_KVA); const bf16_t* QB = wsp<bf16_t>(F, O_QB);
        const bf16_t* KBp = wsp<bf16_t>(F, O_KB); const bf16_t* KR = wsp<bf16_t>(F, O_KR); const bf16_t* Z0 = wsp<bf16_t>(F, O_Z0);
        bf16_t* AO = wsp<bf16_t>(F, O_AO);
        for (int i = 0; i < 3; ++i) {
            int b, hh, q0, kt0, kt1;
            if (i < 2) { const int m = i * 256 + F.vcu; b = m >> 7; hh = (m >> 4) & 7; q0 = b * SEQ + (m & 15) * 256; kt0 = 0; kt1 = 68; }
            else { if (F.vcu >= 32) break; b = (F.vcu >> 3) & 3; hh = F.vcu & 7; q0 = RL + b * CTX; kt0 = 64; kt1 = 68; }
            const int lat0 = b * SEQ, ctx0 = RL + b * CTX;
            AttnSrc<96> S{QA + hh * 64, N_QA, QA + 512 + hh * 32, KVA + hh * 128, N_KVA, KR, 32, KVA + hh * 128 + 64, N_KVA, AO + hh * 64, D};
            attn_unit<96>(F, S, q0, lat0, ctx0, kt0, kt1);
        }
        for (int i = 0; i < 3; ++i) {
            int b, hh, q0, kt0, kt1;
            if (i < 2) { const int m = i * 256 + F.vcu; b = m >> 7; hh = (m >> 4) & 7; q0 = b * SEQ + (m & 15) * 256; kt0 = 0; kt1 = 68; }
            else { if (F.vcu < 32 || F.vcu >= 64) break; b = (F.vcu >> 3) & 3; hh = F.vcu & 7; q0 = RL + b * CTX; kt0 = 64; kt1 = 68; }
            const int lat0 = b * SEQ, ctx0 = RL + b * CTX; const int kvh = hh >> 2;
            AttnSrc<64> S{QB + hh * 64, 512, nullptr, KBp + kvh * 64, 128, nullptr, 0, Z0 + 1280 + kvh * 64, N_IN0, AO + 512 + hh * 64, D};
            attn_unit<64>(F, S, q0, lat0, ctx0, kt0, kt1);
        }
    }
    SEAM(5);

    if (IN(6)) {
        pg8::DenseProb P{wsp<bf16_t>(F, O_AO), wsp<bf16_t>(F, O_WOUT0), 1024, 1024, 1024, {}}; P.ord.init(RL / 256, 4, F.G, (int)blockIdx.x);
        pg8::EpiBf16 E{(bf16_t*)Y, D, nullptr};
        pg8::gemm_phase(F.lds, P, E);
    }
    SEAM(6);


    auto post0 = [&](int row) {
            const float* hp = row < RL ? x_in + (size_t)row * D : ctx_in + (size_t)(row - RL) * D;
            float* ho = row < RL ? args.out + (size_t)row * D : HC + (size_t)(row - RL) * D;
            const int b = row_bidx(row);
            f32x4 y[4], h[4], uo[4]; load_row_bf16((const bf16_t*)Y + (size_t)row * D, lane, y); load_row(hp, lane, h);
            const float rstd = __builtin_amdgcn_rsqf(row_ssq(y) * (1.0f / D) + EPS);
#pragma unroll
            for (int j = 0; j < 4; ++j) { const int c = 4 * lane + 256 * j; const f32x4 g = *(const f32x4*)(normg + 1 * D + c), mg = *(const f32x4*)(MV(0, b, 2) + c);
                h[j] = h[j] + mg * (y[j] * rstd * g); *(f32x4*)(ho + c) = h[j]; }
            norm_mod_store(h, normg + 2 * D, MV(0, b, 3), MV(0, b, 4), nullptr, lane, uo, wsp<unsigned char>(F, O_U) + (size_t)row * D);
    };
    if (IN(7)) {
        const bool split = F.G > 32;
        if (!split || blockIdx.x < 16) {
            pg8::DenseProb P{wsp<bf16_t>(F, O_AO) + (size_t)RL * D, wsp<bf16_t>(F, O_WOUT0), 1024, 1024, 1024, {}}; P.ord.init(RC / 256, 4, split ? 16 : F.G, (int)blockIdx.x);
            pg8::EpiBf16 E{(bf16_t*)Y + (size_t)RL * D, D, nullptr};
            pg8::gemm_phase(F.lds, P, E);
        }
        if (!split) { for (int row = gw; row < RL; row += NGW) post0(row); }
        else if (blockIdx.x >= 16) { for (int row = ((int)blockIdx.x - 16) * 8 + wave; row < RL; row += (F.G - 16) * 8) post0(row); }
    }
    SEAM(7);
    if (IN(8)) { for (int row = RL + gw; row < R; row += NGW) post0(row); }
    SEAM(8);


    if (IN(9)) {
        pg8::DenseProb8<125, 121> P{wsp<unsigned char>(F, O_U), wsp<unsigned char>(F, O_WGU0), 512, 512, 1024, {}}; P.ord.init(R / 256, N_GU0 / 256, F.G, (int)blockIdx.x);
        pg8::EpiSwiglu E{wsp<bf16_t>(F, O_H0), FFN};
        pg8::gemm_phase(F.lds, P, E);
    }
    SEAM(9);
    if (IN(10)) {
        pg8::DenseProb P{wsp<bf16_t>(F, O_H0), wsp<bf16_t>(F, O_WD0), FFN, FFN, FFN, {}}; P.ord.init(RL / 256, 4, F.G, (int)blockIdx.x);
        pg8::EpiBf16 E{(bf16_t*)Y, D, nullptr};
        pg8::gemm_phase(F.lds, P, E);
    }
    SEAM(10);


    auto post1 = [&](int row) {
            float* hp = row < RL ? args.out + (size_t)row * D : HC + (size_t)(row - RL) * D;
            const int b = row_bidx(row);
            f32x4 y[4], h[4], uo[4]; load_row_bf16((const bf16_t*)Y + (size_t)row * D, lane, y); load_row(hp, lane, h);
            const float rstd = __builtin_amdgcn_rsqf(row_ssq(y) * (1.0f / D) + EPS);
#pragma unroll
            for (int j = 0; j < 4; ++j) { const int c = 4 * lane + 256 * j; const f32x4 g = *(const f32x4*)(normg + 3 * D + c), mg = *(const f32x4*)(MV(0, b, 5) + c);
                h[j] = h[j] + mg * (y[j] * rstd * g); *(f32x4*)(hp + c) = h[j]; }
            norm_mod_store(h, normg + 4 * D, MV(1, b, 0), MV(1, b, 1), U + (size_t)row * D, lane, uo);
    };
    if (IN(11)) {
        const bool split = F.G > 32;
        if (!split || blockIdx.x < 16) {
            pg8::DenseProb P{wsp<bf16_t>(F, O_H0) + (size_t)RL * FFN, wsp<bf16_t>(F, O_WD0), FFN, FFN, FFN, {}}; P.ord.init(RC / 256, 4, split ? 16 : F.G, (int)blockIdx.x);
            pg8::EpiBf16 E{(bf16_t*)Y + (size_t)RL * D, D, nullptr};
            pg8::gemm_phase(F.lds, P, E);
        }
        if (!split) { for (int row = gw; row < RL; row += NGW) post1(row); }
        else if (blockIdx.x >= 16) { for (int row = ((int)blockIdx.x - 16) * 8 + wave; row < RL; row += (F.G - 16) * 8) post1(row); }
    }
    SEAM(11);
    if (IN(12)) { for (int row = RL + gw; row < R; row += NGW) post1(row); }
    SEAM(12);


    if (IN(13)) {
        pg8::DenseProb P{U, wsp<bf16_t>(F, O_WIN1), 1024, 1024, 1024, {}}; P.ord.init(R / 256, N_IN1 / 256, F.G, (int)blockIdx.x);
        pg8::EpiIn1 E{wsp<bf16_t>(F, O_QK1), wsp<bf16_t>(F, O_V1), wsp<bf16_t>(F, O_G1), wsp<bf16_t>(F, O_RR)};
        pg8::gemm_phase(F.lds, P, E);
    }
    SEAM(13);

    if (IN(14)) {
        const bf16_t* QK1 = wsp<bf16_t>(F, O_QK1); const bf16_t* V1 = wsp<bf16_t>(F, O_V1); const bf16_t* RRp = wsp<bf16_t>(F, O_RR);
        bf16_t* QDd[2] = {wsp<bf16_t>(F, O_QDF), wsp<bf16_t>(F, O_QDB)}; bf16_t* KId[2] = {wsp<bf16_t>(F, O_KIF), wsp<bf16_t>(F, O_KIB)}; bf16_t* KTd[2] = {wsp<bf16_t>(F, O_KTF), wsp<bf16_t>(F, O_KTB)};
        bf16_t* VT = wsp<bf16_t>(F, O_VT); float* ECL = wsp<float>(F, O_ECL);
        LAS float* tot = (LAS float*)F.lds;
        LAS unsigned* rrs = (LAS unsigned*)(F.lds + 16384);
        const int dkp = tid & 63, dk0 = 2 * dkp, tq = tid >> 6;
        const int dv = tid & 255, th = tid >> 8;
        float w2[2][16][2], bg[2][2];
        unsigned rrw = 0, qw[4], kw[4], vv[16];
        auto loadp = [&](int item) {
            const int rc = item >> 2, hh = item & 3, row0 = rc * 32;
            rrw = ((const unsigned*)(RRp + (size_t)(row0 + (tid >> 4)) * 256))[tid & 15];
#pragma unroll
            for (int i = 0; i < 4; ++i) { const int row = row0 + 4 * tq + i;
                qw[i] = *(const unsigned*)(QK1 + (size_t)row * D + hh * 128 + dk0); kw[i] = *(const unsigned*)(QK1 + (size_t)row * D + 512 + hh * 128 + dk0); }
#pragma unroll
            for (int i = 0; i < 16; ++i) vv[i] = V1[(size_t)(row0 + 16 * th + i) * D + hh * 256 + dv];
        };
        unsigned pq[4][2], pk[4][2], pvw[8]; float pe[4]; int prev = -1;
        auto store_prev = [&]() {
            const int rc = prev >> 2, hh = prev & 3, row0 = rc * 32;
            const int pc = hh * 128 + (dk0 & ~31) + sig5(dk0 & 31);
#pragma unroll
            for (int i = 0; i < 4; ++i) { const int row = row0 + 4 * tq + i;
#pragma unroll
                for (int d = 0; d < 2; ++d) { *(unsigned*)(QDd[d] + (size_t)row * 512 + pc) = pq[i][d]; *(unsigned*)(KId[d] + (size_t)row * 512 + pc) = pk[i][d]; } }
            if (tq == 0) { *(f32x2_t*)(ECL + ((size_t)(rc * 2 + 0) * 4 + hh) * 256 + dk0) = (f32x2_t){pe[0], pe[1]};
                           *(f32x2_t*)(ECL + ((size_t)(rc * 2 + 1) * 4 + hh) * 256 + dk0) = (f32x2_t){pe[2], pe[3]}; }
            bf16_t* vp = VT + ((size_t)rc * 1024 + hh * 256 + dv) * 32 + 16 * th;
            u32x4 o0; o0.x = pvw[0]; o0.y = pvw[1]; o0.z = pvw[2]; o0.w = pvw[3]; *(u32x4*)vp = o0;
            u32x4 o1; o1.x = pvw[4]; o1.y = pvw[5]; o1.z = pvw[6]; o1.w = pvw[7]; *(u32x4*)(vp + 8) = o1;
        };
        auto load_w = [&](int hh) {
#pragma unroll
            for (int d = 0; d < 2; ++d) { const f32x2_t bv = *(const f32x2_t*)(args.in[I_GBGATE] + d * 512 + hh * 128 + dk0); bg[d][0] = bv[0]; bg[d][1] = bv[1];
#pragma unroll
                for (int j = 0; j < 16; ++j) { const f32x2_t wv = *(const f32x2_t*)(args.in[I_GGATE2] + (size_t)(d * 16 + j) * 512 + hh * 128 + dk0); w2[d][j][0] = wv[0]; w2[d][j][1] = wv[1]; } }
        };
        int par = 0;
        auto process = [&](int item) {
            LAS unsigned* rrp = rrs + par * 512; LAS float* totp = tot + par * 2048;
            rrp[tid] = rrw;
            unsigned cq[4], ck[4], cv[16];
#pragma unroll
            for (int i = 0; i < 4; ++i) { cq[i] = qw[i]; ck[i] = kw[i]; }
#pragma unroll
            for (int i = 0; i < 16; ++i) cv[i] = vv[i];
            asm volatile("s_waitcnt lgkmcnt(0)\n\ts_barrier" ::: "memory");
            if (prev >= 0) store_prev();
            if (item + F.G < 544 * 4) loadp(item + F.G);
            float a[2][4][2];
#pragma unroll
            for (int i = 0; i < 4; ++i) {
                const LAS u32x4* rp = (const LAS u32x4*)(rrp + (4 * tq + i) * 16);
#pragma unroll
                for (int d = 0; d < 2; ++d) { const u32x4 r0 = rp[2 * d], r1 = rp[2 * d + 1];
                    const float rv[16] = {bflo(r0.x), bfhi(r0.x), bflo(r0.y), bfhi(r0.y), bflo(r0.z), bfhi(r0.z), bflo(r0.w), bfhi(r0.w), bflo(r1.x), bfhi(r1.x), bflo(r1.y), bfhi(r1.y), bflo(r1.z), bfhi(r1.z), bflo(r1.w), bfhi(r1.w)};
#pragma unroll
                    for (int c = 0; c < 2; ++c) { float z = bg[d][c];
#pragma unroll
                        for (int j = 0; j < 16; ++j) z += rv[j] * w2[d][j][c];
                        a[d][i][c] = (fminf(z, 0.f) - __logf(1.0f + __expf(-fabsf(z)))) * (1.0f / 16.0f); } } }
            float cf[4][2], sb[4][2];
#pragma unroll
            for (int c = 0; c < 2; ++c) { float sfw = 0.f;
#pragma unroll
                for (int i = 0; i < 4; ++i) { sfw += a[0][i][c]; cf[i][c] = sfw; }
                float sbw = 0.f;
#pragma unroll
                for (int i = 3; i >= 0; --i) { sbw += a[1][i][c]; sb[i][c] = sbw; } }
            *(LAS f32x2_t*)(totp + (0 * 8 + tq) * 128 + dk0) = (f32x2_t){cf[3][0], cf[3][1]};
            *(LAS f32x2_t*)(totp + (1 * 8 + tq) * 128 + dk0) = (f32x2_t){sb[0][0], sb[0][1]};
            asm volatile("s_waitcnt lgkmcnt(0)\n\ts_barrier" ::: "memory");
            float offF[2] = {0.f, 0.f}, offB[2] = {0.f, 0.f}, clF[2] = {0.f, 0.f}, clB[2] = {0.f, 0.f};
#pragma unroll
            for (int g = 0; g < 8; ++g) { const f32x2_t tf = *(const LAS f32x2_t*)(totp + (0 * 8 + g) * 128 + dk0), tb = *(const LAS f32x2_t*)(totp + (1 * 8 + g) * 128 + dk0);
#pragma unroll
                for (int c = 0; c < 2; ++c) { clF[c] += tf[c]; clB[c] += tb[c]; if (g < tq) offF[c] += tf[c]; if (g > tq) offB[c] += tb[c]; } }
#pragma unroll
            for (int i = 0; i < 4; ++i) {
                const float q[2] = {bflo(cq[i]), bfhi(cq[i])}, k[2] = {bflo(ck[i]), bfhi(ck[i])};
                float qdv[2][2], kiv[2][2];
#pragma unroll
                for (int c = 0; c < 2; ++c) { const float cF = offF[c] + cf[i][c], cB = offB[c] + sb[i][c];
                    qdv[0][c] = q[c] * __expf(cF); kiv[0][c] = k[c] * __expf(-cF); qdv[1][c] = q[c] * __expf(cB); kiv[1][c] = k[c] * __expf(-cB); }
#pragma unroll
                for (int d = 0; d < 2; ++d) { pq[i][d] = cvtpk(qdv[d][0], qdv[d][1]); pk[i][d] = cvtpk(kiv[d][0], kiv[d][1]); } }
            pe[0] = __expf(clF[0]); pe[1] = __expf(clF[1]); pe[2] = __expf(clB[0]); pe[3] = __expf(clB[1]);
#pragma unroll
            for (int i = 0; i < 16; ++i) { const unsigned bv = cv[i] & 0xffffu; const int cc = sig5(i);
                if (cc & 1) pvw[cc >> 1] |= bv << 16; else pvw[cc >> 1] = bv; }
            prev = item; par ^= 1;
        };
        if (F.vcu < 544 * 4) loadp(F.vcu);
        if ((F.G & 3) == 0) { load_w(F.vcu & 3);
#pragma unroll
            for (int d = 0; d < 2; ++d) { asm volatile("" : "+v"(bg[d][0]), "+v"(bg[d][1]));
#pragma unroll
                for (int j = 0; j < 16; ++j) asm volatile("" : "+v"(w2[d][j][0]), "+v"(w2[d][j][1])); }
            for (int item = F.vcu; item < 544 * 4; item += F.G) process(item); }
        else { for (int item = F.vcu; item < 544 * 4; item += F.G) { load_w(item & 3); process(item); } }
        if (prev >= 0) store_prev();
    }
    SEAM(14);

    if (IN(15)) {
        const int xl = blockIdx.x & 7, jj = blockIdx.x >> 3;
        const bool scan_role = (jj & 1) == 0;
        const int nscan = ((F.G >> 3) + 1) / 2 * 8, nconv = F.G - nscan;
        if ((F.G & 7) == 0 && nconv > 0 && !scan_role) {
            LAS float* scr = (LAS float*)(F.lds + wave * 16640);
            const int cidx = xl * (F.G >> 4) + (jj >> 1); int base = 0; const int gwi = cidx * 8 + wave, ngw = nconv * 8;
            for (int e = 0; e < NEXP; ++e) {
                conv64_run(Conv64{args.in[I_MWG] + (size_t)e * D * EXD, args.in[I_MWU] + (size_t)e * D * EXD, EXD, 1024, N_GU1, wsp<bf16_t>(F, O_WGU1) + (size_t)e * N_GU1 * 1024 / 2, 3, 0, 0, 64.0f, 1}, scr, lane, gwi, ngw, base);
                conv64_run(Conv64{args.in[I_MWD] + (size_t)e * EXD * D, nullptr, 1024, EXD, 1024, wsp<bf16_t>(F, O_WD1) + (size_t)e * 1024 * EXD / 2, 0, 1024, 1024, 64.0f, 1}, scr, lane, gwi, ngw, base);
            }
        } else {
        const bool split = (F.G & 7) == 0 && nconv > 0;
        const int sidx = split ? xl * ((F.G >> 4) + ((F.G >> 3) & 1)) + (jj >> 1) : F.vcu, nsw = split ? nscan : F.G;
        const bf16_t* VT = wsp<bf16_t>(F, O_VT); const float* ECL = wsp<float>(F, O_ECL);
        constexpr int SLOT = 8192 * 2 + 2 * 2048 + 1024;
        const int r32 = lane & 31, hi = lane >> 5;
        for (int unit = sidx; unit < 128; unit += nsw) {
            const int chain = unit >> 2, dvp = unit & 3, b = chain >> 3, hh = (chain >> 1) & 3, dir = chain & 1;
            const int dvb = dvp * 2 + (wave & 1);
            const bf16_t* QDp = wsp<bf16_t>(F, dir ? O_QDB : O_QDF); const bf16_t* KIp = wsp<bf16_t>(F, dir ? O_KIB : O_KIF);
            bf16_t* Odp = wsp<bf16_t>(F, dir ? O_OB : O_OF);
            auto rcof = [&](int step) { return step < 8 ? 512 + b * 8 + (dir ? 7 - step : step) : b * 128 + (dir ? 127 - (step - 8) : (step - 8)); };
            const unsigned lds0 = (unsigned)(size_t)F.lds;
            auto dma = [&](int step, int slot) {
                if (wave < 2) return;
                const int rc = rcof(step); const unsigned sb = lds0 + slot * SLOT;
#pragma unroll
                for (int i = 0; i < 4; ++i) { const int j = (wave - 2) + 6 * i; if (j >= 21) break;
                    if (j < 16) { const int p = j & 7; const int r = 4 * p + (lane >> 4), c = (lane & 15) ^ (r & 15);
                        glds16((j < 8 ? KIp : QDp) + (size_t)(rc * 32 + r) * 512 + hh * 128 + c * 8, (unsigned)__builtin_amdgcn_readfirstlane(sb + j * 1024)); }
                    else if (j < 20) { const int p = j - 16; const int r = 16 * (p & 1) + (lane >> 2), c = (lane & 3) ^ ((r >> 2) & 3);
                        glds16(VT + ((size_t)rc * 1024 + hh * 256 + (dvp * 2 + (p >> 1)) * 32 + r) * 32 + c * 8, (unsigned)__builtin_amdgcn_readfirstlane(sb + 16384 + p * 1024)); }
                    else glds16(ECL + ((size_t)(rc * 2 + dir) * 4 + hh) * 256 + lane * 4, (unsigned)__builtin_amdgcn_readfirstlane(sb + 20480)); }
            };
            auto wait_bar = [&](int ngrp) { if (wave < 2) { asm volatile("s_waitcnt lgkmcnt(0)\n\ts_barrier" ::: "memory"); }
                else if (ngrp == 0) { WAIT_BAR(0); } else if (ngrp == 1) { if (wave < 5) { WAIT_BAR(4); } else { WAIT_BAR(3); } } else { if (wave < 5) { WAIT_BAR(8); } else { WAIT_BAR(6); } } };
            f32x16 S4[4];
#pragma unroll
            for (int k = 0; k < 4; ++k)
#pragma unroll
                for (int r = 0; r < 16; ++r) S4[k][r] = 0.f;
            dma(0, 0); dma(1, 1); dma(2, 2);
            wait_bar(2);
            int slot = 0;
            for (int step = 0; step < 136; ++step) {
                if (step + 3 < 136) dma(step + 3, (slot + 3) & 3);
                if (wave < 2) {
                    const LAS unsigned char* sb = F.lds + slot * SLOT;
                    const int x15 = r32 & 15, x3 = (r32 >> 2) & 3;
                    const int trq = (lane & 15) >> 2, trp = lane & 3, trpp = ((trp & 1) << 1) | (trp >> 1), trg = (lane >> 4) & 1;
                    const LAS unsigned char* vbase = sb + 16384 + wave * 2048;
                    bf16x8 qdF[8], kiF[8];
#pragma unroll
                    for (int k = 0; k < 8; ++k) { qdF[k] = *(const LAS bf16x8*)(sb + 8192 + r32 * 256 + (((2 * k + hi) ^ x15) << 4)); kiF[k] = *(const LAS bf16x8*)(sb + r32 * 256 + (((2 * k + hi) ^ x15) << 4)); }
                    const bf16x8 vF0 = *(const LAS bf16x8*)(vbase + r32 * 64 + ((hi ^ x3) << 4)), vF1 = *(const LAS bf16x8*)(vbase + r32 * 64 + (((2 + hi) ^ x3) << 4));
                    __builtin_amdgcn_sched_barrier(0);
                    f32x16 o;
#pragma unroll
                    for (int r = 0; r < 16; ++r) o[r] = 0.f;
                    if (step >= 8) {
                        f32x16 sc;
#pragma unroll
                        for (int r = 0; r < 16; ++r) sc[r] = 0.f;
#pragma unroll
                        for (int k = 0; k < 8; ++k) sc = __builtin_amdgcn_mfma_f32_32x32x16_bf16(kiF[k], qdF[k], sc, 0, 0, 0);
#pragma unroll
                        for (int r = 0; r < 16; ++r) { const int s = (r & 3) + 8 * (r >> 2) + 4 * hi; const bool keep = dir ? (s >= r32) : (s <= r32); sc[r] = keep ? sc[r] : 0.f; }
                        u32x4 w; bf16x8 pf0, pf1;
                        w.x = cvtpk(sc[0], sc[1]); w.y = cvtpk(sc[2], sc[3]); w.z = cvtpk(sc[4], sc[5]); w.w = cvtpk(sc[6], sc[7]); pf0 = __builtin_bit_cast(bf16x8, w);
                        w.x = cvtpk(sc[8], sc[9]); w.y = cvtpk(sc[10], sc[11]); w.z = cvtpk(sc[12], sc[13]); w.w = cvtpk(sc[14], sc[15]); pf1 = __builtin_bit_cast(bf16x8, w);
                        o = __builtin_amdgcn_mfma_f32_32x32x16_bf16(vF0, pf0, o, 0, 0, 0);
                        o = __builtin_amdgcn_mfma_f32_32x32x16_bf16(vF1, pf1, o, 0, 0, 0);
#pragma unroll
                        for (int blk = 0; blk < 4; ++blk)
#pragma unroll
                            for (int s2 = 0; s2 < 2; ++s2) { u32x4 ws4; ws4.x = cvtpk(S4[blk][8 * s2], S4[blk][8 * s2 + 1]); ws4.y = cvtpk(S4[blk][8 * s2 + 2], S4[blk][8 * s2 + 3]);
                                ws4.z = cvtpk(S4[blk][8 * s2 + 4], S4[blk][8 * s2 + 5]); ws4.w = cvtpk(S4[blk][8 * s2 + 6], S4[blk][8 * s2 + 7]);
                                o = __builtin_amdgcn_mfma_f32_32x32x16_bf16(__builtin_bit_cast(bf16x8, ws4), qdF[2 * blk + s2], o, 0, 0, 0); }
                        const int rc = rcof(step);
                        bf16_t* op = Odp + (size_t)(rc * 32 + r32) * D + hh * 256 + dvb * 32 + 4 * hi;
#pragma unroll
                        for (int g = 0; g < 4; ++g) { u32x2 w2; w2.x = cvtpk(o[4 * g], o[4 * g + 1]); w2.y = cvtpk(o[4 * g + 2], o[4 * g + 3]); *(u32x2*)(op + 8 * g) = w2; }
                    }
#pragma unroll
                    for (int blk = 0; blk < 4; ++blk) {
                        bf16x8 kt0, kt1;
                        { const int chunk = 4 * blk + 2 * trg + (trpp >> 1); const int wb = (trpp & 1) * 8;
                          const int tl = 4 * hi + trq, th = tl + 8;
                          const LAS unsigned char* pl = sb + tl * 256 + ((chunk ^ tl) << 4) + wb; const LAS unsigned char* ph = sb + th * 256 + ((chunk ^ th) << 4) + wb;
                          const s16x4 a0 = vtr(pl), a1 = vtr(ph), b0 = vtr(pl + 4096), b1 = vtr(ph + 4096);
                          kt0 = (bf16x8){a0[0], a0[1], a0[2], a0[3], a1[0], a1[1], a1[2], a1[3]}; kt1 = (bf16x8){b0[0], b0[1], b0[2], b0[3], b1[0], b1[1], b1[2], b1[3]}; }
                        S4[blk] = __builtin_amdgcn_mfma_f32_32x32x16_bf16(kt0, vF0, S4[blk], 0, 0, 0);
                        S4[blk] = __builtin_amdgcn_mfma_f32_32x32x16_bf16(kt1, vF1, S4[blk], 0, 0, 0);
#pragma unroll
                        for (int g = 0; g < 4; ++g) { const f32x4 e4 = *(const LAS f32x4*)(sb + 20480 + (32 * blk + 8 * g + 4 * hi) * 4);
                            S4[blk][4 * g] *= e4[0]; S4[blk][4 * g + 1] *= e4[1]; S4[blk][4 * g + 2] *= e4[2]; S4[blk][4 * g + 3] *= e4[3]; }
                    }
                }
                wait_bar(step + 3 < 136 ? 2 : (step + 2 < 136 ? 1 : 0));
                slot = (slot + 1) & 3;
            }
        }
        if (!split) {
            LAS float* scr = (LAS float*)(F.lds + wave * 16640); int base = 0;
            for (int e = 0; e < NEXP; ++e) {
                conv64_run(Conv64{args.in[I_MWG] + (size_t)e * D * EXD, args.in[I_MWU] + (size_t)e * D * EXD, EXD, 1024, N_GU1, wsp<bf16_t>(F, O_WGU1) + (size_t)e * N_GU1 * 1024 / 2, 3, 0, 0, 64.0f, 1}, scr, lane, gw, NGW, base);
                conv64_run(Conv64{args.in[I_MWD] + (size_t)e * EXD * D, nullptr, 1024, EXD, 1024, wsp<bf16_t>(F, O_WD1) + (size_t)e * 1024 * EXD / 2, 0, 1024, 1024, 64.0f, 1}, scr, lane, gw, NGW, base);
            }
        }
        }
    }
    SEAM(15);

    if (IN(16)) {
        const bf16_t* OFp = wsp<bf16_t>(F, O_OF); const bf16_t* OBp = wsp<bf16_t>(F, O_OB); const bf16_t* G1 = wsp<bf16_t>(F, O_G1); bf16_t* GA = wsp<bf16_t>(F, O_GA);
        const float* on = args.in[I_GONORM];
        for (int row = gw; row < RL; row += NGW) {
            const u32x4* pf = (const u32x4*)(OFp + (size_t)row * D + lane * 16); const u32x4* pb = (const u32x4*)(OBp + (size_t)row * D + lane * 16); const u32x4* pg = (const u32x4*)(G1 + (size_t)row * D + lane * 16);
            float v[16], gv[16];
#pragma unroll
            for (int q = 0; q < 2; ++q) { const u32x4 a = pf[q], bq = pb[q], gq = pg[q]; const unsigned aw[4] = {a.x, a.y, a.z, a.w}, bw[4] = {bq.x, bq.y, bq.z, bq.w}, gw4[4] = {gq.x, gq.y, gq.z, gq.w};
#pragma unroll
                for (int j = 0; j < 4; ++j) { v[8 * q + 2 * j] = bflo(aw[j]) + bflo(bw[j]); v[8 * q + 2 * j + 1] = bfhi(aw[j]) + bfhi(bw[j]); gv[8 * q + 2 * j] = bflo(gw4[j]); gv[8 * q + 2 * j + 1] = bfhi(gw4[j]); } }
            float ss = 0.f;
#pragma unroll
            for (int j = 0; j < 16; ++j) ss += v[j] * v[j];
            ss += __shfl_xor(ss, 1); ss += __shfl_xor(ss, 2); ss += __shfl_xor(ss, 4); ss += __shfl_xor(ss, 8);
            const float rstd = __builtin_amdgcn_rsqf(ss * (1.0f / 256.0f) + EPS);
            const int c0 = (lane & 15) * 16;
            unsigned ow[8];
#pragma unroll
            for (int j = 0; j < 8; ++j) { const float a = v[2 * j] * rstd * on[c0 + 2 * j] * silu_f(gv[2 * j]), bq = v[2 * j + 1] * rstd * on[c0 + 2 * j + 1] * silu_f(gv[2 * j + 1]); ow[j] = cvtpk(a, bq); }
            u32x4* po = (u32x4*)(GA + (size_t)row * D + lane * 16);
            u32x4 o0; o0.x = ow[0]; o0.y = ow[1]; o0.z = ow[2]; o0.w = ow[3]; po[0] = o0; u32x4 o1; o1.x = ow[4]; o1.y = ow[5]; o1.z = ow[6]; o1.w = ow[7]; po[1] = o1;
        }
    }
    SEAM(16);

    if (IN(17)) {
        pg8::DenseProb P{wsp<bf16_t>(F, O_GA), wsp<bf16_t>(F, O_WOUT1), 1024, 1024, 1024, {}}; P.ord.init(RL / 256, 4, F.G, (int)blockIdx.x);
        pg8::EpiBf16 E{(bf16_t*)Y, D, nullptr};
        pg8::gemm_phase(F.lds, P, E);
    }
    SEAM(17);

    if (IN(18)) {
        int* SEL = wsp<int>(F, O_SEL); int* ROWTOK = wsp<int>(F, O_ROWTOK);
        LAS float* wr_l = (LAS float*)F.lds;
        LAS int* se = (LAS int*)(F.lds + 32768);
        LAS float* sw = (LAS float*)(F.lds + 32768 + 512);
        LAS int* sbase = (LAS int*)(F.lds + 32768 + 1024);
        for (int i = tid; i < 8192; i += 512) wr_l[i] = args.in[I_MROUTER][i];
        __syncthreads();
        for (int tile = F.vcu; tile < RL / 64; tile += F.G) {
            for (int rr = 0; rr < 8; ++rr) {
                const int lr = wave * 8 + rr, row = tile * 64 + lr; const int b = row >> 12;
                float* hp = args.out + (size_t)row * D;
                f32x4 y[4], h[4], uo[4]; load_row_bf16((const bf16_t*)Y + (size_t)row * D, lane, y); load_row(hp, lane, h);
                const float rstd = __builtin_amdgcn_rsqf(row_ssq(y) * (1.0f / D) + EPS);
#pragma unroll
                for (int j = 0; j < 4; ++j) { const int c = 4 * lane + 256 * j; const f32x4 g = *(const f32x4*)(normg + 5 * D + c), mg = *(const f32x4*)(MV(1, b, 2) + c);
                    h[j] = h[j] + mg * (y[j] * rstd * g); *(f32x4*)(hp + c) = h[j]; }
                norm_mod_store(h, normg + 6 * D, MV(1, b, 3), MV(1, b, 4), nullptr, lane, uo, wsp<unsigned char>(F, O_U) + (size_t)row * D);
                float lg[8];
#pragma unroll
                for (int e = 0; e < 8; ++e) lg[e] = 0.f;
#pragma unroll
                for (int j = 0; j < 4; ++j)
#pragma unroll
                    for (int q = 0; q < 4; ++q) { const int k = 4 * lane + 256 * j + q; const LAS f32x4* wp = (const LAS f32x4*)(wr_l + k * 8); const f32x4 w0 = wp[0], w1 = wp[1]; const float uv = uo[j][q];
                        lg[0] += uv * w0[0]; lg[1] += uv * w0[1]; lg[2] += uv * w0[2]; lg[3] += uv * w0[3]; lg[4] += uv * w1[0]; lg[5] += uv * w1[1]; lg[6] += uv * w1[2]; lg[7] += uv * w1[3]; }
#pragma unroll
                for (int e = 0; e < 8; ++e) lg[e] = wave_sum(lg[e]) + args.in[I_MBROUTER][e];
                int e0 = 0; float l0 = lg[0];
#pragma unroll
                for (int e = 1; e < 8; ++e) if (lg[e] > l0) { l0 = lg[e]; e0 = e; }
                int e1 = -1; float l1 = -3.0e38f;
#pragma unroll
                for (int e = 0; e < 8; ++e) if (e != e0 && lg[e] > l1) { l1 = lg[e]; e1 = e; }
                const float p1 = __expf(l1 - l0), w0n = 1.0f / (1.0f + p1), w1n = p1 / (1.0f + p1);
                if (lane == 0) { se[lr * 2] = e0; se[lr * 2 + 1] = e1; sw[lr * 2] = w0n; sw[lr * 2 + 1] = w1n; }
            }
            __syncthreads();
            if (tid < 8) { int c = 0; for (int r2 = 0; r2 < 64; ++r2) c += (se[2 * r2] == tid) + (se[2 * r2 + 1] == tid);
                sbase[tid] = (int)__hip_atomic_fetch_add(ctl + CW_CNT + 64 * tid, (unsigned)c, RLX_AGENT); }
            __syncthreads();
            if (tid < 64) { const int e0 = se[2 * tid], e1 = se[2 * tid + 1]; int r0 = 0, r1 = 0;
                for (int r2 = 0; r2 < tid; ++r2) { const int a0 = se[2 * r2], a1 = se[2 * r2 + 1]; r0 += (a0 == e0) + (a1 == e0); r1 += (a0 == e1) + (a1 == e1); }
                const int p0 = sbase[e0] + r0, p1 = sbase[e1] + r1, tok = tile * 64 + tid;
                ROWTOK[e0 * CAPE + p0] = tok; ROWTOK[e1 * CAPE + p1] = tok;
                int* sp = SEL + (size_t)tok * 8; sp[0] = e0; sp[1] = p0; sp[2] = e1; sp[3] = p1; sp[4] = __float_as_int(sw[2 * tid]); sp[5] = __float_as_int(sw[2 * tid + 1]); }
            __syncthreads();
        }
    }
    SEAM(18);

    pg8::MoeTiles MT;
    if (IN(19) || IN(20) || IN(21)) {
        int acc = 0; MT.tp8 = 0ull; MT.c4a = 0ull; MT.c4b = 0ull;
#pragma unroll
        for (int e = 0; e < 8; ++e) { const int c = (int)__builtin_amdgcn_readfirstlane((int)__hip_atomic_load(ctl + CW_CNT + 64 * e, RLX_AGENT));
            if (e < 4) MT.c4a |= (unsigned long long)(unsigned)c << (16 * e); else MT.c4b |= (unsigned long long)(unsigned)c << (16 * (e - 4));
            MT.tp8 |= (unsigned long long)(unsigned)acc << (8 * e); acc += (c + 255) >> 8; }
        MT.nt = acc;
    }
    if (IN(19)) {
        pg8::MoeGuProb P{wsp<unsigned char>(F, O_U), wsp<unsigned char>(F, O_WGU1), 512, 512, {}, MT, wsp<int>(F, O_ROWTOK)}; P.ord.init(MT.nt, N_GU1 / 256, F.G, (int)blockIdx.x);
        pg8::EpiSwiglu8 E{wsp<unsigned char>(F, O_HM), EXD};
        pg8::gemm_phase(F.lds, P, E);
    }
    SEAM(19);
    if (IN(20)) {
        pg8::MoeDnProb P{wsp<unsigned char>(F, O_HM), wsp<unsigned char>(F, O_WD1), EXD / 2, EXD / 2, {}, MT}; P.ord.init(MT.nt, 4, F.G, (int)blockIdx.x);
        pg8::EpiBf16 E{wsp<bf16_t>(F, O_YE), D, nullptr};
        pg8::gemm_phase(F.lds, P, E);
    }
    SEAM(20);
    if (IN(21)) {
        const int* SEL = wsp<int>(F, O_SEL); const bf16_t* YE = wsp<bf16_t>(F, O_YE);
        for (int row = gw; row < RL; row += NGW) {
            const int b = row >> 12; const int* sp = SEL + (size_t)row * 8;
            const int e0 = sp[0], p0 = sp[1], e1 = sp[2], p1 = sp[3]; const float w0 = __int_as_float(sp[4]), w1 = __int_as_float(sp[5]);
            const int t0 = pg8::moe_tp(MT, e0), t1 = pg8::moe_tp(MT, e1);
            const bf16_t* y0 = YE + ((size_t)t0 * 256 + p0) * D; const bf16_t* y1 = YE + ((size_t)t1 * 256 + p1) * D;
            float* hp = args.out + (size_t)row * D;
            f32x4 y[4], h[4]; load_row(hp, lane, h);
#pragma unroll
            for (int j = 0; j < 4; ++j) { const int c = 4 * lane + 256 * j; const u32x2 a = *(const u32x2*)(y0 + c), bq = *(const u32x2*)(y1 + c);
                y[j][0] = w0 * bflo(a.x) + w1 * bflo(bq.x); y[j][1] = w0 * bfhi(a.x) + w1 * bfhi(bq.x); y[j][2] = w0 * bflo(a.y) + w1 * bflo(bq.y); y[j][3] = w0 * bfhi(a.y) + w1 * bfhi(bq.y); }
            const float rstd = __builtin_amdgcn_rsqf(row_ssq(y) * (1.0f / D) + EPS);
#pragma unroll
            for (int j = 0; j < 4; ++j) { const int c = 4 * lane + 256 * j; const f32x4 g = *(const f32x4*)(normg + 7 * D + c), mg = *(const f32x4*)(MV(1, b, 5) + c);
                *(f32x4*)(hp + c) = h[j] + mg * (y[j] * rstd * g); }
        }
    }
#undef IN
#undef SEAM
#undef MV
}

constexpr int N_PHASES = 22;
extern "C" void kernel_launch(void* const* d_in, const int* in_sizes, int n_in, void* d_out, int out_size, void* d_ws, size_t ws_size, hipStream_t stream) {
    static int grid = 0;
    if (grid == 0) {
        if (n_in != 27 || out_size != RL * D || ws_size < WS_END) { fprintf(stderr, "kernel_launch: unexpected shapes n_in %d out %d ws %zu (need %zu)\n", n_in, out_size, ws_size, (size_t)WS_END); grid = -1; return; }
        int dev = 0, cus = 0, per_cu = 0;
        if (hipGetDevice(&dev) != hipSuccess || hipDeviceGetAttribute(&cus, hipDeviceAttributeMultiprocessorCount, dev) != hipSuccess) { grid = -1; return; }
        if (hipFuncSetAttribute((const void*)mk_fwd, hipFuncAttributeMaxDynamicSharedMemorySize, LDS_BYTES) != hipSuccess) { fprintf(stderr, "kernel_launch: hipFuncSetAttribute failed\n"); grid = -1; return; }
        if (hipOccupancyMaxActiveBlocksPerMultiprocessor(&per_cu, (const void*)mk_fwd, 512, LDS_BYTES) != hipSuccess || per_cu < 1) { fprintf(stderr, "kernel_launch: occupancy query says %d\n", per_cu); }
        (void)hipGetLastError();
        grid = cus;
        if (grid > 256) grid = 256;
    }
    if (grid < 0) return;
    (void)hipMemsetAsync((char*)d_ws + O_CTL, 0, CTL_BYTES, stream);
    Args a{};
    for (int i = 0; i < 27; ++i) a.in[i] = (const float*)d_in[i];
    a.out = (float*)d_out; a.ws = (unsigned char*)d_ws;
#if MK_ONE_LAUNCH
    a.ph_lo = 0; a.ph_hi = N_PHASES;
    hipLaunchKernelGGL(mk_fwd, dim3(grid), dim3(512), LDS_BYTES, stream, a);
#else
    for (int p = 0; p < N_PHASES; ++p) { a.ph_lo = p; a.ph_hi = p + 1; for (int rep = 0; rep < (p == MK_REP ? 2 : 1); ++rep) hipLaunchKernelGGL(mk_fwd, dim3(grid), dim3(512), LDS_BYTES, stream, a); }
#endif
}
```

```cpp
#include <hip/hip_runtime.h>
#include <cstdio>
#include <cstdint>

#ifndef MK_ONE_LAUNCH
#define MK_ONE_LAUNCH 1
#endif
#ifndef MK_EPI2
#define MK_EPI2 0
#endif
#ifndef MK_REP
#define MK_REP -1
#endif

#define LAS __attribute__((address_space(3)))
#define GAS __attribute__((address_space(1)))
typedef unsigned short bf16_t;
typedef short bf16x8 __attribute__((ext_vector_type(8)));
typedef short s16x4 __attribute__((ext_vector_type(4)));
typedef float f32x4 __attribute__((ext_vector_type(4)));
typedef float f32x16 __attribute__((ext_vector_type(16)));
typedef unsigned u32x4 __attribute__((ext_vector_type(4)));
typedef unsigned u32x2 __attribute__((ext_vector_type(2)));
typedef float f32x2_t __attribute__((ext_vector_type(2)));
typedef __bf16 bf16x2_t __attribute__((ext_vector_type(2)));
#define RLX_AGENT __ATOMIC_RELAXED, __HIP_MEMORY_SCOPE_AGENT

__device__ __forceinline__ unsigned cvtpk(float lo, float hi) { f32x2_t v = {lo, hi}; bf16x2_t b = __builtin_convertvector(v, bf16x2_t); return __builtin_bit_cast(unsigned, b); }
__device__ __forceinline__ bf16_t f2bf(float f) { return (bf16_t)(cvtpk(f, 0.f) & 0xffffu); }
__device__ __forceinline__ float bflo(unsigned w) { return __uint_as_float(w << 16); }
__device__ __forceinline__ float bfhi(unsigned w) { return __uint_as_float(w & 0xffff0000u); }
__device__ __forceinline__ float bf2f(bf16_t b) { return __uint_as_float(((unsigned)b) << 16); }
template <int CTRL> __device__ __forceinline__ float dpp_f(float v) { return __builtin_bit_cast(float, __builtin_amdgcn_update_dpp(0, __builtin_bit_cast(int, v), CTRL, 0xF, 0xF, true)); }
__device__ __forceinline__ float quad_sum(float v) { v += dpp_f<0xB1>(v); v += dpp_f<0x4E>(v); return v; }
__device__ __forceinline__ float oct_sum(float v) { v = quad_sum(v); v += dpp_f<0x141>(v); return v; }
__device__ __forceinline__ float row_sum(float v) { v = quad_sum(v); v += dpp_f<0x124>(v); v += dpp_f<0x128>(v); return v; }
__device__ __forceinline__ float wave_sum(float v) {
    v = row_sum(v);
    const auto rr = __builtin_amdgcn_permlane32_swap(__float_as_uint(v), __float_as_uint(v), false, false);
    v = __uint_as_float(rr[0]) + __uint_as_float(rr[1]);
    return __uint_as_float(__builtin_amdgcn_readlane(__float_as_uint(v), 0)) + __uint_as_float(__builtin_amdgcn_readlane(__float_as_uint(v), 16));
}
__device__ __forceinline__ float fast_exp(float x) { return __builtin_amdgcn_exp2f(x * 1.4426950408889634f); }
__device__ __forceinline__ float clamp8(float x) { return __builtin_amdgcn_fmed3f(x, -448.0f, 448.0f); }
__device__ __forceinline__ unsigned pack_fp8x4(float a, float b, float c, float d) { int w = __builtin_amdgcn_cvt_pk_fp8_f32(clamp8(a), clamp8(b), 0, false); w = __builtin_amdgcn_cvt_pk_fp8_f32(clamp8(c), clamp8(d), w, true); return (unsigned)w; }
__device__ __forceinline__ float swiglu_f(float gp, float up, float k) { return (gp * up) * __builtin_amdgcn_rcpf(__builtin_fmaf(__builtin_amdgcn_exp2f(gp), k, k)); }
__device__ __forceinline__ float silu_f(float g) { return g * __builtin_amdgcn_rcpf(1.0f + fast_exp(-g)); }

#define XB_TMO      128
#define XB_XCNT(j)  (256  + 64 * (j))
#define XB_XSUB(j)  (1280 + 64 * (j))
#define XB_XGEN(j)  (2304 + 64 * (j))
#define XB_TOP      3328
#define XB_TOPGEN   3392
#define XCD_BAR_WORDS 3456
#define XB_SPIN_CAP (1u << 18)
__device__ __forceinline__ unsigned xb_ld(unsigned* p)              { return __hip_atomic_load(p, __ATOMIC_RELAXED, __HIP_MEMORY_SCOPE_AGENT); }
__device__ __forceinline__ unsigned xb_add(unsigned* p, unsigned v) { return __hip_atomic_fetch_add(p, v, __ATOMIC_RELAXED, __HIP_MEMORY_SCOPE_AGENT); }
__device__ __forceinline__ unsigned xb_xcc_id() { return (unsigned)__builtin_amdgcn_s_getreg((3 << 11) | 20) & 0xFu; }
#define XB_SPIN(cond, bar) do { unsigned _sp = 0; while (cond) { __builtin_amdgcn_s_sleep(1); \
    if ((++_sp & 255u) == 0u) { if (xb_ld(&(bar)[XB_TMO])) break; if (_sp > XB_SPIN_CAP) { atomicAdd(&(bar)[XB_TMO], 1u); break; } } } } while (0)
struct XcdBarrier { unsigned* bar; unsigned x; volatile LAS unsigned* st; };
__device__ __forceinline__ XcdBarrier xcd_barrier_post(unsigned* bar, volatile LAS unsigned* st) {
    XcdBarrier b; b.bar = bar; b.x = xb_xcc_id(); b.st = st;
    if (threadIdx.x == 0) (void)xb_add(&bar[XB_XCNT(b.x)], 1u);
    return b;
}
__device__ __forceinline__ void xcd_barrier_complete(unsigned* bar, unsigned x, unsigned& nloc, unsigned& nx) {
    const unsigned G = gridDim.x * gridDim.y * gridDim.z;
    unsigned sum, cnt, mine, sp = 0u;
    for (;;) {
        sum = 0u; cnt = 0u; mine = 0u;
#pragma unroll
        for (unsigned j = 0; j < 16; ++j) { const unsigned c = xb_ld(&bar[XB_XCNT(j)]); sum += c; cnt += (c > 0u) ? 1u : 0u; mine = (j == x) ? c : mine; }
        if (sum == G) break;
        __builtin_amdgcn_s_sleep(1);
        if ((++sp & 255u) == 0u) { if (xb_ld(&bar[XB_TMO])) break; if (sp > XB_SPIN_CAP) { atomicAdd(&bar[XB_TMO], 1u); break; } }
    }
    nloc = mine > 0u ? mine : 1u; nx = cnt > 0u ? cnt : 1u;
}
__device__ __forceinline__ void xcd_barrier(const XcdBarrier& b) {
    asm volatile("s_waitcnt vmcnt(0)" ::: "memory");
    __syncthreads();
    if (threadIdx.x == 0) {
        unsigned* bar = b.bar;
        __builtin_amdgcn_s_waitcnt(0);
        unsigned nloc = b.st[0], nx = b.st[1];
        if (nloc == 0u) { xcd_barrier_complete(bar, b.x, nloc, nx); b.st[0] = nloc; b.st[1] = nx; }
        const unsigned old = xb_add(&bar[XB_XSUB(b.x)], 1u);
        const unsigned gen = old / nloc;
        if (old + 1u == (gen + 1u) * nloc) {
            __builtin_amdgcn_fence(__ATOMIC_RELEASE, "agent");
            asm volatile("s_waitcnt vmcnt(0)" ::: "memory");
            const unsigned og = xb_add(&bar[XB_TOP], 1u);
            const unsigned tg = og / nx;
            if (og + 1u == (tg + 1u) * nx) xb_add(&bar[XB_TOPGEN], 1u);
            else XB_SPIN(xb_ld(&bar[XB_TOPGEN]) == tg, bar);
            __builtin_amdgcn_fence(__ATOMIC_ACQUIRE, "agent");
            xb_add(&bar[XB_XGEN(b.x)], 1u);
            asm volatile("s_waitcnt vmcnt(0)" ::: "memory");
        } else {
            XB_SPIN(xb_ld(&bar[XB_XGEN(b.x)]) == gen, bar);
            __builtin_amdgcn_fence(__ATOMIC_ACQUIRE, "agent");
            asm volatile("s_waitcnt vmcnt(0)" ::: "memory");
        }
    }
    __syncthreads();
}

constexpr int D = 1024, NB = 4, SEQ = 4096, CTX = 256;
constexpr int RL = NB * SEQ;
constexpr int RC = NB * CTX;
constexpr int R = RL + RC;
constexpr float EPS = 1e-6f;
constexpr float LOG2E = 1.4426950408889634f;
constexpr int N_IN0 = 1536, N_QA = 768, N_KVA = 1024, FFN = 2816, N_GU0 = 2 * FFN, N_IN1 = 3328, EXD = 3584, N_GU1 = 2 * EXD, NEXP = 8;
constexpr int CAPE = 16384;

constexpr size_t MiB = 1u << 20;
constexpr size_t O_CTL = 0;
constexpr size_t CTL_BYTES = 65536;
constexpr int CW_BAR = 0;
constexpr int CW_CNT = 8192;
constexpr size_t O_MODV = 1 * MiB;
constexpr size_t O_TAB16 = O_MODV + 256 * 1024;
constexpr size_t O_TAB32 = O_TAB16 + 8192;
constexpr size_t O_RSTDQ = O_TAB32 + 16384;
constexpr size_t O_RSTDKV = O_RSTDQ + 81920;
constexpr size_t O_SEL = 2 * MiB;
constexpr size_t O_ROWTOK = 3 * MiB;
constexpr size_t O_WGU1 = 4 * MiB;
constexpr size_t O_YE = O_WGU1;
constexpr size_t O_WD1 = 116 * MiB;
constexpr size_t O_WIN1 = 172 * MiB;
constexpr size_t O_WOUT1 = 179 * MiB;
constexpr size_t O_WIN0 = 181 * MiB;
constexpr size_t O_WUQ = 184 * MiB;
constexpr size_t O_WUKV = 185 * MiB;
constexpr size_t O_WOUT0 = 186 * MiB;
constexpr size_t O_WGU0 = 188 * MiB;
constexpr size_t O_WD0 = 199 * MiB;
constexpr size_t O_HC = 205 * MiB;
constexpr size_t O_U = 209 * MiB;
constexpr size_t O_Y = 243 * MiB;
constexpr size_t O_Z0 = 311 * MiB;
constexpr size_t O_QA = 362 * MiB;
constexpr size_t O_KVA = 388 * MiB;
constexpr size_t O_QB = 422 * MiB;
constexpr size_t O_KB = 439 * MiB;
constexpr size_t O_KR = 444 * MiB;
constexpr size_t O_AO = 446 * MiB;
constexpr size_t O_H0 = 311 * MiB;
constexpr size_t O_QK1 = 311 * MiB;
constexpr size_t O_V1 = 345 * MiB;
constexpr size_t O_G1 = 379 * MiB;
constexpr size_t O_RR = 413 * MiB;
constexpr size_t O_QDF = 422 * MiB, O_KIF = 439 * MiB, O_KTF = 456 * MiB, O_QDB = 473 * MiB;
constexpr size_t O_KIB = 243 * MiB, O_KTB = 260 * MiB, O_VT = 277 * MiB;
constexpr size_t O_ECL = 490 * MiB;
constexpr size_t O_OF = O_QK1, O_OB = O_VT;
constexpr size_t O_GA = O_QDF;
constexpr size_t O_HM = 243 * MiB;
constexpr size_t WS_END = 495 * MiB;
static_assert(O_HM + (size_t)34816 * EXD * 2 <= 482 * MiB, "HM");
static_assert(O_RR + (size_t)R * 256 * 2 <= O_QDF, "RR");
static_assert(O_ECL + (size_t)544 * 8 * 1024 <= WS_END, "ECL");

constexpr int RING_BYTES = 131072;
constexpr int LDS_BYTES = 163840;
constexpr int LDSCTL_OFF = LDS_BYTES - 256;

struct Args {
    const float* in[27];
    float* out; unsigned char* ws;
    int ph_lo, ph_hi;
};
enum { I_X = 0, I_C, I_CTX, I_CCTX, I_MODW, I_MODB, I_NORMG, I_AWIN, I_AQN, I_AWUQ, I_AKVN, I_AWUKV, I_AQKN, I_AWOUT, I_GWIN, I_GGATE2, I_GBGATE, I_GONORM, I_GWOUT,
       I_FWG, I_FWU, I_FWD, I_MROUTER, I_MBROUTER, I_MWG, I_MWU, I_MWD };

struct Conv { const float* s0; const float* s1; int Nsrc; int K; int Ndst; bf16_t* dst; int mode; const float* kscale; };
__device__ __forceinline__ int ilv64(int p) { return (p >> 5) * 32 + (p & 1) * 16 + ((p & 31) >> 1); }
__device__ __forceinline__ int ilv32(int p) { return (p >> 4) * 16 + (p & 1) * 8 + ((p & 15) >> 1); }
__device__ __forceinline__ const float* conv_col(const Conv& c, int n, float& sc) {
    sc = 1.0f;
    switch (c.mode) {
    case 0: return c.s0 + n;
    case 1: {
        if (n < 640) return c.s0 + n;
        if (n < 1152) { const int hh = (n - 640) >> 6, p = (n - 640) & 63; return c.s0 + 672 + hh * 64 + ilv64(p); }
        if (n < 1280) { const int hh = (n - 1152) >> 6, p = (n - 1152) & 63; return c.s0 + 1184 + hh * 64 + ilv64(p); }
        if (n < 1408) return c.s0 + 1312 + (n - 1280);
        if (n < 1440) return c.s0 + 640 + ilv32(n - 1408);
        return nullptr; }
    case 2: {
        if (n < 512) return c.s0 + (n >> 6) * 96 + (n & 63);
        const int hh = (n - 512) >> 5, p = (n - 512) & 31; return c.s0 + hh * 96 + 64 + ilv32(p); }
    case 3: {
        const int G = n >> 5, j = n & 31; return (j < 16) ? c.s0 + 16 * G + j : c.s1 + 16 * G + (j - 16); }
    case 4: {
        if (n >= 3104) return nullptr;
        if (n < 512) sc = 0.08838834764831845f;
        return c.s0 + n; }
    }
    return nullptr;
}
__device__ __forceinline__ void conv_item(const Conv& c, int item, LAS float* scr, int lane) {
    const int nblk = c.Ndst / 32, kb = item / nblk, nb = item % nblk, k0 = 64 * kb, n0 = 32 * nb;
    float sc; const float* cp = conv_col(c, n0 + (lane & 31), sc);
    const int kh = lane >> 5;
#pragma unroll 16
    for (int i = 0; i < 32; ++i) { const int kk = 2 * i + kh; float v = 0.f;
        if (cp) { v = __builtin_nontemporal_load(cp + (size_t)(k0 + kk) * c.Nsrc) * sc; if (c.kscale) v *= c.kscale[k0 + kk]; }
        scr[kk * 33 + (lane & 31)] = v; }
    asm volatile("s_waitcnt lgkmcnt(0)" ::: "memory");
    const int ch = lane & 7;
#pragma unroll
    for (int j = 0; j < 4; ++j) { const int n = (lane >> 3) + 8 * j; const LAS float* s = scr + (8 * ch) * 33 + n;
        u32x4 o; o.x = cvtpk(s[0 * 33], s[1 * 33]); o.y = cvtpk(s[2 * 33], s[3 * 33]); o.z = cvtpk(s[4 * 33], s[5 * 33]); o.w = cvtpk(s[6 * 33], s[7 * 33]);
        *(u32x4*)(c.dst + (size_t)(n0 + n) * c.K + k0 + 8 * ch) = o; }
    asm volatile("s_waitcnt lgkmcnt(0)" ::: "memory");
}

struct Conv64 { const float* s0; const float* s1; int Nsrc; int K; int Ndst; bf16_t* dst; int mode; int nvalid; int nscaled; float rscale; int f8; };
struct Conv64Geo { int k0, n0, nd; bool valid; float sc; const float* src; };
__device__ __forceinline__ Conv64Geo conv64_geo(const Conv64& c, int item, int lane) {
    Conv64Geo g; const int nblk = c.Ndst / 64, kb = item / nblk, nb = item % nblk; g.k0 = 64 * kb; g.n0 = 64 * nb;
    const int c4 = lane & 15, kr = lane >> 4; g.valid = true; g.sc = 1.0f;
    if (c.mode == 3) { const int cc = 4 * (c4 & 7); g.src = c.s0 + ((c4 < 8) ? (long)0 : (long)(c.s1 - c.s0)) + 32 * nb + cc; g.nd = 32 * (cc >> 4) + ((c4 < 8) ? 0 : 16) + (cc & 15); g.sc = c.rscale * ((c4 < 8) ? -1.4426950408889634f : 1.0f); }
    else { g.nd = 4 * c4; g.src = c.s0 + g.n0 + g.nd; g.valid = (g.n0 + g.nd) < c.nvalid; if (g.n0 + g.nd < c.nscaled) g.sc = c.rscale; }
    g.src += (size_t)(g.k0 + kr) * c.Nsrc;
    return g;
}
__device__ __forceinline__ void conv64_load(const Conv64& c, int item, int lane, f32x4 (&v)[16]) {
    const Conv64Geo g = conv64_geo(c, item, lane);
#pragma unroll
    for (int i = 0; i < 16; ++i) v[i] = g.valid ? __builtin_nontemporal_load((const f32x4*)(g.src + (size_t)(4 * i) * c.Nsrc)) : (f32x4){0.f, 0.f, 0.f, 0.f};
}
__device__ __forceinline__ void conv64_store(const Conv64& c, int item, LAS float* scr, int lane, const f32x4 (&v)[16]) {
    const Conv64Geo g = conv64_geo(c, item, lane); const int kr = lane >> 4, nd = g.nd, k0 = g.k0, n0 = g.n0; const float sc = g.sc;
#pragma unroll
    for (int i = 0; i < 16; ++i) { LAS float* p = scr + (4 * i + kr) * 65 + nd; p[0] = v[i][0] * sc; p[1] = v[i][1] * sc; p[2] = v[i][2] * sc; p[3] = v[i][3] * sc; }
    asm volatile("s_waitcnt lgkmcnt(0)" ::: "memory");
    if (c.f8) {
        const int ch = lane & 3; unsigned char* d8 = (unsigned char*)c.dst;
#pragma unroll
        for (int it = 0; it < 4; ++it) { const int r = it * 16 + (lane >> 2); const LAS float* sp = scr + (16 * ch) * 65 + r; u32x4 o;
            o.x = pack_fp8x4(sp[0 * 65], sp[1 * 65], sp[2 * 65], sp[3 * 65]); o.y = pack_fp8x4(sp[4 * 65], sp[5 * 65], sp[6 * 65], sp[7 * 65]);
            o.z = pack_fp8x4(sp[8 * 65], sp[9 * 65], sp[10 * 65], sp[11 * 65]); o.w = pack_fp8x4(sp[12 * 65], sp[13 * 65], sp[14 * 65], sp[15 * 65]);
            if (c.f8 == 3) __builtin_nontemporal_store(o, (u32x4*)(d8 + (size_t)(n0 + r) * c.K + k0 + 16 * ch)); else *(u32x4*)(d8 + (size_t)(n0 + r) * c.K + k0 + 16 * ch) = o; }
    } else {
    const int ch = lane & 7;
#pragma unroll
    for (int it = 0; it < 8; ++it) { const int r = it * 8 + (lane >> 3); const LAS float* sp = scr + (8 * ch) * 65 + r;
        u32x4 o; o.x = cvtpk(sp[0 * 65], sp[1 * 65]); o.y = cvtpk(sp[2 * 65], sp[3 * 65]); o.z = cvtpk(sp[4 * 65], sp[5 * 65]); o.w = cvtpk(sp[6 * 65], sp[7 * 65]);
        *(u32x4*)(c.dst + (size_t)(n0 + r) * c.K + k0 + 8 * ch) = o; }
    }
    asm volatile("s_waitcnt lgkmcnt(0)" ::: "memory");
}

__device__ __forceinline__ void conv64_run(const Conv64& c, LAS float* scr, int lane, int gwi, int ngw, int& base) {
    const int n = (c.K / 64) * (c.Ndst / 64); int it = gwi - base; if (it < 0) it += ngw;
    if (it < n) { f32x4 va[16], vb[16]; conv64_load(c, it, lane, va);
        for (;;) { const int i2 = it + ngw; if (i2 < n) conv64_load(c, i2, lane, vb); conv64_store(c, it, scr, lane, va); if (i2 >= n) break;
                   const int i3 = i2 + ngw; if (i3 < n) conv64_load(c, i3, lane, va); conv64_store(c, i2, scr, lane, vb); if (i3 >= n) break; it = i3; } }
    base = (base + n) % ngw;
}

namespace pg8 {
constexpr int BM = 256, BK = 64, HALF = 128, HTB = HALF * BK * 2, STAGE_BYTES = 8 * HTB;
constexpr int NXCD = 8, WGM = 8;
__device__ __forceinline__ int lds_byte(int r, int c) { const int st = (r >> 4) * 2 + (c >> 5), rr = r & 15, cc = c & 31, ob = rr * 64 + cc * 2; return st * 1024 + (ob ^ (((ob >> 9) & 1) << 5)); }
__device__ __forceinline__ void stage_rc(int b, int& Rr, int& C) { const int st = b / 1024, sb = b % 1024, swz = sb ^ (((sb >> 9) & 1) << 5); Rr = (st >> 1) * 16 + swz / 64; C = (st & 1) * 32 + (swz % 64) / 2; }
__device__ __forceinline__ int perm32(int rho) { const int n = rho >> 4, i = rho & 15; return 8 * (i >> 2) + 4 * n + (i & 3); }
struct Unit { int pm, pn; };
typedef int v8i_t __attribute__((ext_vector_type(8)));
typedef int v4i_t __attribute__((ext_vector_type(4)));
__device__ __forceinline__ v8i_t cat8(bf16x8 a, bf16x8 b) { const v4i_t x = __builtin_bit_cast(v4i_t, a), y = __builtin_bit_cast(v4i_t, b); return __builtin_shufflevector(x, y, 0, 1, 2, 3, 4, 5, 6, 7); }
struct Order {
    int nM, nN, nwg, G, c;
    __device__ __forceinline__ void init(int nM_, int nN_, int G_, int c_) { nM = nM_; nN = nN_; nwg = nM * nN; G = G_; c = c_; }
    __device__ __forceinline__ bool next(int i, Unit& u) const {
        const long L = (long)i * G + c; if (L >= nwg) return false;
        int wgid = (int)L; { const int q = nwg / NXCD, r = nwg % NXCD, xcd = wgid % NXCD, off = wgid / NXCD; wgid = (xcd < r ? xcd * (q + 1) : r * (q + 1) + (xcd - r) * q) + off; }
        const int nig = WGM * nN, gid = wgid / nig, fm = gid * WGM, gsz = (nM - fm) < WGM ? (nM - fm) : WGM;
        u.pm = fm + ((wgid % nig) % gsz); u.pn = (wgid % nig) / gsz; return true;
    }
};

template <class Prob, class Epi>
__device__ __forceinline__ void gemm_phase(LAS unsigned char* lds, const Prob& P, const Epi& E) {
    const int tid = threadIdx.x, wid = __builtin_amdgcn_readfirstlane(tid >> 6), lane = tid & 63, wr = wid >> 2, wc = wid & 3, fr = lane & 15, fq = lane >> 4;
    const int K = P.K, nt = K / BK, ldb = P.ldb;
    int RA[2], CA[2]; unsigned voffB[2];
#pragma unroll
    for (int i = 0; i < 2; ++i) { int Rr, C; stage_rc(tid * 16 + i * 8192, Rr, C); const int Rb = Epi::PERM ? ((Rr & ~31) + perm32(Rr & 31)) : Rr;
        RA[i] = Rr; CA[i] = C; voffB[i] = (unsigned)(Rb * ldb + C) * 2u; }
    const size_t hstepB = (size_t)HALF * ldb * 2;
    const unsigned ldsw = (unsigned)wid * 1024u;
    const int aoff = lds_byte(wr * 64 + fr, fq * 8), boff = lds_byte(wc * 32 + fr, fq * 8);
    const char* Abase = (const char*)P.Abase;
    const int scl_a = P.sa * 0x01010101, scl_b = P.sb * 0x01010101;
#define PG8_SA(b, h) (((b) * 2 + (h)) * HTB)
#define PG8_SB(b, h) ((4 + (b) * 2 + (h)) * HTB)
#define PG8_STAGEB(bufoff, gbase) do { _Pragma("unroll") for (int _i = 0; _i < 2; ++_i) \
        __builtin_amdgcn_global_load_lds((const unsigned*)((const char*)(gbase) + voffB[_i]), (LAS unsigned*)(lds + (bufoff) + ldsw + _i * 8192), 16, 0, 0); } while (0)
#define PG8_STAGEA(bufoff, vo, h, kb) do { _Pragma("unroll") for (int _i = 0; _i < 2; ++_i) \
        __builtin_amdgcn_global_load_lds((const unsigned*)(Abase + (size_t)(kb) + (vo)[h][_i]), (LAS unsigned*)(lds + (bufoff) + ldsw + _i * 8192), 16, 0, 0); } while (0)
#define PG8_LDA(dst, b, h) do { _Pragma("unroll") for (int m = 0; m < 4; ++m) { if constexpr (Prob::FP8) dst##8[m] = cat8(*(const LAS bf16x8*)(lds + PG8_SA(b, h) + aoff + m * 2048), *(const LAS bf16x8*)(lds + PG8_SA(b, h) + aoff + m * 2048 + 1024)); \
        else { _Pragma("unroll") for (int k = 0; k < 2; ++k) dst[m][k] = *(const LAS bf16x8*)(lds + PG8_SA(b, h) + aoff + m * 2048 + k * 1024); } } } while (0)
#define PG8_LDB(dst, b, h) do { _Pragma("unroll") for (int n = 0; n < 2; ++n) { if constexpr (Prob::FP8) dst##8[n] = cat8(*(const LAS bf16x8*)(lds + PG8_SB(b, h) + boff + n * 2048), *(const LAS bf16x8*)(lds + PG8_SB(b, h) + boff + n * 2048 + 1024)); \
        else { _Pragma("unroll") for (int k = 0; k < 2; ++k) dst[n][k] = *(const LAS bf16x8*)(lds + PG8_SB(b, h) + boff + n * 2048 + k * 1024); } } } while (0)
#define PG8_MMA(ai, bj, At, Bt) do { __builtin_amdgcn_s_setprio(1); _Pragma("unroll") for (int m = 0; m < 4; ++m) _Pragma("unroll") for (int n = 0; n < 2; ++n) { \
        if constexpr (Prob::FP8) asm volatile("v_mfma_scale_f32_16x16x128_f8f6f4 %0, %1, %2, %0, %3, %4 op_sel_hi:[0,0,0]" : "+v"(acc[ai][bj][m][n]) : "v"(Bt##8[n]), "v"(At##8[m]), "v"(scl_b), "v"(scl_a)); \
        else { _Pragma("unroll") for (int k = 0; k < 2; ++k) acc[ai][bj][m][n] = __builtin_amdgcn_mfma_f32_16x16x32_bf16(Bt[n][k], At[m][k], acc[ai][bj][m][n], 0, 0, 0); } } \
        __builtin_amdgcn_s_setprio(0); } while (0)
#define PG8_WAIT_V(n) asm volatile("s_waitcnt vmcnt(" #n ")" ::: "memory")
#define PG8_WAIT_L(n) asm volatile("s_waitcnt lgkmcnt(" #n ")" ::: "memory")
#define PG8_BAR __builtin_amdgcn_s_barrier()
#define PG8_SCHED __builtin_amdgcn_sched_barrier(0)
    Unit cur, nxt; int ui = 0;
    if (!P.next(0, cur)) return;
    f32x4 acc[2][2][4][2];
#pragma unroll
    for (int a = 0; a < 2; ++a)
#pragma unroll
        for (int b = 0; b < 2; ++b)
#pragma unroll
            for (int m = 0; m < 4; ++m)
#pragma unroll
                for (int n = 0; n < 2; ++n) acc[a][b][m][n] = (f32x4){0.f, 0.f, 0.f, 0.f};
    bf16x8 At[4][2], B0[2][2], B1[2][2]; v8i_t At8[4], B08[2], B18[2];
    unsigned cvo[2][2], nvo[2][2];
#pragma unroll
    for (int h = 0; h < 2; ++h)
#pragma unroll
        for (int i = 0; i < 2; ++i) cvo[h][i] = P.a_off(cur, h * HALF + RA[i]) + (unsigned)CA[i] * 2u;
    const char* cB = P.b_ptr(cur);
    const size_t kstep = (size_t)(BK * 2);
    PG8_STAGEB(PG8_SB(0, 0), cB); PG8_STAGEB(PG8_SB(0, 1), cB + hstepB); PG8_STAGEA(PG8_SA(0, 0), cvo, 0, 0); PG8_STAGEA(PG8_SA(0, 1), cvo, 1, 0);
    if (wr == 1) PG8_BAR;
    PG8_WAIT_V(2); PG8_BAR;
    PG8_STAGEB(PG8_SB(1, 0), cB + kstep); PG8_STAGEA(PG8_SA(1, 0), cvo, 0, kstep); PG8_STAGEB(PG8_SB(1, 1), cB + hstepB + kstep);
    PG8_WAIT_V(6); PG8_BAR;
    for (;;) {
        const bool has_next = P.next(ui + 1, nxt);
        const char* nB = cB;
#pragma unroll
        for (int h = 0; h < 2; ++h)
#pragma unroll
            for (int i = 0; i < 2; ++i) nvo[h][i] = cvo[h][i];
        if (has_next) { nB = P.b_ptr(nxt);
#pragma unroll
            for (int h = 0; h < 2; ++h)
#pragma unroll
                for (int i = 0; i < 2; ++i) nvo[h][i] = P.a_off(nxt, h * HALF + RA[i]) + (unsigned)CA[i] * 2u; }
        for (int t = 0; t < nt; t += 2) {
            const bool last = (t == nt - 2);
            const size_t k1 = (size_t)(t + 1) * kstep;
            const size_t k2 = last ? 0 : (size_t)(t + 2) * kstep, k3 = k2 + kstep;
            unsigned vo2[2][2];
#pragma unroll
            for (int h = 0; h < 2; ++h)
#pragma unroll
                for (int i = 0; i < 2; ++i) vo2[h][i] = last ? nvo[h][i] : cvo[h][i];
            const char* b2 = (last ? nB : cB) + k2; const char* b3 = b2 + kstep;
            PG8_LDB(B0, 0, 0); PG8_LDB(B1, 0, 1); PG8_SCHED; PG8_LDA(At, 0, 0); PG8_STAGEA(PG8_SA(1, 1), cvo, 1, k1);
            PG8_WAIT_V(8); PG8_WAIT_L(0); PG8_BAR; PG8_MMA(0, 0, At, B0); PG8_MMA(0, 1, At, B1); PG8_BAR; PG8_SCHED;
            PG8_LDA(At, 0, 1); PG8_STAGEB(PG8_SB(0, 0), b2); PG8_STAGEB(PG8_SB(0, 1), b2 + hstepB); PG8_STAGEA(PG8_SA(0, 0), vo2, 0, k2);
            PG8_WAIT_V(8); PG8_WAIT_L(0); PG8_BAR; PG8_MMA(1, 0, At, B0); PG8_MMA(1, 1, At, B1); PG8_BAR; PG8_SCHED;
            PG8_LDB(B0, 1, 0); PG8_LDB(B1, 1, 1); PG8_SCHED; PG8_LDA(At, 1, 0); PG8_STAGEA(PG8_SA(0, 1), vo2, 1, k2);
            PG8_WAIT_V(8); PG8_WAIT_L(0); PG8_BAR; PG8_MMA(0, 0, At, B0); PG8_MMA(0, 1, At, B1); PG8_BAR; PG8_SCHED;
            PG8_LDA(At, 1, 1); PG8_STAGEB(PG8_SB(1, 0), b3); PG8_STAGEB(PG8_SB(1, 1), b3 + hstepB); PG8_STAGEA(PG8_SA(1, 0), vo2, 0, k3);
            PG8_WAIT_V(8); PG8_WAIT_L(0); PG8_BAR; PG8_MMA(1, 0, At, B0); PG8_MMA(1, 1, At, B1); PG8_BAR; PG8_SCHED;
        }
        if (wr == 0) PG8_BAR;
        if constexpr (Prob::FP8) asm volatile("s_nop 15\n\ts_nop 15" ::: "memory");
        if constexpr (Epi::STAGED) E.staged(acc, P, cur, wr, wc, fr, fq, lds + STAGE_BYTES, tid);
        else { E(acc, P, cur, wr, wc, fr, fq); if (MK_EPI2) { asm volatile("" ::: "memory"); E(acc, P, cur, wr, wc, fr, fq); } }
        if (!has_next) break;
#pragma unroll
        for (int a = 0; a < 2; ++a)
#pragma unroll
            for (int b = 0; b < 2; ++b)
#pragma unroll
                for (int m = 0; m < 4; ++m)
#pragma unroll
                    for (int n = 0; n < 2; ++n) acc[a][b][m][n] = (f32x4){0.f, 0.f, 0.f, 0.f};
        cur = nxt; cB = nB; ++ui;
#pragma unroll
        for (int h = 0; h < 2; ++h)
#pragma unroll
            for (int i = 0; i < 2; ++i) cvo[h][i] = nvo[h][i];
        if (wr == 1) PG8_BAR;
    }
    PG8_WAIT_V(0);
    PG8_BAR;
#undef PG8_SA
#undef PG8_SB
#undef PG8_STAGEA
#undef PG8_STAGEB
#undef PG8_LDA
#undef PG8_LDB
#undef PG8_MMA
#undef PG8_WAIT_V
#undef PG8_WAIT_L
#undef PG8_BAR
#undef PG8_SCHED
}

struct DenseProb {
    static constexpr bool FP8 = false; static constexpr int sa = 127, sb = 127;
    const bf16_t* Abase; const bf16_t* Bt; int K, lda, ldb; Order ord;
    __device__ __forceinline__ bool next(int i, Unit& u) const { return ord.next(i, u); }
    __device__ __forceinline__ unsigned a_off(const Unit& u, int r) const { return (unsigned)((size_t)(u.pm * BM + r) * lda * 2); }
    __device__ __forceinline__ const char* b_ptr(const Unit& u) const { return (const char*)Bt + (size_t)u.pn * BM * ldb * 2; }
    __device__ __forceinline__ int orow0(const Unit& u) const { return u.pm * BM; }
};
template <int SA, int SB> struct DenseProb8 {
    static constexpr bool FP8 = true; static constexpr int sa = SA, sb = SB;
    const unsigned char* Abase; const unsigned char* Bt; int K, ldb; int lda; Order ord;
    __device__ __forceinline__ bool next(int i, Unit& u) const { return ord.next(i, u); }
    __device__ __forceinline__ unsigned a_off(const Unit& u, int r) const { return (unsigned)((size_t)(u.pm * BM + r) * lda); }
    __device__ __forceinline__ const char* b_ptr(const Unit& u) const { return (const char*)Bt + (size_t)u.pn * BM * ldb * 2; }
    __device__ __forceinline__ int orow0(const Unit& u) const { return u.pm * BM; }
};
struct MoeTiles { unsigned long long tp8; unsigned long long c4a, c4b; int nt; };
__device__ __forceinline__ int moe_tp(const MoeTiles& T, int e) { return (int)((T.tp8 >> (8 * e)) & 0xffull); }
__device__ __forceinline__ int moe_cnt(const MoeTiles& T, int e) { const unsigned long long w = (e < 4) ? T.c4a : T.c4b; return (int)((w >> (16 * (e & 3))) & 0xffffull); }
__device__ __forceinline__ int moe_expert(const MoeTiles& T, int pm) { int e = 0;
#pragma unroll
    for (int j = 1; j < 8; ++j) e += (pm >= (int)((T.tp8 >> (8 * j)) & 0xffull)) ? 1 : 0;
    return e; }
struct MoeGuProb {
    static constexpr bool FP8 = true; static constexpr int sa = 125, sb = 121;
    const unsigned char* Abase; const unsigned char* Bt; int K, ldb; Order ord; MoeTiles T; const int* rowtok;
    __device__ __forceinline__ bool next(int i, Unit& u) const { return ord.next(i, u); }
    __device__ __forceinline__ unsigned a_off(const Unit& u, int r) const {
        const int e = moe_expert(T, u.pm); const int idx = (u.pm - moe_tp(T, e)) * BM + r; const int cm1 = moe_cnt(T, e) - 1;
        const int tok = rowtok[e * CAPE + (idx < cm1 ? idx : cm1)];
        return (unsigned)tok * (unsigned)D; }
    __device__ __forceinline__ const char* b_ptr(const Unit& u) const { const int e = moe_expert(T, u.pm); return (const char*)Bt + ((size_t)e * N_GU1 + (size_t)u.pn * BM) * D; }
    __device__ __forceinline__ int orow0(const Unit& u) const { return u.pm * BM; }
};
struct MoeDnProb {
    static constexpr bool FP8 = true; static constexpr int sa = 124, sb = 121;
    const unsigned char* Abase; const unsigned char* Bt; int K, ldb; Order ord; MoeTiles T;
    __device__ __forceinline__ bool next(int i, Unit& u) const { return ord.next(i, u); }
    __device__ __forceinline__ unsigned a_off(const Unit& u, int r) const { return (unsigned)((size_t)(u.pm * BM + r) * EXD); }
    __device__ __forceinline__ const char* b_ptr(const Unit& u) const { const int e = moe_expert(T, u.pm); return (const char*)Bt + ((size_t)e * D + (size_t)u.pn * BM) * EXD; }
    __device__ __forceinline__ int orow0(const Unit& u) const { return u.pm * BM; }
};

struct EpiF32 { static constexpr bool PERM = false; static constexpr bool STAGED = false; float* C; int ldc;
    template <class Prob> __device__ __forceinline__ void operator()(const f32x4 (&acc)[2][2][4][2], const Prob& P, const Unit& u, int wr, int wc, int fr, int fq) const {
        const int row0 = P.orow0(u) + wr * 64 + fr, col0 = u.pn * BM + wc * 32 + 4 * fq;
#pragma unroll
        for (int ai = 0; ai < 2; ++ai)
#pragma unroll
            for (int m = 0; m < 4; ++m) { float* rowp = C + (size_t)(row0 + ai * HALF + m * 16) * ldc + col0;
#pragma unroll
                for (int bj = 0; bj < 2; ++bj)
#pragma unroll
                    for (int n = 0; n < 2; ++n) *(f32x4*)(rowp + bj * HALF + n * 16) = acc[ai][bj][m][n]; }
    }
};
struct EpiBf16 { static constexpr bool PERM = true; static constexpr bool STAGED = false; bf16_t* O; int ldc; const float* rowscale;
    template <class Prob> __device__ __forceinline__ void operator()(const f32x4 (&acc)[2][2][4][2], const Prob& P, const Unit& u, int wr, int wc, int fr, int fq) const {
        const int row0 = P.orow0(u) + wr * 64 + fr, col0 = u.pn * BM + wc * 32 + 8 * fq;
#pragma unroll
        for (int ai = 0; ai < 2; ++ai)
#pragma unroll
            for (int m = 0; m < 4; ++m) { const int row = row0 + ai * HALF + m * 16; bf16_t* rowp = O + (size_t)row * ldc + col0; const float rs = rowscale ? rowscale[row] : 1.0f;
#pragma unroll
                for (int bj = 0; bj < 2; ++bj) { const f32x4 v0 = acc[ai][bj][m][0] * rs, v1 = acc[ai][bj][m][1] * rs;
                    u32x4 w; w.x = cvtpk(v0[0], v0[1]); w.y = cvtpk(v0[2], v0[3]); w.z = cvtpk(v1[0], v1[1]); w.w = cvtpk(v1[2], v1[3]);
                    *(u32x4*)(rowp + bj * HALF) = w; } }
    }
};
struct EpiIn1 { static constexpr bool PERM = true; static constexpr bool STAGED = false; bf16_t* QK; bf16_t* V; bf16_t* G; bf16_t* RRp;
    template <class Prob> __device__ __forceinline__ void operator()(const f32x4 (&acc)[2][2][4][2], const Prob& P, const Unit& u, int wr, int wc, int fr, int fq) const {
        const int t = u.pn >> 2; bf16_t* base = (t == 0) ? QK : (t == 1) ? V : (t == 2) ? G : RRp; const int ldc = (t == 3) ? 256 : 1024;
        const int row0 = P.orow0(u) + wr * 64 + fr, col0 = (u.pn & 3) * BM + wc * 32 + 8 * fq;
#pragma unroll
        for (int ai = 0; ai < 2; ++ai)
#pragma unroll
            for (int m = 0; m < 4; ++m) { const int row = row0 + ai * HALF + m * 16; bf16_t* rowp = base + (size_t)row * ldc + col0;
#pragma unroll
                for (int bj = 0; bj < 2; ++bj) { const f32x4 v0 = acc[ai][bj][m][0], v1 = acc[ai][bj][m][1];
                    u32x4 w; w.x = cvtpk(v0[0], v0[1]); w.y = cvtpk(v0[2], v0[3]); w.z = cvtpk(v1[0], v1[1]); w.w = cvtpk(v1[2], v1[3]);
                    *(u32x4*)(rowp + bj * HALF) = w; } }
    }
};
struct EpiQA { static constexpr bool PERM = true; static constexpr bool STAGED = false; bf16_t* O; const float* rstd; const float* tab16; float qscale;
    template <class Prob> __device__ __forceinline__ void operator()(const f32x4 (&acc)[2][2][4][2], const Prob& P, const Unit& u, int wr, int wc, int fr, int fq) const {
        const int row0 = P.orow0(u) + wr * 64 + fr, col0 = u.pn * BM + wc * 32 + 8 * fq;
        const bool ropet = (u.pn == 2);
#pragma unroll
        for (int ai = 0; ai < 2; ++ai)
#pragma unroll
            for (int m = 0; m < 4; ++m) { const int row = row0 + ai * HALF + m * 16; bf16_t* rowp = O + (size_t)row * N_QA + col0; const float rs = rstd[row] * qscale;
                f32x4 cs0 = {1.f, 1.f, 1.f, 1.f}, sn0 = {0.f, 0.f, 0.f, 0.f};
                if (ropet && row < RL) { const int tt = row & (SEQ - 1); const int pos = (fq >> 1) ? (tt & 63) : (tt >> 6); const int i0 = 4 * (fq & 1);
                    cs0 = *(const f32x4*)(tab16 + pos * 8 + i0); sn0 = *(const f32x4*)(tab16 + 512 + pos * 8 + i0); }
#pragma unroll
                for (int bj = 0; bj < 2; ++bj) { f32x4 v0 = acc[ai][bj][m][0] * rs, v1 = acc[ai][bj][m][1] * rs;
                    if (ropet) {
                        const f32x4 a = v0, b = v1;
                        v0[0] = a[0] * cs0[0] - a[1] * sn0[0]; v0[1] = a[1] * cs0[0] + a[0] * sn0[0];
                        v0[2] = a[2] * cs0[1] - a[3] * sn0[1]; v0[3] = a[3] * cs0[1] + a[2] * sn0[1];
                        v1[0] = b[0] * cs0[2] - b[1] * sn0[2]; v1[1] = b[1] * cs0[2] + b[0] * sn0[2];
                        v1[2] = b[2] * cs0[3] - b[3] * sn0[3]; v1[3] = b[3] * cs0[3] + b[2] * sn0[3]; }
                    u32x4 w; w.x = cvtpk(v0[0], v0[1]); w.y = cvtpk(v0[2], v0[3]); w.z = cvtpk(v1[0], v1[1]); w.w = cvtpk(v1[2], v1[3]);
                    *(u32x4*)(rowp + bj * HALF) = w; } }
    }
};
struct EpiSwiglu { static constexpr bool PERM = false; static constexpr bool STAGED = false; bf16_t* Hh; int ldh;
    template <class Prob> __device__ __forceinline__ void operator()(const f32x4 (&acc)[2][2][4][2], const Prob& P, const Unit& u, int wr, int wc, int fr, int fq) const {
        const int row0 = P.orow0(u) + wr * 64 + fr, col0 = (u.pn * BM + wc * 32) / 2 + 4 * fq;
#pragma unroll
        for (int ai = 0; ai < 2; ++ai)
#pragma unroll
            for (int m = 0; m < 4; ++m) { bf16_t* rowp = Hh + (size_t)(row0 + ai * HALF + m * 16) * ldh + col0;
#pragma unroll
                for (int bj = 0; bj < 2; ++bj) { const f32x4 g = acc[ai][bj][m][0], up = acc[ai][bj][m][1];
                    u32x2 w; w.x = cvtpk(swiglu_f(g[0], up[0], -1.4426950408889634f), swiglu_f(g[1], up[1], -1.4426950408889634f)); w.y = cvtpk(swiglu_f(g[2], up[2], -1.4426950408889634f), swiglu_f(g[3], up[3], -1.4426950408889634f));
                    *(u32x2*)(rowp + bj * (HALF / 2)) = w; } }
    }
};
struct EpiSwiglu8 { static constexpr bool PERM = false; static constexpr bool STAGED = true; unsigned char* Hh; int ldh;
    template <class Prob> __device__ __forceinline__ void staged(const f32x4 (&acc)[2][2][4][2], const Prob& P, const Unit& u, int wr, int wc, int fr, int fq, LAS unsigned char* stg, int tid) const {
        LAS unsigned char* sg = stg + wr * 8192;
        const int t = tid & 255;
        unsigned char* gbase = Hh + (size_t)(P.orow0(u) + wr * 64) * ldh + (size_t)u.pn * 128;
#pragma unroll
        for (int ai = 0; ai < 2; ++ai) {
#pragma unroll
            for (int m = 0; m < 4; ++m) { const int row = m * 16 + fr;
#pragma unroll
                for (int bj = 0; bj < 2; ++bj) { const f32x4 g = acc[ai][bj][m][0], up = acc[ai][bj][m][1]; const int p = bj * 4 + wc;
                    *(LAS unsigned*)(sg + row * 128 + ((p ^ (row & 7)) << 4) + 4 * fq) = pack_fp8x4(swiglu_f(g[0], up[0], -0.18033688011112042f), swiglu_f(g[1], up[1], -0.18033688011112042f), swiglu_f(g[2], up[2], -0.18033688011112042f), swiglu_f(g[3], up[3], -0.18033688011112042f)); } }
            asm volatile("s_waitcnt lgkmcnt(0)" ::: "memory"); __builtin_amdgcn_s_barrier(); asm volatile("" ::: "memory");
#pragma unroll
            for (int j = 0; j < 2; ++j) { const int row = (t >> 3) + 32 * j, p = t & 7;
                const u32x4 v = *(const LAS u32x4*)(sg + row * 128 + ((p ^ (row & 7)) << 4));
                *(u32x4*)(gbase + (size_t)(ai * HALF + row) * ldh + p * 16) = v; }
            if (ai == 0) { asm volatile("s_waitcnt lgkmcnt(0)" ::: "memory"); __builtin_amdgcn_s_barrier(); asm volatile("" ::: "memory"); }
        }
    }
};
}

struct Frame {
    LAS unsigned char* lds;
    unsigned char* ws;
    int tid, lane, wave, vcu, G;
};
template <class T> __device__ __forceinline__ T* wsp(const Frame& F, size_t off) { return (T*)(F.ws + off); }

__device__ __forceinline__ void load_row(const float* p, int lane, f32x4 (&v)[4]) {
    const f32x4* r = (const f32x4*)p + lane;
#pragma unroll
    for (int j = 0; j < 4; ++j) v[j] = r[64 * j];
}
__device__ __forceinline__ void load_row_bf16(const bf16_t* p, int lane, f32x4 (&v)[4]) {
#pragma unroll
    for (int j = 0; j < 4; ++j) { const u32x2 w = *(const u32x2*)(p + 4 * lane + 256 * j); v[j][0] = bflo(w.x); v[j][1] = bfhi(w.x); v[j][2] = bflo(w.y); v[j][3] = bfhi(w.y); }
}
__device__ __forceinline__ float row_ssq(const f32x4 (&v)[4]) { float s = 0.f;
#pragma unroll
    for (int j = 0; j < 4; ++j) s += (v[j][0] * v[j][0] + v[j][1] * v[j][1]) + (v[j][2] * v[j][2] + v[j][3] * v[j][3]);
    return wave_sum(s); }
__device__ __forceinline__ void norm_mod_store(const f32x4 (&h)[4], const float* g, const float* sh, const float* sc, bf16_t* urow, int lane, f32x4 (&uo)[4], unsigned char* u8row = nullptr) {
    const float rstd = __builtin_amdgcn_rsqf(row_ssq(h) * (1.0f / D) + EPS);
#pragma unroll
    for (int j = 0; j < 4; ++j) { const int c = 4 * lane + 256 * j; const f32x4 gg = *(const f32x4*)(g + c), s1 = *(const f32x4*)(sc + c), s0 = *(const f32x4*)(sh + c);
        const f32x4 uu = (h[j] * rstd * gg) * (1.0f + s1) + s0; uo[j] = uu;
        if (u8row) *(unsigned*)(u8row + c) = pack_fp8x4(4.0f * uu[0], 4.0f * uu[1], 4.0f * uu[2], 4.0f * uu[3]);
        else { u32x2 w; w.x = cvtpk(uu[0], uu[1]); w.y = cvtpk(uu[2], uu[3]); *(u32x2*)(urow + c) = w; } }
}
__device__ __forceinline__ int row_bidx(int row) { return row < RL ? (row >> 12) : 4; }

__device__ __forceinline__ void glds16(const void* gsrc, unsigned lds_dst) { unsigned keep;
    asm volatile("s_mov_b32 %0, m0\n\ts_mov_b32 m0, %2\n\ts_nop 0\n\tglobal_load_lds_dwordx4 %1, off\n\ts_mov_b32 m0, %0" : "=&s"(keep) : "v"(gsrc), "s"(lds_dst) : "memory"); }
__device__ __forceinline__ float max3f(float a, float b, float c) { float r; asm("v_max3_f32 %0, %1, %2, %3" : "=v"(r) : "v"(a), "v"(b), "v"(c)); return r; }
#define WAIT_BAR(N) asm volatile("s_waitcnt vmcnt(" #N ") lgkmcnt(0)\n\ts_barrier" ::: "memory")
template <int DQK> struct AttnSrc {
    const bf16_t* Q; int qpitch; const bf16_t* Qr;
    const bf16_t* Kn; int kpitch; const bf16_t* Kr; int krpitch;
    const bf16_t* V; int vpitch;
    bf16_t* O; int opitch;
};
__device__ __forceinline__ s16x4 vtr(const LAS unsigned char* p) { typedef short v4i16_t __attribute__((ext_vector_type(4))); return __builtin_bit_cast(s16x4, __builtin_amdgcn_ds_read_tr16_b64_v4i16((LAS v4i16_t*)p)); }
__device__ __forceinline__ int attn_krow(int kt, int lat0, int ctx0) { return kt < 64 ? lat0 + kt * 64 : ctx0 + (kt - 64) * 64; }
__device__ __forceinline__ f32x16 mfma_first(bf16x8 a, bf16x8 b, const f32x16& c) { f32x16 d; asm volatile("s_nop 4\n\tv_mfma_f32_32x32x16_bf16 %0, %1, %2, %3" : "=&v"(d) : "v"(a), "v"(b), "v"(c)); return d; }
template <int DQK, bool SAFE>
__device__ __forceinline__ bool attn_run(const Frame& F, const AttnSrc<DQK>& S, int q0, int lat0, int ctx0, int kt0, int kt1) {
    constexpr int NKS = DQK / 16, KB = DQK * 128, SLOT = KB + 8192;
    constexpr float THR = 8.0f;
    constexpr float BIG = 1.0e12f;
    bool ovf = false;
    const int lane = F.lane, wid = F.wave, r32 = lane & 31, hi = lane >> 5;
    LAS unsigned char* lds = F.lds;
    constexpr bool QLDS = false;
    bf16x8 qf[QLDS ? 1 : NKS];
    LAS unsigned char* qfl = lds + 4 * SLOT + wid * (NKS * 1024) + lane * 16;
    { const bf16_t* qrow = S.Q + (size_t)(q0 + wid * 32 + r32) * S.qpitch;
#pragma unroll
      for (int ks = 0; ks < 4; ++ks) { const bf16x8 v = *(const bf16x8*)(qrow + ks * 16 + hi * 8); if (QLDS) *(LAS bf16x8*)(qfl + ks * 1024) = v; else qf[ks] = v; }
      if (DQK == 96) { const bf16_t* qr = S.Qr + (size_t)(q0 + wid * 32 + r32) * S.qpitch;
#pragma unroll
          for (int ks = 4; ks < NKS; ++ks) { const bf16x8 v = *(const bf16x8*)(qr + (ks - 4) * 16 + hi * 8); if (QLDS) *(LAS bf16x8*)(qfl + ks * 1024) = v; else qf[ks] = v; } } }
    const unsigned lds0 = (unsigned)(size_t)lds;
    auto dma = [&](int kt, int slot) {
        const int krow = attn_krow(kt, lat0, ctx0);
        const unsigned sb = lds0 + slot * SLOT;
        glds16(S.Kn + (size_t)(krow + lane) * S.kpitch + wid * 8, (unsigned)__builtin_amdgcn_readfirstlane(sb + wid * 1024));
        if (DQK == 96 && wid < 4) glds16(S.Kr + (size_t)(krow + lane) * S.krpitch + wid * 8, (unsigned)__builtin_amdgcn_readfirstlane(sb + (8 + wid) * 1024));
        glds16(S.V + (size_t)(krow + 16 * (wid & 3) + (lane >> 2)) * S.vpitch + (wid >> 2) * 32 + (lane & 3) * 8, (unsigned)__builtin_amdgcn_readfirstlane(sb + KB + wid * 1024));
    };
    auto wait_bar = [&](bool inflight) {
        if (!inflight) { WAIT_BAR(0); } else if (DQK == 96 && wid < 4) { WAIT_BAR(3); } else { WAIT_BAR(2); }
    };
    f32x16 oT[2]; f32x16 negm;
#pragma unroll
    for (int r = 0; r < 16; ++r) { oT[0][r] = 0.f; oT[1][r] = 0.f; negm[r] = 0.f; }
    float mrun = 0.f, lrun = 0.f;
    const int vlane = ((lane >> 4) & 1) * 32 + (lane & 3) * 8 + (4 * hi + ((lane & 15) >> 2)) * 64;
    auto qk = [&](int slot, f32x16& p0, f32x16& p1) {
        const LAS unsigned char* kb = lds + slot * SLOT + hi * 1024 + r32 * 16;
        p0 = negm; p1 = negm;
        bf16x8 ka = *(const LAS bf16x8*)(kb), kc = *(const LAS bf16x8*)(kb + 512);
#pragma unroll
        for (int ks = 0; ks < NKS; ++ks) {
            bf16x8 na = ka, nc = kc;
            if (ks + 1 < NKS) { na = *(const LAS bf16x8*)(kb + (ks + 1) * 2048); nc = *(const LAS bf16x8*)(kb + (ks + 1) * 2048 + 512); }
            const bf16x8 qv = QLDS ? *(const LAS bf16x8*)(qfl + ks * 1024) : qf[QLDS ? 0 : ks];
            p0 = __builtin_amdgcn_mfma_f32_32x32x16_bf16(ka, qv, p0, 0, 0, 0);
            p1 = __builtin_amdgcn_mfma_f32_32x32x16_bf16(kc, qv, p1, 0, 0, 0);
            ka = na; kc = nc;
        }
    };
    auto tilemax = [&](f32x16& p0, f32x16& p1) -> float {
        asm volatile("s_nop 15\n\ts_nop 7" : "+v"(p0), "+v"(p1));
        float a = max3f(p0[0], p0[1], p1[0]), b = max3f(p0[2], p0[3], p1[1]); a = max3f(a, p1[2], p1[3]);
#pragma unroll
        for (int r = 4; r < 16; r += 4) { a = max3f(a, p0[r], p0[r + 1]); b = max3f(b, p0[r + 2], p0[r + 3]); a = max3f(a, p1[r], p1[r + 1]); b = max3f(b, p1[r + 2], p1[r + 3]); }
        float tm = fmaxf(a, b);
        auto rr = __builtin_amdgcn_permlane32_swap(__float_as_uint(tm), __float_as_uint(tm), false, false); return fmaxf(__uint_as_float(rr[0]), __uint_as_float(rr[1]));
    };
    auto step = [&](f32x16& c0, f32x16& c1, f32x16& n0, f32x16& n1, int slot_c, int slot_n) {
        if constexpr (SAFE) {
            const float tm = tilemax(c0, c1);
            if (__any(tm > THR)) {
                const float dl = fmaxf(tm, 0.f); mrun += dl; const float al = __builtin_amdgcn_exp2f(-dl); lrun *= al;
#pragma unroll
                for (int r = 0; r < 16; ++r) { c0[r] -= dl; c1[r] -= dl; negm[r] = -mrun; oT[0][r] *= al; oT[1][r] *= al; }
            }
        }
        float rs = 0.f;
        {
            const LAS unsigned char* kb = lds + slot_n * SLOT + hi * 1024 + r32 * 16;
            bf16x8 ka = *(const LAS bf16x8*)(kb), kc = *(const LAS bf16x8*)(kb + 512);
#pragma unroll
            for (int ks = 0; ks < NKS; ++ks) {
                bf16x8 na = ka, nc = kc;
                if (ks + 1 < NKS) { na = *(const LAS bf16x8*)(kb + (ks + 1) * 2048); nc = *(const LAS bf16x8*)(kb + (ks + 1) * 2048 + 512); }
                if (ks == 0) { n0 = mfma_first(ka, qf[0], negm); n1 = mfma_first(kc, qf[0], negm); }
                else { n0 = __builtin_amdgcn_mfma_f32_32x32x16_bf16(ka, qf[ks], n0, 0, 0, 0);
                       n1 = __builtin_amdgcn_mfma_f32_32x32x16_bf16(kc, qf[ks], n1, 0, 0, 0); }
                ka = na; kc = nc;
#pragma unroll
                for (int r = (16 * ks) / NKS; r < (16 * (ks + 1)) / NKS; ++r) { c0[r] = __builtin_amdgcn_exp2f(c0[r]); c1[r] = __builtin_amdgcn_exp2f(c1[r]); rs += c0[r] + c1[r]; }
            }
        }
        bool mv = false; float dl = 0.f;
        if constexpr (!SAFE) mv = __any(!(rs < BIG));
        lrun += rs;
        bf16x8 pf[4];
        { u32x4 w;
          w.x = cvtpk(c0[0], c0[1]); w.y = cvtpk(c0[2], c0[3]); w.z = cvtpk(c0[4], c0[5]); w.w = cvtpk(c0[6], c0[7]); pf[0] = __builtin_bit_cast(bf16x8, w);
          w.x = cvtpk(c0[8], c0[9]); w.y = cvtpk(c0[10], c0[11]); w.z = cvtpk(c0[12], c0[13]); w.w = cvtpk(c0[14], c0[15]); pf[1] = __builtin_bit_cast(bf16x8, w);
          w.x = cvtpk(c1[0], c1[1]); w.y = cvtpk(c1[2], c1[3]); w.z = cvtpk(c1[4], c1[5]); w.w = cvtpk(c1[6], c1[7]); pf[2] = __builtin_bit_cast(bf16x8, w);
          w.x = cvtpk(c1[8], c1[9]); w.y = cvtpk(c1[10], c1[11]); w.z = cvtpk(c1[12], c1[13]); w.w = cvtpk(c1[14], c1[15]); pf[3] = __builtin_bit_cast(bf16x8, w); }
        const LAS unsigned char* vb = lds + slot_c * SLOT + KB + vlane;
        s16x4 lo = vtr(vb), hh = vtr(vb + 512);
#pragma unroll
        for (int i = 0; i < 8; ++i) {
            const int d0 = i >> 2, ks = i & 3;
            s16x4 nlo = lo, nhh = hh;
            if (i + 1 < 8) { const int o2 = ((i + 1) >> 2) * 4096 + ((i + 1) & 3) * 1024; nlo = vtr(vb + o2); nhh = vtr(vb + o2 + 512); }
            const bf16x8 vf = (bf16x8){lo[0], lo[1], lo[2], lo[3], hh[0], hh[1], hh[2], hh[3]};
            oT[d0] = __builtin_amdgcn_mfma_f32_32x32x16_bf16(vf, pf[ks], oT[d0], 0, 0, 0);
            lo = nlo; hh = nhh;
        }
        if constexpr (!SAFE) {
            if (mv) {
                auto rr = __builtin_amdgcn_permlane32_swap(__float_as_uint(rs), __float_as_uint(rs), false, false);
                const float rrow = __uint_as_float(rr[0]) + __uint_as_float(rr[1]);
                ovf = ovf || !(rrow < 1.0e30f);
                const int ex = __builtin_amdgcn_frexp_expf(rrow) - 1;
                dl = (float)(ex > 0 ? ex : 0); const float al = __builtin_amdgcn_exp2f(-dl); lrun *= al;
#pragma unroll
                for (int r = 0; r < 16; ++r) { n0[r] -= dl; n1[r] -= dl; negm[r] -= dl; oT[0][r] *= al; oT[1][r] *= al; }
            }
        }
    };
    dma(kt0, 0); dma(kt0 + 1, 1); dma(kt0 + 2, 2);
    wait_bar(true);
    f32x16 pA0, pA1, pB0, pB1;
    qk(0, pA0, pA1);
    { mrun = tilemax(pA0, pA1);
#pragma unroll
      for (int r = 0; r < 16; ++r) negm[r] = -mrun;
      qk(0, pA0, pA1); }
    int sc = 0;
    for (int kt = kt0; kt < kt1; kt += 2) {
        { const int s1 = (sc + 1) & 3, s3 = (sc + 3) & 3;
          if (kt + 3 < kt1) dma(kt + 3, s3);
          step(pA0, pA1, pB0, pB1, sc, s1);
          wait_bar(kt + 3 < kt1);
          sc = s1; }
        { const int s1 = (sc + 1) & 3, s3 = (sc + 3) & 3;
          if (kt + 4 < kt1) dma(kt + 4, s3);
          step(pB0, pB1, pA0, pA1, sc, s1);
          wait_bar(kt + 4 < kt1);
          sc = s1; }
    }
    { auto rr = __builtin_amdgcn_permlane32_swap(__float_as_uint(lrun), __float_as_uint(lrun), false, false); lrun = __uint_as_float(rr[0]) + __uint_as_float(rr[1]); }
    const float inv = 1.0f / lrun;
    bf16_t* orow = S.O + (size_t)(q0 + wid * 32 + r32) * S.opitch;
#pragma unroll
    for (int d0 = 0; d0 < 2; ++d0)
#pragma unroll
        for (int g = 0; g < 4; ++g) { u32x2 w; w.x = cvtpk(oT[d0][4 * g] * inv, oT[d0][4 * g + 1] * inv); w.y = cvtpk(oT[d0][4 * g + 2] * inv, oT[d0][4 * g + 3] * inv);
            *(u32x2*)(orow + 32 * d0 + 8 * g + 4 * hi) = w; }
    return ovf;
}
template <int DQK>
__device__ __forceinline__ bool attn_fast(const Frame& F, const AttnSrc<DQK>& S, int q0, int lat0, int ctx0, int kt0, int kt1) {
    constexpr int NKS = DQK / 16, KB = DQK * 128, SLOT = KB + 8192, NS = 5;
    constexpr float BIG = 1.0e12f;
    bool ovf = false;
    const int lane = F.lane, wid = F.wave, r32 = lane & 31, hi = lane >> 5;
    LAS unsigned char* lds = F.lds;
    bf16x8 qf[NKS];
    { const bf16_t* qrow = S.Q + (size_t)(q0 + wid * 32 + r32) * S.qpitch;
#pragma unroll
      for (int ks = 0; ks < 4; ++ks) qf[ks] = *(const bf16x8*)(qrow + ks * 16 + hi * 8);
      if (DQK == 96) { const bf16_t* qr = S.Qr + (size_t)(q0 + wid * 32 + r32) * S.qpitch;
#pragma unroll
          for (int ks = 4; ks < NKS; ++ks) qf[ks] = *(const bf16x8*)(qr + (ks - 4) * 16 + hi * 8); } }
    const unsigned lds0 = (unsigned)(size_t)lds;
    auto dma = [&](int kt, int slot) {
        const int krow = attn_krow(kt, lat0, ctx0);
        const unsigned sb = lds0 + slot * SLOT;
        { const int k8 = lane >> 3, key = 8 * wid + k8, s8 = lane & 7;
          glds16(S.Kn + (size_t)(krow + key) * S.kpitch + (s8 ^ ((key >> 1) & 7)) * 8, (unsigned)__builtin_amdgcn_readfirstlane(sb + wid * 1024));
          if (DQK == 96 && wid < 4) { const int kr = 16 * wid + (lane >> 2); glds16(S.Kr + (size_t)(krow + kr) * S.krpitch + ((lane & 3) ^ ((kr >> 2) & 3)) * 8, (unsigned)__builtin_amdgcn_readfirstlane(sb + (8 + wid) * 1024)); }
          glds16(S.V + (size_t)(krow + key) * S.vpitch + (s8 ^ (((k8 >> 1) & 1) << 1)) * 8, (unsigned)__builtin_amdgcn_readfirstlane(sb + KB + wid * 1024)); }
    };
    auto wait_bar = [&](bool inflight) {
        if (!inflight) { WAIT_BAR(0); } else if (DQK == 96 && wid < 4) { WAIT_BAR(3); } else { WAIT_BAR(2); }
    };
    f32x16 oT[2]; f32x16 negm;
#pragma unroll
    for (int r = 0; r < 16; ++r) { oT[0][r] = 0.f; oT[1][r] = 0.f; negm[r] = 0.f; }
    float lrun = 0.f;
    int koff[NKS];
#pragma unroll
    for (int ks = 0; ks < NKS; ++ks) koff[ks] = ks < 4 ? r32 * 128 + (((2 * ks + hi) ^ ((r32 >> 1) & 7)) << 4) : 8192 + r32 * 64 + (((2 * (ks - 4) + hi) ^ ((r32 >> 2) & 3)) << 4);
    const int vq4 = (lane & 15) >> 2;
    const int vlane = (4 * hi + vq4) * 128 + (lane & 1) * 8 + (((2 * ((lane >> 4) & 1) + ((lane & 3) >> 1)) ^ (((vq4 >> 1) & 1) << 1)) << 4);
    auto qk = [&](int slot, f32x16& p0, f32x16& p1) {
        const LAS unsigned char* kb = lds + slot * SLOT;
        p0 = negm; p1 = negm;
        bf16x8 ka = *(const LAS bf16x8*)(kb + koff[0]), kc = *(const LAS bf16x8*)(kb + koff[0] + 4096);
#pragma unroll
        for (int ks = 0; ks < NKS; ++ks) {
            bf16x8 na = ka, nc = kc;
            if (ks + 1 < NKS) { na = *(const LAS bf16x8*)(kb + koff[ks + 1]); nc = *(const LAS bf16x8*)(kb + koff[ks + 1] + ((ks + 1) < 4 ? 4096 : 2048)); }
            p0 = __builtin_amdgcn_mfma_f32_32x32x16_bf16(ka, qf[ks], p0, 0, 0, 0);
            p1 = __builtin_amdgcn_mfma_f32_32x32x16_bf16(kc, qf[ks], p1, 0, 0, 0);
            ka = na; kc = nc;
        }
    };
    bf16x8 pf[4];
#pragma unroll
    for (int j = 0; j < 4; ++j) pf[j] = (bf16x8){0, 0, 0, 0, 0, 0, 0, 0};
    auto step = [&](f32x16& c0, f32x16& c1, f32x16& n0, f32x16& n1, int slot_p, int slot_n) {
        float rs = 0.f;
        asm volatile("" : "+v"(c0), "+v"(c1));
        const LAS unsigned char* kb = lds + slot_n * SLOT;
        const LAS unsigned char* vb = lds + slot_p * SLOT + KB + vlane;
        bf16x8 ka = *(const LAS bf16x8*)(kb + koff[0]), kc = *(const LAS bf16x8*)(kb + koff[0] + 4096);
        s16x4 lo = vtr(vb), hh = vtr(vb + 1024);
#pragma unroll
        for (int ks = 0; ks < NKS; ++ks) {
            bf16x8 na = ka, nc = kc;
            if (ks + 1 < NKS) { na = *(const LAS bf16x8*)(kb + koff[ks + 1]); nc = *(const LAS bf16x8*)(kb + koff[ks + 1] + ((ks + 1) < 4 ? 4096 : 2048)); }
            if (ks == 0) { n0 = mfma_first(ka, qf[0], negm); n1 = mfma_first(kc, qf[0], negm); }
            else { n0 = __builtin_amdgcn_mfma_f32_32x32x16_bf16(ka, qf[ks], n0, 0, 0, 0);
                   n1 = __builtin_amdgcn_mfma_f32_32x32x16_bf16(kc, qf[ks], n1, 0, 0, 0); }
            ka = na; kc = nc;
#pragma unroll
            for (int i = (8 * ks) / NKS; i < (8 * (ks + 1)) / NKS; ++i) {
                s16x4 nlo = lo, nhh = hh;
                if (i + 1 < 8) { const int o2 = ((i + 1) >> 2) * 64 + ((i + 1) & 3) * 2048; nlo = vtr(vb + o2); nhh = vtr(vb + o2 + 1024); }
                const bf16x8 vf = (bf16x8){lo[0], lo[1], lo[2], lo[3], hh[0], hh[1], hh[2], hh[3]};
                oT[i >> 2] = __builtin_amdgcn_mfma_f32_32x32x16_bf16(vf, pf[i & 3], oT[i >> 2], 0, 0, 0);
                lo = nlo; hh = nhh;
            }
#pragma unroll
            for (int r = (16 * ks) / NKS; r < (16 * (ks + 1)) / NKS; ++r) { c0[r] = __builtin_amdgcn_exp2f(c0[r]); c1[r] = __builtin_amdgcn_exp2f(c1[r]); rs = (rs + c0[r]) + c1[r]; }
            __builtin_amdgcn_sched_barrier(0);
        }
        ovf = ovf || !(rs < BIG);
        lrun += rs;
        { u32x4 w;
          w.x = cvtpk(c0[0], c0[1]); w.y = cvtpk(c0[2], c0[3]); w.z = cvtpk(c0[4], c0[5]); w.w = cvtpk(c0[6], c0[7]); pf[0] = __builtin_bit_cast(bf16x8, w);
          w.x = cvtpk(c0[8], c0[9]); w.y = cvtpk(c0[10], c0[11]); w.z = cvtpk(c0[12], c0[13]); w.w = cvtpk(c0[14], c0[15]); pf[1] = __builtin_bit_cast(bf16x8, w);
          w.x = cvtpk(c1[0], c1[1]); w.y = cvtpk(c1[2], c1[3]); w.z = cvtpk(c1[4], c1[5]); w.w = cvtpk(c1[6], c1[7]); pf[2] = __builtin_bit_cast(bf16x8, w);
          w.x = cvtpk(c1[8], c1[9]); w.y = cvtpk(c1[10], c1[11]); w.z = cvtpk(c1[12], c1[13]); w.w = cvtpk(c1[14], c1[15]); pf[3] = __builtin_bit_cast(bf16x8, w); }
        asm volatile("" : "+v"(pf[0]), "+v"(pf[1]), "+v"(pf[2]), "+v"(pf[3]), "+v"(lrun));
    };
    dma(kt0, 0); dma(kt0 + 1, 1); dma(kt0 + 2, 2);
    wait_bar(true);
    f32x16 pA0, pA1, pB0, pB1;
    qk(0, pA0, pA1);
    {
        asm volatile("s_nop 15\n\ts_nop 7" : "+v"(pA0), "+v"(pA1));
        float a = max3f(pA0[0], pA0[1], pA1[0]), b = max3f(pA0[2], pA0[3], pA1[1]); a = max3f(a, pA1[2], pA1[3]);
#pragma unroll
        for (int r = 4; r < 16; r += 4) { a = max3f(a, pA0[r], pA0[r + 1]); b = max3f(b, pA0[r + 2], pA0[r + 3]); a = max3f(a, pA1[r], pA1[r + 1]); b = max3f(b, pA1[r + 2], pA1[r + 3]); }
        float tm = fmaxf(a, b);
        auto rr = __builtin_amdgcn_permlane32_swap(__float_as_uint(tm), __float_as_uint(tm), false, false); tm = fmaxf(__uint_as_float(rr[0]), __uint_as_float(rr[1]));
#pragma unroll
        for (int r = 0; r < 16; ++r) { negm[r] = -tm; pA0[r] -= tm; pA1[r] -= tm; } }
    int sc = 0;
    for (int kt = kt0; kt < kt1; kt += 2) {
        { const int sp = (kt == kt0) ? sc : (sc == 0 ? NS - 1 : sc - 1), s1 = (sc == NS - 1) ? 0 : sc + 1, s3 = (sc + 3 >= NS) ? sc + 3 - NS : sc + 3;
          if (kt + 3 < kt1) dma(kt + 3, s3);
          step(pA0, pA1, pB0, pB1, sp, s1);
          wait_bar(kt + 3 < kt1);
          sc = s1; }
        { const int sp = (sc == 0) ? NS - 1 : sc - 1, s1 = (sc == NS - 1) ? 0 : sc + 1, s3 = (sc + 3 >= NS) ? sc + 3 - NS : sc + 3;
          if (kt + 4 < kt1) dma(kt + 4, s3);
          step(pB0, pB1, pA0, pA1, sp, s1);
          wait_bar(kt + 4 < kt1);
          sc = s1; }
    }
    {
        const int sp = (sc == 0) ? NS - 1 : sc - 1;
        const LAS unsigned char* vb = lds + sp * SLOT + KB + vlane;
        s16x4 lo = vtr(vb), hh = vtr(vb + 1024);
#pragma unroll
        for (int i = 0; i < 8; ++i) {
            s16x4 nlo = lo, nhh = hh;
            if (i + 1 < 8) { const int o2 = ((i + 1) >> 2) * 64 + ((i + 1) & 3) * 2048; nlo = vtr(vb + o2); nhh = vtr(vb + o2 + 1024); }
            const bf16x8 vf = (bf16x8){lo[0], lo[1], lo[2], lo[3], hh[0], hh[1], hh[2], hh[3]};
            oT[i >> 2] = __builtin_amdgcn_mfma_f32_32x32x16_bf16(vf, pf[i & 3], oT[i >> 2], 0, 0, 0);
            lo = nlo; hh = nhh;
        }
    }
    { auto rr = __builtin_amdgcn_permlane32_swap(__float_as_uint(lrun), __float_as_uint(lrun), false, false); lrun = __uint_as_float(rr[0]) + __uint_as_float(rr[1]); }
    const float inv = 1.0f / lrun;
    bf16_t* orow = S.O + (size_t)(q0 + wid * 32 + r32) * S.opitch;
#pragma unroll
    for (int d0 = 0; d0 < 2; ++d0)
#pragma unroll
        for (int g = 0; g < 4; ++g) { u32x2 w; w.x = cvtpk(oT[d0][4 * g] * inv, oT[d0][4 * g + 1] * inv); w.y = cvtpk(oT[d0][4 * g + 2] * inv, oT[d0][4 * g + 3] * inv);
            *(u32x2*)(orow + 32 * d0 + 8 * g + 4 * hi) = w; }
    return ovf;
}
template <int DQK>
__device__ __forceinline__ void attn_unit(const Frame& F, const AttnSrc<DQK>& S, int q0, int lat0, int ctx0, int kt0, int kt1) {
    volatile LAS unsigned* flag = (volatile LAS unsigned*)(F.lds + LDSCTL_OFF);
    const bool ovf = attn_fast<DQK>(F, S, q0, lat0, ctx0, kt0, kt1);
    if (__any(ovf) && F.lane == 0) flag[0] = 1u;
    asm volatile("s_waitcnt lgkmcnt(0)\n\ts_barrier" ::: "memory");
    const bool redo = __builtin_amdgcn_readfirstlane((int)flag[0]) != 0;
    asm volatile("s_waitcnt lgkmcnt(0)\n\ts_barrier" ::: "memory");
    if (redo) { if (F.tid == 0) flag[0] = 0u; (void)attn_run<DQK, true>(F, S, q0, lat0, ctx0, kt0, kt1); }
}

__device__ __forceinline__ int sig5(int c) { return (c & ~12) | ((c & 8) >> 1) | ((c & 4) << 1); }

__global__ void __launch_bounds__(512, 2) mk_fwd(Args args) {
    extern __shared__ __attribute__((aligned(16))) unsigned char lds_raw[];
    Frame F;
    F.lds = (LAS unsigned char*)lds_raw; F.ws = args.ws;
    F.tid = threadIdx.x; F.lane = F.tid & 63; F.wave = __builtin_amdgcn_readfirstlane(F.tid >> 6);
    F.G = gridDim.x; { const int bx = blockIdx.x; F.vcu = (F.G % 8 == 0) ? (bx % 8) * (F.G / 8) + bx / 8 : bx; }
    volatile LAS unsigned* MISC = (volatile LAS unsigned*)(F.lds + LDSCTL_OFF);
    if (F.tid < 64) MISC[F.tid] = 0u;
    __syncthreads();
    unsigned* ctl = wsp<unsigned>(F, O_CTL);
#if MK_ONE_LAUNCH
    XcdBarrier bar = xcd_barrier_post(ctl + CW_BAR, MISC + 8);
#define GRID_BAR() xcd_barrier(bar)
#else
#define GRID_BAR() do {} while (0)
#endif
    const int lo = args.ph_lo, hi_ph = args.ph_hi;
#define IN(k) (lo <= (k) && (k) < hi_ph)
#define SEAM(k) do { if (IN(k) && IN((k) + 1)) GRID_BAR(); } while (0)
    const int lane = F.lane, wave = F.wave, tid = F.tid;
    const int gw = F.vcu * 8 + wave, NGW = F.G * 8;

    const float* x_in = args.in[I_X]; const float* ctx_in = args.in[I_CTX];
    float* MODV = wsp<float>(F, O_MODV);
    float* TAB16 = wsp<float>(F, O_TAB16); float* TAB32 = wsp<float>(F, O_TAB32);
    float* HC = wsp<float>(F, O_HC);
    bf16_t* U = wsp<bf16_t>(F, O_U);
    float* Y = wsp<float>(F, O_Y);
    const float* normg = args.in[I_NORMG];
#define MV(layer, bidx, k) (MODV + ((size_t)((layer) * 5 + (bidx)) * 6 + (k)) * D)

    if (IN(0)) {
        {
            LAS float* sc = (LAS float*)F.lds;
            LAS float* red = sc + 5 * 1024;
            for (int i = tid; i < 5 * 1024; i += 512) { const int b = i >> 10, k = i & 1023; const float cv = (b < 4) ? args.in[I_C][b * 1024 + k] : args.in[I_CCTX][k]; sc[i] = cv / (1.0f + __expf(-cv)); }
            __syncthreads();
            for (int unit = F.vcu; unit < 192; unit += F.G) {
                const int layer = unit / 96, cb = unit % 96, col = cb * 64 + lane;
                const float* W = args.in[I_MODW] + (size_t)layer * D * 6144 + col;
                float a0 = 0.f, a1 = 0.f, a2 = 0.f, a3 = 0.f, a4 = 0.f;
#pragma unroll 16
                for (int kk = 0; kk < 128; ++kk) { const int k = wave * 128 + kk; const float w = __builtin_nontemporal_load(W + (size_t)k * 6144);
                    a0 += sc[k] * w; a1 += sc[1024 + k] * w; a2 += sc[2048 + k] * w; a3 += sc[3072 + k] * w; a4 += sc[4096 + k] * w; }
                red[(wave * 5 + 0) * 64 + lane] = a0; red[(wave * 5 + 1) * 64 + lane] = a1; red[(wave * 5 + 2) * 64 + lane] = a2; red[(wave * 5 + 3) * 64 + lane] = a3; red[(wave * 5 + 4) * 64 + lane] = a4;
                __syncthreads();
                if (tid < 320) { const int b = tid >> 6, cc = tid & 63; float s = 0.f;
#pragma unroll
                    for (int w = 0; w < 8; ++w) s += red[(w * 5 + b) * 64 + cc];
                    MODV[(size_t)(layer * 5 + b) * 6144 + cb * 64 + cc] = s + args.in[I_MODB][layer * 6144 + cb * 64 + cc]; }
                __syncthreads();
            }
        }
        {
            const bool spread = F.G >= 256; const bool mine = spread ? (F.vcu >= 192 && F.vcu < 256) : (blockIdx.x == 0);
            const int sl = spread ? F.vcu - 192 : 0, n16 = spread ? 8 : 512, n32 = spread ? 16 : 1024;
            if (mine) {
                for (int t = tid; t < n16; t += 512) { const int i = sl * n16 + t; const int pos = i >> 3, f = i & 7; const float fr = powf(10000.0f, -(float)f / 8.0f), a = (float)pos * fr; TAB16[i] = cosf(a); TAB16[512 + i] = sinf(a); }
                for (int t = tid; t < n32; t += 512) { const int i = sl * n32 + t; const int pos = i >> 4, f = i & 15; const float fr = powf(10000.0f, -(float)f / 16.0f), a = (float)pos * fr; TAB32[i] = cosf(a); TAB32[1024 + i] = sinf(a); }
            }
        }
        {
            LAS float* scr = (LAS float*)(F.lds + wave * 16640);
            int base = 0;
            auto run = [&](const Conv& c) { const int n = (c.K / 64) * (c.Ndst / 32); for (int it = gw - base; it < n; it += NGW) { if (it >= 0) conv_item(c, it, scr, lane); }
                base = (base + n) % NGW; };
            auto run64 = [&](const Conv64& c) { conv64_run(c, scr, lane, gw, NGW, base); };
            run64(Conv64{args.in[I_FWG], args.in[I_FWU], FFN, 1024, N_GU0, wsp<bf16_t>(F, O_WGU0), 3, 0, 0, 64.0f, 1});
            run64(Conv64{args.in[I_FWD], nullptr, 1024, FFN, 1024, wsp<bf16_t>(F, O_WD0), 0, 1024, 1024, 64.0f, 1});
            run64(Conv64{args.in[I_GWIN], nullptr, 3104, 1024, N_IN1, wsp<bf16_t>(F, O_WIN1), 0, 3104, 512, 0.08838834764831845f, 0});
            run64(Conv64{args.in[I_GWOUT], nullptr, 1024, 1024, 1024, wsp<bf16_t>(F, O_WOUT1), 0, 1024, 0, 1.0f, 0});
            run64(Conv64{args.in[I_AWOUT], nullptr, 1024, 1024, 1024, wsp<bf16_t>(F, O_WOUT0), 0, 1024, 0, 1.0f, 0});
            run(Conv{args.in[I_AWIN], nullptr, 1440, 1024, N_IN0, wsp<bf16_t>(F, O_WIN0), 1, nullptr});
            run(Conv{args.in[I_AWUQ], nullptr, 768, 384, N_QA, wsp<bf16_t>(F, O_WUQ), 2, args.in[I_AQN]});
            run(Conv{args.in[I_AWUKV], nullptr, 1024, 256, N_KVA, wsp<bf16_t>(F, O_WUKV), 0, args.in[I_AKVN]});
        }
    }
    SEAM(0);

    if (IN(1)) {
        for (int row = gw; row < R; row += 2 * NGW) {
            const int rb = row + NGW; const bool hb = rb < R;
            f32x4 ha[4], hb4[4], uo[4];
            { const f32x4* ra = (const f32x4*)(row < RL ? x_in + (size_t)row * D : ctx_in + (size_t)(row - RL) * D) + lane;
#pragma unroll
              for (int j = 0; j < 4; ++j) ha[j] = __builtin_nontemporal_load(ra + 64 * j); }
            if (hb) { const f32x4* rb4 = (const f32x4*)(rb < RL ? x_in + (size_t)rb * D : ctx_in + (size_t)(rb - RL) * D) + lane;
#pragma unroll
              for (int j = 0; j < 4; ++j) hb4[j] = __builtin_nontemporal_load(rb4 + 64 * j); }
            norm_mod_store(ha, normg + 0 * D, MV(0, row_bidx(row), 0), MV(0, row_bidx(row), 1), U + (size_t)row * D, lane, uo);
            if (hb) norm_mod_store(hb4, normg + 0 * D, MV(0, row_bidx(rb), 0), MV(0, row_bidx(rb), 1), U + (size_t)rb * D, lane, uo);
        }
    }
    SEAM(1);

    if (IN(2)) {
        pg8::DenseProb P{U, wsp<bf16_t>(F, O_WIN0), 1024, 1024, 1024, {}}; P.ord.init(R / 256, N_IN0 / 256, F.G, (int)blockIdx.x);
        pg8::EpiBf16 E{wsp<bf16_t>(F, O_Z0), N_IN0, nullptr};
        pg8::gemm_phase(F.lds, P, E);
    }
    SEAM(2);

    if (IN(3)) {
        const bf16_t* Z0 = wsp<bf16_t>(F, O_Z0);
        float* RSQ = wsp<float>(F, O_RSTDQ); float* RSKV = wsp<float>(F, O_RSTDKV);
        bf16_t* QB = wsp<bf16_t>(F, O_QB); bf16_t* KBp = wsp<bf16_t>(F, O_KB); bf16_t* KR = wsp<bf16_t>(F, O_KR);
        const float* qkn = args.in[I_AQKN];
        const int jp = lane & 7, half = jp >> 2, i0 = 4 * (jp & 3);
        float gq[8], gk[8];
#pragma unroll
        for (int pz = 0; pz < 4; ++pz) { gq[2 * pz] = qkn[half * 32 + i0 + pz]; gq[2 * pz + 1] = qkn[half * 32 + 16 + i0 + pz]; gk[2 * pz] = qkn[64 + half * 32 + i0 + pz]; gk[2 * pz + 1] = qkn[64 + half * 32 + 16 + i0 + pz]; }
        for (int row0 = gw; row0 < R; row0 += 2 * NGW) {
            const int rws[2] = {row0, row0 + NGW}; const bool has[2] = {true, row0 + NGW < R};
            unsigned za[2][3], zb[2][2]; u32x4 wq[2], wk[2], wr4[2];
#pragma unroll
            for (int q = 0; q < 2; ++q) { if (!has[q]) continue; const bf16_t* zr = Z0 + (size_t)rws[q] * N_IN0; const unsigned* z32 = (const unsigned*)zr;
#pragma unroll
                for (int j = 0; j < 3; ++j) za[q][j] = z32[lane + 64 * j];
#pragma unroll
                for (int j = 0; j < 2; ++j) zb[q][j] = z32[192 + lane + 64 * j];
                wq[q] = *(const u32x4*)(zr + 640 + lane * 8);
                wk[q] = (lane < 16) ? *(const u32x4*)(zr + 1152 + lane * 8) : (u32x4){0u, 0u, 0u, 0u};
                wr4[q] = (lane < 4) ? *(const u32x4*)(zr + 1408 + lane * 8) : (u32x4){0u, 0u, 0u, 0u}; }
#pragma unroll
            for (int q = 0; q < 2; ++q) { if (!has[q]) continue; const int row = rws[q];
            float s = 0.f;
#pragma unroll
            for (int j = 0; j < 3; ++j) { const float a = bflo(za[q][j]), b = bfhi(za[q][j]); s += a * a + b * b; }
            s = wave_sum(s);
            float s2 = 0.f;
#pragma unroll
            for (int j = 0; j < 2; ++j) { const float a = bflo(zb[q][j]), b = bfhi(zb[q][j]); s2 += a * a + b * b; }
            s2 = wave_sum(s2);
            if (lane == 0) { RSQ[row] = __builtin_amdgcn_rsqf(s * (1.0f / 384.0f) + EPS); RSKV[row] = __builtin_amdgcn_rsqf(s2 * (1.0f / 256.0f) + EPS); }
            const bool lat = row < RL; const int tt = row & (SEQ - 1);
#pragma unroll
            for (int which = 0; which < 2; ++which) {
                if (which == 1 && lane >= 16) break;
                const u32x4 w4 = which ? wk[q] : wq[q];
                float v[8] = {bflo(w4.x), bfhi(w4.x), bflo(w4.y), bfhi(w4.y), bflo(w4.z), bfhi(w4.z), bflo(w4.w), bfhi(w4.w)};
                float ss = 0.f;
#pragma unroll
                for (int j = 0; j < 8; ++j) ss += v[j] * v[j];
                ss = oct_sum(ss);
                const float rstd = __builtin_amdgcn_rsqf(ss * (1.0f / 64.0f) + EPS);
#pragma unroll
                for (int j = 0; j < 8; ++j) v[j] *= rstd * (which ? gk[j] : gq[j]);
                if (lat) { const int pos = half ? (tt & 63) : (tt >> 6);
                    const f32x4 cs = *(const f32x4*)(TAB32 + pos * 16 + i0), sn = *(const f32x4*)(TAB32 + 1024 + pos * 16 + i0);
#pragma unroll
                    for (int pz = 0; pz < 4; ++pz) { const float a = v[2 * pz], b = v[2 * pz + 1]; v[2 * pz] = a * cs[pz] - b * sn[pz]; v[2 * pz + 1] = b * cs[pz] + a * sn[pz]; } }
                const float osc = which ? 1.0f : 0.125f * LOG2E;
                u32x4 o; o.x = cvtpk(v[0] * osc, v[1] * osc); o.y = cvtpk(v[2] * osc, v[3] * osc); o.z = cvtpk(v[4] * osc, v[5] * osc); o.w = cvtpk(v[6] * osc, v[7] * osc);
                if (which == 0) *(u32x4*)(QB + (size_t)row * 512 + lane * 8) = o; else *(u32x4*)(KBp + (size_t)row * 128 + lane * 8) = o;
            }
            if (lane < 4) {
                const u32x4 w4 = wr4[q];
                float v[8] = {bflo(w4.x), bfhi(w4.x), bflo(w4.y), bfhi(w4.y), bflo(w4.z), bfhi(w4.z), bflo(w4.w), bfhi(w4.w)};
                if (lat) { const int half2 = lane >> 1, i02 = 4 * (lane & 1); const int pos = half2 ? (tt & 63) : (tt >> 6);
                    const f32x4 cs = *(const f32x4*)(TAB16 + pos * 8 + i02), sn = *(const f32x4*)(TAB16 + 512 + pos * 8 + i02);
#pragma unroll
                    for (int pz = 0; pz < 4; ++pz) { const float a = v[2 * pz], b = v[2 * pz + 1]; v[2 * pz] = a * cs[pz] - b * sn[pz]; v[2 * pz + 1] = b * cs[pz] + a * sn[pz]; } }
                u32x4 o; o.x = cvtpk(v[0], v[1]); o.y = cvtpk(v[2], v[3]); o.z = cvtpk(v[4], v[5]); o.w = cvtpk(v[6], v[7]);
                *(u32x4*)(KR + (size_t)row * 32 + lane * 8) = o;
            }
            }
        }
    }
    SEAM(3);

    if (IN(4)) {
        { pg8::DenseProb P{wsp<bf16_t>(F, O_Z0), wsp<bf16_t>(F, O_WUQ), 384, N_IN0, 384, {}}; P.ord.init(R / 256, N_QA / 256, F.G, (int)blockIdx.x);
          pg8::EpiQA E{wsp<bf16_t>(F, O_QA), wsp<float>(F, O_RSTDQ), TAB16, 0.10206207261596577f * LOG2E};
          pg8::gemm_phase(F.lds, P, E); }
        { pg8::DenseProb P{wsp<bf16_t>(F, O_Z0) + 384, wsp<bf16_t>(F, O_WUKV), 256, N_IN0, 256, {}}; P.ord.init(R / 256, N_KVA / 256, F.G, (int)((blockIdx.x + F.G - (204 % F.G)) % F.G));
          pg8::EpiBf16 E{wsp<bf16_t>(F, O_KVA), N_KVA, wsp<float>(F, O_RSTDKV)};
          pg8::gemm_phase(F.lds, P, E); }
    }
    SEAM(4);

    if (IN(5)) {
        const bf16_t* QA = wsp<bf16_t>(F, O_QA); const bf16_t* KVA = wsp<bf16_t>(F, O_KVA); const bf16_t* QB = wsp<bf16_t>(F, O_QB);
        const bf16_t* KBp = wsp<bf16_t>(F, O_KB); const bf16_t* KR = wsp<bf16_t>(F, O_KR); const bf16_t* Z0 = wsp<bf16_t>(F, O_Z0);
        bf16_t* AO = wsp<bf16_t>(F, O_AO);
        for (int i = 0; i < 3; ++i) {
            int b, hh, q0, kt0, kt1;
            if (i < 2) { const int m = i * 256 + F.vcu; b = m >> 7; hh = (m >> 4) & 7; q0 = b * SEQ + (m & 15) * 256; kt0 = 0; kt1 = 68; }
            else { if (F.vcu >= 32) break; b = (F.vcu >> 3) & 3; hh = F.vcu & 7; q0 = RL + b * CTX; kt0 = 64; kt1 = 68; }
            const int lat0 = b * SEQ, ctx0 = RL + b * CTX;
            AttnSrc<96> S{QA + hh * 64, N_QA, QA + 512 + hh * 32, KVA + hh * 128, N_KVA, KR, 32, KVA + hh * 128 + 64, N_KVA, AO + hh * 64, D};
            attn_unit<96>(F, S, q0, lat0, ctx0, kt0, kt1);
        }
        for (int i = 0; i < 3; ++i) {
            int b, hh, q0, kt0, kt1;
            if (i < 2) { const int m = i * 256 + F.vcu; b = m >> 7; hh = (m >> 4) & 7; q0 = b * SEQ + (m & 15) * 256; kt0 = 0; kt1 = 68; }
            else { if (F.vcu < 32 || F.vcu >= 64) break; b = (F.vcu >> 3) & 3; hh = F.vcu & 7; q0 = RL + b * CTX; kt0 = 64; kt1 = 68; }
            const int lat0 = b * SEQ, ctx0 = RL + b * CTX; const int kvh = hh >> 2;
            AttnSrc<64> S{QB + hh * 64, 512, nullptr, KBp + kvh * 64, 128, nullptr, 0, Z0 + 1280 + kvh * 64, N_IN0, AO + 512 + hh * 64, D};
            attn_unit<64>(F, S, q0, lat0, ctx0, kt0, kt1);
        }
    }
    SEAM(5);

    if (IN(6)) {
        pg8::DenseProb P{wsp<bf16_t>(F, O_AO), wsp<bf16_t>(F, O_WOUT0), 1024, 1024, 1024, {}}; P.ord.init(RL / 256, 4, F.G, (int)blockIdx.x);
        pg8::EpiBf16 E{(bf16_t*)Y, D, nullptr};
        pg8::gemm_phase(F.lds, P, E);
    }
    SEAM(6);


    auto ld_yh = [&](const bf16_t* yrow, const float* hrow, u32x2 (&yr)[4], f32x4 (&h)[4], bool nth = false) {
#pragma unroll
        for (int j = 0; j < 4; ++j) { yr[j] = *(const u32x2*)(yrow + 4 * lane + 256 * j); h[j] = nth ? __builtin_nontemporal_load((const f32x4*)hrow + lane + 64 * j) : *((const f32x4*)hrow + lane + 64 * j); } };
    auto cvt_y = [&](const u32x2 (&yr)[4], f32x4 (&y)[4]) {
#pragma unroll
        for (int j = 0; j < 4; ++j) { y[j][0] = bflo(yr[j].x); y[j][1] = bfhi(yr[j].x); y[j][2] = bflo(yr[j].y); y[j][3] = bfhi(yr[j].y); } };
    auto rows2 = [&](int start, int end, int stride, auto&& ld, auto&& cp) {
        for (int row = start; row < end; row += 2 * stride) {
            const int rb = row + stride; const bool hb = rb < end;
            u32x2 ya[4], yb[4]; f32x4 ha[4], hb4[4];
            ld(row, ya, ha); if (hb) ld(rb, yb, hb4);
            cp(row, ya, ha); if (hb) cp(rb, yb, hb4);
        }
    };
    auto post0_ld = [&](int row, u32x2 (&yr)[4], f32x4 (&h)[4]) {
        ld_yh((const bf16_t*)Y + (size_t)row * D, row < RL ? x_in + (size_t)row * D : ctx_in + (size_t)(row - RL) * D, yr, h, true); };
    auto post0_cp = [&](int row, const u32x2 (&yr)[4], f32x4 (&h)[4]) {
            float* ho = row < RL ? args.out + (size_t)row * D : HC + (size_t)(row - RL) * D;
            const int b = row_bidx(row);
            f32x4 y[4], uo[4]; cvt_y(yr, y);
            const float rstd = __builtin_amdgcn_rsqf(row_ssq(y) * (1.0f / D) + EPS);
#pragma unroll
            for (int j = 0; j < 4; ++j) { const int c = 4 * lane + 256 * j; const f32x4 g = *(const f32x4*)(normg + 1 * D + c), mg = *(const f32x4*)(MV(0, b, 2) + c);
                h[j] = h[j] + mg * (y[j] * rstd * g); *(f32x4*)(ho + c) = h[j]; }
            norm_mod_store(h, normg + 2 * D, MV(0, b, 3), MV(0, b, 4), nullptr, lane, uo, wsp<unsigned char>(F, O_U) + (size_t)row * D);
    };
    if (IN(7)) {
        const bool split = F.G > 32;
        if (!split || blockIdx.x < 16) {
            pg8::DenseProb P{wsp<bf16_t>(F, O_AO) + (size_t)RL * D, wsp<bf16_t>(F, O_WOUT0), 1024, 1024, 1024, {}}; P.ord.init(RC / 256, 4, split ? 16 : F.G, (int)blockIdx.x);
            pg8::EpiBf16 E{(bf16_t*)Y + (size_t)RL * D, D, nullptr};
            pg8::gemm_phase(F.lds, P, E);
        }
        if (!split) rows2(gw, RL, NGW, post0_ld, post0_cp);
        else if (blockIdx.x >= 16) rows2(((int)blockIdx.x - 16) * 8 + wave, RL, (F.G - 16) * 8, post0_ld, post0_cp);
    }
    SEAM(7);
    if (IN(8)) rows2(RL + gw, R, NGW, post0_ld, post0_cp);
    SEAM(8);


    if (IN(9)) {
        pg8::DenseProb8<125, 121> P{wsp<unsigned char>(F, O_U), wsp<unsigned char>(F, O_WGU0), 512, 512, 1024, {}}; P.ord.init(R / 256, N_GU0 / 256, F.G, (int)blockIdx.x);
        pg8::EpiSwiglu8 E{wsp<unsigned char>(F, O_H0), FFN};
        pg8::gemm_phase(F.lds, P, E);
    }
    SEAM(9);
    if (IN(10)) {
        pg8::DenseProb8<124, 121> P{wsp<unsigned char>(F, O_H0), wsp<unsigned char>(F, O_WD0), FFN / 2, FFN / 2, FFN, {}}; P.ord.init(RL / 256, 4, F.G, (int)blockIdx.x);
        pg8::EpiBf16 E{(bf16_t*)Y, D, nullptr};
        pg8::gemm_phase(F.lds, P, E);
    }
    SEAM(10);


    auto post1_ld = [&](int row, u32x2 (&yr)[4], f32x4 (&h)[4]) {
        ld_yh((const bf16_t*)Y + (size_t)row * D, row < RL ? args.out + (size_t)row * D : HC + (size_t)(row - RL) * D, yr, h); };
    auto post1_cp = [&](int row, const u32x2 (&yr)[4], f32x4 (&h)[4]) {
            float* hp = row < RL ? args.out + (size_t)row * D : HC + (size_t)(row - RL) * D;
            const int b = row_bidx(row);
            f32x4 y[4], uo[4]; cvt_y(yr, y);
            const float rstd = __builtin_amdgcn_rsqf(row_ssq(y) * (1.0f / D) + EPS);
#pragma unroll
            for (int j = 0; j < 4; ++j) { const int c = 4 * lane + 256 * j; const f32x4 g = *(const f32x4*)(normg + 3 * D + c), mg = *(const f32x4*)(MV(0, b, 5) + c);
                h[j] = h[j] + mg * (y[j] * rstd * g); *(f32x4*)(hp + c) = h[j]; }
            norm_mod_store(h, normg + 4 * D, MV(1, b, 0), MV(1, b, 1), U + (size_t)row * D, lane, uo);
    };
    if (IN(11)) {
        const bool split = F.G > 32;
        if (!split || blockIdx.x < 16) {
            pg8::DenseProb8<124, 121> P{wsp<unsigned char>(F, O_H0) + (size_t)RL * FFN, wsp<unsigned char>(F, O_WD0), FFN / 2, FFN / 2, FFN, {}}; P.ord.init(RC / 256, 4, split ? 16 : F.G, (int)blockIdx.x);
            pg8::EpiBf16 E{(bf16_t*)Y + (size_t)RL * D, D, nullptr};
            pg8::gemm_phase(F.lds, P, E);
        }
        if (!split) rows2(gw, RL, NGW, post1_ld, post1_cp);
        else if (blockIdx.x >= 16) rows2(((int)blockIdx.x - 16) * 8 + wave, RL, (F.G - 16) * 8, post1_ld, post1_cp);
    }
    SEAM(11);
    if (IN(12)) rows2(RL + gw, R, NGW, post1_ld, post1_cp);
    SEAM(12);


    if (IN(13)) {
        pg8::DenseProb P{U, wsp<bf16_t>(F, O_WIN1), 1024, 1024, 1024, {}}; P.ord.init(R / 256, N_IN1 / 256, F.G, (int)blockIdx.x);
        pg8::EpiIn1 E{wsp<bf16_t>(F, O_QK1), wsp<bf16_t>(F, O_V1), wsp<bf16_t>(F, O_G1), wsp<bf16_t>(F, O_RR)};
        pg8::gemm_phase(F.lds, P, E);
    }
    SEAM(13);

    if (IN(14)) {
        const bf16_t* QK1 = wsp<bf16_t>(F, O_QK1); const bf16_t* V1 = wsp<bf16_t>(F, O_V1); const bf16_t* RRp = wsp<bf16_t>(F, O_RR);
        bf16_t* QDd[2] = {wsp<bf16_t>(F, O_QDF), wsp<bf16_t>(F, O_QDB)}; bf16_t* KId[2] = {wsp<bf16_t>(F, O_KIF), wsp<bf16_t>(F, O_KIB)}; bf16_t* KTd[2] = {wsp<bf16_t>(F, O_KTF), wsp<bf16_t>(F, O_KTB)};
        float* ECL = wsp<float>(F, O_ECL);
        LAS float* tot = (LAS float*)F.lds;
        LAS float* rrs = (LAS float*)(F.lds + 16384);
        LAS float* zs = (LAS float*)(F.lds + 16384 + 2 * 32 * 36 * 4);
        const int r32 = lane & 31, hi = lane >> 5, wd = wave >> 2, wcb = wave & 3;
        const int dkp = tid & 63, dk0 = 2 * dkp, tq = tid >> 6;
        float w2a[8], bg[2][2];
        unsigned rrw = 0, qw[4], kw[4];
        auto loadp = [&](int item) {
            const int rc = item >> 2, hh = item & 3, row0 = rc * 32;
            rrw = ((const unsigned*)(RRp + (size_t)(row0 + (tid >> 4)) * 256))[tid & 15];
#pragma unroll
            for (int i = 0; i < 4; ++i) { const int row = row0 + 4 * tq + i;
                qw[i] = *(const unsigned*)(QK1 + (size_t)row * D + hh * 128 + dk0); kw[i] = *(const unsigned*)(QK1 + (size_t)row * D + 512 + hh * 128 + dk0); }
        };
        unsigned pq[4][2], pk[4][2]; float pe[4]; int prev = -1;
        auto store_prev = [&]() {
            const int rc = prev >> 2, hh = prev & 3, row0 = rc * 32;
            const int pc = hh * 128 + (dk0 & ~31) + sig5(dk0 & 31);
#pragma unroll
            for (int i = 0; i < 4; ++i) { const int row = row0 + 4 * tq + i;
#pragma unroll
                for (int d = 0; d < 2; ++d) { *(unsigned*)(QDd[d] + (size_t)row * 512 + pc) = pq[i][d]; *(unsigned*)(KId[d] + (size_t)row * 512 + pc) = pk[i][d]; } }
            if (tq == 0) { *(f32x2_t*)(ECL + ((size_t)(rc * 2 + 0) * 4 + hh) * 256 + dk0) = (f32x2_t){pe[0], pe[1]};
                           *(f32x2_t*)(ECL + ((size_t)(rc * 2 + 1) * 4 + hh) * 256 + dk0) = (f32x2_t){pe[2], pe[3]}; }
        };
        auto load_w = [&](int hh) {
#pragma unroll
            for (int d = 0; d < 2; ++d) { const f32x2_t bv = *(const f32x2_t*)(args.in[I_GBGATE] + d * 512 + hh * 128 + dk0); bg[d][0] = bv[0]; bg[d][1] = bv[1]; }
#pragma unroll
            for (int sI = 0; sI < 8; ++sI) w2a[sI] = args.in[I_GGATE2][(size_t)(wd * 16 + 2 * sI + hi) * 512 + hh * 128 + wcb * 32 + r32];
        };
        int par = 0;
        auto process = [&](int item) {
            LAS float* rrp = rrs + par * (32 * 36); LAS float* totp = tot + par * 2048;
            { const int rt = tid >> 4, o = 2 * (tid & 15), dd = o >> 4, sI = (o & 15) >> 1;
              rrp[rt * 36 + dd * 16 + sI] = bflo(rrw); rrp[rt * 36 + dd * 16 + 8 + sI] = bfhi(rrw); }
            unsigned cq[4], ck[4];
#pragma unroll
            for (int i = 0; i < 4; ++i) { cq[i] = qw[i]; ck[i] = kw[i]; }
            asm volatile("s_waitcnt lgkmcnt(0)\n\ts_barrier" ::: "memory");
            if (prev >= 0) store_prev();
            if (item + F.G < 544 * 4) loadp(item + F.G);
            {
                const LAS f32x4* bp = (const LAS f32x4*)(rrp + r32 * 36 + wd * 16 + hi * 8);
                const f32x4 b0 = bp[0], b1 = bp[1];
                const float bv[8] = {b0[0], b0[1], b0[2], b0[3], b1[0], b1[1], b1[2], b1[3]};
                f32x16 zt;
#pragma unroll
                for (int r = 0; r < 16; ++r) zt[r] = 0.f;
#pragma unroll
                for (int sI = 0; sI < 8; ++sI) zt = __builtin_amdgcn_mfma_f32_32x32x2f32(w2a[sI], bv[sI], zt, 0, 0, 0);
                LAS float* zp = zs + (wd * 32 + r32) * 132 + wcb * 32 + 4 * hi;
#pragma unroll
                for (int g = 0; g < 4; ++g) *(LAS f32x4*)(zp + 8 * g) = (f32x4){zt[4 * g], zt[4 * g + 1], zt[4 * g + 2], zt[4 * g + 3]};
            }
            asm volatile("s_waitcnt lgkmcnt(0)\n\ts_barrier" ::: "memory");
            float a[2][4][2];
#pragma unroll
            for (int i = 0; i < 4; ++i)
#pragma unroll
                for (int d = 0; d < 2; ++d) { const f32x2_t zv = *(const LAS f32x2_t*)(zs + (d * 32 + 4 * tq + i) * 132 + dk0);
#pragma unroll
                    for (int c = 0; c < 2; ++c) { const float z = zv[c] + bg[d][c];
                        a[d][i][c] = (fminf(z, 0.f) - __logf(1.0f + __expf(-fabsf(z)))) * (1.0f / 16.0f); } }
            float cf[4][2], sb[4][2];
#pragma unroll
            for (int c = 0; c < 2; ++c) { float sfw = 0.f;
#pragma unroll
                for (int i = 0; i < 4; ++i) { sfw += a[0][i][c]; cf[i][c] = sfw; }
                float sbw = 0.f;
#pragma unroll
                for (int i = 3; i >= 0; --i) { sbw += a[1][i][c]; sb[i][c] = sbw; } }
            *(LAS f32x2_t*)(totp + (0 * 8 + tq) * 128 + dk0) = (f32x2_t){cf[3][0], cf[3][1]};
            *(LAS f32x2_t*)(totp + (1 * 8 + tq) * 128 + dk0) = (f32x2_t){sb[0][0], sb[0][1]};
            asm volatile("s_waitcnt lgkmcnt(0)\n\ts_barrier" ::: "memory");
            float offF[2] = {0.f, 0.f}, offB[2] = {0.f, 0.f}, clF[2] = {0.f, 0.f}, clB[2] = {0.f, 0.f};
#pragma unroll
            for (int g = 0; g < 8; ++g) { const f32x2_t tf = *(const LAS f32x2_t*)(totp + (0 * 8 + g) * 128 + dk0), tb = *(const LAS f32x2_t*)(totp + (1 * 8 + g) * 128 + dk0);
#pragma unroll
                for (int c = 0; c < 2; ++c) { clF[c] += tf[c]; clB[c] += tb[c]; if (g < tq) offF[c] += tf[c]; if (g > tq) offB[c] += tb[c]; } }
#pragma unroll
            for (int i = 0; i < 4; ++i) {
                const float q[2] = {bflo(cq[i]), bfhi(cq[i])}, k[2] = {bflo(ck[i]), bfhi(ck[i])};
                float qdv[2][2], kiv[2][2];
#pragma unroll
                for (int c = 0; c < 2; ++c) { const float cF = offF[c] + cf[i][c], cB = offB[c] + sb[i][c];
                    qdv[0][c] = q[c] * __expf(cF); kiv[0][c] = k[c] * __expf(-cF); qdv[1][c] = q[c] * __expf(cB); kiv[1][c] = k[c] * __expf(-cB); }
#pragma unroll
                for (int d = 0; d < 2; ++d) { pq[i][d] = cvtpk(qdv[d][0], qdv[d][1]); pk[i][d] = cvtpk(kiv[d][0], kiv[d][1]); } }
            pe[0] = __expf(clF[0]); pe[1] = __expf(clF[1]); pe[2] = __expf(clB[0]); pe[3] = __expf(clB[1]);
            prev = item; par ^= 1;
        };
        if (F.vcu < 544 * 4) loadp(F.vcu);
        if ((F.G & 3) == 0) { load_w(F.vcu & 3);
#pragma unroll
            for (int d = 0; d < 2; ++d) asm volatile("" : "+v"(bg[d][0]), "+v"(bg[d][1]));
#pragma unroll
            for (int sI = 0; sI < 8; ++sI) asm volatile("" : "+v"(w2a[sI]));
            for (int item = F.vcu; item < 544 * 4; item += F.G) process(item); }
        else { for (int item = F.vcu; item < 544 * 4; item += F.G) { load_w(item & 3); process(item); } }
        if (prev >= 0) store_prev();
    }
    SEAM(14);

    if (IN(15)) {
        const int xl = blockIdx.x & 7, jj = blockIdx.x >> 3;
        const bool scan_role = (jj & 1) == 0;
        const int nscan = ((F.G >> 3) + 1) / 2 * 8, nconv = F.G - nscan;
        if ((F.G & 7) == 0 && nconv > 0 && !scan_role) {
            LAS float* scr = (LAS float*)(F.lds + wave * 16640);
            const int cidx = xl * (F.G >> 4) + (jj >> 1); int base = 0; const int gwi = cidx * 8 + wave, ngw = nconv * 8;
            for (int e = 0; e < NEXP; ++e) {
                conv64_run(Conv64{args.in[I_MWG] + (size_t)e * D * EXD, args.in[I_MWU] + (size_t)e * D * EXD, EXD, 1024, N_GU1, wsp<bf16_t>(F, O_WGU1) + (size_t)e * N_GU1 * 1024 / 2, 3, 0, 0, 64.0f, 3}, scr, lane, gwi, ngw, base);
                conv64_run(Conv64{args.in[I_MWD] + (size_t)e * EXD * D, nullptr, 1024, EXD, 1024, wsp<bf16_t>(F, O_WD1) + (size_t)e * 1024 * EXD / 2, 0, 1024, 1024, 64.0f, 3}, scr, lane, gwi, ngw, base);
            }
        } else {
        const bool split = (F.G & 7) == 0 && nconv > 0;
        const int sidx = split ? xl * ((F.G >> 4) + ((F.G >> 3) & 1)) + (jj >> 1) : F.vcu, nsw = split ? nscan : F.G;
        const bf16_t* V1s = wsp<bf16_t>(F, O_V1); const float* ECL = wsp<float>(F, O_ECL);
        constexpr int SLOT = 8192 * 2 + 2 * 2048 + 1024;
        const int r32 = lane & 31, hi = lane >> 5;
        for (int unit = sidx; unit < 128; unit += nsw) {
            const int chain = unit >> 2, dvp = unit & 3, b = chain >> 3, hh = (chain >> 1) & 3, dir = chain & 1;
            const int dvb = dvp * 2 + (wave & 1);
            const bf16_t* QDp = wsp<bf16_t>(F, dir ? O_QDB : O_QDF); const bf16_t* KIp = wsp<bf16_t>(F, dir ? O_KIB : O_KIF);
            bf16_t* Odp = wsp<bf16_t>(F, dir ? O_OB : O_OF);
            auto rcof = [&](int step) { return step < 8 ? 512 + b * 8 + (dir ? 7 - step : step) : b * 128 + (dir ? 127 - (step - 8) : (step - 8)); };
            const unsigned lds0 = (unsigned)(size_t)F.lds;
            auto dma = [&](int step, int slot) {
                if (wave < 2) return;
                const int rc = rcof(step); const unsigned sb = lds0 + slot * SLOT;
#pragma unroll
                for (int i = 0; i < 4; ++i) { const int j = (wave - 2) + 6 * i; if (j >= 21) break;
                    if (j < 16) { const int p = j & 7; const int r = 4 * p + (lane >> 4), c = (lane & 15) ^ (r & 15);
                        glds16((j < 8 ? KIp : QDp) + (size_t)(rc * 32 + r) * 512 + hh * 128 + c * 8, (unsigned)__builtin_amdgcn_readfirstlane(sb + j * 1024)); }
                    else if (j < 20) { const int p = j - 16; const int t8 = lane >> 3, c = (lane & 7) ^ (((t8 >> 1) & 1) << 1);
                        glds16(V1s + (size_t)(rc * 32 + 8 * p + t8) * D + hh * 256 + dvp * 64 + c * 8, (unsigned)__builtin_amdgcn_readfirstlane(sb + 16384 + p * 1024)); }
                    else glds16(ECL + ((size_t)(rc * 2 + dir) * 4 + hh) * 256 + lane * 4, (unsigned)__builtin_amdgcn_readfirstlane(sb + 20480)); }
            };
            auto wait_bar = [&](int ngrp) { if (wave < 2) { asm volatile("s_waitcnt lgkmcnt(0)\n\ts_barrier" ::: "memory"); }
                else if (ngrp == 0) { WAIT_BAR(0); } else if (ngrp == 1) { if (wave < 5) { WAIT_BAR(4); } else { WAIT_BAR(3); } } else { if (wave < 5) { WAIT_BAR(8); } else { WAIT_BAR(6); } } };
            unsigned km[8];
#pragma unroll
            for (int j = 0; j < 8; ++j) { const int r0 = 2 * j, r1 = 2 * j + 1; const int s0 = (r0 & 3) + 8 * (r0 >> 2) + 4 * hi, s1 = (r1 & 3) + 8 * (r1 >> 2) + 4 * hi;
                const bool k0 = dir ? (s0 >= r32) : (s0 <= r32), k1 = dir ? (s1 >= r32) : (s1 <= r32); km[j] = (k0 ? 0xffffu : 0u) | (k1 ? 0xffff0000u : 0u); }
            f32x16 S4[4];
#pragma unroll
            for (int k = 0; k < 4; ++k)
#pragma unroll
                for (int r = 0; r < 16; ++r) S4[k][r] = 0.f;
            dma(0, 0); dma(1, 1); dma(2, 2);
            wait_bar(2);
            int slot = 0;
            for (int step = 0; step < 136; ++step) {
                if (step + 3 < 136) dma(step + 3, (slot + 3) & 3);
                if (wave < 2) {
                    const LAS unsigned char* sb = F.lds + slot * SLOT;
                    const int x15 = r32 & 15, x3 = (r32 >> 2) & 3;
                    const int trq = (lane & 15) >> 2, trp = lane & 3, trpp = ((trp & 1) << 1) | (trp >> 1), trg = (lane >> 4) & 1;
                    const LAS unsigned char* vbase = sb + 16384 + wave * 2048;
                    bf16x8 qdF[8], kiF[8];
#pragma unroll
                    for (int k = 0; k < 8; ++k) { qdF[k] = *(const LAS bf16x8*)(sb + 8192 + r32 * 256 + (((2 * k + hi) ^ x15) << 4)); kiF[k] = *(const LAS bf16x8*)(sb + r32 * 256 + (((2 * k + hi) ^ x15) << 4)); }
                    bf16x8 vF0, vF1;
                    { const int q4 = (lane & 15) >> 2, cw = wave * 4 + ((lane >> 4) & 1) * 2 + ((lane & 3) >> 1);
                      const LAS unsigned char* vq = sb + 16384 + (4 * hi + q4) * 128 + ((cw ^ (((q4 >> 1) & 1) << 1)) << 4) + (lane & 1) * 8;
                      const s16x4 a0 = vtr(vq), a1 = vtr(vq + 1024), b0 = vtr(vq + 2048), b1 = vtr(vq + 3072);
                      vF0 = (bf16x8){a0[0], a0[1], a0[2], a0[3], a1[0], a1[1], a1[2], a1[3]}; vF1 = (bf16x8){b0[0], b0[1], b0[2], b0[3], b1[0], b1[1], b1[2], b1[3]}; }
                    auto rd_kt = [&](int blk, bf16x8& kt0, bf16x8& kt1) {
                        const int chunk = 4 * blk + 2 * trg + (trpp >> 1); const int wb = (trpp & 1) * 8;
                        const int tl = 4 * hi + trq, th = tl + 8;
                        const LAS unsigned char* pl = sb + tl * 256 + ((chunk ^ tl) << 4) + wb; const LAS unsigned char* ph = sb + th * 256 + ((chunk ^ th) << 4) + wb;
                        const s16x4 a0 = vtr(pl), a1 = vtr(ph), b0 = vtr(pl + 4096), b1 = vtr(ph + 4096);
                        kt0 = (bf16x8){a0[0], a0[1], a0[2], a0[3], a1[0], a1[1], a1[2], a1[3]}; kt1 = (bf16x8){b0[0], b0[1], b0[2], b0[3], b1[0], b1[1], b1[2], b1[3]}; };
                    auto rd_e = [&](int blk, f32x4 (&e)[4]) {
#pragma unroll
                        for (int g = 0; g < 4; ++g) e[g] = *(const LAS f32x4*)(sb + 20480 + (32 * blk + 8 * g + 4 * hi) * 4); };
                    bf16x8 uk0, uk1; f32x4 ue[4];
                    rd_kt(0, uk0, uk1); rd_e(0, ue);
                    __builtin_amdgcn_sched_barrier(0);
                    f32x16 o;
#pragma unroll
                    for (int r = 0; r < 16; ++r) o[r] = 0.f;
                    if (step >= 8) {
                        f32x16 sc;
#pragma unroll
                        for (int r = 0; r < 16; ++r) sc[r] = 0.f;
#pragma unroll
                        for (int k = 0; k < 8; ++k) sc = __builtin_amdgcn_mfma_f32_32x32x16_bf16(kiF[k], qdF[k], sc, 0, 0, 0);
                        u32x4 w; bf16x8 pf0, pf1;
                        w.x = cvtpk(sc[0], sc[1]) & km[0]; w.y = cvtpk(sc[2], sc[3]) & km[1]; w.z = cvtpk(sc[4], sc[5]) & km[2]; w.w = cvtpk(sc[6], sc[7]) & km[3]; pf0 = __builtin_bit_cast(bf16x8, w);
                        w.x = cvtpk(sc[8], sc[9]) & km[4]; w.y = cvtpk(sc[10], sc[11]) & km[5]; w.z = cvtpk(sc[12], sc[13]) & km[6]; w.w = cvtpk(sc[14], sc[15]) & km[7]; pf1 = __builtin_bit_cast(bf16x8, w);
                        o = __builtin_amdgcn_mfma_f32_32x32x16_bf16(vF0, pf0, o, 0, 0, 0);
                        o = __builtin_amdgcn_mfma_f32_32x32x16_bf16(vF1, pf1, o, 0, 0, 0);
#pragma unroll
                        for (int blk = 0; blk < 4; ++blk)
#pragma unroll
                            for (int s2 = 0; s2 < 2; ++s2) { u32x4 ws4; ws4.x = cvtpk(S4[blk][8 * s2], S4[blk][8 * s2 + 1]); ws4.y = cvtpk(S4[blk][8 * s2 + 2], S4[blk][8 * s2 + 3]);
                                ws4.z = cvtpk(S4[blk][8 * s2 + 4], S4[blk][8 * s2 + 5]); ws4.w = cvtpk(S4[blk][8 * s2 + 6], S4[blk][8 * s2 + 7]);
                                o = __builtin_amdgcn_mfma_f32_32x32x16_bf16(__builtin_bit_cast(bf16x8, ws4), qdF[2 * blk + s2], o, 0, 0, 0); }
                        const int rc = rcof(step);
                        bf16_t* op = Odp + (size_t)(rc * 32 + r32) * D + hh * 256 + dvb * 32 + 8 * hi;
#pragma unroll
                        for (int g = 0; g < 4; g += 2) {
                            const unsigned ax = cvtpk(o[4 * g], o[4 * g + 1]), ay = cvtpk(o[4 * g + 2], o[4 * g + 3]), bx = cvtpk(o[4 * g + 4], o[4 * g + 5]), by = cvtpk(o[4 * g + 6], o[4 * g + 7]);
                            const auto sx = __builtin_amdgcn_permlane32_swap(ax, bx, false, false), sy = __builtin_amdgcn_permlane32_swap(ay, by, false, false);
                            u32x4 w4; w4.x = sx[0]; w4.y = sy[0]; w4.z = sx[1]; w4.w = sy[1];
                            *(u32x4*)(op + 8 * g) = w4; }
                    }
#pragma unroll
                    for (int blk = 0; blk < 4; ++blk) {
                        bf16x8 nk0 = uk0, nk1 = uk1; f32x4 ne[4] = {ue[0], ue[1], ue[2], ue[3]};
                        if (blk + 1 < 4) { rd_kt(blk + 1, nk0, nk1); rd_e(blk + 1, ne); }
                        __builtin_amdgcn_sched_barrier(0);
                        S4[blk] = __builtin_amdgcn_mfma_f32_32x32x16_bf16(uk0, vF0, S4[blk], 0, 0, 0);
                        S4[blk] = __builtin_amdgcn_mfma_f32_32x32x16_bf16(uk1, vF1, S4[blk], 0, 0, 0);
#pragma unroll
                        for (int g = 0; g < 4; ++g) { S4[blk][4 * g] *= ue[g][0]; S4[blk][4 * g + 1] *= ue[g][1]; S4[blk][4 * g + 2] *= ue[g][2]; S4[blk][4 * g + 3] *= ue[g][3]; }
                        uk0 = nk0; uk1 = nk1;
#pragma unroll
                        for (int g = 0; g < 4; ++g) ue[g] = ne[g];
                    }
                }
                wait_bar(step + 3 < 136 ? 2 : (step + 2 < 136 ? 1 : 0));
                slot = (slot + 1) & 3;
            }
        }
        if (!split) {
            LAS float* scr = (LAS float*)(F.lds + wave * 16640); int base = 0;
            for (int e = 0; e < NEXP; ++e) {
                conv64_run(Conv64{args.in[I_MWG] + (size_t)e * D * EXD, args.in[I_MWU] + (size_t)e * D * EXD, EXD, 1024, N_GU1, wsp<bf16_t>(F, O_WGU1) + (size_t)e * N_GU1 * 1024 / 2, 3, 0, 0, 64.0f, 3}, scr, lane, gw, NGW, base);
                conv64_run(Conv64{args.in[I_MWD] + (size_t)e * EXD * D, nullptr, 1024, EXD, 1024, wsp<bf16_t>(F, O_WD1) + (size_t)e * 1024 * EXD / 2, 0, 1024, 1024, 64.0f, 3}, scr, lane, gw, NGW, base);
            }
        }
        }
    }
    SEAM(15);

    if (IN(16)) {
        const bf16_t* OFp = wsp<bf16_t>(F, O_OF); const bf16_t* OBp = wsp<bf16_t>(F, O_OB); const bf16_t* G1 = wsp<bf16_t>(F, O_G1); bf16_t* GA = wsp<bf16_t>(F, O_GA);
        const float* on = args.in[I_GONORM];
        for (int row = gw; row < RL; row += NGW) {
            const u32x4* pf = (const u32x4*)(OFp + (size_t)row * D + lane * 16); const u32x4* pb = (const u32x4*)(OBp + (size_t)row * D + lane * 16); const u32x4* pg = (const u32x4*)(G1 + (size_t)row * D + lane * 16);
            float v[16], gv[16];
#pragma unroll
            for (int q = 0; q < 2; ++q) { const u32x4 a = pf[q], bq = pb[q], gq = pg[q]; const unsigned aw[4] = {a.x, a.y, a.z, a.w}, bw[4] = {bq.x, bq.y, bq.z, bq.w}, gw4[4] = {gq.x, gq.y, gq.z, gq.w};
#pragma unroll
                for (int j = 0; j < 4; ++j) { v[8 * q + 2 * j] = bflo(aw[j]) + bflo(bw[j]); v[8 * q + 2 * j + 1] = bfhi(aw[j]) + bfhi(bw[j]); gv[8 * q + 2 * j] = bflo(gw4[j]); gv[8 * q + 2 * j + 1] = bfhi(gw4[j]); } }
            float ss = 0.f;
#pragma unroll
            for (int j = 0; j < 16; ++j) ss += v[j] * v[j];
            ss = row_sum(ss);
            const float rstd = __builtin_amdgcn_rsqf(ss * (1.0f / 256.0f) + EPS);
            const int c0 = (lane & 15) * 16;
            unsigned ow[8];
#pragma unroll
            for (int j = 0; j < 8; ++j) { const float a = v[2 * j] * rstd * on[c0 + 2 * j] * silu_f(gv[2 * j]), bq = v[2 * j + 1] * rstd * on[c0 + 2 * j + 1] * silu_f(gv[2 * j + 1]); ow[j] = cvtpk(a, bq); }
            u32x4* po = (u32x4*)(GA + (size_t)row * D + lane * 16);
            u32x4 o0; o0.x = ow[0]; o0.y = ow[1]; o0.z = ow[2]; o0.w = ow[3]; po[0] = o0; u32x4 o1; o1.x = ow[4]; o1.y = ow[5]; o1.z = ow[6]; o1.w = ow[7]; po[1] = o1;
        }
    }
    SEAM(16);

    if (IN(17)) {
        pg8::DenseProb P{wsp<bf16_t>(F, O_GA), wsp<bf16_t>(F, O_WOUT1), 1024, 1024, 1024, {}}; P.ord.init(RL / 256, 4, F.G, (int)blockIdx.x);
        pg8::EpiBf16 E{(bf16_t*)Y, D, nullptr};
        pg8::gemm_phase(F.lds, P, E);
    }
    SEAM(17);

    if (IN(18)) {
        int* SEL = wsp<int>(F, O_SEL); int* ROWTOK = wsp<int>(F, O_ROWTOK);
        LAS float* wr_l = (LAS float*)F.lds;
        LAS int* se = (LAS int*)(F.lds + 32768);
        LAS float* sw = (LAS float*)(F.lds + 32768 + 512);
        LAS int* sbase = (LAS int*)(F.lds + 32768 + 1024);
        for (int i = tid; i < 8192; i += 512) { const int blk = i >> 5, c = (i >> 2) & 7; wr_l[(blk << 5) + ((c ^ ((blk >> 1) & 7)) << 2) + (i & 3)] = args.in[I_MROUTER][i]; }
        __syncthreads();
        for (int tile = F.vcu; tile < RL / 64; tile += F.G) {
            for (int rr = 0; rr < 8; rr += 2) {
                u32x2 yr[2][4]; f32x4 h2[2][4];
#pragma unroll
                for (int q = 0; q < 2; ++q) { const int row = tile * 64 + wave * 8 + rr + q; ld_yh((const bf16_t*)Y + (size_t)row * D, args.out + (size_t)row * D, yr[q], h2[q]); }
#pragma unroll
                for (int q = 0; q < 2; ++q) {
                const int lr = wave * 8 + rr + q, row = tile * 64 + lr; const int b = row >> 12;
                float* hp = args.out + (size_t)row * D;
                f32x4 y[4], uo[4]; cvt_y(yr[q], y); f32x4 (&h)[4] = h2[q];
                const float rstd = __builtin_amdgcn_rsqf(row_ssq(y) * (1.0f / D) + EPS);
#pragma unroll
                for (int j = 0; j < 4; ++j) { const int c = 4 * lane + 256 * j; const f32x4 g = *(const f32x4*)(normg + 5 * D + c), mg = *(const f32x4*)(MV(1, b, 2) + c);
                    h[j] = h[j] + mg * (y[j] * rstd * g); *(f32x4*)(hp + c) = h[j]; }
                norm_mod_store(h, normg + 6 * D, MV(1, b, 3), MV(1, b, 4), nullptr, lane, uo, wsp<unsigned char>(F, O_U) + (size_t)row * D);
                float lg[8];
#pragma unroll
                for (int e = 0; e < 8; ++e) lg[e] = 0.f;
#pragma unroll
                for (int j = 0; j < 4; ++j)
#pragma unroll
                    for (int q2 = 0; q2 < 4; ++q2) { const int blk = lane + 64 * j, sw = (lane >> 1) & 7; const LAS f32x4* wp = (const LAS f32x4*)(wr_l + blk * 32); const f32x4 w0 = wp[(2 * q2) ^ sw], w1 = wp[(2 * q2 + 1) ^ sw]; const float uv = uo[j][q2];
                        lg[0] += uv * w0[0]; lg[1] += uv * w0[1]; lg[2] += uv * w0[2]; lg[3] += uv * w0[3]; lg[4] += uv * w1[0]; lg[5] += uv * w1[1]; lg[6] += uv * w1[2]; lg[7] += uv * w1[3]; }
#pragma unroll
                for (int e = 0; e < 8; ++e) lg[e] = wave_sum(lg[e]) + args.in[I_MBROUTER][e];
                int e0 = 0; float l0 = lg[0];
#pragma unroll
                for (int e = 1; e < 8; ++e) if (lg[e] > l0) { l0 = lg[e]; e0 = e; }
                int e1 = -1; float l1 = -3.0e38f;
#pragma unroll
                for (int e = 0; e < 8; ++e) if (e != e0 && lg[e] > l1) { l1 = lg[e]; e1 = e; }
                const float p1 = __expf(l1 - l0), w0n = 1.0f / (1.0f + p1), w1n = p1 / (1.0f + p1);
                if (lane == 0) { se[lr * 2] = e0; se[lr * 2 + 1] = e1; sw[lr * 2] = w0n; sw[lr * 2 + 1] = w1n; }
                }
            }
            asm volatile("s_waitcnt lgkmcnt(0)\n\ts_barrier" ::: "memory");
            if (wave == 0) {
                const int e0 = se[2 * lane], e1 = se[2 * lane + 1]; const unsigned long long lt = (1ull << lane) - 1ull;
                int r0 = 0, r1 = 0, mycnt = 0;
#pragma unroll
                for (int e = 0; e < 8; ++e) { const unsigned long long b0 = __ballot(e0 == e), b1 = __ballot(e1 == e);
                    const int below = __popcll(b0 & lt) + __popcll(b1 & lt), tot = __popcll(b0) + __popcll(b1);
                    if (e0 == e) r0 = below; if (e1 == e) r1 = below; if (lane == e) mycnt = tot; }
                int base = 0;
                if (lane < 8) base = (int)__hip_atomic_fetch_add(ctl + CW_CNT + 64 * lane, (unsigned)mycnt, RLX_AGENT);
                const int p0 = __builtin_amdgcn_ds_bpermute(e0 << 2, base) + r0, p1 = __builtin_amdgcn_ds_bpermute(e1 << 2, base) + r1, tok = tile * 64 + lane;
                ROWTOK[e0 * CAPE + p0] = tok; ROWTOK[e1 * CAPE + p1] = tok;
                int* sp = SEL + (size_t)tok * 8; sp[0] = e0; sp[1] = p0; sp[2] = e1; sp[3] = p1; sp[4] = __float_as_int(sw[2 * lane]); sp[5] = __float_as_int(sw[2 * lane + 1]); }
            asm volatile("s_waitcnt lgkmcnt(0)\n\ts_barrier" ::: "memory");
        }
    }
    SEAM(18);

    pg8::MoeTiles MT;
    if (IN(19) || IN(20) || IN(21)) {
        int acc = 0; MT.tp8 = 0ull; MT.c4a = 0ull; MT.c4b = 0ull;
#pragma unroll
        for (int e = 0; e < 8; ++e) { const int c = (int)__builtin_amdgcn_readfirstlane((int)__hip_atomic_load(ctl + CW_CNT + 64 * e, RLX_AGENT));
            if (e < 4) MT.c4a |= (unsigned long long)(unsigned)c << (16 * e); else MT.c4b |= (unsigned long long)(unsigned)c << (16 * (e - 4));
            MT.tp8 |= (unsigned long long)(unsigned)acc << (8 * e); acc += (c + 255) >> 8; }
        MT.nt = acc;
    }
    if (IN(19)) {
        pg8::MoeGuProb P{wsp<unsigned char>(F, O_U), wsp<unsigned char>(F, O_WGU1), 512, 512, {}, MT, wsp<int>(F, O_ROWTOK)}; P.ord.init(MT.nt, N_GU1 / 256, F.G, (int)blockIdx.x);
        pg8::EpiSwiglu8 E{wsp<unsigned char>(F, O_HM), EXD};
        pg8::gemm_phase(F.lds, P, E);
    }
    SEAM(19);
    if (IN(20)) {
        pg8::MoeDnProb P{wsp<unsigned char>(F, O_HM), wsp<unsigned char>(F, O_WD1), EXD / 2, EXD / 2, {}, MT}; P.ord.init(MT.nt, 4, F.G, (int)blockIdx.x);
        pg8::EpiBf16 E{wsp<bf16_t>(F, O_YE), D, nullptr};
        pg8::gemm_phase(F.lds, P, E);
    }
    SEAM(20);
    if (IN(21)) {
        const int* SEL = wsp<int>(F, O_SEL); const bf16_t* YE = wsp<bf16_t>(F, O_YE);
        for (int row0 = gw; row0 < RL; row0 += 2 * NGW) {
            const int rw[2] = {row0, row0 + NGW}; const bool has[2] = {true, row0 + NGW < RL};
            const bf16_t* y0[2]; const bf16_t* y1[2]; float w0[2], w1[2];
#pragma unroll
            for (int q = 0; q < 2; ++q) { const int* sp = SEL + (size_t)(has[q] ? rw[q] : row0) * 8;
                const int e0 = sp[0], p0 = sp[1], e1 = sp[2], p1 = sp[3]; w0[q] = __int_as_float(sp[4]); w1[q] = __int_as_float(sp[5]);
                y0[q] = YE + ((size_t)pg8::moe_tp(MT, e0) * 256 + p0) * D; y1[q] = YE + ((size_t)pg8::moe_tp(MT, e1) * 256 + p1) * D; }
            u32x2 ar[2][4], br[2][4]; f32x4 h[2][4];
#pragma unroll
            for (int q = 0; q < 2; ++q) { if (!has[q]) continue; const float* hp = args.out + (size_t)rw[q] * D;
#pragma unroll
                for (int j = 0; j < 4; ++j) { const int c = 4 * lane + 256 * j; ar[q][j] = *(const u32x2*)(y0[q] + c); br[q][j] = *(const u32x2*)(y1[q] + c); h[q][j] = *(const f32x4*)(hp + c); } }
#pragma unroll
            for (int q = 0; q < 2; ++q) { if (!has[q]) continue; const int b = rw[q] >> 12; float* hp = args.out + (size_t)rw[q] * D; f32x4 y[4];
#pragma unroll
                for (int j = 0; j < 4; ++j) { const u32x2 a = ar[q][j], bq = br[q][j];
                    y[j][0] = w0[q] * bflo(a.x) + w1[q] * bflo(bq.x); y[j][1] = w0[q] * bfhi(a.x) + w1[q] * bfhi(bq.x); y[j][2] = w0[q] * bflo(a.y) + w1[q] * bflo(bq.y); y[j][3] = w0[q] * bfhi(a.y) + w1[q] * bfhi(bq.y); }
                const float rstd = __builtin_amdgcn_rsqf(row_ssq(y) * (1.0f / D) + EPS);
#pragma unroll
                for (int j = 0; j < 4; ++j) { const int c = 4 * lane + 256 * j; const f32x4 g = *(const f32x4*)(normg + 7 * D + c), mg = *(const f32x4*)(MV(1, b, 5) + c);
                    __builtin_nontemporal_store(h[q][j] + mg * (y[j] * rstd * g), (f32x4*)(hp + c)); } }
        }
    }
#undef IN
#undef SEAM
#undef MV
}

constexpr int N_PHASES = 22;
extern "C" void kernel_launch(void* const* d_in, const int* in_sizes, int n_in, void* d_out, int out_size, void* d_ws, size_t ws_size, hipStream_t stream) {
    static int grid = 0;
    if (grid == 0) {
        if (n_in != 27 || out_size != RL * D || ws_size < WS_END) { fprintf(stderr, "kernel_launch: unexpected shapes n_in %d out %d ws %zu (need %zu)\n", n_in, out_size, ws_size, (size_t)WS_END); grid = -1; return; }
        int dev = 0, cus = 0, per_cu = 0;
        if (hipGetDevice(&dev) != hipSuccess || hipDeviceGetAttribute(&cus, hipDeviceAttributeMultiprocessorCount, dev) != hipSuccess) { grid = -1; return; }
        if (hipFuncSetAttribute((const void*)mk_fwd, hipFuncAttributeMaxDynamicSharedMemorySize, LDS_BYTES) != hipSuccess) { fprintf(stderr, "kernel_launch: hipFuncSetAttribute failed\n"); grid = -1; return; }
        if (hipOccupancyMaxActiveBlocksPerMultiprocessor(&per_cu, (const void*)mk_fwd, 512, LDS_BYTES) != hipSuccess || per_cu < 1) { fprintf(stderr, "kernel_launch: occupancy query says %d\n", per_cu); }
        (void)hipGetLastError();
        grid = cus;
        if (grid > 256) grid = 256;
    }
    if (grid < 0) return;
    (void)hipMemsetAsync((char*)d_ws + O_CTL, 0, CTL_BYTES, stream);
    Args a{};
    for (int i = 0; i < 27; ++i) a.in[i] = (const float*)d_in[i];
    a.out = (float*)d_out; a.ws = (unsigned char*)d_ws;
#if MK_ONE_LAUNCH
    a.ph_lo = 0; a.ph_hi = N_PHASES;
    hipLaunchKernelGGL(mk_fwd, dim3(grid), dim3(512), LDS_BYTES, stream, a);
#else
    for (int p = 0; p < N_PHASES; ++p) { a.ph_lo = p; a.ph_hi = p + 1; for (int rep = 0; rep < (p == MK_REP ? 2 : 1); ++rep) hipLaunchKernelGGL(mk_fwd, dim3(grid), dim3(512), LDS_BYTES, stream, a); }
#endif
}
```
